# Optimizing an MI355X kernel written in HIP

```python
import jax, jax.numpy as jnp
from jax import lax
import numpy as np

D_MODEL = 2048
BATCH = 4
SEQ = 4096
DEPTH = 1

GRID_W = 64
CTX_LEN = 256

POOL_WINDOWS = (2, 4, 8, 16)
POOL_GROUPS = 4
POOL_GROUP = 256
D_POOL = POOL_GROUPS * POOL_GROUP

HEAD_SIZE = 64
D_ATT = D_MODEL
N_HEADS = D_ATT // HEAD_SIZE
D_DECAY_LORA = 96
D_ICLR_LORA = 96
D_GATE_LORA = 256
GN_EPS = 64e-5
D_SHIFT = 3 * D_ATT + 2 * D_DECAY_LORA + 2 * D_ICLR_LORA + D_GATE_LORA
SHIFT_SPLITS = (D_ATT, 2 * D_ATT, 3 * D_ATT,
                3 * D_ATT + D_DECAY_LORA,
                3 * D_ATT + 2 * D_DECAY_LORA,
                3 * D_ATT + 2 * D_DECAY_LORA + D_ICLR_LORA,
                3 * D_ATT + 2 * D_DECAY_LORA + 2 * D_ICLR_LORA)

D_IN = D_POOL + D_SHIFT + 2 * D_MODEL
IN_SPLITS = (D_POOL, D_POOL + D_SHIFT)

N_EXPERTS = 64
TOP_K = 8
N_GROUPS = 8
TOPK_GROUPS = 4
D_EXPERT = 512
D_SHARED = 512
ROUTED_SCALE = 2.5
MOE_BLOCK = 128

NORM_EPS = 1e-6

kernel_name = "hybrid_pool_rwkv7_moe_prefix_dit_layer"


def rms_norm(x, g):
    xf = x.astype(jnp.float32)
    y = xf * lax.rsqrt(jnp.mean(xf * xf, axis=-1, keepdims=True) + NORM_EPS)
    return (y * g.astype(jnp.float32)).astype(x.dtype)


def grid_shift(u, rows):
    B, T, C = u.shape
    g = u.reshape(B, rows, GRID_W, C // 4, 4)
    left = jnp.pad(g[:, :, :-1, :, 0], ((0, 0), (0, 0), (1, 0), (0, 0)))
    right = jnp.pad(g[:, :, 1:, :, 1], ((0, 0), (0, 0), (0, 1), (0, 0)))
    up = jnp.pad(g[:, :-1, :, :, 2], ((0, 0), (1, 0), (0, 0), (0, 0)))
    down = jnp.pad(g[:, 1:, :, :, 3], ((0, 0), (0, 1), (0, 0), (0, 0)))
    return jnp.stack([left, right, up, down], axis=-1).reshape(B, T, C)


def seq_shift(u):
    B, T, C = u.shape
    g = u.reshape(B, T, C // 2, 2)
    prev = jnp.pad(g[:, :-1, :, 0], ((0, 0), (1, 0), (0, 0)))
    nxt = jnp.pad(g[:, 1:, :, 1], ((0, 0), (0, 1), (0, 0)))
    return jnp.stack([prev, nxt], axis=-1).reshape(B, T, C)


def multiscale_pool(u):
    L = u.shape[-2]
    uf = u.astype(jnp.float32)
    cs = jnp.cumsum(uf, axis=-2)
    cs = jnp.concatenate([jnp.zeros_like(cs[..., :1, :]), cs], axis=-2)
    t = jnp.arange(L)
    outs = []
    for gi, w in enumerate(POOL_WINDOWS):
        sl = slice(gi * POOL_GROUP, (gi + 1) * POOL_GROUP)
        cg = cs[..., sl]
        lo = jnp.clip(t - w // 2, 0, L)
        hi = jnp.clip(t + (w - w // 2), 0, L)
        win_sum = jnp.take(cg, hi, axis=-2) - jnp.take(cg, lo, axis=-2)
        mean = win_sum / (hi - lo).astype(jnp.float32)[:, None]
        outs.append(mean - uf[..., sl])
    return jnp.concatenate(outs, axis=-1).astype(u.dtype)


def pool_branch(u, pool_w, pool_scale, w_pool_out):
    d = multiscale_pool(u)
    d = d.reshape(d.shape[:-1] + (POOL_GROUPS, POOL_GROUP))
    y = jnp.einsum('...gc,gcd->...gd', d, pool_w)
    y = y.reshape(y.shape[:-2] + (D_POOL,)) * pool_scale
    return y @ w_pool_out


def rwkv_prepare(s, w0, w2, a0, a2, k_k, k_a):
    B, T, _ = s.shape
    f32 = jnp.float32
    r, k, v, wd_f, wd_b, ad_f, ad_b, gd = jnp.split(s, SHIFT_SPLITS, axis=-1)

    def heads(a):
        return a.astype(f32).reshape(B, T, N_HEADS, HEAD_SIZE)

    def decay(wd, w0_d, w2_d):
        w = -jax.nn.softplus(-(w0_d + jnp.tanh(wd) @ w2_d).astype(f32)) - 0.5
        return heads(jnp.exp(-jnp.exp(w)))

    def iclr(ad, a0_d, a2_d):
        return heads(jax.nn.sigmoid((a0_d + ad @ a2_d).astype(f32)))

    kh = heads(k)
    kk = kh * k_k.astype(f32).reshape(N_HEADS, HEAD_SIZE)
    kk = kk * lax.rsqrt(jnp.sum(kk * kk, axis=-1, keepdims=True) + 1e-12)
    ka = k_a.astype(f32).reshape(N_HEADS, HEAD_SIZE)
    a_f = iclr(ad_f, a0[0], a2[0])
    a_b = iclr(ad_b, a0[1], a2[1])
    k_f = kh * (1.0 + (a_f - 1.0) * ka)
    k_b = kh * (1.0 + (a_b - 1.0) * ka)
    return (heads(r), heads(v), kk,
            decay(wd_f, w0[0], w2[0]), decay(wd_b, w0[1], w2[1]),
            k_f, k_b, kk * a_f, kk * a_b, gd)


def wkv_scan(s0, r, w, k, v, kk, b, reverse, emit):
    def tm(a):
        return jnp.moveaxis(a, 1, 0)

    def step(S, inp):
        r_t, w_t, k_t, v_t, kk_t, b_t = inp
        S = (S * w_t[:, :, None, :]
             - jnp.einsum('bhij,bhj->bhi', S, kk_t)[..., None] * b_t[:, :, None, :]
             + v_t[..., None] * k_t[:, :, None, :])
        y = jnp.einsum('bhij,bhj->bhi', S, r_t) if emit else None
        return S, y

    S, ys = lax.scan(step, s0, (tm(r), tm(w), tm(k), tm(v), tm(kk), tm(b)), reverse=reverse)
    return S, (jnp.moveaxis(ys, 0, 1) if emit else None)


def rwkv_readout(y, r, v, k_f, k_b, gd, g2, r_k, lnx_w, lnx_b, w_rwkv_out):
    B, T = y.shape[:2]
    f32 = jnp.float32
    mean = jnp.mean(y, axis=-1, keepdims=True)
    var = jnp.mean(jnp.square(y - mean), axis=-1, keepdims=True)
    yn = ((y - mean) * lax.rsqrt(var + GN_EPS)).reshape(B, T, D_ATT)
    yn = yn * lnx_w.astype(f32) + lnx_b.astype(f32)
    bonus = jnp.sum(r * (k_f + k_b) * r_k.astype(f32), axis=-1, keepdims=True) * v
    g = (jax.nn.sigmoid(gd) @ g2).astype(f32)
    out = (yn + bonus.reshape(B, T, D_ATT)) * g
    return out.astype(gd.dtype) @ w_rwkv_out


def merge_branches(y_pool, y_rwkv, gates, w_out_l):
    g_pool, g_rwkv = jnp.split(gates, 2, axis=-1)
    return (jax.nn.sigmoid(g_pool) * y_pool + jax.nn.sigmoid(g_rwkv) * y_rwkv) @ w_out_l


def moe_ffn(h, router_w, router_bias, w_gate, w_up, w_down, sh_gate, sh_up, sh_down):
    shp = h.shape
    f32 = jnp.float32
    ht = h.reshape(-1, D_MODEL)
    n = ht.shape[0]
    scores = jax.nn.sigmoid((ht @ router_w).astype(f32))
    sel = scores + router_bias.astype(f32)
    grp = sel.reshape(n, N_GROUPS, N_EXPERTS // N_GROUPS)
    grp_score = jnp.sum(lax.top_k(grp, 2)[0], axis=-1)
    _, gidx = lax.top_k(grp_score, TOPK_GROUPS)
    gmask = jnp.sum(jax.nn.one_hot(gidx, N_GROUPS, dtype=f32), axis=-2)
    emask = jnp.repeat(gmask, N_EXPERTS // N_GROUPS, axis=-1)
    _, eidx = lax.top_k(jnp.where(emask > 0, sel, -jnp.inf), TOP_K)
    wsel = jnp.take_along_axis(scores, eidx, axis=-1)
    wsel = wsel / jnp.sum(wsel, axis=-1, keepdims=True) * ROUTED_SCALE

    nk = n * TOP_K
    cap = nk + N_EXPERTS * MOE_BLOCK
    n_blocks = cap // MOE_BLOCK
    e_flat = eidx.reshape(-1)
    tok_flat = jnp.repeat(jnp.arange(n, dtype=jnp.int32), TOP_K)
    oh = jax.nn.one_hot(e_flat, N_EXPERTS, dtype=jnp.int32)
    csum = jnp.cumsum(oh, axis=0)
    rank = jnp.take_along_axis(csum, e_flat[:, None], axis=-1)[:, 0] - 1
    counts = csum[-1]
    padded = (counts + MOE_BLOCK - 1) // MOE_BLOCK * MOE_BLOCK
    pstarts = jnp.cumsum(padded) - padded
    dest = pstarts[e_flat] + rank
    tok_buf = jnp.zeros((cap,), jnp.int32).at[dest].set(tok_flat)
    w_buf = jnp.zeros((cap,), f32).at[dest].set(wsel.reshape(-1))
    block_start = jnp.arange(n_blocks, dtype=jnp.int32) * MOE_BLOCK
    block_expert = jnp.minimum(
        jnp.sum(block_start[:, None] >= (pstarts + padded)[None, :], axis=-1), N_EXPERTS - 1)

    def expert_block(args):
        tok, wgt, e = args
        hb = ht[tok]
        act = jax.nn.silu(hb @ w_gate[e]) * (hb @ w_up[e])
        return (act @ w_down[e]) * wgt[:, None].astype(hb.dtype)

    y = lax.map(expert_block, (tok_buf.reshape(n_blocks, MOE_BLOCK),
                               w_buf.reshape(n_blocks, MOE_BLOCK), block_expert))
    routed = jnp.zeros_like(ht).at[tok_buf].add(y.reshape(cap, D_MODEL))
    shared = (jax.nn.silu(ht @ sh_gate) * (ht @ sh_up)) @ sh_down
    return (routed + shared).reshape(shp)


def setup_inputs(seed: int = 0) -> dict:
    key = jax.random.key(seed)
    keys = jax.random.split(key, 40)
    counter = iter(range(40))

    def nrm(shape, scale):
        return jax.random.normal(keys[next(counter)], shape, jnp.float32) * scale

    def uni(shape, lo, hi):
        return jax.random.uniform(keys[next(counter)], shape, jnp.float32, lo, hi)

    L, D = DEPTH, D_MODEL
    return {
        "x": nrm((BATCH, SEQ, D), 1.0),
        "c": nrm((BATCH, D), 1.0),
        "ctx": nrm((BATCH, CTX_LEN, D), 1.0),
        "c_ctx": nrm((D,), 1.0),
        "norm1_g": 1.0 + nrm((L, D), 0.05),
        "norm2_g": 1.0 + nrm((L, D), 0.05),
        "ada_w": nrm((L, D, 6 * D), 0.5 * D ** -0.5),
        "ada_b": nrm((L, 6 * D), 0.02),
        "w_in": nrm((L, D, D_IN), D ** -0.5),
        "shift_mu": uni((L, D_SHIFT), 0.0, 1.0),
        "pool_w": nrm((L, POOL_GROUPS, POOL_GROUP, POOL_GROUP), POOL_GROUP ** -0.5),
        "pool_scale": 1.0 + nrm((L, D_POOL), 0.1),
        "w_pool_out": nrm((L, D_POOL, D), D_POOL ** -0.5),
        "decay_w0": uni((L, 2, D_ATT), -6.0, 0.0),
        "decay_w2": nrm((L, 2, D_DECAY_LORA, D_ATT), 0.5 * D_DECAY_LORA ** -0.5),
        "iclr_a0": nrm((L, 2, D_ATT), 0.5),
        "iclr_a2": nrm((L, 2, D_ICLR_LORA, D_ATT), 0.5 * D_ICLR_LORA ** -0.5),
        "gate_g2": nrm((L, D_GATE_LORA, D_ATT), D_GATE_LORA ** -0.5),
        "k_k": 0.85 + nrm((L, D_ATT), 0.1),
        "k_a": 1.0 + nrm((L, D_ATT), 0.1),
        "r_k": nrm((L, N_HEADS, HEAD_SIZE), 0.1),
        "lnx_w": 1.0 + nrm((L, D_ATT), 0.05),
        "lnx_b": nrm((L, D_ATT), 0.02),
        "w_rwkv_out": nrm((L, D_ATT, D), D_ATT ** -0.5),
        "w_out": nrm((L, D, D), D ** -0.5),
        "router_w": nrm((L, D, N_EXPERTS), D ** -0.5),
        "router_bias": nrm((L, N_EXPERTS), 0.01),
        "exp_w_gate": nrm((L, N_EXPERTS, D, D_EXPERT), D ** -0.5),
        "exp_w_up": nrm((L, N_EXPERTS, D, D_EXPERT), D ** -0.5),
        "exp_w_down": nrm((L, N_EXPERTS, D_EXPERT, D), D_EXPERT ** -0.5),
        "shared_w_gate": nrm((L, D, D_SHARED), D ** -0.5),
        "shared_w_up": nrm((L, D, D_SHARED), D ** -0.5),
        "shared_w_down": nrm((L, D_SHARED, D), D_SHARED ** -0.5),
        "final_g": 1.0 + nrm((D,), 0.05),
    }


def reference(x, c, ctx, c_ctx, norm1_g, norm2_g, ada_w, ada_b, w_in, shift_mu, pool_w,
              pool_scale, w_pool_out, decay_w0, decay_w2, iclr_a0, iclr_a2, gate_g2, k_k, k_a,
              r_k, lnx_w, lnx_b, w_rwkv_out, w_out, router_w, router_bias, exp_w_gate, exp_w_up,
              exp_w_down, shared_w_gate, shared_w_up, shared_w_down, final_g):
    B, T, _ = x.shape
    rows = T // GRID_W
    s0 = jnp.zeros((B, N_HEADS, HEAD_SIZE, HEAD_SIZE), jnp.float32)
    xc = ctx
    for l in range(DEPTH):
        last = l == DEPTH - 1
        rw = (decay_w0[l], decay_w2[l], iclr_a0[l], iclr_a2[l], k_k[l], k_a[l])
        ro = (gate_g2[l], r_k[l], lnx_w[l], lnx_b[l], w_rwkv_out[l])
        po = (pool_w[l], pool_scale[l], w_pool_out[l])
        moe = (router_w[l], router_bias[l], exp_w_gate[l], exp_w_up[l], exp_w_down[l],
               shared_w_gate[l], shared_w_up[l], shared_w_down[l])

        mod = jax.nn.silu(c) @ ada_w[l] + ada_b[l]
        sh1, sc1, gt1, sh2, sc2, gt2 = [m[:, None, :] for m in jnp.split(mod, 6, axis=-1)]
        modc = jax.nn.silu(c_ctx) @ ada_w[l] + ada_b[l]
        sh1c, sc1c, gt1c, sh2c, sc2c, gt2c = jnp.split(modc, 6, axis=-1)

        hc = rms_norm(xc, norm1_g[l]) * (1.0 + sc1c) + sh1c
        if last:
            slab_c = hc @ w_in[l][:, D_POOL:D_POOL + D_SHIFT]
        else:
            uc, slab_c, gates_c = jnp.split(hc @ w_in[l], IN_SPLITS, axis=-1)
        slab_c = slab_c + (seq_shift(slab_c) - slab_c) * shift_mu[l]
        rc, vc, kkc, wfc, wbc, kfc, kbc, bfc, bbc, gdc = rwkv_prepare(slab_c, *rw)
        st_f, yc_f = wkv_scan(s0, rc, wfc, kfc, vc, kkc, bfc, False, not last)
        st_b, yc_b = wkv_scan(s0, rc, wbc, kbc, vc, kkc, bbc, True, not last)

        h = rms_norm(x, norm1_g[l]) * (1.0 + sc1) + sh1
        u, slab, gates = jnp.split(h @ w_in[l], IN_SPLITS, axis=-1)
        slab = slab + (grid_shift(slab, rows) - slab) * shift_mu[l]
        r, v, kk, wf, wb, kf, kb, bf, bb, gd = rwkv_prepare(slab, *rw)
        _, y_f = wkv_scan(st_f, r, wf, kf, v, kk, bf, False, True)
        _, y_b = wkv_scan(st_b, r, wb, kb, v, kk, bb, True, True)
        y_rwkv = rwkv_readout(y_f + y_b, r, v, kf, kb, gd, *ro)
        y_pool = pool_branch(u.reshape(B, rows, GRID_W, D_POOL), *po).reshape(B, T, D_MODEL)
        x = x + gt1 * merge_branches(y_pool, y_rwkv, gates, w_out[l])

        x = x + gt2 * moe_ffn(rms_norm(x, norm2_g[l]) * (1.0 + sc2) + sh2, *moe)

        if not last:
            yc_rwkv = rwkv_readout(yc_f + yc_b, rc, vc, kfc, kbc, gdc, *ro)
            yc_pool = pool_branch(uc, *po)
            xc = xc + gt1c * merge_branches(yc_pool, yc_rwkv, gates_c, w_out[l])
            xc = xc + gt2c * moe_ffn(rms_norm(xc, norm2_g[l]) * (1.0 + sc2c) + sh2c, *moe)
    return rms_norm(x, final_g)
```

```cpp
#include <hip/hip_runtime.h>
#include <cstdio>
#include <cstdint>

#define GAS __attribute__((address_space(1)))
#define LAS __attribute__((address_space(3)))
typedef unsigned short bf16;
typedef unsigned v4u __attribute__((ext_vector_type(4)));
typedef unsigned v2u __attribute__((ext_vector_type(2)));
typedef float f32x4 __attribute__((ext_vector_type(4)));
typedef float f32x2 __attribute__((ext_vector_type(2)));
typedef short bf16x8 __attribute__((ext_vector_type(8)));

constexpr int D = 2048, NB = 4, TSEQ = 4096, NT = NB * TSEQ  , CTXL = 256, NC = NB * CTXL  , MT = NT + NC  ;
constexpr int DIN = 11904, DSH = 6784, NPAD = 12032, SLABLD = 6912, NH = 32, HS = 64;
constexpr int NEXP = 64, DEXP = 512, TOPK = 8;
constexpr int NSLOT = NT * TOPK + NEXP * 256 + NT;
constexpr int MAXTILES = NSLOT / 256;
constexpr int LINLD = 768;

__device__ __forceinline__ unsigned f2bf(float f) { unsigned u = __builtin_bit_cast(unsigned, f); return (u + 0x7fffu + ((u >> 16) & 1u)) >> 16; }
__device__ __forceinline__ unsigned pk2(float lo, float hi) { unsigned r; asm volatile("v_cvt_pk_bf16_f32 %0, %1, %2" : "=v"(r) : "v"(lo), "v"(hi)); return r; }
__device__ __forceinline__ float bflo(unsigned w) { return __builtin_bit_cast(float, w << 16); }
__device__ __forceinline__ float bfhi(unsigned w) { return __builtin_bit_cast(float, w & 0xffff0000u); }
__device__ __forceinline__ unsigned pkh2(float lo, float hi) { const unsigned short a = __builtin_bit_cast(unsigned short, (_Float16)lo), b = __builtin_bit_cast(unsigned short, (_Float16)hi); return (unsigned)a | ((unsigned)b << 16); }
__device__ __forceinline__ float hlo(unsigned w) { return (float)__builtin_bit_cast(_Float16, (unsigned short)(w & 0xffffu)); }
__device__ __forceinline__ float hhi(unsigned w) { return (float)__builtin_bit_cast(_Float16, (unsigned short)(w >> 16)); }
__device__ __forceinline__ float sigmoidf_(float x) { return 1.0f / (1.0f + __expf(-x)); }
__device__ __forceinline__ float wave_sum(float v) {
#pragma unroll
    for (int o = 1; o < 64; o <<= 1) v += __shfl_xor(v, o);
    return v;
}
__device__ __forceinline__ float dpp_f(float v, const int ctrl_sel) {
    int r;
    const int x = __builtin_bit_cast(int, v);
    if (ctrl_sel == 0) r = __builtin_amdgcn_update_dpp(0, x, 0xB1, 0xF, 0xF, true);
    else if (ctrl_sel == 1) r = __builtin_amdgcn_update_dpp(0, x, 0x4E, 0xF, 0xF, true);
    else if (ctrl_sel == 2) r = __builtin_amdgcn_update_dpp(0, x, 0x141, 0xF, 0xF, true);
    else r = __builtin_amdgcn_update_dpp(0, x, 0x140, 0xF, 0xF, true);
    return __builtin_bit_cast(float, r);
}
__device__ __forceinline__ float allred16(float v) { v += dpp_f(v, 0); v += dpp_f(v, 1); v += dpp_f(v, 2); v += dpp_f(v, 3); return v; }

#define LDS_WAIT() asm volatile("s_waitcnt lgkmcnt(0)" ::: "memory")
#define VM_WAIT() asm volatile("s_waitcnt vmcnt(0)" ::: "memory")

namespace pg8 {
constexpr int BM = 256, BK = 64, HALF = 128, HTB = HALF * BK * 2, STAGE_BYTES = 8 * HTB, NXCD = 8, WGM = 8;
__host__ __device__ __forceinline__ int lds_byte(int r, int c) { const int st = (r >> 4) * 2 + (c >> 5), rr = r & 15, cc = c & 31, ob = rr * 64 + cc * 2; return st * 1024 + (ob ^ (((ob >> 9) & 1) << 5)); }
__host__ __device__ __forceinline__ void stage_rc(int b, int& R, int& C) { const int st = b / 1024, sb = b % 1024, swz = sb ^ (((sb >> 9) & 1) << 5); R = (st >> 1) * 16 + swz / 64; C = (st & 1) * 32 + (swz % 64) / 2; }
__host__ __device__ __forceinline__ int perm32(int rho) { const int n = rho >> 4, i = rho & 15; return 8 * (i >> 2) + 4 * n + (i & 3); }
struct Unit { const char* A; const char* B; int pm, pn, aux; };
__device__ __forceinline__ int xcd_remap(int L, int nwg) { const int q = nwg / NXCD, r = nwg % NXCD, xcd = L % NXCD, off = L / NXCD; return (xcd < r ? xcd * (q + 1) : r * (q + 1) + (xcd - r) * q) + off; }
__device__ __forceinline__ void grid_tile(int wgid, int nM, int nN, int& pm, int& pn) { const int nig = WGM * nN, gid = wgid / nig, fm = gid * WGM, gsz = (nM - fm) < WGM ? (nM - fm) : WGM; pm = fm + ((wgid % nig) % gsz); pn = (wgid % nig) / gsz; }

__device__ __forceinline__ void stage2(LAS unsigned char* lds, int bufoff, unsigned ldsw, const char* g, unsigned o0, unsigned o1) {
    __builtin_amdgcn_global_load_lds((const unsigned*)(g + o0), (LAS unsigned*)(lds + bufoff + ldsw), 16, 0, 0);
    __builtin_amdgcn_global_load_lds((const unsigned*)(g + o1), (LAS unsigned*)(lds + bufoff + ldsw + 8192), 16, 0, 0);
}

template <class Epi, class Sched, bool GATHER>
__device__ __forceinline__ void gemm_phase(LAS unsigned char* lds, const int wave_, const int K, const int lda, const int ldb, const Sched& S, const Epi& E) {
    int tid_ = wave_ * 64 + (int)__builtin_amdgcn_mbcnt_hi(~0u, __builtin_amdgcn_mbcnt_lo(~0u, 0u)); asm volatile("" : "+v"(tid_));
    const int tid = tid_, wid = __builtin_amdgcn_readfirstlane(tid >> 6), lane = tid & 63, wr = wid >> 2, wc = wid & 3, fr = lane & 15, fq = lane >> 4;
    const int nt = K / BK;
    unsigned voffA[2], voffB[2]; int RA[2], CA[2];
#pragma unroll
    for (int i = 0; i < 2; ++i) { int R, C; stage_rc(tid * 16 + i * 8192, R, C); const int Rb = Epi::PERM ? ((R & ~31) + perm32(R & 31)) : R;
        RA[i] = R; CA[i] = C; voffA[i] = (unsigned)(R * lda + C) * 2u; voffB[i] = (unsigned)(Rb * ldb + C) * 2u; }
    const size_t kstep = (size_t)(BK * 2);
    const size_t hstepA = (size_t)HALF * lda * 2, hstepB = (size_t)HALF * ldb * 2;
    const unsigned ldsw = (unsigned)wid * 1024u;
    const int aoff = lds_byte(wr * 64 + fr, fq * 8), boff = lds_byte(wc * 32 + fr, fq * 8);
#define PG8_SA(b, h) (((b) * 2 + (h)) * HTB)
#define PG8_SB(b, h) ((4 + (b) * 2 + (h)) * HTB)
#define PG8_STB(bufoff, gbase) stage2(lds, (bufoff), ldsw, (gbase), voffB[0], voffB[1])
#define PG8_STA(bufoff, gk, h, NX) do { if constexpr (GATHER) { const unsigned _o0 = (NX) ? vn[h][0] : vc[h][0], _o1 = (NX) ? vn[h][1] : vc[h][1]; stage2(lds, (bufoff), ldsw, (gk), _o0, _o1); } \
        else stage2(lds, (bufoff), ldsw, (gk) + (h) * hstepA, voffA[0], voffA[1]); } while (0)
#define PG8_LDA(dst, b, h) do { _Pragma("unroll") for (int m = 0; m < 4; ++m) _Pragma("unroll") for (int k = 0; k < 2; ++k) dst[m][k] = *(const LAS bf16x8*)(lds + PG8_SA(b, h) + aoff + m * 2048 + k * 1024); } while (0)
#define PG8_LDB(dst, b, h) do { _Pragma("unroll") for (int n = 0; n < 2; ++n) _Pragma("unroll") for (int k = 0; k < 2; ++k) dst[n][k] = *(const LAS bf16x8*)(lds + PG8_SB(b, h) + boff + n * 2048 + k * 1024); } while (0)
#define PG8_MMA(ai, bj, At, Bt) do { __builtin_amdgcn_s_setprio(1); _Pragma("unroll") for (int m = 0; m < 4; ++m) _Pragma("unroll") for (int n = 0; n < 2; ++n) _Pragma("unroll") for (int k = 0; k < 2; ++k) \
        acc[ai][bj][m][n] = __builtin_amdgcn_mfma_f32_16x16x32_bf16(Bt[n][k], At[m][k], acc[ai][bj][m][n], 0, 0, 0); __builtin_amdgcn_s_setprio(0); } while (0)
#define PG8_WAIT_V(n) asm volatile("s_waitcnt vmcnt(" #n ")" ::: "memory")
#define PG8_WAIT_L(n) asm volatile("s_waitcnt lgkmcnt(" #n ")" ::: "memory")
#define PG8_BAR __builtin_amdgcn_s_barrier()
#define PG8_SCHED __builtin_amdgcn_sched_barrier(0)
    Unit cur, nxt; int ui = 0;
    if (!S.next(0, cur)) return;
    unsigned vc[2][2], vn[2][2];
    if constexpr (GATHER) {
#pragma unroll
        for (int h = 0; h < 2; ++h)
#pragma unroll
            for (int i = 0; i < 2; ++i) { vc[h][i] = ((unsigned)S.row(cur, h * HALF + RA[i]) * (unsigned)lda + (unsigned)CA[i]) * 2u; vn[h][i] = vc[h][i]; }
        asm volatile("s_waitcnt vmcnt(0)" ::: "memory");
    }
    f32x4 acc[2][2][4][2];
#pragma unroll
    for (int a = 0; a < 2; ++a)
#pragma unroll
        for (int b = 0; b < 2; ++b)
#pragma unroll
            for (int m = 0; m < 4; ++m)
#pragma unroll
                for (int n = 0; n < 2; ++n) acc[a][b][m][n] = (f32x4){0.f, 0.f, 0.f, 0.f};
    bf16x8 At[4][2], B0[2][2], B1[2][2];
    const char* cA = cur.A; const char* cB = cur.B;
    PG8_STB(PG8_SB(0, 0), cB); PG8_STB(PG8_SB(0, 1), cB + hstepB); PG8_STA(PG8_SA(0, 0), cA, 0, false); PG8_STA(PG8_SA(0, 1), cA, 1, false);
    if (wr == 1) PG8_BAR;
    PG8_WAIT_V(2); PG8_BAR;
    PG8_STB(PG8_SB(1, 0), cB + kstep); PG8_STA(PG8_SA(1, 0), cA + kstep, 0, false); PG8_STB(PG8_SB(1, 1), cB + hstepB + kstep);
    PG8_WAIT_V(6); PG8_BAR;
    for (;;) {
        const bool has_next = S.next(ui + 1, nxt);
        const char* nA = has_next ? nxt.A : cA; const char* nB = has_next ? nxt.B : cB;
        for (int t = 0; t < nt; t += 2) {
            const bool last = (t == nt - 2);
            const char* a1 = cA + (size_t)(t + 1) * kstep;
            const char* a2 = last ? nA : cA + (size_t)(t + 2) * kstep; const char* b2 = last ? nB : cB + (size_t)(t + 2) * kstep;
            const char* a3 = a2 + kstep; const char* b3 = b2 + kstep;
            if constexpr (GATHER) {
                if (last && has_next) {
#pragma unroll
                    for (int h = 0; h < 2; ++h)
#pragma unroll
                        for (int i = 0; i < 2; ++i) vn[h][i] = ((unsigned)S.row(nxt, h * HALF + RA[i]) * (unsigned)lda + (unsigned)CA[i]) * 2u;
                    asm volatile("s_waitcnt vmcnt(0)" ::: "memory");
                }
            }
            PG8_LDB(B0, 0, 0); PG8_LDB(B1, 0, 1); PG8_SCHED; PG8_LDA(At, 0, 0); PG8_STA(PG8_SA(1, 1), a1, 1, false);
            PG8_WAIT_V(8); PG8_WAIT_L(0); PG8_BAR; PG8_MMA(0, 0, At, B0); PG8_MMA(0, 1, At, B1); PG8_BAR; PG8_SCHED;
            PG8_LDA(At, 0, 1); PG8_STB(PG8_SB(0, 0), b2); PG8_STB(PG8_SB(0, 1), b2 + hstepB); PG8_STA(PG8_SA(0, 0), a2, 0, last);
            PG8_WAIT_V(8); PG8_WAIT_L(0); PG8_BAR; PG8_MMA(1, 0, At, B0); PG8_MMA(1, 1, At, B1); PG8_BAR; PG8_SCHED;
            PG8_LDB(B0, 1, 0); PG8_LDB(B1, 1, 1); PG8_SCHED; PG8_LDA(At, 1, 0); PG8_STA(PG8_SA(0, 1), a2, 1, last);
            PG8_WAIT_V(8); PG8_WAIT_L(0); PG8_BAR; PG8_MMA(0, 0, At, B0); PG8_MMA(0, 1, At, B1); PG8_BAR; PG8_SCHED;
            PG8_LDA(At, 1, 1); PG8_STB(PG8_SB(1, 0), b3); PG8_STB(PG8_SB(1, 1), b3 + hstepB); PG8_STA(PG8_SA(1, 0), a3, 0, last);
            PG8_WAIT_V(8); PG8_WAIT_L(0); PG8_BAR; PG8_MMA(1, 0, At, B0); PG8_MMA(1, 1, At, B1); PG8_BAR; PG8_SCHED;
        }
        if (wr == 0) PG8_BAR;
        { int fr_ = fr, fq_ = fq; asm volatile("" : "+v"(fr_), "+v"(fq_));
          E(acc, cur, wr, wc, fr_, fq_); }
        if (!has_next) break;
#pragma unroll
        for (int a = 0; a < 2; ++a)
#pragma unroll
            for (int b = 0; b < 2; ++b)
#pragma unroll
                for (int m = 0; m < 4; ++m)
#pragma unroll
                    for (int n = 0; n < 2; ++n) acc[a][b][m][n] = (f32x4){0.f, 0.f, 0.f, 0.f};
        cur = nxt; cA = nA; cB = nB; ++ui;
        if constexpr (GATHER) {
#pragma unroll
            for (int h = 0; h < 2; ++h)
#pragma unroll
                for (int i = 0; i < 2; ++i) vc[h][i] = vn[h][i];
        }
        if (wr == 1) PG8_BAR;
    }
    PG8_WAIT_V(0);
    PG8_BAR;
#undef PG8_SA
#undef PG8_SB
#undef PG8_STB
#undef PG8_STA
#undef PG8_LDA
#undef PG8_LDB
#undef PG8_MMA
#undef PG8_WAIT_V
#undef PG8_WAIT_L
#undef PG8_BAR
#undef PG8_SCHED
}
}
#define XB_TMO      128
#define XB_XCNT(j)  (256  + 64 * (j))
#define XB_XSUB(j)  (1280 + 64 * (j))
#define XB_XGEN(j)  (2304 + 64 * (j))
#define XB_TOP      3328
#define XB_TOPGEN   3392
#define XCD_BAR_WORDS 3456
#define XB_SPIN_CAP (1u << 18)
__device__ __forceinline__ unsigned xb_ld(unsigned* p)              { return __hip_atomic_load(p, __ATOMIC_RELAXED, __HIP_MEMORY_SCOPE_AGENT); }
__device__ __forceinline__ unsigned xb_add(unsigned* p, unsigned v) { return __hip_atomic_fetch_add(p, v, __ATOMIC_RELAXED, __HIP_MEMORY_SCOPE_AGENT); }
__device__ __forceinline__ unsigned xb_xcc_id() { return (unsigned)__builtin_amdgcn_s_getreg((3 << 11) | 20) & 0xFu; }
#define XB_SPIN(cond, bar) do { unsigned _sp = 0; while (cond) { __builtin_amdgcn_s_sleep(1); \
    if ((++_sp & 255u) == 0u) { if (xb_ld(&(bar)[XB_TMO])) break; if (_sp > XB_SPIN_CAP) { atomicAdd(&(bar)[XB_TMO], 1u); break; } } } } while (0)
struct XcdBarrier { unsigned* bar; unsigned x; volatile LAS unsigned* st; };
__device__ __forceinline__ XcdBarrier xcd_barrier_post(unsigned* bar, volatile LAS unsigned* st) {
    XcdBarrier b; b.bar = bar; b.x = xb_xcc_id(); b.st = st;
    if (threadIdx.x == 0) (void)xb_add(&bar[XB_XCNT(b.x)], 1u);
    return b;
}
__device__ __forceinline__ void xcd_barrier_complete(unsigned* bar, unsigned x, unsigned& nloc, unsigned& nx) {
    const unsigned G = gridDim.x * gridDim.y * gridDim.z;
    unsigned sum, cnt, mine, sp = 0u;
    for (;;) {
        sum = 0u; cnt = 0u; mine = 0u;
#pragma unroll
        for (unsigned j = 0; j < 16; ++j) { const unsigned c = xb_ld(&bar[XB_XCNT(j)]); sum += c; cnt += (c > 0u) ? 1u : 0u; mine = (j == x) ? c : mine; }
        if (sum == G) break;
        __builtin_amdgcn_s_sleep(1);
        if ((++sp & 255u) == 0u) { if (xb_ld(&bar[XB_TMO])) break; if (sp > XB_SPIN_CAP) { atomicAdd(&bar[XB_TMO], 1u); break; } }
    }
    nloc = mine > 0u ? mine : 1u; nx = cnt > 0u ? cnt : 1u;
}
__device__ __forceinline__ void xcd_barrier(const XcdBarrier& b) {
    asm volatile("s_waitcnt vmcnt(0)" ::: "memory");
    __syncthreads();
    if (threadIdx.x == 0) {
        unsigned* bar = b.bar;
        __builtin_amdgcn_s_waitcnt(0);
        unsigned nloc = b.st[0], nx = b.st[1];
        if (nloc == 0u) { xcd_barrier_complete(bar, b.x, nloc, nx); b.st[0] = nloc; b.st[1] = nx; }
        const unsigned old = xb_add(&bar[XB_XSUB(b.x)], 1u);
        const unsigned gen = old / nloc;
        if (old + 1u == (gen + 1u) * nloc) {
            __builtin_amdgcn_fence(__ATOMIC_RELEASE, "agent");
            asm volatile("s_waitcnt vmcnt(0)" ::: "memory");
            const unsigned og = xb_add(&bar[XB_TOP], 1u);
            const unsigned tg = og / nx;
            if (og + 1u == (tg + 1u) * nx) xb_add(&bar[XB_TOPGEN], 1u);
            else XB_SPIN(xb_ld(&bar[XB_TOPGEN]) == tg, bar);
            __builtin_amdgcn_fence(__ATOMIC_ACQUIRE, "agent");
            xb_add(&bar[XB_XGEN(b.x)], 1u);
            asm volatile("s_waitcnt vmcnt(0)" ::: "memory");
        } else {
            XB_SPIN(xb_ld(&bar[XB_XGEN(b.x)]) == gen, bar);
            __builtin_amdgcn_fence(__ATOMIC_ACQUIRE, "agent");
            asm volatile("s_waitcnt vmcnt(0)" ::: "memory");
        }
    }
    __syncthreads();
}

constexpr size_t MiB = 1u << 20;
constexpr size_t WS_CTL = 0, CTL_ZERO_BYTES = 64 * 1024;
constexpr size_t WS_MOD = 1 * MiB;
constexpr size_t WS_EIDX = 2 * MiB;
constexpr size_t WS_WSEL = WS_EIDX + 512 * 1024;
constexpr size_t WS_RANK = WS_WSEL + 512 * 1024;
constexpr size_t WS_TOK = 4 * MiB;
constexpr size_t WS_DST = WS_TOK + 1 * MiB;
constexpr size_t WS_WSL = WS_DST + 1 * MiB;
constexpr size_t WS_WIN = 8 * MiB;
constexpr size_t WS_POOLW = 55 * MiB;
constexpr size_t WS_WPO = 56 * MiB;
constexpr size_t WS_LORA = 60 * MiB;
constexpr size_t WS_G2 = 62 * MiB;
constexpr size_t WS_WRO = 63 * MiB;
constexpr size_t WS_WO = 71 * MiB;
constexpr size_t WS_SLAB = 80 * MiB;
constexpr size_t WS_EA = 80 * MiB;
constexpr size_t EA_STRIDE = (size_t)MT * D * 2;
constexpr size_t WS_YF = 352 * MiB, WS_YB = 416 * MiB;
constexpr size_t WS_HA = 438 * MiB;
constexpr size_t WS_Z = 480 * MiB;
constexpr size_t WS_U = 506 * MiB;
constexpr size_t WS_RM = 544 * MiB, WS_KM = 612 * MiB, WS_VM = 680 * MiB;
constexpr size_t WS_LIN = 748 * MiB;
constexpr size_t WS_DP = 774 * MiB;
constexpr size_t WS_Y2 = 806 * MiB;
constexpr size_t WS_MP = 838 * MiB;
constexpr size_t WS_GATES = 902 * MiB;
constexpr size_t WS_OR = 80 * MiB;
constexpr size_t WS_H2 = 520 * MiB;
constexpr size_t WS_GU = 584 * MiB;
constexpr size_t WS_ACT = 844 * MiB;
constexpr size_t WS_DT = 1004 * MiB;
constexpr size_t WS_YP = 8 * MiB;
constexpr size_t WS_END = 1134 * MiB;
constexpr int CW_BAR = 1024;
constexpr int CW_GCNT = 8192;
static_assert((CW_BAR + XCD_BAR_WORDS) <= CW_GCNT && (CW_GCNT + 128) * 4 <= (int)CTL_ZERO_BYTES, "ctl");

constexpr int RING_OFF = 0, RING_BYTES = 131072;
constexpr int LDSCTL_OFF = RING_BYTES;
constexpr int TAB_OFF = LDSCTL_OFF + 1024;
constexpr int LDS_BYTES = 147456;

using pg8::Unit;
struct RepOrder {
    const char* A; const char* B; size_t repA, repB, tA, tB; int nM, nN, nrep, G, c;
    __device__ __forceinline__ bool next(int i, Unit& u) const {
        const long L = (long)i * G + c; const int per = nM * nN; if (L >= (long)per * nrep) return false;
        const int rep = (int)(L / per); const int w = pg8::xcd_remap((int)(L % per), per); pg8::grid_tile(w, nM, nN, u.pm, u.pn); u.aux = rep;
        u.A = A + (size_t)rep * repA + (size_t)u.pm * tA; u.B = B + (size_t)rep * repB + (size_t)u.pn * tB; return true; }
    __device__ __forceinline__ int row(const Unit&, int) const { return 0; }
};
struct G1Order {
    const char* A; const char* B; size_t tA, tB; int G, c;
    __device__ __forceinline__ bool next(int i, Unit& u) const {
        const long L = (long)i * G + c; constexpr int N1 = 64 * 47, N2 = 4 * 27; if (L >= N1 + N2) return false;
        if (L < N1) { const int w = pg8::xcd_remap((int)L, N1); pg8::grid_tile(w, 64, 47, u.pm, u.pn); }
        else { const int l2 = (int)L - N1; u.pm = 64 + (l2 & 3); u.pn = 4 + (l2 >> 2); }
        u.aux = 0; u.A = A + (size_t)u.pm * tA; u.B = B + (size_t)u.pn * tB; return true; }
    __device__ __forceinline__ int row(const Unit&, int) const { return 0; }
};
struct MoeOrder {
    const char* A; const char* B; const LAS int* te; const int* tok; size_t tA, estride, jstride; int ntiles, NJ, G, c;
    __device__ __forceinline__ bool next(int i, Unit& u) const {
        const long L = (long)i * G + c; const int tot = ntiles * NJ; if (L >= tot) return false;
        const int w = pg8::xcd_remap((int)L, tot); const int rt = w / NJ, j = w - rt * NJ; const int e = te[rt];
        u.pm = rt; u.pn = j; u.aux = e; u.A = A + (size_t)rt * tA; u.B = B + (size_t)e * estride + (size_t)j * jstride; return true; }
    __device__ __forceinline__ int row(const Unit& u, int r) const { return tok[u.pm * 256 + r]; }
};

typedef f32x4 AccT[2][2][4][2];
#define EPI_ROWS_BEGIN _Pragma("unroll") for (int ai = 0; ai < 2; ++ai) _Pragma("unroll") for (int m = 0; m < 4; ++m) { const int rl = ai * 128 + wr * 64 + m * 16 + fr;
#define EPI_ROWS_END }
struct EpiG1 { static constexpr bool PERM = true; bf16* U; bf16* SLAB; bf16* GATES;
    __device__ __forceinline__ void operator()(const AccT& acc, const Unit& u, int wr, int wc, int fr, int fq) const {
        bf16* base; int ld, c0;
        if (u.pn < 4) { base = U; ld = 1024; c0 = u.pn * 256; } else if (u.pn < 31) { base = SLAB; ld = SLABLD; c0 = (u.pn - 4) * 256; } else { base = GATES; ld = 4096; c0 = (u.pn - 31) * 256; }
        EPI_ROWS_BEGIN
            bf16* rowp = base + (size_t)(u.pm * 256 + rl) * ld + c0 + wc * 32 + 8 * fq;
#pragma unroll
            for (int bj = 0; bj < 2; ++bj) { const f32x4 v0 = acc[ai][bj][m][0], v1 = acc[ai][bj][m][1];
                v4u w; w.x = pk2(v0[0], v0[1]); w.y = pk2(v0[2], v0[3]); w.z = pk2(v1[0], v1[1]); w.w = pk2(v1[2], v1[3]); *(v4u*)(rowp + bj * 128) = w; }
        EPI_ROWS_END
    }
};
struct EpiLora { static constexpr bool PERM = true; unsigned short* EA; const float* w0; const float* a0;
    __device__ __forceinline__ void operator()(const AccT& acc, const Unit& u, int wr, int wc, int fr, int fq) const {
        const int rep = u.aux; const float* bias = (rep < 2 ? w0 + rep * D : a0 + (rep - 2) * D) + u.pn * 256 + wc * 32 + 8 * fq;
        const float cc = rep < 2 ? -0.8750424f : 1.0f;
        unsigned short* base = EA + (size_t)rep * ((size_t)MT * D);
        EPI_ROWS_BEGIN
            unsigned short* rowp = base + (size_t)(u.pm * 256 + rl) * D + u.pn * 256 + wc * 32 + 8 * fq;
#pragma unroll
            for (int bj = 0; bj < 2; ++bj) { const f32x4 v0 = acc[ai][bj][m][0] + *(const f32x4*)(bias + bj * 128), v1 = acc[ai][bj][m][1] + *(const f32x4*)(bias + bj * 128 + 4);
                v4u w; w.x = pkh2(cc * sigmoidf_(v0[0]), cc * sigmoidf_(v0[1])); w.y = pkh2(cc * sigmoidf_(v0[2]), cc * sigmoidf_(v0[3]));
                w.z = pkh2(cc * sigmoidf_(v1[0]), cc * sigmoidf_(v1[1])); w.w = pkh2(cc * sigmoidf_(v1[2]), cc * sigmoidf_(v1[3]));
                *(v4u*)(rowp + bj * 128) = w; }
        EPI_ROWS_END
    }
};
struct EpiPoolG { static constexpr bool PERM = true; bf16* Y2; const float* scale;
    __device__ __forceinline__ void operator()(const AccT& acc, const Unit& u, int wr, int wc, int fr, int fq) const {
        const int cb = u.aux * 256 + wc * 32 + 8 * fq;
        f32x4 s0[2], s1[2];
#pragma unroll
        for (int bj = 0; bj < 2; ++bj) { s0[bj] = *(const f32x4*)(scale + cb + bj * 128); s1[bj] = *(const f32x4*)(scale + cb + bj * 128 + 4); }
        EPI_ROWS_BEGIN
            bf16* rowp = Y2 + (size_t)(u.pm * 256 + rl) * 1024 + cb;
#pragma unroll
            for (int bj = 0; bj < 2; ++bj) { const f32x4 v0 = acc[ai][bj][m][0] * s0[bj], v1 = acc[ai][bj][m][1] * s1[bj];
                v4u w; w.x = pk2(v0[0], v0[1]); w.y = pk2(v0[2], v0[3]); w.z = pk2(v1[0], v1[1]); w.w = pk2(v1[2], v1[3]); *(v4u*)(rowp + bj * 128) = w; }
        EPI_ROWS_END
    }
};
template <int MODE> struct EpiMix { static constexpr bool PERM = true; bf16* OUT; int ldo; const bf16* AUX1; int ld1; const bf16* AUX2; int ld2;
    __device__ __forceinline__ void operator()(const AccT& acc, const Unit& u, int wr, int wc, int fr, int fq) const {
        const int cb = u.pn * 256 + wc * 32 + 8 * fq;
        EPI_ROWS_BEGIN
            const size_t row = (size_t)(u.pm * 256 + rl);
#pragma unroll
            for (int bj = 0; bj < 2; ++bj) { const f32x4 v0 = acc[ai][bj][m][0], v1 = acc[ai][bj][m][1];
                const v4u a1 = *(const v4u*)(AUX1 + row * ld1 + cb + bj * 128);
                float x[8] = {bflo(a1.x), bfhi(a1.x), bflo(a1.y), bfhi(a1.y), bflo(a1.z), bfhi(a1.z), bflo(a1.w), bfhi(a1.w)};
                float o[8];
                if (MODE == 0) {
#pragma unroll
                    for (int j = 0; j < 4; ++j) { o[j] = sigmoidf_(x[j]) * v0[j]; o[4 + j] = sigmoidf_(x[4 + j]) * v1[j]; } }
                else if (MODE == 1) {
#pragma unroll
                    for (int j = 0; j < 4; ++j) { o[j] = x[j] * v0[j]; o[4 + j] = x[4 + j] * v1[j]; } }
                else { const v4u a2 = *(const v4u*)(AUX2 + row * ld2 + cb + bj * 128);
                    const float y[8] = {bflo(a2.x), bfhi(a2.x), bflo(a2.y), bfhi(a2.y), bflo(a2.z), bfhi(a2.z), bflo(a2.w), bfhi(a2.w)};
#pragma unroll
                    for (int j = 0; j < 4; ++j) { o[j] = y[j] + sigmoidf_(x[j]) * v0[j]; o[4 + j] = y[4 + j] + sigmoidf_(x[4 + j]) * v1[j]; } }
                v4u w; w.x = pk2(o[0], o[1]); w.y = pk2(o[2], o[3]); w.z = pk2(o[4], o[5]); w.w = pk2(o[6], o[7]);
                *(v4u*)(OUT + row * ldo + cb + bj * 128) = w; }
        EPI_ROWS_END
    }
};
struct EpiX1 { static constexpr bool PERM = false; const float* X; float* OUT; const float* MOD;
    __device__ __forceinline__ void operator()(const AccT& acc, const Unit& u, int wr, int wc, int fr, int fq) const {
        const int b = u.pm >> 4;
        const int cb = u.pn * 256 + wc * 32 + 4 * fq; const float* g = MOD + (size_t)b * 12288 + 4096 + cb;
        f32x4 gv[2][2];
#pragma unroll
        for (int bj = 0; bj < 2; ++bj)
#pragma unroll
            for (int n = 0; n < 2; ++n) gv[bj][n] = *(const f32x4*)(g + bj * 128 + n * 16);
        EPI_ROWS_BEGIN
            const size_t off = (size_t)(u.pm * 256 + rl) * D + cb;
#pragma unroll
            for (int bj = 0; bj < 2; ++bj)
#pragma unroll
                for (int n = 0; n < 2; ++n) { const f32x4 xv = *(const f32x4*)(X + off + bj * 128 + n * 16); *(f32x4*)(OUT + off + bj * 128 + n * 16) = xv + gv[bj][n] * acc[ai][bj][m][n]; }
        EPI_ROWS_END
    }
};
struct EpiAct { static constexpr bool PERM = true; bf16* ACT;
    __device__ __forceinline__ void operator()(const AccT& acc, const Unit& u, int wr, int wc, int fr, int fq) const {
        EPI_ROWS_BEGIN
            const f32x4 g0 = acc[ai][0][m][0], g1 = acc[ai][0][m][1], u0 = acc[ai][1][m][0], u1 = acc[ai][1][m][1];
            float o[8];
#pragma unroll
            for (int j = 0; j < 4; ++j) { o[j] = g0[j] * sigmoidf_(g0[j]) * u0[j]; o[4 + j] = g1[j] * sigmoidf_(g1[j]) * u1[j]; }
            v4u w; w.x = pk2(o[0], o[1]); w.y = pk2(o[2], o[3]); w.z = pk2(o[4], o[5]); w.w = pk2(o[6], o[7]);
            *(v4u*)(ACT + (size_t)(u.pm * 256 + rl) * DEXP + u.pn * 128 + wc * 32 + 8 * fq) = w;
        EPI_ROWS_END
    }
};
struct EpiDown { static constexpr bool PERM = true; bf16* YP; const int* DST; const float* WSL;
    __device__ __forceinline__ void operator()(const AccT& acc, const Unit& u, int wr, int wc, int fr, int fq) const {
        const int cb = u.pn * 256 + wc * 32 + 8 * fq;
        EPI_ROWS_BEGIN
            const int slot = u.pm * 256 + rl; const int dst = DST[slot]; const float wt = WSL[slot];
            if (dst >= 0) {
#pragma unroll
                for (int bj = 0; bj < 2; ++bj) { const f32x4 v0 = acc[ai][bj][m][0] * wt, v1 = acc[ai][bj][m][1] * wt;
                    v4u w; w.x = pk2(v0[0], v0[1]); w.y = pk2(v0[2], v0[3]); w.z = pk2(v1[0], v1[1]); w.w = pk2(v1[2], v1[3]);
                    *(v4u*)(YP + (size_t)dst * D + cb + bj * 128) = w; } }
        EPI_ROWS_END
    }
};
struct Frame {
    LAS unsigned char* lds;
    volatile LAS unsigned* MISC;
    unsigned* ctl;
    int tid, lane, wave, vcu, G;
    unsigned char* ws;
};
struct Args { const float* in[34]; float* out; unsigned char* ws; int ph_lo, ph_hi; };
enum { I_X = 0, I_C, I_CTX, I_CCTX, I_N1G, I_N2G, I_ADAW, I_ADAB, I_WIN, I_MU, I_POOLW, I_POOLS, I_WPO, I_DW0, I_DW2, I_IA0, I_IA2, I_G2, I_KK, I_KA, I_RK, I_LNW, I_LNB,
       I_WRO, I_WO, I_RW, I_RB, I_EG, I_EU, I_ED, I_SG, I_SU, I_SD, I_FG };

__device__ __forceinline__ void transpose_item(const float* W, int ldw, int kvalid, bf16* WT, int ldt, int k0, int n0, int drow0, LAS float* scr, int lane) {
#pragma unroll 8
    for (int i = 0; i < 32; ++i) { const int kk = 2 * i + (lane >> 5); const int k = k0 + kk; scr[kk * 33 + (lane & 31)] = (k < kvalid) ? W[(size_t)k * ldw + n0 + (lane & 31)] : 0.f; }
    LDS_WAIT(); asm volatile("" ::: "memory");
    const int c = lane & 7;
#pragma unroll
    for (int j = 0; j < 4; ++j) { const int n = (lane >> 3) + 8 * j; const LAS float* s = scr + (8 * c) * 33 + n;
        v4u o; o.x = pk2(s[0 * 33], s[1 * 33]); o.y = pk2(s[2 * 33], s[3 * 33]); o.z = pk2(s[4 * 33], s[5 * 33]); o.w = pk2(s[6 * 33], s[7 * 33]);
        *(v4u*)(WT + (size_t)(drow0 + n) * ldt + k0 + 8 * c) = o; }
    LDS_WAIT(); asm volatile("" ::: "memory");
}

__device__ __forceinline__ void p0_prologue(Frame& F, const Args& a) {
    {
        LAS float* sv = (LAS float*)F.lds;
        LAS float* part = (LAS float*)(F.lds + 40960);
        bool did = false;
        for (int cb = blockIdx.x; cb < 192; cb += F.G) {
            if (!did) { for (int idx = F.tid; idx < 5 * D; idx += 512) { const int j = idx >> 11, k = idx & 2047; const float v = (j < 4) ? a.in[I_C][j * D + k] : a.in[I_CCTX][k]; sv[idx] = v / (1.0f + __expf(-v)); } did = true; }
            __syncthreads();
            const int col = 64 * cb + F.lane, k0 = 256 * F.wave; const float* wp = a.in[I_ADAW] + (size_t)k0 * 12288 + col;
            float acc[5] = {0.f, 0.f, 0.f, 0.f, 0.f};
#pragma unroll 8
            for (int k = 0; k < 256; ++k) { const float w = wp[(size_t)k * 12288];
#pragma unroll
                for (int j = 0; j < 5; ++j) acc[j] += sv[j * D + k0 + k] * w; }
#pragma unroll
            for (int j = 0; j < 5; ++j) part[(F.wave * 5 + j) * 64 + F.lane] = acc[j];
            __syncthreads();
            if (F.tid < 320) { const int j = F.tid >> 6, l = F.tid & 63; float s = a.in[I_ADAB][64 * cb + l];
#pragma unroll
                for (int w = 0; w < 8; ++w) s += part[(w * 5 + j) * 64 + l];
                ((float*)(F.ws + WS_MOD))[j * 12288 + 64 * cb + l] = s; }
            __syncthreads();
        }
        __syncthreads();
    }
    LAS float* scr = (LAS float*)(F.lds + F.wave * 16384);
    const int gw = F.vcu * 8 + F.wave, NGW = F.G * 8;
    constexpr int I_1 = 32 * 372;
    constexpr int I_2 = 4 * 4 * 8;
    constexpr int I_3 = 16 * 64;
    constexpr int I_4 = 4 * 64;
    constexpr int I_5 = 32 * 64;
    constexpr int I_6 = 32 * 64;
    constexpr int I_7 = 4 * 2 * 64;
    constexpr int NITEMS = I_1 + I_2 + I_3 + I_4 + I_5 + I_6 + I_7;
    for (int it = gw; it < NITEMS; it += NGW) {
        int r = it;
        if (r < I_1) { const int kb = r / 372, nb = r % 372, n0 = nb * 32; transpose_item(a.in[I_WIN], DIN, D, (bf16*)(F.ws + WS_WIN), D, kb * 64, n0, n0 + (n0 >= 7808 ? 128 : 0), scr, F.lane); continue; } r -= I_1;
        if (r < I_2) { const int g = r / 32, q = r % 32, kb = q / 8, nb = q % 8; transpose_item(a.in[I_POOLW] + (size_t)g * 65536, 256, 256, (bf16*)(F.ws + WS_POOLW) + (size_t)g * 65536, 256, kb * 64, nb * 32, nb * 32, scr, F.lane); continue; } r -= I_2;
        if (r < I_3) { const int kb = r / 64, nb = r % 64; transpose_item(a.in[I_WPO], D, 1024, (bf16*)(F.ws + WS_WPO), 1024, kb * 64, nb * 32, nb * 32, scr, F.lane); continue; } r -= I_3;
        if (r < I_4) { const int kb = r / 64, nb = r % 64; transpose_item(a.in[I_G2], D, 256, (bf16*)(F.ws + WS_G2), 256, kb * 64, nb * 32, nb * 32, scr, F.lane); continue; } r -= I_4;
        if (r < I_5) { const int kb = r / 64, nb = r % 64; transpose_item(a.in[I_WRO], D, D, (bf16*)(F.ws + WS_WRO), D, kb * 64, nb * 32, nb * 32, scr, F.lane); continue; } r -= I_5;
        if (r < I_6) { const int kb = r / 64, nb = r % 64; transpose_item(a.in[I_WO], D, D, (bf16*)(F.ws + WS_WO), D, kb * 64, nb * 32, nb * 32, scr, F.lane); continue; } r -= I_6;
        { const int mtx = r / 128, q = r % 128, kb = q / 64, nb = q % 64;
          const float* src = (mtx < 2 ? a.in[I_DW2] + (size_t)mtx * 96 * D : a.in[I_IA2] + (size_t)(mtx - 2) * 96 * D);
          transpose_item(src, D, 96, (bf16*)(F.ws + WS_LORA) + (size_t)mtx * D * 128, 128, kb * 64, nb * 32, nb * 32, scr, F.lane); }
    }
    const int gt = F.vcu * 512 + F.tid, NGT = F.G * 512;
    { v4u* z = (v4u*)((bf16*)(F.ws + WS_WIN) + (size_t)7808 * D); for (int i = gt; i < 128 * D / 8; i += NGT) z[i] = (v4u){0u, 0u, 0u, 0u}; }
    { int* tok = (int*)(F.ws + WS_TOK); int* dst = (int*)(F.ws + WS_DST); float* wsl = (float*)(F.ws + WS_WSL);
      for (int i = gt; i < NSLOT; i += NGT) { tok[i] = 0; dst[i] = -1; wsl[i] = 0.f; } }
}

__device__ __forceinline__ void p1_norm1(Frame& F, const Args& a) {
    const int gw = F.vcu * 8 + F.wave, NGW = F.G * 8; const float* MOD = (const float*)(F.ws + WS_MOD); bf16* HA = (bf16*)(F.ws + WS_HA);
    for (int mrow = gw; mrow < MT; mrow += NGW) {
        const float* src = (mrow < NT) ? a.in[I_X] + (size_t)mrow * D : a.in[I_CTX] + (size_t)(mrow - NT) * D; const int j = (mrow < NT) ? (mrow >> 12) : 4;
        const f32x4* xr = (const f32x4*)src + F.lane; f32x4 v[8]; float s = 0.f;
#pragma unroll
        for (int q = 0; q < 8; ++q) { v[q] = xr[64 * q]; s += (v[q].x * v[q].x + v[q].y * v[q].y) + (v[q].z * v[q].z + v[q].w * v[q].w); }
        const float rstd = 1.0f / sqrtf(wave_sum(s) * (1.0f / D) + 1e-6f);
        const f32x4* g = (const f32x4*)a.in[I_N1G] + F.lane; const f32x4* sh = (const f32x4*)(MOD + (size_t)j * 12288) + F.lane; const f32x4* sc = (const f32x4*)(MOD + (size_t)j * 12288 + 2048) + F.lane;
        v2u* o = (v2u*)(HA + (size_t)mrow * D) + F.lane;
#pragma unroll
        for (int q = 0; q < 8; ++q) { const f32x4 y = v[q] * rstd * g[64 * q] * (sc[64 * q] + 1.0f) + sh[64 * q]; v2u w; w.x = pk2(y.x, y.y); w.y = pk2(y.z, y.w); o[64 * q] = w; }
    }
}

template <int W> __device__ __forceinline__ void pool_item(const unsigned* U32, unsigned* DP32, int m0, int cp) {
    unsigned raw[64];
#pragma unroll
    for (int x = 0; x < 64; ++x) raw[x] = U32[(size_t)(m0 + x) * 512 + cp];
    float lo[64], hi[64];
#pragma unroll
    for (int x = 0; x < 64; ++x) { lo[x] = bflo(raw[x]); hi[x] = bfhi(raw[x]); }
#pragma unroll
    for (int x = 0; x < 64; ++x) { const int l = (x - W / 2) < 0 ? 0 : (x - W / 2), h = (x + W / 2) > 64 ? 64 : (x + W / 2); float s0 = 0.f, s1 = 0.f;
#pragma unroll
        for (int j = l; j < h; ++j) { s0 += lo[j]; s1 += hi[j]; }
        const float inv = 1.0f / (float)(h - l); DP32[(size_t)(m0 + x) * 512 + cp] = pk2(s0 * inv - lo[x], s1 * inv - hi[x]); }
}
__device__ __forceinline__ void p3_prep(Frame& F, const Args& a) {
    const bf16* SLAB = (const bf16*)(F.ws + WS_SLAB); const float* mu = a.in[I_MU];
    bf16* RM = (bf16*)(F.ws + WS_RM); bf16* KM = (bf16*)(F.ws + WS_KM); bf16* VM = (bf16*)(F.ws + WS_VM); bf16* LIN = (bf16*)(F.ws + WS_LIN);
    const int gw = F.vcu * 8 + F.wave, NGW = F.G * 8;
    for (int mrow = gw; mrow < MT; mrow += NGW) {
        const bool lat = mrow < NT; const bf16* own = SLAB + (size_t)mrow * SLABLD;
        bool v0, v1, v2 = false, v3 = false; const bf16 *p0, *p1, *p2 = own, *p3 = own;
        if (lat) { const int t = mrow & 4095, gy = t >> 6, gx = t & 63; v0 = gx > 0; v1 = gx < 63; v2 = gy > 0; v3 = gy < 63;
            p0 = own - SLABLD; p1 = own + SLABLD; p2 = own - (size_t)64 * SLABLD; p3 = own + (size_t)64 * SLABLD; }
        else { const int s = (mrow - NT) & 255; v0 = s > 0; v1 = s < 255; p0 = own - SLABLD; p1 = own + SLABLD; }
        for (int ci = F.lane; ci < DSH / 8; ci += 64) {
            const int c0 = ci * 8; const v4u z = (v4u){0u, 0u, 0u, 0u};
            const v4u o = *(const v4u*)(own + c0);
            const v4u n0 = v0 ? *(const v4u*)(p0 + c0) : z, n1 = v1 ? *(const v4u*)(p1 + c0) : z;
            v4u nb;
            if (lat) { const v4u n2 = v2 ? *(const v4u*)(p2 + c0) : z, n3 = v3 ? *(const v4u*)(p3 + c0) : z;
                nb.x = (n0.x & 0xffffu) | (n1.x & 0xffff0000u); nb.y = (n2.y & 0xffffu) | (n3.y & 0xffff0000u); nb.z = (n0.z & 0xffffu) | (n1.z & 0xffff0000u); nb.w = (n2.w & 0xffffu) | (n3.w & 0xffff0000u); }
            else { nb.x = (n0.x & 0xffffu) | (n1.x & 0xffff0000u); nb.y = (n0.y & 0xffffu) | (n1.y & 0xffff0000u); nb.z = (n0.z & 0xffffu) | (n1.z & 0xffff0000u); nb.w = (n0.w & 0xffffu) | (n1.w & 0xffff0000u); }
            const f32x4 m0 = *(const f32x4*)(mu + c0), m1 = *(const f32x4*)(mu + c0 + 4);
            float r[8];
            { const float ov[8] = {bflo(o.x), bfhi(o.x), bflo(o.y), bfhi(o.y), bflo(o.z), bfhi(o.z), bflo(o.w), bfhi(o.w)};
              const float nv[8] = {bflo(nb.x), bfhi(nb.x), bflo(nb.y), bfhi(nb.y), bflo(nb.z), bfhi(nb.z), bflo(nb.w), bfhi(nb.w)};
              const float mv[8] = {m0.x, m0.y, m0.z, m0.w, m1.x, m1.y, m1.z, m1.w};
#pragma unroll
              for (int e = 0; e < 8; ++e) r[e] = ov[e] + (nv[e] - ov[e]) * mv[e]; }
            bf16* dstp;
            if (c0 < 2048) dstp = RM + (size_t)mrow * D + c0;
            else if (c0 < 4096) dstp = KM + (size_t)mrow * D + (c0 - 2048);
            else if (c0 < 6144) dstp = VM + (size_t)mrow * D + (c0 - 4096);
            else { const int lc = c0 - 6144; int dc;
                if (lc < 192) {
#pragma unroll
                    for (int e = 0; e < 8; ++e) r[e] = tanhf(r[e]);
                    dc = (lc < 96) ? lc : 128 + (lc - 96); }
                else if (lc < 384) dc = (lc < 288) ? 256 + (lc - 192) : 384 + (lc - 288);
                else {
#pragma unroll
                    for (int e = 0; e < 8; ++e) r[e] = sigmoidf_(r[e]);
                    dc = 512 + (lc - 384); }
                dstp = LIN + (size_t)mrow * LINLD + dc; }
            v4u w; w.x = pk2(r[0], r[1]); w.y = pk2(r[2], r[3]); w.z = pk2(r[4], r[5]); w.w = pk2(r[6], r[7]); *(v4u*)dstp = w;
        }
        if (F.lane < 16) { const int p = F.lane >> 2, off = (F.lane & 3) * 8; *(v4u*)(LIN + (size_t)mrow * LINLD + 128 * p + 96 + off) = (v4u){0u, 0u, 0u, 0u}; }
    }
    const unsigned* U32 = (const unsigned*)(F.ws + WS_U); unsigned* DP32 = (unsigned*)(F.ws + WS_DP);
    for (int gr = F.vcu; gr < 256; gr += F.G) {
        const int m0 = gr * 64, cp = F.tid; const int g = F.wave >> 1;
        if (g == 0) pool_item<2>(U32, DP32, m0, cp); else if (g == 1) pool_item<4>(U32, DP32, m0, cp); else if (g == 2) pool_item<8>(U32, DP32, m0, cp); else pool_item<16>(U32, DP32, m0, cp);
    }
}

constexpr int SC_CH = 32;
constexpr int SC_VEC = SC_CH * 64;
constexpr int SC_BUF = 6 * SC_VEC + 2 * SC_CH;
__device__ __forceinline__ int scan_row(int n, int b, int dir) {
    if (n < CTXL) return NT + b * CTXL + (dir ? (CTXL - 1 - n) : n);
    const int t = n - CTXL; return b * TSEQ + (dir ? (TSEQ - 1 - t) : t);
}
__device__ __forceinline__ void p6_scan(Frame& F, const Args& a) {
    const bf16* RM = (const bf16*)(F.ws + WS_RM); const bf16* KM = (const bf16*)(F.ws + WS_KM); const bf16* VM = (const bf16*)(F.ws + WS_VM);
    LAS float* bufs = (LAS float*)F.lds; LAS float* ybuf = bufs + 2 * SC_BUF;
    const int tau = F.tid >> 4, sub = F.tid & 15;
    const int p = F.tid >> 4, cq = F.tid & 15;
    for (int unit = blockIdx.x; unit < NB * NH * 2; unit += F.G) {
        const int dir = unit & 1, h = (unit >> 1) & 31, b = unit >> 6;
        const unsigned short* EX = (const unsigned short*)(F.ws + WS_EA + (size_t)dir * EA_STRIDE);
        const unsigned short* AX = (const unsigned short*)(F.ws + WS_EA + (size_t)(2 + dir) * EA_STRIDE);
        bf16* YO = (bf16*)(F.ws + (dir ? WS_YB : WS_YF));
        const int ch0 = h * 64 + 4 * sub;
        const f32x4 kkw = *(const f32x4*)(a.in[I_KK] + ch0), kaw = *(const f32x4*)(a.in[I_KA] + ch0);
        f32x4 S0 = (f32x4){0.f, 0.f, 0.f, 0.f}, S1 = S0;
        v2u lr, lk, lv, la, le;
        constexpr int NCHUNK = (CTXL + TSEQ) / SC_CH;
        { const size_t off = (size_t)scan_row(tau, b, dir) * D + ch0; lr = *(const v2u*)(RM + off); lk = *(const v2u*)(KM + off); lv = *(const v2u*)(VM + off); la = *(const v2u*)(AX + off); le = *(const v2u*)(EX + off); }
        for (int ch = 0; ch <= NCHUNK; ++ch) {
            if (ch < NCHUNK) {
                LAS float* B = bufs + (ch & 1) * SC_BUF;
                const f32x4 r = (f32x4){bflo(lr.x), bfhi(lr.x), bflo(lr.y), bfhi(lr.y)}, k = (f32x4){bflo(lk.x), bfhi(lk.x), bflo(lk.y), bfhi(lk.y)};
                const f32x4 v = (f32x4){bflo(lv.x), bfhi(lv.x), bflo(lv.y), bfhi(lv.y)}, ai = (f32x4){hlo(la.x), hhi(la.x), hlo(la.y), hhi(la.y)};
                const f32x4 e = (f32x4){hlo(le.x), hhi(le.x), hlo(le.y), hhi(le.y)};
                f32x4 kk = k * kkw; float ss = (kk.x * kk.x + kk.y * kk.y) + (kk.z * kk.z + kk.w * kk.w); ss = allred16(ss);
                kk = kk * (1.0f / sqrtf(ss + 1e-12f));
                f32x4 w; w.x = __builtin_amdgcn_exp2f(e.x); w.y = __builtin_amdgcn_exp2f(e.y); w.z = __builtin_amdgcn_exp2f(e.z); w.w = __builtin_amdgcn_exp2f(e.w);
                const f32x4 kd = k * ((ai - 1.0f) * kaw + 1.0f), bb = kk * ai, wrv = w * r;
                float br = (bb.x * r.x + bb.y * r.y) + (bb.z * r.z + bb.w * r.w), kr = (kd.x * r.x + kd.y * r.y) + (kd.z * r.z + kd.w * r.w);
                br = allred16(br); kr = allred16(kr);
                const int o = tau * 64 + 4 * sub;
                *(LAS f32x4*)(B + 0 * SC_VEC + o) = kk; *(LAS f32x4*)(B + 1 * SC_VEC + o) = wrv; *(LAS f32x4*)(B + 2 * SC_VEC + o) = w;
                *(LAS f32x4*)(B + 3 * SC_VEC + o) = bb; *(LAS f32x4*)(B + 4 * SC_VEC + o) = kd; *(LAS f32x4*)(B + 5 * SC_VEC + o) = v;
                if (sub == 0) *(LAS f32x2*)(B + 6 * SC_VEC + 2 * tau) = (f32x2){br, kr};
            }
            if (ch >= 1 && (ch - 1) * SC_CH >= CTXL) {
                const f32x4 y = *(const LAS f32x4*)(ybuf + tau * 64 + 4 * sub); v2u wv; wv.x = pk2(y.x, y.y); wv.y = pk2(y.z, y.w);
                *(v2u*)(YO + (size_t)scan_row((ch - 1) * SC_CH + tau, b, dir) * D + ch0) = wv;
            }
            __syncthreads();
            if (ch == NCHUNK) break;
            if (ch + 1 < NCHUNK) { const size_t off = (size_t)scan_row((ch + 1) * SC_CH + tau, b, dir) * D + ch0;
                lr = *(const v2u*)(RM + off); lk = *(const v2u*)(KM + off); lv = *(const v2u*)(VM + off); la = *(const v2u*)(AX + off); le = *(const v2u*)(EX + off); }
            const LAS float* B = bufs + (ch & 1) * SC_BUF; const bool emit = ch * SC_CH >= CTXL;
#pragma unroll 4
            for (int s = 0; s < SC_CH; ++s) {
                const f32x4 kk = *(const LAS f32x4*)(B + 0 * SC_VEC + s * 64 + 4 * cq), wr = *(const LAS f32x4*)(B + 1 * SC_VEC + s * 64 + 4 * cq), w = *(const LAS f32x4*)(B + 2 * SC_VEC + s * 64 + 4 * cq);
                const f32x4 bb = *(const LAS f32x4*)(B + 3 * SC_VEC + s * 64 + 4 * cq), kd = *(const LAS f32x4*)(B + 4 * SC_VEC + s * 64 + 4 * cq);
                const f32x2 vv = *(const LAS f32x2*)(B + 5 * SC_VEC + s * 64 + 2 * p), sc = *(const LAS f32x2*)(B + 6 * SC_VEC + 2 * s);
                float sa0 = (S0.x * kk.x + S0.y * kk.y) + (S0.z * kk.z + S0.w * kk.w), sa1 = (S1.x * kk.x + S1.y * kk.y) + (S1.z * kk.z + S1.w * kk.w);
                float q0 = (S0.x * wr.x + S0.y * wr.y) + (S0.z * wr.z + S0.w * wr.w), q1 = (S1.x * wr.x + S1.y * wr.y) + (S1.z * wr.z + S1.w * wr.w);
                sa0 = allred16(sa0); sa1 = allred16(sa1); q0 = allred16(q0); q1 = allred16(q1);
                S0 = S0 * w - bb * sa0 + kd * vv.x; S1 = S1 * w - bb * sa1 + kd * vv.y;
                if (emit && cq == 0) *(LAS f32x2*)(ybuf + s * 64 + 2 * p) = (f32x2){q0 - sa0 * sc.x + vv.x * sc.y, q1 - sa1 * sc.x + vv.y * sc.y};
            }
            __syncthreads();
        }
        __syncthreads();
    }
}

__device__ __forceinline__ void p7_readout(Frame& F, const Args& a) {
    const bf16* RM = (const bf16*)(F.ws + WS_RM); const bf16* KM = (const bf16*)(F.ws + WS_KM); const bf16* VM = (const bf16*)(F.ws + WS_VM);
    const unsigned short* AF = (const unsigned short*)(F.ws + WS_EA + 2 * EA_STRIDE); const unsigned short* AB = (const unsigned short*)(F.ws + WS_EA + 3 * EA_STRIDE);
    const bf16* YF = (const bf16*)(F.ws + WS_YF); const bf16* YB = (const bf16*)(F.ws + WS_YB); bf16* Z = (bf16*)(F.ws + WS_Z);
    const int sub = F.tid & 15; const int ngrp = F.G * 32;
    for (int gid = F.vcu * 32 + (F.tid >> 4); gid < NT * NH; gid += ngrp) {
        const int mrow = gid >> 5, h = gid & 31, c = h * 64 + 4 * sub; const size_t off = (size_t)mrow * D + c;
        const v2u yf = *(const v2u*)(YF + off), yb = *(const v2u*)(YB + off), lr = *(const v2u*)(RM + off), lk = *(const v2u*)(KM + off), lv = *(const v2u*)(VM + off), laf = *(const v2u*)(AF + off), lab = *(const v2u*)(AB + off);
        const f32x4 y = (f32x4){bflo(yf.x) + bflo(yb.x), bfhi(yf.x) + bfhi(yb.x), bflo(yf.y) + bflo(yb.y), bfhi(yf.y) + bfhi(yb.y)};
        const float mean = allred16((y.x + y.y) + (y.z + y.w)) * (1.0f / 64.0f); const f32x4 d = y - mean;
        const float var = allred16((d.x * d.x + d.y * d.y) + (d.z * d.z + d.w * d.w)) * (1.0f / 64.0f);
        const f32x4 yn = d * (1.0f / sqrtf(var + 64e-5f)) * *(const f32x4*)(a.in[I_LNW] + c) + *(const f32x4*)(a.in[I_LNB] + c);
        const f32x4 r = (f32x4){bflo(lr.x), bfhi(lr.x), bflo(lr.y), bfhi(lr.y)}, k = (f32x4){bflo(lk.x), bfhi(lk.x), bflo(lk.y), bfhi(lk.y)}, v = (f32x4){bflo(lv.x), bfhi(lv.x), bflo(lv.y), bfhi(lv.y)};
        const f32x4 asum = (f32x4){hlo(laf.x) + hlo(lab.x), hhi(laf.x) + hhi(lab.x), hlo(laf.y) + hlo(lab.y), hhi(laf.y) + hhi(lab.y)};
        const f32x4 ks = k * ((asum - 2.0f) * *(const f32x4*)(a.in[I_KA] + c) + 2.0f);
        const f32x4 t = r * ks * *(const f32x4*)(a.in[I_RK] + c);
        const float bon = allred16((t.x + t.y) + (t.z + t.w));
        const f32x4 z = yn + v * bon; v2u wv; wv.x = pk2(z.x, z.y); wv.y = pk2(z.z, z.w); *(v2u*)(Z + off) = wv;
    }
}
constexpr int RT_LD = 68;
__device__ __forceinline__ void p11_route(Frame& F, const Args& a) {
    {
        LAS float* scr = (LAS float*)(F.lds + F.wave * 16384);
        const int gw = F.vcu * 8 + F.wave, NGW = F.G * 8;
        for (int it = gw; it < 65 * 1536; it += NGW) {
            const int e = it / 1536, q = it % 1536, which = q / 512, r = q % 512;
            if (which < 2) { const float* src = (e < 64) ? (which == 0 ? a.in[I_EG] : a.in[I_EU]) + (size_t)e * D * DEXP : (which == 0 ? a.in[I_SG] : a.in[I_SU]);
                const int kb = r / 16, nb = r % 16, n0 = nb * 32; const int drow = (n0 >> 7) * 256 + which * 128 + (n0 & 127);
                transpose_item(src, DEXP, D, (bf16*)(F.ws + WS_GU) + (size_t)e * 1024 * D, D, kb * 64, n0, drow, scr, F.lane); }
            else { const float* src = (e < 64) ? a.in[I_ED] + (size_t)e * DEXP * D : a.in[I_SD];
                const int kb = r / 64, nb = r % 64; transpose_item(src, D, DEXP, (bf16*)(F.ws + WS_DT) + (size_t)e * D * DEXP, DEXP, kb * 64, nb * 32, nb * 32, scr, F.lane); }
        }
        __syncthreads();
    }
    const float* X1 = a.out; const float* MOD = (const float*)(F.ws + WS_MOD); bf16* H2 = (bf16*)(F.ws + WS_H2);
    LAS float* hs = (LAS float*)F.lds;
    LAS float* wsb = hs + 64 * RT_LD;
    LAS float* lg = wsb + 64 * RT_LD;
    LAS float* lg2 = lg + 64 * 65;
    LAS float* selb = lg2 + 64 * 65;
    LAS float* rs = selb + 64 * 65;
    LAS int* cnt = (LAS int*)(rs + 64);
    LAS int* basee = cnt + 64;
    LAS int* eloc = basee + 64;
    LAS int* rloc = eloc + 512;
    for (int tile = F.vcu; tile < NT / 64; tile += F.G) {
        const int t0 = tile * 64, b = t0 >> 12;
        const float* sh2 = MOD + (size_t)b * 12288 + 6144; const float* sc2 = MOD + (size_t)b * 12288 + 8192; const float* g2 = a.in[I_N2G];
        if (F.tid < 64) cnt[F.tid] = 0;
        for (int rr = 0; rr < 8; ++rr) { const int tl = F.wave * 8 + rr; const f32x4* xr = (const f32x4*)(X1 + (size_t)(t0 + tl) * D) + F.lane; f32x4 v[8]; float s = 0.f;
#pragma unroll
            for (int q = 0; q < 8; ++q) { v[q] = xr[64 * q]; s += (v[q].x * v[q].x + v[q].y * v[q].y) + (v[q].z * v[q].z + v[q].w * v[q].w); }
            const float rstd = 1.0f / sqrtf(wave_sum(s) * (1.0f / D) + 1e-6f); if (F.lane == 0) rs[tl] = rstd;
            v2u* o = (v2u*)(H2 + (size_t)(t0 + tl) * D) + F.lane;
#pragma unroll
            for (int q = 0; q < 8; ++q) { const f32x4 y = v[q] * rstd * ((const f32x4*)g2)[F.lane + 64 * q] * (((const f32x4*)sc2)[F.lane + 64 * q] + 1.0f) + ((const f32x4*)sh2)[F.lane + 64 * q];
                v2u w; w.x = pk2(y.x, y.y); w.y = pk2(y.z, y.w); o[64 * q] = w; } }
        __syncthreads();
        const int tg = F.tid & 15, eg = (F.tid >> 4) & 15, kh = F.tid >> 8;
        float acc[4][4];
#pragma unroll
        for (int i = 0; i < 4; ++i)
#pragma unroll
            for (int j = 0; j < 4; ++j) acc[i][j] = 0.f;
        const int stok = F.tid >> 3, sk8 = (F.tid & 7) * 8; const float rstd_s = rs[stok];
        for (int kc = 0; kc < D / 64; ++kc) {
            { const int k0 = kc * 64 + sk8; const float* xp = X1 + (size_t)(t0 + stok) * D + k0;
              const f32x4 x0 = *(const f32x4*)xp, x1v = *(const f32x4*)(xp + 4);
              const f32x4 ga = *(const f32x4*)(g2 + k0), gb = *(const f32x4*)(g2 + k0 + 4), ca = *(const f32x4*)(sc2 + k0), cb = *(const f32x4*)(sc2 + k0 + 4), ha = *(const f32x4*)(sh2 + k0), hb = *(const f32x4*)(sh2 + k0 + 4);
              const f32x4 y0 = x0 * rstd_s * ga * (ca + 1.0f) + ha, y1 = x1v * rstd_s * gb * (cb + 1.0f) + hb;
              hs[(sk8 + 0) * RT_LD + stok] = y0.x; hs[(sk8 + 1) * RT_LD + stok] = y0.y; hs[(sk8 + 2) * RT_LD + stok] = y0.z; hs[(sk8 + 3) * RT_LD + stok] = y0.w;
              hs[(sk8 + 4) * RT_LD + stok] = y1.x; hs[(sk8 + 5) * RT_LD + stok] = y1.y; hs[(sk8 + 6) * RT_LD + stok] = y1.z; hs[(sk8 + 7) * RT_LD + stok] = y1.w;
              const float* wp = a.in[I_RW] + (size_t)kc * 4096 + F.tid * 8; const f32x4 w0 = *(const f32x4*)wp, w1 = *(const f32x4*)(wp + 4);
              const int wk = F.tid >> 3, we = (F.tid & 7) * 8; *(LAS f32x4*)(wsb + wk * RT_LD + we) = w0; *(LAS f32x4*)(wsb + wk * RT_LD + we + 4) = w1; }
            __syncthreads();
#pragma unroll 8
            for (int k = kh * 32; k < kh * 32 + 32; ++k) { const f32x4 h4 = *(const LAS f32x4*)(hs + k * RT_LD + 4 * tg), w4 = *(const LAS f32x4*)(wsb + k * RT_LD + 4 * eg);
                acc[0][0] += h4.x * w4.x; acc[0][1] += h4.x * w4.y; acc[0][2] += h4.x * w4.z; acc[0][3] += h4.x * w4.w;
                acc[1][0] += h4.y * w4.x; acc[1][1] += h4.y * w4.y; acc[1][2] += h4.y * w4.z; acc[1][3] += h4.y * w4.w;
                acc[2][0] += h4.z * w4.x; acc[2][1] += h4.z * w4.y; acc[2][2] += h4.z * w4.z; acc[2][3] += h4.z * w4.w;
                acc[3][0] += h4.w * w4.x; acc[3][1] += h4.w * w4.y; acc[3][2] += h4.w * w4.z; acc[3][3] += h4.w * w4.w; }
            __syncthreads();
        }
        { LAS float* dstl = kh ? lg2 : lg;
#pragma unroll
          for (int i = 0; i < 4; ++i)
#pragma unroll
              for (int j = 0; j < 4; ++j) dstl[(4 * tg + i) * 65 + 4 * eg + j] = acc[i][j]; }
        __syncthreads();
        for (int idx = F.tid; idx < 4096; idx += 512) { const int tl = idx >> 6, e = idx & 63; const float sc = sigmoidf_(lg[tl * 65 + e] + lg2[tl * 65 + e]); lg[tl * 65 + e] = sc; selb[tl * 65 + e] = sc + a.in[I_RB][e]; }
        __syncthreads();
        if (F.tid < 64) {
            const int tl = F.tid; LAS float* sel = selb + tl * 65; const LAS float* scr = lg + tl * 65;
            float gs[8];
#pragma unroll
            for (int g = 0; g < 8; ++g) { float m1 = -INFINITY, m2 = -INFINITY;
#pragma unroll
                for (int j = 0; j < 8; ++j) { const float v = sel[g * 8 + j]; if (v > m1) { m2 = m1; m1 = v; } else if (v > m2) m2 = v; }
                gs[g] = m1 + m2; }
            unsigned gmask = 0u;
#pragma unroll
            for (int it = 0; it < 4; ++it) { float best = -INFINITY; int bi = 0;
#pragma unroll
                for (int g = 0; g < 8; ++g) { const bool ok = !((gmask >> g) & 1u) && gs[g] > best; best = ok ? gs[g] : best; bi = ok ? g : bi; }
                gmask |= 1u << bi; }
            for (int g = 0; g < 8; ++g) if (!((gmask >> g) & 1u)) { for (int j = 0; j < 8; ++j) sel[g * 8 + j] = -INFINITY; }
            float wv[8]; int ev[8]; float wsum = 0.f;
#pragma unroll
            for (int it = 0; it < 8; ++it) { float best = -INFINITY; int bi = 0;
                for (int e = 0; e < 64; ++e) { const float v = sel[e]; if (v > best) { best = v; bi = e; } }
                sel[bi] = -INFINITY; ev[it] = bi; wv[it] = scr[bi]; wsum += wv[it]; }
            const float inv = 2.5f / wsum;
#pragma unroll
            for (int it = 0; it < 8; ++it) { const int lr = atomicAdd((int*)&cnt[ev[it]], 1); eloc[tl * 8 + it] = ev[it]; rloc[tl * 8 + it] = lr;
                ((float*)(F.ws + WS_WSEL))[(size_t)(t0 + tl) * 8 + it] = wv[it] * inv; }
        }
        __syncthreads();
        if (F.tid < 64) basee[F.tid] = (int)__hip_atomic_fetch_add(F.ctl + CW_GCNT + F.tid, (unsigned)cnt[F.tid], __ATOMIC_RELAXED, __HIP_MEMORY_SCOPE_AGENT);
        __syncthreads();
        { const int e = eloc[F.tid]; ((int*)(F.ws + WS_EIDX))[(size_t)t0 * 8 + F.tid] = e; ((int*)(F.ws + WS_RANK))[(size_t)t0 * 8 + F.tid] = basee[e] + rloc[F.tid]; }
        __syncthreads();
    }
}
__device__ __forceinline__ int moe_tables(Frame& F) {
    LAS int* te = (LAS int*)(F.lds + TAB_OFF); LAS int* off = te + MAXTILES;
    if (F.tid == 0) { int o = 0; for (int e = 0; e < 64; ++e) { off[e] = o; const int c = (int)__hip_atomic_load(F.ctl + CW_GCNT + e, __ATOMIC_RELAXED, __HIP_MEMORY_SCOPE_AGENT); o += (c + 255) & ~255; } off[64] = o; off[65] = o / 256 + NT / 256; }
    __syncthreads();
    const int ntiles = off[65];
    for (int rt = F.tid; rt < ntiles; rt += 512) { int e = 0; for (int j = 1; j <= 64; ++j) if (rt * 256 >= off[j]) e = j; te[rt] = e; }
    __syncthreads();
    return ntiles;
}
__device__ __forceinline__ void p12_slots(Frame& F) {
    (void)moe_tables(F);
    const LAS int* off = (const LAS int*)(F.lds + TAB_OFF) + MAXTILES;
    int* tok = (int*)(F.ws + WS_TOK); int* dst = (int*)(F.ws + WS_DST); float* wsl = (float*)(F.ws + WS_WSL);
    const int* eidx = (const int*)(F.ws + WS_EIDX); const int* rank = (const int*)(F.ws + WS_RANK); const float* wsel = (const float*)(F.ws + WS_WSEL);
    const int gt = F.vcu * 512 + F.tid, NGT = F.G * 512;
    for (int i = gt; i < NT * 8; i += NGT) { const int t = i >> 3, k = i & 7; const int slot = off[eidx[i]] + rank[i]; tok[slot] = t; dst[slot] = t * 9 + k; wsl[slot] = wsel[i]; }
    const int o64 = off[64];
    for (int t = gt; t < NT; t += NGT) { const int slot = o64 + t; tok[slot] = t; dst[slot] = t * 9 + 8; wsl[slot] = 1.0f; }
}
__device__ __forceinline__ void p15_final(Frame& F, const Args& a) {
    const int gw = F.vcu * 8 + F.wave, NGW = F.G * 8; const float* MOD = (const float*)(F.ws + WS_MOD); const bf16* YP = (const bf16*)(F.ws + WS_YP);
    for (int t = gw; t < NT; t += NGW) {
        const int b = t >> 12; const f32x4* gt2 = (const f32x4*)(MOD + (size_t)b * 12288 + 10240) + F.lane; const f32x4* fg = (const f32x4*)a.in[I_FG] + F.lane;
        f32x4* xr = (f32x4*)(a.out + (size_t)t * D) + F.lane; f32x4 v[8]; float s = 0.f;
#pragma unroll
        for (int q = 0; q < 8; ++q) { f32x4 m = (f32x4){0.f, 0.f, 0.f, 0.f};
#pragma unroll
            for (int j = 0; j < 9; ++j) { const v2u y = *((const v2u*)(YP + (size_t)(t * 9 + j) * D) + F.lane + 64 * q); m += (f32x4){bflo(y.x), bfhi(y.x), bflo(y.y), bfhi(y.y)}; }
            v[q] = xr[64 * q] + gt2[64 * q] * m; s += (v[q].x * v[q].x + v[q].y * v[q].y) + (v[q].z * v[q].z + v[q].w * v[q].w); }
        const float rstd = 1.0f / sqrtf(wave_sum(s) * (1.0f / D) + 1e-6f);
#pragma unroll
        for (int q = 0; q < 8; ++q) xr[64 * q] = v[q] * rstd * fg[64 * q];
    }
}
#ifndef MK_ONE_LAUNCH
#define MK_ONE_LAUNCH 0
#endif
constexpr int NPHASE = 16;
__global__ void __launch_bounds__(512, 2) mk_fwd(Args args) {
    extern __shared__ __attribute__((aligned(16))) unsigned char lds[];
    Frame F;
    F.lds = (LAS unsigned char*)lds; F.MISC = (volatile LAS unsigned*)(F.lds + LDSCTL_OFF);
    int wave0 = __builtin_amdgcn_readfirstlane((int)threadIdx.x >> 6); asm volatile("" : "+s"(wave0));
    F.tid = threadIdx.x; F.lane = F.tid & 63; F.wave = wave0;
    F.G = gridDim.x; { const int bx = blockIdx.x; F.vcu = (F.G % 8 == 0) ? (bx % 8) * (F.G / 8) + bx / 8 : bx; }
    F.ws = args.ws; F.ctl = (unsigned*)(args.ws + WS_CTL);
    for (int u = F.tid; u < 256; u += 512) ((LAS unsigned*)(F.lds + LDSCTL_OFF))[u] = 0u;
    __syncthreads();
    XcdBarrier bar; bar.bar = F.ctl + CW_BAR; bar.x = 0; bar.st = nullptr;
    if (MK_ONE_LAUNCH) bar = xcd_barrier_post(F.ctl + CW_BAR, F.MISC + 8);
    const int lo = args.ph_lo, hi = args.ph_hi;
#ifndef PHMASK
#define PHMASK 0xFFFF
#endif
#define IN(k) (((PHMASK >> (k)) & 1) && lo <= (k) && (k) < hi)
#define FRESH() do { int l_ = (int)__builtin_amdgcn_mbcnt_hi(~0u, __builtin_amdgcn_mbcnt_lo(~0u, 0u)); asm volatile("" : "+v"(l_)); int w_ = wave0; asm volatile("" : "+s"(w_)); F.lane = l_; F.wave = w_; F.tid = w_ * 64 + l_; } while (0)
#define SEAM(k) do { if (MK_ONE_LAUNCH) { if (IN(k) && IN((k) + 1)) xcd_barrier(bar); } } while (0)
    const int G = F.G, c = (int)blockIdx.x;
    unsigned char* ws = args.ws;

    if (IN(0)) { FRESH(); p0_prologue(F, args); } SEAM(0);
    if (IN(1)) { FRESH(); p1_norm1(F, args); } SEAM(1);
    if (IN(2)) { FRESH();
        G1Order S{(const char*)(ws + WS_HA), (const char*)(ws + WS_WIN), (size_t)256 * D * 2, (size_t)256 * D * 2, G, c};
        EpiG1 E{(bf16*)(ws + WS_U), (bf16*)(ws + WS_SLAB), (bf16*)(ws + WS_GATES)};
        pg8::gemm_phase<EpiG1, G1Order, false>(F.lds + RING_OFF, F.wave, D, D, D, S, E);
    } SEAM(2);
    if (IN(3)) { FRESH(); p3_prep(F, args); } SEAM(3);
    if (IN(4)) { FRESH();
#ifndef NO4A
        {
            RepOrder S{(const char*)(ws + WS_LIN), (const char*)(ws + WS_LORA), (size_t)128 * 2, (size_t)D * 128 * 2, (size_t)256 * LINLD * 2, (size_t)256 * 128 * 2, MT / 256, D / 256, 4, G, c};
            EpiLora E{(unsigned short*)(ws + WS_EA), args.in[I_DW0], args.in[I_IA0]};
            pg8::gemm_phase<EpiLora, RepOrder, false>(F.lds + RING_OFF, F.wave, 128, LINLD, 128, S, E);
        }
#endif
    }
    if (IN(4)) { FRESH();
#ifndef NO4B
        {
            RepOrder S{(const char*)(ws + WS_DP), (const char*)(ws + WS_POOLW), (size_t)256 * 2, (size_t)256 * 256 * 2, (size_t)256 * 1024 * 2, (size_t)256 * 256 * 2, NT / 256, 1, 4, G, c};
            EpiPoolG E{(bf16*)(ws + WS_Y2), args.in[I_POOLS]};
            pg8::gemm_phase<EpiPoolG, RepOrder, false>(F.lds + RING_OFF, F.wave, 256, 1024, 256, S, E);
        }
#endif
    } SEAM(4);
    if (IN(5)) { FRESH();
        RepOrder S{(const char*)(ws + WS_Y2), (const char*)(ws + WS_WPO), 0, 0, (size_t)256 * 1024 * 2, (size_t)256 * 1024 * 2, NT / 256, D / 256, 1, G, c};
        EpiMix<0> E{(bf16*)(ws + WS_MP), D, (const bf16*)(ws + WS_GATES), 4096, nullptr, 0};
        pg8::gemm_phase<EpiMix<0>, RepOrder, false>(F.lds + RING_OFF, F.wave, 1024, 1024, 1024, S, E);
    } SEAM(5);
    if (IN(6)) { FRESH(); p6_scan(F, args); } SEAM(6);
    if (IN(7)) { FRESH(); p7_readout(F, args); } SEAM(7);
    if (IN(8)) { FRESH();
        RepOrder S{(const char*)(ws + WS_LIN) + 512 * 2, (const char*)(ws + WS_G2), 0, 0, (size_t)256 * LINLD * 2, (size_t)256 * 256 * 2, NT / 256, D / 256, 1, G, c};
        EpiMix<1> E{(bf16*)(ws + WS_OR), D, (const bf16*)(ws + WS_Z), D, nullptr, 0};
        pg8::gemm_phase<EpiMix<1>, RepOrder, false>(F.lds + RING_OFF, F.wave, 256, LINLD, 256, S, E);
    } SEAM(8);
    if (IN(9)) { FRESH();
        RepOrder S{(const char*)(ws + WS_OR), (const char*)(ws + WS_WRO), 0, 0, (size_t)256 * D * 2, (size_t)256 * D * 2, NT / 256, D / 256, 1, G, c};
        EpiMix<2> E{(bf16*)(ws + WS_MP), D, (const bf16*)(ws + WS_GATES) + 2048, 4096, (const bf16*)(ws + WS_MP), D};
        pg8::gemm_phase<EpiMix<2>, RepOrder, false>(F.lds + RING_OFF, F.wave, D, D, D, S, E);
    } SEAM(9);
    if (IN(10)) { FRESH();
        RepOrder S{(const char*)(ws + WS_MP), (const char*)(ws + WS_WO), 0, 0, (size_t)256 * D * 2, (size_t)256 * D * 2, NT / 256, D / 256, 1, G, c};
        EpiX1 E{args.in[I_X], args.out, (const float*)(ws + WS_MOD)};
        pg8::gemm_phase<EpiX1, RepOrder, false>(F.lds + RING_OFF, F.wave, D, D, D, S, E);
    } SEAM(10);
    if (IN(11)) { FRESH(); p11_route(F, args); } SEAM(11);
    if (IN(12)) { FRESH(); p12_slots(F); } SEAM(12);
    if (IN(13)) { FRESH();
        const int ntiles = moe_tables(F);
        MoeOrder S{(const char*)(ws + WS_H2), (const char*)(ws + WS_GU), (const LAS int*)(F.lds + TAB_OFF), (const int*)(ws + WS_TOK), 0, (size_t)1024 * D * 2, (size_t)256 * D * 2, ntiles, 4, G, c};
        EpiAct E{(bf16*)(ws + WS_ACT)};
        pg8::gemm_phase<EpiAct, MoeOrder, true>(F.lds + RING_OFF, F.wave, D, D, D, S, E);
    } SEAM(13);
    if (IN(14)) { FRESH();
        const int ntiles = moe_tables(F);
        MoeOrder S{(const char*)(ws + WS_ACT), (const char*)(ws + WS_DT), (const LAS int*)(F.lds + TAB_OFF), (const int*)(ws + WS_TOK), (size_t)256 * DEXP * 2, (size_t)D * DEXP * 2, (size_t)256 * DEXP * 2, ntiles, 8, G, c};
        EpiDown E{(bf16*)(ws + WS_YP), (const int*)(ws + WS_DST), (const float*)(ws + WS_WSL)};
        pg8::gemm_phase<EpiDown, MoeOrder, false>(F.lds + RING_OFF, F.wave, DEXP, DEXP, DEXP, S, E);
    } SEAM(14);
    if (IN(15)) { FRESH(); p15_final(F, args); }
#undef IN
#undef SEAM
}

extern "C" void kernel_launch(void* const* d_in, const int* in_sizes, int n_in, void* d_out, int out_size, void* d_ws, size_t ws_size, hipStream_t stream) {
    static int grid = 0;
    if (grid == 0) {
        if (n_in != 34 || in_sizes[0] != NT * D || out_size != NT * D || ws_size < WS_END) { fprintf(stderr, "kernel_launch: unexpected shapes (n_in %d, in0 %d, out %d, ws %zu < %zu)\n", n_in, n_in > 0 ? in_sizes[0] : -1, out_size, ws_size, (size_t)WS_END); grid = -1; return; }
        int dev = 0, cus = 0, per_cu = 0;
        if (hipGetDevice(&dev) != hipSuccess || hipDeviceGetAttribute(&cus, hipDeviceAttributeMultiprocessorCount, dev) != hipSuccess) { grid = -1; return; }
        if (hipFuncSetAttribute((const void*)mk_fwd, hipFuncAttributeMaxDynamicSharedMemorySize, LDS_BYTES) != hipSuccess) { fprintf(stderr, "kernel_launch: hipFuncSetAttribute failed\n"); grid = -1; return; }
        if (hipOccupancyMaxActiveBlocksPerMultiprocessor(&per_cu, (const void*)mk_fwd, 512, LDS_BYTES) != hipSuccess || per_cu < 1) fprintf(stderr, "kernel_launch: occupancy query reports %d\n", per_cu);
        (void)hipGetLastError();
        grid = cus;
    }
    if (grid < 0) return;
    if (hipMemsetAsync((char*)d_ws + WS_CTL, 0, CTL_ZERO_BYTES, stream) != hipSuccess) return;
    Args a{};
    for (int i = 0; i < 34; ++i) a.in[i] = (const float*)d_in[i];
    a.out = (float*)d_out; a.ws = (unsigned char*)d_ws;
#if MK_ONE_LAUNCH
    a.ph_lo = 0; a.ph_hi = NPHASE;
    hipLaunchKernelGGL(mk_fwd, dim3(grid), dim3(512), LDS_BYTES, stream, a);
#else
    for (int p = 0; p < NPHASE; ++p) { a.ph_lo = p; a.ph_hi = p + 1; hipLaunchKernelGGL(mk_fwd, dim3(grid), dim3(512), LDS_BYTES, stream, a); }
#endif
}
```

```cpp
#include <hip/hip_runtime.h>
#include <cstdio>
#include <cstdint>

#define GAS __attribute__((address_space(1)))
#define LAS __attribute__((address_space(3)))
typedef unsigned short bf16;
typedef unsigned v4u __attribute__((ext_vector_type(4)));
typedef unsigned v2u __attribute__((ext_vector_type(2)));
typedef float f32x4 __attribute__((ext_vector_type(4)));
typedef float f32x2 __attribute__((ext_vector_type(2)));
typedef short bf16x8 __attribute__((ext_vector_type(8)));

constexpr int D = 2048, NB = 4, TSEQ = 4096, NT = NB * TSEQ  , CTXL = 256, NC = NB * CTXL  , MT = NT + NC  ;
constexpr int DIN = 11904, DSH = 6784, NPAD = 12032, SLABLD = 6912, NH = 32, HS = 64;
constexpr int NEXP = 64, DEXP = 512, TOPK = 8;
constexpr int NSLOT = NT * TOPK + NEXP * 256 + NT;
constexpr int MAXTILES = NSLOT / 256;
constexpr int LINLD = 768;

__device__ __forceinline__ unsigned f2bf(float f) { unsigned u = __builtin_bit_cast(unsigned, f); return (u + 0x7fffu + ((u >> 16) & 1u)) >> 16; }
__device__ __forceinline__ unsigned pk2(float lo, float hi) { unsigned r; asm volatile("v_cvt_pk_bf16_f32 %0, %1, %2" : "=v"(r) : "v"(lo), "v"(hi)); return r; }
__device__ __forceinline__ float bflo(unsigned w) { return __builtin_bit_cast(float, w << 16); }
__device__ __forceinline__ float bfhi(unsigned w) { return __builtin_bit_cast(float, w & 0xffff0000u); }
__device__ __forceinline__ unsigned pkh2(float lo, float hi) { const unsigned short a = __builtin_bit_cast(unsigned short, (_Float16)lo), b = __builtin_bit_cast(unsigned short, (_Float16)hi); return (unsigned)a | ((unsigned)b << 16); }
__device__ __forceinline__ float hlo(unsigned w) { return (float)__builtin_bit_cast(_Float16, (unsigned short)(w & 0xffffu)); }
__device__ __forceinline__ float hhi(unsigned w) { return (float)__builtin_bit_cast(_Float16, (unsigned short)(w >> 16)); }
__device__ __forceinline__ float sigmoidf_(float x) { return 1.0f / (1.0f + __expf(-x)); }
__device__ __forceinline__ float wave_sum(float v) {
#pragma unroll
    for (int o = 1; o < 64; o <<= 1) v += __shfl_xor(v, o);
    return v;
}
__device__ __forceinline__ float dpp_f(float v, const int ctrl_sel) {
    int r;
    const int x = __builtin_bit_cast(int, v);
    if (ctrl_sel == 0) r = __builtin_amdgcn_update_dpp(0, x, 0xB1, 0xF, 0xF, true);
    else if (ctrl_sel == 1) r = __builtin_amdgcn_update_dpp(0, x, 0x4E, 0xF, 0xF, true);
    else if (ctrl_sel == 2) r = __builtin_amdgcn_update_dpp(0, x, 0x141, 0xF, 0xF, true);
    else r = __builtin_amdgcn_update_dpp(0, x, 0x140, 0xF, 0xF, true);
    return __builtin_bit_cast(float, r);
}
__device__ __forceinline__ float allred16(float v) { v += dpp_f(v, 0); v += dpp_f(v, 1); v += dpp_f(v, 2); v += dpp_f(v, 3); return v; }

#define LDS_WAIT() asm volatile("s_waitcnt lgkmcnt(0)" ::: "memory")
#define VM_WAIT() asm volatile("s_waitcnt vmcnt(0)" ::: "memory")

namespace pg8 {
constexpr int BM = 256, BK = 64, HALF = 128, HTB = HALF * BK * 2, STAGE_BYTES = 8 * HTB, NXCD = 8, WGM = 8;
__host__ __device__ __forceinline__ int lds_byte(int r, int c) { const int st = (r >> 4) * 2 + (c >> 5), rr = r & 15, cc = c & 31, ob = rr * 64 + cc * 2; return st * 1024 + (ob ^ (((ob >> 9) & 1) << 5)); }
__host__ __device__ __forceinline__ void stage_rc(int b, int& R, int& C) { const int st = b / 1024, sb = b % 1024, swz = sb ^ (((sb >> 9) & 1) << 5); R = (st >> 1) * 16 + swz / 64; C = (st & 1) * 32 + (swz % 64) / 2; }
__host__ __device__ __forceinline__ int perm32(int rho) { const int n = rho >> 4, i = rho & 15; return 8 * (i >> 2) + 4 * n + (i & 3); }
struct Unit { const char* A; const char* B; int pm, pn, aux; };
__device__ __forceinline__ int xcd_remap(int L, int nwg) { const int q = nwg / NXCD, r = nwg % NXCD, xcd = L % NXCD, off = L / NXCD; return (xcd < r ? xcd * (q + 1) : r * (q + 1) + (xcd - r) * q) + off; }
__device__ __forceinline__ void grid_tile(int wgid, int nM, int nN, int& pm, int& pn) { const int nig = WGM * nN, gid = wgid / nig, fm = gid * WGM, gsz = (nM - fm) < WGM ? (nM - fm) : WGM; pm = fm + ((wgid % nig) % gsz); pn = (wgid % nig) / gsz; }

__device__ __forceinline__ void stage2(LAS unsigned char* lds, int bufoff, unsigned ldsw, const char* g, unsigned o0, unsigned o1) {
    __builtin_amdgcn_global_load_lds((const unsigned*)(g + o0), (LAS unsigned*)(lds + bufoff + ldsw), 16, 0, 0);
    __builtin_amdgcn_global_load_lds((const unsigned*)(g + o1), (LAS unsigned*)(lds + bufoff + ldsw + 8192), 16, 0, 0);
}

template <class Epi, class Sched, bool GATHER>
__device__ __forceinline__ void gemm_phase(LAS unsigned char* lds, const int wave_, const int K, const int lda, const int ldb, const Sched& S, const Epi& E) {
    int tid_ = wave_ * 64 + (int)__builtin_amdgcn_mbcnt_hi(~0u, __builtin_amdgcn_mbcnt_lo(~0u, 0u)); asm volatile("" : "+v"(tid_));
    const int tid = tid_, wid = __builtin_amdgcn_readfirstlane(tid >> 6), lane = tid & 63, wr = wid >> 2, wc = wid & 3, fr = lane & 15, fq = lane >> 4;
    const int nt = K / BK;
    unsigned voffA[2], voffB[2]; int RA[2], CA[2];
#pragma unroll
    for (int i = 0; i < 2; ++i) { int R, C; stage_rc(tid * 16 + i * 8192, R, C); const int Rb = Epi::PERM ? ((R & ~31) + perm32(R & 31)) : R;
        RA[i] = R; CA[i] = C; voffA[i] = (unsigned)(R * lda + C) * 2u; voffB[i] = (unsigned)(Rb * ldb + C) * 2u; }
    const size_t kstep = (size_t)(BK * 2);
    const size_t hstepA = (size_t)HALF * lda * 2, hstepB = (size_t)HALF * ldb * 2;
    const unsigned ldsw = (unsigned)wid * 1024u;
    const int aoff = lds_byte(wr * 64 + fr, fq * 8), boff = lds_byte(wc * 32 + fr, fq * 8);
#define PG8_SA(b, h) (((b) * 2 + (h)) * HTB)
#define PG8_SB(b, h) ((4 + (b) * 2 + (h)) * HTB)
#define PG8_STB(bufoff, gbase) stage2(lds, (bufoff), ldsw, (gbase), voffB[0], voffB[1])
#define PG8_STA(bufoff, gk, h, NX) do { if constexpr (GATHER) { const unsigned _o0 = (NX) ? vn[h][0] : vc[h][0], _o1 = (NX) ? vn[h][1] : vc[h][1]; stage2(lds, (bufoff), ldsw, (gk), _o0, _o1); } \
        else stage2(lds, (bufoff), ldsw, (gk) + (h) * hstepA, voffA[0], voffA[1]); } while (0)
#define PG8_LDA(dst, b, h) do { _Pragma("unroll") for (int m = 0; m < 4; ++m) _Pragma("unroll") for (int k = 0; k < 2; ++k) dst[m][k] = *(const LAS bf16x8*)(lds + PG8_SA(b, h) + aoff + m * 2048 + k * 1024); } while (0)
#define PG8_LDB(dst, b, h) do { _Pragma("unroll") for (int n = 0; n < 2; ++n) _Pragma("unroll") for (int k = 0; k < 2; ++k) dst[n][k] = *(const LAS bf16x8*)(lds + PG8_SB(b, h) + boff + n * 2048 + k * 1024); } while (0)
#define PG8_MMA(ai, bj, At, Bt) do { __builtin_amdgcn_s_setprio(1); _Pragma("unroll") for (int m = 0; m < 4; ++m) _Pragma("unroll") for (int n = 0; n < 2; ++n) _Pragma("unroll") for (int k = 0; k < 2; ++k) \
        acc[ai][bj][m][n] = __builtin_amdgcn_mfma_f32_16x16x32_bf16(Bt[n][k], At[m][k], acc[ai][bj][m][n], 0, 0, 0); __builtin_amdgcn_s_setprio(0); } while (0)
#define PG8_WAIT_V(n) asm volatile("s_waitcnt vmcnt(" #n ")" ::: "memory")
#define PG8_WAIT_L(n) asm volatile("s_waitcnt lgkmcnt(" #n ")" ::: "memory")
#define PG8_BAR __builtin_amdgcn_s_barrier()
#define PG8_SCHED __builtin_amdgcn_sched_barrier(0)
    Unit cur, nxt; int ui = 0;
    if (!S.next(0, cur)) return;
    unsigned vc[2][2], vn[2][2];
    if constexpr (GATHER) {
#pragma unroll
        for (int h = 0; h < 2; ++h)
#pragma unroll
            for (int i = 0; i < 2; ++i) { vc[h][i] = ((unsigned)S.row(cur, h * HALF + RA[i]) * (unsigned)lda + (unsigned)CA[i]) * 2u; vn[h][i] = vc[h][i]; }
        asm volatile("s_waitcnt vmcnt(0)" ::: "memory");
    }
    f32x4 acc[2][2][4][2];
#pragma unroll
    for (int a = 0; a < 2; ++a)
#pragma unroll
        for (int b = 0; b < 2; ++b)
#pragma unroll
            for (int m = 0; m < 4; ++m)
#pragma unroll
                for (int n = 0; n < 2; ++n) acc[a][b][m][n] = (f32x4){0.f, 0.f, 0.f, 0.f};
    bf16x8 At[4][2], B0[2][2], B1[2][2];
    const char* cA = cur.A; const char* cB = cur.B;
    PG8_STB(PG8_SB(0, 0), cB); PG8_STB(PG8_SB(0, 1), cB + hstepB); PG8_STA(PG8_SA(0, 0), cA, 0, false); PG8_STA(PG8_SA(0, 1), cA, 1, false);
    if (wr == 1) PG8_BAR;
    PG8_WAIT_V(2); PG8_BAR;
    PG8_STB(PG8_SB(1, 0), cB + kstep); PG8_STA(PG8_SA(1, 0), cA + kstep, 0, false); PG8_STB(PG8_SB(1, 1), cB + hstepB + kstep);
    PG8_WAIT_V(6); PG8_BAR;
    for (;;) {
        const bool has_next = S.next(ui + 1, nxt);
        const char* nA = has_next ? nxt.A : cA; const char* nB = has_next ? nxt.B : cB;
        for (int t = 0; t < nt; t += 2) {
            const bool last = (t == nt - 2);
            const char* a1 = cA + (size_t)(t + 1) * kstep;
            const char* a2 = last ? nA : cA + (size_t)(t + 2) * kstep; const char* b2 = last ? nB : cB + (size_t)(t + 2) * kstep;
            const char* a3 = a2 + kstep; const char* b3 = b2 + kstep;
            if constexpr (GATHER) {
                if (last && has_next) {
#pragma unroll
                    for (int h = 0; h < 2; ++h)
#pragma unroll
                        for (int i = 0; i < 2; ++i) vn[h][i] = ((unsigned)S.row(nxt, h * HALF + RA[i]) * (unsigned)lda + (unsigned)CA[i]) * 2u;
                    asm volatile("s_waitcnt vmcnt(0)" ::: "memory");
                }
            }
            PG8_LDB(B0, 0, 0); PG8_LDB(B1, 0, 1); PG8_SCHED; PG8_LDA(At, 0, 0); PG8_STA(PG8_SA(1, 1), a1, 1, false);
            PG8_WAIT_V(8); PG8_WAIT_L(0); PG8_BAR; PG8_MMA(0, 0, At, B0); PG8_MMA(0, 1, At, B1); PG8_BAR; PG8_SCHED;
            PG8_LDA(At, 0, 1); PG8_STB(PG8_SB(0, 0), b2); PG8_STB(PG8_SB(0, 1), b2 + hstepB); PG8_STA(PG8_SA(0, 0), a2, 0, last);
            PG8_WAIT_V(8); PG8_WAIT_L(0); PG8_BAR; PG8_MMA(1, 0, At, B0); PG8_MMA(1, 1, At, B1); PG8_BAR; PG8_SCHED;
            PG8_LDB(B0, 1, 0); PG8_LDB(B1, 1, 1); PG8_SCHED; PG8_LDA(At, 1, 0); PG8_STA(PG8_SA(0, 1), a2, 1, last);
            PG8_WAIT_V(8); PG8_WAIT_L(0); PG8_BAR; PG8_MMA(0, 0, At, B0); PG8_MMA(0, 1, At, B1); PG8_BAR; PG8_SCHED;
            PG8_LDA(At, 1, 1); PG8_STB(PG8_SB(1, 0), b3); PG8_STB(PG8_SB(1, 1), b3 + hstepB); PG8_STA(PG8_SA(1, 0), a3, 0, last);
            PG8_WAIT_V(8); PG8_WAIT_L(0); PG8_BAR; PG8_MMA(1, 0, At, B0); PG8_MMA(1, 1, At, B1); PG8_BAR; PG8_SCHED;
        }
        if (wr == 0) PG8_BAR;
        { int fr_ = fr, fq_ = fq; asm volatile("" : "+v"(fr_), "+v"(fq_));
          E(acc, cur, wr, wc, fr_, fq_); }
        if (!has_next) break;
#pragma unroll
        for (int a = 0; a < 2; ++a)
#pragma unroll
            for (int b = 0; b < 2; ++b)
#pragma unroll
                for (int m = 0; m < 4; ++m)
#pragma unroll
                    for (int n = 0; n < 2; ++n) acc[a][b][m][n] = (f32x4){0.f, 0.f, 0.f, 0.f};
        cur = nxt; cA = nA; cB = nB; ++ui;
        if constexpr (GATHER) {
#pragma unroll
            for (int h = 0; h < 2; ++h)
#pragma unroll
                for (int i = 0; i < 2; ++i) vc[h][i] = vn[h][i];
        }
        if (wr == 1) PG8_BAR;
    }
    PG8_WAIT_V(0);
    PG8_BAR;
#undef PG8_SA
#undef PG8_SB
#undef PG8_STB
#undef PG8_STA
#undef PG8_LDA
#undef PG8_LDB
#undef PG8_MMA
#undef PG8_WAIT_V
#undef PG8_WAIT_L
#undef PG8_BAR
#undef PG8_SCHED
}
}
#define XB_TMO      128
#define XB_XCNT(j)  (256  + 64 * (j))
#define XB_XSUB(j)  (1280 + 64 * (j))
#define XB_XGEN(j)  (2304 + 64 * (j))
#define XB_TOP      3328
#define XB_TOPGEN   3392
#define XCD_BAR_WORDS 3456
#define XB_SPIN_CAP (1u << 18)
__device__ __forceinline__ unsigned xb_ld(unsigned* p)              { return __hip_atomic_load(p, __ATOMIC_RELAXED, __HIP_MEMORY_SCOPE_AGENT); }
__device__ __forceinline__ unsigned xb_add(unsigned* p, unsigned v) { return __hip_atomic_fetch_add(p, v, __ATOMIC_RELAXED, __HIP_MEMORY_SCOPE_AGENT); }
__device__ __forceinline__ unsigned xb_xcc_id() { return (unsigned)__builtin_amdgcn_s_getreg((3 << 11) | 20) & 0xFu; }
#define XB_SPIN(cond, bar) do { unsigned _sp = 0; while (cond) { __builtin_amdgcn_s_sleep(1); \
    if ((++_sp & 255u) == 0u) { if (xb_ld(&(bar)[XB_TMO])) break; if (_sp > XB_SPIN_CAP) { atomicAdd(&(bar)[XB_TMO], 1u); break; } } } } while (0)
struct XcdBarrier { unsigned* bar; unsigned x; volatile LAS unsigned* st; };
__device__ __forceinline__ XcdBarrier xcd_barrier_post(unsigned* bar, volatile LAS unsigned* st) {
    XcdBarrier b; b.bar = bar; b.x = xb_xcc_id(); b.st = st;
    if (threadIdx.x == 0) (void)xb_add(&bar[XB_XCNT(b.x)], 1u);
    return b;
}
__device__ __forceinline__ void xcd_barrier_complete(unsigned* bar, unsigned x, unsigned& nloc, unsigned& nx) {
    const unsigned G = gridDim.x * gridDim.y * gridDim.z;
    unsigned sum, cnt, mine, sp = 0u;
    for (;;) {
        sum = 0u; cnt = 0u; mine = 0u;
#pragma unroll
        for (unsigned j = 0; j < 16; ++j) { const unsigned c = xb_ld(&bar[XB_XCNT(j)]); sum += c; cnt += (c > 0u) ? 1u : 0u; mine = (j == x) ? c : mine; }
        if (sum == G) break;
        __builtin_amdgcn_s_sleep(1);
        if ((++sp & 255u) == 0u) { if (xb_ld(&bar[XB_TMO])) break; if (sp > XB_SPIN_CAP) { atomicAdd(&bar[XB_TMO], 1u); break; } }
    }
    nloc = mine > 0u ? mine : 1u; nx = cnt > 0u ? cnt : 1u;
}
__device__ __forceinline__ void xcd_barrier(const XcdBarrier& b) {
    asm volatile("s_waitcnt vmcnt(0)" ::: "memory");
    __syncthreads();
    if (threadIdx.x == 0) {
        unsigned* bar = b.bar;
        __builtin_amdgcn_s_waitcnt(0);
        unsigned nloc = b.st[0], nx = b.st[1];
        if (nloc == 0u) { xcd_barrier_complete(bar, b.x, nloc, nx); b.st[0] = nloc; b.st[1] = nx; }
        const unsigned old = xb_add(&bar[XB_XSUB(b.x)], 1u);
        const unsigned gen = old / nloc;
        if (old + 1u == (gen + 1u) * nloc) {
            __builtin_amdgcn_fence(__ATOMIC_RELEASE, "agent");
            asm volatile("s_waitcnt vmcnt(0)" ::: "memory");
            const unsigned og = xb_add(&bar[XB_TOP], 1u);
            const unsigned tg = og / nx;
            if (og + 1u == (tg + 1u) * nx) xb_add(&bar[XB_TOPGEN], 1u);
            else XB_SPIN(xb_ld(&bar[XB_TOPGEN]) == tg, bar);
            __builtin_amdgcn_fence(__ATOMIC_ACQUIRE, "agent");
            xb_add(&bar[XB_XGEN(b.x)], 1u);
            asm volatile("s_waitcnt vmcnt(0)" ::: "memory");
        } else {
            XB_SPIN(xb_ld(&bar[XB_XGEN(b.x)]) == gen, bar);
            __builtin_amdgcn_fence(__ATOMIC_ACQUIRE, "agent");
            asm volatile("s_waitcnt vmcnt(0)" ::: "memory");
        }
    }
    __syncthreads();
}

constexpr size_t MiB = 1u << 20;
constexpr size_t WS_CTL = 0, CTL_ZERO_BYTES = 64 * 1024;
constexpr size_t WS_MOD = 1 * MiB;
constexpr size_t WS_EIDX = 2 * MiB;
constexpr size_t WS_WSEL = WS_EIDX + 512 * 1024;
constexpr size_t WS_RANK = WS_WSEL + 512 * 1024;
constexpr size_t WS_TOK = 4 * MiB;
constexpr size_t WS_DST = WS_TOK + 1 * MiB;
constexpr size_t WS_WSL = WS_DST + 1 * MiB;
constexpr size_t WS_WIN = 8 * MiB;
constexpr size_t WS_POOLW = 55 * MiB;
constexpr size_t WS_WPO = 56 * MiB;
constexpr size_t WS_LORA = 60 * MiB;
constexpr size_t WS_G2 = 62 * MiB;
constexpr size_t WS_WRO = 63 * MiB;
constexpr size_t WS_WO = 71 * MiB;
constexpr size_t WS_SLAB = 80 * MiB;
constexpr size_t WS_EA = 80 * MiB;
constexpr size_t EA_STRIDE = (size_t)MT * D * 2;
constexpr size_t WS_YF = 352 * MiB, WS_YB = 416 * MiB;
constexpr size_t WS_HA = 438 * MiB;
constexpr size_t WS_Z = 480 * MiB;
constexpr size_t WS_U = 506 * MiB;
constexpr size_t WS_RM = 544 * MiB, WS_KM = 612 * MiB, WS_VM = 680 * MiB;
constexpr size_t WS_LIN = 748 * MiB;
constexpr size_t WS_DP = 774 * MiB;
constexpr size_t WS_Y2 = 806 * MiB;
constexpr size_t WS_MP = 838 * MiB;
constexpr size_t WS_GATES = 902 * MiB;
constexpr size_t WS_OR = 80 * MiB;
constexpr size_t WS_H2 = 520 * MiB;
constexpr size_t WS_GU = 584 * MiB;
constexpr size_t WS_ACT = 844 * MiB;
constexpr size_t WS_DT = 1004 * MiB;
constexpr size_t WS_YP = 8 * MiB;
constexpr size_t WS_END = 1134 * MiB;
constexpr int CW_BAR = 1024;
constexpr int CW_GCNT = 8192;
static_assert((CW_BAR + XCD_BAR_WORDS) <= CW_GCNT && (CW_GCNT + 128) * 4 <= (int)CTL_ZERO_BYTES, "ctl");

constexpr int RING_OFF = 0, RING_BYTES = 131072;
constexpr int LDSCTL_OFF = RING_BYTES;
constexpr int TAB_OFF = LDSCTL_OFF + 1024;
constexpr int LDS_BYTES = 147456;

using pg8::Unit;
struct RepOrder {
    const char* A; const char* B; size_t repA, repB, tA, tB; int nM, nN, nrep, G, c;
    __device__ __forceinline__ bool next(int i, Unit& u) const {
        const long L = (long)i * G + c; const int per = nM * nN; if (L >= (long)per * nrep) return false;
        const int rep = (int)(L / per); const int w = pg8::xcd_remap((int)(L % per), per); pg8::grid_tile(w, nM, nN, u.pm, u.pn); u.aux = rep;
        u.A = A + (size_t)rep * repA + (size_t)u.pm * tA; u.B = B + (size_t)rep * repB + (size_t)u.pn * tB; return true; }
    __device__ __forceinline__ int row(const Unit&, int) const { return 0; }
};
struct G1Order {
    const char* A; const char* B; size_t tA, tB; int G, c;
    __device__ __forceinline__ bool next(int i, Unit& u) const {
        const long L = (long)i * G + c; constexpr int N1 = 64 * 47, N2 = 4 * 27; if (L >= N1 + N2) return false;
        if (L < N1) { const int w = pg8::xcd_remap((int)L, N1); pg8::grid_tile(w, 64, 47, u.pm, u.pn); }
        else { const int l2 = (int)L - N1; u.pm = 64 + (l2 & 3); u.pn = 4 + (l2 >> 2); }
        u.aux = 0; u.A = A + (size_t)u.pm * tA; u.B = B + (size_t)u.pn * tB; return true; }
    __device__ __forceinline__ int row(const Unit&, int) const { return 0; }
};
struct MoeOrder {
    const char* A; const char* B; const LAS int* te; const int* tok; size_t tA, estride, jstride; int ntiles, NJ, G, c;
    __device__ __forceinline__ bool next(int i, Unit& u) const {
        const long L = (long)i * G + c; const int tot = ntiles * NJ; if (L >= tot) return false;
        const int w = pg8::xcd_remap((int)L, tot); const int rt = w / NJ, j = w - rt * NJ; const int e = te[rt];
        u.pm = rt; u.pn = j; u.aux = e; u.A = A + (size_t)rt * tA; u.B = B + (size_t)e * estride + (size_t)j * jstride; return true; }
    __device__ __forceinline__ int row(const Unit& u, int r) const { return tok[u.pm * 256 + r]; }
};

typedef f32x4 AccT[2][2][4][2];
#define EPI_ROWS_BEGIN _Pragma("unroll") for (int ai = 0; ai < 2; ++ai) _Pragma("unroll") for (int m = 0; m < 4; ++m) { const int rl = ai * 128 + wr * 64 + m * 16 + fr;
#define EPI_ROWS_END }
struct EpiG1 { static constexpr bool PERM = true; bf16* U; bf16* SLAB; bf16* GATES;
    __device__ __forceinline__ void operator()(const AccT& acc, const Unit& u, int wr, int wc, int fr, int fq) const {
        bf16* base; int ld, c0;
        if (u.pn < 4) { base = U; ld = 1024; c0 = u.pn * 256; } else if (u.pn < 31) { base = SLAB; ld = SLABLD; c0 = (u.pn - 4) * 256; } else { base = GATES; ld = 4096; c0 = (u.pn - 31) * 256; }
        EPI_ROWS_BEGIN
            bf16* rowp = base + (size_t)(u.pm * 256 + rl) * ld + c0 + wc * 32 + 8 * fq;
#pragma unroll
            for (int bj = 0; bj < 2; ++bj) { const f32x4 v0 = acc[ai][bj][m][0], v1 = acc[ai][bj][m][1];
                v4u w; w.x = pk2(v0[0], v0[1]); w.y = pk2(v0[2], v0[3]); w.z = pk2(v1[0], v1[1]); w.w = pk2(v1[2], v1[3]); *(v4u*)(rowp + bj * 128) = w; }
        EPI_ROWS_END
    }
};
struct EpiLora { static constexpr bool PERM = true; unsigned short* EA; const float* w0; const float* a0;
    __device__ __forceinline__ void operator()(const AccT& acc, const Unit& u, int wr, int wc, int fr, int fq) const {
        const int rep = u.aux; const float* bias = (rep < 2 ? w0 + rep * D : a0 + (rep - 2) * D) + u.pn * 256 + wc * 32 + 8 * fq;
        const float cc = rep < 2 ? -0.8750424f : 1.0f;
        unsigned short* base = EA + (size_t)rep * ((size_t)MT * D);
        EPI_ROWS_BEGIN
            unsigned short* rowp = base + (size_t)(u.pm * 256 + rl) * D + u.pn * 256 + wc * 32 + 8 * fq;
#pragma unroll
            for (int bj = 0; bj < 2; ++bj) { const f32x4 v0 = acc[ai][bj][m][0] + *(const f32x4*)(bias + bj * 128), v1 = acc[ai][bj][m][1] + *(const f32x4*)(bias + bj * 128 + 4);
                v4u w; w.x = pkh2(cc * sigmoidf_(v0[0]), cc * sigmoidf_(v0[1])); w.y = pkh2(cc * sigmoidf_(v0[2]), cc * sigmoidf_(v0[3]));
                w.z = pkh2(cc * sigmoidf_(v1[0]), cc * sigmoidf_(v1[1])); w.w = pkh2(cc * sigmoidf_(v1[2]), cc * sigmoidf_(v1[3]));
                *(v4u*)(rowp + bj * 128) = w; }
        EPI_ROWS_END
    }
};
struct EpiPoolG { static constexpr bool PERM = true; bf16* Y2; const float* scale;
    __device__ __forceinline__ void operator()(const AccT& acc, const Unit& u, int wr, int wc, int fr, int fq) const {
        const int cb = u.aux * 256 + wc * 32 + 8 * fq;
        f32x4 s0[2], s1[2];
#pragma unroll
        for (int bj = 0; bj < 2; ++bj) { s0[bj] = *(const f32x4*)(scale + cb + bj * 128); s1[bj] = *(const f32x4*)(scale + cb + bj * 128 + 4); }
        EPI_ROWS_BEGIN
            bf16* rowp = Y2 + (size_t)(u.pm * 256 + rl) * 1024 + cb;
#pragma unroll
            for (int bj = 0; bj < 2; ++bj) { const f32x4 v0 = acc[ai][bj][m][0] * s0[bj], v1 = acc[ai][bj][m][1] * s1[bj];
                v4u w; w.x = pk2(v0[0], v0[1]); w.y = pk2(v0[2], v0[3]); w.z = pk2(v1[0], v1[1]); w.w = pk2(v1[2], v1[3]); *(v4u*)(rowp + bj * 128) = w; }
        EPI_ROWS_END
    }
};
template <int MODE> struct EpiMix { static constexpr bool PERM = true; bf16* OUT; int ldo; const bf16* AUX1; int ld1; const bf16* AUX2; int ld2;
    __device__ __forceinline__ void operator()(const AccT& acc, const Unit& u, int wr, int wc, int fr, int fq) const {
        const int cb = u.pn * 256 + wc * 32 + 8 * fq;
        EPI_ROWS_BEGIN
            const size_t row = (size_t)(u.pm * 256 + rl);
#pragma unroll
            for (int bj = 0; bj < 2; ++bj) { const f32x4 v0 = acc[ai][bj][m][0], v1 = acc[ai][bj][m][1];
                const v4u a1 = *(const v4u*)(AUX1 + row * ld1 + cb + bj * 128);
                float x[8] = {bflo(a1.x), bfhi(a1.x), bflo(a1.y), bfhi(a1.y), bflo(a1.z), bfhi(a1.z), bflo(a1.w), bfhi(a1.w)};
                float o[8];
                if (MODE == 0) {
#pragma unroll
                    for (int j = 0; j < 4; ++j) { o[j] = sigmoidf_(x[j]) * v0[j]; o[4 + j] = sigmoidf_(x[4 + j]) * v1[j]; } }
                else if (MODE == 1) {
#pragma unroll
                    for (int j = 0; j < 4; ++j) { o[j] = x[j] * v0[j]; o[4 + j] = x[4 + j] * v1[j]; } }
                else { const v4u a2 = *(const v4u*)(AUX2 + row * ld2 + cb + bj * 128);
                    const float y[8] = {bflo(a2.x), bfhi(a2.x), bflo(a2.y), bfhi(a2.y), bflo(a2.z), bfhi(a2.z), bflo(a2.w), bfhi(a2.w)};
#pragma unroll
                    for (int j = 0; j < 4; ++j) { o[j] = y[j] + sigmoidf_(x[j]) * v0[j]; o[4 + j] = y[4 + j] + sigmoidf_(x[4 + j]) * v1[j]; } }
                v4u w; w.x = pk2(o[0], o[1]); w.y = pk2(o[2], o[3]); w.z = pk2(o[4], o[5]); w.w = pk2(o[6], o[7]);
                *(v4u*)(OUT + row * ldo + cb + bj * 128) = w; }
        EPI_ROWS_END
    }
};
struct EpiX1 { static constexpr bool PERM = false; const float* X; float* OUT; const float* MOD;
    __device__ __forceinline__ void operator()(const AccT& acc, const Unit& u, int wr, int wc, int fr, int fq) const {
        const int b = u.pm >> 4;
        const int cb = u.pn * 256 + wc * 32 + 4 * fq; const float* g = MOD + (size_t)b * 12288 + 4096 + cb;
        f32x4 gv[2][2];
#pragma unroll
        for (int bj = 0; bj < 2; ++bj)
#pragma unroll
            for (int n = 0; n < 2; ++n) gv[bj][n] = *(const f32x4*)(g + bj * 128 + n * 16);
        EPI_ROWS_BEGIN
            const size_t off = (size_t)(u.pm * 256 + rl) * D + cb;
#pragma unroll
            for (int bj = 0; bj < 2; ++bj)
#pragma unroll
                for (int n = 0; n < 2; ++n) { const f32x4 xv = *(const f32x4*)(X + off + bj * 128 + n * 16); *(f32x4*)(OUT + off + bj * 128 + n * 16) = xv + gv[bj][n] * acc[ai][bj][m][n]; }
        EPI_ROWS_END
    }
};
struct EpiAct { static constexpr bool PERM = true; bf16* ACT;
    __device__ __forceinline__ void operator()(const AccT& acc, const Unit& u, int wr, int wc, int fr, int fq) const {
        EPI_ROWS_BEGIN
            const f32x4 g0 = acc[ai][0][m][0], g1 = acc[ai][0][m][1], u0 = acc[ai][1][m][0], u1 = acc[ai][1][m][1];
            float o[8];
#pragma unroll
            for (int j = 0; j < 4; ++j) { o[j] = g0[j] * sigmoidf_(g0[j]) * u0[j]; o[4 + j] = g1[j] * sigmoidf_(g1[j]) * u1[j]; }
            v4u w; w.x = pk2(o[0], o[1]); w.y = pk2(o[2], o[3]); w.z = pk2(o[4], o[5]); w.w = pk2(o[6], o[7]);
            *(v4u*)(ACT + (size_t)(u.pm * 256 + rl) * DEXP + u.pn * 128 + wc * 32 + 8 * fq) = w;
        EPI_ROWS_END
    }
};
struct EpiDown { static constexpr bool PERM = true; bf16* YP; const int* DST; const float* WSL;
    __device__ __forceinline__ void operator()(const AccT& acc, const Unit& u, int wr, int wc, int fr, int fq) const {
        const int cb = u.pn * 256 + wc * 32 + 8 * fq;
        EPI_ROWS_BEGIN
            const int slot = u.pm * 256 + rl; const int dst = DST[slot]; const float wt = WSL[slot];
            if (dst >= 0) {
#pragma unroll
                for (int bj = 0; bj < 2; ++bj) { const f32x4 v0 = acc[ai][bj][m][0] * wt, v1 = acc[ai][bj][m][1] * wt;
                    v4u w; w.x = pk2(v0[0], v0[1]); w.y = pk2(v0[2], v0[3]); w.z = pk2(v1[0], v1[1]); w.w = pk2(v1[2], v1[3]);
                    *(v4u*)(YP + (size_t)dst * D + cb + bj * 128) = w; } }
        EPI_ROWS_END
    }
};
struct Frame {
    LAS unsigned char* lds;
    volatile LAS unsigned* MISC;
    unsigned* ctl;
    int tid, lane, wave, vcu, G;
    unsigned char* ws;
};
struct Args { const float* in[34]; float* out; unsigned char* ws; int ph_lo, ph_hi; };
enum { I_X = 0, I_C, I_CTX, I_CCTX, I_N1G, I_N2G, I_ADAW, I_ADAB, I_WIN, I_MU, I_POOLW, I_POOLS, I_WPO, I_DW0, I_DW2, I_IA0, I_IA2, I_G2, I_KK, I_KA, I_RK, I_LNW, I_LNB,
       I_WRO, I_WO, I_RW, I_RB, I_EG, I_EU, I_ED, I_SG, I_SU, I_SD, I_FG };

__device__ __forceinline__ void transpose_item(const float* W, int ldw, int kvalid, bf16* WT, int ldt, int k0, int n0, int drow0, LAS float* scr, int lane) {
#pragma unroll 8
    for (int i = 0; i < 32; ++i) { const int kk = 2 * i + (lane >> 5); const int k = k0 + kk; scr[kk * 33 + (lane & 31)] = (k < kvalid) ? W[(size_t)k * ldw + n0 + (lane & 31)] : 0.f; }
    LDS_WAIT(); asm volatile("" ::: "memory");
    const int c = lane & 7;
#pragma unroll
    for (int j = 0; j < 4; ++j) { const int n = (lane >> 3) + 8 * j; const LAS float* s = scr + (8 * c) * 33 + n;
        v4u o; o.x = pk2(s[0 * 33], s[1 * 33]); o.y = pk2(s[2 * 33], s[3 * 33]); o.z = pk2(s[4 * 33], s[5 * 33]); o.w = pk2(s[6 * 33], s[7 * 33]);
        *(v4u*)(WT + (size_t)(drow0 + n) * ldt + k0 + 8 * c) = o; }
    LDS_WAIT(); asm volatile("" ::: "memory");
}

__device__ __forceinline__ void p0_prologue(Frame& F, const Args& a) {
    {
        LAS float* sv = (LAS float*)F.lds;
        LAS float* part = (LAS float*)(F.lds + 40960);
        bool did = false;
        for (int cb = blockIdx.x; cb < 192; cb += F.G) {
            if (!did) { for (int idx = F.tid; idx < 5 * D; idx += 512) { const int j = idx >> 11, k = idx & 2047; const float v = (j < 4) ? a.in[I_C][j * D + k] : a.in[I_CCTX][k]; sv[idx] = v / (1.0f + __expf(-v)); } did = true; }
            __syncthreads();
            const int col = 64 * cb + F.lane, k0 = 256 * F.wave; const float* wp = a.in[I_ADAW] + (size_t)k0 * 12288 + col;
            float acc[5] = {0.f, 0.f, 0.f, 0.f, 0.f};
#pragma unroll 8
            for (int k = 0; k < 256; ++k) { const float w = wp[(size_t)k * 12288];
#pragma unroll
                for (int j = 0; j < 5; ++j) acc[j] += sv[j * D + k0 + k] * w; }
#pragma unroll
            for (int j = 0; j < 5; ++j) part[(F.wave * 5 + j) * 64 + F.lane] = acc[j];
            __syncthreads();
            if (F.tid < 320) { const int j = F.tid >> 6, l = F.tid & 63; float s = a.in[I_ADAB][64 * cb + l];
#pragma unroll
                for (int w = 0; w < 8; ++w) s += part[(w * 5 + j) * 64 + l];
                ((float*)(F.ws + WS_MOD))[j * 12288 + 64 * cb + l] = s; }
            __syncthreads();
        }
        __syncthreads();
    }
    LAS float* scr = (LAS float*)(F.lds + F.wave * 16384);
    const int gw = F.vcu * 8 + F.wave, NGW = F.G * 8;
    constexpr int I_1 = 32 * 372;
    constexpr int I_2 = 4 * 4 * 8;
    constexpr int I_3 = 16 * 64;
    constexpr int I_4 = 4 * 64;
    constexpr int I_5 = 32 * 64;
    constexpr int I_6 = 32 * 64;
    constexpr int I_7 = 4 * 2 * 64;
    constexpr int NITEMS = I_1 + I_2 + I_3 + I_4 + I_5 + I_6 + I_7;
    for (int it = gw; it < NITEMS; it += NGW) {
        int r = it;
        if (r < I_1) { const int kb = r / 372, nb = r % 372, n0 = nb * 32; transpose_item(a.in[I_WIN], DIN, D, (bf16*)(F.ws + WS_WIN), D, kb * 64, n0, n0 + (n0 >= 7808 ? 128 : 0), scr, F.lane); continue; } r -= I_1;
        if (r < I_2) { const int g = r / 32, q = r % 32, kb = q / 8, nb = q % 8; transpose_item(a.in[I_POOLW] + (size_t)g * 65536, 256, 256, (bf16*)(F.ws + WS_POOLW) + (size_t)g * 65536, 256, kb * 64, nb * 32, nb * 32, scr, F.lane); continue; } r -= I_2;
        if (r < I_3) { const int kb = r / 64, nb = r % 64; transpose_item(a.in[I_WPO], D, 1024, (bf16*)(F.ws + WS_WPO), 1024, kb * 64, nb * 32, nb * 32, scr, F.lane); continue; } r -= I_3;
        if (r < I_4) { const int kb = r / 64, nb = r % 64; transpose_item(a.in[I_G2], D, 256, (bf16*)(F.ws + WS_G2), 256, kb * 64, nb * 32, nb * 32, scr, F.lane); continue; } r -= I_4;
        if (r < I_5) { const int kb = r / 64, nb = r % 64; transpose_item(a.in[I_WRO], D, D, (bf16*)(F.ws + WS_WRO), D, kb * 64, nb * 32, nb * 32, scr, F.lane); continue; } r -= I_5;
        if (r < I_6) { const int kb = r / 64, nb = r % 64; transpose_item(a.in[I_WO], D, D, (bf16*)(F.ws + WS_WO), D, kb * 64, nb * 32, nb * 32, scr, F.lane); continue; } r -= I_6;
        { const int mtx = r / 128, q = r % 128, kb = q / 64, nb = q % 64;
          const float* src = (mtx < 2 ? a.in[I_DW2] + (size_t)mtx * 96 * D : a.in[I_IA2] + (size_t)(mtx - 2) * 96 * D);
          transpose_item(src, D, 96, (bf16*)(F.ws + WS_LORA) + (size_t)mtx * D * 128, 128, kb * 64, nb * 32, nb * 32, scr, F.lane); }
    }
    const int gt = F.vcu * 512 + F.tid, NGT = F.G * 512;
    { v4u* z = (v4u*)((bf16*)(F.ws + WS_WIN) + (size_t)7808 * D); for (int i = gt; i < 128 * D / 8; i += NGT) z[i] = (v4u){0u, 0u, 0u, 0u}; }
    { int* tok = (int*)(F.ws + WS_TOK); int* dst = (int*)(F.ws + WS_DST); float* wsl = (float*)(F.ws + WS_WSL);
      for (int i = gt; i < NSLOT; i += NGT) { tok[i] = 0; dst[i] = -1; wsl[i] = 0.f; } }
}

__device__ __forceinline__ void p1_norm1(Frame& F, const Args& a) {
    const int gw = F.vcu * 8 + F.wave, NGW = F.G * 8; const float* MOD = (const float*)(F.ws + WS_MOD); bf16* HA = (bf16*)(F.ws + WS_HA);
    for (int mrow = gw; mrow < MT; mrow += NGW) {
        const float* src = (mrow < NT) ? a.in[I_X] + (size_t)mrow * D : a.in[I_CTX] + (size_t)(mrow - NT) * D; const int j = (mrow < NT) ? (mrow >> 12) : 4;
        const f32x4* xr = (const f32x4*)src + F.lane; f32x4 v[8]; float s = 0.f;
#pragma unroll
        for (int q = 0; q < 8; ++q) { v[q] = xr[64 * q]; s += (v[q].x * v[q].x + v[q].y * v[q].y) + (v[q].z * v[q].z + v[q].w * v[q].w); }
        const float rstd = 1.0f / sqrtf(wave_sum(s) * (1.0f / D) + 1e-6f);
        const f32x4* g = (const f32x4*)a.in[I_N1G] + F.lane; const f32x4* sh = (const f32x4*)(MOD + (size_t)j * 12288) + F.lane; const f32x4* sc = (const f32x4*)(MOD + (size_t)j * 12288 + 2048) + F.lane;
        v2u* o = (v2u*)(HA + (size_t)mrow * D) + F.lane;
#pragma unroll
        for (int q = 0; q < 8; ++q) { const f32x4 y = v[q] * rstd * g[64 * q] * (sc[64 * q] + 1.0f) + sh[64 * q]; v2u w; w.x = pk2(y.x, y.y); w.y = pk2(y.z, y.w); o[64 * q] = w; }
    }
}

template <int W> __device__ __forceinline__ void pool_item(const unsigned* U32, unsigned* DP32, int m0, int cp) {
    unsigned raw[64];
#pragma unroll
    for (int x = 0; x < 64; ++x) raw[x] = U32[(size_t)(m0 + x) * 512 + cp];
    float lo[64], hi[64];
#pragma unroll
    for (int x = 0; x < 64; ++x) { lo[x] = bflo(raw[x]); hi[x] = bfhi(raw[x]); }
#pragma unroll
    for (int x = 0; x < 64; ++x) { const int l = (x - W / 2) < 0 ? 0 : (x - W / 2), h = (x + W / 2) > 64 ? 64 : (x + W / 2); float s0 = 0.f, s1 = 0.f;
#pragma unroll
        for (int j = l; j < h; ++j) { s0 += lo[j]; s1 += hi[j]; }
        const float inv = 1.0f / (float)(h - l); DP32[(size_t)(m0 + x) * 512 + cp] = pk2(s0 * inv - lo[x], s1 * inv - hi[x]); }
}
__device__ __forceinline__ void p3_prep(Frame& F, const Args& a) {
    const bf16* SLAB = (const bf16*)(F.ws + WS_SLAB); const float* mu = a.in[I_MU];
    bf16* RM = (bf16*)(F.ws + WS_RM); bf16* KM = (bf16*)(F.ws + WS_KM); bf16* VM = (bf16*)(F.ws + WS_VM); bf16* LIN = (bf16*)(F.ws + WS_LIN);
    const int gw = F.vcu * 8 + F.wave, NGW = F.G * 8;
    for (int mrow = gw; mrow < MT; mrow += NGW) {
        const bool lat = mrow < NT; const bf16* own = SLAB + (size_t)mrow * SLABLD;
        bool v0, v1, v2 = false, v3 = false; const bf16 *p0, *p1, *p2 = own, *p3 = own;
        if (lat) { const int t = mrow & 4095, gy = t >> 6, gx = t & 63; v0 = gx > 0; v1 = gx < 63; v2 = gy > 0; v3 = gy < 63;
            p0 = own - SLABLD; p1 = own + SLABLD; p2 = own - (size_t)64 * SLABLD; p3 = own + (size_t)64 * SLABLD; }
        else { const int s = (mrow - NT) & 255; v0 = s > 0; v1 = s < 255; p0 = own - SLABLD; p1 = own + SLABLD; }
        for (int ci = F.lane; ci < DSH / 8; ci += 64) {
            const int c0 = ci * 8; const v4u z = (v4u){0u, 0u, 0u, 0u};
            const v4u o = *(const v4u*)(own + c0);
            const v4u n0 = v0 ? *(const v4u*)(p0 + c0) : z, n1 = v1 ? *(const v4u*)(p1 + c0) : z;
            v4u nb;
            if (lat) { const v4u n2 = v2 ? *(const v4u*)(p2 + c0) : z, n3 = v3 ? *(const v4u*)(p3 + c0) : z;
                nb.x = (n0.x & 0xffffu) | (n1.x & 0xffff0000u); nb.y = (n2.y & 0xffffu) | (n3.y & 0xffff0000u); nb.z = (n0.z & 0xffffu) | (n1.z & 0xffff0000u); nb.w = (n2.w & 0xffffu) | (n3.w & 0xffff0000u); }
            else { nb.x = (n0.x & 0xffffu) | (n1.x & 0xffff0000u); nb.y = (n0.y & 0xffffu) | (n1.y & 0xffff0000u); nb.z = (n0.z & 0xffffu) | (n1.z & 0xffff0000u); nb.w = (n0.w & 0xffffu) | (n1.w & 0xffff0000u); }
            const f32x4 m0 = *(const f32x4*)(mu + c0), m1 = *(const f32x4*)(mu + c0 + 4);
            float r[8];
            { const float ov[8] = {bflo(o.x), bfhi(o.x), bflo(o.y), bfhi(o.y), bflo(o.z), bfhi(o.z), bflo(o.w), bfhi(o.w)};
              const float nv[8] = {bflo(nb.x), bfhi(nb.x), bflo(nb.y), bfhi(nb.y), bflo(nb.z), bfhi(nb.z), bflo(nb.w), bfhi(nb.w)};
              const float mv[8] = {m0.x, m0.y, m0.z, m0.w, m1.x, m1.y, m1.z, m1.w};
#pragma unroll
              for (int e = 0; e < 8; ++e) r[e] = ov[e] + (nv[e] - ov[e]) * mv[e]; }
            bf16* dstp;
            if (c0 < 2048) dstp = RM + (size_t)mrow * D + c0;
            else if (c0 < 4096) dstp = KM + (size_t)mrow * D + (c0 - 2048);
            else if (c0 < 6144) dstp = VM + (size_t)mrow * D + (c0 - 4096);
            else { const int lc = c0 - 6144; int dc;
                if (lc < 192) {
#pragma unroll
                    for (int e = 0; e < 8; ++e) r[e] = tanhf(r[e]);
                    dc = (lc < 96) ? lc : 128 + (lc - 96); }
                else if (lc < 384) dc = (lc < 288) ? 256 + (lc - 192) : 384 + (lc - 288);
                else {
#pragma unroll
                    for (int e = 0; e < 8; ++e) r[e] = sigmoidf_(r[e]);
                    dc = 512 + (lc - 384); }
                dstp = LIN + (size_t)mrow * LINLD + dc; }
            v4u w; w.x = pk2(r[0], r[1]); w.y = pk2(r[2], r[3]); w.z = pk2(r[4], r[5]); w.w = pk2(r[6], r[7]); *(v4u*)dstp = w;
        }
        if (F.lane < 16) { const int p = F.lane >> 2, off = (F.lane & 3) * 8; *(v4u*)(LIN + (size_t)mrow * LINLD + 128 * p + 96 + off) = (v4u){0u, 0u, 0u, 0u}; }
    }
    const unsigned* U32 = (const unsigned*)(F.ws + WS_U); unsigned* DP32 = (unsigned*)(F.ws + WS_DP);
    for (int gr = F.vcu; gr < 256; gr += F.G) {
        const int m0 = gr * 64, cp = F.tid; const int g = F.wave >> 1;
        if (g == 0) pool_item<2>(U32, DP32, m0, cp); else if (g == 1) pool_item<4>(U32, DP32, m0, cp); else if (g == 2) pool_item<8>(U32, DP32, m0, cp); else pool_item<16>(U32, DP32, m0, cp);
    }
}

constexpr int SC_CH = 32;
constexpr int SC_VEC = SC_CH * 64;
constexpr int SC_BUF = 6 * SC_VEC + 2 * SC_CH;
__device__ __forceinline__ int scan_row(int n, int b, int dir) {
    if (n < CTXL) return NT + b * CTXL + (dir ? (CTXL - 1 - n) : n);
    const int t = n - CTXL; return b * TSEQ + (dir ? (TSEQ - 1 - t) : t);
}
__device__ __forceinline__ void p6_scan(Frame& F, const Args& a) {
    const bf16* RM = (const bf16*)(F.ws + WS_RM); const bf16* KM = (const bf16*)(F.ws + WS_KM); const bf16* VM = (const bf16*)(F.ws + WS_VM);
    LAS float* bufs = (LAS float*)F.lds; LAS float* ybuf = bufs + 2 * SC_BUF;
    const int tau = F.tid >> 4, sub = F.tid & 15;
    const int p = F.tid >> 4, cq = F.tid & 15;
    for (int unit = blockIdx.x; unit < NB * NH * 2; unit += F.G) {
        const int dir = unit & 1, h = (unit >> 1) & 31, b = unit >> 6;
        const unsigned short* EX = (const unsigned short*)(F.ws + WS_EA + (size_t)dir * EA_STRIDE);
        const unsigned short* AX = (const unsigned short*)(F.ws + WS_EA + (size_t)(2 + dir) * EA_STRIDE);
        bf16* YO = (bf16*)(F.ws + (dir ? WS_YB : WS_YF));
        const int ch0 = h * 64 + 4 * sub;
        const f32x4 kkw = *(const f32x4*)(a.in[I_KK] + ch0), kaw = *(const f32x4*)(a.in[I_KA] + ch0);
        f32x4 S0 = (f32x4){0.f, 0.f, 0.f, 0.f}, S1 = S0;
        v2u lr, lk, lv, la, le;
        constexpr int NCHUNK = (CTXL + TSEQ) / SC_CH;
        { const size_t off = (size_t)scan_row(tau, b, dir) * D + ch0; lr = *(const v2u*)(RM + off); lk = *(const v2u*)(KM + off); lv = *(const v2u*)(VM + off); la = *(const v2u*)(AX + off); le = *(const v2u*)(EX + off); }
        for (int ch = 0; ch <= NCHUNK; ++ch) {
            if (ch < NCHUNK) {
                LAS float* B = bufs + (ch & 1) * SC_BUF;
                const f32x4 r = (f32x4){bflo(lr.x), bfhi(lr.x), bflo(lr.y), bfhi(lr.y)}, k = (f32x4){bflo(lk.x), bfhi(lk.x), bflo(lk.y), bfhi(lk.y)};
                const f32x4 v = (f32x4){bflo(lv.x), bfhi(lv.x), bflo(lv.y), bfhi(lv.y)}, ai = (f32x4){hlo(la.x), hhi(la.x), hlo(la.y), hhi(la.y)};
                const f32x4 e = (f32x4){hlo(le.x), hhi(le.x), hlo(le.y), hhi(le.y)};
                f32x4 kk = k * kkw; float ss = (kk.x * kk.x + kk.y * kk.y) + (kk.z * kk.z + kk.w * kk.w); ss = allred16(ss);
                kk = kk * (1.0f / sqrtf(ss + 1e-12f));
                f32x4 w; w.x = __builtin_amdgcn_exp2f(e.x); w.y = __builtin_amdgcn_exp2f(e.y); w.z = __builtin_amdgcn_exp2f(e.z); w.w = __builtin_amdgcn_exp2f(e.w);
                const f32x4 kd = k * ((ai - 1.0f) * kaw + 1.0f), bb = kk * ai, wrv = w * r;
                float br = (bb.x * r.x + bb.y * r.y) + (bb.z * r.z + bb.w * r.w), kr = (kd.x * r.x + kd.y * r.y) + (kd.z * r.z + kd.w * r.w);
                br = allred16(br); kr = allred16(kr);
                const int o = tau * 64 + 4 * sub;
                *(LAS f32x4*)(B + 0 * SC_VEC + o) = kk; *(LAS f32x4*)(B + 1 * SC_VEC + o) = wrv; *(LAS f32x4*)(B + 2 * SC_VEC + o) = w;
                *(LAS f32x4*)(B + 3 * SC_VEC + o) = bb; *(LAS f32x4*)(B + 4 * SC_VEC + o) = kd; *(LAS f32x4*)(B + 5 * SC_VEC + o) = v;
                if (sub == 0) *(LAS f32x2*)(B + 6 * SC_VEC + 2 * tau) = (f32x2){br, kr};
            }
            if (ch >= 1 && (ch - 1) * SC_CH >= CTXL) {
                const f32x4 y = *(const LAS f32x4*)(ybuf + tau * 64 + 4 * sub); v2u wv; wv.x = pk2(y.x, y.y); wv.y = pk2(y.z, y.w);
                *(v2u*)(YO + (size_t)scan_row((ch - 1) * SC_CH + tau, b, dir) * D + ch0) = wv;
            }
            __syncthreads();
            if (ch == NCHUNK) break;
            if (ch + 1 < NCHUNK) { const size_t off = (size_t)scan_row((ch + 1) * SC_CH + tau, b, dir) * D + ch0;
                lr = *(const v2u*)(RM + off); lk = *(const v2u*)(KM + off); lv = *(const v2u*)(VM + off); la = *(const v2u*)(AX + off); le = *(const v2u*)(EX + off); }
            const LAS float* B = bufs + (ch & 1) * SC_BUF; const bool emit = ch * SC_CH >= CTXL;
#pragma unroll 4
            for (int s = 0; s < SC_CH; ++s) {
                const f32x4 kk = *(const LAS f32x4*)(B + 0 * SC_VEC + s * 64 + 4 * cq), wr = *(const LAS f32x4*)(B + 1 * SC_VEC + s * 64 + 4 * cq), w = *(const LAS f32x4*)(B + 2 * SC_VEC + s * 64 + 4 * cq);
                const f32x4 bb = *(const LAS f32x4*)(B + 3 * SC_VEC + s * 64 + 4 * cq), kd = *(const LAS f32x4*)(B + 4 * SC_VEC + s * 64 + 4 * cq);
                const f32x2 vv = *(const LAS f32x2*)(B + 5 * SC_VEC + s * 64 + 2 * p), sc = *(const LAS f32x2*)(B + 6 * SC_VEC + 2 * s);
                float sa0 = (S0.x * kk.x + S0.y * kk.y) + (S0.z * kk.z + S0.w * kk.w), sa1 = (S1.x * kk.x + S1.y * kk.y) + (S1.z * kk.z + S1.w * kk.w);
                float q0 = (S0.x * wr.x + S0.y * wr.y) + (S0.z * wr.z + S0.w * wr.w), q1 = (S1.x * wr.x + S1.y * wr.y) + (S1.z * wr.z + S1.w * wr.w);
                sa0 = allred16(sa0); sa1 = allred16(sa1); q0 = allred16(q0); q1 = allred16(q1);
                S0 = S0 * w - bb * sa0 + kd * vv.x; S1 = S1 * w - bb * sa1 + kd * vv.y;
                if (emit && cq == 0) *(LAS f32x2*)(ybuf + s * 64 + 2 * p) = (f32x2){q0 - sa0 * sc.x + vv.x * sc.y, q1 - sa1 * sc.x + vv.y * sc.y};
            }
            __syncthreads();
        }
        __syncthreads();
    }
}

__device__ __forceinline__ void p7_readout(Frame& F, const Args& a) {
    const bf16* RM = (const bf16*)(F.ws + WS_RM); const bf16* KM = (const bf16*)(F.ws + WS_KM); const bf16* VM = (const bf16*)(F.ws + WS_VM);
    const unsigned short* AF = (const unsigned short*)(F.ws + WS_EA + 2 * EA_STRIDE); const unsigned short* AB = (const unsigned short*)(F.ws + WS_EA + 3 * EA_STRIDE);
    const bf16* YF = (const bf16*)(F.ws + WS_YF); const bf16* YB = (const bf16*)(F.ws + WS_YB); bf16* Z = (bf16*)(F.ws + WS_Z);
    const int sub = F.tid & 15; const int ngrp = F.G * 32;
    for (int gid = F.vcu * 32 + (F.tid >> 4); gid < NT * NH; gid += ngrp) {
        const int mrow = gid >> 5, h = gid & 31, c = h * 64 + 4 * sub; const size_t off = (size_t)mrow * D + c;
        const v2u yf = *(const v2u*)(YF + off), yb = *(const v2u*)(YB + off), lr = *(const v2u*)(RM + off), lk = *(const v2u*)(KM + off), lv = *(const v2u*)(VM + off), laf = *(const v2u*)(AF + off), lab = *(const v2u*)(AB + off);
        const f32x4 y = (f32x4){bflo(yf.x) + bflo(yb.x), bfhi(yf.x) + bfhi(yb.x), bflo(yf.y) + bflo(yb.y), bfhi(yf.y) + bfhi(yb.y)};
        const float mean = allred16((y.x + y.y) + (y.z + y.w)) * (1.0f / 64.0f); const f32x4 d = y - mean;
        const float var = allred16((d.x * d.x + d.y * d.y) + (d.z * d.z + d.w * d.w)) * (1.0f / 64.0f);
        const f32x4 yn = d * (1.0f / sqrtf(var + 64e-5f)) * *(const f32x4*)(a.in[I_LNW] + c) + *(const f32x4*)(a.in[I_LNB] + c);
        const f32x4 r = (f32x4){bflo(lr.x), bfhi(lr.x), bflo(lr.y), bfhi(lr.y)}, k = (f32x4){bflo(lk.x), bfhi(lk.x), bflo(lk.y), bfhi(lk.y)}, v = (f32x4){bflo(lv.x), bfhi(lv.x), bflo(lv.y), bfhi(lv.y)};
        const f32x4 asum = (f32x4){hlo(laf.x) + hlo(lab.x), hhi(laf.x) + hhi(lab.x), hlo(laf.y) + hlo(lab.y), hhi(laf.y) + hhi(lab.y)};
        const f32x4 ks = k * ((asum - 2.0f) * *(const f32x4*)(a.in[I_KA] + c) + 2.0f);
        const f32x4 t = r * ks * *(const f32x4*)(a.in[I_RK] + c);
        const float bon = allred16((t.x + t.y) + (t.z + t.w));
        const f32x4 z = yn + v * bon; v2u wv; wv.x = pk2(z.x, z.y); wv.y = pk2(z.z, z.w); *(v2u*)(Z + off) = wv;
    }
}
constexpr int RT_LD = 68;
__device__ __forceinline__ void p11_route(Frame& F, const Args& a) {
    {
        LAS float* scr = (LAS float*)(F.lds + F.wave * 16384);
        const int gw = F.vcu * 8 + F.wave, NGW = F.G * 8;
        for (int it = gw; it < 65 * 1536; it += NGW) {
            const int e = it / 1536, q = it % 1536, which = q / 512, r = q % 512;
            if (which < 2) { const float* src = (e < 64) ? (which == 0 ? a.in[I_EG] : a.in[I_EU]) + (size_t)e * D * DEXP : (which == 0 ? a.in[I_SG] : a.in[I_SU]);
                const int kb = r / 16, nb = r % 16, n0 = nb * 32; const int drow = (n0 >> 7) * 256 + which * 128 + (n0 & 127);
                transpose_item(src, DEXP, D, (bf16*)(F.ws + WS_GU) + (size_t)e * 1024 * D, D, kb * 64, n0, drow, scr, F.lane); }
            else { const float* src = (e < 64) ? a.in[I_ED] + (size_t)e * DEXP * D : a.in[I_SD];
                const int kb = r / 64, nb = r % 64; transpose_item(src, D, DEXP, (bf16*)(F.ws + WS_DT) + (size_t)e * D * DEXP, DEXP, kb * 64, nb * 32, nb * 32, scr, F.lane); }
        }
        __syncthreads();
    }
    const float* X1 = a.out; const float* MOD = (const float*)(F.ws + WS_MOD); bf16* H2 = (bf16*)(F.ws + WS_H2);
    LAS float* hs = (LAS float*)F.lds;
    LAS float* wsb = hs + 64 * RT_LD;
    LAS float* lg = wsb + 64 * RT_LD;
    LAS float* lg2 = lg + 64 * 65;
    LAS float* selb = lg2 + 64 * 65;
    LAS float* rs = selb + 64 * 65;
    LAS int* cnt = (LAS int*)(rs + 64);
    LAS int* basee = cnt + 64;
    LAS int* eloc = basee + 64;
    LAS int* rloc = eloc + 512;
    for (int tile = F.vcu; tile < NT / 64; tile += F.G) {
        const int t0 = tile * 64, b = t0 >> 12;
        const float* sh2 = MOD + (size_t)b * 12288 + 6144; const float* sc2 = MOD + (size_t)b * 12288 + 8192; const float* g2 = a.in[I_N2G];
        if (F.tid < 64) cnt[F.tid] = 0;
        for (int rr = 0; rr < 8; ++rr) { const int tl = F.wave * 8 + rr; const f32x4* xr = (const f32x4*)(X1 + (size_t)(t0 + tl) * D) + F.lane; f32x4 v[8]; float s = 0.f;
#pragma unroll
            for (int q = 0; q < 8; ++q) { v[q] = xr[64 * q]; s += (v[q].x * v[q].x + v[q].y * v[q].y) + (v[q].z * v[q].z + v[q].w * v[q].w); }
            const float rstd = 1.0f / sqrtf(wave_sum(s) * (1.0f / D) + 1e-6f); if (F.lane == 0) rs[tl] = rstd;
            v2u* o = (v2u*)(H2 + (size_t)(t0 + tl) * D) + F.lane;
#pragma unroll
            for (int q = 0; q < 8; ++q) { const f32x4 y = v[q] * rstd * ((const f32x4*)g2)[F.lane + 64 * q] * (((const f32x4*)sc2)[F.lane + 64 * q] + 1.0f) + ((const f32x4*)sh2)[F.lane + 64 * q];
                v2u w; w.x = pk2(y.x, y.y); w.y = pk2(y.z, y.w); o[64 * q] = w; } }
        __syncthreads();
        const int tg = F.tid & 15, eg = (F.tid >> 4) & 15, kh = F.tid >> 8;
        float acc[4][4];
#pragma unroll
        for (int i = 0; i < 4; ++i)
#pragma unroll
            for (int j = 0; j < 4; ++j) acc[i][j] = 0.f;
        const int stok = F.tid >> 3, sk8 = (F.tid & 7) * 8; const float rstd_s = rs[stok];
        for (int kc = 0; kc < D / 64; ++kc) {
            { const int k0 = kc * 64 + sk8; const float* xp = X1 + (size_t)(t0 + stok) * D + k0;
              const f32x4 x0 = *(const f32x4*)xp, x1v = *(const f32x4*)(xp + 4);
              const f32x4 ga = *(const f32x4*)(g2 + k0), gb = *(const f32x4*)(g2 + k0 + 4), ca = *(const f32x4*)(sc2 + k0), cb = *(const f32x4*)(sc2 + k0 + 4), ha = *(const f32x4*)(sh2 + k0), hb = *(const f32x4*)(sh2 + k0 + 4);
              const f32x4 y0 = x0 * rstd_s * ga * (ca + 1.0f) + ha, y1 = x1v * rstd_s * gb * (cb + 1.0f) + hb;
              hs[(sk8 + 0) * RT_LD + stok] = y0.x; hs[(sk8 + 1) * RT_LD + stok] = y0.y; hs[(sk8 + 2) * RT_LD + stok] = y0.z; hs[(sk8 + 3) * RT_LD + stok] = y0.w;
              hs[(sk8 + 4) * RT_LD + stok] = y1.x; hs[(sk8 + 5) * RT_LD + stok] = y1.y; hs[(sk8 + 6) * RT_LD + stok] = y1.z; hs[(sk8 + 7) * RT_LD + stok] = y1.w;
              const float* wp = a.in[I_RW] + (size_t)kc * 4096 + F.tid * 8; const f32x4 w0 = *(const f32x4*)wp, w1 = *(const f32x4*)(wp + 4);
              const int wk = F.tid >> 3, we = (F.tid & 7) * 8; *(LAS f32x4*)(wsb + wk * RT_LD + we) = w0; *(LAS f32x4*)(wsb + wk * RT_LD + we + 4) = w1; }
            __syncthreads();
#pragma unroll 8
            for (int k = kh * 32; k < kh * 32 + 32; ++k) { const f32x4 h4 = *(const LAS f32x4*)(hs + k * RT_LD + 4 * tg), w4 = *(const LAS f32x4*)(wsb + k * RT_LD + 4 * eg);
                acc[0][0] += h4.x * w4.x; acc[0][1] += h4.x * w4.y; acc[0][2] += h4.x * w4.z; acc[0][3] += h4.x * w4.w;
                acc[1][0] += h4.y * w4.x; acc[1][1] += h4.y * w4.y; acc[1][2] += h4.y * w4.z; acc[1][3] += h4.y * w4.w;
                acc[2][0] += h4.z * w4.x; acc[2][1] += h4.z * w4.y; acc[2][2] += h4.z * w4.z; acc[2][3] += h4.z * w4.w;
                acc[3][0] += h4.w * w4.x; acc[3][1] += h4.w * w4.y; acc[3][2] += h4.w * w4.z; acc[3][3] += h4.w * w4.w; }
            __syncthreads();
        }
        { LAS float* dstl = kh ? lg2 : lg;
#pragma unroll
          for (int i = 0; i < 4; ++i)
#pragma unroll
              for (int j = 0; j < 4; ++j) dstl[(4 * tg + i) * 65 + 4 * eg + j] = acc[i][j]; }
        __syncthreads();
        for (int idx = F.tid; idx < 4096; idx += 512) { const int tl = idx >> 6, e = idx & 63; const float sc = sigmoidf_(lg[tl * 65 + e] + lg2[tl * 65 + e]); lg[tl * 65 + e] = sc; selb[tl * 65 + e] = sc + a.in[I_RB][e]; }
        __syncthreads();
        if (F.tid < 64) {
            const int tl = F.tid; LAS float* sel = selb + tl * 65; const LAS float* scr = lg + tl * 65;
            float gs[8];
#pragma unroll
            for (int g = 0; g < 8; ++g) { float m1 = -INFINITY, m2 = -INFINITY;
#pragma unroll
                for (int j = 0; j < 8; ++j) { const float v = sel[g * 8 + j]; if (v > m1) { m2 = m1; m1 = v; } else if (v > m2) m2 = v; }
                gs[g] = m1 + m2; }
            unsigned gmask = 0u;
#pragma unroll
            for (int it = 0; it < 4; ++it) { float best = -INFINITY; int bi = 0;
#pragma unroll
                for (int g = 0; g < 8; ++g) { const bool ok = !((gmask >> g) & 1u) && gs[g] > best; best = ok ? gs[g] : best; bi = ok ? g : bi; }
                gmask |= 1u << bi; }
            for (int g = 0; g < 8; ++g) if (!((gmask >> g) & 1u)) { for (int j = 0; j < 8; ++j) sel[g * 8 + j] = -INFINITY; }
            float wv[8]; int ev[8]; float wsum = 0.f;
#pragma unroll
            for (int it = 0; it < 8; ++it) { float best = -INFINITY; int bi = 0;
                for (int e = 0; e < 64; ++e) { const float v = sel[e]; if (v > best) { best = v; bi = e; } }
                sel[bi] = -INFINITY; ev[it] = bi; wv[it] = scr[bi]; wsum += wv[it]; }
            const float inv = 2.5f / wsum;
#pragma unroll
            for (int it = 0; it < 8; ++it) { const int lr = atomicAdd((int*)&cnt[ev[it]], 1); eloc[tl * 8 + it] = ev[it]; rloc[tl * 8 + it] = lr;
                ((float*)(F.ws + WS_WSEL))[(size_t)(t0 + tl) * 8 + it] = wv[it] * inv; }
        }
        __syncthreads();
        if (F.tid < 64) basee[F.tid] = (int)__hip_atomic_fetch_add(F.ctl + CW_GCNT + F.tid, (unsigned)cnt[F.tid], __ATOMIC_RELAXED, __HIP_MEMORY_SCOPE_AGENT);
        __syncthreads();
        { const int e = eloc[F.tid]; ((int*)(F.ws + WS_EIDX))[(size_t)t0 * 8 + F.tid] = e; ((int*)(F.ws + WS_RANK))[(size_t)t0 * 8 + F.tid] = basee[e] + rloc[F.tid]; }
        __syncthreads();
    }
}
__device__ __forceinline__ int moe_tables(Frame& F) {
    LAS int* te = (LAS int*)(F.lds + TAB_OFF); LAS int* off = te + MAXTILES;
    if (F.tid == 0) { int o = 0; for (int e = 0; e < 64; ++e) { off[e] = o; const int c = (int)__hip_atomic_load(F.ctl + CW_GCNT + e, __ATOMIC_RELAXED, __HIP_MEMORY_SCOPE_AGENT); o += (c + 255) & ~255; } off[64] = o; off[65] = o / 256 + NT / 256; }
    __syncthreads();
    const int ntiles = off[65];
    for (int rt = F.tid; rt < ntiles; rt += 512) { int e = 0; for (int j = 1; j <= 64; ++j) if (rt * 256 >= off[j]) e = j; te[rt] = e; }
    __syncthreads();
    return ntiles;
}
__device__ __forceinline__ void p12_slots(Frame& F) {
    (void)moe_tables(F);
    const LAS int* off = (const LAS int*)(F.lds + TAB_OFF) + MAXTILES;
    int* tok = (int*)(F.ws + WS_TOK); int* dst = (int*)(F.ws + WS_DST); float* wsl = (float*)(F.ws + WS_WSL);
    const int* eidx = (const int*)(F.ws + WS_EIDX); const int* rank = (const int*)(F.ws + WS_RANK); const float* wsel = (const float*)(F.ws + WS_WSEL);
    const int gt = F.vcu * 512 + F.tid, NGT = F.G * 512;
    for (int i = gt; i < NT * 8; i += NGT) { const int t = i >> 3, k = i & 7; const int slot = off[eidx[i]] + rank[i]; tok[slot] = t; dst[slot] = t * 9 + k; wsl[slot] = wsel[i]; }
    const int o64 = off[64];
    for (int t = gt; t < NT; t += NGT) { const int slot = o64 + t; tok[slot] = t; dst[slot] = t * 9 + 8; wsl[slot] = 1.0f; }
}
__device__ __forceinline__ void p15_final(Frame& F, const Args& a) {
    const int gw = F.vcu * 8 + F.wave, NGW = F.G * 8; const float* MOD = (const float*)(F.ws + WS_MOD); const bf16* YP = (const bf16*)(F.ws + WS_YP);
    for (int t = gw; t < NT; t += NGW) {
        const int b = t >> 12; const f32x4* gt2 = (const f32x4*)(MOD + (size_t)b * 12288 + 10240) + F.lane; const f32x4* fg = (const f32x4*)a.in[I_FG] + F.lane;
        f32x4* xr = (f32x4*)(a.out + (size_t)t * D) + F.lane; f32x4 v[8]; float s = 0.f;
#pragma unroll
        for (int q = 0; q < 8; ++q) { f32x4 m = (f32x4){0.f, 0.f, 0.f, 0.f};
#pragma unroll
            for (int j = 0; j < 9; ++j) { const v2u y = *((const v2u*)(YP + (size_t)(t * 9 + j) * D) + F.lane + 64 * q); m += (f32x4){bflo(y.x), bfhi(y.x), bflo(y.y), bfhi(y.y)}; }
            v[q] = xr[64 * q] + gt2[64 * q] * m; s += (v[q].x * v[q].x + v[q].y * v[q].y) + (v[q].z * v[q].z + v[q].w * v[q].w); }
        const float rstd = 1.0f / sqrtf(wave_sum(s) * (1.0f / D) + 1e-6f);
#pragma unroll
        for (int q = 0; q < 8; ++q) xr[64 * q] = v[q] * rstd * fg[64 * q];
    }
}
#ifndef MK_ONE_LAUNCH
#define MK_ONE_LAUNCH 1
#endif
constexpr int NPHASE = 16;
__global__ void __launch_bounds__(512, 2) mk_fwd(Args args) {
    extern __shared__ __attribute__((aligned(16))) unsigned char lds[];
    Frame F;
    F.lds = (LAS unsigned char*)lds; F.MISC = (volatile LAS unsigned*)(F.lds + LDSCTL_OFF);
    int wave0 = __builtin_amdgcn_readfirstlane((int)threadIdx.x >> 6); asm volatile("" : "+s"(wave0));
    F.tid = threadIdx.x; F.lane = F.tid & 63; F.wave = wave0;
    F.G = gridDim.x; { const int bx = blockIdx.x; F.vcu = (F.G % 8 == 0) ? (bx % 8) * (F.G / 8) + bx / 8 : bx; }
    F.ws = args.ws; F.ctl = (unsigned*)(args.ws + WS_CTL);
    for (int u = F.tid; u < 256; u += 512) ((LAS unsigned*)(F.lds + LDSCTL_OFF))[u] = 0u;
    __syncthreads();
    XcdBarrier bar; bar.bar = F.ctl + CW_BAR; bar.x = 0; bar.st = nullptr;
    if (MK_ONE_LAUNCH) bar = xcd_barrier_post(F.ctl + CW_BAR, F.MISC + 8);
    const int lo = args.ph_lo, hi = args.ph_hi;
#ifndef PHMASK
#define PHMASK 0xFFFF
#endif
#define IN(k) (((PHMASK >> (k)) & 1) && lo <= (k) && (k) < hi)
#define FRESH() do { int l_ = (int)__builtin_amdgcn_mbcnt_hi(~0u, __builtin_amdgcn_mbcnt_lo(~0u, 0u)); asm volatile("" : "+v"(l_)); int w_ = wave0; asm volatile("" : "+s"(w_)); F.lane = l_; F.wave = w_; F.tid = w_ * 64 + l_; } while (0)
#define SEAM(k) do { if (MK_ONE_LAUNCH) { if (IN(k) && IN((k) + 1)) xcd_barrier(bar); } } while (0)
    const int G = F.G, c = (int)blockIdx.x;
    unsigned char* ws = args.ws;

    if (IN(0)) { FRESH(); p0_prologue(F, args); } SEAM(0);
    if (IN(1)) { FRESH(); p1_norm1(F, args); } SEAM(1);
    if (IN(2)) { FRESH();
        G1Order S{(const char*)(ws + WS_HA), (const char*)(ws + WS_WIN), (size_t)256 * D * 2, (size_t)256 * D * 2, G, c};
        EpiG1 E{(bf16*)(ws + WS_U), (bf16*)(ws + WS_SLAB), (bf16*)(ws + WS_GATES)};
        pg8::gemm_phase<EpiG1, G1Order, false>(F.lds + RING_OFF, F.wave, D, D, D, S, E);
    } SEAM(2);
    if (IN(3)) { FRESH(); p3_prep(F, args); } SEAM(3);
    if (IN(4)) { FRESH();
#ifndef NO4A
        {
            RepOrder S{(const char*)(ws + WS_LIN), (const char*)(ws + WS_LORA), (size_t)128 * 2, (size_t)D * 128 * 2, (size_t)256 * LINLD * 2, (size_t)256 * 128 * 2, MT / 256, D / 256, 4, G, c};
            EpiLora E{(unsigned short*)(ws + WS_EA), args.in[I_DW0], args.in[I_IA0]};
            pg8::gemm_phase<EpiLora, RepOrder, false>(F.lds + RING_OFF, F.wave, 128, LINLD, 128, S, E);
        }
#endif
    }
    if (IN(4)) { FRESH();
#ifndef NO4B
        {
            RepOrder S{(const char*)(ws + WS_DP), (const char*)(ws + WS_POOLW), (size_t)256 * 2, (size_t)256 * 256 * 2, (size_t)256 * 1024 * 2, (size_t)256 * 256 * 2, NT / 256, 1, 4, G, c};
            EpiPoolG E{(bf16*)(ws + WS_Y2), args.in[I_POOLS]};
            pg8::gemm_phase<EpiPoolG, RepOrder, false>(F.lds + RING_OFF, F.wave, 256, 1024, 256, S, E);
        }
#endif
    } SEAM(4);
    if (IN(5)) { FRESH();
        RepOrder S{(const char*)(ws + WS_Y2), (const char*)(ws + WS_WPO), 0, 0, (size_t)256 * 1024 * 2, (size_t)256 * 1024 * 2, NT / 256, D / 256, 1, G, c};
        EpiMix<0> E{(bf16*)(ws + WS_MP), D, (const bf16*)(ws + WS_GATES), 4096, nullptr, 0};
        pg8::gemm_phase<EpiMix<0>, RepOrder, false>(F.lds + RING_OFF, F.wave, 1024, 1024, 1024, S, E);
    } SEAM(5);
    if (IN(6)) { FRESH(); p6_scan(F, args); } SEAM(6);
    if (IN(7)) { FRESH(); p7_readout(F, args); } SEAM(7);
    if (IN(8)) { FRESH();
        RepOrder S{(const char*)(ws + WS_LIN) + 512 * 2, (const char*)(ws + WS_G2), 0, 0, (size_t)256 * LINLD * 2, (size_t)256 * 256 * 2, NT / 256, D / 256, 1, G, c};
        EpiMix<1> E{(bf16*)(ws + WS_OR), D, (const bf16*)(ws + WS_Z), D, nullptr, 0};
        pg8::gemm_phase<EpiMix<1>, RepOrder, false>(F.lds + RING_OFF, F.wave, 256, LINLD, 256, S, E);
    } SEAM(8);
    if (IN(9)) { FRESH();
        RepOrder S{(const char*)(ws + WS_OR), (const char*)(ws + WS_WRO), 0, 0, (size_t)256 * D * 2, (size_t)256 * D * 2, NT / 256, D / 256, 1, G, c};
        EpiMix<2> E{(bf16*)(ws + WS_MP), D, (const bf16*)(ws + WS_GATES) + 2048, 4096, (const bf16*)(ws + WS_MP), D};
        pg8::gemm_phase<EpiMix<2>, RepOrder, false>(F.lds + RING_OFF, F.wave, D, D, D, S, E);
    } SEAM(9);
    if (IN(10)) { FRESH();
        RepOrder S{(const char*)(ws + WS_MP), (const char*)(ws + WS_WO), 0, 0, (size_t)256 * D * 2, (size_t)256 * D * 2, NT / 256, D / 256, 1, G, c};
        EpiX1 E{args.in[I_X], args.out, (const float*)(ws + WS_MOD)};
        pg8::gemm_phase<EpiX1, RepOrder, false>(F.lds + RING_OFF, F.wave, D, D, D, S, E);
    } SEAM(10);
    if (IN(11)) { FRESH(); p11_route(F, args); } SEAM(11);
    if (IN(12)) { FRESH(); p12_slots(F); } SEAM(12);
    if (IN(13)) { FRESH();
        const int ntiles = moe_tables(F);
        MoeOrder S{(const char*)(ws + WS_H2), (const char*)(ws + WS_GU), (const LAS int*)(F.lds + TAB_OFF), (const int*)(ws + WS_TOK), 0, (size_t)1024 * D * 2, (size_t)256 * D * 2, ntiles, 4, G, c};
        EpiAct E{(bf16*)(ws + WS_ACT)};
        pg8::gemm_phase<EpiAct, MoeOrder, true>(F.lds + RING_OFF, F.wave, D, D, D, S, E);
    } SEAM(13);
    if (IN(14)) { FRESH();
        const int ntiles = moe_tables(F);
        MoeOrder S{(const char*)(ws + WS_ACT), (const char*)(ws + WS_DT), (const LAS int*)(F.lds + TAB_OFF), (const int*)(ws + WS_TOK), (size_t)256 * DEXP * 2, (size_t)D * DEXP * 2, (size_t)256 * DEXP * 2, ntiles, 8, G, c};
        EpiDown E{(bf16*)(ws + WS_YP), (const int*)(ws + WS_DST), (const float*)(ws + WS_WSL)};
        pg8::gemm_phase<EpiDown, MoeOrder, false>(F.lds + RING_OFF, F.wave, DEXP, DEXP, DEXP, S, E);
    } SEAM(14);
    if (IN(15)) { FRESH(); p15_final(F, args); }
#undef IN
#undef SEAM
}

extern "C" void kernel_launch(void* const* d_in, const int* in_sizes, int n_in, void* d_out, int out_size, void* d_ws, size_t ws_size, hipStream_t stream) {
    static int grid = 0;
    if (grid == 0) {
        if (n_in != 34 || in_sizes[0] != NT * D || out_size != NT * D || ws_size < WS_END) { fprintf(stderr, "kernel_launch: unexpected shapes (n_in %d, in0 %d, out %d, ws %zu < %zu)\n", n_in, n_in > 0 ? in_sizes[0] : -1, out_size, ws_size, (size_t)WS_END); grid = -1; return; }
        int dev = 0, cus = 0, per_cu = 0;
        if (hipGetDevice(&dev) != hipSuccess || hipDeviceGetAttribute(&cus, hipDeviceAttributeMultiprocessorCount, dev) != hipSuccess) { grid = -1; return; }
        if (hipFuncSetAttribute((const void*)mk_fwd, hipFuncAttributeMaxDynamicSharedMemorySize, LDS_BYTES) != hipSuccess) { fprintf(stderr, "kernel_launch: hipFuncSetAttribute failed\n"); grid = -1; return; }
        if (hipOccupancyMaxActiveBlocksPerMultiprocessor(&per_cu, (const void*)mk_fwd, 512, LDS_BYTES) != hipSuccess || per_cu < 1) fprintf(stderr, "kernel_launch: occupancy query reports %d\n", per_cu);
        (void)hipGetLastError();
        grid = cus;
    }
    if (grid < 0) return;
    if (hipMemsetAsync((char*)d_ws + WS_CTL, 0, CTL_ZERO_BYTES, stream) != hipSuccess) return;
    Args a{};
    for (int i = 0; i < 34; ++i) a.in[i] = (const float*)d_in[i];
    a.out = (float*)d_out; a.ws = (unsigned char*)d_ws;
#if MK_ONE_LAUNCH
    a.ph_lo = 0; a.ph_hi = NPHASE;
    hipLaunchKernelGGL(mk_fwd, dim3(grid), dim3(512), LDS_BYTES, stream, a);
#else
    for (int p = 0; p < NPHASE; ++p) { a.ph_lo = p; a.ph_hi = p + 1; hipLaunchKernelGGL(mk_fwd, dim3(grid), dim3(512), LDS_BYTES, stream, a); }
#endif
}
```

```cpp
#include <hip/hip_runtime.h>
#include <cstdio>
#include <cstdint>
#ifndef DUPMASK
#define DUPMASK 0x0
#endif

#define GAS __attribute__((address_space(1)))
#define LAS __attribute__((address_space(3)))
typedef unsigned short bf16;
typedef unsigned v4u __attribute__((ext_vector_type(4)));
typedef unsigned v2u __attribute__((ext_vector_type(2)));
typedef float f32x4 __attribute__((ext_vector_type(4)));
typedef float f32x2 __attribute__((ext_vector_type(2)));
typedef short bf16x8 __attribute__((ext_vector_type(8)));

constexpr int D = 2048, NB = 4, TSEQ = 4096, NT = NB * TSEQ  , CTXL = 256, NC = NB * CTXL  , MT = NT + NC  ;
constexpr int DIN = 11904, DSH = 6784, NPAD = 12032, SLABLD = 6912, NH = 32, HS = 64;
constexpr int NEXP = 64, DEXP = 512, TOPK = 8;
constexpr int NSLOT = NT * TOPK + NEXP * 256 + NT;
constexpr int MAXTILES = NSLOT / 256;
constexpr int LINLD = 768;

__device__ __forceinline__ int opaque_n(int n) { asm volatile("" : "+s"(n)); return n; }
__device__ __forceinline__ unsigned f2bf(float f) { unsigned u = __builtin_bit_cast(unsigned, f); return (u + 0x7fffu + ((u >> 16) & 1u)) >> 16; }
typedef __bf16 bf16x2_t __attribute__((ext_vector_type(2)));
__device__ __forceinline__ unsigned pk2(float lo, float hi) { const f32x2 v = {lo, hi}; const bf16x2_t b = __builtin_convertvector(v, bf16x2_t); return __builtin_bit_cast(unsigned, b); }
__device__ __forceinline__ float bflo(unsigned w) { return __builtin_bit_cast(float, w << 16); }
__device__ __forceinline__ float bfhi(unsigned w) { return __builtin_bit_cast(float, w & 0xffff0000u); }
__device__ __forceinline__ unsigned pkh2(float lo, float hi) { const unsigned short a = __builtin_bit_cast(unsigned short, (_Float16)lo), b = __builtin_bit_cast(unsigned short, (_Float16)hi); return (unsigned)a | ((unsigned)b << 16); }
__device__ __forceinline__ float hlo(unsigned w) { return (float)__builtin_bit_cast(_Float16, (unsigned short)(w & 0xffffu)); }
__device__ __forceinline__ float hhi(unsigned w) { return (float)__builtin_bit_cast(_Float16, (unsigned short)(w >> 16)); }
__device__ __forceinline__ float sigmoidf_(float x) { return 1.0f / (1.0f + __expf(-x)); }
__device__ __forceinline__ float wave_sum(float v) {
#pragma unroll
    for (int o = 1; o < 64; o <<= 1) v += __shfl_xor(v, o);
    return v;
}
__device__ __forceinline__ float dpp_f(float v, const int ctrl_sel) {
    int r;
    const int x = __builtin_bit_cast(int, v);
    if (ctrl_sel == 0) r = __builtin_amdgcn_update_dpp(0, x, 0xB1, 0xF, 0xF, true);
    else if (ctrl_sel == 1) r = __builtin_amdgcn_update_dpp(0, x, 0x4E, 0xF, 0xF, true);
    else if (ctrl_sel == 2) r = __builtin_amdgcn_update_dpp(0, x, 0x141, 0xF, 0xF, true);
    else r = __builtin_amdgcn_update_dpp(0, x, 0x140, 0xF, 0xF, true);
    return __builtin_bit_cast(float, r);
}
__device__ __forceinline__ float allred16(float v) { v += dpp_f(v, 0); v += dpp_f(v, 1); v += dpp_f(v, 2); v += dpp_f(v, 3); return v; }

#define LDS_WAIT() asm volatile("s_waitcnt lgkmcnt(0)" ::: "memory")
#define VM_WAIT() asm volatile("s_waitcnt vmcnt(0)" ::: "memory")

namespace pg8 {
constexpr int BM = 256, BK = 64, HALF = 128, HTB = HALF * BK * 2, STAGE_BYTES = 8 * HTB, NXCD = 8, WGM = 8;
__host__ __device__ __forceinline__ int lds_byte(int r, int c) { const int st = (r >> 4) * 2 + (c >> 5), rr = r & 15, cc = c & 31, ob = rr * 64 + cc * 2; return st * 1024 + (ob ^ (((ob >> 9) & 1) << 5)); }
__host__ __device__ __forceinline__ void stage_rc(int b, int& R, int& C) { const int st = b / 1024, sb = b % 1024, swz = sb ^ (((sb >> 9) & 1) << 5); R = (st >> 1) * 16 + swz / 64; C = (st & 1) * 32 + (swz % 64) / 2; }
__host__ __device__ __forceinline__ int perm32(int rho) { const int n = rho >> 4, i = rho & 15; return 8 * (i >> 2) + 4 * n + (i & 3); }
struct Unit { const char* A; const char* B; int pm, pn, aux; };
__device__ __forceinline__ int xcd_remap(int L, int nwg) { const int q = nwg / NXCD, r = nwg % NXCD, xcd = L % NXCD, off = L / NXCD; return (xcd < r ? xcd * (q + 1) : r * (q + 1) + (xcd - r) * q) + off; }
__device__ __forceinline__ void grid_tile(int wgid, int nM, int nN, int& pm, int& pn) { const int nig = WGM * nN, gid = wgid / nig, fm = gid * WGM, gsz = (nM - fm) < WGM ? (nM - fm) : WGM; pm = fm + ((wgid % nig) % gsz); pn = (wgid % nig) / gsz; }

__device__ __forceinline__ void stage2(LAS unsigned char* lds, int bufoff, unsigned ldsw, const char* g, unsigned o0, unsigned o1) {
    __builtin_amdgcn_global_load_lds((const unsigned*)(g + o0), (LAS unsigned*)(lds + bufoff + ldsw), 16, 0, 0);
    __builtin_amdgcn_global_load_lds((const unsigned*)(g + o1), (LAS unsigned*)(lds + bufoff + ldsw + 8192), 16, 0, 0);
}

template <class Epi, class Sched, bool GATHER>
__device__ __forceinline__ void gemm_phase(LAS unsigned char* lds, const int wave_, const int K, const int lda, const int ldb, const Sched& S, const Epi& E) {
    int tid_ = wave_ * 64 + (int)__builtin_amdgcn_mbcnt_hi(~0u, __builtin_amdgcn_mbcnt_lo(~0u, 0u)); asm volatile("" : "+v"(tid_));
    const int tid = tid_, wid = __builtin_amdgcn_readfirstlane(tid >> 6), lane = tid & 63, wr = wid >> 2, wc = wid & 3, fr = lane & 15, fq = lane >> 4;
    const int nt = opaque_n(K / BK);
    unsigned voffA[2], voffB[2]; int RA[2], CA[2];
#pragma unroll
    for (int i = 0; i < 2; ++i) { int R, C; stage_rc(tid * 16 + i * 8192, R, C); const int Rb = Epi::PERM ? ((R & ~31) + perm32(R & 31)) : R;
        RA[i] = R; CA[i] = C; voffA[i] = (unsigned)(R * lda + C) * 2u; voffB[i] = (unsigned)(Rb * ldb + C) * 2u; }
    const size_t kstep = (size_t)(BK * 2);
    const size_t hstepA = (size_t)HALF * lda * 2, hstepB = (size_t)HALF * ldb * 2;
    const unsigned ldsw = (unsigned)wid * 1024u;
    const int aoff = lds_byte(wr * 64 + fr, fq * 8), boff = lds_byte(wc * 32 + fr, fq * 8);
#define PG8_SA(b, h) (((b) * 2 + (h)) * HTB)
#define PG8_SB(b, h) ((4 + (b) * 2 + (h)) * HTB)
#define PG8_STB(bufoff, gbase) stage2(lds, (bufoff), ldsw, (gbase), voffB[0], voffB[1])
#define PG8_STA(bufoff, gk, h, NX) do { if constexpr (GATHER) { const unsigned _o0 = (NX) ? vn[h][0] : vc[h][0], _o1 = (NX) ? vn[h][1] : vc[h][1]; stage2(lds, (bufoff), ldsw, (gk), _o0, _o1); } \
        else stage2(lds, (bufoff), ldsw, (gk) + (h) * hstepA, voffA[0], voffA[1]); } while (0)
#define PG8_LDA(dst, b, h) do { _Pragma("unroll") for (int m = 0; m < 4; ++m) _Pragma("unroll") for (int k = 0; k < 2; ++k) dst[m][k] = *(const LAS bf16x8*)(lds + PG8_SA(b, h) + aoff + m * 2048 + k * 1024); } while (0)
#define PG8_LDB(dst, b, h) do { _Pragma("unroll") for (int n = 0; n < 2; ++n) _Pragma("unroll") for (int k = 0; k < 2; ++k) dst[n][k] = *(const LAS bf16x8*)(lds + PG8_SB(b, h) + boff + n * 2048 + k * 1024); } while (0)
#define PG8_MMA(ai, bj, At, Bt) do { __builtin_amdgcn_s_setprio(1); _Pragma("unroll") for (int m = 0; m < 4; ++m) _Pragma("unroll") for (int n = 0; n < 2; ++n) _Pragma("unroll") for (int k = 0; k < 2; ++k) \
        acc[ai][bj][m][n] = __builtin_amdgcn_mfma_f32_16x16x32_bf16(Bt[n][k], At[m][k], acc[ai][bj][m][n], 0, 0, 0); __builtin_amdgcn_s_setprio(0); } while (0)
#define PG8_WAIT_V(n) asm volatile("s_waitcnt vmcnt(" #n ")" ::: "memory")
#define PG8_WAIT_L(n) asm volatile("s_waitcnt lgkmcnt(" #n ")" ::: "memory")
#define PG8_BAR __builtin_amdgcn_s_barrier()
#define PG8_SCHED __builtin_amdgcn_sched_barrier(0)
    Unit cur, nxt; int ui = 0;
    if (!S.next(0, cur)) return;
    unsigned vc[2][2], vn[2][2];
    if constexpr (GATHER) {
#pragma unroll
        for (int h = 0; h < 2; ++h)
#pragma unroll
            for (int i = 0; i < 2; ++i) { vc[h][i] = ((unsigned)S.row(cur, h * HALF + RA[i]) * (unsigned)lda + (unsigned)CA[i]) * 2u; vn[h][i] = vc[h][i]; }
        asm volatile("s_waitcnt vmcnt(0)" ::: "memory");
    }
    f32x4 acc[2][2][4][2];
#pragma unroll
    for (int a = 0; a < 2; ++a)
#pragma unroll
        for (int b = 0; b < 2; ++b)
#pragma unroll
            for (int m = 0; m < 4; ++m)
#pragma unroll
                for (int n = 0; n < 2; ++n) acc[a][b][m][n] = (f32x4){0.f, 0.f, 0.f, 0.f};
    bf16x8 At[4][2], B0[2][2], B1[2][2];
    const char* cA = cur.A; const char* cB = cur.B;
    PG8_STB(PG8_SB(0, 0), cB); PG8_STB(PG8_SB(0, 1), cB + hstepB); PG8_STA(PG8_SA(0, 0), cA, 0, false); PG8_STA(PG8_SA(0, 1), cA, 1, false);
    if (wr == 1) PG8_BAR;
    PG8_WAIT_V(2); PG8_BAR;
    PG8_STB(PG8_SB(1, 0), cB + kstep); PG8_STA(PG8_SA(1, 0), cA + kstep, 0, false); PG8_STB(PG8_SB(1, 1), cB + hstepB + kstep);
    PG8_WAIT_V(6); PG8_BAR;
    for (;;) {
        const bool has_next = S.next(ui + 1, nxt);
        const char* nA = has_next ? nxt.A : cA; const char* nB = has_next ? nxt.B : cB;
#pragma unroll 1
        for (int t = 0; t < nt; t += 2) {
            const bool last = (t == nt - 2);
            const char* a1 = cA + (size_t)(t + 1) * kstep;
            const char* a2 = last ? nA : cA + (size_t)(t + 2) * kstep; const char* b2 = last ? nB : cB + (size_t)(t + 2) * kstep;
            const char* a3 = a2 + kstep; const char* b3 = b2 + kstep;
            if constexpr (GATHER) {
                if (last && has_next) {
#pragma unroll
                    for (int h = 0; h < 2; ++h)
#pragma unroll
                        for (int i = 0; i < 2; ++i) vn[h][i] = ((unsigned)S.row(nxt, h * HALF + RA[i]) * (unsigned)lda + (unsigned)CA[i]) * 2u;
                    asm volatile("s_waitcnt vmcnt(0)" ::: "memory");
                }
            }
            PG8_LDB(B0, 0, 0); PG8_LDB(B1, 0, 1); PG8_SCHED; PG8_LDA(At, 0, 0); PG8_STA(PG8_SA(1, 1), a1, 1, false);
            PG8_WAIT_V(8); PG8_WAIT_L(0); PG8_BAR; PG8_MMA(0, 0, At, B0); PG8_MMA(0, 1, At, B1); PG8_BAR; PG8_SCHED;
            PG8_LDA(At, 0, 1); PG8_STB(PG8_SB(0, 0), b2); PG8_STB(PG8_SB(0, 1), b2 + hstepB); PG8_STA(PG8_SA(0, 0), a2, 0, last);
            PG8_WAIT_V(8); PG8_WAIT_L(0); PG8_BAR; PG8_MMA(1, 0, At, B0); PG8_MMA(1, 1, At, B1); PG8_BAR; PG8_SCHED;
            PG8_LDB(B0, 1, 0); PG8_LDB(B1, 1, 1); PG8_SCHED; PG8_LDA(At, 1, 0); PG8_STA(PG8_SA(0, 1), a2, 1, last);
            PG8_WAIT_V(8); PG8_WAIT_L(0); PG8_BAR; PG8_MMA(0, 0, At, B0); PG8_MMA(0, 1, At, B1); PG8_BAR; PG8_SCHED;
            PG8_LDA(At, 1, 1); PG8_STB(PG8_SB(1, 0), b3); PG8_STB(PG8_SB(1, 1), b3 + hstepB); PG8_STA(PG8_SA(1, 0), a3, 0, last);
            PG8_WAIT_V(8); PG8_WAIT_L(0); PG8_BAR; PG8_MMA(1, 0, At, B0); PG8_MMA(1, 1, At, B1); PG8_BAR; PG8_SCHED;
        }
        if (wr == 0) PG8_BAR;
        { int fr_ = fr, fq_ = fq; asm volatile("" : "+v"(fr_), "+v"(fq_));
          E(acc, cur, wr, wc, fr_, fq_); }
        if (!has_next) break;
#pragma unroll
        for (int a = 0; a < 2; ++a)
#pragma unroll
            for (int b = 0; b < 2; ++b)
#pragma unroll
                for (int m = 0; m < 4; ++m)
#pragma unroll
                    for (int n = 0; n < 2; ++n) acc[a][b][m][n] = (f32x4){0.f, 0.f, 0.f, 0.f};
        cur = nxt; cA = nA; cB = nB; ++ui;
        if constexpr (GATHER) {
#pragma unroll
            for (int h = 0; h < 2; ++h)
#pragma unroll
                for (int i = 0; i < 2; ++i) vc[h][i] = vn[h][i];
        }
        if (wr == 1) PG8_BAR;
    }
    PG8_WAIT_V(0);
    PG8_BAR;
#undef PG8_SA
#undef PG8_SB
#undef PG8_STB
#undef PG8_STA
#undef PG8_LDA
#undef PG8_LDB
#undef PG8_MMA
#undef PG8_WAIT_V
#undef PG8_WAIT_L
#undef PG8_BAR
#undef PG8_SCHED
}
}
#define XB_TMO      128
#define XB_XCNT(j)  (256  + 64 * (j))
#define XB_XSUB(j)  (1280 + 64 * (j))
#define XB_XGEN(j)  (2304 + 64 * (j))
#define XB_TOP      3328
#define XB_TOPGEN   3392
#define XCD_BAR_WORDS 3456
#define XB_SPIN_CAP (1u << 18)
__device__ __forceinline__ unsigned xb_ld(unsigned* p)              { return __hip_atomic_load(p, __ATOMIC_RELAXED, __HIP_MEMORY_SCOPE_AGENT); }
__device__ __forceinline__ unsigned xb_add(unsigned* p, unsigned v) { return __hip_atomic_fetch_add(p, v, __ATOMIC_RELAXED, __HIP_MEMORY_SCOPE_AGENT); }
__device__ __forceinline__ unsigned xb_xcc_id() { return (unsigned)__builtin_amdgcn_s_getreg((3 << 11) | 20) & 0xFu; }
#define XB_SPIN(cond, bar) do { unsigned _sp = 0; while (cond) { __builtin_amdgcn_s_sleep(1); \
    if ((++_sp & 255u) == 0u) { if (xb_ld(&(bar)[XB_TMO])) break; if (_sp > XB_SPIN_CAP) { atomicAdd(&(bar)[XB_TMO], 1u); break; } } } } while (0)
struct XcdBarrier { unsigned* bar; unsigned x; volatile LAS unsigned* st; };
__device__ __forceinline__ XcdBarrier xcd_barrier_post(unsigned* bar, volatile LAS unsigned* st) {
    XcdBarrier b; b.bar = bar; b.x = xb_xcc_id(); b.st = st;
    if (threadIdx.x == 0) (void)xb_add(&bar[XB_XCNT(b.x)], 1u);
    return b;
}
__device__ __forceinline__ void xcd_barrier_complete(unsigned* bar, unsigned x, unsigned& nloc, unsigned& nx) {
    const unsigned G = gridDim.x * gridDim.y * gridDim.z;
    unsigned sum, cnt, mine, sp = 0u;
    for (;;) {
        sum = 0u; cnt = 0u; mine = 0u;
#pragma unroll
        for (unsigned j = 0; j < 16; ++j) { const unsigned c = xb_ld(&bar[XB_XCNT(j)]); sum += c; cnt += (c > 0u) ? 1u : 0u; mine = (j == x) ? c : mine; }
        if (sum == G) break;
        __builtin_amdgcn_s_sleep(1);
        if ((++sp & 255u) == 0u) { if (xb_ld(&bar[XB_TMO])) break; if (sp > XB_SPIN_CAP) { atomicAdd(&bar[XB_TMO], 1u); break; } }
    }
    nloc = mine > 0u ? mine : 1u; nx = cnt > 0u ? cnt : 1u;
}
__device__ __forceinline__ void xcd_barrier(const XcdBarrier& b) {
    asm volatile("s_waitcnt vmcnt(0)" ::: "memory");
    __syncthreads();
    if (threadIdx.x == 0) {
        unsigned* bar = b.bar;
        __builtin_amdgcn_s_waitcnt(0);
        unsigned nloc = b.st[0], nx = b.st[1];
        if (nloc == 0u) { xcd_barrier_complete(bar, b.x, nloc, nx); b.st[0] = nloc; b.st[1] = nx; }
        const unsigned old = xb_add(&bar[XB_XSUB(b.x)], 1u);
        const unsigned gen = old / nloc;
        if (old + 1u == (gen + 1u) * nloc) {
            __builtin_amdgcn_fence(__ATOMIC_RELEASE, "agent");
            asm volatile("s_waitcnt vmcnt(0)" ::: "memory");
            const unsigned og = xb_add(&bar[XB_TOP], 1u);
            const unsigned tg = og / nx;
            if (og + 1u == (tg + 1u) * nx) xb_add(&bar[XB_TOPGEN], 1u);
            else XB_SPIN(xb_ld(&bar[XB_TOPGEN]) == tg, bar);
            __builtin_amdgcn_fence(__ATOMIC_ACQUIRE, "agent");
            xb_add(&bar[XB_XGEN(b.x)], 1u);
            asm volatile("s_waitcnt vmcnt(0)" ::: "memory");
        } else {
            XB_SPIN(xb_ld(&bar[XB_XGEN(b.x)]) == gen, bar);
            __builtin_amdgcn_fence(__ATOMIC_ACQUIRE, "agent");
            asm volatile("s_waitcnt vmcnt(0)" ::: "memory");
        }
    }
    __syncthreads();
}

constexpr size_t MiB = 1u << 20;
constexpr size_t WS_CTL = 0, CTL_ZERO_BYTES = 64 * 1024;
constexpr size_t WS_MOD = 1 * MiB;
constexpr size_t WS_EIDX = 2 * MiB;
constexpr size_t WS_WSEL = WS_EIDX + 512 * 1024;
constexpr size_t WS_RANK = WS_WSEL + 512 * 1024;
constexpr size_t WS_TOK = 4 * MiB;
constexpr size_t WS_DST = WS_TOK + 1 * MiB;
constexpr size_t WS_WSL = WS_DST + 1 * MiB;
constexpr size_t WS_WIN = 8 * MiB;
constexpr size_t WS_POOLW = 55 * MiB;
constexpr size_t WS_WPO = 56 * MiB;
constexpr size_t WS_LORA = 60 * MiB;
constexpr size_t WS_G2 = 62 * MiB;
constexpr size_t WS_WRO = 63 * MiB;
constexpr size_t WS_WO = 71 * MiB;
constexpr size_t WS_SLAB = 80 * MiB;
constexpr size_t WS_EA = 80 * MiB;
constexpr size_t EA_STRIDE = (size_t)MT * D * 2;
constexpr size_t WS_YF = 352 * MiB, WS_YB = 416 * MiB;
constexpr size_t WS_HA = 438 * MiB;
constexpr size_t WS_Z = 480 * MiB;
constexpr size_t WS_U = 506 * MiB;
constexpr size_t WS_RM = 544 * MiB, WS_KM = 612 * MiB, WS_VM = 680 * MiB;
constexpr size_t WS_LIN = 748 * MiB;
constexpr size_t WS_DP = 774 * MiB;
constexpr size_t WS_Y2 = 806 * MiB;
constexpr size_t WS_MP = 838 * MiB;
constexpr size_t WS_GATES = 902 * MiB;
constexpr size_t WS_OR = 80 * MiB;
constexpr size_t WS_H2 = 520 * MiB;
constexpr size_t WS_GU = 584 * MiB;
constexpr size_t WS_ACT = 844 * MiB;
constexpr size_t WS_DT = 1004 * MiB;
constexpr size_t WS_YP = 8 * MiB;
constexpr size_t WS_END = 1134 * MiB;
constexpr int CW_BAR = 1024;
constexpr int CW_GCNT = 8192;
static_assert((CW_BAR + XCD_BAR_WORDS) <= CW_GCNT && (CW_GCNT + 128) * 4 <= (int)CTL_ZERO_BYTES, "ctl");

constexpr int RING_OFF = 0, RING_BYTES = 131072;
constexpr int LDSCTL_OFF = RING_BYTES;
constexpr int TAB_OFF = LDSCTL_OFF + 1024;
constexpr int LDS_BYTES = 163840;

using pg8::Unit;
struct RepOrder {
    const char* A; const char* B; size_t repA, repB, tA, tB; int nM, nN, nrep, G, c;
    __device__ __forceinline__ bool next(int i, Unit& u) const {
        const long L = (long)i * G + c; const int per = nM * nN; if (L >= (long)per * nrep) return false;
        const int rep = (int)(L / per); const int w = pg8::xcd_remap((int)(L % per), per); pg8::grid_tile(w, nM, nN, u.pm, u.pn); u.aux = rep;
        u.A = A + (size_t)rep * repA + (size_t)u.pm * tA; u.B = B + (size_t)rep * repB + (size_t)u.pn * tB; return true; }
    __device__ __forceinline__ int row(const Unit&, int) const { return 0; }
};
struct G1Order {
    const char* A; const char* B; size_t tA, tB; int G, c;
    __device__ __forceinline__ bool next(int i, Unit& u) const {
        const long L = (long)i * G + c; constexpr int N1 = 64 * 47, N2 = 4 * 27; if (L >= N1 + N2) return false;
        if (L < N1) { const int w = pg8::xcd_remap((int)L, N1); pg8::grid_tile(w, 64, 47, u.pm, u.pn); }
        else { const int l2 = (int)L - N1; u.pm = 64 + (l2 & 3); u.pn = 4 + (l2 >> 2); }
        u.aux = 0; u.A = A + (size_t)u.pm * tA; u.B = B + (size_t)u.pn * tB; return true; }
    __device__ __forceinline__ int row(const Unit&, int) const { return 0; }
};
struct MoeOrder {
    const char* A; const char* B; const LAS int* te; const int* tok; size_t tA, estride, jstride; int ntiles, NJ, G, c;
    __device__ __forceinline__ bool next(int i, Unit& u) const {
        const long L = (long)i * G + c; const int tot = ntiles * NJ; if (L >= tot) return false;
        const int w = pg8::xcd_remap((int)L, tot); const int rt = w / NJ, j = w - rt * NJ; const int e = te[rt];
        u.pm = rt; u.pn = j; u.aux = e; u.A = A + (size_t)rt * tA; u.B = B + (size_t)e * estride + (size_t)j * jstride; return true; }
    __device__ __forceinline__ int row(const Unit& u, int r) const { return tok[u.pm * 256 + r]; }
};

typedef f32x4 AccT[2][2][4][2];
#define EPI_ROWS_BEGIN _Pragma("unroll") for (int ai = 0; ai < 2; ++ai) _Pragma("unroll") for (int m = 0; m < 4; ++m) { const int rl = ai * 128 + wr * 64 + m * 16 + fr;
#define EPI_ROWS_END if (m & 1) asm volatile("" ::: "memory"); }
struct EpiG1 { static constexpr bool PERM = true; bf16* U; bf16* SLAB; bf16* GATES;
    __device__ __forceinline__ void operator()(const AccT& acc, const Unit& u, int wr, int wc, int fr, int fq) const {
        bf16* base; int ld, c0;
        if (u.pn < 4) { base = U; ld = 1024; c0 = u.pn * 256; } else if (u.pn < 31) { base = SLAB; ld = SLABLD; c0 = (u.pn - 4) * 256; } else { base = GATES; ld = 4096; c0 = (u.pn - 31) * 256; }
        EPI_ROWS_BEGIN
            bf16* rowp = base + (size_t)(u.pm * 256 + rl) * ld + c0 + wc * 32 + 8 * fq;
#pragma unroll
            for (int bj = 0; bj < 2; ++bj) { const f32x4 v0 = acc[ai][bj][m][0], v1 = acc[ai][bj][m][1];
                v4u w; w.x = pk2(v0[0], v0[1]); w.y = pk2(v0[2], v0[3]); w.z = pk2(v1[0], v1[1]); w.w = pk2(v1[2], v1[3]); *(v4u*)(rowp + bj * 128) = w; }
        EPI_ROWS_END
    }
};
struct EpiLora { static constexpr bool PERM = true; unsigned short* EA; const float* w0; const float* a0;
    __device__ __forceinline__ void operator()(const AccT& acc, const Unit& u, int wr, int wc, int fr, int fq) const {
        const int rep = u.aux; const float* bias = (rep < 2 ? w0 + rep * D : a0 + (rep - 2) * D) + u.pn * 256 + wc * 32 + 8 * fq;
        const float cc = rep < 2 ? -0.8750424f : 1.0f;
        unsigned short* base = EA + (size_t)rep * ((size_t)MT * D);
        EPI_ROWS_BEGIN
            unsigned short* rowp = base + (size_t)(u.pm * 256 + rl) * D + u.pn * 256 + wc * 32 + 8 * fq;
#pragma unroll
            for (int bj = 0; bj < 2; ++bj) { const f32x4 v0 = acc[ai][bj][m][0] + *(const f32x4*)(bias + bj * 128), v1 = acc[ai][bj][m][1] + *(const f32x4*)(bias + bj * 128 + 4);
                v4u w; w.x = pkh2(cc * sigmoidf_(v0[0]), cc * sigmoidf_(v0[1])); w.y = pkh2(cc * sigmoidf_(v0[2]), cc * sigmoidf_(v0[3]));
                w.z = pkh2(cc * sigmoidf_(v1[0]), cc * sigmoidf_(v1[1])); w.w = pkh2(cc * sigmoidf_(v1[2]), cc * sigmoidf_(v1[3]));
                *(v4u*)(rowp + bj * 128) = w; }
        EPI_ROWS_END
    }
};
struct EpiPoolG { static constexpr bool PERM = true; bf16* Y2; const float* scale;
    __device__ __forceinline__ void operator()(const AccT& acc, const Unit& u, int wr, int wc, int fr, int fq) const {
        const int cb = u.aux * 256 + wc * 32 + 8 * fq;
        f32x4 s0[2], s1[2];
#pragma unroll
        for (int bj = 0; bj < 2; ++bj) { s0[bj] = *(const f32x4*)(scale + cb + bj * 128); s1[bj] = *(const f32x4*)(scale + cb + bj * 128 + 4); }
        EPI_ROWS_BEGIN
            bf16* rowp = Y2 + (size_t)(u.pm * 256 + rl) * 1024 + cb;
#pragma unroll
            for (int bj = 0; bj < 2; ++bj) { const f32x4 v0 = acc[ai][bj][m][0] * s0[bj], v1 = acc[ai][bj][m][1] * s1[bj];
                v4u w; w.x = pk2(v0[0], v0[1]); w.y = pk2(v0[2], v0[3]); w.z = pk2(v1[0], v1[1]); w.w = pk2(v1[2], v1[3]); *(v4u*)(rowp + bj * 128) = w; }
        EPI_ROWS_END
    }
};
template <int MODE> struct EpiMix { static constexpr bool PERM = true; bf16* OUT; int ldo; const bf16* AUX1; int ld1; const bf16* AUX2; int ld2;
    __device__ __forceinline__ void operator()(const AccT& acc, const Unit& u, int wr, int wc, int fr, int fq) const {
        const int cb = u.pn * 256 + wc * 32 + 8 * fq;
        EPI_ROWS_BEGIN
            const size_t row = (size_t)(u.pm * 256 + rl);
#pragma unroll
            for (int bj = 0; bj < 2; ++bj) { const f32x4 v0 = acc[ai][bj][m][0], v1 = acc[ai][bj][m][1];
                const v4u a1 = *(const v4u*)(AUX1 + row * ld1 + cb + bj * 128);
                float x[8] = {bflo(a1.x), bfhi(a1.x), bflo(a1.y), bfhi(a1.y), bflo(a1.z), bfhi(a1.z), bflo(a1.w), bfhi(a1.w)};
                float o[8];
                if (MODE == 0) {
#pragma unroll
                    for (int j = 0; j < 4; ++j) { o[j] = sigmoidf_(x[j]) * v0[j]; o[4 + j] = sigmoidf_(x[4 + j]) * v1[j]; } }
                else if (MODE == 1) {
#pragma unroll
                    for (int j = 0; j < 4; ++j) { o[j] = x[j] * v0[j]; o[4 + j] = x[4 + j] * v1[j]; } }
                else { const v4u a2 = *(const v4u*)(AUX2 + row * ld2 + cb + bj * 128);
                    const float y[8] = {bflo(a2.x), bfhi(a2.x), bflo(a2.y), bfhi(a2.y), bflo(a2.z), bfhi(a2.z), bflo(a2.w), bfhi(a2.w)};
#pragma unroll
                    for (int j = 0; j < 4; ++j) { o[j] = y[j] + sigmoidf_(x[j]) * v0[j]; o[4 + j] = y[4 + j] + sigmoidf_(x[4 + j]) * v1[j]; } }
                v4u w; w.x = pk2(o[0], o[1]); w.y = pk2(o[2], o[3]); w.z = pk2(o[4], o[5]); w.w = pk2(o[6], o[7]);
                *(v4u*)(OUT + row * ldo + cb + bj * 128) = w; }
        EPI_ROWS_END
    }
};
struct EpiX1 { static constexpr bool PERM = false; const float* X; float* OUT; const float* MOD;
    __device__ __forceinline__ void operator()(const AccT& acc, const Unit& u, int wr, int wc, int fr, int fq) const {
        const int b = u.pm >> 4;
        const int cb = u.pn * 256 + wc * 32 + 4 * fq; const float* g = MOD + (size_t)b * 12288 + 4096 + cb;
        f32x4 gv[2][2];
#pragma unroll
        for (int bj = 0; bj < 2; ++bj)
#pragma unroll
            for (int n = 0; n < 2; ++n) gv[bj][n] = *(const f32x4*)(g + bj * 128 + n * 16);
        EPI_ROWS_BEGIN
            const size_t off = (size_t)(u.pm * 256 + rl) * D + cb;
#pragma unroll
            for (int bj = 0; bj < 2; ++bj)
#pragma unroll
                for (int n = 0; n < 2; ++n) { const f32x4 xv = *(const f32x4*)(X + off + bj * 128 + n * 16); *(f32x4*)(OUT + off + bj * 128 + n * 16) = xv + gv[bj][n] * acc[ai][bj][m][n]; }
        EPI_ROWS_END
    }
};
struct EpiAct { static constexpr bool PERM = true; bf16* ACT;
    __device__ __forceinline__ void operator()(const AccT& acc, const Unit& u, int wr, int wc, int fr, int fq) const {
        EPI_ROWS_BEGIN
            const f32x4 g0 = acc[ai][0][m][0], g1 = acc[ai][0][m][1], u0 = acc[ai][1][m][0], u1 = acc[ai][1][m][1];
            float o[8];
#pragma unroll
            for (int j = 0; j < 4; ++j) { o[j] = g0[j] * sigmoidf_(g0[j]) * u0[j]; o[4 + j] = g1[j] * sigmoidf_(g1[j]) * u1[j]; }
            v4u w; w.x = pk2(o[0], o[1]); w.y = pk2(o[2], o[3]); w.z = pk2(o[4], o[5]); w.w = pk2(o[6], o[7]);
            *(v4u*)(ACT + (size_t)(u.pm * 256 + rl) * DEXP + u.pn * 128 + wc * 32 + 8 * fq) = w;
        EPI_ROWS_END
    }
};
struct EpiDown { static constexpr bool PERM = true; bf16* YP; const int* DST; const float* WSL;
    __device__ __forceinline__ void operator()(const AccT& acc, const Unit& u, int wr, int wc, int fr, int fq) const {
        const int cb = u.pn * 256 + wc * 32 + 8 * fq;
        EPI_ROWS_BEGIN
            const int slot = u.pm * 256 + rl; const int dst = DST[slot]; const float wt = WSL[slot];
            if (dst >= 0) {
#pragma unroll
                for (int bj = 0; bj < 2; ++bj) { const f32x4 v0 = acc[ai][bj][m][0] * wt, v1 = acc[ai][bj][m][1] * wt;
                    v4u w; w.x = pk2(v0[0], v0[1]); w.y = pk2(v0[2], v0[3]); w.z = pk2(v1[0], v1[1]); w.w = pk2(v1[2], v1[3]);
                    *(v4u*)(YP + (size_t)dst * D + cb + bj * 128) = w; } }
        EPI_ROWS_END
    }
};
struct Frame {
    LAS unsigned char* lds;
    volatile LAS unsigned* MISC;
    unsigned* ctl;
    int tid, lane, wave, vcu, G;
    unsigned char* ws;
};
struct Args { const float* in[34]; float* out; unsigned char* ws; int ph_lo, ph_hi; };
enum { I_X = 0, I_C, I_CTX, I_CCTX, I_N1G, I_N2G, I_ADAW, I_ADAB, I_WIN, I_MU, I_POOLW, I_POOLS, I_WPO, I_DW0, I_DW2, I_IA0, I_IA2, I_G2, I_KK, I_KA, I_RK, I_LNW, I_LNB,
       I_WRO, I_WO, I_RW, I_RB, I_EG, I_EU, I_ED, I_SG, I_SU, I_SD, I_FG };

struct TrJob { const float* src; bf16* dst; int ldw, kvalid, ldt, k0, n0, drow0; };
__device__ __forceinline__ void tr_load(const TrJob& j, f32x4 (&v)[16], int lane) {
    const int r2 = lane >> 4, c4 = lane & 15;
#pragma unroll
    for (int i = 0; i < 8; ++i) {
#pragma unroll
        for (int h = 0; h < 2; ++h) { const int k = j.k0 + 8 * i + 2 * r2 + h; const int kc = k < j.kvalid ? k : 0;
            const f32x4 x = *(const f32x4*)(j.src + (size_t)kc * j.ldw + j.n0 + 4 * c4); v[2 * i + h] = (k < j.kvalid) ? x : (f32x4){0.f, 0.f, 0.f, 0.f}; } }
}
__device__ __forceinline__ void tr_store(const TrJob& j, const f32x4 (&v)[16], LAS unsigned* P, int lane) {
    const int r2 = lane >> 4, c4 = lane & 15;
#pragma unroll
    for (int i = 0; i < 8; ++i) { LAS unsigned* p = P + (4 * i + r2) * 65 + 4 * c4;
        p[0] = pk2(v[2 * i].x, v[2 * i + 1].x); p[1] = pk2(v[2 * i].y, v[2 * i + 1].y); p[2] = pk2(v[2 * i].z, v[2 * i + 1].z); p[3] = pk2(v[2 * i].w, v[2 * i + 1].w); }
    LDS_WAIT(); asm volatile("" ::: "memory");
    const int nl = lane >> 3, q = lane & 7;
#pragma unroll
    for (int jj = 0; jj < 8; ++jj) { const int n = 8 * jj + nl; const LAS unsigned* s = P + (4 * q) * 65 + n;
        v4u o; o.x = s[0]; o.y = s[65]; o.z = s[130]; o.w = s[195];
        *(v4u*)(j.dst + (size_t)(j.drow0 + n) * j.ldt + j.k0 + 8 * q) = o; }
    LDS_WAIT(); asm volatile("" ::: "memory");
}
template <class Dec> __device__ __forceinline__ void tr_run(const Dec& dec, int first, int stride, LAS unsigned* P, int lane) {
    TrJob ja, jb; f32x4 va[16], vb[16];
    int it = first; bool ha = dec(it, ja); if (ha) tr_load(ja, va, lane);
    while (ha) {
        it += stride; const bool hb = dec(it, jb); if (hb) tr_load(jb, vb, lane);
        tr_store(ja, va, P, lane);
        if (!hb) break;
        it += stride; ha = dec(it, ja); if (ha) tr_load(ja, va, lane);
        tr_store(jb, vb, P, lane);
    }
}
__device__ __forceinline__ void p0_prologue(Frame& F, const Args& a) {
    {
        LAS float* sv = (LAS float*)F.lds;
        LAS float* part = (LAS float*)(F.lds + 40960);
        bool did = false;
        for (int cb = blockIdx.x; cb < 192; cb += F.G) {
            if (!did) { for (int idx = F.tid; idx < 5 * D; idx += 512) { const int j = idx >> 11, k = idx & 2047; const float v = (j < 4) ? a.in[I_C][j * D + k] : a.in[I_CCTX][k]; sv[idx] = v / (1.0f + __expf(-v)); } did = true; }
            __syncthreads();
            const int col = 64 * cb + F.lane, k0 = 256 * F.wave; const float* wp = a.in[I_ADAW] + (size_t)k0 * 12288 + col;
            float acc[5] = {0.f, 0.f, 0.f, 0.f, 0.f};
#pragma unroll 8
            for (int k = 0; k < 256; ++k) { const float w = wp[(size_t)k * 12288];
#pragma unroll
                for (int j = 0; j < 5; ++j) acc[j] += sv[j * D + k0 + k] * w; }
#pragma unroll
            for (int j = 0; j < 5; ++j) part[(F.wave * 5 + j) * 64 + F.lane] = acc[j];
            __syncthreads();
            if (F.tid < 320) { const int j = F.tid >> 6, l = F.tid & 63; float s = a.in[I_ADAB][64 * cb + l];
#pragma unroll
                for (int w = 0; w < 8; ++w) s += part[(w * 5 + j) * 64 + l];
                ((float*)(F.ws + WS_MOD))[j * 12288 + 64 * cb + l] = s; }
            __syncthreads();
        }
        __syncthreads();
    }
    {
        struct DecSmall { const float* const* in; unsigned char* ws;
            __device__ __forceinline__ bool operator()(int it, TrJob& j) const {
                constexpr int I_1 = 32 * 186, I_2 = 4 * 16, I_3 = 16 * 32, I_4 = 4 * 32, I_5 = 32 * 32, I_6 = 32 * 32, I_7 = 4 * 2 * 32;
                int r = it; if (r < 0) return false;
                if (r < I_1) { const int kb = r / 186, nb = r % 186, n0 = nb * 64; j = TrJob{in[I_WIN], (bf16*)(ws + WS_WIN), DIN, D, D, kb * 64, n0, n0 + (n0 >= 7808 ? 128 : 0)}; return true; } r -= I_1;
                if (r < I_2) { const int g = r / 16, q = r % 16; j = TrJob{in[I_POOLW] + (size_t)g * 65536, (bf16*)(ws + WS_POOLW) + (size_t)g * 65536, 256, 256, 256, (q / 4) * 64, (q % 4) * 64, (q % 4) * 64}; return true; } r -= I_2;
                if (r < I_3) { j = TrJob{in[I_WPO], (bf16*)(ws + WS_WPO), D, 1024, 1024, (r / 32) * 64, (r % 32) * 64, (r % 32) * 64}; return true; } r -= I_3;
                if (r < I_4) { j = TrJob{in[I_G2], (bf16*)(ws + WS_G2), D, 256, 256, (r / 32) * 64, (r % 32) * 64, (r % 32) * 64}; return true; } r -= I_4;
                if (r < I_5) { j = TrJob{in[I_WRO], (bf16*)(ws + WS_WRO), D, D, D, (r / 32) * 64, (r % 32) * 64, (r % 32) * 64}; return true; } r -= I_5;
                if (r < I_6) { j = TrJob{in[I_WO], (bf16*)(ws + WS_WO), D, D, D, (r / 32) * 64, (r % 32) * 64, (r % 32) * 64}; return true; } r -= I_6;
                if (r < I_7) { const int mtx = r / 64, q = r % 64;
                    const float* src = (mtx < 2 ? in[I_DW2] + (size_t)mtx * 96 * D : in[I_IA2] + (size_t)(mtx - 2) * 96 * D);
                    j = TrJob{src, (bf16*)(ws + WS_LORA) + (size_t)mtx * D * 128, D, 96, 128, (q / 32) * 64, (q % 32) * 64, (q % 32) * 64}; return true; }
                return false; } };
        DecSmall dec{a.in, F.ws};
        tr_run(dec, F.vcu * 8 + F.wave, F.G * 8, (LAS unsigned*)(F.lds + F.wave * 16384), F.lane);
    }
    const int gt = F.vcu * 512 + F.tid, NGT = F.G * 512;
    { v4u* z = (v4u*)((bf16*)(F.ws + WS_WIN) + (size_t)7808 * D); for (int i = gt; i < 128 * D / 8; i += NGT) z[i] = (v4u){0u, 0u, 0u, 0u}; }
    { int* tok = (int*)(F.ws + WS_TOK); int* dst = (int*)(F.ws + WS_DST); float* wsl = (float*)(F.ws + WS_WSL);
      for (int i = gt; i < NSLOT; i += NGT) { tok[i] = 0; dst[i] = -1; wsl[i] = 0.f; } }
}

__device__ __forceinline__ void p1_norm1(Frame& F, const Args& a) {
    const int gw = F.vcu * 8 + F.wave, NGW = F.G * 8; const float* MOD = (const float*)(F.ws + WS_MOD); bf16* HA = (bf16*)(F.ws + WS_HA);
    for (int mrow = gw; mrow < MT; mrow += NGW) {
        const float* src = (mrow < NT) ? a.in[I_X] + (size_t)mrow * D : a.in[I_CTX] + (size_t)(mrow - NT) * D; const int j = (mrow < NT) ? (mrow >> 12) : 4;
        const f32x4* xr = (const f32x4*)src + F.lane; f32x4 v[8]; float s = 0.f;
#pragma unroll
        for (int q = 0; q < 8; ++q) { v[q] = xr[64 * q]; s += (v[q].x * v[q].x + v[q].y * v[q].y) + (v[q].z * v[q].z + v[q].w * v[q].w); }
        const float rstd = 1.0f / sqrtf(wave_sum(s) * (1.0f / D) + 1e-6f);
        const f32x4* g = (const f32x4*)a.in[I_N1G] + F.lane; const f32x4* sh = (const f32x4*)(MOD + (size_t)j * 12288) + F.lane; const f32x4* sc = (const f32x4*)(MOD + (size_t)j * 12288 + 2048) + F.lane;
        v2u* o = (v2u*)(HA + (size_t)mrow * D) + F.lane;
#pragma unroll
        for (int q = 0; q < 8; ++q) { const f32x4 y = v[q] * rstd * g[64 * q] * (sc[64 * q] + 1.0f) + sh[64 * q]; v2u w; w.x = pk2(y.x, y.y); w.y = pk2(y.z, y.w); o[64 * q] = w; }
    }
}

template <int W> __device__ __forceinline__ void pool_item(const unsigned* U32, unsigned* DP32, int m0, int cp) {
    unsigned raw[64];
#pragma unroll
    for (int x = 0; x < 64; ++x) raw[x] = U32[(size_t)(m0 + x) * 512 + cp];
    float lo[64], hi[64];
#pragma unroll
    for (int x = 0; x < 64; ++x) { lo[x] = bflo(raw[x]); hi[x] = bfhi(raw[x]); }
#pragma unroll
    for (int x = 0; x < 64; ++x) { const int l = (x - W / 2) < 0 ? 0 : (x - W / 2), h = (x + W / 2) > 64 ? 64 : (x + W / 2); float s0 = 0.f, s1 = 0.f;
#pragma unroll
        for (int j = l; j < h; ++j) { s0 += lo[j]; s1 += hi[j]; }
        const float inv = 1.0f / (float)(h - l); DP32[(size_t)(m0 + x) * 512 + cp] = pk2(s0 * inv - lo[x], s1 * inv - hi[x]); }
}
__device__ __forceinline__ void p3_prep(Frame& F, const Args& a) {
    const bf16* SLAB = (const bf16*)(F.ws + WS_SLAB); const float* mu = a.in[I_MU];
    bf16* RM = (bf16*)(F.ws + WS_RM); bf16* KM = (bf16*)(F.ws + WS_KM); bf16* VM = (bf16*)(F.ws + WS_VM); bf16* LIN = (bf16*)(F.ws + WS_LIN);
    const int gw = F.vcu * 8 + F.wave, NGW = F.G * 8;
    for (int mrow = gw; mrow < MT; mrow += NGW) {
        const bool lat = mrow < NT; const bf16* own = SLAB + (size_t)mrow * SLABLD;
        bool v0, v1, v2 = false, v3 = false; const bf16 *p0, *p1, *p2 = own, *p3 = own;
        if (lat) { const int t = mrow & 4095, gy = t >> 6, gx = t & 63; v0 = gx > 0; v1 = gx < 63; v2 = gy > 0; v3 = gy < 63;
            p0 = own - SLABLD; p1 = own + SLABLD; p2 = own - (size_t)64 * SLABLD; p3 = own + (size_t)64 * SLABLD; }
        else { const int s = (mrow - NT) & 255; v0 = s > 0; v1 = s < 255; p0 = own - SLABLD; p1 = own + SLABLD; }
        for (int ci = F.lane; ci < DSH / 8; ci += 64) {
            const int c0 = ci * 8; const v4u z = (v4u){0u, 0u, 0u, 0u};
            const v4u o = *(const v4u*)(own + c0);
            const v4u n0 = v0 ? *(const v4u*)(p0 + c0) : z, n1 = v1 ? *(const v4u*)(p1 + c0) : z;
            v4u nb;
            if (lat) { const v4u n2 = v2 ? *(const v4u*)(p2 + c0) : z, n3 = v3 ? *(const v4u*)(p3 + c0) : z;
                nb.x = (n0.x & 0xffffu) | (n1.x & 0xffff0000u); nb.y = (n2.y & 0xffffu) | (n3.y & 0xffff0000u); nb.z = (n0.z & 0xffffu) | (n1.z & 0xffff0000u); nb.w = (n2.w & 0xffffu) | (n3.w & 0xffff0000u); }
            else { nb.x = (n0.x & 0xffffu) | (n1.x & 0xffff0000u); nb.y = (n0.y & 0xffffu) | (n1.y & 0xffff0000u); nb.z = (n0.z & 0xffffu) | (n1.z & 0xffff0000u); nb.w = (n0.w & 0xffffu) | (n1.w & 0xffff0000u); }
            const f32x4 m0 = *(const f32x4*)(mu + c0), m1 = *(const f32x4*)(mu + c0 + 4);
            float r[8];
            { const float ov[8] = {bflo(o.x), bfhi(o.x), bflo(o.y), bfhi(o.y), bflo(o.z), bfhi(o.z), bflo(o.w), bfhi(o.w)};
              const float nv[8] = {bflo(nb.x), bfhi(nb.x), bflo(nb.y), bfhi(nb.y), bflo(nb.z), bfhi(nb.z), bflo(nb.w), bfhi(nb.w)};
              const float mv[8] = {m0.x, m0.y, m0.z, m0.w, m1.x, m1.y, m1.z, m1.w};
#pragma unroll
              for (int e = 0; e < 8; ++e) r[e] = ov[e] + (nv[e] - ov[e]) * mv[e]; }
            bf16* dstp;
            if (c0 < 2048) dstp = RM + (size_t)mrow * D + c0;
            else if (c0 < 4096) dstp = KM + (size_t)mrow * D + (c0 - 2048);
            else if (c0 < 6144) dstp = VM + (size_t)mrow * D + (c0 - 4096);
            else { const int lc = c0 - 6144; int dc;
                if (lc < 192) {
#pragma unroll
                    for (int e = 0; e < 8; ++e) r[e] = tanhf(r[e]);
                    dc = (lc < 96) ? lc : 128 + (lc - 96); }
                else if (lc < 384) dc = (lc < 288) ? 256 + (lc - 192) : 384 + (lc - 288);
                else {
#pragma unroll
                    for (int e = 0; e < 8; ++e) r[e] = sigmoidf_(r[e]);
                    dc = 512 + (lc - 384); }
                dstp = LIN + (size_t)mrow * LINLD + dc; }
            v4u w; w.x = pk2(r[0], r[1]); w.y = pk2(r[2], r[3]); w.z = pk2(r[4], r[5]); w.w = pk2(r[6], r[7]); *(v4u*)dstp = w;
        }
        if (F.lane < 16) { const int p = F.lane >> 2, off = (F.lane & 3) * 8; *(v4u*)(LIN + (size_t)mrow * LINLD + 128 * p + 96 + off) = (v4u){0u, 0u, 0u, 0u}; }
    }
    const unsigned* U32 = (const unsigned*)(F.ws + WS_U); unsigned* DP32 = (unsigned*)(F.ws + WS_DP);
    for (int gr = F.vcu; gr < 256; gr += F.G) {
        const int m0 = gr * 64, cp = F.tid; const int g = F.wave >> 1;
        if (g == 0) pool_item<2>(U32, DP32, m0, cp); else if (g == 1) pool_item<4>(U32, DP32, m0, cp); else if (g == 2) pool_item<8>(U32, DP32, m0, cp); else pool_item<16>(U32, DP32, m0, cp);
    }
}

constexpr int CK = 16, NSL = 8;
constexpr int SL_Z = 0, SL_AF = 2560, SL_TMT = 3584, SL_ZT = 4096, SL_MPT = 0, SL_BGT = 8192, SL_NNT = 10240, SL_VT = 12288, SL_QT = 14336, SL_RT = SL_QT, SL_WYT = 16384, SL_ART = SL_WYT,
              SL_GC = 16896, SL_SIZE = 17152, SB_OFF = 7 * SL_SIZE  , SL7_OFF = 132096  ;
static_assert(SB_OFF + 8192 <= 131072 && SL7_OFF + SL_SIZE <= 163840, "scan LDS map");
__device__ __forceinline__ int slot_off(int n) { return n < 7 ? n * SL_SIZE : SL7_OFF; }
__device__ __forceinline__ int scan_row(int n, int b, int dir) {
    if (n < CTXL) return NT + b * CTXL + (dir ? (CTXL - 1 - n) : n);
    const int t = n - CTXL; return b * TSEQ + (dir ? (TSEQ - 1 - t) : t);
}
__device__ __forceinline__ bf16x8 frag_ld(const LAS unsigned char* p, bool ok) { v4u z = (v4u){0u, 0u, 0u, 0u}; if (ok) z = *(const LAS v4u*)p; return __builtin_bit_cast(bf16x8, z); }
__device__ __forceinline__ f32x4 mfma16(bf16x8 a, bf16x8 b, f32x4 c) { return __builtin_amdgcn_mfma_f32_16x16x32_bf16(a, b, c, 0, 0, 0); }
__device__ __forceinline__ float dpp_shr(float v, const int n, float fill) {
    const int x = __builtin_bit_cast(int, v), f = __builtin_bit_cast(int, fill); int r;
    if (n == 1) r = __builtin_amdgcn_update_dpp(f, x, 0x111, 0xF, 0xF, false); else if (n == 2) r = __builtin_amdgcn_update_dpp(f, x, 0x112, 0xF, 0xF, false);
    else if (n == 4) r = __builtin_amdgcn_update_dpp(f, x, 0x114, 0xF, 0xF, false); else r = __builtin_amdgcn_update_dpp(f, x, 0x118, 0xF, 0xF, false);
    return __builtin_bit_cast(float, r);
}
struct ScanRaw { v4u r[2], k[2], v[2], a[2], e[2]; };
__device__ __forceinline__ void scan_fetch(ScanRaw& R, const bf16* RM, const bf16* KM, const bf16* VM, const unsigned short* AX, const unsigned short* EX, size_t rowoff) {
#pragma unroll
    for (int ks = 0; ks < 2; ++ks) { const size_t off = rowoff + 32 * ks; R.r[ks] = *(const v4u*)(RM + off); R.k[ks] = *(const v4u*)(KM + off); R.v[ks] = *(const v4u*)(VM + off); R.a[ks] = *(const v4u*)(AX + off); R.e[ks] = *(const v4u*)(EX + off); }
}
__device__ __forceinline__ void p6_scan(Frame& F, const Args& a) {
    const bf16* RM = (const bf16*)(F.ws + WS_RM); const bf16* KM = (const bf16*)(F.ws + WS_KM); const bf16* VM = (const bf16*)(F.ws + WS_VM);
    const int lane = F.lane, w = F.wave, c0_ = lane & 15, q0_ = lane >> 4;
    for (int unit = blockIdx.x; unit < NB * NH * 2; unit += F.G) {
        const int dir = unit & 1, h = (unit >> 1) & 31, b = unit >> 6;
        const unsigned short* EX = (const unsigned short*)(F.ws + WS_EA + (size_t)dir * EA_STRIDE);
        const unsigned short* AX = (const unsigned short*)(F.ws + WS_EA + (size_t)(2 + dir) * EA_STRIDE);
        bf16* YO = (bf16*)(F.ws + (dir ? WS_YB : WS_YF));
        LAS unsigned char* SB = F.lds + SB_OFF;
        for (int i = F.tid; i < 8192 / 16; i += 512) ((LAS v4u*)SB)[i] = (v4u){0u, 0u, 0u, 0u};
        f32x4 X[4];
#pragma unroll
        for (int jt = 0; jt < 4; ++jt) X[jt] = (f32x4){0.f, 0.f, 0.f, 0.f};
        constexpr int NBATCH = (CTXL + TSEQ) / CK / NSL;
        ScanRaw R; scan_fetch(R, RM, KM, VM, AX, EX, (size_t)scan_row(w * CK + c0_, b, dir) * D + h * 64 + 8 * q0_);
        __syncthreads();
        for (int bt = 0; bt < NBATCH; ++bt) {
            int c = c0_, q = q0_; asm volatile("" : "+v"(c), "+v"(q));
            const bool klo = q < 2;
            {
                LAS unsigned char* SL = F.lds + slot_off(w);
                int hq = h * 64 + 8 * q; asm volatile("" : "+v"(hq));
                float ss = 0.f;
#pragma unroll
                for (int ks = 0; ks < 2; ++ks) { const int ch = hq + 32 * ks;
                    const f32x4 k0 = *(const f32x4*)(a.in[I_KK] + ch), k1 = *(const f32x4*)(a.in[I_KK] + ch + 4);
                    const float kv[8] = {bflo(R.k[ks].x), bfhi(R.k[ks].x), bflo(R.k[ks].y), bfhi(R.k[ks].y), bflo(R.k[ks].z), bfhi(R.k[ks].z), bflo(R.k[ks].w), bfhi(R.k[ks].w)};
#pragma unroll
                    for (int e = 0; e < 4; ++e) { const float p0 = kv[e] * k0[e], p1 = kv[4 + e] * k1[e]; ss += p0 * p0 + p1 * p1; } }
                ss += __shfl_xor(ss, 16); ss += __shfl_xor(ss, 32);
                const float inv = __builtin_amdgcn_rsqf(ss + 1e-12f);
                bf16x8 fKT[2], fRT[2], fBT[2], fKQ[2];
#pragma unroll
                for (int ks = 0; ks < 2; ++ks) {
                    const int ch = hq + 32 * ks;
                    const v4u xr = R.r[ks], xk = R.k[ks], xv = R.v[ks], xa = R.a[ks], xe = R.e[ks];
                    const f32x4 k0 = *(const f32x4*)(a.in[I_KK] + ch), k1 = *(const f32x4*)(a.in[I_KK] + ch + 4), a0 = *(const f32x4*)(a.in[I_KA] + ch), a1 = *(const f32x4*)(a.in[I_KA] + ch + 4);
                    const float kkw[8] = {k0[0], k0[1], k0[2], k0[3], k1[0], k1[1], k1[2], k1[3]}, kaw[8] = {a0[0], a0[1], a0[2], a0[3], a1[0], a1[1], a1[2], a1[3]};
                    const float r[8] = {bflo(xr.x), bfhi(xr.x), bflo(xr.y), bfhi(xr.y), bflo(xr.z), bfhi(xr.z), bflo(xr.w), bfhi(xr.w)};
                    const float k[8] = {bflo(xk.x), bfhi(xk.x), bflo(xk.y), bfhi(xk.y), bflo(xk.z), bfhi(xk.z), bflo(xk.w), bfhi(xk.w)};
                    const float v[8] = {bflo(xv.x), bfhi(xv.x), bflo(xv.y), bfhi(xv.y), bflo(xv.z), bfhi(xv.z), bflo(xv.w), bfhi(xv.w)};
                    const float ai[8] = {hlo(xa.x), hhi(xa.x), hlo(xa.y), hhi(xa.y), hlo(xa.z), hhi(xa.z), hlo(xa.w), hhi(xa.w)};
                    const float lw[8] = {hlo(xe.x), hhi(xe.x), hlo(xe.y), hhi(xe.y), hlo(xe.z), hhi(xe.z), hlo(xe.w), hhi(xe.w)};
                    float kt[8], rt[8], btl[8], kq[8], cl[8], G[8], Gi[8], Gm[8], GCv[8];
#pragma unroll
                    for (int e = 0; e < 8; ++e) cl[e] = lw[e];
#pragma unroll
                    for (int e = 0; e < 8; ++e) cl[e] += dpp_shr(cl[e], 1, 0.f);
#pragma unroll
                    for (int e = 0; e < 8; ++e) cl[e] += dpp_shr(cl[e], 2, 0.f);
#pragma unroll
                    for (int e = 0; e < 8; ++e) cl[e] += dpp_shr(cl[e], 4, 0.f);
#pragma unroll
                    for (int e = 0; e < 8; ++e) cl[e] += dpp_shr(cl[e], 8, 0.f);
#pragma unroll
                    for (int e = 0; e < 8; ++e) { G[e] = __builtin_amdgcn_exp2f(cl[e]); Gi[e] = __builtin_amdgcn_exp2f(-cl[e]); }
#pragma unroll
                    for (int e = 0; e < 8; ++e) { Gm[e] = dpp_shr(G[e], 1, 1.0f); GCv[e] = __shfl(G[e], (lane & 48) | 15); }
#pragma unroll
                    for (int e = 0; e < 8; ++e) {
                        const float kke = k[e] * kkw[e] * inv, kd = k[e] * ((ai[e] - 1.0f) * kaw[e] + 1.0f), bb = kke * ai[e], ratio = GCv[e] * Gi[e];
                        kt[e] = Gm[e] * kke; rt[e] = G[e] * r[e]; btl[e] = bb * Gi[e]; kq[e] = kd * Gi[e];
                        const int j = 32 * ks + 8 * q + e;
                        const unsigned w0 = pk2(kt[e], bb * ratio), w1 = pk2(kd * ratio, v[e]);
                        ((LAS bf16*)(SL + SL_Z))[j * 16 + c] = (bf16)(w0 & 0xffffu); ((LAS bf16*)(SL + SL_BGT))[j * 16 + c] = (bf16)(w0 >> 16);
                        ((LAS bf16*)(SL + SL_NNT))[j * 16 + c] = (bf16)(w1 & 0xffffu); ((LAS bf16*)(SL + SL_VT))[j * 16 + c] = (bf16)(w1 >> 16);
                    }
                    if (c == 15) { *(LAS f32x4*)(SL + SL_GC + (32 * ks + 8 * q) * 4) = (f32x4){G[0], G[1], G[2], G[3]}; *(LAS f32x4*)(SL + SL_GC + (32 * ks + 8 * q + 4) * 4) = (f32x4){G[4], G[5], G[6], G[7]}; }
                    v4u p; p.x = pk2(kt[0], kt[1]); p.y = pk2(kt[2], kt[3]); p.z = pk2(kt[4], kt[5]); p.w = pk2(kt[6], kt[7]); fKT[ks] = __builtin_bit_cast(bf16x8, p);
                    p.x = pk2(rt[0], rt[1]); p.y = pk2(rt[2], rt[3]); p.z = pk2(rt[4], rt[5]); p.w = pk2(rt[6], rt[7]); fRT[ks] = __builtin_bit_cast(bf16x8, p);
                    *(LAS v4u*)(SL + SL_RT + (c * 64 + 32 * ks + 8 * q) * 2) = p;
                    p.x = pk2(btl[0], btl[1]); p.y = pk2(btl[2], btl[3]); p.z = pk2(btl[4], btl[5]); p.w = pk2(btl[6], btl[7]); fBT[ks] = __builtin_bit_cast(bf16x8, p);
                    p.x = pk2(kq[0], kq[1]); p.y = pk2(kq[2], kq[3]); p.z = pk2(kq[4], kq[5]); p.w = pk2(kq[6], kq[7]); fKQ[ks] = __builtin_bit_cast(bf16x8, p);
                    asm volatile("" ::: "memory");
                }
                const f32x4 z4 = (f32x4){0.f, 0.f, 0.f, 0.f};
                f32x4 accA = mfma16(fBT[1], fKT[1], mfma16(fBT[0], fKT[0], z4)), accAr = mfma16(fBT[1], fRT[1], mfma16(fBT[0], fRT[0], z4));
                f32x4 accCm = mfma16(fKQ[1], fKT[1], mfma16(fKQ[0], fKT[0], z4)), accCr = mfma16(fKQ[1], fRT[1], mfma16(fKQ[0], fRT[0], z4));
#pragma unroll
                for (int g = 0; g < 4; ++g) { const int srow = 4 * q + g; const bool lt = srow < c, le = srow <= c;
                    accA[g] = lt ? accA[g] : 0.f; accAr[g] = le ? accAr[g] : 0.f; accCm[g] = lt ? accCm[g] : 0.f; accCr[g] = le ? accCr[g] : 0.f;
                    ((LAS float*)(SL + SL_AF))[srow * 16 + c] = accA[g]; ((LAS bf16*)(SL + SL_Z))[(64 + srow) * 16 + c] = (bf16)f2bf(accCm[g]); }
                { v2u p; p.x = pk2(accAr[0], accAr[1]); p.y = pk2(accAr[2], accAr[3]); *(LAS v2u*)(SL + SL_ART + (c * 16 + 4 * q) * 2) = p; }
                LDS_WAIT(); asm volatile("" ::: "memory");
                {
                    float x[16];
#pragma unroll
                    for (int srow = 15; srow >= 0; --srow) { float acc = 0.f;
#pragma unroll
                        for (int m = srow + 1; m < 16; ++m) acc += ((const LAS float*)(SL + SL_AF))[srow * 16 + m] * x[m];
                        x[srow] = (srow < c) ? -acc : ((srow == c) ? 1.0f : 0.f); }
                    if (q == 0) { v4u p0, p1; p0.x = pk2(x[0], x[1]); p0.y = pk2(x[2], x[3]); p0.z = pk2(x[4], x[5]); p0.w = pk2(x[6], x[7]); p1.x = pk2(x[8], x[9]); p1.y = pk2(x[10], x[11]); p1.z = pk2(x[12], x[13]); p1.w = pk2(x[14], x[15]);
                        *(LAS v4u*)(SL + SL_TMT + c * 32) = p0; *(LAS v4u*)(SL + SL_TMT + c * 32 + 16) = p1; }
                }
                LDS_WAIT(); asm volatile("" ::: "memory");
                {
                    const bf16x8 fT = frag_ld(SL + SL_TMT + (c * 16 + 8 * q) * 2, klo);
#pragma unroll
                    for (int zt = 0; zt < 5; ++zt) { const bf16x8 fZ = frag_ld(SL + SL_Z + ((16 * zt + c) * 16 + 8 * q) * 2, klo); const f32x4 d = mfma16(fT, fZ, z4);
                        v2u p; p.x = pk2(d[0], d[1]); p.y = pk2(d[2], d[3]); *(LAS v2u*)(SL + SL_ZT + ((16 * zt + c) * 16 + 4 * q) * 2) = p; }
                }
                LDS_WAIT(); asm volatile("" ::: "memory");
                bf16x8 fZT[5];
#pragma unroll
                for (int zt = 0; zt < 5; ++zt) fZT[zt] = frag_ld(SL + SL_ZT + ((16 * zt + c) * 16 + 8 * q) * 2, klo);
                {
                    const bf16x8 fAr = frag_ld(SL + SL_ART + (c * 16 + 8 * q) * 2, klo);
                    v2u rin[4];
#pragma unroll
                    for (int zt = 0; zt < 4; ++zt) rin[zt] = *(const LAS v2u*)(SL + SL_RT + (c * 64 + 16 * zt + 4 * q) * 2);
                    LDS_WAIT(); asm volatile("" ::: "memory");
#pragma unroll
                    for (int zt = 0; zt < 4; ++zt) { const f32x4 d = mfma16(fZT[zt], fAr, z4);
                        v2u p; p.x = pk2(bflo(rin[zt].x) - d[0], bfhi(rin[zt].x) - d[1]); p.y = pk2(bflo(rin[zt].y) - d[2], bfhi(rin[zt].y) - d[3]);
                        *(LAS v2u*)(SL + SL_QT + (c * 64 + 16 * zt + 4 * q) * 2) = p; }
                    { const f32x4 d = mfma16(fZT[4], fAr, z4); v2u p; p.x = pk2(accCr[0] - d[0], accCr[1] - d[1]); p.y = pk2(accCr[2] - d[2], accCr[3] - d[3]);
                      *(LAS v2u*)(SL + SL_WYT + (c * 16 + 4 * q) * 2) = p; }
                }
#pragma unroll
                for (int jt = 0; jt < 4; ++jt) { const bf16x8 fB = frag_ld(SL + SL_BGT + ((16 * jt + c) * 16 + 8 * q) * 2, klo);
#pragma unroll
                    for (int zt = 0; zt < 4; ++zt) { const f32x4 d = mfma16(fZT[zt], fB, z4); v2u p; p.x = pk2(-d[0], -d[1]); p.y = pk2(-d[2], -d[3]);
                        *(LAS v2u*)(SL + SL_MPT + ((16 * jt + c) * 64 + 16 * zt + 4 * q) * 2) = p; }
                    { const f32x4 d = mfma16(fZT[4], fB, z4); LAS v2u* np = (LAS v2u*)(SL + SL_NNT + ((16 * jt + c) * 16 + 4 * q) * 2); const v2u o = *np;
                      v2u p; p.x = pk2(bflo(o.x) - d[0], bfhi(o.x) - d[1]); p.y = pk2(bflo(o.y) - d[2], bfhi(o.y) - d[3]); *np = p; } }
            }
            if (bt + 1 < NBATCH) scan_fetch(R, RM, KM, VM, AX, EX, (size_t)scan_row((NSL * (bt + 1) + w) * CK + c, b, dir) * D + h * 64 + 8 * q);
            __syncthreads();
            asm volatile("" : "+v"(c), "+v"(q));
            if (w < 4) {
                const f32x4 z4 = (f32x4){0.f, 0.f, 0.f, 0.f};
                LAS unsigned char* SB = F.lds + SB_OFF;
#pragma unroll 1
                for (int n = 0; n < NSL; ++n) {
                    const LAS unsigned char* SL = F.lds + slot_off(n); const int chunk = NSL * bt + n;
                    const bf16x8 fV = frag_ld(SL + SL_VT + ((16 * w + c) * 16 + 8 * q) * 2, klo);
                    bf16x8 fN[4], fM[4][2], fQ[2], fW; f32x4 gc[4];
                    fW = frag_ld(SL + SL_WYT + (c * 16 + 8 * q) * 2, klo);
#pragma unroll
                    for (int ks = 0; ks < 2; ++ks) fQ[ks] = frag_ld(SL + SL_QT + (c * 64 + 32 * ks + 8 * q) * 2, true);
#pragma unroll
                    for (int jt = 0; jt < 4; ++jt) { fN[jt] = frag_ld(SL + SL_NNT + ((16 * jt + c) * 16 + 8 * q) * 2, klo); gc[jt] = *(const LAS f32x4*)(SL + SL_GC + (16 * jt + 4 * q) * 4);
#pragma unroll
                        for (int ks = 0; ks < 2; ++ks) fM[jt][ks] = frag_ld(SL + SL_MPT + ((16 * jt + c) * 64 + 32 * ks + 8 * q) * 2, true); }
                    bf16x8 fS[2];
#pragma unroll
                    for (int ks = 0; ks < 2; ++ks) fS[ks] = frag_ld(SB + ((16 * w + c) * 64 + 32 * ks + 8 * q) * 2, true);
#pragma unroll
                    for (int jt = 0; jt < 4; ++jt) {
                        f32x4 d = mfma16(fN[jt], fV, z4);
#pragma unroll
                        for (int ks = 0; ks < 2; ++ks) d = mfma16(fM[jt][ks], fS[ks], d);
                        X[jt] = X[jt] * gc[jt] + d;
                        v2u p; p.x = pk2(X[jt][0], X[jt][1]); p.y = pk2(X[jt][2], X[jt][3]); *(LAS v2u*)(SB + ((16 * w + c) * 64 + 16 * jt + 4 * q) * 2) = p;
                    }
                    if (chunk * CK >= CTXL) {
                        f32x4 y = mfma16(fW, fV, z4);
#pragma unroll
                        for (int ks = 0; ks < 2; ++ks) y = mfma16(fQ[ks], fS[ks], y);
#pragma unroll
                        for (int g = 0; g < 4; ++g) YO[(size_t)scan_row(chunk * CK + 4 * q + g, b, dir) * D + h * 64 + 16 * w + c] = (bf16)f2bf(y[g]);
                    }
                    LDS_WAIT(); asm volatile("" ::: "memory");
                }
            }
            __syncthreads();
        }
    }
}

__device__ __forceinline__ void p7_readout(Frame& F, const Args& a) {
    const bf16* RM = (const bf16*)(F.ws + WS_RM); const bf16* KM = (const bf16*)(F.ws + WS_KM); const bf16* VM = (const bf16*)(F.ws + WS_VM);
    const unsigned short* AF = (const unsigned short*)(F.ws + WS_EA + 2 * EA_STRIDE); const unsigned short* AB = (const unsigned short*)(F.ws + WS_EA + 3 * EA_STRIDE);
    const bf16* YF = (const bf16*)(F.ws + WS_YF); const bf16* YB = (const bf16*)(F.ws + WS_YB); bf16* Z = (bf16*)(F.ws + WS_Z);
    const int sub = F.tid & 15; const int ngrp = F.G * 32;
    for (int gid = F.vcu * 32 + (F.tid >> 4); gid < NT * NH; gid += ngrp) {
        const int mrow = gid >> 5, h = gid & 31, c = h * 64 + 4 * sub; const size_t off = (size_t)mrow * D + c;
        const v2u yf = *(const v2u*)(YF + off), yb = *(const v2u*)(YB + off), lr = *(const v2u*)(RM + off), lk = *(const v2u*)(KM + off), lv = *(const v2u*)(VM + off), laf = *(const v2u*)(AF + off), lab = *(const v2u*)(AB + off);
        const f32x4 y = (f32x4){bflo(yf.x) + bflo(yb.x), bfhi(yf.x) + bfhi(yb.x), bflo(yf.y) + bflo(yb.y), bfhi(yf.y) + bfhi(yb.y)};
        const float mean = allred16((y.x + y.y) + (y.z + y.w)) * (1.0f / 64.0f); const f32x4 d = y - mean;
        const float var = allred16((d.x * d.x + d.y * d.y) + (d.z * d.z + d.w * d.w)) * (1.0f / 64.0f);
        const f32x4 yn = d * (1.0f / sqrtf(var + 64e-5f)) * *(const f32x4*)(a.in[I_LNW] + c) + *(const f32x4*)(a.in[I_LNB] + c);
        const f32x4 r = (f32x4){bflo(lr.x), bfhi(lr.x), bflo(lr.y), bfhi(lr.y)}, k = (f32x4){bflo(lk.x), bfhi(lk.x), bflo(lk.y), bfhi(lk.y)}, v = (f32x4){bflo(lv.x), bfhi(lv.x), bflo(lv.y), bfhi(lv.y)};
        const f32x4 asum = (f32x4){hlo(laf.x) + hlo(lab.x), hhi(laf.x) + hhi(lab.x), hlo(laf.y) + hlo(lab.y), hhi(laf.y) + hhi(lab.y)};
        const f32x4 ks = k * ((asum - 2.0f) * *(const f32x4*)(a.in[I_KA] + c) + 2.0f);
        const f32x4 t = r * ks * *(const f32x4*)(a.in[I_RK] + c);
        const float bon = allred16((t.x + t.y) + (t.z + t.w));
        const f32x4 z = yn + v * bon; v2u wv; wv.x = pk2(z.x, z.y); wv.y = pk2(z.z, z.w); *(v2u*)(Z + off) = wv;
    }
}
constexpr int RT_LD = 68;
__device__ __forceinline__ void p11_route(Frame& F, const Args& a) {
    for (int repa_ = 0, nrepa_ = opaque_n(1 + ((DUPMASK >> 16) & 1)); repa_ < nrepa_; ++repa_) {
        struct DecExp { const float* const* in; unsigned char* ws;
            __device__ __forceinline__ bool operator()(int it, TrJob& j) const {
                if (it < 0 || it >= 65 * 768) return false;
                const int e = it / 768, q = it % 768, which = q >> 8, r = q & 255;
                if (which < 2) { const float* src = (e < 64) ? (which == 0 ? in[I_EG] : in[I_EU]) + (size_t)e * D * DEXP : (which == 0 ? in[I_SG] : in[I_SU]);
                    const int kb = r >> 3, nb = r & 7, n0 = nb * 64;
                    j = TrJob{src, (bf16*)(ws + WS_GU) + (size_t)e * 1024 * D, DEXP, D, D, kb * 64, n0, (n0 >> 7) * 256 + which * 128 + (n0 & 127)}; }
                else { const float* src = (e < 64) ? in[I_ED] + (size_t)e * DEXP * D : in[I_SD];
                    const int kb = r >> 5, nb = r & 31; j = TrJob{src, (bf16*)(ws + WS_DT) + (size_t)e * D * DEXP, D, DEXP, DEXP, kb * 64, nb * 64, nb * 64}; }
                return true; } };
        DecExp dec{a.in, F.ws};
        tr_run(dec, F.vcu * 8 + F.wave, F.G * 8, (LAS unsigned*)(F.lds + F.wave * 16384), F.lane);
        __syncthreads();
    }
    const float* X1 = a.out; const float* MOD = (const float*)(F.ws + WS_MOD); bf16* H2 = (bf16*)(F.ws + WS_H2);
    LAS float* hs = (LAS float*)F.lds;
    LAS float* wsb = hs + 64 * RT_LD;
    LAS float* lg = wsb + 64 * RT_LD;
    LAS float* lg2 = lg + 64 * 65;
    LAS float* selb = lg2 + 64 * 65;
    LAS float* rs = selb + 64 * 65;
    LAS int* cnt = (LAS int*)(rs + 64);
    LAS int* basee = cnt + 64;
    LAS int* eloc = basee + 64;
    LAS int* rloc = eloc + 512;
    for (int tile = F.vcu; tile < NT / 64; tile += F.G) {
        const int t0 = tile * 64, b = t0 >> 12;
        const float* sh2 = MOD + (size_t)b * 12288 + 6144; const float* sc2 = MOD + (size_t)b * 12288 + 8192; const float* g2 = a.in[I_N2G];
        if (F.tid < 64) cnt[F.tid] = 0;
        for (int rr = 0; rr < 8; ++rr) { const int tl = F.wave * 8 + rr; const f32x4* xr = (const f32x4*)(X1 + (size_t)(t0 + tl) * D) + F.lane; f32x4 v[8]; float s = 0.f;
#pragma unroll
            for (int q = 0; q < 8; ++q) { v[q] = xr[64 * q]; s += (v[q].x * v[q].x + v[q].y * v[q].y) + (v[q].z * v[q].z + v[q].w * v[q].w); }
            const float rstd = 1.0f / sqrtf(wave_sum(s) * (1.0f / D) + 1e-6f); if (F.lane == 0) rs[tl] = rstd;
            v2u* o = (v2u*)(H2 + (size_t)(t0 + tl) * D) + F.lane;
#pragma unroll
            for (int q = 0; q < 8; ++q) { const f32x4 y = v[q] * rstd * ((const f32x4*)g2)[F.lane + 64 * q] * (((const f32x4*)sc2)[F.lane + 64 * q] + 1.0f) + ((const f32x4*)sh2)[F.lane + 64 * q];
                v2u w; w.x = pk2(y.x, y.y); w.y = pk2(y.z, y.w); o[64 * q] = w; } }
        __syncthreads();
        const int tg = F.tid & 15, eg = (F.tid >> 4) & 15, kh = F.tid >> 8;
        float acc[4][4];
#pragma unroll
        for (int i = 0; i < 4; ++i)
#pragma unroll
            for (int j = 0; j < 4; ++j) acc[i][j] = 0.f;
        const int stok = F.tid >> 3, sk8 = (F.tid & 7) * 8; const float rstd_s = rs[stok];
        for (int kc = 0; kc < D / 64; ++kc) {
            { const int k0 = kc * 64 + sk8; const float* xp = X1 + (size_t)(t0 + stok) * D + k0;
              const f32x4 x0 = *(const f32x4*)xp, x1v = *(const f32x4*)(xp + 4);
              const f32x4 ga = *(const f32x4*)(g2 + k0), gb = *(const f32x4*)(g2 + k0 + 4), ca = *(const f32x4*)(sc2 + k0), cb = *(const f32x4*)(sc2 + k0 + 4), ha = *(const f32x4*)(sh2 + k0), hb = *(const f32x4*)(sh2 + k0 + 4);
              const f32x4 y0 = x0 * rstd_s * ga * (ca + 1.0f) + ha, y1 = x1v * rstd_s * gb * (cb + 1.0f) + hb;
              hs[(sk8 + 0) * RT_LD + stok] = y0.x; hs[(sk8 + 1) * RT_LD + stok] = y0.y; hs[(sk8 + 2) * RT_LD + stok] = y0.z; hs[(sk8 + 3) * RT_LD + stok] = y0.w;
              hs[(sk8 + 4) * RT_LD + stok] = y1.x; hs[(sk8 + 5) * RT_LD + stok] = y1.y; hs[(sk8 + 6) * RT_LD + stok] = y1.z; hs[(sk8 + 7) * RT_LD + stok] = y1.w;
              const float* wp = a.in[I_RW] + (size_t)kc * 4096 + F.tid * 8; const f32x4 w0 = *(const f32x4*)wp, w1 = *(const f32x4*)(wp + 4);
              const int wk = F.tid >> 3, we = (F.tid & 7) * 8; *(LAS f32x4*)(wsb + wk * RT_LD + we) = w0; *(LAS f32x4*)(wsb + wk * RT_LD + we + 4) = w1; }
            __syncthreads();
#pragma unroll 8
            for (int k = kh * 32; k < kh * 32 + 32; ++k) { const f32x4 h4 = *(const LAS f32x4*)(hs + k * RT_LD + 4 * tg), w4 = *(const LAS f32x4*)(wsb + k * RT_LD + 4 * eg);
                acc[0][0] += h4.x * w4.x; acc[0][1] += h4.x * w4.y; acc[0][2] += h4.x * w4.z; acc[0][3] += h4.x * w4.w;
                acc[1][0] += h4.y * w4.x; acc[1][1] += h4.y * w4.y; acc[1][2] += h4.y * w4.z; acc[1][3] += h4.y * w4.w;
                acc[2][0] += h4.z * w4.x; acc[2][1] += h4.z * w4.y; acc[2][2] += h4.z * w4.z; acc[2][3] += h4.z * w4.w;
                acc[3][0] += h4.w * w4.x; acc[3][1] += h4.w * w4.y; acc[3][2] += h4.w * w4.z; acc[3][3] += h4.w * w4.w; }
            __syncthreads();
        }
        { LAS float* dstl = kh ? lg2 : lg;
#pragma unroll
          for (int i = 0; i < 4; ++i)
#pragma unroll
              for (int j = 0; j < 4; ++j) dstl[(4 * tg + i) * 65 + 4 * eg + j] = acc[i][j]; }
        __syncthreads();
        for (int idx = F.tid; idx < 4096; idx += 512) { const int tl = idx >> 6, e = idx & 63; const float sc = sigmoidf_(lg[tl * 65 + e] + lg2[tl * 65 + e]); lg[tl * 65 + e] = sc; selb[tl * 65 + e] = sc + a.in[I_RB][e]; }
        __syncthreads();
        if (F.tid < 64) {
            const int tl = F.tid; LAS float* sel = selb + tl * 65; const LAS float* scr = lg + tl * 65;
            float gs[8];
#pragma unroll
            for (int g = 0; g < 8; ++g) { float m1 = -INFINITY, m2 = -INFINITY;
#pragma unroll
                for (int j = 0; j < 8; ++j) { const float v = sel[g * 8 + j]; if (v > m1) { m2 = m1; m1 = v; } else if (v > m2) m2 = v; }
                gs[g] = m1 + m2; }
            unsigned gmask = 0u;
#pragma unroll
            for (int it = 0; it < 4; ++it) { float best = -INFINITY; int bi = 0;
#pragma unroll
                for (int g = 0; g < 8; ++g) { const bool ok = !((gmask >> g) & 1u) && gs[g] > best; best = ok ? gs[g] : best; bi = ok ? g : bi; }
                gmask |= 1u << bi; }
            for (int g = 0; g < 8; ++g) if (!((gmask >> g) & 1u)) { for (int j = 0; j < 8; ++j) sel[g * 8 + j] = -INFINITY; }
            float wv[8]; int ev[8]; float wsum = 0.f;
#pragma unroll
            for (int it = 0; it < 8; ++it) { float best = -INFINITY; int bi = 0;
                for (int e = 0; e < 64; ++e) { const float v = sel[e]; if (v > best) { best = v; bi = e; } }
                sel[bi] = -INFINITY; ev[it] = bi; wv[it] = scr[bi]; wsum += wv[it]; }
            const float inv = 2.5f / wsum;
#pragma unroll
            for (int it = 0; it < 8; ++it) { const int lr = atomicAdd((int*)&cnt[ev[it]], 1); eloc[tl * 8 + it] = ev[it]; rloc[tl * 8 + it] = lr;
                ((float*)(F.ws + WS_WSEL))[(size_t)(t0 + tl) * 8 + it] = wv[it] * inv; }
        }
        __syncthreads();
        if (F.tid < 64) basee[F.tid] = (int)__hip_atomic_fetch_add(F.ctl + CW_GCNT + F.tid, (unsigned)cnt[F.tid], __ATOMIC_RELAXED, __HIP_MEMORY_SCOPE_AGENT);
        __syncthreads();
        { const int e = eloc[F.tid]; ((int*)(F.ws + WS_EIDX))[(size_t)t0 * 8 + F.tid] = e; ((int*)(F.ws + WS_RANK))[(size_t)t0 * 8 + F.tid] = basee[e] + rloc[F.tid]; }
        __syncthreads();
    }
}
__device__ __forceinline__ int moe_tables(Frame& F) {
    LAS int* te = (LAS int*)(F.lds + TAB_OFF); LAS int* off = te + MAXTILES;
    if (F.tid == 0) { int o = 0; for (int e = 0; e < 64; ++e) { off[e] = o; const int c = (int)__hip_atomic_load(F.ctl + CW_GCNT + e, __ATOMIC_RELAXED, __HIP_MEMORY_SCOPE_AGENT); o += (c + 255) & ~255; } off[64] = o; off[65] = o / 256 + NT / 256; }
    __syncthreads();
    const int ntiles = off[65];
    for (int rt = F.tid; rt < ntiles; rt += 512) { int e = 0; for (int j = 1; j <= 64; ++j) if (rt * 256 >= off[j]) e = j; te[rt] = e; }
    __syncthreads();
    return ntiles;
}
__device__ __forceinline__ void p12_slots(Frame& F) {
    (void)moe_tables(F);
    const LAS int* off = (const LAS int*)(F.lds + TAB_OFF) + MAXTILES;
    int* tok = (int*)(F.ws + WS_TOK); int* dst = (int*)(F.ws + WS_DST); float* wsl = (float*)(F.ws + WS_WSL);
    const int* eidx = (const int*)(F.ws + WS_EIDX); const int* rank = (const int*)(F.ws + WS_RANK); const float* wsel = (const float*)(F.ws + WS_WSEL);
    const int gt = F.vcu * 512 + F.tid, NGT = F.G * 512;
    for (int i = gt; i < NT * 8; i += NGT) { const int t = i >> 3, k = i & 7; const int slot = off[eidx[i]] + rank[i]; tok[slot] = t; dst[slot] = t * 9 + k; wsl[slot] = wsel[i]; }
    const int o64 = off[64];
    for (int t = gt; t < NT; t += NGT) { const int slot = o64 + t; tok[slot] = t; dst[slot] = t * 9 + 8; wsl[slot] = 1.0f; }
}
__device__ __forceinline__ void p15_final(Frame& F, const Args& a) {
    const int gw = F.vcu * 8 + F.wave, NGW = F.G * 8; const float* MOD = (const float*)(F.ws + WS_MOD); const bf16* YP = (const bf16*)(F.ws + WS_YP);
    for (int t = gw; t < NT; t += NGW) {
        const int b = t >> 12; const f32x4* gt2 = (const f32x4*)(MOD + (size_t)b * 12288 + 10240) + F.lane; const f32x4* fg = (const f32x4*)a.in[I_FG] + F.lane;
        f32x4* xr = (f32x4*)(a.out + (size_t)t * D) + F.lane; f32x4 v[8]; float s = 0.f;
#pragma unroll
        for (int q = 0; q < 8; ++q) { f32x4 m = (f32x4){0.f, 0.f, 0.f, 0.f};
#pragma unroll
            for (int j = 0; j < 9; ++j) { const v2u y = *((const v2u*)(YP + (size_t)(t * 9 + j) * D) + F.lane + 64 * q); m += (f32x4){bflo(y.x), bfhi(y.x), bflo(y.y), bfhi(y.y)}; }
            v[q] = xr[64 * q] + gt2[64 * q] * m; s += (v[q].x * v[q].x + v[q].y * v[q].y) + (v[q].z * v[q].z + v[q].w * v[q].w); }
        const float rstd = 1.0f / sqrtf(wave_sum(s) * (1.0f / D) + 1e-6f);
#pragma unroll
        for (int q = 0; q < 8; ++q) xr[64 * q] = v[q] * rstd * fg[64 * q];
    }
}
#ifndef MK_ONE_LAUNCH
#define MK_ONE_LAUNCH 1
#endif
constexpr int NPHASE = 16;
__global__ void __launch_bounds__(512, 2) mk_fwd(Args args) {
    extern __shared__ __attribute__((aligned(16))) unsigned char lds[];
    Frame F;
    F.lds = (LAS unsigned char*)lds; F.MISC = (volatile LAS unsigned*)(F.lds + LDSCTL_OFF);
    int wave0 = __builtin_amdgcn_readfirstlane((int)threadIdx.x >> 6); asm volatile("" : "+s"(wave0));
    F.tid = threadIdx.x; F.lane = F.tid & 63; F.wave = wave0;
    F.G = gridDim.x; { const int bx = blockIdx.x; F.vcu = (F.G % 8 == 0) ? (bx % 8) * (F.G / 8) + bx / 8 : bx; }
    F.ws = args.ws; F.ctl = (unsigned*)(args.ws + WS_CTL);
    for (int u = F.tid; u < 256; u += 512) ((LAS unsigned*)(F.lds + LDSCTL_OFF))[u] = 0u;
    __syncthreads();
    XcdBarrier bar; bar.bar = F.ctl + CW_BAR; bar.x = 0; bar.st = nullptr;
    if (MK_ONE_LAUNCH) bar = xcd_barrier_post(F.ctl + CW_BAR, F.MISC + 8);
    const int lo = args.ph_lo, hi = args.ph_hi;
#ifndef PHMASK
#define PHMASK 0xFFFF
#endif
#define IN(k) (((PHMASK >> (k)) & 1) && lo <= (k) && (k) < hi)
#ifndef DUPMASK
#define DUPMASK 0
#endif
#define DUP(k) for (int rep_ = 0, nrep_ = opaque_n(1 + ((DUPMASK >> (k)) & 1)); rep_ < nrep_; ++rep_)
#define FRESH() do { int l_ = (int)__builtin_amdgcn_mbcnt_hi(~0u, __builtin_amdgcn_mbcnt_lo(~0u, 0u)); asm volatile("" : "+v"(l_)); int w_ = wave0; asm volatile("" : "+s"(w_)); F.lane = l_; F.wave = w_; F.tid = w_ * 64 + l_; } while (0)
#define SEAM(k) do { if (MK_ONE_LAUNCH) { if (IN(k) && IN((k) + 1)) { xcd_barrier(bar); if ((DUPMASK >> 18) & 1) xcd_barrier(bar); } } } while (0)
    const int G = F.G, c = (int)blockIdx.x;
    unsigned char* ws = args.ws;

    if (IN(0)) DUP(0) { FRESH(); p0_prologue(F, args); } SEAM(0);
    if (IN(1)) DUP(1) { FRESH(); p1_norm1(F, args); } SEAM(1);
    if (IN(2)) DUP(2) { FRESH();
        G1Order S{(const char*)(ws + WS_HA), (const char*)(ws + WS_WIN), (size_t)256 * D * 2, (size_t)256 * D * 2, G, c};
        EpiG1 E{(bf16*)(ws + WS_U), (bf16*)(ws + WS_SLAB), (bf16*)(ws + WS_GATES)};
        pg8::gemm_phase<EpiG1, G1Order, false>(F.lds + RING_OFF, F.wave, D, D, D, S, E);
    } SEAM(2);
    if (IN(3)) DUP(3) { FRESH(); p3_prep(F, args); } SEAM(3);
    if (IN(4)) DUP(4) { FRESH();
#ifndef NO4A
        {
            RepOrder S{(const char*)(ws + WS_LIN), (const char*)(ws + WS_LORA), (size_t)128 * 2, (size_t)D * 128 * 2, (size_t)256 * LINLD * 2, (size_t)256 * 128 * 2, MT / 256, D / 256, 4, G, c};
            EpiLora E{(unsigned short*)(ws + WS_EA), args.in[I_DW0], args.in[I_IA0]};
            pg8::gemm_phase<EpiLora, RepOrder, false>(F.lds + RING_OFF, F.wave, 128, LINLD, 128, S, E);
        }
#endif
    }
    if (IN(4)) DUP(4) { FRESH();
#ifndef NO4B
        {
            RepOrder S{(const char*)(ws + WS_DP), (const char*)(ws + WS_POOLW), (size_t)256 * 2, (size_t)256 * 256 * 2, (size_t)256 * 1024 * 2, (size_t)256 * 256 * 2, NT / 256, 1, 4, G, c};
            EpiPoolG E{(bf16*)(ws + WS_Y2), args.in[I_POOLS]};
            pg8::gemm_phase<EpiPoolG, RepOrder, false>(F.lds + RING_OFF, F.wave, 256, 1024, 256, S, E);
        }
#endif
    } SEAM(4);
    if (IN(5)) DUP(5) { FRESH();
        RepOrder S{(const char*)(ws + WS_Y2), (const char*)(ws + WS_WPO), 0, 0, (size_t)256 * 1024 * 2, (size_t)256 * 1024 * 2, NT / 256, D / 256, 1, G, c};
        EpiMix<0> E{(bf16*)(ws + WS_MP), D, (const bf16*)(ws + WS_GATES), 4096, nullptr, 0};
        pg8::gemm_phase<EpiMix<0>, RepOrder, false>(F.lds + RING_OFF, F.wave, 1024, 1024, 1024, S, E);
    } SEAM(5);
    if (IN(6)) DUP(6) { FRESH(); p6_scan(F, args); } SEAM(6);
    if (IN(7)) DUP(7) { FRESH(); p7_readout(F, args); } SEAM(7);
    if (IN(8)) DUP(8) { FRESH();
        RepOrder S{(const char*)(ws + WS_LIN) + 512 * 2, (const char*)(ws + WS_G2), 0, 0, (size_t)256 * LINLD * 2, (size_t)256 * 256 * 2, NT / 256, D / 256, 1, G, c};
        EpiMix<1> E{(bf16*)(ws + WS_OR), D, (const bf16*)(ws + WS_Z), D, nullptr, 0};
        pg8::gemm_phase<EpiMix<1>, RepOrder, false>(F.lds + RING_OFF, F.wave, 256, LINLD, 256, S, E);
    } SEAM(8);
    if (IN(9)) DUP(9) { FRESH();
        RepOrder S{(const char*)(ws + WS_OR), (const char*)(ws + WS_WRO), 0, 0, (size_t)256 * D * 2, (size_t)256 * D * 2, NT / 256, D / 256, 1, G, c};
        EpiMix<2> E{(bf16*)(ws + WS_Z), D, (const bf16*)(ws + WS_GATES) + 2048, 4096, (const bf16*)(ws + WS_MP), D};
        pg8::gemm_phase<EpiMix<2>, RepOrder, false>(F.lds + RING_OFF, F.wave, D, D, D, S, E);
    } SEAM(9);
    if (IN(10)) DUP(10) { FRESH();
        RepOrder S{(const char*)(ws + WS_Z), (const char*)(ws + WS_WO), 0, 0, (size_t)256 * D * 2, (size_t)256 * D * 2, NT / 256, D / 256, 1, G, c};
        EpiX1 E{args.in[I_X], args.out, (const float*)(ws + WS_MOD)};
        pg8::gemm_phase<EpiX1, RepOrder, false>(F.lds + RING_OFF, F.wave, D, D, D, S, E);
    } SEAM(10);
    if (IN(11)) DUP(11) { FRESH(); p11_route(F, args); } SEAM(11);
    if (IN(12)) DUP(12) { FRESH(); p12_slots(F); } SEAM(12);
    if (IN(13)) DUP(13) { FRESH();
        const int ntiles = moe_tables(F);
        MoeOrder S{(const char*)(ws + WS_H2), (const char*)(ws + WS_GU), (const LAS int*)(F.lds + TAB_OFF), (const int*)(ws + WS_TOK), 0, (size_t)1024 * D * 2, (size_t)256 * D * 2, ntiles, 4, G, c};
        EpiAct E{(bf16*)(ws + WS_ACT)};
        pg8::gemm_phase<EpiAct, MoeOrder, true>(F.lds + RING_OFF, F.wave, D, D, D, S, E);
    } SEAM(13);
    if (IN(14)) DUP(14) { FRESH();
        const int ntiles = moe_tables(F);
        MoeOrder S{(const char*)(ws + WS_ACT), (const char*)(ws + WS_DT), (const LAS int*)(F.lds + TAB_OFF), (const int*)(ws + WS_TOK), (size_t)256 * DEXP * 2, (size_t)D * DEXP * 2, (size_t)256 * DEXP * 2, ntiles, 8, G, c};
        EpiDown E{(bf16*)(ws + WS_YP), (const int*)(ws + WS_DST), (const float*)(ws + WS_WSL)};
        pg8::gemm_phase<EpiDown, MoeOrder, false>(F.lds + RING_OFF, F.wave, DEXP, DEXP, DEXP, S, E);
    } SEAM(14);
    if (IN(15)) DUP(15) { FRESH(); p15_final(F, args); }
#undef IN
#undef SEAM
}

extern "C" void kernel_launch(void* const* d_in, const int* in_sizes, int n_in, void* d_out, int out_size, void* d_ws, size_t ws_size, hipStream_t stream) {
    static int grid = 0;
    if (grid == 0) {
        if (n_in != 34 || in_sizes[0] != NT * D || out_size != NT * D || ws_size < WS_END) { fprintf(stderr, "kernel_launch: unexpected shapes (n_in %d, in0 %d, out %d, ws %zu < %zu)\n", n_in, n_in > 0 ? in_sizes[0] : -1, out_size, ws_size, (size_t)WS_END); grid = -1; return; }
        int dev = 0, cus = 0, per_cu = 0;
        if (hipGetDevice(&dev) != hipSuccess || hipDeviceGetAttribute(&cus, hipDeviceAttributeMultiprocessorCount, dev) != hipSuccess) { grid = -1; return; }
        if (hipFuncSetAttribute((const void*)mk_fwd, hipFuncAttributeMaxDynamicSharedMemorySize, LDS_BYTES) != hipSuccess) { fprintf(stderr, "kernel_launch: hipFuncSetAttribute failed\n"); grid = -1; return; }
        if (hipOccupancyMaxActiveBlocksPerMultiprocessor(&per_cu, (const void*)mk_fwd, 512, LDS_BYTES) != hipSuccess || per_cu < 1) fprintf(stderr, "kernel_launch: occupancy query reports %d\n", per_cu);
        (void)hipGetLastError();
        grid = cus;
    }
    if (grid < 0) return;
    if (hipMemsetAsync((char*)d_ws + WS_CTL, 0, CTL_ZERO_BYTES, stream) != hipSuccess) return;
    Args a{};
    for (int i = 0; i < 34; ++i) a.in[i] = (const float*)d_in[i];
    a.out = (float*)d_out; a.ws = (unsigned char*)d_ws;
#if MK_ONE_LAUNCH
    a.ph_lo = 0; a.ph_hi = NPHASE;
    hipLaunchKernelGGL(mk_fwd, dim3(grid), dim3(512), LDS_BYTES, stream, a);
#else
    for (int p = 0; p < NPHASE; ++p) { a.ph_lo = p; a.ph_hi = p + 1; hipLaunchKernelGGL(mk_fwd, dim3(grid), dim3(512), LDS_BYTES, stream, a); }
#endif
}
```

```cpp
#include <hip/hip_runtime.h>
#include <cstdio>
#include <cstdint>
#ifndef DUPMASK
#define DUPMASK 0x0
#endif
#ifndef PROBE_PHASE
#define PROBE_PHASE -1
#endif

#define GAS __attribute__((address_space(1)))
#define LAS __attribute__((address_space(3)))
typedef unsigned short bf16;
typedef unsigned v4u __attribute__((ext_vector_type(4)));
typedef unsigned v2u __attribute__((ext_vector_type(2)));
typedef float f32x4 __attribute__((ext_vector_type(4)));
typedef float f32x2 __attribute__((ext_vector_type(2)));
typedef short bf16x8 __attribute__((ext_vector_type(8)));

constexpr int D = 2048, NB = 4, TSEQ = 4096, NT = NB * TSEQ  , CTXL = 256, NC = NB * CTXL  , MT = NT + NC  ;
constexpr int DIN = 11904, DSH = 6784, NPAD = 12032, SLABLD = 6912, NH = 32, HS = 64;
constexpr int NEXP = 64, DEXP = 512, TOPK = 8;
constexpr int NSLOT = NT * TOPK + NEXP * 256 + NT;
constexpr int MAXTILES = NSLOT / 256;
constexpr int LINLD = 768;

__device__ __forceinline__ int opaque_n(int n) { asm volatile("" : "+s"(n)); return n; }
__device__ __forceinline__ unsigned f2bf(float f) { unsigned u = __builtin_bit_cast(unsigned, f); return (u + 0x7fffu + ((u >> 16) & 1u)) >> 16; }
typedef __bf16 bf16x2_t __attribute__((ext_vector_type(2)));
__device__ __forceinline__ unsigned pk2(float lo, float hi) { const f32x2 v = {lo, hi}; const bf16x2_t b = __builtin_convertvector(v, bf16x2_t); return __builtin_bit_cast(unsigned, b); }
__device__ __forceinline__ float bflo(unsigned w) { return __builtin_bit_cast(float, w << 16); }
__device__ __forceinline__ float bfhi(unsigned w) { return __builtin_bit_cast(float, w & 0xffff0000u); }
__device__ __forceinline__ unsigned pkh2(float lo, float hi) { const unsigned short a = __builtin_bit_cast(unsigned short, (_Float16)lo), b = __builtin_bit_cast(unsigned short, (_Float16)hi); return (unsigned)a | ((unsigned)b << 16); }
__device__ __forceinline__ float hlo(unsigned w) { return (float)__builtin_bit_cast(_Float16, (unsigned short)(w & 0xffffu)); }
__device__ __forceinline__ float hhi(unsigned w) { return (float)__builtin_bit_cast(_Float16, (unsigned short)(w >> 16)); }
__device__ __forceinline__ float sigmoidf_(float x) { return __builtin_amdgcn_rcpf(1.0f + __builtin_amdgcn_exp2f(-1.44269504f * x)); }
__device__ __forceinline__ float tanhf_(float x) { return 1.0f - 2.0f * __builtin_amdgcn_rcpf(1.0f + __builtin_amdgcn_exp2f(2.88539008f * x)); }
__device__ __forceinline__ float wave_sum(float v) {
#pragma unroll
    for (int o = 1; o < 64; o <<= 1) v += __shfl_xor(v, o);
    return v;
}
__device__ __forceinline__ float dpp_f(float v, const int ctrl_sel) {
    int r;
    const int x = __builtin_bit_cast(int, v);
    if (ctrl_sel == 0) r = __builtin_amdgcn_update_dpp(0, x, 0xB1, 0xF, 0xF, true);
    else if (ctrl_sel == 1) r = __builtin_amdgcn_update_dpp(0, x, 0x4E, 0xF, 0xF, true);
    else if (ctrl_sel == 2) r = __builtin_amdgcn_update_dpp(0, x, 0x141, 0xF, 0xF, true);
    else r = __builtin_amdgcn_update_dpp(0, x, 0x140, 0xF, 0xF, true);
    return __builtin_bit_cast(float, r);
}
__device__ __forceinline__ float allred16(float v) { v += dpp_f(v, 0); v += dpp_f(v, 1); v += dpp_f(v, 2); v += dpp_f(v, 3); return v; }

#define LDS_WAIT() asm volatile("s_waitcnt lgkmcnt(0)" ::: "memory")
#define VM_WAIT() asm volatile("s_waitcnt vmcnt(0)" ::: "memory")

namespace pg8 {
constexpr int BM = 256, BK = 64, HALF = 128, HTB = HALF * BK * 2, STAGE_BYTES = 8 * HTB, NXCD = 8, WGM = 8;
__host__ __device__ __forceinline__ int lds_byte(int r, int c) { const int st = (r >> 4) * 2 + (c >> 5), rr = r & 15, cc = c & 31, ob = rr * 64 + cc * 2; return st * 1024 + (ob ^ (((ob >> 9) & 1) << 5)); }
__host__ __device__ __forceinline__ void stage_rc(int b, int& R, int& C) { const int st = b / 1024, sb = b % 1024, swz = sb ^ (((sb >> 9) & 1) << 5); R = (st >> 1) * 16 + swz / 64; C = (st & 1) * 32 + (swz % 64) / 2; }
__host__ __device__ __forceinline__ int perm32(int rho) { const int n = rho >> 4, i = rho & 15; return 8 * (i >> 2) + 4 * n + (i & 3); }
struct Unit { const char* A; const char* B; int pm, pn, aux, ui; };
__device__ __forceinline__ int xcd_remap(int L, int nwg) { const int q = nwg / NXCD, r = nwg % NXCD, xcd = L % NXCD, off = L / NXCD; return (xcd < r ? xcd * (q + 1) : r * (q + 1) + (xcd - r) * q) + off; }
__device__ __forceinline__ void grid_tile(int wgid, int nM, int nN, int& pm, int& pn) { const int nig = WGM * nN, gid = wgid / nig, fm = gid * WGM, gsz = (nM - fm) < WGM ? (nM - fm) : WGM; pm = fm + ((wgid % nig) % gsz); pn = (wgid % nig) / gsz; }

__device__ __forceinline__ void stage2(LAS unsigned char* lds, int bufoff, unsigned ldsw, const char* g, unsigned o0, unsigned o1) {
    __builtin_amdgcn_global_load_lds((const unsigned*)(g + o0), (LAS unsigned*)(lds + bufoff + ldsw), 16, 0, 0);
    __builtin_amdgcn_global_load_lds((const unsigned*)(g + o1), (LAS unsigned*)(lds + bufoff + ldsw + 8192), 16, 0, 0);
}

template <class Epi, class = void> struct EpiPerm16 { static constexpr bool value = false; };
template <class Epi> struct EpiPerm16<Epi, decltype((void)Epi::PERM16)> { static constexpr bool value = Epi::PERM16; };
template <class Epi> __host__ __device__ constexpr bool epi_perm16() { return EpiPerm16<Epi>::value; }
template <class Epi> __host__ __device__ __forceinline__ int perm_row(int R) {
    if (epi_perm16<Epi>()) { const int wc = R >> 5, rho = R & 31, n = rho >> 4, i = rho & 15; return 64 * wc + 16 * (i >> 2) + 4 * n + (i & 3); }
    return Epi::PERM ? ((R & ~31) + perm32(R & 31)) : R;
}
template <class Epi, class Sched, bool GATHER, bool ALIGN_EPI = true>
__device__ __forceinline__ void gemm_phase(LAS unsigned char* lds, const int wave_, const int K, const int lda, const int ldb, const Sched& S, const Epi& E) {
    int tid_ = wave_ * 64 + (int)__builtin_amdgcn_mbcnt_hi(~0u, __builtin_amdgcn_mbcnt_lo(~0u, 0u)); asm volatile("" : "+v"(tid_));
    const int tid = tid_, wid = __builtin_amdgcn_readfirstlane(tid >> 6), lane = tid & 63, wr = wid >> 2, wc = wid & 3, fr = lane & 15, fq = lane >> 4;
    const int nt = opaque_n(K / BK);
    unsigned voffA[2], voffB[2]; int RA[2], CA[2];
#pragma unroll
    for (int i = 0; i < 2; ++i) { int R, C; stage_rc(tid * 16 + i * 8192, R, C); const int Rb = perm_row<Epi>(R);
        RA[i] = R; CA[i] = C; voffA[i] = (unsigned)(R * lda + C) * 2u; voffB[i] = (unsigned)(Rb * ldb + C) * 2u; }
    const size_t kstep = (size_t)(BK * 2);
    const size_t hstepA = (size_t)HALF * lda * 2, hstepB = (size_t)(epi_perm16<Epi>() ? 8 : HALF) * ldb * 2;
    const unsigned ldsw = (unsigned)wid * 1024u;
    const int aoff = lds_byte(wr * 64 + fr, fq * 8), boff = lds_byte(wc * 32 + fr, fq * 8);
#define PG8_SA(b, h) (((b) * 2 + (h)) * HTB)
#define PG8_SB(b, h) ((4 + (b) * 2 + (h)) * HTB)
#define PG8_STB(bufoff, gbase) stage2(lds, (bufoff), ldsw, (gbase), voffB[0], voffB[1])
#define PG8_STA(bufoff, gk, h, NX) do { if constexpr (GATHER) { const unsigned _o0 = (NX) ? vn[h][0] : vc[h][0], _o1 = (NX) ? vn[h][1] : vc[h][1]; stage2(lds, (bufoff), ldsw, (gk), _o0, _o1); } \
        else stage2(lds, (bufoff), ldsw, (gk) + (h) * hstepA, voffA[0], voffA[1]); } while (0)
#define PG8_LDA(dst, b, h) do { _Pragma("unroll") for (int m = 0; m < 4; ++m) _Pragma("unroll") for (int k = 0; k < 2; ++k) dst[m][k] = *(const LAS bf16x8*)(lds + PG8_SA(b, h) + aoff + m * 2048 + k * 1024); } while (0)
#define PG8_LDB(dst, b, h) do { _Pragma("unroll") for (int n = 0; n < 2; ++n) _Pragma("unroll") for (int k = 0; k < 2; ++k) dst[n][k] = *(const LAS bf16x8*)(lds + PG8_SB(b, h) + boff + n * 2048 + k * 1024); } while (0)
#define PG8_MMA(ai, bj, At, Bt) do { __builtin_amdgcn_s_setprio(1); _Pragma("unroll") for (int m = 0; m < 4; ++m) _Pragma("unroll") for (int n = 0; n < 2; ++n) _Pragma("unroll") for (int k = 0; k < 2; ++k) \
        acc[ai][bj][m][n] = __builtin_amdgcn_mfma_f32_16x16x32_bf16(Bt[n][k], At[m][k], acc[ai][bj][m][n], 0, 0, 0); __builtin_amdgcn_s_setprio(0); } while (0)
#define PG8_WAIT_V(n) asm volatile("s_waitcnt vmcnt(" #n ")" ::: "memory")
#define PG8_WAIT_L(n) asm volatile("s_waitcnt lgkmcnt(" #n ")" ::: "memory")
#define PG8_BAR __builtin_amdgcn_s_barrier()
#define PG8_SCHED __builtin_amdgcn_sched_barrier(0)
    Unit cur, nxt; int ui = 0;
    if (!S.next(0, cur)) return;
    unsigned vc[2][2], vn[2][2];
    if constexpr (GATHER) {
#pragma unroll
        for (int h = 0; h < 2; ++h)
#pragma unroll
            for (int i = 0; i < 2; ++i) { vc[h][i] = ((unsigned)S.row(cur, h * HALF + RA[i]) * (unsigned)lda + (unsigned)CA[i]) * 2u; vn[h][i] = vc[h][i]; }
        if constexpr (!Sched::ROW_LDS) asm volatile("s_waitcnt vmcnt(0)" ::: "memory");
    }
    f32x4 acc[2][2][4][2];
#pragma unroll
    for (int a = 0; a < 2; ++a)
#pragma unroll
        for (int b = 0; b < 2; ++b)
#pragma unroll
            for (int m = 0; m < 4; ++m)
#pragma unroll
                for (int n = 0; n < 2; ++n) acc[a][b][m][n] = (f32x4){0.f, 0.f, 0.f, 0.f};
    bf16x8 At[4][2], B0[2][2], B1[2][2];
    const char* cA = cur.A; const char* cB = cur.B;
    PG8_STB(PG8_SB(0, 0), cB); PG8_STB(PG8_SB(0, 1), cB + hstepB); PG8_STA(PG8_SA(0, 0), cA, 0, false); PG8_STA(PG8_SA(0, 1), cA, 1, false);
    if (wr == 1) PG8_BAR;
    PG8_WAIT_V(2); PG8_BAR;
    PG8_STB(PG8_SB(1, 0), cB + kstep); PG8_STA(PG8_SA(1, 0), cA + kstep, 0, false); PG8_STB(PG8_SB(1, 1), cB + hstepB + kstep);
    PG8_WAIT_V(6); PG8_BAR;
    for (;;) {
        const bool has_next = S.next(ui + 1, nxt);
        const char* nA = has_next ? nxt.A : cA; const char* nB = has_next ? nxt.B : cB;
#pragma unroll 1
        for (int t = 0; t < nt; t += 2) {
            const bool last = (t == nt - 2);
            const char* a1 = cA + (size_t)(t + 1) * kstep;
            const char* a2 = last ? nA : cA + (size_t)(t + 2) * kstep; const char* b2 = last ? nB : cB + (size_t)(t + 2) * kstep;
            const char* a3 = a2 + kstep; const char* b3 = b2 + kstep;
            if constexpr (GATHER) {
                if (last && has_next) {
#pragma unroll
                    for (int h = 0; h < 2; ++h)
#pragma unroll
                        for (int i = 0; i < 2; ++i) vn[h][i] = ((unsigned)S.row(nxt, h * HALF + RA[i]) * (unsigned)lda + (unsigned)CA[i]) * 2u;
                    if constexpr (!Sched::ROW_LDS) asm volatile("s_waitcnt vmcnt(0)" ::: "memory");
                }
            }
            PG8_LDB(B0, 0, 0); PG8_LDB(B1, 0, 1); PG8_SCHED; PG8_LDA(At, 0, 0); PG8_STA(PG8_SA(1, 1), a1, 1, false);
            PG8_WAIT_V(8); PG8_WAIT_L(0); PG8_BAR; PG8_MMA(0, 0, At, B0); PG8_MMA(0, 1, At, B1); PG8_BAR; PG8_SCHED;
            PG8_LDA(At, 0, 1); PG8_STB(PG8_SB(0, 0), b2); PG8_STB(PG8_SB(0, 1), b2 + hstepB); PG8_STA(PG8_SA(0, 0), a2, 0, last);
            PG8_WAIT_V(8); PG8_WAIT_L(0); PG8_BAR; PG8_MMA(1, 0, At, B0); PG8_MMA(1, 1, At, B1); PG8_BAR; PG8_SCHED;
            PG8_LDB(B0, 1, 0); PG8_LDB(B1, 1, 1); PG8_SCHED; PG8_LDA(At, 1, 0); PG8_STA(PG8_SA(0, 1), a2, 1, last);
            PG8_WAIT_V(8); PG8_WAIT_L(0); PG8_BAR; PG8_MMA(0, 0, At, B0); PG8_MMA(0, 1, At, B1); PG8_BAR; PG8_SCHED;
            PG8_LDA(At, 1, 1); PG8_STB(PG8_SB(1, 0), b3); PG8_STB(PG8_SB(1, 1), b3 + hstepB); PG8_STA(PG8_SA(1, 0), a3, 0, last);
            PG8_WAIT_V(8); PG8_WAIT_L(0); PG8_BAR; PG8_MMA(1, 0, At, B0); PG8_MMA(1, 1, At, B1); PG8_BAR; PG8_SCHED;
        }
        if constexpr (ALIGN_EPI) { if (wr == 0) PG8_BAR; }
        { int fr_ = fr, fq_ = fq; asm volatile("" : "+v"(fr_), "+v"(fq_));
          E(acc, cur, wr, wc, fr_, fq_); }
        if (!has_next) break;
#pragma unroll
        for (int a = 0; a < 2; ++a)
#pragma unroll
            for (int b = 0; b < 2; ++b)
#pragma unroll
                for (int m = 0; m < 4; ++m)
#pragma unroll
                    for (int n = 0; n < 2; ++n) acc[a][b][m][n] = (f32x4){0.f, 0.f, 0.f, 0.f};
        cur = nxt; cA = nA; cB = nB; ++ui;
        if constexpr (GATHER) {
#pragma unroll
            for (int h = 0; h < 2; ++h)
#pragma unroll
                for (int i = 0; i < 2; ++i) vc[h][i] = vn[h][i];
        }
        if constexpr (ALIGN_EPI) { if (wr == 1) PG8_BAR; }
    }
    PG8_WAIT_V(0);
    if constexpr (!ALIGN_EPI) { if (wr == 0) PG8_BAR; }
    PG8_BAR;
#undef PG8_SA
#undef PG8_SB
#undef PG8_STB
#undef PG8_STA
#undef PG8_LDA
#undef PG8_LDB
#undef PG8_MMA
#undef PG8_WAIT_V
#undef PG8_WAIT_L
#undef PG8_BAR
#undef PG8_SCHED
}
}
#define XB_TMO      128
#define XB_XCNT(j)  (256  + 64 * (j))
#define XB_XSUB(j)  (1280 + 64 * (j))
#define XB_XGEN(j)  (2304 + 64 * (j))
#define XB_TOP      3328
#define XB_TOPGEN   3392
#define XCD_BAR_WORDS 3456
#define XB_SPIN_CAP (1u << 18)
__device__ __forceinline__ unsigned xb_ld(unsigned* p)              { return __hip_atomic_load(p, __ATOMIC_RELAXED, __HIP_MEMORY_SCOPE_AGENT); }
__device__ __forceinline__ unsigned xb_add(unsigned* p, unsigned v) { return __hip_atomic_fetch_add(p, v, __ATOMIC_RELAXED, __HIP_MEMORY_SCOPE_AGENT); }
__device__ __forceinline__ unsigned xb_xcc_id() { return (unsigned)__builtin_amdgcn_s_getreg((3 << 11) | 20) & 0xFu; }
#define XB_SPIN(cond, bar) do { unsigned _sp = 0; while (cond) { __builtin_amdgcn_s_sleep(1); \
    if ((++_sp & 255u) == 0u) { if (xb_ld(&(bar)[XB_TMO])) break; if (_sp > XB_SPIN_CAP) { atomicAdd(&(bar)[XB_TMO], 1u); break; } } } } while (0)
struct XcdBarrier { unsigned* bar; unsigned x; volatile LAS unsigned* st; };
__device__ __forceinline__ XcdBarrier xcd_barrier_post(unsigned* bar, volatile LAS unsigned* st) {
    XcdBarrier b; b.bar = bar; b.x = xb_xcc_id(); b.st = st;
    if (threadIdx.x == 0) (void)xb_add(&bar[XB_XCNT(b.x)], 1u);
    return b;
}
__device__ __forceinline__ void xcd_barrier_complete(unsigned* bar, unsigned x, unsigned& nloc, unsigned& nx) {
    const unsigned G = gridDim.x * gridDim.y * gridDim.z;
    unsigned sum, cnt, mine, sp = 0u;
    for (;;) {
        sum = 0u; cnt = 0u; mine = 0u;
#pragma unroll
        for (unsigned j = 0; j < 16; ++j) { const unsigned c = xb_ld(&bar[XB_XCNT(j)]); sum += c; cnt += (c > 0u) ? 1u : 0u; mine = (j == x) ? c : mine; }
        if (sum == G) break;
        __builtin_amdgcn_s_sleep(1);
        if ((++sp & 255u) == 0u) { if (xb_ld(&bar[XB_TMO])) break; if (sp > XB_SPIN_CAP) { atomicAdd(&bar[XB_TMO], 1u); break; } }
    }
    nloc = mine > 0u ? mine : 1u; nx = cnt > 0u ? cnt : 1u;
}
__device__ __forceinline__ void xcd_barrier(const XcdBarrier& b) {
    asm volatile("s_waitcnt vmcnt(0)" ::: "memory");
    __syncthreads();
    if (threadIdx.x == 0) {
        unsigned* bar = b.bar;
        __builtin_amdgcn_s_waitcnt(0);
        unsigned nloc = b.st[0], nx = b.st[1];
        if (nloc == 0u) { xcd_barrier_complete(bar, b.x, nloc, nx); b.st[0] = nloc; b.st[1] = nx; }
        const unsigned old = xb_add(&bar[XB_XSUB(b.x)], 1u);
        const unsigned gen = old / nloc;
        if (old + 1u == (gen + 1u) * nloc) {
            __builtin_amdgcn_fence(__ATOMIC_RELEASE, "agent");
            asm volatile("s_waitcnt vmcnt(0)" ::: "memory");
            const unsigned og = xb_add(&bar[XB_TOP], 1u);
            const unsigned tg = og / nx;
            if (og + 1u == (tg + 1u) * nx) xb_add(&bar[XB_TOPGEN], 1u);
            else XB_SPIN(xb_ld(&bar[XB_TOPGEN]) == tg, bar);
            __builtin_amdgcn_fence(__ATOMIC_ACQUIRE, "agent");
            xb_add(&bar[XB_XGEN(b.x)], 1u);
            asm volatile("s_waitcnt vmcnt(0)" ::: "memory");
        } else {
            XB_SPIN(xb_ld(&bar[XB_XGEN(b.x)]) == gen, bar);
            __builtin_amdgcn_fence(__ATOMIC_ACQUIRE, "agent");
            asm volatile("s_waitcnt vmcnt(0)" ::: "memory");
        }
    }
    __syncthreads();
}

constexpr size_t MiB = 1u << 20;
constexpr size_t WS_CTL = 0, CTL_ZERO_BYTES = 64 * 1024;
constexpr size_t WS_MOD = 1 * MiB;
constexpr size_t WS_EIDX = 2 * MiB;
constexpr size_t WS_WSEL = WS_EIDX + 512 * 1024;
constexpr size_t WS_RANK = WS_WSEL + 512 * 1024;
constexpr size_t WS_TOK = 4 * MiB;
constexpr size_t WS_DST = WS_TOK + 1 * MiB;
constexpr size_t WS_WSL = WS_DST + 1 * MiB;
constexpr size_t WS_WIN = 8 * MiB;
constexpr size_t WS_POOLW = 55 * MiB;
constexpr size_t WS_WPO = 56 * MiB;
constexpr size_t WS_LORA = 60 * MiB;
constexpr size_t WS_G2 = 62 * MiB;
constexpr size_t WS_WRO = 63 * MiB;
constexpr size_t WS_WO = 71 * MiB;
constexpr size_t WS_SLAB = 80 * MiB;
constexpr size_t WS_EA = 80 * MiB;
constexpr size_t EA_STRIDE = (size_t)MT * D * 2;
constexpr size_t WS_YF = 352 * MiB, WS_YB = 416 * MiB;
constexpr size_t WS_HA = 438 * MiB;
constexpr size_t WS_Z = 480 * MiB;
constexpr size_t WS_U = 506 * MiB;
constexpr size_t WS_RM = 544 * MiB, WS_KM = 612 * MiB, WS_VM = 680 * MiB;
constexpr size_t WS_LIN = 748 * MiB;
constexpr size_t WS_DP = 774 * MiB;
constexpr size_t WS_BON = 774 * MiB;
constexpr size_t WS_Y2 = 806 * MiB;
constexpr size_t WS_MP = 838 * MiB;
constexpr size_t WS_GATES = 902 * MiB;
constexpr size_t WS_OR = 80 * MiB;
constexpr size_t WS_H2 = 520 * MiB;
constexpr size_t WS_GU = 584 * MiB;
constexpr size_t WS_ACT = 844 * MiB;
constexpr size_t WS_DT = 1004 * MiB;
constexpr size_t WS_X1 = 328 * MiB;
constexpr size_t WS_YP = 8 * MiB;
constexpr size_t WS_END = 1134 * MiB;
constexpr int CW_BAR = 1024;
constexpr int CW_GCNT = 8192;
constexpr int CW_O64 = 8192 + 100;
static_assert((CW_BAR + XCD_BAR_WORDS) <= CW_GCNT && (CW_GCNT + 128) * 4 <= (int)CTL_ZERO_BYTES, "ctl");

constexpr int RING_OFF = 0, RING_BYTES = 131072;
constexpr int LDSCTL_OFF = RING_BYTES;
constexpr int ROWTAB_OFF = LDSCTL_OFF + 1024 + 4096, ROWTAB_UNITS = 24;
constexpr int TAB_OFF = LDSCTL_OFF + 1024;
constexpr int LDS_BYTES = 163840;

using pg8::Unit;
struct RepOrder { static constexpr bool ROW_LDS = false;
    const char* A; const char* B; size_t repA, repB, tA, tB; int nM, nN, nrep, G, c;
    __device__ __forceinline__ bool next(int i, Unit& u) const {
        const long L = (long)i * G + c; const int per = nM * nN; if (L >= (long)per * nrep) return false;
        const int rep = (int)(L / per); const int w = pg8::xcd_remap((int)(L % per), per); pg8::grid_tile(w, nM, nN, u.pm, u.pn); u.aux = rep;
        u.A = A + (size_t)rep * repA + (size_t)u.pm * tA; u.B = B + (size_t)rep * repB + (size_t)u.pn * tB; return true; }
    __device__ __forceinline__ int row(const Unit&, int) const { return 0; }
};
struct G1Order { static constexpr bool ROW_LDS = false;
    const char* A; const char* B; size_t tA, tB; int G, c;
    __device__ __forceinline__ bool next(int i, Unit& u) const {
        const long L = (long)i * G + c; constexpr int N1 = 64 * 47, N2 = 4 * 27; if (L >= N1 + N2) return false;
        if (L < N1) { const int w = pg8::xcd_remap((int)L, N1); pg8::grid_tile(w, 64, 47, u.pm, u.pn); }
        else { const int l2 = (int)L - N1; u.pm = 64 + (l2 & 3); u.pn = 4 + (l2 >> 2); }
        u.aux = 0; u.A = A + (size_t)u.pm * tA; u.B = B + (size_t)u.pn * tB; return true; }
    __device__ __forceinline__ int row(const Unit&, int) const { return 0; }
};
struct MoeOrder { static constexpr bool ROW_LDS = true;
    const char* A; const char* B; const LAS int* te; const LAS int* rowtab; size_t tA, estride, jstride; int ntiles, NJ, G, c;
    __device__ __forceinline__ bool next(int i, Unit& u) const {
        const long L = (long)i * G + c; const int tot = ntiles * NJ; if (L >= tot) return false;
        const int w = pg8::xcd_remap((int)L, tot); const int rt = w / NJ, j = w - rt * NJ; const int e = te[rt];
        u.pm = rt; u.pn = j; u.aux = e; u.ui = i; u.A = A + (size_t)rt * tA; u.B = B + (size_t)e * estride + (size_t)j * jstride; return true; }
    __device__ __forceinline__ int row(const Unit& u, int r) const { return rowtab[u.ui * 256 + r]; }
};

typedef f32x4 AccT[2][2][4][2];
#define EPI_ROWS_BEGIN _Pragma("unroll") for (int ai = 0; ai < 2; ++ai) _Pragma("unroll") for (int m = 0; m < 4; ++m) { const int rl = ai * 128 + wr * 64 + m * 16 + fr;
#define EPI_ROWS_END if (m & 1) asm volatile("" ::: "memory"); }
struct EpiG1 { static constexpr bool PERM = true, PERM16 = true; bf16* U; bf16* SLAB; unsigned char* GATES;
    __device__ __forceinline__ void operator()(const AccT& acc, const Unit& u, int wr, int wc, int fr, int fq) const {
        if (u.pn >= 31) {
            const int c0 = (u.pn - 31) * 256 + wc * 64 + 16 * fq;
            EPI_ROWS_BEGIN
                unsigned char* rowp = GATES + (size_t)(u.pm * 256 + rl) * 4096 + c0;
#pragma unroll
                for (int bj = 0; bj < 2; ++bj) { const f32x4 v0 = acc[ai][bj][m][0], v1 = acc[ai][bj][m][1]; unsigned p0 = 0u, p1 = 0u;
                    p0 = __builtin_amdgcn_cvt_pk_u8_f32(255.0f * sigmoidf_(v0[0]), 0, p0); p0 = __builtin_amdgcn_cvt_pk_u8_f32(255.0f * sigmoidf_(v0[1]), 1, p0);
                    p0 = __builtin_amdgcn_cvt_pk_u8_f32(255.0f * sigmoidf_(v0[2]), 2, p0); p0 = __builtin_amdgcn_cvt_pk_u8_f32(255.0f * sigmoidf_(v0[3]), 3, p0);
                    p1 = __builtin_amdgcn_cvt_pk_u8_f32(255.0f * sigmoidf_(v1[0]), 0, p1); p1 = __builtin_amdgcn_cvt_pk_u8_f32(255.0f * sigmoidf_(v1[1]), 1, p1);
                    p1 = __builtin_amdgcn_cvt_pk_u8_f32(255.0f * sigmoidf_(v1[2]), 2, p1); p1 = __builtin_amdgcn_cvt_pk_u8_f32(255.0f * sigmoidf_(v1[3]), 3, p1);
                    v2u w; w.x = p0; w.y = p1; *(v2u*)(rowp + bj * 8) = w; }
            EPI_ROWS_END
            return;
        }
        bf16* base; int ld, c0;
        if (u.pn < 4) { base = U; ld = 1024; c0 = u.pn * 256; } else { base = SLAB; ld = SLABLD; c0 = (u.pn - 4) * 256; }
        EPI_ROWS_BEGIN
            bf16* rowp = base + (size_t)(u.pm * 256 + rl) * ld + c0 + wc * 64 + 16 * fq;
#pragma unroll
            for (int bj = 0; bj < 2; ++bj) { const f32x4 v0 = acc[ai][bj][m][0], v1 = acc[ai][bj][m][1];
                v4u w; w.x = pk2(v0[0], v0[1]); w.y = pk2(v0[2], v0[3]); w.z = pk2(v1[0], v1[1]); w.w = pk2(v1[2], v1[3]); *(v4u*)(rowp + bj * 8) = w; }
        EPI_ROWS_END
    }
};
struct EpiLora { static constexpr bool PERM = true, PERM16 = true; unsigned short* EA; const float* w0; const float* a0;
    __device__ __forceinline__ void operator()(const AccT& acc, const Unit& u, int wr, int wc, int fr, int fq) const {
        const int rep = u.aux; const float* bias = (rep < 2 ? w0 + rep * D : a0 + (rep - 2) * D) + u.pn * 256 + wc * 64 + 16 * fq;
        unsigned short* base = EA + (size_t)rep * ((size_t)MT * D);
        if (rep < 2) { const float cc = -0.8750424f;
            EPI_ROWS_BEGIN
                unsigned short* rowp = base + (size_t)(u.pm * 256 + rl) * D + u.pn * 256 + wc * 64 + 16 * fq;
#pragma unroll
                for (int bj = 0; bj < 2; ++bj) { const f32x4 v0 = acc[ai][bj][m][0] + *(const f32x4*)(bias + bj * 8), v1 = acc[ai][bj][m][1] + *(const f32x4*)(bias + bj * 8 + 4);
                    v4u w; w.x = pkh2(cc * sigmoidf_(v0[0]), cc * sigmoidf_(v0[1])); w.y = pkh2(cc * sigmoidf_(v0[2]), cc * sigmoidf_(v0[3]));
                    w.z = pkh2(cc * sigmoidf_(v1[0]), cc * sigmoidf_(v1[1])); w.w = pkh2(cc * sigmoidf_(v1[2]), cc * sigmoidf_(v1[3]));
                    *(v4u*)(rowp + bj * 8) = w; }
            EPI_ROWS_END
        } else {
            EPI_ROWS_BEGIN
                unsigned char* rowp = (unsigned char*)base + (size_t)(u.pm * 256 + rl) * D + u.pn * 256 + wc * 64 + 16 * fq;
#pragma unroll
                for (int bj = 0; bj < 2; ++bj) { const f32x4 v0 = acc[ai][bj][m][0] + *(const f32x4*)(bias + bj * 8), v1 = acc[ai][bj][m][1] + *(const f32x4*)(bias + bj * 8 + 4); unsigned p0 = 0u, p1 = 0u;
                    p0 = __builtin_amdgcn_cvt_pk_u8_f32(255.0f * sigmoidf_(v0[0]), 0, p0); p0 = __builtin_amdgcn_cvt_pk_u8_f32(255.0f * sigmoidf_(v0[1]), 1, p0);
                    p0 = __builtin_amdgcn_cvt_pk_u8_f32(255.0f * sigmoidf_(v0[2]), 2, p0); p0 = __builtin_amdgcn_cvt_pk_u8_f32(255.0f * sigmoidf_(v0[3]), 3, p0);
                    p1 = __builtin_amdgcn_cvt_pk_u8_f32(255.0f * sigmoidf_(v1[0]), 0, p1); p1 = __builtin_amdgcn_cvt_pk_u8_f32(255.0f * sigmoidf_(v1[1]), 1, p1);
                    p1 = __builtin_amdgcn_cvt_pk_u8_f32(255.0f * sigmoidf_(v1[2]), 2, p1); p1 = __builtin_amdgcn_cvt_pk_u8_f32(255.0f * sigmoidf_(v1[3]), 3, p1);
                    v2u w; w.x = p0; w.y = p1; *(v2u*)(rowp + bj * 8) = w; }
            EPI_ROWS_END
        }
    }
};
struct EpiPoolG { static constexpr bool PERM = true, PERM16 = true; bf16* Y2; const float* scale;
    __device__ __forceinline__ void operator()(const AccT& acc, const Unit& u, int wr, int wc, int fr, int fq) const {
        const int cb = u.aux * 256 + wc * 64 + 16 * fq;
        f32x4 s0[2], s1[2];
#pragma unroll
        for (int bj = 0; bj < 2; ++bj) { s0[bj] = *(const f32x4*)(scale + cb + bj * 8); s1[bj] = *(const f32x4*)(scale + cb + bj * 8 + 4); }
        EPI_ROWS_BEGIN
            bf16* rowp = Y2 + (size_t)(u.pm * 256 + rl) * 1024 + cb;
#pragma unroll
            for (int bj = 0; bj < 2; ++bj) { const f32x4 v0 = acc[ai][bj][m][0] * s0[bj], v1 = acc[ai][bj][m][1] * s1[bj];
                v4u w; w.x = pk2(v0[0], v0[1]); w.y = pk2(v0[2], v0[3]); w.z = pk2(v1[0], v1[1]); w.w = pk2(v1[2], v1[3]); *(v4u*)(rowp + bj * 8) = w; }
        EPI_ROWS_END
    }
};
template <int MODE> struct EpiMix { static constexpr bool PERM = true, PERM16 = true; bf16* OUT; int ldo; const void* AUX1; int ld1; const bf16* AUX2; int ld2;
    __device__ __forceinline__ void operator()(const AccT& acc, const Unit& u, int wr, int wc, int fr, int fq) const {
        const int cb = u.pn * 256 + wc * 64 + 16 * fq;
        EPI_ROWS_BEGIN
            const size_t row = (size_t)(u.pm * 256 + rl);
#pragma unroll
            for (int bj = 0; bj < 2; ++bj) { const f32x4 v0 = acc[ai][bj][m][0], v1 = acc[ai][bj][m][1];
                float x[8];
                if (MODE == 1) { const v4u a1 = *(const v4u*)((const bf16*)AUX1 + row * ld1 + cb + bj * 8);
                    x[0] = bflo(a1.x); x[1] = bfhi(a1.x); x[2] = bflo(a1.y); x[3] = bfhi(a1.y); x[4] = bflo(a1.z); x[5] = bfhi(a1.z); x[6] = bflo(a1.w); x[7] = bfhi(a1.w); }
                else { const v2u a1 = *(const v2u*)((const unsigned char*)AUX1 + row * ld1 + cb + bj * 8); const float k = 1.0f / 255.0f;
                    x[0] = (float)(a1.x & 0xffu) * k; x[1] = (float)((a1.x >> 8) & 0xffu) * k; x[2] = (float)((a1.x >> 16) & 0xffu) * k; x[3] = (float)(a1.x >> 24) * k;
                    x[4] = (float)(a1.y & 0xffu) * k; x[5] = (float)((a1.y >> 8) & 0xffu) * k; x[6] = (float)((a1.y >> 16) & 0xffu) * k; x[7] = (float)(a1.y >> 24) * k; }
                float o[8];
                if (MODE == 0 || MODE == 1) {
#pragma unroll
                    for (int j = 0; j < 4; ++j) { o[j] = x[j] * v0[j]; o[4 + j] = x[4 + j] * v1[j]; } }
                else { const v4u a2 = *(const v4u*)(AUX2 + row * ld2 + cb + bj * 8);
                    const float y[8] = {bflo(a2.x), bfhi(a2.x), bflo(a2.y), bfhi(a2.y), bflo(a2.z), bfhi(a2.z), bflo(a2.w), bfhi(a2.w)};
#pragma unroll
                    for (int j = 0; j < 4; ++j) { o[j] = y[j] + x[j] * v0[j]; o[4 + j] = y[4 + j] + x[4 + j] * v1[j]; } }
                v4u w; w.x = pk2(o[0], o[1]); w.y = pk2(o[2], o[3]); w.z = pk2(o[4], o[5]); w.w = pk2(o[6], o[7]);
                *(v4u*)(OUT + row * ldo + cb + bj * 8) = w; }
        EPI_ROWS_END
    }
};
struct EpiX1 { static constexpr bool PERM = true, PERM16 = true; const float* X; bf16* OUT; const float* MOD;
    __device__ __forceinline__ void operator()(const AccT& acc, const Unit& u, int wr, int wc, int fr, int fq) const {
        const int b = u.pm >> 4;
        const int cb = u.pn * 256 + wc * 64 + 16 * fq; const float* g = MOD + (size_t)b * 12288 + 4096 + cb;
        f32x4 gv[2][2];
#pragma unroll
        for (int bj = 0; bj < 2; ++bj)
#pragma unroll
            for (int n = 0; n < 2; ++n) gv[bj][n] = *(const f32x4*)(g + bj * 8 + n * 4);
        EPI_ROWS_BEGIN
            const size_t off = (size_t)(u.pm * 256 + rl) * D + cb;
#pragma unroll
            for (int bj = 0; bj < 2; ++bj) { const f32x4 x0 = *(const f32x4*)(X + off + bj * 8), x1 = *(const f32x4*)(X + off + bj * 8 + 4);
                const f32x4 v0 = x0 + gv[bj][0] * acc[ai][bj][m][0], v1 = x1 + gv[bj][1] * acc[ai][bj][m][1];
                v4u w; w.x = pk2(v0[0], v0[1]); w.y = pk2(v0[2], v0[3]); w.z = pk2(v1[0], v1[1]); w.w = pk2(v1[2], v1[3]); *(v4u*)(OUT + off + bj * 8) = w; }
        EPI_ROWS_END
    }
};
struct EpiAct { static constexpr bool PERM = true; bf16* ACT;
    __device__ __forceinline__ void operator()(const AccT& acc, const Unit& u, int wr, int wc, int fr, int fq) const {
        EPI_ROWS_BEGIN
            const f32x4 g0 = acc[ai][0][m][0], g1 = acc[ai][0][m][1], u0 = acc[ai][1][m][0], u1 = acc[ai][1][m][1];
            float o[8];
#pragma unroll
            for (int j = 0; j < 4; ++j) { o[j] = g0[j] * sigmoidf_(g0[j]) * u0[j]; o[4 + j] = g1[j] * sigmoidf_(g1[j]) * u1[j]; }
            v4u w; w.x = pk2(o[0], o[1]); w.y = pk2(o[2], o[3]); w.z = pk2(o[4], o[5]); w.w = pk2(o[6], o[7]);
            *(v4u*)(ACT + (size_t)(u.pm * 256 + rl) * DEXP + u.pn * 128 + wc * 32 + 8 * fq) = w;
        EPI_ROWS_END
    }
};
constexpr float YP_SCALE = 8.0f;
struct EpiDown { static constexpr bool PERM = true, PERM16 = true; unsigned char* YP;
    __device__ __forceinline__ void operator()(const AccT& acc, const Unit& u, int wr, int wc, int fr, int fq) const {
        const int cb = u.pn * 256 + wc * 64 + 16 * fq;
        EPI_ROWS_BEGIN
            int p[4];
#pragma unroll
            for (int bj = 0; bj < 2; ++bj) { const f32x4 v0 = acc[ai][bj][m][0] * YP_SCALE, v1 = acc[ai][bj][m][1] * YP_SCALE;
                int p0 = __builtin_amdgcn_cvt_pk_fp8_f32(v0[0], v0[1], 0, false); p0 = __builtin_amdgcn_cvt_pk_fp8_f32(v0[2], v0[3], p0, true);
                int p1 = __builtin_amdgcn_cvt_pk_fp8_f32(v1[0], v1[1], 0, false); p1 = __builtin_amdgcn_cvt_pk_fp8_f32(v1[2], v1[3], p1, true);
                p[2 * bj] = p0; p[2 * bj + 1] = p1; }
            v4u w; w.x = (unsigned)p[0]; w.y = (unsigned)p[1]; w.z = (unsigned)p[2]; w.w = (unsigned)p[3];
            *(v4u*)(YP + (size_t)(u.pm * 256 + rl) * D + cb) = w;
        EPI_ROWS_END
    }
};
struct Frame {
    LAS unsigned char* lds;
    volatile LAS unsigned* MISC;
    unsigned* ctl;
    int tid, lane, wave, vcu, G;
    unsigned char* ws;
};
struct Args { const float* in[34]; float* out; unsigned char* ws; int ph_lo, ph_hi; };
enum { I_X = 0, I_C, I_CTX, I_CCTX, I_N1G, I_N2G, I_ADAW, I_ADAB, I_WIN, I_MU, I_POOLW, I_POOLS, I_WPO, I_DW0, I_DW2, I_IA0, I_IA2, I_G2, I_KK, I_KA, I_RK, I_LNW, I_LNB,
       I_WRO, I_WO, I_RW, I_RB, I_EG, I_EU, I_ED, I_SG, I_SU, I_SD, I_FG };

struct TrJob { const float* src; bf16* dst; int ldw, kvalid, ldt, k0, n0, drow0; };
__device__ __forceinline__ void tr_load(const TrJob& j, f32x4 (&v)[16], int lane) {
    const int r2 = lane >> 4, c4 = lane & 15;
#pragma unroll
    for (int i = 0; i < 8; ++i) {
#pragma unroll
        for (int h = 0; h < 2; ++h) { const int k = j.k0 + 8 * i + 2 * r2 + h; const int kc = k < j.kvalid ? k : 0;
            const f32x4 x = *(const f32x4*)(j.src + (size_t)kc * j.ldw + j.n0 + 4 * c4); v[2 * i + h] = (k < j.kvalid) ? x : (f32x4){0.f, 0.f, 0.f, 0.f}; } }
}
__device__ __forceinline__ void tr_store(const TrJob& j, const f32x4 (&v)[16], LAS unsigned* P, int lane) {
    const int r2 = lane >> 4, c4 = lane & 15;
#pragma unroll
    for (int i = 0; i < 8; ++i) { LAS unsigned* p = P + (4 * i + r2) * 65 + 4 * c4;
        p[0] = pk2(v[2 * i].x, v[2 * i + 1].x); p[1] = pk2(v[2 * i].y, v[2 * i + 1].y); p[2] = pk2(v[2 * i].z, v[2 * i + 1].z); p[3] = pk2(v[2 * i].w, v[2 * i + 1].w); }
    LDS_WAIT(); asm volatile("" ::: "memory");
    const int nl = lane >> 3, q = lane & 7;
#pragma unroll
    for (int jj = 0; jj < 8; ++jj) { const int n = 8 * jj + nl; const LAS unsigned* s = P + (4 * q) * 65 + n;
        v4u o; o.x = s[0]; o.y = s[65]; o.z = s[130]; o.w = s[195];
        *(v4u*)(j.dst + (size_t)(j.drow0 + n) * j.ldt + j.k0 + 8 * q) = o; }
    LDS_WAIT(); asm volatile("" ::: "memory");
}
template <class Dec> __device__ __forceinline__ void tr_run(const Dec& dec, int first, int stride, LAS unsigned* P, int lane) {
    TrJob ja, jb; f32x4 va[16], vb[16];
    int it = first; bool ha = dec(it, ja); if (ha) tr_load(ja, va, lane);
    while (ha) {
        it += stride; const bool hb = dec(it, jb); if (hb) tr_load(jb, vb, lane);
        tr_store(ja, va, P, lane);
        if (!hb) break;
        it += stride; ha = dec(it, ja); if (ha) tr_load(ja, va, lane);
        tr_store(jb, vb, P, lane);
    }
}
__device__ __forceinline__ void p0_prologue(Frame& F, const Args& a) {
    {
        LAS float* sv = (LAS float*)F.lds;
        LAS float* part = (LAS float*)(F.lds + 40960);
        bool did = false;
        for (int cb = blockIdx.x; cb < 192; cb += F.G) {
            if (!did) { for (int idx = F.tid; idx < 5 * D; idx += 512) { const int j = idx >> 11, k = idx & 2047; const float v = (j < 4) ? a.in[I_C][j * D + k] : a.in[I_CCTX][k]; sv[idx] = v / (1.0f + __expf(-v)); } did = true; }
            __syncthreads();
            const int col = 64 * cb + F.lane, k0 = 256 * F.wave; const float* wp = a.in[I_ADAW] + (size_t)k0 * 12288 + col;
            float acc[5] = {0.f, 0.f, 0.f, 0.f, 0.f};
#pragma unroll 32
            for (int k = 0; k < 256; ++k) { const float w = wp[(size_t)k * 12288];
#pragma unroll
                for (int j = 0; j < 5; ++j) acc[j] += sv[j * D + k0 + k] * w; }
#pragma unroll
            for (int j = 0; j < 5; ++j) part[(F.wave * 5 + j) * 64 + F.lane] = acc[j];
            __syncthreads();
            if (F.tid < 320) { const int j = F.tid >> 6, l = F.tid & 63; float s = a.in[I_ADAB][64 * cb + l];
#pragma unroll
                for (int w = 0; w < 8; ++w) s += part[(w * 5 + j) * 64 + l];
                ((float*)(F.ws + WS_MOD))[j * 12288 + 64 * cb + l] = s; }
            __syncthreads();
        }
        __syncthreads();
    }
    {
        struct DecSmall { const float* const* in; unsigned char* ws;
            __device__ __forceinline__ bool operator()(int it, TrJob& j) const {
                constexpr int I_1 = 32 * 186, I_2 = 4 * 16, I_3 = 16 * 32, I_4 = 4 * 32, I_5 = 32 * 32, I_6 = 32 * 32, I_7 = 4 * 2 * 32;
                int r = it; if (r < 0) return false;
                if (r < I_1) { const int kb = r / 186, nb = r % 186, n0 = nb * 64; j = TrJob{in[I_WIN], (bf16*)(ws + WS_WIN), DIN, D, D, kb * 64, n0, n0 + (n0 >= 7808 ? 128 : 0)}; return true; } r -= I_1;
                if (r < I_2) { const int g = r / 16, q = r % 16; j = TrJob{in[I_POOLW] + (size_t)g * 65536, (bf16*)(ws + WS_POOLW) + (size_t)g * 65536, 256, 256, 256, (q / 4) * 64, (q % 4) * 64, (q % 4) * 64}; return true; } r -= I_2;
                if (r < I_3) { j = TrJob{in[I_WPO], (bf16*)(ws + WS_WPO), D, 1024, 1024, (r / 32) * 64, (r % 32) * 64, (r % 32) * 64}; return true; } r -= I_3;
                if (r < I_4) { j = TrJob{in[I_G2], (bf16*)(ws + WS_G2), D, 256, 256, (r / 32) * 64, (r % 32) * 64, (r % 32) * 64}; return true; } r -= I_4;
                if (r < I_5) { j = TrJob{in[I_WRO], (bf16*)(ws + WS_WRO), D, D, D, (r / 32) * 64, (r % 32) * 64, (r % 32) * 64}; return true; } r -= I_5;
                if (r < I_6) { j = TrJob{in[I_WO], (bf16*)(ws + WS_WO), D, D, D, (r / 32) * 64, (r % 32) * 64, (r % 32) * 64}; return true; } r -= I_6;
                if (r < I_7) { const int mtx = r / 64, q = r % 64;
                    const float* src = (mtx < 2 ? in[I_DW2] + (size_t)mtx * 96 * D : in[I_IA2] + (size_t)(mtx - 2) * 96 * D);
                    j = TrJob{src, (bf16*)(ws + WS_LORA) + (size_t)mtx * D * 128, D, 96, 128, (q / 32) * 64, (q % 32) * 64, (q % 32) * 64}; return true; }
                return false; } };
        DecSmall dec{a.in, F.ws};
        tr_run(dec, F.vcu * 8 + F.wave, F.G * 8, (LAS unsigned*)(F.lds + F.wave * 16384), F.lane);
    }
    const int gt = F.vcu * 512 + F.tid, NGT = F.G * 512;
    { v4u* z = (v4u*)((bf16*)(F.ws + WS_WIN) + (size_t)7808 * D); for (int i = gt; i < 128 * D / 8; i += NGT) z[i] = (v4u){0u, 0u, 0u, 0u}; }
    { int* tok = (int*)(F.ws + WS_TOK); for (int i = gt; i < NSLOT; i += NGT) tok[i] = 0; }
}

__device__ __forceinline__ void p1_norm1(Frame& F, const Args& a) {
    const int gw = F.vcu * 8 + F.wave, NGW = F.G * 8; const float* MOD = (const float*)(F.ws + WS_MOD); bf16* HA = (bf16*)(F.ws + WS_HA);
    for (int mrow = gw; mrow < MT; mrow += NGW) {
        const float* src = (mrow < NT) ? a.in[I_X] + (size_t)mrow * D : a.in[I_CTX] + (size_t)(mrow - NT) * D; const int j = (mrow < NT) ? (mrow >> 12) : 4;
        const f32x4* xr = (const f32x4*)src + F.lane; f32x4 v[8]; float s = 0.f;
#pragma unroll
        for (int q = 0; q < 8; ++q) { v[q] = xr[64 * q]; s += (v[q].x * v[q].x + v[q].y * v[q].y) + (v[q].z * v[q].z + v[q].w * v[q].w); }
        const float rstd = 1.0f / sqrtf(wave_sum(s) * (1.0f / D) + 1e-6f);
        const f32x4* g = (const f32x4*)a.in[I_N1G] + F.lane; const f32x4* sh = (const f32x4*)(MOD + (size_t)j * 12288) + F.lane; const f32x4* sc = (const f32x4*)(MOD + (size_t)j * 12288 + 2048) + F.lane;
        v2u* o = (v2u*)(HA + (size_t)mrow * D) + F.lane;
#pragma unroll
        for (int q = 0; q < 8; ++q) { const f32x4 y = v[q] * rstd * g[64 * q] * (sc[64 * q] + 1.0f) + sh[64 * q]; v2u w; w.x = pk2(y.x, y.y); w.y = pk2(y.z, y.w); o[64 * q] = w; }
    }
}

template <int W> __device__ __forceinline__ void pool_item(const unsigned* U32, unsigned* DP32, int m0, int cp) {
    unsigned raw[64];
#pragma unroll
    for (int x = 0; x < 64; ++x) raw[x] = U32[(size_t)(m0 + x) * 512 + cp];
    float lo[64], hi[64];
#pragma unroll
    for (int x = 0; x < 64; ++x) { lo[x] = bflo(raw[x]); hi[x] = bfhi(raw[x]); }
#pragma unroll
    for (int x = 0; x < 64; ++x) { const int l = (x - W / 2) < 0 ? 0 : (x - W / 2), h = (x + W / 2) > 64 ? 64 : (x + W / 2); float s0 = 0.f, s1 = 0.f;
#pragma unroll
        for (int j = l; j < h; ++j) { s0 += lo[j]; s1 += hi[j]; }
        const float inv = 1.0f / (float)(h - l); DP32[(size_t)(m0 + x) * 512 + cp] = pk2(s0 * inv - lo[x], s1 * inv - hi[x]); }
}
__device__ __forceinline__ void p3_mix_store(const v4u o, const v4u nb, const f32x4 m0, const f32x4 m1, int c0, int mrow, bf16* RM, bf16* KM, bf16* VM, bf16* LIN) {
    float r[8];
    { const float ov[8] = {bflo(o.x), bfhi(o.x), bflo(o.y), bfhi(o.y), bflo(o.z), bfhi(o.z), bflo(o.w), bfhi(o.w)};
      const float nv[8] = {bflo(nb.x), bfhi(nb.x), bflo(nb.y), bfhi(nb.y), bflo(nb.z), bfhi(nb.z), bflo(nb.w), bfhi(nb.w)};
      const float mv[8] = {m0.x, m0.y, m0.z, m0.w, m1.x, m1.y, m1.z, m1.w};
#pragma unroll
      for (int e = 0; e < 8; ++e) r[e] = ov[e] + (nv[e] - ov[e]) * mv[e]; }
    bf16* dstp;
    if (c0 < 2048) dstp = RM + (size_t)mrow * D + c0;
    else if (c0 < 4096) dstp = KM + (size_t)mrow * D + (c0 - 2048);
    else if (c0 < 6144) dstp = VM + (size_t)mrow * D + (c0 - 4096);
    else { const int lc = c0 - 6144; int dc;
        if (lc < 192) {
#pragma unroll
            for (int e = 0; e < 8; ++e) r[e] = tanhf_(r[e]);
            dc = (lc < 96) ? lc : 128 + (lc - 96); }
        else if (lc < 384) dc = (lc < 288) ? 256 + (lc - 192) : 384 + (lc - 288);
        else {
#pragma unroll
            for (int e = 0; e < 8; ++e) r[e] = sigmoidf_(r[e]);
            dc = 512 + (lc - 384); }
        dstp = LIN + (size_t)mrow * LINLD + dc; }
    v4u w; w.x = pk2(r[0], r[1]); w.y = pk2(r[2], r[3]); w.z = pk2(r[4], r[5]); w.w = pk2(r[6], r[7]); *(v4u*)dstp = w;
}
constexpr int P3_SLICE = 512, P3_NSLICE = (DSH + P3_SLICE - 1) / P3_SLICE  , P3_SLOTS = 96;
__device__ __forceinline__ void p3_prep(Frame& F, const Args& a) {
    const bf16* SLAB = (const bf16*)(F.ws + WS_SLAB); const float* mu = a.in[I_MU];
    bf16* RM = (bf16*)(F.ws + WS_RM); bf16* KM = (bf16*)(F.ws + WS_KM); bf16* VM = (bf16*)(F.ws + WS_VM); bf16* LIN = (bf16*)(F.ws + WS_LIN);
    LAS unsigned char* T = F.lds;
    const int w = F.wave, lane = F.lane;
    for (int pid = F.vcu; pid < NB * 64; pid += F.G) {
        const int b = pid >> 6, py = (pid >> 3) & 7, px = pid & 7; const int m00 = b * TSEQ + (py * 8) * 64 + px * 8;
        int srow[12];
#pragma unroll
        for (int i = 0; i < 12; ++i) { const int sl = w * 12 + i; int gyl, gxl; bool ok = true;
            if (sl < 64) { gyl = sl >> 3; gxl = sl & 7; } else if (sl < 72) { gyl = -1; gxl = sl - 64; ok = py > 0; } else if (sl < 80) { gyl = 8; gxl = sl - 72; ok = py < 7; }
            else if (sl < 88) { gyl = sl - 80; gxl = -1; ok = px > 0; } else { gyl = sl - 88; gxl = 8; ok = px < 7; }
            srow[i] = ok ? m00 + gyl * 64 + gxl : m00; }
        v4u pre[12];
        { const int cl = lane * 8;
#pragma unroll
          for (int i = 0; i < 12; ++i) pre[i] = *(const v4u*)(SLAB + (size_t)srow[i] * SLABLD + cl); }
        for (int sl_ = 0; sl_ < P3_NSLICE; ++sl_) {
            const int c0 = sl_ * P3_SLICE + lane * 8; const bool cok = c0 < DSH;
            __syncthreads();
#pragma unroll
            for (int i = 0; i < 12; ++i) *(LAS v4u*)(T + (w * 12 + i) * 1024 + lane * 16) = pre[i];
            if (sl_ + 1 < P3_NSLICE) { const int cn = (sl_ + 1) * P3_SLICE + lane * 8; const int cl = cn < DSH ? cn : 0;
#pragma unroll
                for (int i = 0; i < 12; ++i) pre[i] = *(const v4u*)(SLAB + (size_t)srow[i] * SLABLD + cl); }
            __syncthreads();
            const f32x4 m0 = *(const f32x4*)(mu + (cok ? c0 : 0)), m1 = *(const f32x4*)(mu + (cok ? c0 : 0) + 4);
            const int gy = py * 8 + w; const unsigned k2m = gy > 0 ? 0xffffu : 0u, k3m = gy < 63 ? 0xffff0000u : 0u;
#pragma unroll
            for (int x = 0; x < 8; ++x) {
                const int gx = px * 8 + x; const unsigned k0m = gx > 0 ? 0xffffu : 0u, k1m = gx < 63 ? 0xffff0000u : 0u;
                const int so = w * 8 + x, sL = x > 0 ? so - 1 : 80 + w, sR = x < 7 ? so + 1 : 88 + w, sU = w > 0 ? so - 8 : 64 + x, sD = w < 7 ? so + 8 : 72 + x;
                const v4u o = *(const LAS v4u*)(T + so * 1024 + lane * 16), n0 = *(const LAS v4u*)(T + sL * 1024 + lane * 16), n1 = *(const LAS v4u*)(T + sR * 1024 + lane * 16),
                          n2 = *(const LAS v4u*)(T + sU * 1024 + lane * 16), n3 = *(const LAS v4u*)(T + sD * 1024 + lane * 16);
                v4u nb; nb.x = (n0.x & k0m) | (n1.x & k1m); nb.y = (n2.y & k2m) | (n3.y & k3m); nb.z = (n0.z & k0m) | (n1.z & k1m); nb.w = (n2.w & k2m) | (n3.w & k3m);
                const int mrow = m00 + w * 64 + x;
                if (cok) p3_mix_store(o, nb, m0, m1, c0, mrow, RM, KM, VM, LIN);
                if (sl_ == P3_NSLICE - 1 && lane >= 48) { const int l16 = lane - 48, p = l16 >> 2, off = (l16 & 3) * 8; *(v4u*)(LIN + (size_t)mrow * LINLD + 128 * p + 96 + off) = (v4u){0u, 0u, 0u, 0u}; }
            }
        }
        __syncthreads();
    }
    const int gw = F.vcu * 8 + F.wave, NGW = F.G * 8;
    for (int mrow = NT + gw; mrow < MT; mrow += NGW) {
        const bf16* own = SLAB + (size_t)mrow * SLABLD; const int sidx = (mrow - NT) & 255; const bool v0 = sidx > 0, v1 = sidx < 255;
        const bf16* p0 = v0 ? own - SLABLD : own; const bf16* p1 = v1 ? own + SLABLD : own;
        const unsigned k0m = v0 ? 0xffffu : 0u, k1m = v1 ? 0xffff0000u : 0u;
        for (int ci0 = F.lane; ci0 < DSH / 8; ci0 += 256) {
            v4u o[4], nb[4]; f32x4 m0[4], m1[4];
#pragma unroll
            for (int u = 0; u < 4; ++u) { const int ci = ci0 + 64 * u; const int c0 = (ci < DSH / 8 ? ci : F.lane) * 8;
                o[u] = *(const v4u*)(own + c0); const v4u n0 = *(const v4u*)(p0 + c0), n1 = *(const v4u*)(p1 + c0);
                nb[u].x = (n0.x & k0m) | (n1.x & k1m); nb[u].y = (n0.y & k0m) | (n1.y & k1m); nb[u].z = (n0.z & k0m) | (n1.z & k1m); nb[u].w = (n0.w & k0m) | (n1.w & k1m);
                m0[u] = *(const f32x4*)(mu + c0); m1[u] = *(const f32x4*)(mu + c0 + 4); }
#pragma unroll
            for (int u = 0; u < 4; ++u) { const int ci = ci0 + 64 * u; if (ci < DSH / 8) p3_mix_store(o[u], nb[u], m0[u], m1[u], ci * 8, mrow, RM, KM, VM, LIN); }
        }
        if (F.lane < 16) { const int p = F.lane >> 2, off = (F.lane & 3) * 8; *(v4u*)(LIN + (size_t)mrow * LINLD + 128 * p + 96 + off) = (v4u){0u, 0u, 0u, 0u}; }
    }
    const unsigned* U32 = (const unsigned*)(F.ws + WS_U); unsigned* DP32 = (unsigned*)(F.ws + WS_DP);
    for (int gr = F.vcu; gr < 256; gr += F.G) {
        const int m0 = gr * 64, cp = F.tid; const int g = F.wave >> 1;
        if (g == 0) pool_item<2>(U32, DP32, m0, cp); else if (g == 1) pool_item<4>(U32, DP32, m0, cp); else if (g == 2) pool_item<8>(U32, DP32, m0, cp); else pool_item<16>(U32, DP32, m0, cp);
    }
}

constexpr int CK = 16, NSL = 8;
constexpr int SL_Z = 0, SL_AF = 2560, SL_TMT = 3584, SL_ABF = 4096, SL_TM = 4608, SL_ZTT = 5120, SL_RT = 7680, SL_CRT = 9728, SL_ART = 10240, SL_BGT = 10752, SL_KGT = 12800, SL_VT = 14848, SL_GC = 16896,
              SL_SIZE = 17152, ZTT_LD = 80, SB_OFF = 7 * SL_SIZE  , SL7_OFF = 132096  ;
static_assert(SB_OFF + 8192 <= 131072 && SL7_OFF + SL_SIZE <= 163840, "scan LDS map");
__device__ __forceinline__ int kpos(int zt, int q) { return 32 * (zt >> 1) + 8 * q + 4 * (zt & 1); }
__device__ __forceinline__ int slot_off(int n) { return n < 7 ? n * SL_SIZE : SL7_OFF; }
__device__ __forceinline__ int sw64(int row, int col) { return (row * 64 + ((((col >> 3) ^ (row & 7)) << 3) | (col & 7))) * 2; }
__device__ __forceinline__ int scan_row(int n, int b, int dir) {
    if (n < CTXL) return NT + b * CTXL + (dir ? (CTXL - 1 - n) : n);
    const int t = n - CTXL; return b * TSEQ + (dir ? (TSEQ - 1 - t) : t);
}
__device__ __forceinline__ bf16x8 frag_ld(const LAS unsigned char* p, bool ok) { v4u z = (v4u){0u, 0u, 0u, 0u}; if (ok) z = *(const LAS v4u*)p; return __builtin_bit_cast(bf16x8, z); }
__device__ __forceinline__ f32x4 mfma16(bf16x8 a, bf16x8 b, f32x4 c) { return __builtin_amdgcn_mfma_f32_16x16x32_bf16(a, b, c, 0, 0, 0); }
__device__ __forceinline__ float dpp_shr(float v, const int n, float fill) {
    const int x = __builtin_bit_cast(int, v), f = __builtin_bit_cast(int, fill); int r;
    if (n == 1) r = __builtin_amdgcn_update_dpp(f, x, 0x111, 0xF, 0xF, false); else if (n == 2) r = __builtin_amdgcn_update_dpp(f, x, 0x112, 0xF, 0xF, false);
    else if (n == 4) r = __builtin_amdgcn_update_dpp(f, x, 0x114, 0xF, 0xF, false); else r = __builtin_amdgcn_update_dpp(f, x, 0x118, 0xF, 0xF, false);
    return __builtin_bit_cast(float, r);
}
struct SeqOps { bf16x8 fV, fZc, fZk[2], fR[2], fCr, fAr4, fKG[4], fBG4[4]; f32x4 gc[4]; };
__device__ __forceinline__ bf16x8 frag4_ld(const LAS unsigned char* p) { const v2u t = *(const LAS v2u*)p; v4u z; z.x = t.x; z.y = t.y; z.z = 0u; z.w = 0u; return __builtin_bit_cast(bf16x8, z); }
__device__ __forceinline__ void seq_load(SeqOps& o, const LAS unsigned char* SL, int w, int c, int q, bool klo) {
    o.fV = frag_ld(SL + SL_VT + ((16 * w + c) * 16 + 8 * q) * 2, klo);
    o.fZc = frag_ld(SL + SL_ZTT + (c * ZTT_LD + 64 + 8 * q) * 2, klo); o.fCr = frag_ld(SL + SL_CRT + (c * 16 + 8 * q) * 2, klo); o.fAr4 = frag4_ld(SL + SL_ART + (c * 16 + 4 * q) * 2);
#pragma unroll
    for (int ks = 0; ks < 2; ++ks) { o.fZk[ks] = frag_ld(SL + SL_ZTT + (c * ZTT_LD + 32 * ks + 8 * q) * 2, true); o.fR[ks] = frag_ld(SL + SL_RT + sw64(c, 32 * ks + 8 * q), true); }
#pragma unroll
    for (int jt = 0; jt < 4; ++jt) { o.fKG[jt] = frag_ld(SL + SL_KGT + ((16 * jt + c) * 16 + 8 * q) * 2, klo); o.fBG4[jt] = frag4_ld(SL + SL_BGT + ((16 * jt + c) * 16 + 4 * q) * 2);
        o.gc[jt] = *(const LAS f32x4*)(SL + SL_GC + (16 * jt + 4 * q) * 4); }
}
__device__ __forceinline__ void seq_step(const SeqOps& o, f32x4 (&X)[4], bool emit, bf16* YO, int chunk, int b, int dir, int h, int w, int c, int q) {
    const f32x4 z4 = (f32x4){0.f, 0.f, 0.f, 0.f};
    bf16x8 fS[2];
#pragma unroll
    for (int ks = 0; ks < 2; ++ks) { v4u p; p.x = pk2(X[2 * ks][0], X[2 * ks][1]); p.y = pk2(X[2 * ks][2], X[2 * ks][3]); p.z = pk2(X[2 * ks + 1][0], X[2 * ks + 1][1]); p.w = pk2(X[2 * ks + 1][2], X[2 * ks + 1][3]);
        fS[ks] = __builtin_bit_cast(bf16x8, p); }
    f32x4 un = mfma16(o.fZc, o.fV, z4);
#pragma unroll
    for (int ks = 0; ks < 2; ++ks) un = mfma16(o.fZk[ks], fS[ks], un);
    bf16x8 fU; { v4u p; p.x = pk2(un[0], un[1]); p.y = pk2(un[2], un[3]); p.z = 0u; p.w = 0u; fU = __builtin_bit_cast(bf16x8, p); }
    if (emit) {
        f32x4 y = mfma16(o.fCr, o.fV, z4); y = mfma16(o.fAr4, fU, y);
#pragma unroll
        for (int ks = 0; ks < 2; ++ks) y = mfma16(o.fR[ks], fS[ks], y);
#pragma unroll
        for (int g = 0; g < 4; ++g) YO[(size_t)scan_row(chunk * CK + 4 * q + g, b, dir) * D + h * 64 + 16 * w + c] = (bf16)f2bf(y[g]);
    }
#pragma unroll
    for (int jt = 0; jt < 4; ++jt) { const f32x4 d = mfma16(o.fBG4[jt], fU, mfma16(o.fKG[jt], o.fV, z4));
        X[jt] = X[jt] * o.gc[jt] + d; }
}
struct ScanRaw { v4u r[2], k[2], v[2], e[2]; v2u a[2]; };
__device__ __forceinline__ void scan_fetch(ScanRaw& R, const bf16* RM, const bf16* KM, const bf16* VM, const unsigned char* AX, const unsigned short* EX, size_t rowoff) {
#pragma unroll
    for (int ks = 0; ks < 2; ++ks) { const size_t off = rowoff + 32 * ks; R.r[ks] = *(const v4u*)(RM + off); R.k[ks] = *(const v4u*)(KM + off); R.v[ks] = *(const v4u*)(VM + off); R.a[ks] = *(const v2u*)(AX + off); R.e[ks] = *(const v4u*)(EX + off); }
}
__device__ __forceinline__ void p6_scan(Frame& F, const Args& a) {
    const bf16* RM = (const bf16*)(F.ws + WS_RM); const bf16* KM = (const bf16*)(F.ws + WS_KM); const bf16* VM = (const bf16*)(F.ws + WS_VM);
    const int lane = F.lane, w = F.wave, c0_ = lane & 15, q0_ = lane >> 4;
    for (int unit = blockIdx.x; unit < NB * NH * 2; unit += F.G) {
        const int dir = unit & 1, h = (unit >> 1) & 31, b = unit >> 6;
        const unsigned short* EX = (const unsigned short*)(F.ws + WS_EA + (size_t)dir * EA_STRIDE);
        const unsigned char* AX = (const unsigned char*)(F.ws + WS_EA + (size_t)(2 + dir) * EA_STRIDE);
        bf16* YO = (bf16*)(F.ws + (dir ? WS_YB : WS_YF)); float* BON = (float*)(F.ws + WS_BON) + (size_t)dir * NT * NH;
        f32x4 X[4];
#pragma unroll
        for (int jt = 0; jt < 4; ++jt) X[jt] = (f32x4){0.f, 0.f, 0.f, 0.f};
        constexpr int NBATCH = (CTXL + TSEQ) / CK / NSL;
        { LAS float* cst = (LAS float*)(F.lds + SB_OFF);
          if (F.tid < 192) { const int which = F.tid >> 6, j = F.tid & 63; cst[F.tid] = (which == 0 ? a.in[I_KK] : which == 1 ? a.in[I_KA] : a.in[I_RK])[h * 64 + j]; } }
        ScanRaw R; scan_fetch(R, RM, KM, VM, AX, EX, (size_t)scan_row(w * CK + c0_, b, dir) * D + h * 64 + 8 * q0_);
        __syncthreads();
        for (int bt = 0; bt < NBATCH; ++bt) {
            int c = c0_, q = q0_; asm volatile("" : "+v"(c), "+v"(q));
            const bool klo = q < 2;
            {
                LAS unsigned char* SL = F.lds + slot_off(w);
                int cq8 = 8 * q; asm volatile("" : "+v"(cq8));
                const LAS float* cst = (const LAS float*)(F.lds + SB_OFF) + cq8;
                float ss = 0.f;
#pragma unroll
                for (int ks = 0; ks < 2; ++ks) {
                    const f32x4 k0 = *(const LAS f32x4*)(cst + 32 * ks), k1 = *(const LAS f32x4*)(cst + 32 * ks + 4);
                    const float kv[8] = {bflo(R.k[ks].x), bfhi(R.k[ks].x), bflo(R.k[ks].y), bfhi(R.k[ks].y), bflo(R.k[ks].z), bfhi(R.k[ks].z), bflo(R.k[ks].w), bfhi(R.k[ks].w)};
#pragma unroll
                    for (int e = 0; e < 4; ++e) { const float p0 = kv[e] * k0[e], p1 = kv[4 + e] * k1[e]; ss += p0 * p0 + p1 * p1; } }
                ss += __shfl_xor(ss, 16); ss += __shfl_xor(ss, 32);
                const float inv = __builtin_amdgcn_rsqf(ss + 1e-12f);
                bf16x8 fKT[2], fRT[2], fBT[2], fKQ[2]; float bonp = 0.f;
#pragma unroll
                for (int ks = 0; ks < 2; ++ks) {
                    const v4u xr = R.r[ks], xk = R.k[ks], xv = R.v[ks], xe = R.e[ks]; const v2u xa = R.a[ks];
                    const f32x4 k0 = *(const LAS f32x4*)(cst + 32 * ks), k1 = *(const LAS f32x4*)(cst + 32 * ks + 4), a0 = *(const LAS f32x4*)(cst + 64 + 32 * ks), a1 = *(const LAS f32x4*)(cst + 64 + 32 * ks + 4);
                    const float kkw[8] = {k0[0], k0[1], k0[2], k0[3], k1[0], k1[1], k1[2], k1[3]}, kaw[8] = {a0[0], a0[1], a0[2], a0[3], a1[0], a1[1], a1[2], a1[3]};
                    const f32x4 q0 = *(const LAS f32x4*)(cst + 128 + 32 * ks), q1 = *(const LAS f32x4*)(cst + 128 + 32 * ks + 4); const float rkw[8] = {q0[0], q0[1], q0[2], q0[3], q1[0], q1[1], q1[2], q1[3]};
                    const float r[8] = {bflo(xr.x), bfhi(xr.x), bflo(xr.y), bfhi(xr.y), bflo(xr.z), bfhi(xr.z), bflo(xr.w), bfhi(xr.w)};
                    const float k[8] = {bflo(xk.x), bfhi(xk.x), bflo(xk.y), bfhi(xk.y), bflo(xk.z), bfhi(xk.z), bflo(xk.w), bfhi(xk.w)};
                    const float v[8] = {bflo(xv.x), bfhi(xv.x), bflo(xv.y), bfhi(xv.y), bflo(xv.z), bfhi(xv.z), bflo(xv.w), bfhi(xv.w)};
                    const float ku8 = 1.0f / 255.0f;
                    const float ai[8] = {(float)(xa.x & 0xffu) * ku8, (float)((xa.x >> 8) & 0xffu) * ku8, (float)((xa.x >> 16) & 0xffu) * ku8, (float)(xa.x >> 24) * ku8,
                                         (float)(xa.y & 0xffu) * ku8, (float)((xa.y >> 8) & 0xffu) * ku8, (float)((xa.y >> 16) & 0xffu) * ku8, (float)(xa.y >> 24) * ku8};
                    const float lw[8] = {hlo(xe.x), hhi(xe.x), hlo(xe.y), hhi(xe.y), hlo(xe.z), hhi(xe.z), hlo(xe.w), hhi(xe.w)};
                    float kt[8], rt[8], btl[8], kq[8], cl[8], G[8], Gi[8], Gm[8], GCv[8];
#pragma unroll
                    for (int e = 0; e < 8; ++e) cl[e] = lw[e];
#pragma unroll
                    for (int e = 0; e < 8; ++e) cl[e] += dpp_shr(cl[e], 1, 0.f);
#pragma unroll
                    for (int e = 0; e < 8; ++e) cl[e] += dpp_shr(cl[e], 2, 0.f);
#pragma unroll
                    for (int e = 0; e < 8; ++e) cl[e] += dpp_shr(cl[e], 4, 0.f);
#pragma unroll
                    for (int e = 0; e < 8; ++e) cl[e] += dpp_shr(cl[e], 8, 0.f);
#pragma unroll
                    for (int e = 0; e < 8; ++e) { G[e] = __builtin_amdgcn_exp2f(cl[e]); Gi[e] = __builtin_amdgcn_exp2f(-cl[e]); }
#pragma unroll
                    for (int e = 0; e < 8; ++e) { Gm[e] = dpp_shr(G[e], 1, 1.0f); GCv[e] = __shfl(G[e], (lane & 48) | 15); }
#pragma unroll
                    for (int e = 0; e < 8; ++e) {
                        const float kke = k[e] * kkw[e] * inv, kd = k[e] * ((ai[e] - 1.0f) * kaw[e] + 1.0f), bb = kke * ai[e], ratio = GCv[e] * Gi[e];
                        kt[e] = Gm[e] * kke; rt[e] = G[e] * r[e]; btl[e] = bb * Gi[e]; kq[e] = kd * Gi[e];
                        bonp += r[e] * kd * rkw[e];
                        const int j = 32 * ks + 8 * q + e;
                        const unsigned w0 = pk2(kt[e], bb * ratio), w1 = pk2(kd * ratio, v[e]);
                        ((LAS bf16*)(SL + SL_Z))[j * 16 + c] = (bf16)(w0 & 0xffffu); ((LAS bf16*)(SL + SL_BGT))[j * 16 + c] = (bf16)(w0 >> 16);
                        ((LAS bf16*)(SL + SL_KGT))[j * 16 + c] = (bf16)(w1 & 0xffffu); ((LAS bf16*)(SL + SL_VT))[j * 16 + c] = (bf16)(w1 >> 16);
                    }
                    if (c == 15) { *(LAS f32x4*)(SL + SL_GC + (32 * ks + 8 * q) * 4) = (f32x4){G[0], G[1], G[2], G[3]}; *(LAS f32x4*)(SL + SL_GC + (32 * ks + 8 * q + 4) * 4) = (f32x4){G[4], G[5], G[6], G[7]}; }
                    v4u p; p.x = pk2(kt[0], kt[1]); p.y = pk2(kt[2], kt[3]); p.z = pk2(kt[4], kt[5]); p.w = pk2(kt[6], kt[7]); fKT[ks] = __builtin_bit_cast(bf16x8, p);
                    p.x = pk2(rt[0], rt[1]); p.y = pk2(rt[2], rt[3]); p.z = pk2(rt[4], rt[5]); p.w = pk2(rt[6], rt[7]); fRT[ks] = __builtin_bit_cast(bf16x8, p);
                    { v2u p0; p0.x = p.x; p0.y = p.y; v2u p1; p1.x = p.z; p1.y = p.w; const int pp = 32 * ks + 16 * (q & 1) + 4 * (q >> 1);
                      *(LAS v2u*)(SL + SL_RT + sw64(c, pp)) = p0; *(LAS v2u*)(SL + SL_RT + sw64(c, pp + 8)) = p1; }
                    p.x = pk2(btl[0], btl[1]); p.y = pk2(btl[2], btl[3]); p.z = pk2(btl[4], btl[5]); p.w = pk2(btl[6], btl[7]); fBT[ks] = __builtin_bit_cast(bf16x8, p);
                    p.x = pk2(kq[0], kq[1]); p.y = pk2(kq[2], kq[3]); p.z = pk2(kq[4], kq[5]); p.w = pk2(kq[6], kq[7]); fKQ[ks] = __builtin_bit_cast(bf16x8, p);
                    asm volatile("" ::: "memory");
                }
                bonp += __shfl_xor(bonp, 16); bonp += __shfl_xor(bonp, 32);
                if (q == 0 && (NSL * bt + w) * CK >= CTXL) BON[(size_t)scan_row((NSL * bt + w) * CK + c, b, dir) * NH + h] = bonp;
                const f32x4 z4 = (f32x4){0.f, 0.f, 0.f, 0.f};
                f32x4 accA = mfma16(fBT[1], fKT[1], mfma16(fBT[0], fKT[0], z4)), accAr = mfma16(fBT[1], fRT[1], mfma16(fBT[0], fRT[0], z4));
                f32x4 accCm = mfma16(fKQ[1], fKT[1], mfma16(fKQ[0], fKT[0], z4)), accCr = mfma16(fKQ[1], fRT[1], mfma16(fKQ[0], fRT[0], z4));
#pragma unroll
                for (int g = 0; g < 4; ++g) { const int srow = 4 * q + g; const bool lt = srow < c, le = srow <= c;
                    accA[g] = lt ? accA[g] : 0.f; accAr[g] = le ? accAr[g] : 0.f; accCm[g] = lt ? accCm[g] : 0.f; accCr[g] = le ? accCr[g] : 0.f;
                    ((LAS float*)(SL + SL_AF))[srow * 16 + c] = accA[g]; ((LAS bf16*)(SL + SL_ABF))[srow * 16 + c] = (bf16)f2bf(accA[g]); ((LAS bf16*)(SL + SL_Z))[(64 + srow) * 16 + c] = (bf16)f2bf(accCm[g]); }
                { v2u p; p.x = pk2(accAr[0], accAr[1]); p.y = pk2(accAr[2], accAr[3]); *(LAS v2u*)(SL + SL_ART + (c * 16 + 4 * q) * 2) = p; }
                { v2u p; p.x = pk2(accCr[0], accCr[1]); p.y = pk2(accCr[2], accCr[3]); *(LAS v2u*)(SL + SL_CRT + (c * 16 + 4 * q) * 2) = p; }
                LDS_WAIT(); asm volatile("" ::: "memory");
                {
                    const int base = c & 8, cl = c & 7; float x[8];
#pragma unroll
                    for (int sr = 7; sr >= 0; --sr) { float acc = 0.f;
#pragma unroll
                        for (int m = sr + 1; m < 8; ++m) acc += ((const LAS float*)(SL + SL_AF))[(base + sr) * 16 + base + m] * x[m];
                        x[sr] = (sr < cl) ? -acc : ((sr == cl) ? -1.0f : 0.f); }
                    if (q == 0) { v4u px; px.x = pk2(x[0], x[1]); px.y = pk2(x[2], x[3]); px.z = pk2(x[4], x[5]); px.w = pk2(x[6], x[7]);
                        *(LAS v4u*)(SL + SL_TMT + (c * 16 + base) * 2) = px; *(LAS v4u*)(SL + SL_TMT + (c * 16 + (base ^ 8)) * 2) = (v4u){0u, 0u, 0u, 0u};
#pragma unroll
                        for (int sr = 0; sr < 8; ++sr) { ((LAS bf16*)(SL + SL_TM))[(base + sr) * 16 + c] = (bf16)f2bf(x[sr]); ((LAS bf16*)(SL + SL_TM))[((base ^ 8) + sr) * 16 + c] = (bf16)0; } }
                    LDS_WAIT(); asm volatile("" ::: "memory");
                    const bf16x8 fAb = frag_ld(SL + SL_ABF + (c * 16 + 8 * q) * 2, klo), fTd = frag_ld(SL + SL_TMT + (c * 16 + 8 * q) * 2, klo);
                    const f32x4 d1 = mfma16(fAb, fTd, z4);
                    bf16x8 fD1; { v4u p; p.x = pk2(d1[0], d1[1]); p.y = pk2(d1[2], d1[3]); p.z = 0u; p.w = 0u; fD1 = __builtin_bit_cast(bf16x8, p); }
                    const f32x4 d2 = mfma16(fD1, frag4_ld(SL + SL_TM + (c * 16 + 4 * q) * 2), z4);
                    if (c < 8 && q >= 2) {
#pragma unroll
                        for (int g = 0; g < 4; ++g) ((LAS bf16*)(SL + SL_TMT))[(4 * q + g) * 16 + c] = (bf16)f2bf(d2[g]); }
                }
                LDS_WAIT(); asm volatile("" ::: "memory");
                {
                    const bf16x8 fT = frag_ld(SL + SL_TMT + (c * 16 + 8 * q) * 2, klo);
#pragma unroll
                    for (int zt = 0; zt < 5; ++zt) { const bf16x8 fZ = frag_ld(SL + SL_Z + ((16 * zt + c) * 16 + 8 * q) * 2, klo); const f32x4 d = mfma16(fZ, fT, z4);
                        v2u p; p.x = pk2(d[0], d[1]); p.y = pk2(d[2], d[3]); *(LAS v2u*)(SL + SL_ZTT + (c * ZTT_LD + (zt < 4 ? kpos(zt, q) : 64 + 4 * q)) * 2) = p; }
                }
            }
            if (bt + 1 < NBATCH) scan_fetch(R, RM, KM, VM, AX, EX, (size_t)scan_row((NSL * (bt + 1) + w) * CK + c, b, dir) * D + h * 64 + 8 * q);
            __syncthreads();
            asm volatile("" : "+v"(c), "+v"(q));
            if (w < 4) {
                const bool emit = (NSL * bt) * CK >= CTXL;
#pragma unroll 1
                for (int n = 0; n < NSL; ++n) { SeqOps A; seq_load(A, F.lds + slot_off(n), w, c, q, klo); seq_step(A, X, emit, YO, NSL * bt + n, b, dir, h, w, c, q); }
            }
            __syncthreads();
        }
    }
}

__device__ __forceinline__ void p7_readout(Frame& F, const Args& a) {
    const bf16* VM = (const bf16*)(F.ws + WS_VM); const float* BONF = (const float*)(F.ws + WS_BON); const float* BONB = BONF + (size_t)NT * NH;
    const bf16* YF = (const bf16*)(F.ws + WS_YF); const bf16* YB = (const bf16*)(F.ws + WS_YB); bf16* Z = (bf16*)(F.ws + WS_Z);
    const int sub = F.tid & 15; const int ngrp = F.G * 32;
    for (int gid0 = F.vcu * 32 + (F.tid >> 4); gid0 < NT * NH; gid0 += 4 * ngrp) {
        v2u ayf[4], ayb[4], alv[4]; float abf[4], abb[4]; f32x4 alw[4], alb[4];
#pragma unroll
        for (int u = 0; u < 4; ++u) { const int gid = gid0 + u * ngrp; const int mrow = gid >> 5, h = gid & 31, c = h * 64 + 4 * sub; const size_t off = (size_t)mrow * D + c;
            ayf[u] = *(const v2u*)(YF + off); ayb[u] = *(const v2u*)(YB + off); alv[u] = *(const v2u*)(VM + off); abf[u] = BONF[gid]; abb[u] = BONB[gid]; alw[u] = *(const f32x4*)(a.in[I_LNW] + c); alb[u] = *(const f32x4*)(a.in[I_LNB] + c); }
#pragma unroll
        for (int u = 0; u < 4; ++u) { const int gid = gid0 + u * ngrp;
        const int mrow = gid >> 5, h = gid & 31, c = h * 64 + 4 * sub; const size_t off = (size_t)mrow * D + c;
        const v2u yf = ayf[u], yb = ayb[u], lv = alv[u];
        const f32x4 y = (f32x4){bflo(yf.x) + bflo(yb.x), bfhi(yf.x) + bfhi(yb.x), bflo(yf.y) + bflo(yb.y), bfhi(yf.y) + bfhi(yb.y)};
        const float mean = allred16((y.x + y.y) + (y.z + y.w)) * (1.0f / 64.0f); const f32x4 d = y - mean;
        const float var = allred16((d.x * d.x + d.y * d.y) + (d.z * d.z + d.w * d.w)) * (1.0f / 64.0f);
        const f32x4 yn = d * __builtin_amdgcn_rsqf(var + 64e-5f) * alw[u] + alb[u];
        const f32x4 v = (f32x4){bflo(lv.x), bfhi(lv.x), bflo(lv.y), bfhi(lv.y)};
        const f32x4 z = yn + v * (abf[u] + abb[u]); v2u wv; wv.x = pk2(z.x, z.y); wv.y = pk2(z.z, z.w); *(v2u*)(Z + off) = wv;
        }
    }
}
constexpr int RT_LD = 68;
__device__ __forceinline__ void p11_route(Frame& F, const Args& a) {
    for (int repa_ = 0, nrepa_ = opaque_n(1 + ((DUPMASK >> 16) & 1)); repa_ < nrepa_; ++repa_) {
        struct DecExp { const float* const* in; unsigned char* ws;
            __device__ __forceinline__ bool operator()(int it, TrJob& j) const {
                if (it < 0 || it >= 65 * 768) return false;
                const int e = it / 768, q = it % 768, which = q >> 8, r = q & 255;
                if (which < 2) { const float* src = (e < 64) ? (which == 0 ? in[I_EG] : in[I_EU]) + (size_t)e * D * DEXP : (which == 0 ? in[I_SG] : in[I_SU]);
                    const int kb = r >> 3, nb = r & 7, n0 = nb * 64;
                    j = TrJob{src, (bf16*)(ws + WS_GU) + (size_t)e * 1024 * D, DEXP, D, D, kb * 64, n0, (n0 >> 7) * 256 + which * 128 + (n0 & 127)}; }
                else { const float* src = (e < 64) ? in[I_ED] + (size_t)e * DEXP * D : in[I_SD];
                    const int kb = r >> 5, nb = r & 31; j = TrJob{src, (bf16*)(ws + WS_DT) + (size_t)e * D * DEXP, D, DEXP, DEXP, kb * 64, nb * 64, nb * 64}; }
                return true; } };
        DecExp dec{a.in, F.ws};
        tr_run(dec, F.vcu * 8 + F.wave, F.G * 8, (LAS unsigned*)(F.lds + F.wave * 16384), F.lane);
        __syncthreads();
    }
    const bf16* X1 = (const bf16*)(F.ws + WS_X1); const float* MOD = (const float*)(F.ws + WS_MOD); bf16* H2 = (bf16*)(F.ws + WS_H2);
    LAS float* hs = (LAS float*)F.lds;
    LAS float* wsb = hs + 64 * RT_LD;
    LAS float* lg = wsb + 64 * RT_LD;
    LAS float* lg2 = lg + 64 * 65;
    LAS float* selb = lg2 + 64 * 65;
    LAS float* rs = selb + 64 * 65;
    LAS int* cnt = (LAS int*)(rs + 64);
    LAS int* basee = cnt + 64;
    LAS int* eloc = basee + 64;
    LAS int* rloc = eloc + 512;
    for (int tile = F.vcu; tile < NT / 64; tile += F.G) {
        const int t0 = tile * 64, b = t0 >> 12;
        const float* sh2 = MOD + (size_t)b * 12288 + 6144; const float* sc2 = MOD + (size_t)b * 12288 + 8192; const float* g2 = a.in[I_N2G];
        if (F.tid < 64) cnt[F.tid] = 0;
        for (int rr = 0; rr < 8; ++rr) { const int tl = F.wave * 8 + rr; const v2u* xr = (const v2u*)(X1 + (size_t)(t0 + tl) * D) + F.lane; f32x4 v[8]; float s = 0.f;
#pragma unroll
            for (int q = 0; q < 8; ++q) { const v2u xw = xr[64 * q]; v[q] = (f32x4){bflo(xw.x), bfhi(xw.x), bflo(xw.y), bfhi(xw.y)}; s += (v[q].x * v[q].x + v[q].y * v[q].y) + (v[q].z * v[q].z + v[q].w * v[q].w); }
            const float rstd = 1.0f / sqrtf(wave_sum(s) * (1.0f / D) + 1e-6f); if (F.lane == 0) rs[tl] = rstd;
            v2u* o = (v2u*)(H2 + (size_t)(t0 + tl) * D) + F.lane;
#pragma unroll
            for (int q = 0; q < 8; ++q) { const f32x4 y = v[q] * rstd * ((const f32x4*)g2)[F.lane + 64 * q] * (((const f32x4*)sc2)[F.lane + 64 * q] + 1.0f) + ((const f32x4*)sh2)[F.lane + 64 * q];
                v2u w; w.x = pk2(y.x, y.y); w.y = pk2(y.z, y.w); o[64 * q] = w; } }
        __syncthreads();
        const int tg = F.tid & 15, eg = (F.tid >> 4) & 15, kh = F.tid >> 8;
        float acc[4][4];
#pragma unroll
        for (int i = 0; i < 4; ++i)
#pragma unroll
            for (int j = 0; j < 4; ++j) acc[i][j] = 0.f;
        const int stok = F.tid >> 3, sk8 = (F.tid & 7) * 8; const float rstd_s = rs[stok];
        f32x4 px0, px1, pw0, pw1;
        { const v4u xw = *(const v4u*)(X1 + (size_t)(t0 + stok) * D + sk8); px0 = (f32x4){bflo(xw.x), bfhi(xw.x), bflo(xw.y), bfhi(xw.y)}; px1 = (f32x4){bflo(xw.z), bfhi(xw.z), bflo(xw.w), bfhi(xw.w)}; const float* wp = a.in[I_RW] + F.tid * 8; pw0 = *(const f32x4*)wp; pw1 = *(const f32x4*)(wp + 4); }
        for (int kc = 0; kc < D / 64; ++kc) {
            { const int k0 = kc * 64 + sk8;
              const f32x4 ga = *(const f32x4*)(g2 + k0), gb = *(const f32x4*)(g2 + k0 + 4), ca = *(const f32x4*)(sc2 + k0), cb = *(const f32x4*)(sc2 + k0 + 4), ha = *(const f32x4*)(sh2 + k0), hb = *(const f32x4*)(sh2 + k0 + 4);
              const f32x4 y0 = px0 * rstd_s * ga * (ca + 1.0f) + ha, y1 = px1 * rstd_s * gb * (cb + 1.0f) + hb;
              hs[(sk8 + 0) * RT_LD + stok] = y0.x; hs[(sk8 + 1) * RT_LD + stok] = y0.y; hs[(sk8 + 2) * RT_LD + stok] = y0.z; hs[(sk8 + 3) * RT_LD + stok] = y0.w;
              hs[(sk8 + 4) * RT_LD + stok] = y1.x; hs[(sk8 + 5) * RT_LD + stok] = y1.y; hs[(sk8 + 6) * RT_LD + stok] = y1.z; hs[(sk8 + 7) * RT_LD + stok] = y1.w;
              const int wk = F.tid >> 3, we = (F.tid & 7) * 8; *(LAS f32x4*)(wsb + wk * RT_LD + we) = pw0; *(LAS f32x4*)(wsb + wk * RT_LD + we + 4) = pw1; }
            __syncthreads();
            if (kc + 1 < D / 64) { const v4u xw = *(const v4u*)(X1 + (size_t)(t0 + stok) * D + (kc + 1) * 64 + sk8); px0 = (f32x4){bflo(xw.x), bfhi(xw.x), bflo(xw.y), bfhi(xw.y)}; px1 = (f32x4){bflo(xw.z), bfhi(xw.z), bflo(xw.w), bfhi(xw.w)};
                const float* wp = a.in[I_RW] + (size_t)(kc + 1) * 4096 + F.tid * 8; pw0 = *(const f32x4*)wp; pw1 = *(const f32x4*)(wp + 4); }
#pragma unroll 8
            for (int k = kh * 32; k < kh * 32 + 32; ++k) { const f32x4 h4 = *(const LAS f32x4*)(hs + k * RT_LD + 4 * tg), w4 = *(const LAS f32x4*)(wsb + k * RT_LD + 4 * eg);
                acc[0][0] += h4.x * w4.x; acc[0][1] += h4.x * w4.y; acc[0][2] += h4.x * w4.z; acc[0][3] += h4.x * w4.w;
                acc[1][0] += h4.y * w4.x; acc[1][1] += h4.y * w4.y; acc[1][2] += h4.y * w4.z; acc[1][3] += h4.y * w4.w;
                acc[2][0] += h4.z * w4.x; acc[2][1] += h4.z * w4.y; acc[2][2] += h4.z * w4.z; acc[2][3] += h4.z * w4.w;
                acc[3][0] += h4.w * w4.x; acc[3][1] += h4.w * w4.y; acc[3][2] += h4.w * w4.z; acc[3][3] += h4.w * w4.w; }
            __syncthreads();
        }
        { LAS float* dstl = kh ? lg2 : lg;
#pragma unroll
          for (int i = 0; i < 4; ++i)
#pragma unroll
              for (int j = 0; j < 4; ++j) dstl[(4 * tg + i) * 65 + 4 * eg + j] = acc[i][j]; }
        __syncthreads();
        for (int idx = F.tid; idx < 4096; idx += 512) { const int tl = idx >> 6, e = idx & 63; const float sc = sigmoidf_(lg[tl * 65 + e] + lg2[tl * 65 + e]); lg[tl * 65 + e] = sc; selb[tl * 65 + e] = sc + a.in[I_RB][e]; }
        __syncthreads();
        if (F.tid < 64) {
            const int tl = F.tid; LAS float* sel = selb + tl * 65; const LAS float* scr = lg + tl * 65;
            float gs[8];
#pragma unroll
            for (int g = 0; g < 8; ++g) { float m1 = -INFINITY, m2 = -INFINITY;
#pragma unroll
                for (int j = 0; j < 8; ++j) { const float v = sel[g * 8 + j]; if (v > m1) { m2 = m1; m1 = v; } else if (v > m2) m2 = v; }
                gs[g] = m1 + m2; }
            unsigned gmask = 0u;
#pragma unroll
            for (int it = 0; it < 4; ++it) { float best = -INFINITY; int bi = 0;
#pragma unroll
                for (int g = 0; g < 8; ++g) { const bool ok = !((gmask >> g) & 1u) && gs[g] > best; best = ok ? gs[g] : best; bi = ok ? g : bi; }
                gmask |= 1u << bi; }
            for (int g = 0; g < 8; ++g) if (!((gmask >> g) & 1u)) { for (int j = 0; j < 8; ++j) sel[g * 8 + j] = -INFINITY; }
            float wv[8]; int ev[8]; float wsum = 0.f;
#pragma unroll
            for (int it = 0; it < 8; ++it) { float best = -INFINITY; int bi = 0;
                for (int e = 0; e < 64; ++e) { const float v = sel[e]; if (v > best) { best = v; bi = e; } }
                sel[bi] = -INFINITY; ev[it] = bi; wv[it] = scr[bi]; wsum += wv[it]; }
            const float inv = 2.5f / wsum;
#pragma unroll
            for (int it = 0; it < 8; ++it) { const int lr = atomicAdd((int*)&cnt[ev[it]], 1); eloc[tl * 8 + it] = ev[it]; rloc[tl * 8 + it] = lr;
                ((float*)(F.ws + WS_WSEL))[(size_t)(t0 + tl) * 8 + it] = wv[it] * inv; }
        }
        __syncthreads();
        if (F.tid < 64) basee[F.tid] = (int)__hip_atomic_fetch_add(F.ctl + CW_GCNT + F.tid, (unsigned)cnt[F.tid], __ATOMIC_RELAXED, __HIP_MEMORY_SCOPE_AGENT);
        __syncthreads();
        { const int e = eloc[F.tid]; ((int*)(F.ws + WS_EIDX))[(size_t)t0 * 8 + F.tid] = e; ((int*)(F.ws + WS_RANK))[(size_t)t0 * 8 + F.tid] = basee[e] + rloc[F.tid]; }
        __syncthreads();
    }
}
__device__ __forceinline__ int moe_tables(Frame& F) {
    LAS int* te = (LAS int*)(F.lds + TAB_OFF); LAS int* off = te + MAXTILES;
    if (F.tid < 64) off[66 + F.tid] = (int)__hip_atomic_load(F.ctl + CW_GCNT + F.tid, __ATOMIC_RELAXED, __HIP_MEMORY_SCOPE_AGENT);
    __syncthreads();
    if (F.tid == 0) { int o = 0; for (int e = 0; e < 64; ++e) { off[e] = o; o += (off[66 + e] + 255) & ~255; } off[64] = o; off[65] = o / 256 + NT / 256; }
    __syncthreads();
    const int ntiles = off[65];
    for (int rt = F.tid; rt < ntiles; rt += 512) { int e = 0; for (int j = 1; j <= 64; ++j) if (rt * 256 >= off[j]) e = j; te[rt] = e; }
    __syncthreads();
    return ntiles;
}
__device__ __forceinline__ void p12_slots(Frame& F) {
    (void)moe_tables(F);
    const LAS int* off = (const LAS int*)(F.lds + TAB_OFF) + MAXTILES;
    int* tok = (int*)(F.ws + WS_TOK);
    const int* eidx = (const int*)(F.ws + WS_EIDX); int* rank = (int*)(F.ws + WS_RANK);
    const int gt = F.vcu * 512 + F.tid, NGT = F.G * 512;
    for (int i = gt; i < NT * 8; i += NGT) { const int slot = off[eidx[i]] + rank[i]; tok[slot] = i >> 3; rank[i] = slot; }
    const int o64 = off[64];
    for (int t = gt; t < NT; t += NGT) tok[o64 + t] = t;
    if (gt == 0) F.ctl[CW_O64] = (unsigned)o64;
}
__device__ __forceinline__ void p15_final(Frame& F, const Args& a) {
    const int gw = F.vcu * 8 + F.wave, NGW = F.G * 8; const float* MOD = (const float*)(F.ws + WS_MOD); const unsigned char* YP = (const unsigned char*)(F.ws + WS_YP);
    const int* SLOTMAP = (const int*)(F.ws + WS_RANK); const float* WSEL = (const float*)(F.ws + WS_WSEL); const int o64 = (int)F.ctl[CW_O64];
    for (int t = gw; t < NT; t += NGW) {
        const int b = t >> 12; const float* gt2 = MOD + (size_t)b * 12288 + 10240; const float* fg = a.in[I_FG]; float* xr = a.out + (size_t)t * D; const bf16* x1r = (const bf16*)(F.ws + WS_X1) + (size_t)t * D;
        const v4u s0 = *(const v4u*)(SLOTMAP + (size_t)t * 8), s1 = *(const v4u*)(SLOTMAP + (size_t)t * 8 + 4); const f32x4 w0 = *(const f32x4*)(WSEL + (size_t)t * 8), w1 = *(const f32x4*)(WSEL + (size_t)t * 8 + 4);
        const unsigned sl[9] = {s0.x, s0.y, s0.z, s0.w, s1.x, s1.y, s1.z, s1.w, (unsigned)(o64 + t)}; const float wt[9] = {w0.x, w0.y, w0.z, w0.w, w1.x, w1.y, w1.z, w1.w, 1.0f};
        float v[2][16]; float s = 0.f;
#pragma unroll
        for (int jj = 0; jj < 2; ++jj) { const int col = 16 * F.lane + 1024 * jj; float m[16];
#pragma unroll
            for (int e = 0; e < 16; ++e) m[e] = 0.f;
#pragma unroll
            for (int j = 0; j < 9; ++j) { const v4u y = *(const v4u*)(YP + (size_t)sl[j] * D + col); const unsigned yw[4] = {y.x, y.y, y.z, y.w}; const float wj = wt[j];
#pragma unroll
                for (int e = 0; e < 4; ++e) { const f32x2 lo = __builtin_amdgcn_cvt_pk_f32_fp8((int)yw[e], false), hi = __builtin_amdgcn_cvt_pk_f32_fp8((int)yw[e], true);
                    m[4 * e] += wj * lo.x; m[4 * e + 1] += wj * lo.y; m[4 * e + 2] += wj * hi.x; m[4 * e + 3] += wj * hi.y; } }
#pragma unroll
            for (int e4 = 0; e4 < 4; ++e4) { const v2u xw = *(const v2u*)(x1r + col + 4 * e4); const f32x4 x0 = (f32x4){bflo(xw.x), bfhi(xw.x), bflo(xw.y), bfhi(xw.y)}, g0 = *(const f32x4*)(gt2 + col + 4 * e4);
#pragma unroll
                for (int e = 0; e < 4; ++e) { const float val = x0[e] + g0[e] * (m[4 * e4 + e] * (1.0f / YP_SCALE)); v[jj][4 * e4 + e] = val; s += val * val; } } }
        float rstd = __builtin_amdgcn_rsqf(wave_sum(s) * (1.0f / D) + 1e-6f);
#if defined(PROBE_PHASE)
        if (PROBE_PHASE >= 0) rstd *= 1.0f + (float)__hip_atomic_load(F.ctl + 12000, __ATOMIC_RELAXED, __HIP_MEMORY_SCOPE_AGENT) * 2e-6f;
#endif
#pragma unroll
        for (int jj = 0; jj < 2; ++jj) { const int col = 16 * F.lane + 1024 * jj;
#pragma unroll
            for (int e4 = 0; e4 < 4; ++e4) { const f32x4 f0 = *(const f32x4*)(fg + col + 4 * e4);
                *(f32x4*)(xr + col + 4 * e4) = (f32x4){v[jj][4 * e4], v[jj][4 * e4 + 1], v[jj][4 * e4 + 2], v[jj][4 * e4 + 3]} * rstd * f0; } }
    }
}
#ifndef MK_ONE_LAUNCH
#define MK_ONE_LAUNCH 1
#endif
constexpr int NPHASE = 16;
__global__ void __launch_bounds__(512, 2) mk_fwd(Args args) {
    extern __shared__ __attribute__((aligned(16))) unsigned char lds[];
    Frame F;
    F.lds = (LAS unsigned char*)lds; F.MISC = (volatile LAS unsigned*)(F.lds + LDSCTL_OFF);
    int wave0 = __builtin_amdgcn_readfirstlane((int)threadIdx.x >> 6); asm volatile("" : "+s"(wave0));
    F.tid = threadIdx.x; F.lane = F.tid & 63; F.wave = wave0;
    F.G = gridDim.x; { const int bx = blockIdx.x; F.vcu = (F.G % 8 == 0) ? (bx % 8) * (F.G / 8) + bx / 8 : bx; }
    F.ws = args.ws; F.ctl = (unsigned*)(args.ws + WS_CTL);
    for (int u = F.tid; u < 256; u += 512) ((LAS unsigned*)(F.lds + LDSCTL_OFF))[u] = 0u;
    __syncthreads();
    XcdBarrier bar; bar.bar = F.ctl + CW_BAR; bar.x = 0; bar.st = nullptr;
    if (MK_ONE_LAUNCH) bar = xcd_barrier_post(F.ctl + CW_BAR, F.MISC + 8);
    const int lo = args.ph_lo, hi = args.ph_hi;
#ifndef PHMASK
#define PHMASK 0xFFFF
#endif
#define IN(k) (((PHMASK >> (k)) & 1) && lo <= (k) && (k) < hi)
#ifndef DUPMASK
#define DUPMASK 0
#endif
#define DUP(k) for (int rep_ = 0, nrep_ = opaque_n(1 + ((DUPMASK >> (k)) & 1)); rep_ < nrep_; ++rep_)
#define FRESH() do { int l_ = (int)__builtin_amdgcn_mbcnt_hi(~0u, __builtin_amdgcn_mbcnt_lo(~0u, 0u)); asm volatile("" : "+v"(l_)); int w_ = wave0; asm volatile("" : "+s"(w_)); F.lane = l_; F.wave = w_; F.tid = w_ * 64 + l_; { unsigned char* p_ = args.ws; asm volatile("" : "+s"(p_)); F.ws = p_; ws = p_; F.ctl = (unsigned*)(p_ + WS_CTL); } } while (0)
#define SEAM(k) do { if (MK_ONE_LAUNCH) { if (IN(k) && IN((k) + 1)) { xcd_barrier(bar); if ((DUPMASK >> 18) & 1) xcd_barrier(bar); } } } while (0)
    const int G = F.G, c = (int)blockIdx.x;
#ifndef PROBE_PHASE
#define PROBE_PHASE -1
#endif
    unsigned long long pt0_ = 0;
#define PSTART(k) do { if (PROBE_PHASE == (k)) pt0_ = __builtin_amdgcn_s_memrealtime(); } while (0)
#define PEND(k) do { if (PROBE_PHASE == (k) && blockIdx.x == 0 && threadIdx.x == 0) { const unsigned long long t1_ = __builtin_amdgcn_s_memrealtime(); __hip_atomic_store(F.ctl + 12000, (unsigned)(t1_ - pt0_), __ATOMIC_RELAXED, __HIP_MEMORY_SCOPE_AGENT); } } while (0)
    unsigned char* ws = args.ws;

    PSTART(0);
    if (IN(0)) DUP(0) { FRESH(); p0_prologue(F, args); } SEAM(0); PEND(0);
    PSTART(1);
    if (IN(1)) DUP(1) { FRESH(); p1_norm1(F, args); } SEAM(1); PEND(1);
    PSTART(2);
    if (IN(2)) DUP(2) { FRESH();
        G1Order S{(const char*)(ws + WS_HA), (const char*)(ws + WS_WIN), (size_t)256 * D * 2, (size_t)256 * D * 2, G, c};
        EpiG1 E{(bf16*)(ws + WS_U), (bf16*)(ws + WS_SLAB), (unsigned char*)(ws + WS_GATES)};
        pg8::gemm_phase<EpiG1, G1Order, false>(F.lds + RING_OFF, F.wave, D, D, D, S, E);
    } SEAM(2); PEND(2);
    PSTART(3);
    if (IN(3)) DUP(3) { FRESH(); p3_prep(F, args); } SEAM(3); PEND(3);
    PSTART(4);
    if (IN(4)) DUP(4) { FRESH();
#ifndef NO4A
        {
            RepOrder S{(const char*)(ws + WS_LIN), (const char*)(ws + WS_LORA), (size_t)128 * 2, (size_t)D * 128 * 2, (size_t)256 * LINLD * 2, (size_t)256 * 128 * 2, MT / 256, D / 256, 4, G, c};
            EpiLora E{(unsigned short*)(ws + WS_EA), args.in[I_DW0], args.in[I_IA0]};
            pg8::gemm_phase<EpiLora, RepOrder, false>(F.lds + RING_OFF, F.wave, 128, LINLD, 128, S, E);
        }
#endif
    }
    if (IN(4)) DUP(4) { FRESH();
#ifndef NO4B
        {
            RepOrder S{(const char*)(ws + WS_DP), (const char*)(ws + WS_POOLW), (size_t)256 * 2, (size_t)256 * 256 * 2, (size_t)256 * 1024 * 2, (size_t)256 * 256 * 2, NT / 256, 1, 4, G, c};
            EpiPoolG E{(bf16*)(ws + WS_Y2), args.in[I_POOLS]};
            pg8::gemm_phase<EpiPoolG, RepOrder, false>(F.lds + RING_OFF, F.wave, 256, 1024, 256, S, E);
        }
#endif
    } SEAM(4); PEND(4);
    PSTART(5);
    if (IN(5)) DUP(5) { FRESH();
        RepOrder S{(const char*)(ws + WS_Y2), (const char*)(ws + WS_WPO), 0, 0, (size_t)256 * 1024 * 2, (size_t)256 * 1024 * 2, NT / 256, D / 256, 1, G, c};
        EpiMix<0> E{(bf16*)(ws + WS_MP), D, (const void*)(ws + WS_GATES), 4096, nullptr, 0};
        pg8::gemm_phase<EpiMix<0>, RepOrder, false>(F.lds + RING_OFF, F.wave, 1024, 1024, 1024, S, E);
    }
    PSTART(6);
    if (IN(6)) DUP(6) { FRESH(); p6_scan(F, args); if ((DUPMASK >> 19) & 1) { FRESH(); p6_scan(F, args); } } SEAM(6); PEND(6);
    PSTART(7);
    if (IN(7)) DUP(7) { FRESH(); p7_readout(F, args); } SEAM(7); PEND(7);
    PSTART(8);
    if (IN(8)) DUP(8) { FRESH();
        RepOrder S{(const char*)(ws + WS_LIN) + 512 * 2, (const char*)(ws + WS_G2), 0, 0, (size_t)256 * LINLD * 2, (size_t)256 * 256 * 2, NT / 256, D / 256, 1, G, c};
        EpiMix<1> E{(bf16*)(ws + WS_OR), D, (const void*)(ws + WS_Z), D, nullptr, 0};
        pg8::gemm_phase<EpiMix<1>, RepOrder, false>(F.lds + RING_OFF, F.wave, 256, LINLD, 256, S, E);
    } SEAM(8); PEND(8);
    PSTART(9);
    if (IN(9)) DUP(9) { FRESH();
        RepOrder S{(const char*)(ws + WS_OR), (const char*)(ws + WS_WRO), 0, 0, (size_t)256 * D * 2, (size_t)256 * D * 2, NT / 256, D / 256, 1, G, c};
        EpiMix<2> E{(bf16*)(ws + WS_Z), D, (const void*)(ws + WS_GATES + 2048), 4096, (const bf16*)(ws + WS_MP), D};
        pg8::gemm_phase<EpiMix<2>, RepOrder, false>(F.lds + RING_OFF, F.wave, D, D, D, S, E);
    } SEAM(9); PEND(9);
    PSTART(10);
    if (IN(10)) DUP(10) { FRESH();
        RepOrder S{(const char*)(ws + WS_Z), (const char*)(ws + WS_WO), 0, 0, (size_t)256 * D * 2, (size_t)256 * D * 2, NT / 256, D / 256, 1, G, c};
        EpiX1 E{args.in[I_X], (bf16*)(ws + WS_X1), (const float*)(ws + WS_MOD)};
        pg8::gemm_phase<EpiX1, RepOrder, false>(F.lds + RING_OFF, F.wave, D, D, D, S, E);
    } SEAM(10); PEND(10);
    PSTART(11);
    if (IN(11)) DUP(11) { FRESH(); p11_route(F, args); } SEAM(11); PEND(11);
    PSTART(12);
    if (IN(12)) DUP(12) { FRESH(); p12_slots(F); } SEAM(12); PEND(12);
    PSTART(13);
    if (IN(13)) DUP(13) { FRESH();
        const int ntiles = moe_tables(F);
        MoeOrder S{(const char*)(ws + WS_H2), (const char*)(ws + WS_GU), (const LAS int*)(F.lds + TAB_OFF), (const LAS int*)(F.lds + ROWTAB_OFF), 0, (size_t)1024 * D * 2, (size_t)256 * D * 2, ntiles, 4, G, c};
        { LAS int* rt = (LAS int*)(F.lds + ROWTAB_OFF); const int* tok = (const int*)(ws + WS_TOK); Unit uu;
          for (int i = 0; i < ROWTAB_UNITS && S.next(i, uu); ++i) if (F.tid < 256) rt[i * 256 + F.tid] = tok[uu.pm * 256 + F.tid];
          __syncthreads(); }
        EpiAct E{(bf16*)(ws + WS_ACT)};
        pg8::gemm_phase<EpiAct, MoeOrder, true>(F.lds + RING_OFF, F.wave, D, D, D, S, E);
    } SEAM(13); PEND(13);
    PSTART(14);
    if (IN(14)) DUP(14) { FRESH();
        const int ntiles = moe_tables(F);
        MoeOrder S{(const char*)(ws + WS_ACT), (const char*)(ws + WS_DT), (const LAS int*)(F.lds + TAB_OFF), (const LAS int*)(F.lds + ROWTAB_OFF), (size_t)256 * DEXP * 2, (size_t)D * DEXP * 2, (size_t)256 * DEXP * 2, ntiles, 8, G, c};
        EpiDown E{(unsigned char*)(ws + WS_YP)};
        pg8::gemm_phase<EpiDown, MoeOrder, false>(F.lds + RING_OFF, F.wave, DEXP, DEXP, DEXP, S, E);
    } SEAM(14); PEND(14);
    PSTART(15);
    if (IN(15)) DUP(15) { FRESH(); p15_final(F, args); }
#undef IN
#undef SEAM
}

extern "C" void kernel_launch(void* const* d_in, const int* in_sizes, int n_in, void* d_out, int out_size, void* d_ws, size_t ws_size, hipStream_t stream) {
    static int grid = 0;
    if (grid == 0) {
        if (n_in != 34 || in_sizes[0] != NT * D || out_size != NT * D || ws_size < WS_END) { fprintf(stderr, "kernel_launch: unexpected shapes (n_in %d, in0 %d, out %d, ws %zu < %zu)\n", n_in, n_in > 0 ? in_sizes[0] : -1, out_size, ws_size, (size_t)WS_END); grid = -1; return; }
        int dev = 0, cus = 0, per_cu = 0;
        if (hipGetDevice(&dev) != hipSuccess || hipDeviceGetAttribute(&cus, hipDeviceAttributeMultiprocessorCount, dev) != hipSuccess) { grid = -1; return; }
        if (hipFuncSetAttribute((const void*)mk_fwd, hipFuncAttributeMaxDynamicSharedMemorySize, LDS_BYTES) != hipSuccess) { fprintf(stderr, "kernel_launch: hipFuncSetAttribute failed\n"); grid = -1; return; }
        if (hipOccupancyMaxActiveBlocksPerMultiprocessor(&per_cu, (const void*)mk_fwd, 512, LDS_BYTES) != hipSuccess || per_cu < 1) fprintf(stderr, "kernel_launch: occupancy query reports %d\n", per_cu);
        (void)hipGetLastError();
        grid = cus;
    }
    if (grid < 0) return;
    if (hipMemsetAsync((char*)d_ws + WS_CTL, 0, CTL_ZERO_BYTES, stream) != hipSuccess) return;
    Args a{};
    for (int i = 0; i < 34; ++i) a.in[i] = (const float*)d_in[i];
    a.out = (float*)d_out; a.ws = (unsigned char*)d_ws;
#if MK_ONE_LAUNCH
    a.ph_lo = 0; a.ph_hi = NPHASE;
    hipLaunchKernelGGL(mk_fwd, dim3(grid), dim3(512), LDS_BYTES, stream, a);
#else
    for (int p = 0; p < NPHASE; ++p) { a.ph_lo = p; a.ph_hi = p + 1; hipLaunchKernelGGL(mk_fwd, dim3(grid), dim3(512), LDS_BYTES, stream, a); }
#endif
}
```

```cpp
#include <hip/hip_runtime.h>
#include <cstdio>
#include <cstdint>
#ifndef DUPMASK
#define DUPMASK 0x0
#endif
#ifndef PROBE_PHASE
#define PROBE_PHASE -1
#endif

#define GAS __attribute__((address_space(1)))
#define LAS __attribute__((address_space(3)))
typedef unsigned short bf16;
typedef unsigned v4u __attribute__((ext_vector_type(4)));
typedef unsigned v2u __attribute__((ext_vector_type(2)));
typedef float f32x4 __attribute__((ext_vector_type(4)));
typedef float f32x2 __attribute__((ext_vector_type(2)));
typedef short bf16x8 __attribute__((ext_vector_type(8)));

constexpr int D = 2048, NB = 4, TSEQ = 4096, NT = NB * TSEQ  , CTXL = 256, NC = NB * CTXL  , MT = NT + NC  ;
constexpr int DIN = 11904, DSH = 6784, NPAD = 12032, SLABLD = 6912, NH = 32, HS = 64;
constexpr int NEXP = 64, DEXP = 512, TOPK = 8;
constexpr int NSLOT = NT * TOPK + NEXP * 256 + NT;
constexpr int MAXTILES = NSLOT / 256;
constexpr int LINLD = 768;

__device__ __forceinline__ int opaque_n(int n) { asm volatile("" : "+s"(n)); return n; }
__device__ __forceinline__ unsigned f2bf(float f) { unsigned u = __builtin_bit_cast(unsigned, f); return (u + 0x7fffu + ((u >> 16) & 1u)) >> 16; }
typedef __bf16 bf16x2_t __attribute__((ext_vector_type(2)));
__device__ __forceinline__ unsigned pk2(float lo, float hi) { const f32x2 v = {lo, hi}; const bf16x2_t b = __builtin_convertvector(v, bf16x2_t); return __builtin_bit_cast(unsigned, b); }
__device__ __forceinline__ float bflo(unsigned w) { return __builtin_bit_cast(float, w << 16); }
__device__ __forceinline__ float bfhi(unsigned w) { return __builtin_bit_cast(float, w & 0xffff0000u); }
__device__ __forceinline__ unsigned pkh2(float lo, float hi) { const unsigned short a = __builtin_bit_cast(unsigned short, (_Float16)lo), b = __builtin_bit_cast(unsigned short, (_Float16)hi); return (unsigned)a | ((unsigned)b << 16); }
__device__ __forceinline__ float hlo(unsigned w) { return (float)__builtin_bit_cast(_Float16, (unsigned short)(w & 0xffffu)); }
__device__ __forceinline__ float hhi(unsigned w) { return (float)__builtin_bit_cast(_Float16, (unsigned short)(w >> 16)); }
__device__ __forceinline__ float sigmoidf_(float x) { return __builtin_amdgcn_rcpf(1.0f + __builtin_amdgcn_exp2f(-1.44269504f * x)); }
__device__ __forceinline__ float tanhf_(float x) { return 1.0f - 2.0f * __builtin_amdgcn_rcpf(1.0f + __builtin_amdgcn_exp2f(2.88539008f * x)); }
__device__ __forceinline__ float wave_sum(float v) {
#pragma unroll
    for (int o = 1; o < 64; o <<= 1) v += __shfl_xor(v, o);
    return v;
}
__device__ __forceinline__ float dpp_f(float v, const int ctrl_sel) {
    int r;
    const int x = __builtin_bit_cast(int, v);
    if (ctrl_sel == 0) r = __builtin_amdgcn_update_dpp(0, x, 0xB1, 0xF, 0xF, true);
    else if (ctrl_sel == 1) r = __builtin_amdgcn_update_dpp(0, x, 0x4E, 0xF, 0xF, true);
    else if (ctrl_sel == 2) r = __builtin_amdgcn_update_dpp(0, x, 0x141, 0xF, 0xF, true);
    else r = __builtin_amdgcn_update_dpp(0, x, 0x140, 0xF, 0xF, true);
    return __builtin_bit_cast(float, r);
}
__device__ __forceinline__ float allred16(float v) { v += dpp_f(v, 0); v += dpp_f(v, 1); v += dpp_f(v, 2); v += dpp_f(v, 3); return v; }

#define LDS_WAIT() asm volatile("s_waitcnt lgkmcnt(0)" ::: "memory")
#define VM_WAIT() asm volatile("s_waitcnt vmcnt(0)" ::: "memory")

namespace pg8 {
constexpr int BM = 256, BK = 64, HALF = 128, HTB = HALF * BK * 2, STAGE_BYTES = 8 * HTB, NXCD = 8, WGM = 8;
__host__ __device__ __forceinline__ int lds_byte(int r, int c) { const int st = (r >> 4) * 2 + (c >> 5), rr = r & 15, cc = c & 31, ob = rr * 64 + cc * 2; return st * 1024 + (ob ^ (((ob >> 9) & 1) << 5)); }
__host__ __device__ __forceinline__ void stage_rc(int b, int& R, int& C) { const int st = b / 1024, sb = b % 1024, swz = sb ^ (((sb >> 9) & 1) << 5); R = (st >> 1) * 16 + swz / 64; C = (st & 1) * 32 + (swz % 64) / 2; }
__host__ __device__ __forceinline__ int perm32(int rho) { const int n = rho >> 4, i = rho & 15; return 8 * (i >> 2) + 4 * n + (i & 3); }
struct Unit { const char* A; const char* B; int pm, pn, aux, ui; };
__device__ __forceinline__ int xcd_remap(int L, int nwg) { const int q = nwg / NXCD, r = nwg % NXCD, xcd = L % NXCD, off = L / NXCD; return (xcd < r ? xcd * (q + 1) : r * (q + 1) + (xcd - r) * q) + off; }
__device__ __forceinline__ void grid_tile(int wgid, int nM, int nN, int& pm, int& pn) { const int nig = WGM * nN, gid = wgid / nig, fm = gid * WGM, gsz = (nM - fm) < WGM ? (nM - fm) : WGM; pm = fm + ((wgid % nig) % gsz); pn = (wgid % nig) / gsz; }

__device__ __forceinline__ void stage2(LAS unsigned char* lds, int bufoff, unsigned ldsw, const char* g, unsigned o0, unsigned o1) {
    __builtin_amdgcn_global_load_lds((const unsigned*)(g + o0), (LAS unsigned*)(lds + bufoff + ldsw), 16, 0, 0);
    __builtin_amdgcn_global_load_lds((const unsigned*)(g + o1), (LAS unsigned*)(lds + bufoff + ldsw + 8192), 16, 0, 0);
}

template <class Epi, class = void> struct EpiPerm16 { static constexpr bool value = false; };
template <class Epi> struct EpiPerm16<Epi, decltype((void)Epi::PERM16)> { static constexpr bool value = Epi::PERM16; };
template <class Epi> __host__ __device__ constexpr bool epi_perm16() { return EpiPerm16<Epi>::value; }
template <class Epi> __host__ __device__ __forceinline__ int perm_row(int R) {
    if (epi_perm16<Epi>()) { const int wc = R >> 5, rho = R & 31, n = rho >> 4, i = rho & 15; return 64 * wc + 16 * (i >> 2) + 4 * n + (i & 3); }
    return Epi::PERM ? ((R & ~31) + perm32(R & 31)) : R;
}
template <class Epi, class Sched, bool GATHER, bool ALIGN_EPI = true>
__device__ __forceinline__ void gemm_phase(LAS unsigned char* lds, const int wave_, const int K, const int lda, const int ldb, const Sched& S, const Epi& E) {
    int tid_ = wave_ * 64 + (int)__builtin_amdgcn_mbcnt_hi(~0u, __builtin_amdgcn_mbcnt_lo(~0u, 0u)); asm volatile("" : "+v"(tid_));
    const int tid = tid_, wid = __builtin_amdgcn_readfirstlane(tid >> 6), lane = tid & 63, wr = wid >> 2, wc = wid & 3, fr = lane & 15, fq = lane >> 4;
    const int nt = opaque_n(K / BK);
    unsigned voffA[2], voffB[2]; int RA[2], CA[2];
#pragma unroll
    for (int i = 0; i < 2; ++i) { int R, C; stage_rc(tid * 16 + i * 8192, R, C); const int Rb = perm_row<Epi>(R);
        RA[i] = R; CA[i] = C; voffA[i] = (unsigned)(R * lda + C) * 2u; voffB[i] = (unsigned)(Rb * ldb + C) * 2u; }
    const size_t kstep = (size_t)(BK * 2);
    const size_t hstepA = (size_t)HALF * lda * 2, hstepB = (size_t)(epi_perm16<Epi>() ? 8 : HALF) * ldb * 2;
    const unsigned ldsw = (unsigned)wid * 1024u;
    const int aoff = lds_byte(wr * 64 + fr, fq * 8), boff = lds_byte(wc * 32 + fr, fq * 8);
#define PG8_SA(b, h) (((b) * 2 + (h)) * HTB)
#define PG8_SB(b, h) ((4 + (b) * 2 + (h)) * HTB)
#define PG8_STB(bufoff, gbase) stage2(lds, (bufoff), ldsw, (gbase), voffB[0], voffB[1])
#define PG8_STA(bufoff, gk, h, NX) do { if constexpr (GATHER) { const unsigned _o0 = (NX) ? vn[h][0] : vc[h][0], _o1 = (NX) ? vn[h][1] : vc[h][1]; stage2(lds, (bufoff), ldsw, (gk), _o0, _o1); } \
        else stage2(lds, (bufoff), ldsw, (gk) + (h) * hstepA, voffA[0], voffA[1]); } while (0)
#define PG8_LDA(dst, b, h) do { _Pragma("unroll") for (int m = 0; m < 4; ++m) _Pragma("unroll") for (int k = 0; k < 2; ++k) dst[m][k] = *(const LAS bf16x8*)(lds + PG8_SA(b, h) + aoff + m * 2048 + k * 1024); } while (0)
#define PG8_LDB(dst, b, h) do { _Pragma("unroll") for (int n = 0; n < 2; ++n) _Pragma("unroll") for (int k = 0; k < 2; ++k) dst[n][k] = *(const LAS bf16x8*)(lds + PG8_SB(b, h) + boff + n * 2048 + k * 1024); } while (0)
#define PG8_MMA(ai, bj, At, Bt) do { __builtin_amdgcn_s_setprio(1); _Pragma("unroll") for (int m = 0; m < 4; ++m) _Pragma("unroll") for (int n = 0; n < 2; ++n) _Pragma("unroll") for (int k = 0; k < 2; ++k) \
        acc[ai][bj][m][n] = __builtin_amdgcn_mfma_f32_16x16x32_bf16(Bt[n][k], At[m][k], acc[ai][bj][m][n], 0, 0, 0); __builtin_amdgcn_s_setprio(0); } while (0)
#define PG8_WAIT_V(n) asm volatile("s_waitcnt vmcnt(" #n ")" ::: "memory")
#define PG8_WAIT_L(n) asm volatile("s_waitcnt lgkmcnt(" #n ")" ::: "memory")
#define PG8_BAR __builtin_amdgcn_s_barrier()
#define PG8_SCHED __builtin_amdgcn_sched_barrier(0)
    Unit cur, nxt; int ui = 0;
    if (!S.next(0, cur)) return;
    unsigned vc[2][2], vn[2][2];
    if constexpr (GATHER) {
#pragma unroll
        for (int h = 0; h < 2; ++h)
#pragma unroll
            for (int i = 0; i < 2; ++i) { vc[h][i] = ((unsigned)S.row(cur, h * HALF + RA[i]) * (unsigned)lda + (unsigned)CA[i]) * 2u; vn[h][i] = vc[h][i]; }
        if constexpr (!Sched::ROW_LDS) asm volatile("s_waitcnt vmcnt(0)" ::: "memory");
    }
    f32x4 acc[2][2][4][2];
#pragma unroll
    for (int a = 0; a < 2; ++a)
#pragma unroll
        for (int b = 0; b < 2; ++b)
#pragma unroll
            for (int m = 0; m < 4; ++m)
#pragma unroll
                for (int n = 0; n < 2; ++n) acc[a][b][m][n] = (f32x4){0.f, 0.f, 0.f, 0.f};
    bf16x8 At[4][2], B0[2][2], B1[2][2];
    const char* cA = cur.A; const char* cB = cur.B;
    PG8_STB(PG8_SB(0, 0), cB); PG8_STB(PG8_SB(0, 1), cB + hstepB); PG8_STA(PG8_SA(0, 0), cA, 0, false); PG8_STA(PG8_SA(0, 1), cA, 1, false);
    if (wr == 1) PG8_BAR;
    PG8_WAIT_V(2); PG8_BAR;
    PG8_STB(PG8_SB(1, 0), cB + kstep); PG8_STA(PG8_SA(1, 0), cA + kstep, 0, false); PG8_STB(PG8_SB(1, 1), cB + hstepB + kstep);
    PG8_WAIT_V(6); PG8_BAR;
    for (;;) {
        const bool has_next = S.next(ui + 1, nxt);
        const char* nA = has_next ? nxt.A : cA; const char* nB = has_next ? nxt.B : cB;
#pragma unroll 1
        for (int t = 0; t < nt; t += 2) {
            const bool last = (t == nt - 2);
            const char* a1 = cA + (size_t)(t + 1) * kstep;
            const char* a2 = last ? nA : cA + (size_t)(t + 2) * kstep; const char* b2 = last ? nB : cB + (size_t)(t + 2) * kstep;
            const char* a3 = a2 + kstep; const char* b3 = b2 + kstep;
            if constexpr (GATHER) {
                if (last && has_next) {
#pragma unroll
                    for (int h = 0; h < 2; ++h)
#pragma unroll
                        for (int i = 0; i < 2; ++i) vn[h][i] = ((unsigned)S.row(nxt, h * HALF + RA[i]) * (unsigned)lda + (unsigned)CA[i]) * 2u;
                    if constexpr (!Sched::ROW_LDS) asm volatile("s_waitcnt vmcnt(0)" ::: "memory");
                }
            }
            PG8_LDB(B0, 0, 0); PG8_LDB(B1, 0, 1); PG8_SCHED; PG8_LDA(At, 0, 0); PG8_STA(PG8_SA(1, 1), a1, 1, false);
            PG8_WAIT_V(8); PG8_WAIT_L(0); PG8_BAR; PG8_MMA(0, 0, At, B0); PG8_MMA(0, 1, At, B1); PG8_BAR; PG8_SCHED;
            PG8_LDA(At, 0, 1); PG8_STB(PG8_SB(0, 0), b2); PG8_STB(PG8_SB(0, 1), b2 + hstepB); PG8_STA(PG8_SA(0, 0), a2, 0, last);
            PG8_WAIT_V(8); PG8_WAIT_L(0); PG8_BAR; PG8_MMA(1, 0, At, B0); PG8_MMA(1, 1, At, B1); PG8_BAR; PG8_SCHED;
            PG8_LDB(B0, 1, 0); PG8_LDB(B1, 1, 1); PG8_SCHED; PG8_LDA(At, 1, 0); PG8_STA(PG8_SA(0, 1), a2, 1, last);
            PG8_WAIT_V(8); PG8_WAIT_L(0); PG8_BAR; PG8_MMA(0, 0, At, B0); PG8_MMA(0, 1, At, B1); PG8_BAR; PG8_SCHED;
            PG8_LDA(At, 1, 1); PG8_STB(PG8_SB(1, 0), b3); PG8_STB(PG8_SB(1, 1), b3 + hstepB); PG8_STA(PG8_SA(1, 0), a3, 0, last);
            PG8_WAIT_V(8); PG8_WAIT_L(0); PG8_BAR; PG8_MMA(1, 0, At, B0); PG8_MMA(1, 1, At, B1); PG8_BAR; PG8_SCHED;
        }
        if constexpr (ALIGN_EPI) { if (wr == 0) PG8_BAR; }
        { int fr_ = fr, fq_ = fq; asm volatile("" : "+v"(fr_), "+v"(fq_));
          E(acc, cur, wr, wc, fr_, fq_); }
        if (!has_next) break;
#pragma unroll
        for (int a = 0; a < 2; ++a)
#pragma unroll
            for (int b = 0; b < 2; ++b)
#pragma unroll
                for (int m = 0; m < 4; ++m)
#pragma unroll
                    for (int n = 0; n < 2; ++n) acc[a][b][m][n] = (f32x4){0.f, 0.f, 0.f, 0.f};
        cur = nxt; cA = nA; cB = nB; ++ui;
        if constexpr (GATHER) {
#pragma unroll
            for (int h = 0; h < 2; ++h)
#pragma unroll
                for (int i = 0; i < 2; ++i) vc[h][i] = vn[h][i];
        }
        if constexpr (ALIGN_EPI) { if (wr == 1) PG8_BAR; }
    }
    PG8_WAIT_V(0);
    if constexpr (!ALIGN_EPI) { if (wr == 0) PG8_BAR; }
    PG8_BAR;
#undef PG8_SA
#undef PG8_SB
#undef PG8_STB
#undef PG8_STA
#undef PG8_LDA
#undef PG8_LDB
#undef PG8_MMA
#undef PG8_WAIT_V
#undef PG8_WAIT_L
#undef PG8_BAR
#undef PG8_SCHED
}
}
#define XB_TMO      128
#define XB_XCNT(j)  (256  + 64 * (j))
#define XB_XSUB(j)  (1280 + 64 * (j))
#define XB_XGEN(j)  (2304 + 64 * (j))
#define XB_TOP      3328
#define XB_TOPGEN   3392
#define XCD_BAR_WORDS 3456
#define XB_SPIN_CAP (1u << 18)
__device__ __forceinline__ unsigned xb_ld(unsigned* p)              { return __hip_atomic_load(p, __ATOMIC_RELAXED, __HIP_MEMORY_SCOPE_AGENT); }
__device__ __forceinline__ unsigned xb_add(unsigned* p, unsigned v) { return __hip_atomic_fetch_add(p, v, __ATOMIC_RELAXED, __HIP_MEMORY_SCOPE_AGENT); }
__device__ __forceinline__ unsigned xb_xcc_id() { return (unsigned)__builtin_amdgcn_s_getreg((3 << 11) | 20) & 0xFu; }
#define XB_SPIN(cond, bar) do { unsigned _sp = 0; while (cond) { __builtin_amdgcn_s_sleep(1); \
    if ((++_sp & 255u) == 0u) { if (xb_ld(&(bar)[XB_TMO])) break; if (_sp > XB_SPIN_CAP) { atomicAdd(&(bar)[XB_TMO], 1u); break; } } } } while (0)
struct XcdBarrier { unsigned* bar; unsigned x; volatile LAS unsigned* st; };
__device__ __forceinline__ XcdBarrier xcd_barrier_post(unsigned* bar, volatile LAS unsigned* st) {
    XcdBarrier b; b.bar = bar; b.x = xb_xcc_id(); b.st = st;
    if (threadIdx.x == 0) (void)xb_add(&bar[XB_XCNT(b.x)], 1u);
    return b;
}
__device__ __forceinline__ void xcd_barrier_complete(unsigned* bar, unsigned x, unsigned& nloc, unsigned& nx) {
    const unsigned G = gridDim.x * gridDim.y * gridDim.z;
    unsigned sum, cnt, mine, sp = 0u;
    for (;;) {
        sum = 0u; cnt = 0u; mine = 0u;
#pragma unroll
        for (unsigned j = 0; j < 16; ++j) { const unsigned c = xb_ld(&bar[XB_XCNT(j)]); sum += c; cnt += (c > 0u) ? 1u : 0u; mine = (j == x) ? c : mine; }
        if (sum == G) break;
        __builtin_amdgcn_s_sleep(1);
        if ((++sp & 255u) == 0u) { if (xb_ld(&bar[XB_TMO])) break; if (sp > XB_SPIN_CAP) { atomicAdd(&bar[XB_TMO], 1u); break; } }
    }
    nloc = mine > 0u ? mine : 1u; nx = cnt > 0u ? cnt : 1u;
}
__device__ __forceinline__ void xcd_barrier(const XcdBarrier& b) {
    asm volatile("s_waitcnt vmcnt(0)" ::: "memory");
    __syncthreads();
    if (threadIdx.x == 0) {
        unsigned* bar = b.bar;
        __builtin_amdgcn_s_waitcnt(0);
        unsigned nloc = b.st[0], nx = b.st[1];
        if (nloc == 0u) { xcd_barrier_complete(bar, b.x, nloc, nx); b.st[0] = nloc; b.st[1] = nx; }
        const unsigned old = xb_add(&bar[XB_XSUB(b.x)], 1u);
        const unsigned gen = old / nloc;
        if (old + 1u == (gen + 1u) * nloc) {
            __builtin_amdgcn_fence(__ATOMIC_RELEASE, "agent");
            asm volatile("s_waitcnt vmcnt(0)" ::: "memory");
            const unsigned og = xb_add(&bar[XB_TOP], 1u);
            const unsigned tg = og / nx;
            if (og + 1u == (tg + 1u) * nx) xb_add(&bar[XB_TOPGEN], 1u);
            else XB_SPIN(xb_ld(&bar[XB_TOPGEN]) == tg, bar);
            __builtin_amdgcn_fence(__ATOMIC_ACQUIRE, "agent");
            xb_add(&bar[XB_XGEN(b.x)], 1u);
            asm volatile("s_waitcnt vmcnt(0)" ::: "memory");
        } else {
            XB_SPIN(xb_ld(&bar[XB_XGEN(b.x)]) == gen, bar);
            __builtin_amdgcn_fence(__ATOMIC_ACQUIRE, "agent");
            asm volatile("s_waitcnt vmcnt(0)" ::: "memory");
        }
    }
    __syncthreads();
}

constexpr size_t MiB = 1u << 20;
constexpr size_t WS_CTL = 0, CTL_ZERO_BYTES = 64 * 1024;
constexpr size_t WS_MOD = 1 * MiB;
constexpr size_t WS_EIDX = 2 * MiB;
constexpr size_t WS_WSEL = WS_EIDX + 512 * 1024;
constexpr size_t WS_RANK = WS_WSEL + 512 * 1024;
constexpr size_t WS_TOK = 4 * MiB;
constexpr size_t WS_DST = WS_TOK + 1 * MiB;
constexpr size_t WS_WSL = WS_DST + 1 * MiB;
constexpr size_t WS_WIN = 8 * MiB;
constexpr size_t WS_POOLW = 55 * MiB;
constexpr size_t WS_WPO = 56 * MiB;
constexpr size_t WS_LORA = 60 * MiB;
constexpr size_t WS_G2 = 62 * MiB;
constexpr size_t WS_WRO = 63 * MiB;
constexpr size_t WS_WO = 71 * MiB;
constexpr size_t WS_SLAB = 80 * MiB;
constexpr size_t WS_EA = 80 * MiB;
constexpr size_t EA_STRIDE = (size_t)MT * D * 2;
constexpr size_t WS_YF = 352 * MiB, WS_YB = 416 * MiB;
constexpr size_t WS_HA = 438 * MiB;
constexpr size_t WS_Z = 480 * MiB;
constexpr size_t WS_U = 506 * MiB;
constexpr size_t WS_RM = 544 * MiB, WS_KM = 612 * MiB, WS_VM = 680 * MiB;
constexpr size_t WS_LIN = 748 * MiB;
constexpr size_t WS_DP = 774 * MiB;
constexpr size_t WS_BON = 774 * MiB;
constexpr size_t WS_Y2 = 806 * MiB;
constexpr size_t WS_MP = 838 * MiB;
constexpr size_t WS_GATES = 902 * MiB;
constexpr size_t WS_OR = 80 * MiB;
constexpr size_t WS_H2 = 520 * MiB;
constexpr size_t WS_GU = 584 * MiB;
constexpr size_t WS_GU2 = 966 * MiB, WS_GU3 = 1134 * MiB;
constexpr int GU_E2 = 52, GU_E3 = 61;
constexpr size_t WS_ACT = 792 * MiB;
constexpr size_t WS_DT = 1004 * MiB;
constexpr size_t WS_X1 = 328 * MiB;
constexpr size_t WS_YP = 8 * MiB;
constexpr size_t WS_END = 1150 * MiB;
__host__ __device__ __forceinline__ size_t gu_base(int e) { return e < GU_E2 ? WS_GU + (size_t)e * (4 * MiB) : e < GU_E3 ? WS_GU2 + (size_t)(e - GU_E2) * (4 * MiB) : WS_GU3 + (size_t)(e - GU_E3) * (4 * MiB); }
constexpr int CW_BAR = 1024;
constexpr int CW_GCNT = 8192;
constexpr int CW_O64 = 8192 + 100;
constexpr int CW_CONV = 8448, CW_P2DONE = 8512;
static_assert((CW_BAR + XCD_BAR_WORDS) <= CW_GCNT && (CW_P2DONE + 128) * 4 <= (int)CTL_ZERO_BYTES, "ctl");

constexpr int RING_OFF = 0, RING_BYTES = 131072;
constexpr int LDSCTL_OFF = RING_BYTES;
constexpr int ROWTAB_OFF = LDSCTL_OFF + 1024 + 4096, ROWTAB_UNITS = 24;
constexpr int TAB_OFF = LDSCTL_OFF + 1024;
constexpr int LDS_BYTES = 163840;

using pg8::Unit;
struct RepOrder { static constexpr bool ROW_LDS = false;
    const char* A; const char* B; size_t repA, repB, tA, tB; int nM, nN, nrep, G, c;
    __device__ __forceinline__ bool next(int i, Unit& u) const {
        const long L = (long)i * G + c; const int per = nM * nN; if (L >= (long)per * nrep) return false;
        const int rep = (int)(L / per); const int w = pg8::xcd_remap((int)(L % per), per); pg8::grid_tile(w, nM, nN, u.pm, u.pn); u.aux = rep;
        u.A = A + (size_t)rep * repA + (size_t)u.pm * tA; u.B = B + (size_t)rep * repB + (size_t)u.pn * tB; return true; }
    __device__ __forceinline__ int row(const Unit&, int) const { return 0; }
};
struct G1Order { static constexpr bool ROW_LDS = false;
    const char* A; const char* B; size_t tA, tB; int G, c;
    __device__ __forceinline__ bool next(int i, Unit& u) const {
        const long L = (long)i * G + c; constexpr int N1 = 64 * 47, N2 = 4 * 27; if (L >= N1 + N2) return false;
        if (L < N1) { const int w = pg8::xcd_remap((int)L, N1); pg8::grid_tile(w, 64, 47, u.pm, u.pn); }
        else { const int l2 = (int)L - N1; u.pm = 64 + (l2 & 3); u.pn = 4 + (l2 >> 2); }
        u.aux = 0; u.A = A + (size_t)u.pm * tA; u.B = B + (size_t)u.pn * tB; return true; }
    __device__ __forceinline__ int row(const Unit&, int) const { return 0; }
};
template <bool GUMAP> struct MoeOrderT { static constexpr bool ROW_LDS = true;
    const char* A; const char* B; const LAS int* te; const LAS int* rowtab; size_t tA, estride, jstride; int ntiles, NJ, G, c;
    __device__ __forceinline__ bool next(int i, Unit& u) const {
        const long L = (long)i * G + c; const int tot = ntiles * NJ; if (L >= tot) return false;
        const int w = pg8::xcd_remap((int)L, tot); const int rt = w / NJ, j = w - rt * NJ; const int e = te[rt];
        u.pm = rt; u.pn = j; u.aux = e; u.ui = i; u.A = A + (size_t)rt * tA; u.B = B + (GUMAP ? gu_base(e) : (size_t)e * estride) + (size_t)j * jstride; return true; }
    __device__ __forceinline__ int row(const Unit& u, int r) const { return rowtab[u.ui * 256 + r]; }
};

typedef f32x4 AccT[2][2][4][2];
#define EPI_ROWS_BEGIN _Pragma("unroll") for (int ai = 0; ai < 2; ++ai) _Pragma("unroll") for (int m = 0; m < 4; ++m) { const int rl = ai * 128 + wr * 64 + m * 16 + fr;
#define EPI_ROWS_END if (m & 1) asm volatile("" ::: "memory"); }
struct EpiG1 { static constexpr bool PERM = true; bf16* U; bf16* SLAB; unsigned char* GATES;
    __device__ __forceinline__ void operator()(const AccT& acc, const Unit& u, int wr, int wc, int fr, int fq) const {
        if (u.pn >= 31) {
            const int c0 = (u.pn - 31) * 256 + wc * 32 + 8 * fq;
            EPI_ROWS_BEGIN
                unsigned char* rowp = GATES + (size_t)(u.pm * 256 + rl) * 4096 + c0;
#pragma unroll
                for (int bj = 0; bj < 2; ++bj) { const f32x4 v0 = acc[ai][bj][m][0], v1 = acc[ai][bj][m][1]; unsigned p0 = 0u, p1 = 0u;
                    p0 = __builtin_amdgcn_cvt_pk_u8_f32(255.0f * sigmoidf_(v0[0]), 0, p0); p0 = __builtin_amdgcn_cvt_pk_u8_f32(255.0f * sigmoidf_(v0[1]), 1, p0);
                    p0 = __builtin_amdgcn_cvt_pk_u8_f32(255.0f * sigmoidf_(v0[2]), 2, p0); p0 = __builtin_amdgcn_cvt_pk_u8_f32(255.0f * sigmoidf_(v0[3]), 3, p0);
                    p1 = __builtin_amdgcn_cvt_pk_u8_f32(255.0f * sigmoidf_(v1[0]), 0, p1); p1 = __builtin_amdgcn_cvt_pk_u8_f32(255.0f * sigmoidf_(v1[1]), 1, p1);
                    p1 = __builtin_amdgcn_cvt_pk_u8_f32(255.0f * sigmoidf_(v1[2]), 2, p1); p1 = __builtin_amdgcn_cvt_pk_u8_f32(255.0f * sigmoidf_(v1[3]), 3, p1);
                    v2u w; w.x = p0; w.y = p1; *(v2u*)(rowp + bj * 128) = w; }
            EPI_ROWS_END
            return;
        }
        bf16* base; int ld, c0;
        if (u.pn < 4) { base = U; ld = 1024; c0 = u.pn * 256; } else { base = SLAB; ld = SLABLD; c0 = (u.pn - 4) * 256; }
        EPI_ROWS_BEGIN
            bf16* rowp = base + (size_t)(u.pm * 256 + rl) * ld + c0 + wc * 32 + 8 * fq;
#pragma unroll
            for (int bj = 0; bj < 2; ++bj) { const f32x4 v0 = acc[ai][bj][m][0], v1 = acc[ai][bj][m][1];
                v4u w; w.x = pk2(v0[0], v0[1]); w.y = pk2(v0[2], v0[3]); w.z = pk2(v1[0], v1[1]); w.w = pk2(v1[2], v1[3]); *(v4u*)(rowp + bj * 128) = w; }
        EPI_ROWS_END
    }
};
struct EpiLora { static constexpr bool PERM = true; unsigned short* EA; const float* w0; const float* a0;
    __device__ __forceinline__ void operator()(const AccT& acc, const Unit& u, int wr, int wc, int fr, int fq) const {
        const int rep = u.aux; const float* bias = (rep < 2 ? w0 + rep * D : a0 + (rep - 2) * D) + u.pn * 256 + wc * 32 + 8 * fq;
        unsigned short* base = EA + (size_t)rep * ((size_t)MT * D);
        if (rep < 2) { const float cc = -0.8750424f;
            EPI_ROWS_BEGIN
                unsigned short* rowp = base + (size_t)(u.pm * 256 + rl) * D + u.pn * 256 + wc * 32 + 8 * fq;
#pragma unroll
                for (int bj = 0; bj < 2; ++bj) { const f32x4 v0 = acc[ai][bj][m][0] + *(const f32x4*)(bias + bj * 128), v1 = acc[ai][bj][m][1] + *(const f32x4*)(bias + bj * 128 + 4);
                    v4u w; w.x = pkh2(cc * sigmoidf_(v0[0]), cc * sigmoidf_(v0[1])); w.y = pkh2(cc * sigmoidf_(v0[2]), cc * sigmoidf_(v0[3]));
                    w.z = pkh2(cc * sigmoidf_(v1[0]), cc * sigmoidf_(v1[1])); w.w = pkh2(cc * sigmoidf_(v1[2]), cc * sigmoidf_(v1[3]));
                    *(v4u*)(rowp + bj * 128) = w; }
            EPI_ROWS_END
        } else {
            EPI_ROWS_BEGIN
                unsigned char* rowp = (unsigned char*)base + (size_t)(u.pm * 256 + rl) * D + u.pn * 256 + wc * 32 + 8 * fq;
#pragma unroll
                for (int bj = 0; bj < 2; ++bj) { const f32x4 v0 = acc[ai][bj][m][0] + *(const f32x4*)(bias + bj * 128), v1 = acc[ai][bj][m][1] + *(const f32x4*)(bias + bj * 128 + 4); unsigned p0 = 0u, p1 = 0u;
                    p0 = __builtin_amdgcn_cvt_pk_u8_f32(255.0f * sigmoidf_(v0[0]), 0, p0); p0 = __builtin_amdgcn_cvt_pk_u8_f32(255.0f * sigmoidf_(v0[1]), 1, p0);
                    p0 = __builtin_amdgcn_cvt_pk_u8_f32(255.0f * sigmoidf_(v0[2]), 2, p0); p0 = __builtin_amdgcn_cvt_pk_u8_f32(255.0f * sigmoidf_(v0[3]), 3, p0);
                    p1 = __builtin_amdgcn_cvt_pk_u8_f32(255.0f * sigmoidf_(v1[0]), 0, p1); p1 = __builtin_amdgcn_cvt_pk_u8_f32(255.0f * sigmoidf_(v1[1]), 1, p1);
                    p1 = __builtin_amdgcn_cvt_pk_u8_f32(255.0f * sigmoidf_(v1[2]), 2, p1); p1 = __builtin_amdgcn_cvt_pk_u8_f32(255.0f * sigmoidf_(v1[3]), 3, p1);
                    v2u w; w.x = p0; w.y = p1; *(v2u*)(rowp + bj * 128) = w; }
            EPI_ROWS_END
        }
    }
};
struct EpiPoolG { static constexpr bool PERM = true; bf16* Y2; const float* scale;
    __device__ __forceinline__ void operator()(const AccT& acc, const Unit& u, int wr, int wc, int fr, int fq) const {
        const int cb = u.aux * 256 + wc * 32 + 8 * fq;
        f32x4 s0[2], s1[2];
#pragma unroll
        for (int bj = 0; bj < 2; ++bj) { s0[bj] = *(const f32x4*)(scale + cb + bj * 128); s1[bj] = *(const f32x4*)(scale + cb + bj * 128 + 4); }
        EPI_ROWS_BEGIN
            bf16* rowp = Y2 + (size_t)(u.pm * 256 + rl) * 1024 + cb;
#pragma unroll
            for (int bj = 0; bj < 2; ++bj) { const f32x4 v0 = acc[ai][bj][m][0] * s0[bj], v1 = acc[ai][bj][m][1] * s1[bj];
                v4u w; w.x = pk2(v0[0], v0[1]); w.y = pk2(v0[2], v0[3]); w.z = pk2(v1[0], v1[1]); w.w = pk2(v1[2], v1[3]); *(v4u*)(rowp + bj * 128) = w; }
        EPI_ROWS_END
    }
};
template <int MODE> struct EpiMix { static constexpr bool PERM = true; bf16* OUT; int ldo; const void* AUX1; int ld1; const bf16* AUX2; int ld2;
    __device__ __forceinline__ void operator()(const AccT& acc, const Unit& u, int wr, int wc, int fr, int fq) const {
        const int cb = u.pn * 256 + wc * 32 + 8 * fq;
        EPI_ROWS_BEGIN
            const size_t row = (size_t)(u.pm * 256 + rl);
#pragma unroll
            for (int bj = 0; bj < 2; ++bj) { const f32x4 v0 = acc[ai][bj][m][0], v1 = acc[ai][bj][m][1];
                float x[8];
                if (MODE == 1) { const v4u a1 = *(const v4u*)((const bf16*)AUX1 + row * ld1 + cb + bj * 128);
                    x[0] = bflo(a1.x); x[1] = bfhi(a1.x); x[2] = bflo(a1.y); x[3] = bfhi(a1.y); x[4] = bflo(a1.z); x[5] = bfhi(a1.z); x[6] = bflo(a1.w); x[7] = bfhi(a1.w); }
                else { const v2u a1 = *(const v2u*)((const unsigned char*)AUX1 + row * ld1 + cb + bj * 128); const float k = 1.0f / 255.0f;
                    x[0] = (float)(a1.x & 0xffu) * k; x[1] = (float)((a1.x >> 8) & 0xffu) * k; x[2] = (float)((a1.x >> 16) & 0xffu) * k; x[3] = (float)(a1.x >> 24) * k;
                    x[4] = (float)(a1.y & 0xffu) * k; x[5] = (float)((a1.y >> 8) & 0xffu) * k; x[6] = (float)((a1.y >> 16) & 0xffu) * k; x[7] = (float)(a1.y >> 24) * k; }
                float o[8];
                if (MODE == 0 || MODE == 1) {
#pragma unroll
                    for (int j = 0; j < 4; ++j) { o[j] = x[j] * v0[j]; o[4 + j] = x[4 + j] * v1[j]; } }
                else { const v4u a2 = *(const v4u*)(AUX2 + row * ld2 + cb + bj * 128);
                    const float y[8] = {bflo(a2.x), bfhi(a2.x), bflo(a2.y), bfhi(a2.y), bflo(a2.z), bfhi(a2.z), bflo(a2.w), bfhi(a2.w)};
#pragma unroll
                    for (int j = 0; j < 4; ++j) { o[j] = y[j] + x[j] * v0[j]; o[4 + j] = y[4 + j] + x[4 + j] * v1[j]; } }
                v4u w; w.x = pk2(o[0], o[1]); w.y = pk2(o[2], o[3]); w.z = pk2(o[4], o[5]); w.w = pk2(o[6], o[7]);
                *(v4u*)(OUT + row * ldo + cb + bj * 128) = w; }
        EPI_ROWS_END
    }
};
struct EpiX1 { static constexpr bool PERM = true; const float* X; bf16* OUT; const float* MOD;
    __device__ __forceinline__ void operator()(const AccT& acc, const Unit& u, int wr, int wc, int fr, int fq) const {
        const int b = u.pm >> 4;
        const int cb = u.pn * 256 + wc * 32 + 8 * fq; const float* g = MOD + (size_t)b * 12288 + 4096 + cb;
        f32x4 gv[2][2];
#pragma unroll
        for (int bj = 0; bj < 2; ++bj)
#pragma unroll
            for (int n = 0; n < 2; ++n) gv[bj][n] = *(const f32x4*)(g + bj * 128 + n * 4);
        EPI_ROWS_BEGIN
            const size_t off = (size_t)(u.pm * 256 + rl) * D + cb;
#pragma unroll
            for (int bj = 0; bj < 2; ++bj) { const f32x4 x0 = *(const f32x4*)(X + off + bj * 128), x1 = *(const f32x4*)(X + off + bj * 128 + 4);
                const f32x4 v0 = x0 + gv[bj][0] * acc[ai][bj][m][0], v1 = x1 + gv[bj][1] * acc[ai][bj][m][1];
                v4u w; w.x = pk2(v0[0], v0[1]); w.y = pk2(v0[2], v0[3]); w.z = pk2(v1[0], v1[1]); w.w = pk2(v1[2], v1[3]); *(v4u*)(OUT + off + bj * 128) = w; }
        EPI_ROWS_END
    }
};
struct EpiAct { static constexpr bool PERM = true; bf16* ACT;
    __device__ __forceinline__ void operator()(const AccT& acc, const Unit& u, int wr, int wc, int fr, int fq) const {
        EPI_ROWS_BEGIN
            const f32x4 g0 = acc[ai][0][m][0], g1 = acc[ai][0][m][1], u0 = acc[ai][1][m][0], u1 = acc[ai][1][m][1];
            float o[8];
#pragma unroll
            for (int j = 0; j < 4; ++j) { o[j] = g0[j] * sigmoidf_(g0[j]) * u0[j]; o[4 + j] = g1[j] * sigmoidf_(g1[j]) * u1[j]; }
            v4u w; w.x = pk2(o[0], o[1]); w.y = pk2(o[2], o[3]); w.z = pk2(o[4], o[5]); w.w = pk2(o[6], o[7]);
            *(v4u*)(ACT + (size_t)(u.pm * 256 + rl) * DEXP + u.pn * 128 + wc * 32 + 8 * fq) = w;
        EPI_ROWS_END
    }
};
constexpr float YP_SCALE = 8.0f;
struct EpiDown { static constexpr bool PERM = true, PERM16 = true; unsigned char* YP;
    __device__ __forceinline__ void operator()(const AccT& acc, const Unit& u, int wr, int wc, int fr, int fq) const {
        const int cb = u.pn * 256 + wc * 64 + 16 * fq;
        EPI_ROWS_BEGIN
            int p[4];
#pragma unroll
            for (int bj = 0; bj < 2; ++bj) { const f32x4 v0 = acc[ai][bj][m][0] * YP_SCALE, v1 = acc[ai][bj][m][1] * YP_SCALE;
                int p0 = __builtin_amdgcn_cvt_pk_fp8_f32(v0[0], v0[1], 0, false); p0 = __builtin_amdgcn_cvt_pk_fp8_f32(v0[2], v0[3], p0, true);
                int p1 = __builtin_amdgcn_cvt_pk_fp8_f32(v1[0], v1[1], 0, false); p1 = __builtin_amdgcn_cvt_pk_fp8_f32(v1[2], v1[3], p1, true);
                p[2 * bj] = p0; p[2 * bj + 1] = p1; }
            v4u w; w.x = (unsigned)p[0]; w.y = (unsigned)p[1]; w.z = (unsigned)p[2]; w.w = (unsigned)p[3];
            *(v4u*)(YP + (size_t)(u.pm * 256 + rl) * D + cb) = w;
        EPI_ROWS_END
    }
};
struct Frame {
    LAS unsigned char* lds;
    volatile LAS unsigned* MISC;
    unsigned* ctl;
    int tid, lane, wave, vcu, G;
    unsigned char* ws;
};
struct Args { const float* in[34]; float* out; unsigned char* ws; int ph_lo, ph_hi; };
enum { I_X = 0, I_C, I_CTX, I_CCTX, I_N1G, I_N2G, I_ADAW, I_ADAB, I_WIN, I_MU, I_POOLW, I_POOLS, I_WPO, I_DW0, I_DW2, I_IA0, I_IA2, I_G2, I_KK, I_KA, I_RK, I_LNW, I_LNB,
       I_WRO, I_WO, I_RW, I_RB, I_EG, I_EU, I_ED, I_SG, I_SU, I_SD, I_FG };

struct TrJob { const float* src; bf16* dst; int ldw, kvalid, ldt, k0, n0, drow0; };
template <bool NT = false> __device__ __forceinline__ void tr_load(const TrJob& j, f32x4 (&v)[16], int lane) {
    const int r2 = lane >> 4, c4 = lane & 15;
#pragma unroll
    for (int i = 0; i < 8; ++i) {
#pragma unroll
        for (int h = 0; h < 2; ++h) { const int k = j.k0 + 8 * i + 2 * r2 + h; const int kc = k < j.kvalid ? k : 0;
            const f32x4* sp_ = (const f32x4*)(j.src + (size_t)kc * j.ldw + j.n0 + 4 * c4); const f32x4 x = NT ? __builtin_nontemporal_load(sp_) : *sp_; v[2 * i + h] = (k < j.kvalid) ? x : (f32x4){0.f, 0.f, 0.f, 0.f}; } }
}
template <bool NT = false> __device__ __forceinline__ void tr_store(const TrJob& j, const f32x4 (&v)[16], LAS unsigned* P, int lane) {
    const int r2 = lane >> 4, c4 = lane & 15;
#pragma unroll
    for (int i = 0; i < 8; ++i) { LAS unsigned* p = P + (4 * i + r2) * 65 + 4 * c4;
        p[0] = pk2(v[2 * i].x, v[2 * i + 1].x); p[1] = pk2(v[2 * i].y, v[2 * i + 1].y); p[2] = pk2(v[2 * i].z, v[2 * i + 1].z); p[3] = pk2(v[2 * i].w, v[2 * i + 1].w); }
    LDS_WAIT(); asm volatile("" ::: "memory");
    const int nl = lane >> 3, q = lane & 7;
#pragma unroll
    for (int jj = 0; jj < 8; ++jj) { const int n = 8 * jj + nl; const LAS unsigned* s = P + (4 * q) * 65 + n;
        v4u o; o.x = s[0]; o.y = s[65]; o.z = s[130]; o.w = s[195];
        v4u* dp_ = (v4u*)(j.dst + (size_t)(j.drow0 + n) * j.ldt + j.k0 + 8 * q); if (NT) __builtin_nontemporal_store(o, dp_); else *dp_ = o; }
    LDS_WAIT(); asm volatile("" ::: "memory");
}
template <class Dec> __device__ __forceinline__ void tr_run(const Dec& dec, int first, int stride, LAS unsigned* P, int lane) {
    TrJob ja, jb; f32x4 va[16], vb[16];
    int it = first; bool ha = dec(it, ja); if (ha) tr_load(ja, va, lane);
    while (ha) {
        it += stride; const bool hb = dec(it, jb); if (hb) tr_load(jb, vb, lane);
        tr_store(ja, va, P, lane);
        if (!hb) break;
        it += stride; ha = dec(it, ja); if (ha) tr_load(ja, va, lane);
        tr_store(jb, vb, P, lane);
    }
}
__device__ __forceinline__ void p0_prologue(Frame& F, const Args& a) {
    {
        LAS float* sv = (LAS float*)F.lds;
        LAS float* part = (LAS float*)(F.lds + 40960);
        bool did = false;
        for (int cb = blockIdx.x; cb < 192; cb += F.G) {
            if (!did) { for (int idx = F.tid; idx < 5 * D; idx += 512) { const int j = idx >> 11, k = idx & 2047; const float v = (j < 4) ? a.in[I_C][j * D + k] : a.in[I_CCTX][k]; sv[idx] = v / (1.0f + __expf(-v)); } did = true; }
            __syncthreads();
            const int col = 64 * cb + F.lane, k0 = 256 * F.wave; const float* wp = a.in[I_ADAW] + (size_t)k0 * 12288 + col;
            float acc[5] = {0.f, 0.f, 0.f, 0.f, 0.f};
#pragma unroll 32
            for (int k = 0; k < 256; ++k) { const float w = wp[(size_t)k * 12288];
#pragma unroll
                for (int j = 0; j < 5; ++j) acc[j] += sv[j * D + k0 + k] * w; }
#pragma unroll
            for (int j = 0; j < 5; ++j) part[(F.wave * 5 + j) * 64 + F.lane] = acc[j];
            __syncthreads();
            if (F.tid < 320) { const int j = F.tid >> 6, l = F.tid & 63; float s = a.in[I_ADAB][64 * cb + l];
#pragma unroll
                for (int w = 0; w < 8; ++w) s += part[(w * 5 + j) * 64 + l];
                ((float*)(F.ws + WS_MOD))[j * 12288 + 64 * cb + l] = s; }
            __syncthreads();
        }
        __syncthreads();
    }
    {
        struct DecSmall { const float* const* in; unsigned char* ws;
            __device__ __forceinline__ bool operator()(int it, TrJob& j) const {
                constexpr int I_1 = 32 * 186, I_2 = 4 * 16, I_3 = 16 * 32, I_4 = 4 * 32, I_5 = 32 * 32, I_6 = 32 * 32, I_7 = 4 * 2 * 32;
                int r = it; if (r < 0) return false;
                if (r < I_1) { const int kb = r / 186, nb = r % 186, n0 = nb * 64; j = TrJob{in[I_WIN], (bf16*)(ws + WS_WIN), DIN, D, D, kb * 64, n0, n0 + (n0 >= 7808 ? 128 : 0)}; return true; } r -= I_1;
                if (r < I_2) { const int g = r / 16, q = r % 16; j = TrJob{in[I_POOLW] + (size_t)g * 65536, (bf16*)(ws + WS_POOLW) + (size_t)g * 65536, 256, 256, 256, (q / 4) * 64, (q % 4) * 64, (q % 4) * 64}; return true; } r -= I_2;
                if (r < I_3) { j = TrJob{in[I_WPO], (bf16*)(ws + WS_WPO), D, 1024, 1024, (r / 32) * 64, (r % 32) * 64, (r % 32) * 64}; return true; } r -= I_3;
                if (r < I_4) { j = TrJob{in[I_G2], (bf16*)(ws + WS_G2), D, 256, 256, (r / 32) * 64, (r % 32) * 64, (r % 32) * 64}; return true; } r -= I_4;
                if (r < I_5) { j = TrJob{in[I_WRO], (bf16*)(ws + WS_WRO), D, D, D, (r / 32) * 64, (r % 32) * 64, (r % 32) * 64}; return true; } r -= I_5;
                if (r < I_6) { j = TrJob{in[I_WO], (bf16*)(ws + WS_WO), D, D, D, (r / 32) * 64, (r % 32) * 64, (r % 32) * 64}; return true; } r -= I_6;
                if (r < I_7) { const int mtx = r / 64, q = r % 64;
                    const float* src = (mtx < 2 ? in[I_DW2] + (size_t)mtx * 96 * D : in[I_IA2] + (size_t)(mtx - 2) * 96 * D);
                    j = TrJob{src, (bf16*)(ws + WS_LORA) + (size_t)mtx * D * 128, D, 96, 128, (q / 32) * 64, (q % 32) * 64, (q % 32) * 64}; return true; }
                return false; } };
        DecSmall dec{a.in, F.ws};
        tr_run(dec, F.vcu * 8 + F.wave, F.G * 8, (LAS unsigned*)(F.lds + F.wave * 16384), F.lane);
    }
    const int gt = F.vcu * 512 + F.tid, NGT = F.G * 512;
    { v4u* z = (v4u*)((bf16*)(F.ws + WS_WIN) + (size_t)7808 * D); for (int i = gt; i < 128 * D / 8; i += NGT) z[i] = (v4u){0u, 0u, 0u, 0u}; }
    { int* tok = (int*)(F.ws + WS_TOK); for (int i = gt; i < NSLOT; i += NGT) tok[i] = 0; }
}

__device__ __forceinline__ void p1_norm1(Frame& F, const Args& a) {
    const int gw = F.vcu * 8 + F.wave, NGW = F.G * 8; const float* MOD = (const float*)(F.ws + WS_MOD); bf16* HA = (bf16*)(F.ws + WS_HA);
    for (int mrow = gw; mrow < MT; mrow += NGW) {
        const float* src = (mrow < NT) ? a.in[I_X] + (size_t)mrow * D : a.in[I_CTX] + (size_t)(mrow - NT) * D; const int j = (mrow < NT) ? (mrow >> 12) : 4;
        const f32x4* xr = (const f32x4*)src + F.lane; f32x4 v[8]; float s = 0.f;
#pragma unroll
        for (int q = 0; q < 8; ++q) { v[q] = xr[64 * q]; s += (v[q].x * v[q].x + v[q].y * v[q].y) + (v[q].z * v[q].z + v[q].w * v[q].w); }
        const float rstd = 1.0f / sqrtf(wave_sum(s) * (1.0f / D) + 1e-6f);
        const f32x4* g = (const f32x4*)a.in[I_N1G] + F.lane; const f32x4* sh = (const f32x4*)(MOD + (size_t)j * 12288) + F.lane; const f32x4* sc = (const f32x4*)(MOD + (size_t)j * 12288 + 2048) + F.lane;
        v2u* o = (v2u*)(HA + (size_t)mrow * D) + F.lane;
#pragma unroll
        for (int q = 0; q < 8; ++q) { const f32x4 y = v[q] * rstd * g[64 * q] * (sc[64 * q] + 1.0f) + sh[64 * q]; v2u w; w.x = pk2(y.x, y.y); w.y = pk2(y.z, y.w); o[64 * q] = w; }
    }
}

template <int W> __device__ __forceinline__ void pool_item(const unsigned* U32, unsigned* DP32, int m0, int cp) {
    unsigned raw[64];
#pragma unroll
    for (int x = 0; x < 64; ++x) raw[x] = U32[(size_t)(m0 + x) * 512 + cp];
    float lo[64], hi[64];
#pragma unroll
    for (int x = 0; x < 64; ++x) { lo[x] = bflo(raw[x]); hi[x] = bfhi(raw[x]); }
#pragma unroll
    for (int x = 0; x < 64; ++x) { const int l = (x - W / 2) < 0 ? 0 : (x - W / 2), h = (x + W / 2) > 64 ? 64 : (x + W / 2); float s0 = 0.f, s1 = 0.f;
#pragma unroll
        for (int j = l; j < h; ++j) { s0 += lo[j]; s1 += hi[j]; }
        const float inv = 1.0f / (float)(h - l); DP32[(size_t)(m0 + x) * 512 + cp] = pk2(s0 * inv - lo[x], s1 * inv - hi[x]); }
}
__device__ __forceinline__ void p3_mix_store(const v4u o, const v4u nb, const f32x4 m0, const f32x4 m1, int c0, int mrow, bf16* RM, bf16* KM, bf16* VM, bf16* LIN) {
    float r[8];
    { const float ov[8] = {bflo(o.x), bfhi(o.x), bflo(o.y), bfhi(o.y), bflo(o.z), bfhi(o.z), bflo(o.w), bfhi(o.w)};
      const float nv[8] = {bflo(nb.x), bfhi(nb.x), bflo(nb.y), bfhi(nb.y), bflo(nb.z), bfhi(nb.z), bflo(nb.w), bfhi(nb.w)};
      const float mv[8] = {m0.x, m0.y, m0.z, m0.w, m1.x, m1.y, m1.z, m1.w};
#pragma unroll
      for (int e = 0; e < 8; ++e) r[e] = ov[e] + (nv[e] - ov[e]) * mv[e]; }
    bf16* dstp;
    if (c0 < 2048) dstp = RM + (size_t)mrow * D + c0;
    else if (c0 < 4096) dstp = KM + (size_t)mrow * D + (c0 - 2048);
    else if (c0 < 6144) dstp = VM + (size_t)mrow * D + (c0 - 4096);
    else { const int lc = c0 - 6144; int dc;
        if (lc < 192) {
#pragma unroll
            for (int e = 0; e < 8; ++e) r[e] = tanhf_(r[e]);
            dc = (lc < 96) ? lc : 128 + (lc - 96); }
        else if (lc < 384) dc = (lc < 288) ? 256 + (lc - 192) : 384 + (lc - 288);
        else {
#pragma unroll
            for (int e = 0; e < 8; ++e) r[e] = sigmoidf_(r[e]);
            dc = 512 + (lc - 384); }
        dstp = LIN + (size_t)mrow * LINLD + dc; }
    v4u w; w.x = pk2(r[0], r[1]); w.y = pk2(r[2], r[3]); w.z = pk2(r[4], r[5]); w.w = pk2(r[6], r[7]); *(v4u*)dstp = w;
}
constexpr int P3_SLICE = 512, P3_NSLICE = (DSH + P3_SLICE - 1) / P3_SLICE  , P3_SLOTS = 96;
__device__ __forceinline__ void p3_prep(Frame& F, const Args& a) {
    const bf16* SLAB = (const bf16*)(F.ws + WS_SLAB); const float* mu = a.in[I_MU];
    bf16* RM = (bf16*)(F.ws + WS_RM); bf16* KM = (bf16*)(F.ws + WS_KM); bf16* VM = (bf16*)(F.ws + WS_VM); bf16* LIN = (bf16*)(F.ws + WS_LIN);
    LAS unsigned char* T = F.lds;
    const int w = F.wave, lane = F.lane;
    for (int pid = F.vcu; pid < NB * 64; pid += F.G) {
        const int b = pid >> 6, py = (pid >> 3) & 7, px = pid & 7; const int m00 = b * TSEQ + (py * 8) * 64 + px * 8;
        int srow[12];
#pragma unroll
        for (int i = 0; i < 12; ++i) { const int sl = w * 12 + i; int gyl, gxl; bool ok = true;
            if (sl < 64) { gyl = sl >> 3; gxl = sl & 7; } else if (sl < 72) { gyl = -1; gxl = sl - 64; ok = py > 0; } else if (sl < 80) { gyl = 8; gxl = sl - 72; ok = py < 7; }
            else if (sl < 88) { gyl = sl - 80; gxl = -1; ok = px > 0; } else { gyl = sl - 88; gxl = 8; ok = px < 7; }
            srow[i] = ok ? m00 + gyl * 64 + gxl : m00; }
        v4u pre[12];
        { const int cl = lane * 8;
#pragma unroll
          for (int i = 0; i < 12; ++i) pre[i] = *(const v4u*)(SLAB + (size_t)srow[i] * SLABLD + cl); }
        for (int sl_ = 0; sl_ < P3_NSLICE; ++sl_) {
            const int c0 = sl_ * P3_SLICE + lane * 8; const bool cok = c0 < DSH;
            __syncthreads();
#pragma unroll
            for (int i = 0; i < 12; ++i) *(LAS v4u*)(T + (w * 12 + i) * 1024 + lane * 16) = pre[i];
            if (sl_ + 1 < P3_NSLICE) { const int cn = (sl_ + 1) * P3_SLICE + lane * 8; const int cl = cn < DSH ? cn : 0;
#pragma unroll
                for (int i = 0; i < 12; ++i) pre[i] = *(const v4u*)(SLAB + (size_t)srow[i] * SLABLD + cl); }
            __syncthreads();
            const f32x4 m0 = *(const f32x4*)(mu + (cok ? c0 : 0)), m1 = *(const f32x4*)(mu + (cok ? c0 : 0) + 4);
            const int gy = py * 8 + w; const unsigned k2m = gy > 0 ? 0xffffu : 0u, k3m = gy < 63 ? 0xffff0000u : 0u;
#pragma unroll
            for (int x = 0; x < 8; ++x) {
                const int gx = px * 8 + x; const unsigned k0m = gx > 0 ? 0xffffu : 0u, k1m = gx < 63 ? 0xffff0000u : 0u;
                const int so = w * 8 + x, sL = x > 0 ? so - 1 : 80 + w, sR = x < 7 ? so + 1 : 88 + w, sU = w > 0 ? so - 8 : 64 + x, sD = w < 7 ? so + 8 : 72 + x;
                const v4u o = *(const LAS v4u*)(T + so * 1024 + lane * 16), n0 = *(const LAS v4u*)(T + sL * 1024 + lane * 16), n1 = *(const LAS v4u*)(T + sR * 1024 + lane * 16),
                          n2 = *(const LAS v4u*)(T + sU * 1024 + lane * 16), n3 = *(const LAS v4u*)(T + sD * 1024 + lane * 16);
                v4u nb; nb.x = (n0.x & k0m) | (n1.x & k1m); nb.y = (n2.y & k2m) | (n3.y & k3m); nb.z = (n0.z & k0m) | (n1.z & k1m); nb.w = (n2.w & k2m) | (n3.w & k3m);
                const int mrow = m00 + w * 64 + x;
                if (cok) p3_mix_store(o, nb, m0, m1, c0, mrow, RM, KM, VM, LIN);
                if (sl_ == P3_NSLICE - 1 && lane >= 48) { const int l16 = lane - 48, p = l16 >> 2, off = (l16 & 3) * 8; *(v4u*)(LIN + (size_t)mrow * LINLD + 128 * p + 96 + off) = (v4u){0u, 0u, 0u, 0u}; }
            }
        }
        __syncthreads();
    }
    const int gw = F.vcu * 8 + F.wave, NGW = F.G * 8;
    for (int mrow = NT + gw; mrow < MT; mrow += NGW) {
        const bf16* own = SLAB + (size_t)mrow * SLABLD; const int sidx = (mrow - NT) & 255; const bool v0 = sidx > 0, v1 = sidx < 255;
        const bf16* p0 = v0 ? own - SLABLD : own; const bf16* p1 = v1 ? own + SLABLD : own;
        const unsigned k0m = v0 ? 0xffffu : 0u, k1m = v1 ? 0xffff0000u : 0u;
        for (int ci0 = F.lane; ci0 < DSH / 8; ci0 += 256) {
            v4u o[4], nb[4]; f32x4 m0[4], m1[4];
#pragma unroll
            for (int u = 0; u < 4; ++u) { const int ci = ci0 + 64 * u; const int c0 = (ci < DSH / 8 ? ci : F.lane) * 8;
                o[u] = *(const v4u*)(own + c0); const v4u n0 = *(const v4u*)(p0 + c0), n1 = *(const v4u*)(p1 + c0);
                nb[u].x = (n0.x & k0m) | (n1.x & k1m); nb[u].y = (n0.y & k0m) | (n1.y & k1m); nb[u].z = (n0.z & k0m) | (n1.z & k1m); nb[u].w = (n0.w & k0m) | (n1.w & k1m);
                m0[u] = *(const f32x4*)(mu + c0); m1[u] = *(const f32x4*)(mu + c0 + 4); }
#pragma unroll
            for (int u = 0; u < 4; ++u) { const int ci = ci0 + 64 * u; if (ci < DSH / 8) p3_mix_store(o[u], nb[u], m0[u], m1[u], ci * 8, mrow, RM, KM, VM, LIN); }
        }
        if (F.lane < 16) { const int p = F.lane >> 2, off = (F.lane & 3) * 8; *(v4u*)(LIN + (size_t)mrow * LINLD + 128 * p + 96 + off) = (v4u){0u, 0u, 0u, 0u}; }
    }
    const unsigned* U32 = (const unsigned*)(F.ws + WS_U); unsigned* DP32 = (unsigned*)(F.ws + WS_DP);
    for (int gr = F.vcu; gr < 256; gr += F.G) {
        const int m0 = gr * 64, cp = F.tid; const int g = F.wave >> 1;
        if (g == 0) pool_item<2>(U32, DP32, m0, cp); else if (g == 1) pool_item<4>(U32, DP32, m0, cp); else if (g == 2) pool_item<8>(U32, DP32, m0, cp); else pool_item<16>(U32, DP32, m0, cp);
    }
}

constexpr int CK = 16, NSL = 8;
constexpr int SL_Z = 0, SL_AF = 2560, SL_TMT = 3584, SL_ABF = 4096, SL_TM = 4608, SL_ZTT = 5120, SL_RT = 7680, SL_CRT = 9728, SL_ART = 10240, SL_BGT = 10752, SL_KGT = 12800, SL_VT = 14848, SL_GC = 16896,
              SL_SIZE = 17152, ZTT_LD = 80, SB_OFF = 7 * SL_SIZE  , SL7_OFF = 132096  ;
static_assert(SB_OFF + 8192 <= 131072 && SL7_OFF + SL_SIZE <= 163840, "scan LDS map");
__device__ __forceinline__ int kpos(int zt, int q) { return 32 * (zt >> 1) + 8 * q + 4 * (zt & 1); }
__device__ __forceinline__ int slot_off(int n) { return n < 7 ? n * SL_SIZE : SL7_OFF; }
__device__ __forceinline__ int sw64(int row, int col) { return (row * 64 + ((((col >> 3) ^ (row & 7)) << 3) | (col & 7))) * 2; }
__device__ __forceinline__ int scan_row(int n, int b, int dir) {
    if (n < CTXL) return NT + b * CTXL + (dir ? (CTXL - 1 - n) : n);
    const int t = n - CTXL; return b * TSEQ + (dir ? (TSEQ - 1 - t) : t);
}
__device__ __forceinline__ bf16x8 frag_ld(const LAS unsigned char* p, bool ok) { v4u z = (v4u){0u, 0u, 0u, 0u}; if (ok) z = *(const LAS v4u*)p; return __builtin_bit_cast(bf16x8, z); }
__device__ __forceinline__ f32x4 mfma16(bf16x8 a, bf16x8 b, f32x4 c) { return __builtin_amdgcn_mfma_f32_16x16x32_bf16(a, b, c, 0, 0, 0); }
__device__ __forceinline__ float dpp_shr(float v, const int n, float fill) {
    const int x = __builtin_bit_cast(int, v), f = __builtin_bit_cast(int, fill); int r;
    if (n == 1) r = __builtin_amdgcn_update_dpp(f, x, 0x111, 0xF, 0xF, false); else if (n == 2) r = __builtin_amdgcn_update_dpp(f, x, 0x112, 0xF, 0xF, false);
    else if (n == 4) r = __builtin_amdgcn_update_dpp(f, x, 0x114, 0xF, 0xF, false); else r = __builtin_amdgcn_update_dpp(f, x, 0x118, 0xF, 0xF, false);
    return __builtin_bit_cast(float, r);
}
struct SeqOps { bf16x8 fV, fZc, fZk[2], fR[2], fCr, fAr4, fKG[4], fBG4[4]; f32x4 gc[4]; };
__device__ __forceinline__ bf16x8 frag4_ld(const LAS unsigned char* p) { const v2u t = *(const LAS v2u*)p; v4u z; z.x = t.x; z.y = t.y; z.z = 0u; z.w = 0u; return __builtin_bit_cast(bf16x8, z); }
__device__ __forceinline__ void seq_load(SeqOps& o, const LAS unsigned char* SL, int w, int c, int q, bool klo) {
    o.fV = frag_ld(SL + SL_VT + ((16 * w + c) * 16 + 8 * q) * 2, klo);
    o.fZc = frag_ld(SL + SL_ZTT + (c * ZTT_LD + 64 + 8 * q) * 2, klo); o.fCr = frag_ld(SL + SL_CRT + (c * 16 + 8 * q) * 2, klo); o.fAr4 = frag4_ld(SL + SL_ART + (c * 16 + 4 * q) * 2);
#pragma unroll
    for (int ks = 0; ks < 2; ++ks) { o.fZk[ks] = frag_ld(SL + SL_ZTT + (c * ZTT_LD + 32 * ks + 8 * q) * 2, true); o.fR[ks] = frag_ld(SL + SL_RT + sw64(c, 32 * ks + 8 * q), true); }
#pragma unroll
    for (int jt = 0; jt < 4; ++jt) { o.fKG[jt] = frag_ld(SL + SL_KGT + ((16 * jt + c) * 16 + 8 * q) * 2, klo); o.fBG4[jt] = frag4_ld(SL + SL_BGT + ((16 * jt + c) * 16 + 4 * q) * 2);
        o.gc[jt] = *(const LAS f32x4*)(SL + SL_GC + (16 * jt + 4 * q) * 4); }
}
__device__ __forceinline__ void seq_step(const SeqOps& o, f32x4 (&X)[4], bool emit, bf16* YO, int chunk, int b, int dir, int h, int w, int c, int q) {
    const f32x4 z4 = (f32x4){0.f, 0.f, 0.f, 0.f};
    bf16x8 fS[2];
#pragma unroll
    for (int ks = 0; ks < 2; ++ks) { v4u p; p.x = pk2(X[2 * ks][0], X[2 * ks][1]); p.y = pk2(X[2 * ks][2], X[2 * ks][3]); p.z = pk2(X[2 * ks + 1][0], X[2 * ks + 1][1]); p.w = pk2(X[2 * ks + 1][2], X[2 * ks + 1][3]);
        fS[ks] = __builtin_bit_cast(bf16x8, p); }
    f32x4 un = mfma16(o.fZc, o.fV, z4);
#pragma unroll
    for (int ks = 0; ks < 2; ++ks) un = mfma16(o.fZk[ks], fS[ks], un);
    bf16x8 fU; { v4u p; p.x = pk2(un[0], un[1]); p.y = pk2(un[2], un[3]); p.z = 0u; p.w = 0u; fU = __builtin_bit_cast(bf16x8, p); }
    if (emit) {
        f32x4 y = mfma16(o.fCr, o.fV, z4); y = mfma16(o.fAr4, fU, y);
#pragma unroll
        for (int ks = 0; ks < 2; ++ks) y = mfma16(o.fR[ks], fS[ks], y);
#pragma unroll
        for (int g = 0; g < 4; ++g) YO[(size_t)scan_row(chunk * CK + 4 * q + g, b, dir) * D + h * 64 + 16 * w + c] = (bf16)f2bf(y[g]);
    }
#pragma unroll
    for (int jt = 0; jt < 4; ++jt) { const f32x4 d = mfma16(o.fBG4[jt], fU, mfma16(o.fKG[jt], o.fV, z4));
        X[jt] = X[jt] * o.gc[jt] + d; }
}
struct ScanRaw { v4u r[2], k[2], v[2], e[2]; v2u a[2]; };
__device__ __forceinline__ void scan_fetch(ScanRaw& R, const bf16* RM, const bf16* KM, const bf16* VM, const unsigned char* AX, const unsigned short* EX, size_t rowoff) {
#pragma unroll
    for (int ks = 0; ks < 2; ++ks) { const size_t off = rowoff + 32 * ks; R.r[ks] = *(const v4u*)(RM + off); R.k[ks] = *(const v4u*)(KM + off); R.v[ks] = *(const v4u*)(VM + off); R.a[ks] = *(const v2u*)(AX + off); R.e[ks] = *(const v4u*)(EX + off); }
}
__device__ __forceinline__ void p6_scan(Frame& F, const Args& a) {
    const bf16* RM = (const bf16*)(F.ws + WS_RM); const bf16* KM = (const bf16*)(F.ws + WS_KM); const bf16* VM = (const bf16*)(F.ws + WS_VM);
    const int lane = F.lane, w = F.wave, c0_ = lane & 15, q0_ = lane >> 4;
    for (int unit = blockIdx.x; unit < NB * NH * 2; unit += F.G) {
        const int dir = unit & 1, h = (unit >> 1) & 31, b = unit >> 6;
        const unsigned short* EX = (const unsigned short*)(F.ws + WS_EA + (size_t)dir * EA_STRIDE);
        const unsigned char* AX = (const unsigned char*)(F.ws + WS_EA + (size_t)(2 + dir) * EA_STRIDE);
        bf16* YO = (bf16*)(F.ws + (dir ? WS_YB : WS_YF)); float* BON = (float*)(F.ws + WS_BON) + (size_t)dir * NT * NH;
        f32x4 X[4];
#pragma unroll
        for (int jt = 0; jt < 4; ++jt) X[jt] = (f32x4){0.f, 0.f, 0.f, 0.f};
        constexpr int NBATCH = (CTXL + TSEQ) / CK / NSL;
        { LAS float* cst = (LAS float*)(F.lds + SB_OFF);
          if (F.tid < 192) { const int which = F.tid >> 6, j = F.tid & 63; cst[F.tid] = (which == 0 ? a.in[I_KK] : which == 1 ? a.in[I_KA] : a.in[I_RK])[h * 64 + j]; } }
        ScanRaw R; scan_fetch(R, RM, KM, VM, AX, EX, (size_t)scan_row(w * CK + c0_, b, dir) * D + h * 64 + 8 * q0_);
        __syncthreads();
        for (int bt = 0; bt < NBATCH; ++bt) {
            int c = c0_, q = q0_; asm volatile("" : "+v"(c), "+v"(q));
            const bool klo = q < 2;
            {
                LAS unsigned char* SL = F.lds + slot_off(w);
                int cq8 = 8 * q; asm volatile("" : "+v"(cq8));
                const LAS float* cst = (const LAS float*)(F.lds + SB_OFF) + cq8;
                float ss = 0.f;
#pragma unroll
                for (int ks = 0; ks < 2; ++ks) {
                    const f32x4 k0 = *(const LAS f32x4*)(cst + 32 * ks), k1 = *(const LAS f32x4*)(cst + 32 * ks + 4);
                    const float kv[8] = {bflo(R.k[ks].x), bfhi(R.k[ks].x), bflo(R.k[ks].y), bfhi(R.k[ks].y), bflo(R.k[ks].z), bfhi(R.k[ks].z), bflo(R.k[ks].w), bfhi(R.k[ks].w)};
#pragma unroll
                    for (int e = 0; e < 4; ++e) { const float p0 = kv[e] * k0[e], p1 = kv[4 + e] * k1[e]; ss += p0 * p0 + p1 * p1; } }
                ss += __shfl_xor(ss, 16); ss += __shfl_xor(ss, 32);
                const float inv = __builtin_amdgcn_rsqf(ss + 1e-12f);
                bf16x8 fKT[2], fRT[2], fBT[2], fKQ[2]; float bonp = 0.f;
#pragma unroll
                for (int ks = 0; ks < 2; ++ks) {
                    const v4u xr = R.r[ks], xk = R.k[ks], xv = R.v[ks], xe = R.e[ks]; const v2u xa = R.a[ks];
                    const f32x4 k0 = *(const LAS f32x4*)(cst + 32 * ks), k1 = *(const LAS f32x4*)(cst + 32 * ks + 4), a0 = *(const LAS f32x4*)(cst + 64 + 32 * ks), a1 = *(const LAS f32x4*)(cst + 64 + 32 * ks + 4);
                    const float kkw[8] = {k0[0], k0[1], k0[2], k0[3], k1[0], k1[1], k1[2], k1[3]}, kaw[8] = {a0[0], a0[1], a0[2], a0[3], a1[0], a1[1], a1[2], a1[3]};
                    const f32x4 q0 = *(const LAS f32x4*)(cst + 128 + 32 * ks), q1 = *(const LAS f32x4*)(cst + 128 + 32 * ks + 4); const float rkw[8] = {q0[0], q0[1], q0[2], q0[3], q1[0], q1[1], q1[2], q1[3]};
                    const float r[8] = {bflo(xr.x), bfhi(xr.x), bflo(xr.y), bfhi(xr.y), bflo(xr.z), bfhi(xr.z), bflo(xr.w), bfhi(xr.w)};
                    const float k[8] = {bflo(xk.x), bfhi(xk.x), bflo(xk.y), bfhi(xk.y), bflo(xk.z), bfhi(xk.z), bflo(xk.w), bfhi(xk.w)};
                    const float v[8] = {bflo(xv.x), bfhi(xv.x), bflo(xv.y), bfhi(xv.y), bflo(xv.z), bfhi(xv.z), bflo(xv.w), bfhi(xv.w)};
                    const float ku8 = 1.0f / 255.0f;
                    const float ai[8] = {(float)(xa.x & 0xffu) * ku8, (float)((xa.x >> 8) & 0xffu) * ku8, (float)((xa.x >> 16) & 0xffu) * ku8, (float)(xa.x >> 24) * ku8,
                                         (float)(xa.y & 0xffu) * ku8, (float)((xa.y >> 8) & 0xffu) * ku8, (float)((xa.y >> 16) & 0xffu) * ku8, (float)(xa.y >> 24) * ku8};
                    const float lw[8] = {hlo(xe.x), hhi(xe.x), hlo(xe.y), hhi(xe.y), hlo(xe.z), hhi(xe.z), hlo(xe.w), hhi(xe.w)};
                    float kt[8], rt[8], btl[8], kq[8], cl[8], G[8], Gi[8], Gm[8], GCv[8];
#pragma unroll
                    for (int e = 0; e < 8; ++e) cl[e] = lw[e];
#pragma unroll
                    for (int e = 0; e < 8; ++e) cl[e] += dpp_shr(cl[e], 1, 0.f);
#pragma unroll
                    for (int e = 0; e < 8; ++e) cl[e] += dpp_shr(cl[e], 2, 0.f);
#pragma unroll
                    for (int e = 0; e < 8; ++e) cl[e] += dpp_shr(cl[e], 4, 0.f);
#pragma unroll
                    for (int e = 0; e < 8; ++e) cl[e] += dpp_shr(cl[e], 8, 0.f);
#pragma unroll
                    for (int e = 0; e < 8; ++e) { G[e] = __builtin_amdgcn_exp2f(cl[e]); Gi[e] = __builtin_amdgcn_exp2f(-cl[e]); }
#pragma unroll
                    for (int e = 0; e < 8; ++e) { Gm[e] = dpp_shr(G[e], 1, 1.0f); GCv[e] = __shfl(G[e], (lane & 48) | 15); }
#pragma unroll
                    for (int e = 0; e < 8; ++e) {
                        const float kke = k[e] * kkw[e] * inv, kd = k[e] * ((ai[e] - 1.0f) * kaw[e] + 1.0f), bb = kke * ai[e], ratio = GCv[e] * Gi[e];
                        kt[e] = Gm[e] * kke; rt[e] = G[e] * r[e]; btl[e] = bb * Gi[e]; kq[e] = kd * Gi[e];
                        bonp += r[e] * kd * rkw[e];
                        const int j = 32 * ks + 8 * q + e;
                        const unsigned w0 = pk2(kt[e], bb * ratio), w1 = pk2(kd * ratio, v[e]);
                        ((LAS bf16*)(SL + SL_Z))[j * 16 + c] = (bf16)(w0 & 0xffffu); ((LAS bf16*)(SL + SL_BGT))[j * 16 + c] = (bf16)(w0 >> 16);
                        ((LAS bf16*)(SL + SL_KGT))[j * 16 + c] = (bf16)(w1 & 0xffffu); ((LAS bf16*)(SL + SL_VT))[j * 16 + c] = (bf16)(w1 >> 16);
                    }
                    if (c == 15) { *(LAS f32x4*)(SL + SL_GC + (32 * ks + 8 * q) * 4) = (f32x4){G[0], G[1], G[2], G[3]}; *(LAS f32x4*)(SL + SL_GC + (32 * ks + 8 * q + 4) * 4) = (f32x4){G[4], G[5], G[6], G[7]}; }
                    v4u p; p.x = pk2(kt[0], kt[1]); p.y = pk2(kt[2], kt[3]); p.z = pk2(kt[4], kt[5]); p.w = pk2(kt[6], kt[7]); fKT[ks] = __builtin_bit_cast(bf16x8, p);
                    p.x = pk2(rt[0], rt[1]); p.y = pk2(rt[2], rt[3]); p.z = pk2(rt[4], rt[5]); p.w = pk2(rt[6], rt[7]); fRT[ks] = __builtin_bit_cast(bf16x8, p);
                    { v2u p0; p0.x = p.x; p0.y = p.y; v2u p1; p1.x = p.z; p1.y = p.w; const int pp = 32 * ks + 16 * (q & 1) + 4 * (q >> 1);
                      *(LAS v2u*)(SL + SL_RT + sw64(c, pp)) = p0; *(LAS v2u*)(SL + SL_RT + sw64(c, pp + 8)) = p1; }
                    p.x = pk2(btl[0], btl[1]); p.y = pk2(btl[2], btl[3]); p.z = pk2(btl[4], btl[5]); p.w = pk2(btl[6], btl[7]); fBT[ks] = __builtin_bit_cast(bf16x8, p);
                    p.x = pk2(kq[0], kq[1]); p.y = pk2(kq[2], kq[3]); p.z = pk2(kq[4], kq[5]); p.w = pk2(kq[6], kq[7]); fKQ[ks] = __builtin_bit_cast(bf16x8, p);
                    asm volatile("" ::: "memory");
                }
                bonp += __shfl_xor(bonp, 16); bonp += __shfl_xor(bonp, 32);
                if (q == 0 && (NSL * bt + w) * CK >= CTXL) BON[(size_t)scan_row((NSL * bt + w) * CK + c, b, dir) * NH + h] = bonp;
                const f32x4 z4 = (f32x4){0.f, 0.f, 0.f, 0.f};
                f32x4 accA = mfma16(fBT[1], fKT[1], mfma16(fBT[0], fKT[0], z4)), accAr = mfma16(fBT[1], fRT[1], mfma16(fBT[0], fRT[0], z4));
                f32x4 accCm = mfma16(fKQ[1], fKT[1], mfma16(fKQ[0], fKT[0], z4)), accCr = mfma16(fKQ[1], fRT[1], mfma16(fKQ[0], fRT[0], z4));
#pragma unroll
                for (int g = 0; g < 4; ++g) { const int srow = 4 * q + g; const bool lt = srow < c, le = srow <= c;
                    accA[g] = lt ? accA[g] : 0.f; accAr[g] = le ? accAr[g] : 0.f; accCm[g] = lt ? accCm[g] : 0.f; accCr[g] = le ? accCr[g] : 0.f;
                    ((LAS float*)(SL + SL_AF))[srow * 16 + c] = accA[g]; ((LAS bf16*)(SL + SL_ABF))[srow * 16 + c] = (bf16)f2bf(accA[g]); ((LAS bf16*)(SL + SL_Z))[(64 + srow) * 16 + c] = (bf16)f2bf(accCm[g]); }
                { v2u p; p.x = pk2(accAr[0], accAr[1]); p.y = pk2(accAr[2], accAr[3]); *(LAS v2u*)(SL + SL_ART + (c * 16 + 4 * q) * 2) = p; }
                { v2u p; p.x = pk2(accCr[0], accCr[1]); p.y = pk2(accCr[2], accCr[3]); *(LAS v2u*)(SL + SL_CRT + (c * 16 + 4 * q) * 2) = p; }
                LDS_WAIT(); asm volatile("" ::: "memory");
                {
                    const int base = c & 8, cl = c & 7; float x[8];
#pragma unroll
                    for (int sr = 7; sr >= 0; --sr) { float acc = 0.f;
#pragma unroll
                        for (int m = sr + 1; m < 8; ++m) acc += ((const LAS float*)(SL + SL_AF))[(base + sr) * 16 + base + m] * x[m];
                        x[sr] = (sr < cl) ? -acc : ((sr == cl) ? -1.0f : 0.f); }
                    if (q == 0) { v4u px; px.x = pk2(x[0], x[1]); px.y = pk2(x[2], x[3]); px.z = pk2(x[4], x[5]); px.w = pk2(x[6], x[7]);
                        *(LAS v4u*)(SL + SL_TMT + (c * 16 + base) * 2) = px; *(LAS v4u*)(SL + SL_TMT + (c * 16 + (base ^ 8)) * 2) = (v4u){0u, 0u, 0u, 0u};
#pragma unroll
                        for (int sr = 0; sr < 8; ++sr) { ((LAS bf16*)(SL + SL_TM))[(base + sr) * 16 + c] = (bf16)f2bf(x[sr]); ((LAS bf16*)(SL + SL_TM))[((base ^ 8) + sr) * 16 + c] = (bf16)0; } }
                    LDS_WAIT(); asm volatile("" ::: "memory");
                    const bf16x8 fAb = frag_ld(SL + SL_ABF + (c * 16 + 8 * q) * 2, klo), fTd = frag_ld(SL + SL_TMT + (c * 16 + 8 * q) * 2, klo);
                    const f32x4 d1 = mfma16(fAb, fTd, z4);
                    bf16x8 fD1; { v4u p; p.x = pk2(d1[0], d1[1]); p.y = pk2(d1[2], d1[3]); p.z = 0u; p.w = 0u; fD1 = __builtin_bit_cast(bf16x8, p); }
                    const f32x4 d2 = mfma16(fD1, frag4_ld(SL + SL_TM + (c * 16 + 4 * q) * 2), z4);
                    if (c < 8 && q >= 2) {
#pragma unroll
                        for (int g = 0; g < 4; ++g) ((LAS bf16*)(SL + SL_TMT))[(4 * q + g) * 16 + c] = (bf16)f2bf(d2[g]); }
                }
                LDS_WAIT(); asm volatile("" ::: "memory");
                {
                    const bf16x8 fT = frag_ld(SL + SL_TMT + (c * 16 + 8 * q) * 2, klo);
#pragma unroll
                    for (int zt = 0; zt < 5; ++zt) { const bf16x8 fZ = frag_ld(SL + SL_Z + ((16 * zt + c) * 16 + 8 * q) * 2, klo); const f32x4 d = mfma16(fZ, fT, z4);
                        v2u p; p.x = pk2(d[0], d[1]); p.y = pk2(d[2], d[3]); *(LAS v2u*)(SL + SL_ZTT + (c * ZTT_LD + (zt < 4 ? kpos(zt, q) : 64 + 4 * q)) * 2) = p; }
                }
            }
            if (bt + 1 < NBATCH) scan_fetch(R, RM, KM, VM, AX, EX, (size_t)scan_row((NSL * (bt + 1) + w) * CK + c, b, dir) * D + h * 64 + 8 * q);
            __syncthreads();
            asm volatile("" : "+v"(c), "+v"(q));
            if (w < 4) {
                const bool emit = (NSL * bt) * CK >= CTXL;
#pragma unroll 1
                for (int n = 0; n < NSL; ++n) { SeqOps A; seq_load(A, F.lds + slot_off(n), w, c, q, klo); seq_step(A, X, emit, YO, NSL * bt + n, b, dir, h, w, c, q); }
            }
            __syncthreads();
        }
    }
}

__device__ __forceinline__ void p7_readout(Frame& F, const Args& a) {
    const bf16* VM = (const bf16*)(F.ws + WS_VM); const float* BONF = (const float*)(F.ws + WS_BON); const float* BONB = BONF + (size_t)NT * NH;
    const bf16* YF = (const bf16*)(F.ws + WS_YF); const bf16* YB = (const bf16*)(F.ws + WS_YB); bf16* Z = (bf16*)(F.ws + WS_Z);
    const int sub = F.tid & 15; const int ngrp = F.G * 32;
    for (int gid0 = F.vcu * 32 + (F.tid >> 4); gid0 < NT * NH; gid0 += 4 * ngrp) {
        v2u ayf[4], ayb[4], alv[4]; float abf[4], abb[4]; f32x4 alw[4], alb[4];
#pragma unroll
        for (int u = 0; u < 4; ++u) { const int gid = gid0 + u * ngrp; const int mrow = gid >> 5, h = gid & 31, c = h * 64 + 4 * sub; const size_t off = (size_t)mrow * D + c;
            ayf[u] = *(const v2u*)(YF + off); ayb[u] = *(const v2u*)(YB + off); alv[u] = *(const v2u*)(VM + off); abf[u] = BONF[gid]; abb[u] = BONB[gid]; alw[u] = *(const f32x4*)(a.in[I_LNW] + c); alb[u] = *(const f32x4*)(a.in[I_LNB] + c); }
#pragma unroll
        for (int u = 0; u < 4; ++u) { const int gid = gid0 + u * ngrp;
        const int mrow = gid >> 5, h = gid & 31, c = h * 64 + 4 * sub; const size_t off = (size_t)mrow * D + c;
        const v2u yf = ayf[u], yb = ayb[u], lv = alv[u];
        const f32x4 y = (f32x4){bflo(yf.x) + bflo(yb.x), bfhi(yf.x) + bfhi(yb.x), bflo(yf.y) + bflo(yb.y), bfhi(yf.y) + bfhi(yb.y)};
        const float mean = allred16((y.x + y.y) + (y.z + y.w)) * (1.0f / 64.0f); const f32x4 d = y - mean;
        const float var = allred16((d.x * d.x + d.y * d.y) + (d.z * d.z + d.w * d.w)) * (1.0f / 64.0f);
        const f32x4 yn = d * __builtin_amdgcn_rsqf(var + 64e-5f) * alw[u] + alb[u];
        const f32x4 v = (f32x4){bflo(lv.x), bfhi(lv.x), bflo(lv.y), bfhi(lv.y)};
        const f32x4 z = yn + v * (abf[u] + abb[u]); v2u wv; wv.x = pk2(z.x, z.y); wv.y = pk2(z.z, z.w); *(v2u*)(Z + off) = wv;
        }
    }
}
constexpr int CONV_ITEMS = 65 * 768, CONV_DT = 65 * 256, CONV_FREE = CONV_DT + (65 - GU_E2) * 512;
struct DecExp { const float* const* in; unsigned char* ws;
    __device__ __forceinline__ bool operator()(int it, TrJob& j) const {
        if (it < 0 || it >= CONV_ITEMS) return false;
        if (it < CONV_DT) { const int e = it >> 8, r = it & 255; const float* src = (e < 64) ? in[I_ED] + (size_t)e * DEXP * D : in[I_SD];
            const int kb = r >> 5, nb = r & 31; j = TrJob{src, (bf16*)(ws + WS_DT) + (size_t)e * D * DEXP, D, DEXP, DEXP, kb * 64, nb * 64, nb * 64}; }
        else { const int g = it - CONV_DT, eg = g >> 9, q = g & 511, which = q >> 8, r = q & 255, e = eg < 65 - GU_E2 ? GU_E2 + eg : eg - (65 - GU_E2);
            const float* src = (e < 64) ? (which == 0 ? in[I_EG] : in[I_EU]) + (size_t)e * D * DEXP : (which == 0 ? in[I_SG] : in[I_SU]);
            const int kb = r >> 3, nb = r & 7, n0 = nb * 64;
            j = TrJob{src, (bf16*)(ws + gu_base(e)), DEXP, D, D, kb * 64, n0, (n0 >> 7) * 256 + which * 128 + (n0 & 127)}; }
        return true; } };
__device__ __forceinline__ void conv_steal(Frame& F, const Args& a, const unsigned stopn) {
    DecExp dec{a.in, F.ws};
    unsigned* cnt = F.ctl + CW_CONV; unsigned* dnp = F.ctl + CW_P2DONE;
    LAS unsigned* P = (LAS unsigned*)(F.lds + F.wave * 16384);
    const int lane = F.lane;
    unsigned nxt = 0u, dnow = 0u;
    if (lane == 0) nxt = xb_add(cnt, 1u);
    nxt = __builtin_amdgcn_readfirstlane(nxt);
#pragma unroll 1
    for (;;) {
        const unsigned cur = nxt;
        if (cur >= (unsigned)CONV_FREE) break;
        unsigned n2 = (unsigned)CONV_FREE, d2 = dnow;
        if (dnow < stopn) { if (lane == 0) { n2 = xb_add(cnt, 1u); d2 = xb_ld(dnp); } }
        asm volatile("" ::: "memory");
        TrJob ja; f32x4 va[16];
        dec((int)cur, ja); tr_load<true>(ja, va, lane);
        tr_store<true>(ja, va, P, lane);
        nxt = __builtin_amdgcn_readfirstlane(n2); dnow = __builtin_amdgcn_readfirstlane(d2);
    }
}
constexpr int RT_LD = 68;
__device__ __forceinline__ void p11_route(Frame& F, const Args& a) {
    for (int repa_ = 0, nrepa_ = opaque_n(1 + ((DUPMASK >> 16) & 1)); repa_ < nrepa_; ++repa_) {
        unsigned nd = xb_ld(F.ctl + CW_CONV); nd = __builtin_amdgcn_readfirstlane(nd < (unsigned)CONV_FREE ? nd : (unsigned)CONV_FREE);
        DecExp dec{a.in, F.ws};
        tr_run(dec, (int)nd + F.vcu * 8 + F.wave, F.G * 8, (LAS unsigned*)(F.lds + F.wave * 16384), F.lane);
        __syncthreads();
    }
    const bf16* X1 = (const bf16*)(F.ws + WS_X1); const float* MOD = (const float*)(F.ws + WS_MOD); bf16* H2 = (bf16*)(F.ws + WS_H2);
    LAS float* hs = (LAS float*)F.lds;
    LAS float* wsb = hs + 64 * RT_LD;
    LAS float* lg = wsb + 64 * RT_LD;
    LAS float* lg2 = lg + 64 * 65;
    LAS float* selb = lg2 + 64 * 65;
    LAS float* rs = selb + 64 * 65;
    LAS int* cnt = (LAS int*)(rs + 64);
    LAS int* basee = cnt + 64;
    LAS int* eloc = basee + 64;
    LAS int* rloc = eloc + 512;
    for (int tile = F.vcu; tile < NT / 64; tile += F.G) {
        const int t0 = tile * 64, b = t0 >> 12;
        const float* sh2 = MOD + (size_t)b * 12288 + 6144; const float* sc2 = MOD + (size_t)b * 12288 + 8192; const float* g2 = a.in[I_N2G];
        if (F.tid < 64) cnt[F.tid] = 0;
        for (int rr = 0; rr < 8; ++rr) { const int tl = F.wave * 8 + rr; const v2u* xr = (const v2u*)(X1 + (size_t)(t0 + tl) * D) + F.lane; f32x4 v[8]; float s = 0.f;
#pragma unroll
            for (int q = 0; q < 8; ++q) { const v2u xw = xr[64 * q]; v[q] = (f32x4){bflo(xw.x), bfhi(xw.x), bflo(xw.y), bfhi(xw.y)}; s += (v[q].x * v[q].x + v[q].y * v[q].y) + (v[q].z * v[q].z + v[q].w * v[q].w); }
            const float rstd = 1.0f / sqrtf(wave_sum(s) * (1.0f / D) + 1e-6f); if (F.lane == 0) rs[tl] = rstd;
            v2u* o = (v2u*)(H2 + (size_t)(t0 + tl) * D) + F.lane;
#pragma unroll
            for (int q = 0; q < 8; ++q) { const f32x4 y = v[q] * rstd * ((const f32x4*)g2)[F.lane + 64 * q] * (((const f32x4*)sc2)[F.lane + 64 * q] + 1.0f) + ((const f32x4*)sh2)[F.lane + 64 * q];
                v2u w; w.x = pk2(y.x, y.y); w.y = pk2(y.z, y.w); o[64 * q] = w; } }
        __syncthreads();
        const int tg = F.tid & 15, eg = (F.tid >> 4) & 15, kh = F.tid >> 8;
        float acc[4][4];
#pragma unroll
        for (int i = 0; i < 4; ++i)
#pragma unroll
            for (int j = 0; j < 4; ++j) acc[i][j] = 0.f;
        const int stok = F.tid >> 3, sk8 = (F.tid & 7) * 8; const float rstd_s = rs[stok];
        f32x4 px0, px1, pw0, pw1;
        { const v4u xw = *(const v4u*)(X1 + (size_t)(t0 + stok) * D + sk8); px0 = (f32x4){bflo(xw.x), bfhi(xw.x), bflo(xw.y), bfhi(xw.y)}; px1 = (f32x4){bflo(xw.z), bfhi(xw.z), bflo(xw.w), bfhi(xw.w)}; const float* wp = a.in[I_RW] + F.tid * 8; pw0 = *(const f32x4*)wp; pw1 = *(const f32x4*)(wp + 4); }
        for (int kc = 0; kc < D / 64; ++kc) {
            { const int k0 = kc * 64 + sk8;
              const f32x4 ga = *(const f32x4*)(g2 + k0), gb = *(const f32x4*)(g2 + k0 + 4), ca = *(const f32x4*)(sc2 + k0), cb = *(const f32x4*)(sc2 + k0 + 4), ha = *(const f32x4*)(sh2 + k0), hb = *(const f32x4*)(sh2 + k0 + 4);
              const f32x4 y0 = px0 * rstd_s * ga * (ca + 1.0f) + ha, y1 = px1 * rstd_s * gb * (cb + 1.0f) + hb;
              hs[(sk8 + 0) * RT_LD + stok] = y0.x; hs[(sk8 + 1) * RT_LD + stok] = y0.y; hs[(sk8 + 2) * RT_LD + stok] = y0.z; hs[(sk8 + 3) * RT_LD + stok] = y0.w;
              hs[(sk8 + 4) * RT_LD + stok] = y1.x; hs[(sk8 + 5) * RT_LD + stok] = y1.y; hs[(sk8 + 6) * RT_LD + stok] = y1.z; hs[(sk8 + 7) * RT_LD + stok] = y1.w;
              const int wk = F.tid >> 3, we = (F.tid & 7) * 8; *(LAS f32x4*)(wsb + wk * RT_LD + we) = pw0; *(LAS f32x4*)(wsb + wk * RT_LD + we + 4) = pw1; }
            __syncthreads();
            if (kc + 1 < D / 64) { const v4u xw = *(const v4u*)(X1 + (size_t)(t0 + stok) * D + (kc + 1) * 64 + sk8); px0 = (f32x4){bflo(xw.x), bfhi(xw.x), bflo(xw.y), bfhi(xw.y)}; px1 = (f32x4){bflo(xw.z), bfhi(xw.z), bflo(xw.w), bfhi(xw.w)};
                const float* wp = a.in[I_RW] + (size_t)(kc + 1) * 4096 + F.tid * 8; pw0 = *(const f32x4*)wp; pw1 = *(const f32x4*)(wp + 4); }
#pragma unroll 8
            for (int k = kh * 32; k < kh * 32 + 32; ++k) { const f32x4 h4 = *(const LAS f32x4*)(hs + k * RT_LD + 4 * tg), w4 = *(const LAS f32x4*)(wsb + k * RT_LD + 4 * eg);
                acc[0][0] += h4.x * w4.x; acc[0][1] += h4.x * w4.y; acc[0][2] += h4.x * w4.z; acc[0][3] += h4.x * w4.w;
                acc[1][0] += h4.y * w4.x; acc[1][1] += h4.y * w4.y; acc[1][2] += h4.y * w4.z; acc[1][3] += h4.y * w4.w;
                acc[2][0] += h4.z * w4.x; acc[2][1] += h4.z * w4.y; acc[2][2] += h4.z * w4.z; acc[2][3] += h4.z * w4.w;
                acc[3][0] += h4.w * w4.x; acc[3][1] += h4.w * w4.y; acc[3][2] += h4.w * w4.z; acc[3][3] += h4.w * w4.w; }
            __syncthreads();
        }
        { LAS float* dstl = kh ? lg2 : lg;
#pragma unroll
          for (int i = 0; i < 4; ++i)
#pragma unroll
              for (int j = 0; j < 4; ++j) dstl[(4 * tg + i) * 65 + 4 * eg + j] = acc[i][j]; }
        __syncthreads();
        for (int idx = F.tid; idx < 4096; idx += 512) { const int tl = idx >> 6, e = idx & 63; const float sc = sigmoidf_(lg[tl * 65 + e] + lg2[tl * 65 + e]); lg[tl * 65 + e] = sc; selb[tl * 65 + e] = sc + a.in[I_RB][e]; }
        __syncthreads();
        if (F.tid < 64) {
            const int tl = F.tid; LAS float* sel = selb + tl * 65; const LAS float* scr = lg + tl * 65;
            float gs[8];
#pragma unroll
            for (int g = 0; g < 8; ++g) { float m1 = -INFINITY, m2 = -INFINITY;
#pragma unroll
                for (int j = 0; j < 8; ++j) { const float v = sel[g * 8 + j]; if (v > m1) { m2 = m1; m1 = v; } else if (v > m2) m2 = v; }
                gs[g] = m1 + m2; }
            unsigned gmask = 0u;
#pragma unroll
            for (int it = 0; it < 4; ++it) { float best = -INFINITY; int bi = 0;
#pragma unroll
                for (int g = 0; g < 8; ++g) { const bool ok = !((gmask >> g) & 1u) && gs[g] > best; best = ok ? gs[g] : best; bi = ok ? g : bi; }
                gmask |= 1u << bi; }
            for (int g = 0; g < 8; ++g) if (!((gmask >> g) & 1u)) { for (int j = 0; j < 8; ++j) sel[g * 8 + j] = -INFINITY; }
            float wv[8]; int ev[8]; float wsum = 0.f;
#pragma unroll
            for (int it = 0; it < 8; ++it) { float best = -INFINITY; int bi = 0;
                for (int e = 0; e < 64; ++e) { const float v = sel[e]; if (v > best) { best = v; bi = e; } }
                sel[bi] = -INFINITY; ev[it] = bi; wv[it] = scr[bi]; wsum += wv[it]; }
            const float inv = 2.5f / wsum;
#pragma unroll
            for (int it = 0; it < 8; ++it) { const int lr = atomicAdd((int*)&cnt[ev[it]], 1); eloc[tl * 8 + it] = ev[it]; rloc[tl * 8 + it] = lr;
                ((float*)(F.ws + WS_WSEL))[(size_t)(t0 + tl) * 8 + it] = wv[it] * inv; }
        }
        __syncthreads();
        if (F.tid < 64) basee[F.tid] = (int)__hip_atomic_fetch_add(F.ctl + CW_GCNT + F.tid, (unsigned)cnt[F.tid], __ATOMIC_RELAXED, __HIP_MEMORY_SCOPE_AGENT);
        __syncthreads();
        { const int e = eloc[F.tid]; ((int*)(F.ws + WS_EIDX))[(size_t)t0 * 8 + F.tid] = e; ((int*)(F.ws + WS_RANK))[(size_t)t0 * 8 + F.tid] = basee[e] + rloc[F.tid]; }
        __syncthreads();
    }
}
__device__ __forceinline__ int moe_tables(Frame& F) {
    LAS int* te = (LAS int*)(F.lds + TAB_OFF); LAS int* off = te + MAXTILES;
    if (F.tid < 64) off[66 + F.tid] = (int)__hip_atomic_load(F.ctl + CW_GCNT + F.tid, __ATOMIC_RELAXED, __HIP_MEMORY_SCOPE_AGENT);
    __syncthreads();
    if (F.tid == 0) { int o = 0; for (int e = 0; e < 64; ++e) { off[e] = o; o += (off[66 + e] + 255) & ~255; } off[64] = o; off[65] = o / 256 + NT / 256; }
    __syncthreads();
    const int ntiles = off[65];
    for (int rt = F.tid; rt < ntiles; rt += 512) { int e = 0; for (int j = 1; j <= 64; ++j) if (rt * 256 >= off[j]) e = j; te[rt] = e; }
    __syncthreads();
    return ntiles;
}
__device__ __forceinline__ void p12_slots(Frame& F) {
    (void)moe_tables(F);
    const LAS int* off = (const LAS int*)(F.lds + TAB_OFF) + MAXTILES;
    int* tok = (int*)(F.ws + WS_TOK);
    const int* eidx = (const int*)(F.ws + WS_EIDX); int* rank = (int*)(F.ws + WS_RANK);
    const int gt = F.vcu * 512 + F.tid, NGT = F.G * 512;
    for (int i = gt; i < NT * 8; i += NGT) { const int slot = off[eidx[i]] + rank[i]; tok[slot] = i >> 3; rank[i] = slot; }
    const int o64 = off[64];
    for (int t = gt; t < NT; t += NGT) tok[o64 + t] = t;
    if (gt == 0) F.ctl[CW_O64] = (unsigned)o64;
}
__device__ __forceinline__ void p15_final(Frame& F, const Args& a) {
    const int gw = F.vcu * 8 + F.wave, NGW = F.G * 8; const float* MOD = (const float*)(F.ws + WS_MOD); const unsigned char* YP = (const unsigned char*)(F.ws + WS_YP);
    const int* SLOTMAP = (const int*)(F.ws + WS_RANK); const float* WSEL = (const float*)(F.ws + WS_WSEL); const int o64 = (int)F.ctl[CW_O64];
    for (int t = gw; t < NT; t += NGW) {
        const int b = t >> 12; const float* gt2 = MOD + (size_t)b * 12288 + 10240; const float* fg = a.in[I_FG]; float* xr = a.out + (size_t)t * D; const bf16* x1r = (const bf16*)(F.ws + WS_X1) + (size_t)t * D;
        const v4u s0 = *(const v4u*)(SLOTMAP + (size_t)t * 8), s1 = *(const v4u*)(SLOTMAP + (size_t)t * 8 + 4); const f32x4 w0 = *(const f32x4*)(WSEL + (size_t)t * 8), w1 = *(const f32x4*)(WSEL + (size_t)t * 8 + 4);
        const unsigned sl[9] = {s0.x, s0.y, s0.z, s0.w, s1.x, s1.y, s1.z, s1.w, (unsigned)(o64 + t)}; const float wt[9] = {w0.x, w0.y, w0.z, w0.w, w1.x, w1.y, w1.z, w1.w, 1.0f};
        float v[2][16]; float s = 0.f;
#pragma unroll
        for (int jj = 0; jj < 2; ++jj) { const int col = 16 * F.lane + 1024 * jj; float m[16];
#pragma unroll
            for (int e = 0; e < 16; ++e) m[e] = 0.f;
#pragma unroll
            for (int j = 0; j < 9; ++j) { const v4u y = *(const v4u*)(YP + (size_t)sl[j] * D + col); const unsigned yw[4] = {y.x, y.y, y.z, y.w}; const float wj = wt[j];
#pragma unroll
                for (int e = 0; e < 4; ++e) { const f32x2 lo = __builtin_amdgcn_cvt_pk_f32_fp8((int)yw[e], false), hi = __builtin_amdgcn_cvt_pk_f32_fp8((int)yw[e], true);
                    m[4 * e] += wj * lo.x; m[4 * e + 1] += wj * lo.y; m[4 * e + 2] += wj * hi.x; m[4 * e + 3] += wj * hi.y; } }
#pragma unroll
            for (int e4 = 0; e4 < 4; ++e4) { const v2u xw = *(const v2u*)(x1r + col + 4 * e4); const f32x4 x0 = (f32x4){bflo(xw.x), bfhi(xw.x), bflo(xw.y), bfhi(xw.y)}, g0 = *(const f32x4*)(gt2 + col + 4 * e4);
#pragma unroll
                for (int e = 0; e < 4; ++e) { const float val = x0[e] + g0[e] * (m[4 * e4 + e] * (1.0f / YP_SCALE)); v[jj][4 * e4 + e] = val; s += val * val; } } }
        float rstd = __builtin_amdgcn_rsqf(wave_sum(s) * (1.0f / D) + 1e-6f);
#if defined(PROBE_PHASE)
        if (PROBE_PHASE >= 0) rstd *= 1.0f + (float)__hip_atomic_load(F.ctl + 12000, __ATOMIC_RELAXED, __HIP_MEMORY_SCOPE_AGENT) * 2e-6f;
#endif
#pragma unroll
        for (int jj = 0; jj < 2; ++jj) { const int col = 16 * F.lane + 1024 * jj;
#pragma unroll
            for (int e4 = 0; e4 < 4; ++e4) { const f32x4 f0 = *(const f32x4*)(fg + col + 4 * e4);
                *(f32x4*)(xr + col + 4 * e4) = (f32x4){v[jj][4 * e4], v[jj][4 * e4 + 1], v[jj][4 * e4 + 2], v[jj][4 * e4 + 3]} * rstd * f0; } }
    }
}
#ifndef MK_ONE_LAUNCH
#define MK_ONE_LAUNCH 1
#endif
constexpr int NPHASE = 16;
__global__ void __launch_bounds__(512, 2) mk_fwd(Args args) {
    extern __shared__ __attribute__((aligned(16))) unsigned char lds[];
    Frame F;
    F.lds = (LAS unsigned char*)lds; F.MISC = (volatile LAS unsigned*)(F.lds + LDSCTL_OFF);
    int wave0 = __builtin_amdgcn_readfirstlane((int)threadIdx.x >> 6); asm volatile("" : "+s"(wave0));
    F.tid = threadIdx.x; F.lane = F.tid & 63; F.wave = wave0;
    F.G = gridDim.x; { const int bx = blockIdx.x; F.vcu = (F.G % 8 == 0) ? (bx % 8) * (F.G / 8) + bx / 8 : bx; }
    F.ws = args.ws; F.ctl = (unsigned*)(args.ws + WS_CTL);
    for (int u = F.tid; u < 256; u += 512) ((LAS unsigned*)(F.lds + LDSCTL_OFF))[u] = 0u;
    __syncthreads();
    XcdBarrier bar; bar.bar = F.ctl + CW_BAR; bar.x = 0; bar.st = nullptr;
    if (MK_ONE_LAUNCH) bar = xcd_barrier_post(F.ctl + CW_BAR, F.MISC + 8);
    const int lo = args.ph_lo, hi = args.ph_hi;
#ifndef PHMASK
#define PHMASK 0xFFFF
#endif
#define IN(k) (((PHMASK >> (k)) & 1) && lo <= (k) && (k) < hi)
#ifndef DUPMASK
#define DUPMASK 0
#endif
#define DUP(k) for (int rep_ = 0, nrep_ = opaque_n(1 + ((DUPMASK >> (k)) & 1)); rep_ < nrep_; ++rep_)
#define FRESH() do { int l_ = (int)__builtin_amdgcn_mbcnt_hi(~0u, __builtin_amdgcn_mbcnt_lo(~0u, 0u)); asm volatile("" : "+v"(l_)); int w_ = wave0; asm volatile("" : "+s"(w_)); F.lane = l_; F.wave = w_; F.tid = w_ * 64 + l_; { unsigned char* p_ = args.ws; asm volatile("" : "+s"(p_)); F.ws = p_; ws = p_; F.ctl = (unsigned*)(p_ + WS_CTL); } } while (0)
#define SEAM(k) do { if (MK_ONE_LAUNCH) { if (IN(k) && IN((k) + 1)) { xcd_barrier(bar); if ((DUPMASK >> 18) & 1) xcd_barrier(bar); } } } while (0)
    const int G = F.G, c = (int)blockIdx.x;
#ifndef PROBE_PHASE
#define PROBE_PHASE -1
#endif
    unsigned long long pt0_ = 0;
#define PSTART(k) do { if (PROBE_PHASE == (k)) pt0_ = __builtin_amdgcn_s_memrealtime(); } while (0)
#define PEND(k) do { if (PROBE_PHASE == (k) && blockIdx.x == 0 && threadIdx.x == 0) { const unsigned long long t1_ = __builtin_amdgcn_s_memrealtime(); __hip_atomic_store(F.ctl + 12000, (unsigned)(t1_ - pt0_), __ATOMIC_RELAXED, __HIP_MEMORY_SCOPE_AGENT); } } while (0)
    unsigned char* ws = args.ws;

    PSTART(0);
    if (IN(0)) DUP(0) { FRESH(); p0_prologue(F, args); } SEAM(0); PEND(0);
    PSTART(1);
    if (IN(1)) DUP(1) { FRESH(); p1_norm1(F, args); } SEAM(1); PEND(1);
    PSTART(2);
    if (IN(2)) DUP(2) { FRESH();
        const int g1 = (G == 256) ? 240 : G;
        if (c < g1) {
            G1Order S{(const char*)(ws + WS_HA), (const char*)(ws + WS_WIN), (size_t)256 * D * 2, (size_t)256 * D * 2, g1, c};
            EpiG1 E{(bf16*)(ws + WS_U), (bf16*)(ws + WS_SLAB), (unsigned char*)(ws + WS_GATES)};
            pg8::gemm_phase<EpiG1, G1Order, false>(F.lds + RING_OFF, F.wave, D, D, D, S, E);
            FRESH();
            if (F.tid == 0) (void)xb_add(F.ctl + CW_P2DONE, 1u);
        } else conv_steal(F, args, 8u);
    } SEAM(2); PEND(2);
    PSTART(3);
    if (IN(3)) DUP(3) { FRESH(); p3_prep(F, args); } SEAM(3); PEND(3);
    PSTART(4);
    if (IN(4)) DUP(4) { FRESH();
#ifndef NO4A
        {
            RepOrder S{(const char*)(ws + WS_LIN), (const char*)(ws + WS_LORA), (size_t)128 * 2, (size_t)D * 128 * 2, (size_t)256 * LINLD * 2, (size_t)256 * 128 * 2, MT / 256, D / 256, 4, G, c};
            EpiLora E{(unsigned short*)(ws + WS_EA), args.in[I_DW0], args.in[I_IA0]};
            pg8::gemm_phase<EpiLora, RepOrder, false>(F.lds + RING_OFF, F.wave, 128, LINLD, 128, S, E);
        }
#endif
    }
    if (IN(4)) DUP(4) { FRESH();
#ifndef NO4B
        {
            RepOrder S{(const char*)(ws + WS_DP), (const char*)(ws + WS_POOLW), (size_t)256 * 2, (size_t)256 * 256 * 2, (size_t)256 * 1024 * 2, (size_t)256 * 256 * 2, NT / 256, 1, 4, G, c};
            EpiPoolG E{(bf16*)(ws + WS_Y2), args.in[I_POOLS]};
            pg8::gemm_phase<EpiPoolG, RepOrder, false>(F.lds + RING_OFF, F.wave, 256, 1024, 256, S, E);
        }
#endif
    } SEAM(4); PEND(4);
    PSTART(5);
    if (IN(5)) DUP(5) { FRESH();
        RepOrder S{(const char*)(ws + WS_Y2), (const char*)(ws + WS_WPO), 0, 0, (size_t)256 * 1024 * 2, (size_t)256 * 1024 * 2, NT / 256, D / 256, 1, G, c};
        EpiMix<0> E{(bf16*)(ws + WS_MP), D, (const void*)(ws + WS_GATES), 4096, nullptr, 0};
        pg8::gemm_phase<EpiMix<0>, RepOrder, false>(F.lds + RING_OFF, F.wave, 1024, 1024, 1024, S, E);
    }
    PSTART(6);
    if (IN(6)) DUP(6) { FRESH(); p6_scan(F, args); if ((DUPMASK >> 19) & 1) { FRESH(); p6_scan(F, args); } } SEAM(6); PEND(6);
    PSTART(7);
    if (IN(7)) DUP(7) { FRESH(); p7_readout(F, args); } SEAM(7); PEND(7);
    PSTART(8);
    if (IN(8)) DUP(8) { FRESH();
        RepOrder S{(const char*)(ws + WS_LIN) + 512 * 2, (const char*)(ws + WS_G2), 0, 0, (size_t)256 * LINLD * 2, (size_t)256 * 256 * 2, NT / 256, D / 256, 1, G, c};
        EpiMix<1> E{(bf16*)(ws + WS_OR), D, (const void*)(ws + WS_Z), D, nullptr, 0};
        pg8::gemm_phase<EpiMix<1>, RepOrder, false>(F.lds + RING_OFF, F.wave, 256, LINLD, 256, S, E);
    } SEAM(8); PEND(8);
    PSTART(9);
    if (IN(9)) DUP(9) { FRESH();
        RepOrder S{(const char*)(ws + WS_OR), (const char*)(ws + WS_WRO), 0, 0, (size_t)256 * D * 2, (size_t)256 * D * 2, NT / 256, D / 256, 1, G, c};
        EpiMix<2> E{(bf16*)(ws + WS_Z), D, (const void*)(ws + WS_GATES + 2048), 4096, (const bf16*)(ws + WS_MP), D};
        pg8::gemm_phase<EpiMix<2>, RepOrder, false>(F.lds + RING_OFF, F.wave, D, D, D, S, E);
    } SEAM(9); PEND(9);
    PSTART(10);
    if (IN(10)) DUP(10) { FRESH();
        RepOrder S{(const char*)(ws + WS_Z), (const char*)(ws + WS_WO), 0, 0, (size_t)256 * D * 2, (size_t)256 * D * 2, NT / 256, D / 256, 1, G, c};
        EpiX1 E{args.in[I_X], (bf16*)(ws + WS_X1), (const float*)(ws + WS_MOD)};
        pg8::gemm_phase<EpiX1, RepOrder, false>(F.lds + RING_OFF, F.wave, D, D, D, S, E);
    } SEAM(10); PEND(10);
    PSTART(11);
    if (IN(11)) DUP(11) { FRESH(); p11_route(F, args); } SEAM(11); PEND(11);
    PSTART(12);
    if (IN(12)) DUP(12) { FRESH(); p12_slots(F); } SEAM(12); PEND(12);
    PSTART(13);
    if (IN(13)) DUP(13) { FRESH();
        const int ntiles = moe_tables(F);
        MoeOrderT<true> S{(const char*)(ws + WS_H2), (const char*)ws, (const LAS int*)(F.lds + TAB_OFF), (const LAS int*)(F.lds + ROWTAB_OFF), 0, (size_t)1024 * D * 2, (size_t)256 * D * 2, ntiles, 4, G, c};
        { LAS int* rt = (LAS int*)(F.lds + ROWTAB_OFF); const int* tok = (const int*)(ws + WS_TOK); Unit uu;
          for (int i = 0; i < ROWTAB_UNITS && S.next(i, uu); ++i) if (F.tid < 256) rt[i * 256 + F.tid] = tok[uu.pm * 256 + F.tid];
          __syncthreads(); }
        EpiAct E{(bf16*)(ws + WS_ACT)};
        pg8::gemm_phase<EpiAct, MoeOrderT<true>, true>(F.lds + RING_OFF, F.wave, D, D, D, S, E);
    } SEAM(13); PEND(13);
    PSTART(14);
    if (IN(14)) DUP(14) { FRESH();
        const int ntiles = moe_tables(F);
        MoeOrderT<false> S{(const char*)(ws + WS_ACT), (const char*)(ws + WS_DT), (const LAS int*)(F.lds + TAB_OFF), (const LAS int*)(F.lds + ROWTAB_OFF), (size_t)256 * DEXP * 2, (size_t)D * DEXP * 2, (size_t)256 * DEXP * 2, ntiles, 8, G, c};
        EpiDown E{(unsigned char*)(ws + WS_YP)};
        pg8::gemm_phase<EpiDown, MoeOrderT<false>, false>(F.lds + RING_OFF, F.wave, DEXP, DEXP, DEXP, S, E);
    } SEAM(14); PEND(14);
    PSTART(15);
    if (IN(15)) DUP(15) { FRESH(); p15_final(F, args); }
#undef IN
#undef SEAM
}

extern "C" void kernel_launch(void* const* d_in, const int* in_sizes, int n_in, void* d_out, int out_size, void* d_ws, size_t ws_size, hipStream_t stream) {
    static int grid = 0;
    if (grid == 0) {
        if (n_in != 34 || in_sizes[0] != NT * D || out_size != NT * D || ws_size < WS_END) { fprintf(stderr, "kernel_launch: unexpected shapes (n_in %d, in0 %d, out %d, ws %zu < %zu)\n", n_in, n_in > 0 ? in_sizes[0] : -1, out_size, ws_size, (size_t)WS_END); grid = -1; return; }
        int dev = 0, cus = 0, per_cu = 0;
        if (hipGetDevice(&dev) != hipSuccess || hipDeviceGetAttribute(&cus, hipDeviceAttributeMultiprocessorCount, dev) != hipSuccess) { grid = -1; return; }
        if (hipFuncSetAttribute((const void*)mk_fwd, hipFuncAttributeMaxDynamicSharedMemorySize, LDS_BYTES) != hipSuccess) { fprintf(stderr, "kernel_launch: hipFuncSetAttribute failed\n"); grid = -1; return; }
        if (hipOccupancyMaxActiveBlocksPerMultiprocessor(&per_cu, (const void*)mk_fwd, 512, LDS_BYTES) != hipSuccess || per_cu < 1) fprintf(stderr, "kernel_launch: occupancy query reports %d\n", per_cu);
        (void)hipGetLastError();
        grid = cus;
    }
    if (grid < 0) return;
    if (hipMemsetAsync((char*)d_ws + WS_CTL, 0, CTL_ZERO_BYTES, stream) != hipSuccess) return;
    Args a{};
    for (int i = 0; i < 34; ++i) a.in[i] = (const float*)d_in[i];
    a.out = (float*)d_out; a.ws = (unsigned char*)d_ws;
#if MK_ONE_LAUNCH
    a.ph_lo = 0; a.ph_hi = NPHASE;
    hipLaunchKernelGGL(mk_fwd, dim3(grid), dim3(512), LDS_BYTES, stream, a);
#else
    for (int p = 0; p < NPHASE; ++p) { a.ph_lo = p; a.ph_hi = p + 1; hipLaunchKernelGGL(mk_fwd, dim3(grid), dim3(512), LDS_BYTES, stream, a); }
#endif
}
```

```cpp
#include <hip/hip_runtime.h>
#include <cstdio>
#include <cstdint>
#ifndef DUPMASK
#define DUPMASK 0
#endif
#ifndef PROBE_PHASE
#define PROBE_PHASE -1
#endif

#define GAS __attribute__((address_space(1)))
#define LAS __attribute__((address_space(3)))
typedef unsigned short bf16;
typedef unsigned v4u __attribute__((ext_vector_type(4)));
typedef unsigned v2u __attribute__((ext_vector_type(2)));
typedef float f32x4 __attribute__((ext_vector_type(4)));
typedef float f32x2 __attribute__((ext_vector_type(2)));
typedef short bf16x8 __attribute__((ext_vector_type(8)));

constexpr int D = 2048, NB = 4, TSEQ = 4096, NT = NB * TSEQ  , CTXL = 256, NC = NB * CTXL  , MT = NT + NC  ;
constexpr int DIN = 11904, DSH = 6784, NPAD = 12032, SLABLD = 6912, NH = 32, HS = 64;
constexpr int NEXP = 64, DEXP = 512, TOPK = 8;
constexpr int NSLOT = NT * TOPK + NEXP * 256 + NT;
constexpr int MAXTILES = NSLOT / 256;
constexpr int LINLD = 768;

__device__ __forceinline__ int opaque_n(int n) { asm volatile("" : "+s"(n)); return n; }
__device__ __forceinline__ unsigned f2bf(float f) { unsigned u = __builtin_bit_cast(unsigned, f); return (u + 0x7fffu + ((u >> 16) & 1u)) >> 16; }
typedef __bf16 bf16x2_t __attribute__((ext_vector_type(2)));
__device__ __forceinline__ unsigned pk2(float lo, float hi) { const f32x2 v = {lo, hi}; const bf16x2_t b = __builtin_convertvector(v, bf16x2_t); return __builtin_bit_cast(unsigned, b); }
__device__ __forceinline__ unsigned pk8(float a, float b, float c, float d) { int w = __builtin_amdgcn_cvt_pk_fp8_f32(a, b, 0, false); w = __builtin_amdgcn_cvt_pk_fp8_f32(c, d, w, true); return (unsigned)w; }
__device__ __forceinline__ float bflo(unsigned w) { return __builtin_bit_cast(float, w << 16); }
__device__ __forceinline__ float bfhi(unsigned w) { return __builtin_bit_cast(float, w & 0xffff0000u); }
__device__ __forceinline__ unsigned pkh2(float lo, float hi) { const unsigned short a = __builtin_bit_cast(unsigned short, (_Float16)lo), b = __builtin_bit_cast(unsigned short, (_Float16)hi); return (unsigned)a | ((unsigned)b << 16); }
__device__ __forceinline__ float hlo(unsigned w) { return (float)__builtin_bit_cast(_Float16, (unsigned short)(w & 0xffffu)); }
__device__ __forceinline__ float hhi(unsigned w) { return (float)__builtin_bit_cast(_Float16, (unsigned short)(w >> 16)); }
__device__ __forceinline__ float sigmoidf_(float x) { return __builtin_amdgcn_rcpf(1.0f + __builtin_amdgcn_exp2f(-1.44269504f * x)); }
__device__ __forceinline__ float tanhf_(float x) { return 1.0f - 2.0f * __builtin_amdgcn_rcpf(1.0f + __builtin_amdgcn_exp2f(2.88539008f * x)); }
__device__ __forceinline__ float wave_sum(float v) {
#pragma unroll
    for (int o = 1; o < 64; o <<= 1) v += __shfl_xor(v, o);
    return v;
}
__device__ __forceinline__ float dpp_f(float v, const int ctrl_sel) {
    int r;
    const int x = __builtin_bit_cast(int, v);
    if (ctrl_sel == 0) r = __builtin_amdgcn_update_dpp(0, x, 0xB1, 0xF, 0xF, true);
    else if (ctrl_sel == 1) r = __builtin_amdgcn_update_dpp(0, x, 0x4E, 0xF, 0xF, true);
    else if (ctrl_sel == 2) r = __builtin_amdgcn_update_dpp(0, x, 0x141, 0xF, 0xF, true);
    else r = __builtin_amdgcn_update_dpp(0, x, 0x140, 0xF, 0xF, true);
    return __builtin_bit_cast(float, r);
}
__device__ __forceinline__ float allred16(float v) { v += dpp_f(v, 0); v += dpp_f(v, 1); v += dpp_f(v, 2); v += dpp_f(v, 3); return v; }

#define LDS_WAIT() asm volatile("s_waitcnt lgkmcnt(0)" ::: "memory")
#define VM_WAIT() asm volatile("s_waitcnt vmcnt(0)" ::: "memory")

namespace pg8 {
constexpr int BM = 256, BK = 64, HALF = 128, HTB = HALF * BK * 2, STAGE_BYTES = 8 * HTB, NXCD = 8, WGM = 8;
__host__ __device__ __forceinline__ int lds_byte(int r, int c) { const int st = (r >> 4) * 2 + (c >> 5), rr = r & 15, cc = c & 31, ob = rr * 64 + cc * 2; return st * 1024 + (ob ^ (((ob >> 9) & 1) << 5)); }
__host__ __device__ __forceinline__ void stage_rc(int b, int& R, int& C) { const int st = b / 1024, sb = b % 1024, swz = sb ^ (((sb >> 9) & 1) << 5); R = (st >> 1) * 16 + swz / 64; C = (st & 1) * 32 + (swz % 64) / 2; }
__host__ __device__ __forceinline__ int perm32(int rho) { const int n = rho >> 4, i = rho & 15; return 8 * (i >> 2) + 4 * n + (i & 3); }
struct Unit { const char* A; const char* B; int pm, pn, aux, ui; };
__device__ __forceinline__ int xcd_remap(int L, int nwg) { const int q = nwg / NXCD, r = nwg % NXCD, xcd = L % NXCD, off = L / NXCD; return (xcd < r ? xcd * (q + 1) : r * (q + 1) + (xcd - r) * q) + off; }
__device__ __forceinline__ void grid_tile(int wgid, int nM, int nN, int& pm, int& pn) { const int nig = WGM * nN, gid = wgid / nig, fm = gid * WGM, gsz = (nM - fm) < WGM ? (nM - fm) : WGM; pm = fm + ((wgid % nig) % gsz); pn = (wgid % nig) / gsz; }

__device__ __forceinline__ void stage2(LAS unsigned char* lds, int bufoff, unsigned ldsw, const char* g, unsigned o0, unsigned o1) {
    __builtin_amdgcn_global_load_lds((const unsigned*)(g + o0), (LAS unsigned*)(lds + bufoff + ldsw), 16, 0, 0);
    __builtin_amdgcn_global_load_lds((const unsigned*)(g + o1), (LAS unsigned*)(lds + bufoff + ldsw + 8192), 16, 0, 0);
}

typedef int v8i_t __attribute__((ext_vector_type(8)));
typedef int v4i_t __attribute__((ext_vector_type(4)));
__device__ __forceinline__ v8i_t mx_cat(const bf16x8& lo, const bf16x8& hi) { const v4i_t a = __builtin_bit_cast(v4i_t, lo), b = __builtin_bit_cast(v4i_t, hi); return __builtin_shufflevector(a, b, 0, 1, 2, 3, 4, 5, 6, 7); }

template <class Epi, class = void> struct EpiPerm16 { static constexpr bool value = false; };
template <class Epi> struct EpiPerm16<Epi, decltype((void)Epi::PERM16)> { static constexpr bool value = Epi::PERM16; };
template <class Epi> __host__ __device__ constexpr bool epi_perm16() { return EpiPerm16<Epi>::value; }
template <class Epi> __host__ __device__ __forceinline__ int perm_row(int R) {
    if (epi_perm16<Epi>()) { const int wc = R >> 5, rho = R & 31, n = rho >> 4, i = rho & 15; return 64 * wc + 16 * (i >> 2) + 4 * n + (i & 3); }
    return Epi::PERM ? ((R & ~31) + perm32(R & 31)) : R;
}
template <class Epi, class Sched, bool GATHER, bool ALIGN_EPI = true, int MXS = 0>
__device__ __forceinline__ void gemm_phase(LAS unsigned char* lds, const int wave_, const int K, const int lda, const int ldb, const Sched& S, const Epi& E) {
    int tid_ = wave_ * 64 + (int)__builtin_amdgcn_mbcnt_hi(~0u, __builtin_amdgcn_mbcnt_lo(~0u, 0u)); asm volatile("" : "+v"(tid_));
    const int tid = tid_, wid = __builtin_amdgcn_readfirstlane(tid >> 6), lane = tid & 63, wr = wid >> 2, wc = wid & 3, fr = lane & 15, fq = lane >> 4;
    const int nt = opaque_n(K / BK);
    unsigned voffA[2], voffB[2]; int RA[2], CA[2];
#pragma unroll
    for (int i = 0; i < 2; ++i) { int R, C; stage_rc(tid * 16 + i * 8192, R, C); const int Rb = perm_row<Epi>(R);
        RA[i] = R; CA[i] = C; voffA[i] = (unsigned)(R * lda + C) * 2u; voffB[i] = (unsigned)(Rb * ldb + C) * 2u; }
    const size_t kstep = (size_t)(BK * 2);
    const size_t hstepA = (size_t)HALF * lda * 2, hstepB = (size_t)(epi_perm16<Epi>() ? 8 : HALF) * ldb * 2;
    const unsigned ldsw = (unsigned)wid * 1024u;
    const int aoff = lds_byte(wr * 64 + fr, fq * 8), boff = lds_byte(wc * 32 + fr, fq * 8);
#define PG8_SA(b, h) (((b) * 2 + (h)) * HTB)
#define PG8_SB(b, h) ((4 + (b) * 2 + (h)) * HTB)
#define PG8_STB(bufoff, gbase) stage2(lds, (bufoff), ldsw, (gbase), voffB[0], voffB[1])
#define PG8_STA(bufoff, gk, h, NX) do { if constexpr (GATHER) { const unsigned _o0 = (NX) ? vn[h][0] : vc[h][0], _o1 = (NX) ? vn[h][1] : vc[h][1]; stage2(lds, (bufoff), ldsw, (gk), _o0, _o1); } \
        else stage2(lds, (bufoff), ldsw, (gk) + (h) * hstepA, voffA[0], voffA[1]); } while (0)
#define PG8_LDA(dst, b, h) do { _Pragma("unroll") for (int m = 0; m < 4; ++m) _Pragma("unroll") for (int k = 0; k < 2; ++k) dst[m][k] = *(const LAS bf16x8*)(lds + PG8_SA(b, h) + aoff + m * 2048 + k * 1024); } while (0)
#define PG8_LDB(dst, b, h) do { _Pragma("unroll") for (int n = 0; n < 2; ++n) _Pragma("unroll") for (int k = 0; k < 2; ++k) dst[n][k] = *(const LAS bf16x8*)(lds + PG8_SB(b, h) + boff + n * 2048 + k * 1024); } while (0)
#define PG8_MMA(ai, bj, At, Bt) do { __builtin_amdgcn_s_setprio(1); if constexpr (MXS != 0) { _Pragma("unroll") for (int m = 0; m < 4; ++m) _Pragma("unroll") for (int n = 0; n < 2; ++n) \
        asm volatile("v_mfma_scale_f32_16x16x128_f8f6f4 %0, %1, %2, %0, %3, %3 op_sel_hi:[0,0,0]" : "+v"(acc[ai][bj][m][n]) : "v"(mx_cat(Bt[n][0], Bt[n][1])), "v"(mx_cat(At[m][0], At[m][1])), "v"(mxs_)); } \
        else { _Pragma("unroll") for (int m = 0; m < 4; ++m) _Pragma("unroll") for (int n = 0; n < 2; ++n) _Pragma("unroll") for (int k = 0; k < 2; ++k) \
        acc[ai][bj][m][n] = __builtin_amdgcn_mfma_f32_16x16x32_bf16(Bt[n][k], At[m][k], acc[ai][bj][m][n], 0, 0, 0); } __builtin_amdgcn_s_setprio(0); } while (0)
#define PG8_WAIT_V(n) asm volatile("s_waitcnt vmcnt(" #n ")" ::: "memory")
#define PG8_WAIT_L(n) asm volatile("s_waitcnt lgkmcnt(" #n ")" ::: "memory")
#define PG8_BAR __builtin_amdgcn_s_barrier()
#define PG8_SCHED __builtin_amdgcn_sched_barrier(0)
    Unit cur, nxt; int ui = 0;
    if (!S.next(0, cur)) return;
    int mxs_ = MXS * 0x01010101; asm volatile("" : "+v"(mxs_));
    unsigned vc[2][2], vn[2][2];
    if constexpr (GATHER) {
#pragma unroll
        for (int h = 0; h < 2; ++h)
#pragma unroll
            for (int i = 0; i < 2; ++i) { vc[h][i] = ((unsigned)S.row(cur, h * HALF + RA[i]) * (unsigned)lda + (unsigned)CA[i]) * 2u; vn[h][i] = vc[h][i]; }
        if constexpr (!Sched::ROW_LDS) asm volatile("s_waitcnt vmcnt(0)" ::: "memory");
    }
    f32x4 acc[2][2][4][2];
#pragma unroll
    for (int a = 0; a < 2; ++a)
#pragma unroll
        for (int b = 0; b < 2; ++b)
#pragma unroll
            for (int m = 0; m < 4; ++m)
#pragma unroll
                for (int n = 0; n < 2; ++n) acc[a][b][m][n] = (f32x4){0.f, 0.f, 0.f, 0.f};
    bf16x8 At[4][2], B0[2][2], B1[2][2];
    const char* cA = cur.A; const char* cB = cur.B;
    PG8_STB(PG8_SB(0, 0), cB); PG8_STB(PG8_SB(0, 1), cB + hstepB); PG8_STA(PG8_SA(0, 0), cA, 0, false); PG8_STA(PG8_SA(0, 1), cA, 1, false);
    if (wr == 1) PG8_BAR;
    PG8_WAIT_V(2); PG8_BAR;
    PG8_STB(PG8_SB(1, 0), cB + kstep); PG8_STA(PG8_SA(1, 0), cA + kstep, 0, false); PG8_STB(PG8_SB(1, 1), cB + hstepB + kstep);
    PG8_WAIT_V(6); PG8_BAR;
    for (;;) {
        const bool has_next = S.next(ui + 1, nxt);
        const char* nA = has_next ? nxt.A : cA; const char* nB = has_next ? nxt.B : cB;
#pragma unroll 1
        for (int t = 0; t < nt; t += 2) {
            const bool last = (t == nt - 2);
            const char* a1 = cA + (size_t)(t + 1) * kstep;
            const char* a2 = last ? nA : cA + (size_t)(t + 2) * kstep; const char* b2 = last ? nB : cB + (size_t)(t + 2) * kstep;
            const char* a3 = a2 + kstep; const char* b3 = b2 + kstep;
            if constexpr (GATHER) {
                if (last && has_next) {
#pragma unroll
                    for (int h = 0; h < 2; ++h)
#pragma unroll
                        for (int i = 0; i < 2; ++i) vn[h][i] = ((unsigned)S.row(nxt, h * HALF + RA[i]) * (unsigned)lda + (unsigned)CA[i]) * 2u;
                    if constexpr (!Sched::ROW_LDS) asm volatile("s_waitcnt vmcnt(0)" ::: "memory");
                }
            }
            PG8_LDB(B0, 0, 0); PG8_LDB(B1, 0, 1); PG8_SCHED; PG8_LDA(At, 0, 0); PG8_STA(PG8_SA(1, 1), a1, 1, false);
            PG8_WAIT_V(8); PG8_WAIT_L(0); PG8_BAR; PG8_MMA(0, 0, At, B0); PG8_MMA(0, 1, At, B1); PG8_BAR; PG8_SCHED;
            PG8_LDA(At, 0, 1); PG8_STB(PG8_SB(0, 0), b2); PG8_STB(PG8_SB(0, 1), b2 + hstepB); PG8_STA(PG8_SA(0, 0), a2, 0, last);
            PG8_WAIT_V(8); PG8_WAIT_L(0); PG8_BAR; PG8_MMA(1, 0, At, B0); PG8_MMA(1, 1, At, B1); PG8_BAR; PG8_SCHED;
            PG8_LDB(B0, 1, 0); PG8_LDB(B1, 1, 1); PG8_SCHED; PG8_LDA(At, 1, 0); PG8_STA(PG8_SA(0, 1), a2, 1, last);
            PG8_WAIT_V(8); PG8_WAIT_L(0); PG8_BAR; PG8_MMA(0, 0, At, B0); PG8_MMA(0, 1, At, B1); PG8_BAR; PG8_SCHED;
            PG8_LDA(At, 1, 1); PG8_STB(PG8_SB(1, 0), b3); PG8_STB(PG8_SB(1, 1), b3 + hstepB); PG8_STA(PG8_SA(1, 0), a3, 0, last);
            PG8_WAIT_V(8); PG8_WAIT_L(0); PG8_BAR; PG8_MMA(1, 0, At, B0); PG8_MMA(1, 1, At, B1); PG8_BAR; PG8_SCHED;
        }
        if constexpr (ALIGN_EPI) { if (wr == 0) PG8_BAR; }
        if constexpr (MXS != 0) asm volatile("s_nop 15\n\ts_nop 15" ::: "memory");
        { int fr_ = fr, fq_ = fq; asm volatile("" : "+v"(fr_), "+v"(fq_));
          E(acc, cur, wr, wc, fr_, fq_); }
        if (!has_next) break;
#pragma unroll
        for (int a = 0; a < 2; ++a)
#pragma unroll
            for (int b = 0; b < 2; ++b)
#pragma unroll
                for (int m = 0; m < 4; ++m)
#pragma unroll
                    for (int n = 0; n < 2; ++n) acc[a][b][m][n] = (f32x4){0.f, 0.f, 0.f, 0.f};
        cur = nxt; cA = nA; cB = nB; ++ui;
        if constexpr (GATHER) {
#pragma unroll
            for (int h = 0; h < 2; ++h)
#pragma unroll
                for (int i = 0; i < 2; ++i) vc[h][i] = vn[h][i];
        }
        if constexpr (ALIGN_EPI) { if (wr == 1) PG8_BAR; }
    }
    PG8_WAIT_V(0);
    if constexpr (!ALIGN_EPI) { if (wr == 0) PG8_BAR; }
    PG8_BAR;
#undef PG8_SA
#undef PG8_SB
#undef PG8_STB
#undef PG8_STA
#undef PG8_LDA
#undef PG8_LDB
#undef PG8_MMA
#undef PG8_WAIT_V
#undef PG8_WAIT_L
#undef PG8_BAR
#undef PG8_SCHED
}
}
#define XB_TMO      128
#define XB_XCNT(j)  (256  + 64 * (j))
#define XB_XSUB(j)  (1280 + 64 * (j))
#define XB_XGEN(j)  (2304 + 64 * (j))
#define XB_TOP      3328
#define XB_TOPGEN   3392
#define XCD_BAR_WORDS 3456
#define XB_SPIN_CAP (1u << 18)
__device__ __forceinline__ unsigned xb_ld(unsigned* p)              { return __hip_atomic_load(p, __ATOMIC_RELAXED, __HIP_MEMORY_SCOPE_AGENT); }
__device__ __forceinline__ unsigned xb_add(unsigned* p, unsigned v) { return __hip_atomic_fetch_add(p, v, __ATOMIC_RELAXED, __HIP_MEMORY_SCOPE_AGENT); }
__device__ __forceinline__ unsigned xb_xcc_id() { return (unsigned)__builtin_amdgcn_s_getreg((3 << 11) | 20) & 0xFu; }
#define XB_SPIN(cond, bar) do { unsigned _sp = 0; while (cond) { __builtin_amdgcn_s_sleep(1); \
    if ((++_sp & 255u) == 0u) { if (xb_ld(&(bar)[XB_TMO])) break; if (_sp > XB_SPIN_CAP) { atomicAdd(&(bar)[XB_TMO], 1u); break; } } } } while (0)
struct XcdBarrier { unsigned* bar; unsigned x; volatile LAS unsigned* st; };
__device__ __forceinline__ XcdBarrier xcd_barrier_post(unsigned* bar, volatile LAS unsigned* st) {
    XcdBarrier b; b.bar = bar; b.x = xb_xcc_id(); b.st = st;
    if (threadIdx.x == 0) (void)xb_add(&bar[XB_XCNT(b.x)], 1u);
    return b;
}
__device__ __forceinline__ void xcd_barrier_complete(unsigned* bar, unsigned x, unsigned& nloc, unsigned& nx) {
    const unsigned G = gridDim.x * gridDim.y * gridDim.z;
    unsigned sum, cnt, mine, sp = 0u;
    for (;;) {
        sum = 0u; cnt = 0u; mine = 0u;
#pragma unroll
        for (unsigned j = 0; j < 16; ++j) { const unsigned c = xb_ld(&bar[XB_XCNT(j)]); sum += c; cnt += (c > 0u) ? 1u : 0u; mine = (j == x) ? c : mine; }
        if (sum == G) break;
        __builtin_amdgcn_s_sleep(1);
        if ((++sp & 255u) == 0u) { if (xb_ld(&bar[XB_TMO])) break; if (sp > XB_SPIN_CAP) { atomicAdd(&bar[XB_TMO], 1u); break; } }
    }
    nloc = mine > 0u ? mine : 1u; nx = cnt > 0u ? cnt : 1u;
}
__device__ __forceinline__ void xcd_barrier(const XcdBarrier& b) {
    asm volatile("s_waitcnt vmcnt(0)" ::: "memory");
    __syncthreads();
    if (threadIdx.x == 0) {
        unsigned* bar = b.bar;
        __builtin_amdgcn_s_waitcnt(0);
        unsigned nloc = b.st[0], nx = b.st[1];
        if (nloc == 0u) { xcd_barrier_complete(bar, b.x, nloc, nx); b.st[0] = nloc; b.st[1] = nx; }
        const unsigned old = xb_add(&bar[XB_XSUB(b.x)], 1u);
        const unsigned gen = old / nloc;
        if (old + 1u == (gen + 1u) * nloc) {
            __builtin_amdgcn_fence(__ATOMIC_RELEASE, "agent");
            asm volatile("s_waitcnt vmcnt(0)" ::: "memory");
            const unsigned og = xb_add(&bar[XB_TOP], 1u);
            const unsigned tg = og / nx;
            if (og + 1u == (tg + 1u) * nx) xb_add(&bar[XB_TOPGEN], 1u);
            else XB_SPIN(xb_ld(&bar[XB_TOPGEN]) == tg, bar);
            __builtin_amdgcn_fence(__ATOMIC_ACQUIRE, "agent");
            xb_add(&bar[XB_XGEN(b.x)], 1u);
            asm volatile("s_waitcnt vmcnt(0)" ::: "memory");
        } else {
            XB_SPIN(xb_ld(&bar[XB_XGEN(b.x)]) == gen, bar);
            __builtin_amdgcn_fence(__ATOMIC_ACQUIRE, "agent");
            asm volatile("s_waitcnt vmcnt(0)" ::: "memory");
        }
    }
    __syncthreads();
}

constexpr size_t MiB = 1u << 20;
constexpr size_t WS_CTL = 0, CTL_ZERO_BYTES = 64 * 1024;
constexpr size_t WS_MOD = 1 * MiB;
constexpr size_t WS_EIDX = 2 * MiB;
constexpr size_t WS_WSEL = WS_EIDX + 512 * 1024;
constexpr size_t WS_RANK = WS_WSEL + 512 * 1024;
constexpr size_t WS_TOK = 4 * MiB;
constexpr size_t WS_DST = WS_TOK + 1 * MiB;
constexpr size_t WS_WSL = WS_DST + 1 * MiB;
constexpr size_t WS_WIN = 8 * MiB;
constexpr size_t WS_POOLW = 55 * MiB;
constexpr size_t WS_WPO = 56 * MiB;
constexpr size_t WS_LORA = 60 * MiB;
constexpr size_t WS_G2 = 62 * MiB;
constexpr size_t WS_WRO = 63 * MiB;
constexpr size_t WS_WO = 71 * MiB;
constexpr size_t WS_SLAB = 80 * MiB;
constexpr size_t WS_EA = 80 * MiB;
constexpr size_t EA_STRIDE = (size_t)MT * D * 2;
constexpr size_t WS_YF = 352 * MiB, WS_YB = 416 * MiB;
constexpr size_t WS_HA = 438 * MiB;
constexpr size_t WS_Z = 480 * MiB;
constexpr size_t WS_U = 506 * MiB;
constexpr size_t WS_RM = 544 * MiB, WS_KM = 612 * MiB, WS_VM = 680 * MiB;
constexpr size_t WS_LIN = 748 * MiB;
constexpr size_t WS_DP = 774 * MiB;
constexpr size_t WS_BON = 774 * MiB;
constexpr size_t WS_Y2 = 806 * MiB;
constexpr size_t WS_MP = 838 * MiB;
constexpr size_t WS_GATES = 902 * MiB;
constexpr size_t WS_OR = 80 * MiB;
constexpr size_t WS_H2 = 520 * MiB;
constexpr size_t WS_GU = 584 * MiB;
constexpr size_t WS_GU2 = 966 * MiB, WS_GU3 = 1134 * MiB;
constexpr int GU_E2 = 52, GU_E3 = 61;
constexpr size_t WS_ACT = 792 * MiB;
constexpr size_t WS_DT = 1004 * MiB;
constexpr size_t WS_X1 = 328 * MiB;
constexpr size_t WS_YP = 8 * MiB;
constexpr size_t WS_END = 1150 * MiB;
__host__ __device__ __forceinline__ size_t gu_base(int e) { return e < GU_E2 ? WS_GU + (size_t)e * (4 * MiB) : e < GU_E3 ? WS_GU2 + (size_t)(e - GU_E2) * (4 * MiB) : WS_GU3 + (size_t)(e - GU_E3) * (4 * MiB); }
constexpr int CW_BAR = 1024;
constexpr int CW_GCNT = 8192;
constexpr int CW_O64 = 8192 + 100;
constexpr int CW_CONV = 8448, CW_P2DONE = 8512;
static_assert((CW_BAR + XCD_BAR_WORDS) <= CW_GCNT && (CW_P2DONE + 128) * 4 <= (int)CTL_ZERO_BYTES, "ctl");

constexpr int RING_OFF = 0, RING_BYTES = 131072;
constexpr int LDSCTL_OFF = RING_BYTES;
constexpr int ROWTAB_OFF = LDSCTL_OFF + 1024 + 4096, ROWTAB_UNITS = 24;
constexpr int TAB_OFF = LDSCTL_OFF + 1024;
constexpr int LDS_BYTES = 163840;

using pg8::Unit;
struct RepOrder { static constexpr bool ROW_LDS = false;
    const char* A; const char* B; size_t repA, repB, tA, tB; int nM, nN, nrep, G, c;
    __device__ __forceinline__ bool next(int i, Unit& u) const {
        const long L = (long)i * G + c; const int per = nM * nN; if (L >= (long)per * nrep) return false;
        const int rep = (int)(L / per); const int w = pg8::xcd_remap((int)(L % per), per); pg8::grid_tile(w, nM, nN, u.pm, u.pn); u.aux = rep;
        u.A = A + (size_t)rep * repA + (size_t)u.pm * tA; u.B = B + (size_t)rep * repB + (size_t)u.pn * tB; return true; }
    __device__ __forceinline__ int row(const Unit&, int) const { return 0; }
};
struct G1Order { static constexpr bool ROW_LDS = false;
    const char* A; const char* B; size_t tA, tB; int G, c;
    __device__ __forceinline__ bool next(int i, Unit& u) const {
        const long L = (long)i * G + c; constexpr int N1 = 64 * 47, N2 = 4 * 27; if (L >= N1 + N2) return false;
        if (L < N1) { const int w = pg8::xcd_remap((int)L, N1); pg8::grid_tile(w, 64, 47, u.pm, u.pn); }
        else { const int l2 = (int)L - N1; u.pm = 64 + (l2 & 3); u.pn = 4 + (l2 >> 2); }
        u.aux = 0; u.A = A + (size_t)u.pm * tA; u.B = B + (size_t)u.pn * tB; return true; }
    __device__ __forceinline__ int row(const Unit&, int) const { return 0; }
};
template <bool GUMAP> struct MoeOrderT { static constexpr bool ROW_LDS = true;
    const char* A; const char* B; const LAS int* te; const LAS int* rowtab; size_t tA, estride, jstride; int ntiles, NJ, G, c;
    __device__ __forceinline__ bool next(int i, Unit& u) const {
        const long L = (long)i * G + c; const int tot = ntiles * NJ; if (L >= tot) return false;
        const int w = pg8::xcd_remap((int)L, tot); const int rt = w / NJ, j = w - rt * NJ; const int e = te[rt];
        u.pm = rt; u.pn = j; u.aux = e; u.ui = i; u.A = A + (size_t)rt * tA; u.B = B + (GUMAP ? gu_base(e) : (size_t)e * estride) + (size_t)j * jstride; return true; }
    __device__ __forceinline__ int row(const Unit& u, int r) const { return rowtab[u.ui * 256 + r]; }
};

typedef f32x4 AccT[2][2][4][2];
#define EPI_ROWS_BEGIN _Pragma("unroll") for (int ai = 0; ai < 2; ++ai) _Pragma("unroll") for (int m = 0; m < 4; ++m) { const int rl = ai * 128 + wr * 64 + m * 16 + fr;
#define EPI_ROWS_END if (m & 1) asm volatile("" ::: "memory"); }
struct EpiG1 { static constexpr bool PERM = true; bf16* U; bf16* SLAB; unsigned char* GATES;
    __device__ __forceinline__ void operator()(const AccT& acc, const Unit& u, int wr, int wc, int fr, int fq) const {
        if (u.pn >= 31) {
            const int c0 = (u.pn - 31) * 256 + wc * 32 + 8 * fq;
            EPI_ROWS_BEGIN
                unsigned char* rowp = GATES + (size_t)(u.pm * 256 + rl) * 4096 + c0;
#pragma unroll
                for (int bj = 0; bj < 2; ++bj) { const f32x4 v0 = acc[ai][bj][m][0], v1 = acc[ai][bj][m][1]; unsigned p0 = 0u, p1 = 0u;
                    p0 = __builtin_amdgcn_cvt_pk_u8_f32(255.0f * sigmoidf_(v0[0]), 0, p0); p0 = __builtin_amdgcn_cvt_pk_u8_f32(255.0f * sigmoidf_(v0[1]), 1, p0);
                    p0 = __builtin_amdgcn_cvt_pk_u8_f32(255.0f * sigmoidf_(v0[2]), 2, p0); p0 = __builtin_amdgcn_cvt_pk_u8_f32(255.0f * sigmoidf_(v0[3]), 3, p0);
                    p1 = __builtin_amdgcn_cvt_pk_u8_f32(255.0f * sigmoidf_(v1[0]), 0, p1); p1 = __builtin_amdgcn_cvt_pk_u8_f32(255.0f * sigmoidf_(v1[1]), 1, p1);
                    p1 = __builtin_amdgcn_cvt_pk_u8_f32(255.0f * sigmoidf_(v1[2]), 2, p1); p1 = __builtin_amdgcn_cvt_pk_u8_f32(255.0f * sigmoidf_(v1[3]), 3, p1);
                    v2u w; w.x = p0; w.y = p1; *(v2u*)(rowp + bj * 128) = w; }
            EPI_ROWS_END
            return;
        }
        bf16* base; int ld, c0;
        if (u.pn < 4) { base = U; ld = 1024; c0 = u.pn * 256; } else { base = SLAB; ld = SLABLD; c0 = (u.pn - 4) * 256; }
        EPI_ROWS_BEGIN
            bf16* rowp = base + (size_t)(u.pm * 256 + rl) * ld + c0 + wc * 32 + 8 * fq;
#pragma unroll
            for (int bj = 0; bj < 2; ++bj) { const f32x4 v0 = acc[ai][bj][m][0], v1 = acc[ai][bj][m][1];
                v4u w; w.x = pk2(v0[0], v0[1]); w.y = pk2(v0[2], v0[3]); w.z = pk2(v1[0], v1[1]); w.w = pk2(v1[2], v1[3]); *(v4u*)(rowp + bj * 128) = w; }
        EPI_ROWS_END
    }
};
struct EpiLora { static constexpr bool PERM = true; unsigned short* EA; const float* w0; const float* a0;
    __device__ __forceinline__ void operator()(const AccT& acc, const Unit& u, int wr, int wc, int fr, int fq) const {
        const int rep = u.aux; const float* bias = (rep < 2 ? w0 + rep * D : a0 + (rep - 2) * D) + u.pn * 256 + wc * 32 + 8 * fq;
        unsigned short* base = EA + (size_t)rep * ((size_t)MT * D);
        if (rep < 2) { const float cc = -0.8750424f;
            EPI_ROWS_BEGIN
                unsigned short* rowp = base + (size_t)(u.pm * 256 + rl) * D + u.pn * 256 + wc * 32 + 8 * fq;
#pragma unroll
                for (int bj = 0; bj < 2; ++bj) { const f32x4 v0 = acc[ai][bj][m][0] + *(const f32x4*)(bias + bj * 128), v1 = acc[ai][bj][m][1] + *(const f32x4*)(bias + bj * 128 + 4);
                    v4u w; w.x = pkh2(cc * sigmoidf_(v0[0]), cc * sigmoidf_(v0[1])); w.y = pkh2(cc * sigmoidf_(v0[2]), cc * sigmoidf_(v0[3]));
                    w.z = pkh2(cc * sigmoidf_(v1[0]), cc * sigmoidf_(v1[1])); w.w = pkh2(cc * sigmoidf_(v1[2]), cc * sigmoidf_(v1[3]));
                    *(v4u*)(rowp + bj * 128) = w; }
            EPI_ROWS_END
        } else {
            EPI_ROWS_BEGIN
                unsigned char* rowp = (unsigned char*)base + (size_t)(u.pm * 256 + rl) * D + u.pn * 256 + wc * 32 + 8 * fq;
#pragma unroll
                for (int bj = 0; bj < 2; ++bj) { const f32x4 v0 = acc[ai][bj][m][0] + *(const f32x4*)(bias + bj * 128), v1 = acc[ai][bj][m][1] + *(const f32x4*)(bias + bj * 128 + 4); unsigned p0 = 0u, p1 = 0u;
                    p0 = __builtin_amdgcn_cvt_pk_u8_f32(255.0f * sigmoidf_(v0[0]), 0, p0); p0 = __builtin_amdgcn_cvt_pk_u8_f32(255.0f * sigmoidf_(v0[1]), 1, p0);
                    p0 = __builtin_amdgcn_cvt_pk_u8_f32(255.0f * sigmoidf_(v0[2]), 2, p0); p0 = __builtin_amdgcn_cvt_pk_u8_f32(255.0f * sigmoidf_(v0[3]), 3, p0);
                    p1 = __builtin_amdgcn_cvt_pk_u8_f32(255.0f * sigmoidf_(v1[0]), 0, p1); p1 = __builtin_amdgcn_cvt_pk_u8_f32(255.0f * sigmoidf_(v1[1]), 1, p1);
                    p1 = __builtin_amdgcn_cvt_pk_u8_f32(255.0f * sigmoidf_(v1[2]), 2, p1); p1 = __builtin_amdgcn_cvt_pk_u8_f32(255.0f * sigmoidf_(v1[3]), 3, p1);
                    v2u w; w.x = p0; w.y = p1; *(v2u*)(rowp + bj * 128) = w; }
            EPI_ROWS_END
        }
    }
};
struct EpiPoolG { static constexpr bool PERM = true; bf16* Y2; const float* scale;
    __device__ __forceinline__ void operator()(const AccT& acc, const Unit& u, int wr, int wc, int fr, int fq) const {
        const int cb = u.aux * 256 + wc * 32 + 8 * fq;
        f32x4 s0[2], s1[2];
#pragma unroll
        for (int bj = 0; bj < 2; ++bj) { s0[bj] = *(const f32x4*)(scale + cb + bj * 128); s1[bj] = *(const f32x4*)(scale + cb + bj * 128 + 4); }
        EPI_ROWS_BEGIN
            bf16* rowp = Y2 + (size_t)(u.pm * 256 + rl) * 1024 + cb;
#pragma unroll
            for (int bj = 0; bj < 2; ++bj) { const f32x4 v0 = acc[ai][bj][m][0] * s0[bj], v1 = acc[ai][bj][m][1] * s1[bj];
                v4u w; w.x = pk2(v0[0], v0[1]); w.y = pk2(v0[2], v0[3]); w.z = pk2(v1[0], v1[1]); w.w = pk2(v1[2], v1[3]); *(v4u*)(rowp + bj * 128) = w; }
        EPI_ROWS_END
    }
};
template <int MODE> struct EpiMix { static constexpr bool PERM = true; bf16* OUT; int ldo; const void* AUX1; int ld1; const bf16* AUX2; int ld2;
    __device__ __forceinline__ void operator()(const AccT& acc, const Unit& u, int wr, int wc, int fr, int fq) const {
        const int cb = u.pn * 256 + wc * 32 + 8 * fq;
        EPI_ROWS_BEGIN
            const size_t row = (size_t)(u.pm * 256 + rl);
#pragma unroll
            for (int bj = 0; bj < 2; ++bj) { const f32x4 v0 = acc[ai][bj][m][0], v1 = acc[ai][bj][m][1];
                float x[8];
                if (MODE == 1) { const v4u a1 = *(const v4u*)((const bf16*)AUX1 + row * ld1 + cb + bj * 128);
                    x[0] = bflo(a1.x); x[1] = bfhi(a1.x); x[2] = bflo(a1.y); x[3] = bfhi(a1.y); x[4] = bflo(a1.z); x[5] = bfhi(a1.z); x[6] = bflo(a1.w); x[7] = bfhi(a1.w); }
                else { const v2u a1 = *(const v2u*)((const unsigned char*)AUX1 + row * ld1 + cb + bj * 128); const float k = 1.0f / 255.0f;
                    x[0] = (float)(a1.x & 0xffu) * k; x[1] = (float)((a1.x >> 8) & 0xffu) * k; x[2] = (float)((a1.x >> 16) & 0xffu) * k; x[3] = (float)(a1.x >> 24) * k;
                    x[4] = (float)(a1.y & 0xffu) * k; x[5] = (float)((a1.y >> 8) & 0xffu) * k; x[6] = (float)((a1.y >> 16) & 0xffu) * k; x[7] = (float)(a1.y >> 24) * k; }
                float o[8];
                if (MODE == 0 || MODE == 1) {
#pragma unroll
                    for (int j = 0; j < 4; ++j) { o[j] = x[j] * v0[j]; o[4 + j] = x[4 + j] * v1[j]; } }
                else { const v4u a2 = *(const v4u*)(AUX2 + row * ld2 + cb + bj * 128);
                    const float y[8] = {bflo(a2.x), bfhi(a2.x), bflo(a2.y), bfhi(a2.y), bflo(a2.z), bfhi(a2.z), bflo(a2.w), bfhi(a2.w)};
#pragma unroll
                    for (int j = 0; j < 4; ++j) { o[j] = y[j] + x[j] * v0[j]; o[4 + j] = y[4 + j] + x[4 + j] * v1[j]; } }
                v4u w; w.x = pk2(o[0], o[1]); w.y = pk2(o[2], o[3]); w.z = pk2(o[4], o[5]); w.w = pk2(o[6], o[7]);
                *(v4u*)(OUT + row * ldo + cb + bj * 128) = w; }
        EPI_ROWS_END
    }
};
struct EpiX1 { static constexpr bool PERM = true; const float* X; bf16* OUT; const float* MOD;
    __device__ __forceinline__ void operator()(const AccT& acc, const Unit& u, int wr, int wc, int fr, int fq) const {
        const int b = u.pm >> 4;
        const int cb = u.pn * 256 + wc * 32 + 8 * fq; const float* g = MOD + (size_t)b * 12288 + 4096 + cb;
        f32x4 gv[2][2];
#pragma unroll
        for (int bj = 0; bj < 2; ++bj)
#pragma unroll
            for (int n = 0; n < 2; ++n) gv[bj][n] = *(const f32x4*)(g + bj * 128 + n * 4);
        EPI_ROWS_BEGIN
            const size_t off = (size_t)(u.pm * 256 + rl) * D + cb;
#pragma unroll
            for (int bj = 0; bj < 2; ++bj) { const f32x4 x0 = *(const f32x4*)(X + off + bj * 128), x1 = *(const f32x4*)(X + off + bj * 128 + 4);
                const f32x4 v0 = x0 + gv[bj][0] * acc[ai][bj][m][0], v1 = x1 + gv[bj][1] * acc[ai][bj][m][1];
                v4u w; w.x = pk2(v0[0], v0[1]); w.y = pk2(v0[2], v0[3]); w.z = pk2(v1[0], v1[1]); w.w = pk2(v1[2], v1[3]); *(v4u*)(OUT + off + bj * 128) = w; }
        EPI_ROWS_END
    }
};
constexpr float ACT_F8SCALE = 8.0f;
struct EpiAct { static constexpr bool PERM = true; unsigned char* ACT;
    __device__ __forceinline__ void operator()(const AccT& acc, const Unit& u, int wr, int wc, int fr, int fq) const {
        EPI_ROWS_BEGIN
            const f32x4 g0 = acc[ai][0][m][0], g1 = acc[ai][0][m][1], u0 = acc[ai][1][m][0], u1 = acc[ai][1][m][1];
            float o[8];
#pragma unroll
            for (int j = 0; j < 4; ++j) { o[j] = __builtin_amdgcn_fmed3f(ACT_F8SCALE * g0[j] * sigmoidf_(g0[j]) * u0[j], -440.f, 440.f); o[4 + j] = __builtin_amdgcn_fmed3f(ACT_F8SCALE * g1[j] * sigmoidf_(g1[j]) * u1[j], -440.f, 440.f); }
            v2u w; w.x = pk8(o[0], o[1], o[2], o[3]); w.y = pk8(o[4], o[5], o[6], o[7]);
            *(v2u*)(ACT + (size_t)(u.pm * 256 + rl) * DEXP + u.pn * 128 + wc * 32 + 8 * fq) = w;
        EPI_ROWS_END
    }
};
constexpr float YP_SCALE = 8.0f;
struct EpiDown { static constexpr bool PERM = true, PERM16 = true; unsigned char* YP;
    __device__ __forceinline__ void operator()(const AccT& acc, const Unit& u, int wr, int wc, int fr, int fq) const {
        const int cb = u.pn * 256 + wc * 64 + 16 * fq;
        EPI_ROWS_BEGIN
            int p[4];
#pragma unroll
            for (int bj = 0; bj < 2; ++bj) { const f32x4 v0 = acc[ai][bj][m][0] * YP_SCALE, v1 = acc[ai][bj][m][1] * YP_SCALE;
                int p0 = __builtin_amdgcn_cvt_pk_fp8_f32(v0[0], v0[1], 0, false); p0 = __builtin_amdgcn_cvt_pk_fp8_f32(v0[2], v0[3], p0, true);
                int p1 = __builtin_amdgcn_cvt_pk_fp8_f32(v1[0], v1[1], 0, false); p1 = __builtin_amdgcn_cvt_pk_fp8_f32(v1[2], v1[3], p1, true);
                p[2 * bj] = p0; p[2 * bj + 1] = p1; }
            v4u w; w.x = (unsigned)p[0]; w.y = (unsigned)p[1]; w.z = (unsigned)p[2]; w.w = (unsigned)p[3];
            *(v4u*)(YP + (size_t)(u.pm * 256 + rl) * D + cb) = w;
        EPI_ROWS_END
    }
};
struct Frame {
    LAS unsigned char* lds;
    volatile LAS unsigned* MISC;
    unsigned* ctl;
    int tid, lane, wave, vcu, G;
    unsigned char* ws;
};
struct Args { const float* in[34]; float* out; unsigned char* ws; int ph_lo, ph_hi; };
enum { I_X = 0, I_C, I_CTX, I_CCTX, I_N1G, I_N2G, I_ADAW, I_ADAB, I_WIN, I_MU, I_POOLW, I_POOLS, I_WPO, I_DW0, I_DW2, I_IA0, I_IA2, I_G2, I_KK, I_KA, I_RK, I_LNW, I_LNB,
       I_WRO, I_WO, I_RW, I_RB, I_EG, I_EU, I_ED, I_SG, I_SU, I_SD, I_FG };

struct TrJob { const float* src; bf16* dst; int ldw, kvalid, ldt, k0, n0, drow0; float f8; };
template <bool NT = false> __device__ __forceinline__ void tr_load(const TrJob& j, f32x4 (&v)[16], int lane) {
    const int r2 = lane >> 4, c4 = lane & 15;
#pragma unroll
    for (int i = 0; i < 8; ++i) {
#pragma unroll
        for (int h = 0; h < 2; ++h) { const int k = j.k0 + 8 * i + 2 * r2 + h; const int kc = k < j.kvalid ? k : 0;
            const f32x4* sp_ = (const f32x4*)(j.src + (size_t)kc * j.ldw + j.n0 + 4 * c4); const f32x4 x = NT ? __builtin_nontemporal_load(sp_) : *sp_; v[2 * i + h] = (k < j.kvalid) ? x : (f32x4){0.f, 0.f, 0.f, 0.f}; } }
}
template <bool NT = false> __device__ __forceinline__ void tr_store(const TrJob& j, const f32x4 (&v)[16], LAS unsigned* P, int lane) {
    const int r2 = lane >> 4, c4 = lane & 15;
#pragma unroll
    for (int i = 0; i < 8; ++i) { LAS unsigned* p = P + (4 * i + r2) * 65 + 4 * c4;
        p[0] = pk2(v[2 * i].x, v[2 * i + 1].x); p[1] = pk2(v[2 * i].y, v[2 * i + 1].y); p[2] = pk2(v[2 * i].z, v[2 * i + 1].z); p[3] = pk2(v[2 * i].w, v[2 * i + 1].w); }
    LDS_WAIT(); asm volatile("" ::: "memory");
    const int nl = lane >> 3, q = lane & 7;
#pragma unroll
    for (int jj = 0; jj < 8; ++jj) { const int n = 8 * jj + nl; const LAS unsigned* s = P + (4 * q) * 65 + n;
        v4u o; o.x = s[0]; o.y = s[65]; o.z = s[130]; o.w = s[195];
        v4u* dp_ = (v4u*)(j.dst + (size_t)(j.drow0 + n) * j.ldt + j.k0 + 8 * q); if (NT) __builtin_nontemporal_store(o, dp_); else *dp_ = o; }
    LDS_WAIT(); asm volatile("" ::: "memory");
}
template <bool NT = false> __device__ __forceinline__ void tr_load8(const TrJob& j, f32x4 (&v)[16], int lane) {
    const int r2 = lane >> 4, c4 = lane & 15;
#pragma unroll
    for (int i = 0; i < 4; ++i) {
#pragma unroll
        for (int h = 0; h < 4; ++h) { const int k = j.k0 + 16 * i + 4 * r2 + h; const f32x4* sp_ = (const f32x4*)(j.src + (size_t)k * j.ldw + j.n0 + 4 * c4); v[4 * i + h] = NT ? __builtin_nontemporal_load(sp_) : *sp_; } }
}
template <bool NT = false> __device__ __forceinline__ void tr_store8(const TrJob& j, const f32x4 (&v)[16], LAS unsigned* P, int lane) {
    const int r2 = lane >> 4, c4 = lane & 15; const float sc = j.f8;
#pragma unroll
    for (int i = 0; i < 4; ++i) { LAS unsigned* p = P + (4 * i + r2) * 65 + 4 * c4;
        p[0] = pk8(sc * v[4 * i].x, sc * v[4 * i + 1].x, sc * v[4 * i + 2].x, sc * v[4 * i + 3].x); p[1] = pk8(sc * v[4 * i].y, sc * v[4 * i + 1].y, sc * v[4 * i + 2].y, sc * v[4 * i + 3].y);
        p[2] = pk8(sc * v[4 * i].z, sc * v[4 * i + 1].z, sc * v[4 * i + 2].z, sc * v[4 * i + 3].z); p[3] = pk8(sc * v[4 * i].w, sc * v[4 * i + 1].w, sc * v[4 * i + 2].w, sc * v[4 * i + 3].w); }
    LDS_WAIT(); asm volatile("" ::: "memory");
    const int nl = lane >> 2, q = lane & 3;
#pragma unroll
    for (int jj = 0; jj < 4; ++jj) { const int n = 16 * jj + nl; const LAS unsigned* s = P + (4 * q) * 65 + n;
        v4u o; o.x = s[0]; o.y = s[65]; o.z = s[130]; o.w = s[195];
        v4u* dp_ = (v4u*)((unsigned char*)j.dst + (size_t)(j.drow0 + n) * j.ldt + j.k0 + 16 * q); if (NT) __builtin_nontemporal_store(o, dp_); else *dp_ = o; }
    LDS_WAIT(); asm volatile("" ::: "memory");
}
template <bool NT = false> __device__ __forceinline__ void tr_ld(const TrJob& j, f32x4 (&v)[16], int lane) { if (j.f8 != 0.f) tr_load8<NT>(j, v, lane); else tr_load<NT>(j, v, lane); }
template <bool NT = false> __device__ __forceinline__ void tr_st(const TrJob& j, const f32x4 (&v)[16], LAS unsigned* P, int lane) { if (j.f8 != 0.f) tr_store8<NT>(j, v, P, lane); else tr_store<NT>(j, v, P, lane); }
template <class Dec> __device__ __forceinline__ void tr_run(const Dec& dec, int first, int stride, LAS unsigned* P, int lane) {
    TrJob ja, jb; f32x4 va[16], vb[16];
    int it = first; bool ha = dec(it, ja); if (ha) tr_ld(ja, va, lane);
    while (ha) {
        it += stride; const bool hb = dec(it, jb); if (hb) tr_ld(jb, vb, lane);
        tr_st(ja, va, P, lane);
        if (!hb) break;
        it += stride; ha = dec(it, ja); if (ha) tr_ld(ja, va, lane);
        tr_st(jb, vb, P, lane);
    }
}
__device__ __forceinline__ void p0_prologue(Frame& F, const Args& a) {
    {
        LAS float* sv = (LAS float*)F.lds;
        LAS float* part = (LAS float*)(F.lds + 40960);
        bool did = false;
        for (int cb = blockIdx.x; cb < 192; cb += F.G) {
            if (!did) { for (int idx = F.tid; idx < 5 * D; idx += 512) { const int j = idx >> 11, k = idx & 2047; const float v = (j < 4) ? a.in[I_C][j * D + k] : a.in[I_CCTX][k]; sv[idx] = v / (1.0f + __expf(-v)); } did = true; }
            __syncthreads();
            const int col = 64 * cb + F.lane, k0 = 256 * F.wave; const float* wp = a.in[I_ADAW] + (size_t)k0 * 12288 + col;
            float acc[5] = {0.f, 0.f, 0.f, 0.f, 0.f};
#pragma unroll 32
            for (int k = 0; k < 256; ++k) { const float w = wp[(size_t)k * 12288];
#pragma unroll
                for (int j = 0; j < 5; ++j) acc[j] += sv[j * D + k0 + k] * w; }
#pragma unroll
            for (int j = 0; j < 5; ++j) part[(F.wave * 5 + j) * 64 + F.lane] = acc[j];
            __syncthreads();
            if (F.tid < 320) { const int j = F.tid >> 6, l = F.tid & 63; float s = a.in[I_ADAB][64 * cb + l];
#pragma unroll
                for (int w = 0; w < 8; ++w) s += part[(w * 5 + j) * 64 + l];
                ((float*)(F.ws + WS_MOD))[j * 12288 + 64 * cb + l] = s; }
            __syncthreads();
        }
        __syncthreads();
    }
    {
        struct DecSmall { const float* const* in; unsigned char* ws;
            __device__ __forceinline__ bool operator()(int it, TrJob& j) const {
                constexpr int I_1 = 32 * 186, I_2 = 4 * 16, I_3 = 16 * 32, I_4 = 4 * 32, I_5 = 32 * 32, I_6 = 32 * 32, I_7 = 4 * 2 * 32;
                int r = it; if (r < 0) return false;
                if (r < I_1) { const int kb = r / 186, nb = r % 186, n0 = nb * 64; j = TrJob{in[I_WIN], (bf16*)(ws + WS_WIN), DIN, D, D, kb * 64, n0, n0 + (n0 >= 7808 ? 128 : 0)}; return true; } r -= I_1;
                if (r < I_2) { const int g = r / 16, q = r % 16; j = TrJob{in[I_POOLW] + (size_t)g * 65536, (bf16*)(ws + WS_POOLW) + (size_t)g * 65536, 256, 256, 256, (q / 4) * 64, (q % 4) * 64, (q % 4) * 64}; return true; } r -= I_2;
                if (r < I_3) { j = TrJob{in[I_WPO], (bf16*)(ws + WS_WPO), D, 1024, 1024, (r / 32) * 64, (r % 32) * 64, (r % 32) * 64}; return true; } r -= I_3;
                if (r < I_4) { j = TrJob{in[I_G2], (bf16*)(ws + WS_G2), D, 256, 256, (r / 32) * 64, (r % 32) * 64, (r % 32) * 64}; return true; } r -= I_4;
                if (r < I_5) { j = TrJob{in[I_WRO], (bf16*)(ws + WS_WRO), D, D, D, (r / 32) * 64, (r % 32) * 64, (r % 32) * 64}; return true; } r -= I_5;
                if (r < I_6) { j = TrJob{in[I_WO], (bf16*)(ws + WS_WO), D, D, D, (r / 32) * 64, (r % 32) * 64, (r % 32) * 64}; return true; } r -= I_6;
                if (r < I_7) { const int mtx = r / 64, q = r % 64;
                    const float* src = (mtx < 2 ? in[I_DW2] + (size_t)mtx * 96 * D : in[I_IA2] + (size_t)(mtx - 2) * 96 * D);
                    j = TrJob{src, (bf16*)(ws + WS_LORA) + (size_t)mtx * D * 128, D, 96, 128, (q / 32) * 64, (q % 32) * 64, (q % 32) * 64}; return true; }
                return false; } };
        DecSmall dec{a.in, F.ws};
        tr_run(dec, F.vcu * 8 + F.wave, F.G * 8, (LAS unsigned*)(F.lds + F.wave * 16384), F.lane);
    }
    const int gt = F.vcu * 512 + F.tid, NGT = F.G * 512;
    { v4u* z = (v4u*)((bf16*)(F.ws + WS_WIN) + (size_t)7808 * D); for (int i = gt; i < 128 * D / 8; i += NGT) z[i] = (v4u){0u, 0u, 0u, 0u}; }
    { int* tok = (int*)(F.ws + WS_TOK); for (int i = gt; i < NSLOT; i += NGT) tok[i] = 0; }
}

__device__ __forceinline__ void p1_norm1(Frame& F, const Args& a) {
    const int gw = F.vcu * 8 + F.wave, NGW = F.G * 8; const float* MOD = (const float*)(F.ws + WS_MOD); bf16* HA = (bf16*)(F.ws + WS_HA);
    for (int mrow = gw; mrow < MT; mrow += NGW) {
        const float* src = (mrow < NT) ? a.in[I_X] + (size_t)mrow * D : a.in[I_CTX] + (size_t)(mrow - NT) * D; const int j = (mrow < NT) ? (mrow >> 12) : 4;
        const f32x4* xr = (const f32x4*)src + F.lane; f32x4 v[8]; float s = 0.f;
#pragma unroll
        for (int q = 0; q < 8; ++q) { v[q] = xr[64 * q]; s += (v[q].x * v[q].x + v[q].y * v[q].y) + (v[q].z * v[q].z + v[q].w * v[q].w); }
        const float rstd = 1.0f / sqrtf(wave_sum(s) * (1.0f / D) + 1e-6f);
        const f32x4* g = (const f32x4*)a.in[I_N1G] + F.lane; const f32x4* sh = (const f32x4*)(MOD + (size_t)j * 12288) + F.lane; const f32x4* sc = (const f32x4*)(MOD + (size_t)j * 12288 + 2048) + F.lane;
        v2u* o = (v2u*)(HA + (size_t)mrow * D) + F.lane;
#pragma unroll
        for (int q = 0; q < 8; ++q) { const f32x4 y = v[q] * rstd * g[64 * q] * (sc[64 * q] + 1.0f) + sh[64 * q]; v2u w; w.x = pk2(y.x, y.y); w.y = pk2(y.z, y.w); o[64 * q] = w; }
    }
}

template <int W> __device__ __forceinline__ void pool_item(const unsigned* U32, unsigned* DP32, int m0, int cp) {
    unsigned raw[64];
#pragma unroll
    for (int x = 0; x < 64; ++x) raw[x] = U32[(size_t)(m0 + x) * 512 + cp];
    float lo[64], hi[64];
#pragma unroll
    for (int x = 0; x < 64; ++x) { lo[x] = bflo(raw[x]); hi[x] = bfhi(raw[x]); }
#pragma unroll
    for (int x = 0; x < 64; ++x) { const int l = (x - W / 2) < 0 ? 0 : (x - W / 2), h = (x + W / 2) > 64 ? 64 : (x + W / 2); float s0 = 0.f, s1 = 0.f;
#pragma unroll
        for (int j = l; j < h; ++j) { s0 += lo[j]; s1 += hi[j]; }
        const float inv = 1.0f / (float)(h - l); DP32[(size_t)(m0 + x) * 512 + cp] = pk2(s0 * inv - lo[x], s1 * inv - hi[x]); }
}
__device__ __forceinline__ void p3_mix_store(const v4u o, const v4u nb, const f32x4 m0, const f32x4 m1, int c0, int mrow, bf16* RM, bf16* KM, bf16* VM, bf16* LIN) {
    float r[8];
    { const float ov[8] = {bflo(o.x), bfhi(o.x), bflo(o.y), bfhi(o.y), bflo(o.z), bfhi(o.z), bflo(o.w), bfhi(o.w)};
      const float nv[8] = {bflo(nb.x), bfhi(nb.x), bflo(nb.y), bfhi(nb.y), bflo(nb.z), bfhi(nb.z), bflo(nb.w), bfhi(nb.w)};
      const float mv[8] = {m0.x, m0.y, m0.z, m0.w, m1.x, m1.y, m1.z, m1.w};
#pragma unroll
      for (int e = 0; e < 8; ++e) r[e] = ov[e] + (nv[e] - ov[e]) * mv[e]; }
    bf16* dstp;
    if (c0 < 2048) dstp = RM + (size_t)mrow * D + c0;
    else if (c0 < 4096) dstp = KM + (size_t)mrow * D + (c0 - 2048);
    else if (c0 < 6144) dstp = VM + (size_t)mrow * D + (c0 - 4096);
    else { const int lc = c0 - 6144; int dc;
        if (lc < 192) {
#pragma unroll
            for (int e = 0; e < 8; ++e) r[e] = tanhf_(r[e]);
            dc = (lc < 96) ? lc : 128 + (lc - 96); }
        else if (lc < 384) dc = (lc < 288) ? 256 + (lc - 192) : 384 + (lc - 288);
        else {
#pragma unroll
            for (int e = 0; e < 8; ++e) r[e] = sigmoidf_(r[e]);
            dc = 512 + (lc - 384); }
        dstp = LIN + (size_t)mrow * LINLD + dc; }
    v4u w; w.x = pk2(r[0], r[1]); w.y = pk2(r[2], r[3]); w.z = pk2(r[4], r[5]); w.w = pk2(r[6], r[7]); *(v4u*)dstp = w;
}
constexpr int P3_SLICE = 512, P3_NSLICE = (DSH + P3_SLICE - 1) / P3_SLICE  , P3_SLOTS = 96;
__device__ __forceinline__ void p3_prep(Frame& F, const Args& a) {
    const bf16* SLAB = (const bf16*)(F.ws + WS_SLAB); const float* mu = a.in[I_MU];
    bf16* RM = (bf16*)(F.ws + WS_RM); bf16* KM = (bf16*)(F.ws + WS_KM); bf16* VM = (bf16*)(F.ws + WS_VM); bf16* LIN = (bf16*)(F.ws + WS_LIN);
    LAS unsigned char* T = F.lds;
    const int w = F.wave, lane = F.lane;
    for (int pid = F.vcu; pid < NB * 64; pid += F.G) {
        const int b = pid >> 6, py = (pid >> 3) & 7, px = pid & 7; const int m00 = b * TSEQ + (py * 8) * 64 + px * 8;
        int srow[12];
#pragma unroll
        for (int i = 0; i < 12; ++i) { const int sl = w * 12 + i; int gyl, gxl; bool ok = true;
            if (sl < 64) { gyl = sl >> 3; gxl = sl & 7; } else if (sl < 72) { gyl = -1; gxl = sl - 64; ok = py > 0; } else if (sl < 80) { gyl = 8; gxl = sl - 72; ok = py < 7; }
            else if (sl < 88) { gyl = sl - 80; gxl = -1; ok = px > 0; } else { gyl = sl - 88; gxl = 8; ok = px < 7; }
            srow[i] = ok ? m00 + gyl * 64 + gxl : m00; }
        v4u pre[12];
        { const int cl = lane * 8;
#pragma unroll
          for (int i = 0; i < 12; ++i) pre[i] = *(const v4u*)(SLAB + (size_t)srow[i] * SLABLD + cl); }
        for (int sl_ = 0; sl_ < P3_NSLICE; ++sl_) {
            const int c0 = sl_ * P3_SLICE + lane * 8; const bool cok = c0 < DSH;
            __syncthreads();
#pragma unroll
            for (int i = 0; i < 12; ++i) *(LAS v4u*)(T + (w * 12 + i) * 1024 + lane * 16) = pre[i];
            if (sl_ + 1 < P3_NSLICE) { const int cn = (sl_ + 1) * P3_SLICE + lane * 8; const int cl = cn < DSH ? cn : 0;
#pragma unroll
                for (int i = 0; i < 12; ++i) pre[i] = *(const v4u*)(SLAB + (size_t)srow[i] * SLABLD + cl); }
            __syncthreads();
            const f32x4 m0 = *(const f32x4*)(mu + (cok ? c0 : 0)), m1 = *(const f32x4*)(mu + (cok ? c0 : 0) + 4);
            const int gy = py * 8 + w; const unsigned k2m = gy > 0 ? 0xffffu : 0u, k3m = gy < 63 ? 0xffff0000u : 0u;
#pragma unroll
            for (int x = 0; x < 8; ++x) {
                const int gx = px * 8 + x; const unsigned k0m = gx > 0 ? 0xffffu : 0u, k1m = gx < 63 ? 0xffff0000u : 0u;
                const int so = w * 8 + x, sL = x > 0 ? so - 1 : 80 + w, sR = x < 7 ? so + 1 : 88 + w, sU = w > 0 ? so - 8 : 64 + x, sD = w < 7 ? so + 8 : 72 + x;
                const v4u o = *(const LAS v4u*)(T + so * 1024 + lane * 16), n0 = *(const LAS v4u*)(T + sL * 1024 + lane * 16), n1 = *(const LAS v4u*)(T + sR * 1024 + lane * 16),
                          n2 = *(const LAS v4u*)(T + sU * 1024 + lane * 16), n3 = *(const LAS v4u*)(T + sD * 1024 + lane * 16);
                v4u nb; nb.x = (n0.x & k0m) | (n1.x & k1m); nb.y = (n2.y & k2m) | (n3.y & k3m); nb.z = (n0.z & k0m) | (n1.z & k1m); nb.w = (n2.w & k2m) | (n3.w & k3m);
                const int mrow = m00 + w * 64 + x;
                if (cok) p3_mix_store(o, nb, m0, m1, c0, mrow, RM, KM, VM, LIN);
                if (sl_ == P3_NSLICE - 1 && lane >= 48) { const int l16 = lane - 48, p = l16 >> 2, off = (l16 & 3) * 8; *(v4u*)(LIN + (size_t)mrow * LINLD + 128 * p + 96 + off) = (v4u){0u, 0u, 0u, 0u}; }
            }
        }
        __syncthreads();
    }
    const int gw = F.vcu * 8 + F.wave, NGW = F.G * 8;
    for (int mrow = NT + gw; mrow < MT; mrow += NGW) {
        const bf16* own = SLAB + (size_t)mrow * SLABLD; const int sidx = (mrow - NT) & 255; const bool v0 = sidx > 0, v1 = sidx < 255;
        const bf16* p0 = v0 ? own - SLABLD : own; const bf16* p1 = v1 ? own + SLABLD : own;
        const unsigned k0m = v0 ? 0xffffu : 0u, k1m = v1 ? 0xffff0000u : 0u;
        for (int ci0 = F.lane; ci0 < DSH / 8; ci0 += 256) {
            v4u o[4], nb[4]; f32x4 m0[4], m1[4];
#pragma unroll
            for (int u = 0; u < 4; ++u) { const int ci = ci0 + 64 * u; const int c0 = (ci < DSH / 8 ? ci : F.lane) * 8;
                o[u] = *(const v4u*)(own + c0); const v4u n0 = *(const v4u*)(p0 + c0), n1 = *(const v4u*)(p1 + c0);
                nb[u].x = (n0.x & k0m) | (n1.x & k1m); nb[u].y = (n0.y & k0m) | (n1.y & k1m); nb[u].z = (n0.z & k0m) | (n1.z & k1m); nb[u].w = (n0.w & k0m) | (n1.w & k1m);
                m0[u] = *(const f32x4*)(mu + c0); m1[u] = *(const f32x4*)(mu + c0 + 4); }
#pragma unroll
            for (int u = 0; u < 4; ++u) { const int ci = ci0 + 64 * u; if (ci < DSH / 8) p3_mix_store(o[u], nb[u], m0[u], m1[u], ci * 8, mrow, RM, KM, VM, LIN); }
        }
        if (F.lane < 16) { const int p = F.lane >> 2, off = (F.lane & 3) * 8; *(v4u*)(LIN + (size_t)mrow * LINLD + 128 * p + 96 + off) = (v4u){0u, 0u, 0u, 0u}; }
    }
    const unsigned* U32 = (const unsigned*)(F.ws + WS_U); unsigned* DP32 = (unsigned*)(F.ws + WS_DP);
    for (int gr = F.vcu; gr < 256; gr += F.G) {
        const int m0 = gr * 64, cp = F.tid; const int g = F.wave >> 1;
        if (g == 0) pool_item<2>(U32, DP32, m0, cp); else if (g == 1) pool_item<4>(U32, DP32, m0, cp); else if (g == 2) pool_item<8>(U32, DP32, m0, cp); else pool_item<16>(U32, DP32, m0, cp);
    }
}

constexpr int CK = 16, NSL = 8;
constexpr int SL_Z = 0, SL_AF = 2560, SL_TMT = 3584, SL_ABF = 4096, SL_TM = 4608, SL_ZTT = 5120, SL_RT = 7680, SL_CRT = 9728, SL_ART = 10240, SL_BGT = 10752, SL_KGT = 12800, SL_VT = 14848, SL_GC = 16896,
              SL_SIZE = 17152, ZTT_LD = 80, SB_OFF = 7 * SL_SIZE  , SL7_OFF = 132096  ;
static_assert(SB_OFF + 8192 <= 131072 && SL7_OFF + SL_SIZE <= 163840, "scan LDS map");
__device__ __forceinline__ int kpos(int zt, int q) { return 32 * (zt >> 1) + 8 * q + 4 * (zt & 1); }
__device__ __forceinline__ int slot_off(int n) { return n < 7 ? n * SL_SIZE : SL7_OFF; }
__device__ __forceinline__ int sw64(int row, int col) { return (row * 64 + ((((col >> 3) ^ (row & 7)) << 3) | (col & 7))) * 2; }
__device__ __forceinline__ int scan_row(int n, int b, int dir) {
    if (n < CTXL) return NT + b * CTXL + (dir ? (CTXL - 1 - n) : n);
    const int t = n - CTXL; return b * TSEQ + (dir ? (TSEQ - 1 - t) : t);
}
__device__ __forceinline__ bf16x8 frag_ld(const LAS unsigned char* p, bool ok) { v4u z = (v4u){0u, 0u, 0u, 0u}; if (ok) z = *(const LAS v4u*)p; return __builtin_bit_cast(bf16x8, z); }
__device__ __forceinline__ f32x4 mfma16(bf16x8 a, bf16x8 b, f32x4 c) { return __builtin_amdgcn_mfma_f32_16x16x32_bf16(a, b, c, 0, 0, 0); }
__device__ __forceinline__ float dpp_shr(float v, const int n, float fill) {
    const int x = __builtin_bit_cast(int, v), f = __builtin_bit_cast(int, fill); int r;
    if (n == 1) r = __builtin_amdgcn_update_dpp(f, x, 0x111, 0xF, 0xF, false); else if (n == 2) r = __builtin_amdgcn_update_dpp(f, x, 0x112, 0xF, 0xF, false);
    else if (n == 4) r = __builtin_amdgcn_update_dpp(f, x, 0x114, 0xF, 0xF, false); else r = __builtin_amdgcn_update_dpp(f, x, 0x118, 0xF, 0xF, false);
    return __builtin_bit_cast(float, r);
}
struct SeqOps { bf16x8 fV, fZc, fZk[2], fR[2], fCr, fAr4, fKG[4], fBG4[4]; f32x4 gc[4]; };
__device__ __forceinline__ bf16x8 frag4_ld(const LAS unsigned char* p) { const v2u t = *(const LAS v2u*)p; v4u z; z.x = t.x; z.y = t.y; z.z = 0u; z.w = 0u; return __builtin_bit_cast(bf16x8, z); }
__device__ __forceinline__ void seq_load(SeqOps& o, const LAS unsigned char* SL, int w, int c, int q, bool klo) {
    o.fV = frag_ld(SL + SL_VT + ((16 * w + c) * 16 + 8 * q) * 2, klo);
    o.fZc = frag_ld(SL + SL_ZTT + (c * ZTT_LD + 64 + 8 * q) * 2, klo); o.fCr = frag_ld(SL + SL_CRT + (c * 16 + 8 * q) * 2, klo); o.fAr4 = frag4_ld(SL + SL_ART + (c * 16 + 4 * q) * 2);
#pragma unroll
    for (int ks = 0; ks < 2; ++ks) { o.fZk[ks] = frag_ld(SL + SL_ZTT + (c * ZTT_LD + 32 * ks + 8 * q) * 2, true); o.fR[ks] = frag_ld(SL + SL_RT + sw64(c, 32 * ks + 8 * q), true); }
#pragma unroll
    for (int jt = 0; jt < 4; ++jt) { o.fKG[jt] = frag_ld(SL + SL_KGT + ((16 * jt + c) * 16 + 8 * q) * 2, klo); o.fBG4[jt] = frag4_ld(SL + SL_BGT + ((16 * jt + c) * 16 + 4 * q) * 2);
        o.gc[jt] = *(const LAS f32x4*)(SL + SL_GC + (16 * jt + 4 * q) * 4); }
}
__device__ __forceinline__ void seq_step(const SeqOps& o, f32x4 (&X)[4], bool emit, bf16* YO, int chunk, int b, int dir, int h, int w, int c, int q) {
    const f32x4 z4 = (f32x4){0.f, 0.f, 0.f, 0.f};
    bf16x8 fS[2];
#pragma unroll
    for (int ks = 0; ks < 2; ++ks) { v4u p; p.x = pk2(X[2 * ks][0], X[2 * ks][1]); p.y = pk2(X[2 * ks][2], X[2 * ks][3]); p.z = pk2(X[2 * ks + 1][0], X[2 * ks + 1][1]); p.w = pk2(X[2 * ks + 1][2], X[2 * ks + 1][3]);
        fS[ks] = __builtin_bit_cast(bf16x8, p); }
    f32x4 un = mfma16(o.fZc, o.fV, z4);
#pragma unroll
    for (int ks = 0; ks < 2; ++ks) un = mfma16(o.fZk[ks], fS[ks], un);
    bf16x8 fU; { v4u p; p.x = pk2(un[0], un[1]); p.y = pk2(un[2], un[3]); p.z = 0u; p.w = 0u; fU = __builtin_bit_cast(bf16x8, p); }
    if (emit) {
        f32x4 y = mfma16(o.fCr, o.fV, z4); y = mfma16(o.fAr4, fU, y);
#pragma unroll
        for (int ks = 0; ks < 2; ++ks) y = mfma16(o.fR[ks], fS[ks], y);
#pragma unroll
        for (int g = 0; g < 4; ++g) YO[(size_t)scan_row(chunk * CK + 4 * q + g, b, dir) * D + h * 64 + 16 * w + c] = (bf16)f2bf(y[g]);
    }
#pragma unroll
    for (int jt = 0; jt < 4; ++jt) { const f32x4 d = mfma16(o.fBG4[jt], fU, mfma16(o.fKG[jt], o.fV, z4));
        X[jt] = X[jt] * o.gc[jt] + d; }
}
struct ScanRaw { v4u r[2], k[2], v[2], e[2]; v2u a[2]; };
__device__ __forceinline__ void scan_fetch(ScanRaw& R, const bf16* RM, const bf16* KM, const bf16* VM, const unsigned char* AX, const unsigned short* EX, size_t rowoff) {
#pragma unroll
    for (int ks = 0; ks < 2; ++ks) { const size_t off = rowoff + 32 * ks; R.r[ks] = *(const v4u*)(RM + off); R.k[ks] = *(const v4u*)(KM + off); R.v[ks] = *(const v4u*)(VM + off); R.a[ks] = *(const v2u*)(AX + off); R.e[ks] = *(const v4u*)(EX + off); }
}
__device__ __forceinline__ void p6_scan(Frame& F, const Args& a) {
    const bf16* RM = (const bf16*)(F.ws + WS_RM); const bf16* KM = (const bf16*)(F.ws + WS_KM); const bf16* VM = (const bf16*)(F.ws + WS_VM);
    const int lane = F.lane, w = F.wave, c0_ = lane & 15, q0_ = lane >> 4;
    for (int unit = blockIdx.x; unit < NB * NH * 2; unit += F.G) {
        const int dir = unit & 1, h = (unit >> 1) & 31, b = unit >> 6;
        const unsigned short* EX = (const unsigned short*)(F.ws + WS_EA + (size_t)dir * EA_STRIDE);
        const unsigned char* AX = (const unsigned char*)(F.ws + WS_EA + (size_t)(2 + dir) * EA_STRIDE);
        bf16* YO = (bf16*)(F.ws + (dir ? WS_YB : WS_YF)); float* BON = (float*)(F.ws + WS_BON) + (size_t)dir * NT * NH;
        f32x4 X[4];
#pragma unroll
        for (int jt = 0; jt < 4; ++jt) X[jt] = (f32x4){0.f, 0.f, 0.f, 0.f};
        constexpr int NBATCH = (CTXL + TSEQ) / CK / NSL;
        { LAS float* cst = (LAS float*)(F.lds + SB_OFF);
          if (F.tid < 192) { const int which = F.tid >> 6, j = F.tid & 63; cst[F.tid] = (which == 0 ? a.in[I_KK] : which == 1 ? a.in[I_KA] : a.in[I_RK])[h * 64 + j]; } }
        ScanRaw R; scan_fetch(R, RM, KM, VM, AX, EX, (size_t)scan_row(w * CK + c0_, b, dir) * D + h * 64 + 8 * q0_);
        __syncthreads();
        for (int bt = 0; bt < NBATCH; ++bt) {
            int c = c0_, q = q0_; asm volatile("" : "+v"(c), "+v"(q));
            const bool klo = q < 2;
            {
                LAS unsigned char* SL = F.lds + slot_off(w);
                int cq8 = 8 * q; asm volatile("" : "+v"(cq8));
                const LAS float* cst = (const LAS float*)(F.lds + SB_OFF) + cq8;
                float ss = 0.f;
#pragma unroll
                for (int ks = 0; ks < 2; ++ks) {
                    const f32x4 k0 = *(const LAS f32x4*)(cst + 32 * ks), k1 = *(const LAS f32x4*)(cst + 32 * ks + 4);
                    const float kv[8] = {bflo(R.k[ks].x), bfhi(R.k[ks].x), bflo(R.k[ks].y), bfhi(R.k[ks].y), bflo(R.k[ks].z), bfhi(R.k[ks].z), bflo(R.k[ks].w), bfhi(R.k[ks].w)};
#pragma unroll
                    for (int e = 0; e < 4; ++e) { const float p0 = kv[e] * k0[e], p1 = kv[4 + e] * k1[e]; ss += p0 * p0 + p1 * p1; } }
                ss += __shfl_xor(ss, 16); ss += __shfl_xor(ss, 32);
                const float inv = __builtin_amdgcn_rsqf(ss + 1e-12f);
                bf16x8 fKT[2], fRT[2], fBT[2], fKQ[2]; float bonp = 0.f;
#pragma unroll
                for (int ks = 0; ks < 2; ++ks) {
                    const v4u xr = R.r[ks], xk = R.k[ks], xv = R.v[ks], xe = R.e[ks]; const v2u xa = R.a[ks];
                    const f32x4 k0 = *(const LAS f32x4*)(cst + 32 * ks), k1 = *(const LAS f32x4*)(cst + 32 * ks + 4), a0 = *(const LAS f32x4*)(cst + 64 + 32 * ks), a1 = *(const LAS f32x4*)(cst + 64 + 32 * ks + 4);
                    const float kkw[8] = {k0[0], k0[1], k0[2], k0[3], k1[0], k1[1], k1[2], k1[3]}, kaw[8] = {a0[0], a0[1], a0[2], a0[3], a1[0], a1[1], a1[2], a1[3]};
                    const f32x4 q0 = *(const LAS f32x4*)(cst + 128 + 32 * ks), q1 = *(const LAS f32x4*)(cst + 128 + 32 * ks + 4); const float rkw[8] = {q0[0], q0[1], q0[2], q0[3], q1[0], q1[1], q1[2], q1[3]};
                    const float r[8] = {bflo(xr.x), bfhi(xr.x), bflo(xr.y), bfhi(xr.y), bflo(xr.z), bfhi(xr.z), bflo(xr.w), bfhi(xr.w)};
                    const float k[8] = {bflo(xk.x), bfhi(xk.x), bflo(xk.y), bfhi(xk.y), bflo(xk.z), bfhi(xk.z), bflo(xk.w), bfhi(xk.w)};
                    const float v[8] = {bflo(xv.x), bfhi(xv.x), bflo(xv.y), bfhi(xv.y), bflo(xv.z), bfhi(xv.z), bflo(xv.w), bfhi(xv.w)};
                    const float ku8 = 1.0f / 255.0f;
                    const float ai[8] = {(float)(xa.x & 0xffu) * ku8, (float)((xa.x >> 8) & 0xffu) * ku8, (float)((xa.x >> 16) & 0xffu) * ku8, (float)(xa.x >> 24) * ku8,
                                         (float)(xa.y & 0xffu) * ku8, (float)((xa.y >> 8) & 0xffu) * ku8, (float)((xa.y >> 16) & 0xffu) * ku8, (float)(xa.y >> 24) * ku8};
                    const float lw[8] = {hlo(xe.x), hhi(xe.x), hlo(xe.y), hhi(xe.y), hlo(xe.z), hhi(xe.z), hlo(xe.w), hhi(xe.w)};
                    float kt[8], rt[8], btl[8], kq[8], cl[8], G[8], Gi[8], Gm[8], GCv[8];
#pragma unroll
                    for (int e = 0; e < 8; ++e) cl[e] = lw[e];
#pragma unroll
                    for (int e = 0; e < 8; ++e) cl[e] += dpp_shr(cl[e], 1, 0.f);
#pragma unroll
                    for (int e = 0; e < 8; ++e) cl[e] += dpp_shr(cl[e], 2, 0.f);
#pragma unroll
                    for (int e = 0; e < 8; ++e) cl[e] += dpp_shr(cl[e], 4, 0.f);
#pragma unroll
                    for (int e = 0; e < 8; ++e) cl[e] += dpp_shr(cl[e], 8, 0.f);
#pragma unroll
                    for (int e = 0; e < 8; ++e) { G[e] = __builtin_amdgcn_exp2f(cl[e]); Gi[e] = __builtin_amdgcn_exp2f(-cl[e]); }
#pragma unroll
                    for (int e = 0; e < 8; ++e) { Gm[e] = dpp_shr(G[e], 1, 1.0f); GCv[e] = __shfl(G[e], (lane & 48) | 15); }
#pragma unroll
                    for (int e = 0; e < 8; ++e) {
                        const float kke = k[e] * kkw[e] * inv, kd = k[e] * ((ai[e] - 1.0f) * kaw[e] + 1.0f), bb = kke * ai[e], ratio = GCv[e] * Gi[e];
                        kt[e] = Gm[e] * kke; rt[e] = G[e] * r[e]; btl[e] = bb * Gi[e]; kq[e] = kd * Gi[e];
                        bonp += r[e] * kd * rkw[e];
                        const int j = 32 * ks + 8 * q + e;
                        const unsigned w0 = pk2(kt[e], bb * ratio), w1 = pk2(kd * ratio, v[e]);
                        ((LAS bf16*)(SL + SL_Z))[j * 16 + c] = (bf16)(w0 & 0xffffu); ((LAS bf16*)(SL + SL_BGT))[j * 16 + c] = (bf16)(w0 >> 16);
                        ((LAS bf16*)(SL + SL_KGT))[j * 16 + c] = (bf16)(w1 & 0xffffu); ((LAS bf16*)(SL + SL_VT))[j * 16 + c] = (bf16)(w1 >> 16);
                    }
                    if (c == 15) { *(LAS f32x4*)(SL + SL_GC + (32 * ks + 8 * q) * 4) = (f32x4){G[0], G[1], G[2], G[3]}; *(LAS f32x4*)(SL + SL_GC + (32 * ks + 8 * q + 4) * 4) = (f32x4){G[4], G[5], G[6], G[7]}; }
                    v4u p; p.x = pk2(kt[0], kt[1]); p.y = pk2(kt[2], kt[3]); p.z = pk2(kt[4], kt[5]); p.w = pk2(kt[6], kt[7]); fKT[ks] = __builtin_bit_cast(bf16x8, p);
                    p.x = pk2(rt[0], rt[1]); p.y = pk2(rt[2], rt[3]); p.z = pk2(rt[4], rt[5]); p.w = pk2(rt[6], rt[7]); fRT[ks] = __builtin_bit_cast(bf16x8, p);
                    { v2u p0; p0.x = p.x; p0.y = p.y; v2u p1; p1.x = p.z; p1.y = p.w; const int pp = 32 * ks + 16 * (q & 1) + 4 * (q >> 1);
                      *(LAS v2u*)(SL + SL_RT + sw64(c, pp)) = p0; *(LAS v2u*)(SL + SL_RT + sw64(c, pp + 8)) = p1; }
                    p.x = pk2(btl[0], btl[1]); p.y = pk2(btl[2], btl[3]); p.z = pk2(btl[4], btl[5]); p.w = pk2(btl[6], btl[7]); fBT[ks] = __builtin_bit_cast(bf16x8, p);
                    p.x = pk2(kq[0], kq[1]); p.y = pk2(kq[2], kq[3]); p.z = pk2(kq[4], kq[5]); p.w = pk2(kq[6], kq[7]); fKQ[ks] = __builtin_bit_cast(bf16x8, p);
                    asm volatile("" ::: "memory");
                }
                bonp += __shfl_xor(bonp, 16); bonp += __shfl_xor(bonp, 32);
                if (q == 0 && (NSL * bt + w) * CK >= CTXL) BON[(size_t)scan_row((NSL * bt + w) * CK + c, b, dir) * NH + h] = bonp;
                const f32x4 z4 = (f32x4){0.f, 0.f, 0.f, 0.f};
                f32x4 accA = mfma16(fBT[1], fKT[1], mfma16(fBT[0], fKT[0], z4)), accAr = mfma16(fBT[1], fRT[1], mfma16(fBT[0], fRT[0], z4));
                f32x4 accCm = mfma16(fKQ[1], fKT[1], mfma16(fKQ[0], fKT[0], z4)), accCr = mfma16(fKQ[1], fRT[1], mfma16(fKQ[0], fRT[0], z4));
#pragma unroll
                for (int g = 0; g < 4; ++g) { const int srow = 4 * q + g; const bool lt = srow < c, le = srow <= c;
                    accA[g] = lt ? accA[g] : 0.f; accAr[g] = le ? accAr[g] : 0.f; accCm[g] = lt ? accCm[g] : 0.f; accCr[g] = le ? accCr[g] : 0.f;
                    ((LAS float*)(SL + SL_AF))[srow * 16 + c] = accA[g]; ((LAS bf16*)(SL + SL_ABF))[srow * 16 + c] = (bf16)f2bf(accA[g]); ((LAS bf16*)(SL + SL_Z))[(64 + srow) * 16 + c] = (bf16)f2bf(accCm[g]); }
                { v2u p; p.x = pk2(accAr[0], accAr[1]); p.y = pk2(accAr[2], accAr[3]); *(LAS v2u*)(SL + SL_ART + (c * 16 + 4 * q) * 2) = p; }
                { v2u p; p.x = pk2(accCr[0], accCr[1]); p.y = pk2(accCr[2], accCr[3]); *(LAS v2u*)(SL + SL_CRT + (c * 16 + 4 * q) * 2) = p; }
                LDS_WAIT(); asm volatile("" ::: "memory");
                {
                    const int base = c & 8, cl = c & 7; float x[8];
#pragma unroll
                    for (int sr = 7; sr >= 0; --sr) { float acc = 0.f;
#pragma unroll
                        for (int m = sr + 1; m < 8; ++m) acc += ((const LAS float*)(SL + SL_AF))[(base + sr) * 16 + base + m] * x[m];
                        x[sr] = (sr < cl) ? -acc : ((sr == cl) ? -1.0f : 0.f); }
                    if (q == 0) { v4u px; px.x = pk2(x[0], x[1]); px.y = pk2(x[2], x[3]); px.z = pk2(x[4], x[5]); px.w = pk2(x[6], x[7]);
                        *(LAS v4u*)(SL + SL_TMT + (c * 16 + base) * 2) = px; *(LAS v4u*)(SL + SL_TMT + (c * 16 + (base ^ 8)) * 2) = (v4u){0u, 0u, 0u, 0u};
#pragma unroll
                        for (int sr = 0; sr < 8; ++sr) { ((LAS bf16*)(SL + SL_TM))[(base + sr) * 16 + c] = (bf16)f2bf(x[sr]); ((LAS bf16*)(SL + SL_TM))[((base ^ 8) + sr) * 16 + c] = (bf16)0; } }
                    LDS_WAIT(); asm volatile("" ::: "memory");
                    const bf16x8 fAb = frag_ld(SL + SL_ABF + (c * 16 + 8 * q) * 2, klo), fTd = frag_ld(SL + SL_TMT + (c * 16 + 8 * q) * 2, klo);
                    const f32x4 d1 = mfma16(fAb, fTd, z4);
                    bf16x8 fD1; { v4u p; p.x = pk2(d1[0], d1[1]); p.y = pk2(d1[2], d1[3]); p.z = 0u; p.w = 0u; fD1 = __builtin_bit_cast(bf16x8, p); }
                    const f32x4 d2 = mfma16(fD1, frag4_ld(SL + SL_TM + (c * 16 + 4 * q) * 2), z4);
                    if (c < 8 && q >= 2) {
#pragma unroll
                        for (int g = 0; g < 4; ++g) ((LAS bf16*)(SL + SL_TMT))[(4 * q + g) * 16 + c] = (bf16)f2bf(d2[g]); }
                }
                LDS_WAIT(); asm volatile("" ::: "memory");
                {
                    const bf16x8 fT = frag_ld(SL + SL_TMT + (c * 16 + 8 * q) * 2, klo);
#pragma unroll
                    for (int zt = 0; zt < 5; ++zt) { const bf16x8 fZ = frag_ld(SL + SL_Z + ((16 * zt + c) * 16 + 8 * q) * 2, klo); const f32x4 d = mfma16(fZ, fT, z4);
                        v2u p; p.x = pk2(d[0], d[1]); p.y = pk2(d[2], d[3]); *(LAS v2u*)(SL + SL_ZTT + (c * ZTT_LD + (zt < 4 ? kpos(zt, q) : 64 + 4 * q)) * 2) = p; }
                }
            }
            if (bt + 1 < NBATCH) scan_fetch(R, RM, KM, VM, AX, EX, (size_t)scan_row((NSL * (bt + 1) + w) * CK + c, b, dir) * D + h * 64 + 8 * q);
            __syncthreads();
            asm volatile("" : "+v"(c), "+v"(q));
            if (w < 4) {
                const bool emit = (NSL * bt) * CK >= CTXL;
#pragma unroll 1
                for (int n = 0; n < NSL; ++n) { SeqOps A; seq_load(A, F.lds + slot_off(n), w, c, q, klo); seq_step(A, X, emit, YO, NSL * bt + n, b, dir, h, w, c, q); }
            }
            __syncthreads();
        }
    }
}

__device__ __forceinline__ void p7_readout(Frame& F, const Args& a) {
    const bf16* VM = (const bf16*)(F.ws + WS_VM); const float* BONF = (const float*)(F.ws + WS_BON); const float* BONB = BONF + (size_t)NT * NH;
    const bf16* YF = (const bf16*)(F.ws + WS_YF); const bf16* YB = (const bf16*)(F.ws + WS_YB); bf16* Z = (bf16*)(F.ws + WS_Z);
    const int sub = F.tid & 15; const int ngrp = F.G * 32;
    for (int gid0 = F.vcu * 32 + (F.tid >> 4); gid0 < NT * NH; gid0 += 4 * ngrp) {
        v2u ayf[4], ayb[4], alv[4]; float abf[4], abb[4]; f32x4 alw[4], alb[4];
#pragma unroll
        for (int u = 0; u < 4; ++u) { const int gid = gid0 + u * ngrp; const int mrow = gid >> 5, h = gid & 31, c = h * 64 + 4 * sub; const size_t off = (size_t)mrow * D + c;
            ayf[u] = *(const v2u*)(YF + off); ayb[u] = *(const v2u*)(YB + off); alv[u] = *(const v2u*)(VM + off); abf[u] = BONF[gid]; abb[u] = BONB[gid]; alw[u] = *(const f32x4*)(a.in[I_LNW] + c); alb[u] = *(const f32x4*)(a.in[I_LNB] + c); }
#pragma unroll
        for (int u = 0; u < 4; ++u) { const int gid = gid0 + u * ngrp;
        const int mrow = gid >> 5, h = gid & 31, c = h * 64 + 4 * sub; const size_t off = (size_t)mrow * D + c;
        const v2u yf = ayf[u], yb = ayb[u], lv = alv[u];
        const f32x4 y = (f32x4){bflo(yf.x) + bflo(yb.x), bfhi(yf.x) + bfhi(yb.x), bflo(yf.y) + bflo(yb.y), bfhi(yf.y) + bfhi(yb.y)};
        const float mean = allred16((y.x + y.y) + (y.z + y.w)) * (1.0f / 64.0f); const f32x4 d = y - mean;
        const float var = allred16((d.x * d.x + d.y * d.y) + (d.z * d.z + d.w * d.w)) * (1.0f / 64.0f);
        const f32x4 yn = d * __builtin_amdgcn_rsqf(var + 64e-5f) * alw[u] + alb[u];
        const f32x4 v = (f32x4){bflo(lv.x), bfhi(lv.x), bflo(lv.y), bfhi(lv.y)};
        const f32x4 z = yn + v * (abf[u] + abb[u]); v2u wv; wv.x = pk2(z.x, z.y); wv.y = pk2(z.z, z.w); *(v2u*)(Z + off) = wv;
        }
    }
}
constexpr float GU_F8SCALE = 8.0f, H2_F8SCALE = 8.0f, DT_F8SCALE = 8.0f;
constexpr int CONV_ITEMS = 65 * 768, CONV_DT = 65 * 256, CONV_FREE = CONV_DT + (65 - GU_E2) * 512;
struct DecExp { const float* const* in; unsigned char* ws;
    __device__ __forceinline__ bool operator()(int it, TrJob& j) const {
        if (it < 0 || it >= CONV_ITEMS) return false;
        if (it < CONV_DT) { const int e = it >> 8, r = it & 255; const float* src = (e < 64) ? in[I_ED] + (size_t)e * DEXP * D : in[I_SD];
            const int kb = r >> 5, nb = r & 31; j = TrJob{src, (bf16*)(ws + WS_DT + (size_t)e * D * DEXP), D, DEXP, DEXP, kb * 64, nb * 64, nb * 64, DT_F8SCALE}; }
        else { const int g = it - CONV_DT, eg = g >> 9, q = g & 511, which = q >> 8, r = q & 255, e = eg < 65 - GU_E2 ? GU_E2 + eg : eg - (65 - GU_E2);
            const float* src = (e < 64) ? (which == 0 ? in[I_EG] : in[I_EU]) + (size_t)e * D * DEXP : (which == 0 ? in[I_SG] : in[I_SU]);
            const int kb = r >> 3, nb = r & 7, n0 = nb * 64;
            j = TrJob{src, (bf16*)(ws + gu_base(e)), DEXP, D, D, kb * 64, n0, (n0 >> 7) * 256 + which * 128 + (n0 & 127), GU_F8SCALE}; }
        return true; } };
__device__ __forceinline__ void conv_steal(Frame& F, const Args& a, const unsigned stopn) {
    DecExp dec{a.in, F.ws};
    unsigned* cnt = F.ctl + CW_CONV; unsigned* dnp = F.ctl + CW_P2DONE;
    LAS unsigned* P = (LAS unsigned*)(F.lds + F.wave * 16384);
    const int lane = F.lane;
    unsigned nxt = 0u, dnow = 0u;
    if (lane == 0) nxt = xb_add(cnt, 1u);
    nxt = __builtin_amdgcn_readfirstlane(nxt);
#pragma unroll 1
    for (;;) {
        const unsigned cur = nxt;
        if (cur >= (unsigned)CONV_FREE) break;
        unsigned n2 = (unsigned)CONV_FREE, d2 = dnow;
        if (dnow < stopn) { if (lane == 0) { n2 = xb_add(cnt, 1u); d2 = xb_ld(dnp); } }
        asm volatile("" ::: "memory");
        TrJob ja; f32x4 va[16];
        dec((int)cur, ja); tr_ld<true>(ja, va, lane);
        tr_st<true>(ja, va, P, lane);
        nxt = __builtin_amdgcn_readfirstlane(n2); dnow = __builtin_amdgcn_readfirstlane(d2);
    }
}
constexpr int RT_LD = 68;
__device__ __forceinline__ void p11_route(Frame& F, const Args& a) {
    for (int repa_ = 0, nrepa_ = opaque_n(1 + ((DUPMASK >> 16) & 1)); repa_ < nrepa_; ++repa_) {
        unsigned nd = xb_ld(F.ctl + CW_CONV); nd = __builtin_amdgcn_readfirstlane(nd < (unsigned)CONV_FREE ? nd : (unsigned)CONV_FREE);
        DecExp dec{a.in, F.ws};
        tr_run(dec, (int)nd + F.vcu * 8 + F.wave, F.G * 8, (LAS unsigned*)(F.lds + F.wave * 16384), F.lane);
        __syncthreads();
    }
    const bf16* X1 = (const bf16*)(F.ws + WS_X1); const float* MOD = (const float*)(F.ws + WS_MOD); unsigned char* H2 = F.ws + WS_H2;
    LAS float* hs = (LAS float*)F.lds;
    LAS float* wsb = hs + 64 * RT_LD;
    LAS float* lg = wsb + 64 * RT_LD;
    LAS float* lg2 = lg + 64 * 65;
    LAS float* selb = lg2 + 64 * 65;
    LAS float* rs = selb + 64 * 65;
    LAS int* cnt = (LAS int*)(rs + 64);
    LAS int* basee = cnt + 64;
    LAS int* eloc = basee + 64;
    LAS int* rloc = eloc + 512;
    for (int tile = F.vcu; tile < NT / 64; tile += F.G) {
        const int t0 = tile * 64, b = t0 >> 12;
        const float* sh2 = MOD + (size_t)b * 12288 + 6144; const float* sc2 = MOD + (size_t)b * 12288 + 8192; const float* g2 = a.in[I_N2G];
        if (F.tid < 64) cnt[F.tid] = 0;
        for (int rr = 0; rr < 8; ++rr) { const int tl = F.wave * 8 + rr; const v2u* xr = (const v2u*)(X1 + (size_t)(t0 + tl) * D) + F.lane; f32x4 v[8]; float s = 0.f;
#pragma unroll
            for (int q = 0; q < 8; ++q) { const v2u xw = xr[64 * q]; v[q] = (f32x4){bflo(xw.x), bfhi(xw.x), bflo(xw.y), bfhi(xw.y)}; s += (v[q].x * v[q].x + v[q].y * v[q].y) + (v[q].z * v[q].z + v[q].w * v[q].w); }
            const float rstd = 1.0f / sqrtf(wave_sum(s) * (1.0f / D) + 1e-6f); if (F.lane == 0) rs[tl] = rstd;
            unsigned* o = (unsigned*)(H2 + (size_t)(t0 + tl) * D) + F.lane;
#pragma unroll
            for (int q = 0; q < 8; ++q) { const f32x4 y = v[q] * rstd * ((const f32x4*)g2)[F.lane + 64 * q] * (((const f32x4*)sc2)[F.lane + 64 * q] + 1.0f) + ((const f32x4*)sh2)[F.lane + 64 * q];
                o[64 * q] = pk8(H2_F8SCALE * y.x, H2_F8SCALE * y.y, H2_F8SCALE * y.z, H2_F8SCALE * y.w); } }
        __syncthreads();
        const int tg = F.tid & 15, eg = (F.tid >> 4) & 15, kh = F.tid >> 8;
        float acc[4][4];
#pragma unroll
        for (int i = 0; i < 4; ++i)
#pragma unroll
            for (int j = 0; j < 4; ++j) acc[i][j] = 0.f;
        const int stok = F.tid >> 3, sk8 = (F.tid & 7) * 8; const float rstd_s = rs[stok];
        f32x4 px0, px1, pw0, pw1;
        { const v4u xw = *(const v4u*)(X1 + (size_t)(t0 + stok) * D + sk8); px0 = (f32x4){bflo(xw.x), bfhi(xw.x), bflo(xw.y), bfhi(xw.y)}; px1 = (f32x4){bflo(xw.z), bfhi(xw.z), bflo(xw.w), bfhi(xw.w)}; const float* wp = a.in[I_RW] + F.tid * 8; pw0 = *(const f32x4*)wp; pw1 = *(const f32x4*)(wp + 4); }
        for (int kc = 0; kc < D / 64; ++kc) {
            { const int k0 = kc * 64 + sk8;
              const f32x4 ga = *(const f32x4*)(g2 + k0), gb = *(const f32x4*)(g2 + k0 + 4), ca = *(const f32x4*)(sc2 + k0), cb = *(const f32x4*)(sc2 + k0 + 4), ha = *(const f32x4*)(sh2 + k0), hb = *(const f32x4*)(sh2 + k0 + 4);
              const f32x4 y0 = px0 * rstd_s * ga * (ca + 1.0f) + ha, y1 = px1 * rstd_s * gb * (cb + 1.0f) + hb;
              hs[(sk8 + 0) * RT_LD + stok] = y0.x; hs[(sk8 + 1) * RT_LD + stok] = y0.y; hs[(sk8 + 2) * RT_LD + stok] = y0.z; hs[(sk8 + 3) * RT_LD + stok] = y0.w;
              hs[(sk8 + 4) * RT_LD + stok] = y1.x; hs[(sk8 + 5) * RT_LD + stok] = y1.y; hs[(sk8 + 6) * RT_LD + stok] = y1.z; hs[(sk8 + 7) * RT_LD + stok] = y1.w;
              const int wk = F.tid >> 3, we = (F.tid & 7) * 8; *(LAS f32x4*)(wsb + wk * RT_LD + we) = pw0; *(LAS f32x4*)(wsb + wk * RT_LD + we + 4) = pw1; }
            __syncthreads();
            if (kc + 1 < D / 64) { const v4u xw = *(const v4u*)(X1 + (size_t)(t0 + stok) * D + (kc + 1) * 64 + sk8); px0 = (f32x4){bflo(xw.x), bfhi(xw.x), bflo(xw.y), bfhi(xw.y)}; px1 = (f32x4){bflo(xw.z), bfhi(xw.z), bflo(xw.w), bfhi(xw.w)};
                const float* wp = a.in[I_RW] + (size_t)(kc + 1) * 4096 + F.tid * 8; pw0 = *(const f32x4*)wp; pw1 = *(const f32x4*)(wp + 4); }
#pragma unroll 8
            for (int k = kh * 32; k < kh * 32 + 32; ++k) { const f32x4 h4 = *(const LAS f32x4*)(hs + k * RT_LD + 4 * tg), w4 = *(const LAS f32x4*)(wsb + k * RT_LD + 4 * eg);
                acc[0][0] += h4.x * w4.x; acc[0][1] += h4.x * w4.y; acc[0][2] += h4.x * w4.z; acc[0][3] += h4.x * w4.w;
                acc[1][0] += h4.y * w4.x; acc[1][1] += h4.y * w4.y; acc[1][2] += h4.y * w4.z; acc[1][3] += h4.y * w4.w;
                acc[2][0] += h4.z * w4.x; acc[2][1] += h4.z * w4.y; acc[2][2] += h4.z * w4.z; acc[2][3] += h4.z * w4.w;
                acc[3][0] += h4.w * w4.x; acc[3][1] += h4.w * w4.y; acc[3][2] += h4.w * w4.z; acc[3][3] += h4.w * w4.w; }
            __syncthreads();
        }
        { LAS float* dstl = kh ? lg2 : lg;
#pragma unroll
          for (int i = 0; i < 4; ++i)
#pragma unroll
              for (int j = 0; j < 4; ++j) dstl[(4 * tg + i) * 65 + 4 * eg + j] = acc[i][j]; }
        __syncthreads();
        for (int idx = F.tid; idx < 4096; idx += 512) { const int tl = idx >> 6, e = idx & 63; const float sc = sigmoidf_(lg[tl * 65 + e] + lg2[tl * 65 + e]); lg[tl * 65 + e] = sc; selb[tl * 65 + e] = sc + a.in[I_RB][e]; }
        __syncthreads();
        if (F.tid < 64) {
            const int tl = F.tid; LAS float* sel = selb + tl * 65; const LAS float* scr = lg + tl * 65;
            float gs[8];
#pragma unroll
            for (int g = 0; g < 8; ++g) { float m1 = -INFINITY, m2 = -INFINITY;
#pragma unroll
                for (int j = 0; j < 8; ++j) { const float v = sel[g * 8 + j]; if (v > m1) { m2 = m1; m1 = v; } else if (v > m2) m2 = v; }
                gs[g] = m1 + m2; }
            unsigned gmask = 0u;
#pragma unroll
            for (int it = 0; it < 4; ++it) { float best = -INFINITY; int bi = 0;
#pragma unroll
                for (int g = 0; g < 8; ++g) { const bool ok = !((gmask >> g) & 1u) && gs[g] > best; best = ok ? gs[g] : best; bi = ok ? g : bi; }
                gmask |= 1u << bi; }
            for (int g = 0; g < 8; ++g) if (!((gmask >> g) & 1u)) { for (int j = 0; j < 8; ++j) sel[g * 8 + j] = -INFINITY; }
            float wv[8]; int ev[8]; float wsum = 0.f;
#pragma unroll
            for (int it = 0; it < 8; ++it) { float best = -INFINITY; int bi = 0;
                for (int e = 0; e < 64; ++e) { const float v = sel[e]; if (v > best) { best = v; bi = e; } }
                sel[bi] = -INFINITY; ev[it] = bi; wv[it] = scr[bi]; wsum += wv[it]; }
            const float inv = 2.5f / wsum;
#pragma unroll
            for (int it = 0; it < 8; ++it) { const int lr = atomicAdd((int*)&cnt[ev[it]], 1); eloc[tl * 8 + it] = ev[it]; rloc[tl * 8 + it] = lr;
                ((float*)(F.ws + WS_WSEL))[(size_t)(t0 + tl) * 8 + it] = wv[it] * inv; }
        }
        __syncthreads();
        if (F.tid < 64) basee[F.tid] = (int)__hip_atomic_fetch_add(F.ctl + CW_GCNT + F.tid, (unsigned)cnt[F.tid], __ATOMIC_RELAXED, __HIP_MEMORY_SCOPE_AGENT);
        __syncthreads();
        { const int e = eloc[F.tid]; ((int*)(F.ws + WS_EIDX))[(size_t)t0 * 8 + F.tid] = e; ((int*)(F.ws + WS_RANK))[(size_t)t0 * 8 + F.tid] = basee[e] + rloc[F.tid]; }
        __syncthreads();
    }
}
__device__ __forceinline__ int moe_tables(Frame& F) {
    LAS int* te = (LAS int*)(F.lds + TAB_OFF); LAS int* off = te + MAXTILES;
    if (F.tid < 64) off[66 + F.tid] = (int)__hip_atomic_load(F.ctl + CW_GCNT + F.tid, __ATOMIC_RELAXED, __HIP_MEMORY_SCOPE_AGENT);
    __syncthreads();
    if (F.tid == 0) { int o = 0; for (int e = 0; e < 64; ++e) { off[e] = o; o += (off[66 + e] + 255) & ~255; } off[64] = o; off[65] = o / 256 + NT / 256; }
    __syncthreads();
    const int ntiles = off[65];
    for (int rt = F.tid; rt < ntiles; rt += 512) { int e = 0; for (int j = 1; j <= 64; ++j) if (rt * 256 >= off[j]) e = j; te[rt] = e; }
    __syncthreads();
    return ntiles;
}
__device__ __forceinline__ void p12_slots(Frame& F) {
    (void)moe_tables(F);
    const LAS int* off = (const LAS int*)(F.lds + TAB_OFF) + MAXTILES;
    int* tok = (int*)(F.ws + WS_TOK);
    const int* eidx = (const int*)(F.ws + WS_EIDX); int* rank = (int*)(F.ws + WS_RANK);
    const int gt = F.vcu * 512 + F.tid, NGT = F.G * 512;
    for (int i = gt; i < NT * 8; i += NGT) { const int slot = off[eidx[i]] + rank[i]; tok[slot] = i >> 3; rank[i] = slot; }
    const int o64 = off[64];
    for (int t = gt; t < NT; t += NGT) tok[o64 + t] = t;
    if (gt == 0) F.ctl[CW_O64] = (unsigned)o64;
}
__device__ __forceinline__ void p15_final(Frame& F, const Args& a) {
    const int gw = F.vcu * 8 + F.wave, NGW = F.G * 8; const float* MOD = (const float*)(F.ws + WS_MOD); const unsigned char* YP = (const unsigned char*)(F.ws + WS_YP);
    const int* SLOTMAP = (const int*)(F.ws + WS_RANK); const float* WSEL = (const float*)(F.ws + WS_WSEL); const int o64 = (int)F.ctl[CW_O64];
    for (int t = gw; t < NT; t += NGW) {
        const int b = t >> 12; const float* gt2 = MOD + (size_t)b * 12288 + 10240; const float* fg = a.in[I_FG]; float* xr = a.out + (size_t)t * D; const bf16* x1r = (const bf16*)(F.ws + WS_X1) + (size_t)t * D;
        const v4u s0 = *(const v4u*)(SLOTMAP + (size_t)t * 8), s1 = *(const v4u*)(SLOTMAP + (size_t)t * 8 + 4); const f32x4 w0 = *(const f32x4*)(WSEL + (size_t)t * 8), w1 = *(const f32x4*)(WSEL + (size_t)t * 8 + 4);
        const unsigned sl[9] = {s0.x, s0.y, s0.z, s0.w, s1.x, s1.y, s1.z, s1.w, (unsigned)(o64 + t)}; const float wt[9] = {w0.x, w0.y, w0.z, w0.w, w1.x, w1.y, w1.z, w1.w, 1.0f};
        float v[2][16]; float s = 0.f;
#pragma unroll
        for (int jj = 0; jj < 2; ++jj) { const int col = 16 * F.lane + 1024 * jj; float m[16];
#pragma unroll
            for (int e = 0; e < 16; ++e) m[e] = 0.f;
#pragma unroll
            for (int j = 0; j < 9; ++j) { const v4u y = *(const v4u*)(YP + (size_t)sl[j] * D + col); const unsigned yw[4] = {y.x, y.y, y.z, y.w}; const float wj = wt[j];
#pragma unroll
                for (int e = 0; e < 4; ++e) { const f32x2 lo = __builtin_amdgcn_cvt_pk_f32_fp8((int)yw[e], false), hi = __builtin_amdgcn_cvt_pk_f32_fp8((int)yw[e], true);
                    m[4 * e] += wj * lo.x; m[4 * e + 1] += wj * lo.y; m[4 * e + 2] += wj * hi.x; m[4 * e + 3] += wj * hi.y; } }
#pragma unroll
            for (int e4 = 0; e4 < 4; ++e4) { const v2u xw = *(const v2u*)(x1r + col + 4 * e4); const f32x4 x0 = (f32x4){bflo(xw.x), bfhi(xw.x), bflo(xw.y), bfhi(xw.y)}, g0 = *(const f32x4*)(gt2 + col + 4 * e4);
#pragma unroll
                for (int e = 0; e < 4; ++e) { const float val = x0[e] + g0[e] * (m[4 * e4 + e] * (1.0f / YP_SCALE)); v[jj][4 * e4 + e] = val; s += val * val; } } }
        float rstd = __builtin_amdgcn_rsqf(wave_sum(s) * (1.0f / D) + 1e-6f);
#if defined(PROBE_PHASE)
        if (PROBE_PHASE >= 0) rstd *= 1.0f + (float)__hip_atomic_load(F.ctl + 12000, __ATOMIC_RELAXED, __HIP_MEMORY_SCOPE_AGENT) * 2e-6f;
#endif
#pragma unroll
        for (int jj = 0; jj < 2; ++jj) { const int col = 16 * F.lane + 1024 * jj;
#pragma unroll
            for (int e4 = 0; e4 < 4; ++e4) { const f32x4 f0 = *(const f32x4*)(fg + col + 4 * e4);
                *(f32x4*)(xr + col + 4 * e4) = (f32x4){v[jj][4 * e4], v[jj][4 * e4 + 1], v[jj][4 * e4 + 2], v[jj][4 * e4 + 3]} * rstd * f0; } }
    }
}
#ifndef MK_ONE_LAUNCH
#define MK_ONE_LAUNCH 1
#endif
constexpr int NPHASE = 16;
__global__ void __launch_bounds__(512, 2) mk_fwd(Args args) {
    extern __shared__ __attribute__((aligned(16))) unsigned char lds[];
    Frame F;
    F.lds = (LAS unsigned char*)lds; F.MISC = (volatile LAS unsigned*)(F.lds + LDSCTL_OFF);
    int wave0 = __builtin_amdgcn_readfirstlane((int)threadIdx.x >> 6); asm volatile("" : "+s"(wave0));
    F.tid = threadIdx.x; F.lane = F.tid & 63; F.wave = wave0;
    F.G = gridDim.x; { const int bx = blockIdx.x; F.vcu = (F.G % 8 == 0) ? (bx % 8) * (F.G / 8) + bx / 8 : bx; }
    F.ws = args.ws; F.ctl = (unsigned*)(args.ws + WS_CTL);
    for (int u = F.tid; u < 256; u += 512) ((LAS unsigned*)(F.lds + LDSCTL_OFF))[u] = 0u;
    __syncthreads();
    XcdBarrier bar; bar.bar = F.ctl + CW_BAR; bar.x = 0; bar.st = nullptr;
    if (MK_ONE_LAUNCH) bar = xcd_barrier_post(F.ctl + CW_BAR, F.MISC + 8);
    const int lo = args.ph_lo, hi = args.ph_hi;
#ifndef PHMASK
#define PHMASK 0xFFFF
#endif
#define IN(k) (((PHMASK >> (k)) & 1) && lo <= (k) && (k) < hi)
#ifndef DUPMASK
#define DUPMASK 0
#endif
#define DUP(k) for (int rep_ = 0, nrep_ = opaque_n(1 + ((DUPMASK >> (k)) & 1)); rep_ < nrep_; ++rep_)
#define FRESH() do { int l_ = (int)__builtin_amdgcn_mbcnt_hi(~0u, __builtin_amdgcn_mbcnt_lo(~0u, 0u)); asm volatile("" : "+v"(l_)); int w_ = wave0; asm volatile("" : "+s"(w_)); F.lane = l_; F.wave = w_; F.tid = w_ * 64 + l_; { unsigned char* p_ = args.ws; asm volatile("" : "+s"(p_)); F.ws = p_; ws = p_; F.ctl = (unsigned*)(p_ + WS_CTL); } } while (0)
#define SEAM(k) do { if (MK_ONE_LAUNCH) { if (IN(k) && IN((k) + 1)) { xcd_barrier(bar); if ((DUPMASK >> 18) & 1) xcd_barrier(bar); } } } while (0)
    const int G = F.G, c = (int)blockIdx.x;
#ifndef PROBE_PHASE
#define PROBE_PHASE -1
#endif
    unsigned long long pt0_ = 0;
#define PSTART(k) do { if (PROBE_PHASE == (k)) pt0_ = __builtin_amdgcn_s_memrealtime(); } while (0)
#define PEND(k) do { if (PROBE_PHASE == (k) && blockIdx.x == 0 && threadIdx.x == 0) { const unsigned long long t1_ = __builtin_amdgcn_s_memrealtime(); __hip_atomic_store(F.ctl + 12000, (unsigned)(t1_ - pt0_), __ATOMIC_RELAXED, __HIP_MEMORY_SCOPE_AGENT); } } while (0)
    unsigned char* ws = args.ws;

    PSTART(0);
    if (IN(0)) DUP(0) { FRESH(); p0_prologue(F, args); } SEAM(0); PEND(0);
    PSTART(1);
    if (IN(1)) DUP(1) { FRESH(); p1_norm1(F, args); } SEAM(1); PEND(1);
    PSTART(2);
    if (IN(2)) DUP(2) { FRESH();
        const int g1 = (G == 256) ? 240 : G;
        if (c < g1) {
            G1Order S{(const char*)(ws + WS_HA), (const char*)(ws + WS_WIN), (size_t)256 * D * 2, (size_t)256 * D * 2, g1, c};
            EpiG1 E{(bf16*)(ws + WS_U), (bf16*)(ws + WS_SLAB), (unsigned char*)(ws + WS_GATES)};
            pg8::gemm_phase<EpiG1, G1Order, false>(F.lds + RING_OFF, F.wave, D, D, D, S, E);
            FRESH();
            if (F.tid == 0) (void)xb_add(F.ctl + CW_P2DONE, 1u);
        } else conv_steal(F, args, 8u);
    } SEAM(2); PEND(2);
    PSTART(3);
    if (IN(3)) DUP(3) { FRESH(); p3_prep(F, args); } SEAM(3); PEND(3);
    PSTART(4);
    if (IN(4)) DUP(4) { FRESH();
#ifndef NO4A
        {
            RepOrder S{(const char*)(ws + WS_LIN), (const char*)(ws + WS_LORA), (size_t)128 * 2, (size_t)D * 128 * 2, (size_t)256 * LINLD * 2, (size_t)256 * 128 * 2, MT / 256, D / 256, 4, G, c};
            EpiLora E{(unsigned short*)(ws + WS_EA), args.in[I_DW0], args.in[I_IA0]};
            pg8::gemm_phase<EpiLora, RepOrder, false>(F.lds + RING_OFF, F.wave, 128, LINLD, 128, S, E);
        }
#endif
    }
    if (IN(4)) DUP(4) { FRESH();
#ifndef NO4B
        {
            RepOrder S{(const char*)(ws + WS_DP), (const char*)(ws + WS_POOLW), (size_t)256 * 2, (size_t)256 * 256 * 2, (size_t)256 * 1024 * 2, (size_t)256 * 256 * 2, NT / 256, 1, 4, G, c};
            EpiPoolG E{(bf16*)(ws + WS_Y2), args.in[I_POOLS]};
            pg8::gemm_phase<EpiPoolG, RepOrder, false>(F.lds + RING_OFF, F.wave, 256, 1024, 256, S, E);
        }
#endif
    } SEAM(4); PEND(4);
    PSTART(5);
    if (IN(5)) DUP(5) { FRESH();
        RepOrder S{(const char*)(ws + WS_Y2), (const char*)(ws + WS_WPO), 0, 0, (size_t)256 * 1024 * 2, (size_t)256 * 1024 * 2, NT / 256, D / 256, 1, G, c};
        EpiMix<0> E{(bf16*)(ws + WS_MP), D, (const void*)(ws + WS_GATES), 4096, nullptr, 0};
        pg8::gemm_phase<EpiMix<0>, RepOrder, false>(F.lds + RING_OFF, F.wave, 1024, 1024, 1024, S, E);
    }
    PSTART(6);
    if (IN(6)) DUP(6) { FRESH(); p6_scan(F, args); if ((DUPMASK >> 19) & 1) { FRESH(); p6_scan(F, args); } } SEAM(6); PEND(6);
    PSTART(7);
    if (IN(7)) DUP(7) { FRESH(); p7_readout(F, args); } SEAM(7); PEND(7);
    PSTART(8);
    if (IN(8)) DUP(8) { FRESH();
        RepOrder S{(const char*)(ws + WS_LIN) + 512 * 2, (const char*)(ws + WS_G2), 0, 0, (size_t)256 * LINLD * 2, (size_t)256 * 256 * 2, NT / 256, D / 256, 1, G, c};
        EpiMix<1> E{(bf16*)(ws + WS_OR), D, (const void*)(ws + WS_Z), D, nullptr, 0};
        pg8::gemm_phase<EpiMix<1>, RepOrder, false>(F.lds + RING_OFF, F.wave, 256, LINLD, 256, S, E);
    } SEAM(8); PEND(8);
    PSTART(9);
    if (IN(9)) DUP(9) { FRESH();
        RepOrder S{(const char*)(ws + WS_OR), (const char*)(ws + WS_WRO), 0, 0, (size_t)256 * D * 2, (size_t)256 * D * 2, NT / 256, D / 256, 1, G, c};
        EpiMix<2> E{(bf16*)(ws + WS_Z), D, (const void*)(ws + WS_GATES + 2048), 4096, (const bf16*)(ws + WS_MP), D};
        pg8::gemm_phase<EpiMix<2>, RepOrder, false>(F.lds + RING_OFF, F.wave, D, D, D, S, E);
    } SEAM(9); PEND(9);
    PSTART(10);
    if (IN(10)) DUP(10) { FRESH();
        RepOrder S{(const char*)(ws + WS_Z), (const char*)(ws + WS_WO), 0, 0, (size_t)256 * D * 2, (size_t)256 * D * 2, NT / 256, D / 256, 1, G, c};
        EpiX1 E{args.in[I_X], (bf16*)(ws + WS_X1), (const float*)(ws + WS_MOD)};
        pg8::gemm_phase<EpiX1, RepOrder, false>(F.lds + RING_OFF, F.wave, D, D, D, S, E);
    } SEAM(10); PEND(10);
    PSTART(11);
    if (IN(11)) DUP(11) { FRESH(); p11_route(F, args); } SEAM(11); PEND(11);
    PSTART(12);
    if (IN(12)) DUP(12) { FRESH(); p12_slots(F); } SEAM(12); PEND(12);
    PSTART(13);
    if (IN(13)) DUP(13) { FRESH();
        const int ntiles = moe_tables(F);
        MoeOrderT<true> S{(const char*)(ws + WS_H2), (const char*)ws, (const LAS int*)(F.lds + TAB_OFF), (const LAS int*)(F.lds + ROWTAB_OFF), 0, (size_t)1024 * D * 2, (size_t)256 * D, ntiles, 4, G, c};
        { LAS int* rt = (LAS int*)(F.lds + ROWTAB_OFF); const int* tok = (const int*)(ws + WS_TOK); Unit uu;
          for (int i = 0; i < ROWTAB_UNITS && S.next(i, uu); ++i) if (F.tid < 256) rt[i * 256 + F.tid] = tok[uu.pm * 256 + F.tid];
          __syncthreads(); }
        EpiAct E{ws + WS_ACT};
        pg8::gemm_phase<EpiAct, MoeOrderT<true>, true, true, 124>(F.lds + RING_OFF, F.wave, D / 2, D / 2, D / 2, S, E);
    } SEAM(13); PEND(13);
    PSTART(14);
    if (IN(14)) DUP(14) { FRESH();
        const int ntiles = moe_tables(F);
        MoeOrderT<false> S{(const char*)(ws + WS_ACT), (const char*)(ws + WS_DT), (const LAS int*)(F.lds + TAB_OFF), (const LAS int*)(F.lds + ROWTAB_OFF), (size_t)256 * DEXP, (size_t)D * DEXP, (size_t)256 * DEXP, ntiles, 8, G, c};
        EpiDown E{(unsigned char*)(ws + WS_YP)};
        pg8::gemm_phase<EpiDown, MoeOrderT<false>, false, true, 124>(F.lds + RING_OFF, F.wave, DEXP / 2, DEXP / 2, DEXP / 2, S, E);
    } SEAM(14); PEND(14);
    PSTART(15);
    if (IN(15)) DUP(15) { FRESH(); p15_final(F, args); }
#undef IN
#undef SEAM
}

extern "C" void kernel_launch(void* const* d_in, const int* in_sizes, int n_in, void* d_out, int out_size, void* d_ws, size_t ws_size, hipStream_t stream) {
    static int grid = 0;
    if (grid == 0) {
        if (n_in != 34 || in_sizes[0] != NT * D || out_size != NT * D || ws_size < WS_END) { fprintf(stderr, "kernel_launch: unexpected shapes (n_in %d, in0 %d, out %d, ws %zu < %zu)\n", n_in, n_in > 0 ? in_sizes[0] : -1, out_size, ws_size, (size_t)WS_END); grid = -1; return; }
        int dev = 0, cus = 0, per_cu = 0;
        if (hipGetDevice(&dev) != hipSuccess || hipDeviceGetAttribute(&cus, hipDeviceAttributeMultiprocessorCount, dev) != hipSuccess) { grid = -1; return; }
        if (hipFuncSetAttribute((const void*)mk_fwd, hipFuncAttributeMaxDynamicSharedMemorySize, LDS_BYTES) != hipSuccess) { fprintf(stderr, "kernel_launch: hipFuncSetAttribute failed\n"); grid = -1; return; }
        if (hipOccupancyMaxActiveBlocksPerMultiprocessor(&per_cu, (const void*)mk_fwd, 512, LDS_BYTES) != hipSuccess || per_cu < 1) fprintf(stderr, "kernel_launch: occupancy query reports %d\n", per_cu);
        (void)hipGetLastError();
        grid = cus;
    }
    if (grid < 0) return;
    if (hipMemsetAsync((char*)d_ws + WS_CTL, 0, CTL_ZERO_BYTES, stream) != hipSuccess) return;
    Args a{};
    for (int i = 0; i < 34; ++i) a.in[i] = (const float*)d_in[i];
    a.out = (float*)d_out; a.ws = (unsigned char*)d_ws;
#if MK_ONE_LAUNCH
    a.ph_lo = 0; a.ph_hi = NPHASE;
    hipLaunchKernelGGL(mk_fwd, dim3(grid), dim3(512), LDS_BYTES, stream, a);
#else
    for (int p = 0; p < NPHASE; ++p) { a.ph_lo = p; a.ph_hi = p + 1; hipLaunchKernelGGL(mk_fwd, dim3(grid), dim3(512), LDS_BYTES, stream, a); }
#endif
}
```

```cpp
#include <hip/hip_runtime.h>
#include <cstdio>
#include <cstdint>
#ifndef DUPMASK
#define DUPMASK 0
#endif
#ifndef PROBE_PHASE
#define PROBE_PHASE -1
#endif
#ifndef P2_FP8
#define P2_FP8 1
#endif

#define GAS __attribute__((address_space(1)))
#define LAS __attribute__((address_space(3)))
typedef unsigned short bf16;
typedef unsigned v4u __attribute__((ext_vector_type(4)));
typedef unsigned v2u __attribute__((ext_vector_type(2)));
typedef float f32x4 __attribute__((ext_vector_type(4)));
typedef float f32x2 __attribute__((ext_vector_type(2)));
typedef short bf16x8 __attribute__((ext_vector_type(8)));

constexpr int D = 2048, NB = 4, TSEQ = 4096, NT = NB * TSEQ  , CTXL = 256, NC = NB * CTXL  , MT = NT + NC  ;
constexpr int DIN = 11904, DSH = 6784, NPAD = 12032, SLABLD = 6912, NH = 32, HS = 64;
constexpr int NEXP = 64, DEXP = 512, TOPK = 8;
constexpr int NSLOT = NT * TOPK + NEXP * 256 + NT;
constexpr int MAXTILES = NSLOT / 256;
constexpr int LINLD = 768;

__device__ __forceinline__ int opaque_n(int n) { asm volatile("" : "+s"(n)); return n; }
__device__ __forceinline__ unsigned f2bf(float f) { unsigned u = __builtin_bit_cast(unsigned, f); return (u + 0x7fffu + ((u >> 16) & 1u)) >> 16; }
typedef __bf16 bf16x2_t __attribute__((ext_vector_type(2)));
__device__ __forceinline__ unsigned pk2(float lo, float hi) { const f32x2 v = {lo, hi}; const bf16x2_t b = __builtin_convertvector(v, bf16x2_t); return __builtin_bit_cast(unsigned, b); }
__device__ __forceinline__ unsigned pk8(float a, float b, float c, float d) { int w = __builtin_amdgcn_cvt_pk_fp8_f32(a, b, 0, false); w = __builtin_amdgcn_cvt_pk_fp8_f32(c, d, w, true); return (unsigned)w; }
__device__ __forceinline__ float bflo(unsigned w) { return __builtin_bit_cast(float, w << 16); }
__device__ __forceinline__ float bfhi(unsigned w) { return __builtin_bit_cast(float, w & 0xffff0000u); }
__device__ __forceinline__ unsigned pkh2(float lo, float hi) { const unsigned short a = __builtin_bit_cast(unsigned short, (_Float16)lo), b = __builtin_bit_cast(unsigned short, (_Float16)hi); return (unsigned)a | ((unsigned)b << 16); }
__device__ __forceinline__ float hlo(unsigned w) { return (float)__builtin_bit_cast(_Float16, (unsigned short)(w & 0xffffu)); }
__device__ __forceinline__ float hhi(unsigned w) { return (float)__builtin_bit_cast(_Float16, (unsigned short)(w >> 16)); }
__device__ __forceinline__ float sigmoidf_(float x) { return __builtin_amdgcn_rcpf(1.0f + __builtin_amdgcn_exp2f(-1.44269504f * x)); }
__device__ __forceinline__ float tanhf_(float x) { return 1.0f - 2.0f * __builtin_amdgcn_rcpf(1.0f + __builtin_amdgcn_exp2f(2.88539008f * x)); }
__device__ __forceinline__ float wave_sum(float v) {
#pragma unroll
    for (int o = 1; o < 64; o <<= 1) v += __shfl_xor(v, o);
    return v;
}
__device__ __forceinline__ float dpp_f(float v, const int ctrl_sel) {
    int r;
    const int x = __builtin_bit_cast(int, v);
    if (ctrl_sel == 0) r = __builtin_amdgcn_update_dpp(0, x, 0xB1, 0xF, 0xF, true);
    else if (ctrl_sel == 1) r = __builtin_amdgcn_update_dpp(0, x, 0x4E, 0xF, 0xF, true);
    else if (ctrl_sel == 2) r = __builtin_amdgcn_update_dpp(0, x, 0x141, 0xF, 0xF, true);
    else r = __builtin_amdgcn_update_dpp(0, x, 0x140, 0xF, 0xF, true);
    return __builtin_bit_cast(float, r);
}
__device__ __forceinline__ float allred16(float v) { v += dpp_f(v, 0); v += dpp_f(v, 1); v += dpp_f(v, 2); v += dpp_f(v, 3); return v; }

#define LDS_WAIT() asm volatile("s_waitcnt lgkmcnt(0)" ::: "memory")
#define VM_WAIT() asm volatile("s_waitcnt vmcnt(0)" ::: "memory")

namespace pg8 {
constexpr int BM = 256, BK = 64, HALF = 128, HTB = HALF * BK * 2, STAGE_BYTES = 8 * HTB, NXCD = 8, WGM = 8;
__host__ __device__ __forceinline__ int lds_byte(int r, int c) { const int st = (r >> 4) * 2 + (c >> 5), rr = r & 15, cc = c & 31, ob = rr * 64 + cc * 2; return st * 1024 + (ob ^ (((ob >> 9) & 1) << 5)); }
__host__ __device__ __forceinline__ void stage_rc(int b, int& R, int& C) { const int st = b / 1024, sb = b % 1024, swz = sb ^ (((sb >> 9) & 1) << 5); R = (st >> 1) * 16 + swz / 64; C = (st & 1) * 32 + (swz % 64) / 2; }
__host__ __device__ __forceinline__ int perm32(int rho) { const int n = rho >> 4, i = rho & 15; return 8 * (i >> 2) + 4 * n + (i & 3); }
struct Unit { const char* A; const char* B; int pm, pn, aux, ui; };
__device__ __forceinline__ int xcd_remap(int L, int nwg) { const int q = nwg / NXCD, r = nwg % NXCD, xcd = L % NXCD, off = L / NXCD; return (xcd < r ? xcd * (q + 1) : r * (q + 1) + (xcd - r) * q) + off; }
__device__ __forceinline__ void grid_tile(int wgid, int nM, int nN, int& pm, int& pn) { const int nig = WGM * nN, gid = wgid / nig, fm = gid * WGM, gsz = (nM - fm) < WGM ? (nM - fm) : WGM; pm = fm + ((wgid % nig) % gsz); pn = (wgid % nig) / gsz; }

__device__ __forceinline__ void stage2(LAS unsigned char* lds, int bufoff, unsigned ldsw, const char* g, unsigned o0, unsigned o1) {
    __builtin_amdgcn_global_load_lds((const unsigned*)(g + o0), (LAS unsigned*)(lds + bufoff + ldsw), 16, 0, 0);
    __builtin_amdgcn_global_load_lds((const unsigned*)(g + o1), (LAS unsigned*)(lds + bufoff + ldsw + 8192), 16, 0, 0);
}

typedef int v8i_t __attribute__((ext_vector_type(8)));
typedef int v4i_t __attribute__((ext_vector_type(4)));
__device__ __forceinline__ v8i_t mx_cat(const bf16x8& lo, const bf16x8& hi) { const v4i_t a = __builtin_bit_cast(v4i_t, lo), b = __builtin_bit_cast(v4i_t, hi); return __builtin_shufflevector(a, b, 0, 1, 2, 3, 4, 5, 6, 7); }

template <class Epi, class = void> struct EpiPerm16 { static constexpr bool value = false; };
template <class Epi> struct EpiPerm16<Epi, decltype((void)Epi::PERM16)> { static constexpr bool value = Epi::PERM16; };
template <class Epi> __host__ __device__ constexpr bool epi_perm16() { return EpiPerm16<Epi>::value; }
template <class Epi> __host__ __device__ __forceinline__ int perm_row(int R) {
    if (epi_perm16<Epi>()) { const int wc = R >> 5, rho = R & 31, n = rho >> 4, i = rho & 15; return 64 * wc + 16 * (i >> 2) + 4 * n + (i & 3); }
    return Epi::PERM ? ((R & ~31) + perm32(R & 31)) : R;
}
template <class Epi, class Sched, bool GATHER, bool ALIGN_EPI = true, int MXS = 0>
__device__ __forceinline__ void gemm_phase(LAS unsigned char* lds, const int wave_, const int K, const int lda, const int ldb, const Sched& S, const Epi& E) {
    int tid_ = wave_ * 64 + (int)__builtin_amdgcn_mbcnt_hi(~0u, __builtin_amdgcn_mbcnt_lo(~0u, 0u)); asm volatile("" : "+v"(tid_));
    const int tid = tid_, wid = __builtin_amdgcn_readfirstlane(tid >> 6), lane = tid & 63, wr = wid >> 2, wc = wid & 3, fr = lane & 15, fq = lane >> 4;
    const int nt = opaque_n(K / BK);
    unsigned voffA[2], voffB[2]; int RA[2], CA[2];
#pragma unroll
    for (int i = 0; i < 2; ++i) { int R, C; stage_rc(tid * 16 + i * 8192, R, C); const int Rb = perm_row<Epi>(R);
        RA[i] = R; CA[i] = C; voffA[i] = (unsigned)(R * lda + C) * 2u; voffB[i] = (unsigned)(Rb * ldb + C) * 2u; }
    const size_t kstep = (size_t)(BK * 2);
    const size_t hstepA = (size_t)HALF * lda * 2, hstepB = (size_t)(epi_perm16<Epi>() ? 8 : HALF) * ldb * 2;
    const unsigned ldsw = (unsigned)wid * 1024u;
    const int aoff = lds_byte(wr * 64 + fr, fq * 8), boff = lds_byte(wc * 32 + fr, fq * 8);
#define PG8_SA(b, h) (((b) * 2 + (h)) * HTB)
#define PG8_SB(b, h) ((4 + (b) * 2 + (h)) * HTB)
#define PG8_STB(bufoff, gbase) stage2(lds, (bufoff), ldsw, (gbase), voffB[0], voffB[1])
#define PG8_STA(bufoff, gk, h, NX) do { if constexpr (GATHER) { const unsigned _o0 = (NX) ? vn[h][0] : vc[h][0], _o1 = (NX) ? vn[h][1] : vc[h][1]; stage2(lds, (bufoff), ldsw, (gk), _o0, _o1); } \
        else stage2(lds, (bufoff), ldsw, (gk) + (h) * hstepA, voffA[0], voffA[1]); } while (0)
#define PG8_LDA(dst, b, h) do { _Pragma("unroll") for (int m = 0; m < 4; ++m) _Pragma("unroll") for (int k = 0; k < 2; ++k) dst[m][k] = *(const LAS bf16x8*)(lds + PG8_SA(b, h) + aoff + m * 2048 + k * 1024); } while (0)
#define PG8_LDB(dst, b, h) do { _Pragma("unroll") for (int n = 0; n < 2; ++n) _Pragma("unroll") for (int k = 0; k < 2; ++k) dst[n][k] = *(const LAS bf16x8*)(lds + PG8_SB(b, h) + boff + n * 2048 + k * 1024); } while (0)
#define PG8_MMA(ai, bj, At, Bt) do { __builtin_amdgcn_s_setprio(1); if constexpr (MXS != 0) { _Pragma("unroll") for (int m = 0; m < 4; ++m) _Pragma("unroll") for (int n = 0; n < 2; ++n) \
        asm volatile("v_mfma_scale_f32_16x16x128_f8f6f4 %0, %1, %2, %0, %3, %3 op_sel_hi:[0,0,0]" : "+v"(acc[ai][bj][m][n]) : "v"(mx_cat(Bt[n][0], Bt[n][1])), "v"(mx_cat(At[m][0], At[m][1])), "v"(mxs_)); } \
        else { _Pragma("unroll") for (int m = 0; m < 4; ++m) _Pragma("unroll") for (int n = 0; n < 2; ++n) _Pragma("unroll") for (int k = 0; k < 2; ++k) \
        acc[ai][bj][m][n] = __builtin_amdgcn_mfma_f32_16x16x32_bf16(Bt[n][k], At[m][k], acc[ai][bj][m][n], 0, 0, 0); } __builtin_amdgcn_s_setprio(0); } while (0)
#define PG8_WAIT_V(n) asm volatile("s_waitcnt vmcnt(" #n ")" ::: "memory")
#define PG8_WAIT_L(n) asm volatile("s_waitcnt lgkmcnt(" #n ")" ::: "memory")
#define PG8_BAR __builtin_amdgcn_s_barrier()
#define PG8_SCHED __builtin_amdgcn_sched_barrier(0)
    Unit cur, nxt; int ui = 0;
    if (!S.next(0, cur)) return;
    int mxs_ = MXS * 0x01010101; asm volatile("" : "+v"(mxs_));
    unsigned vc[2][2], vn[2][2];
    if constexpr (GATHER) {
#pragma unroll
        for (int h = 0; h < 2; ++h)
#pragma unroll
            for (int i = 0; i < 2; ++i) { vc[h][i] = ((unsigned)S.row(cur, h * HALF + RA[i]) * (unsigned)lda + (unsigned)CA[i]) * 2u; vn[h][i] = vc[h][i]; }
        if constexpr (!Sched::ROW_LDS) asm volatile("s_waitcnt vmcnt(0)" ::: "memory");
    }
    f32x4 acc[2][2][4][2];
#pragma unroll
    for (int a = 0; a < 2; ++a)
#pragma unroll
        for (int b = 0; b < 2; ++b)
#pragma unroll
            for (int m = 0; m < 4; ++m)
#pragma unroll
                for (int n = 0; n < 2; ++n) acc[a][b][m][n] = (f32x4){0.f, 0.f, 0.f, 0.f};
    bf16x8 At[4][2], B0[2][2], B1[2][2];
    const char* cA = cur.A; const char* cB = cur.B;
    PG8_STB(PG8_SB(0, 0), cB); PG8_STB(PG8_SB(0, 1), cB + hstepB); PG8_STA(PG8_SA(0, 0), cA, 0, false); PG8_STA(PG8_SA(0, 1), cA, 1, false);
    if (wr == 1) PG8_BAR;
    PG8_WAIT_V(2); PG8_BAR;
    PG8_STB(PG8_SB(1, 0), cB + kstep); PG8_STA(PG8_SA(1, 0), cA + kstep, 0, false); PG8_STB(PG8_SB(1, 1), cB + hstepB + kstep);
    PG8_WAIT_V(6); PG8_BAR;
    for (;;) {
        const bool has_next = S.next(ui + 1, nxt);
        const char* nA = has_next ? nxt.A : cA; const char* nB = has_next ? nxt.B : cB;
#pragma unroll 1
        for (int t = 0; t < nt; t += 2) {
            const bool last = (t == nt - 2);
            const char* a1 = cA + (size_t)(t + 1) * kstep;
            const char* a2 = last ? nA : cA + (size_t)(t + 2) * kstep; const char* b2 = last ? nB : cB + (size_t)(t + 2) * kstep;
            const char* a3 = a2 + kstep; const char* b3 = b2 + kstep;
            if constexpr (GATHER) {
                if (last && has_next) {
#pragma unroll
                    for (int h = 0; h < 2; ++h)
#pragma unroll
                        for (int i = 0; i < 2; ++i) vn[h][i] = ((unsigned)S.row(nxt, h * HALF + RA[i]) * (unsigned)lda + (unsigned)CA[i]) * 2u;
                    if constexpr (!Sched::ROW_LDS) asm volatile("s_waitcnt vmcnt(0)" ::: "memory");
                }
            }
            PG8_LDB(B0, 0, 0); PG8_LDB(B1, 0, 1); PG8_SCHED; PG8_LDA(At, 0, 0); PG8_STA(PG8_SA(1, 1), a1, 1, false);
            PG8_WAIT_V(8); PG8_WAIT_L(0); PG8_BAR; PG8_MMA(0, 0, At, B0); PG8_MMA(0, 1, At, B1); PG8_BAR; PG8_SCHED;
            PG8_LDA(At, 0, 1); PG8_STB(PG8_SB(0, 0), b2); PG8_STB(PG8_SB(0, 1), b2 + hstepB); PG8_STA(PG8_SA(0, 0), a2, 0, last);
            PG8_WAIT_V(8); PG8_WAIT_L(0); PG8_BAR; PG8_MMA(1, 0, At, B0); PG8_MMA(1, 1, At, B1); PG8_BAR; PG8_SCHED;
            PG8_LDB(B0, 1, 0); PG8_LDB(B1, 1, 1); PG8_SCHED; PG8_LDA(At, 1, 0); PG8_STA(PG8_SA(0, 1), a2, 1, last);
            PG8_WAIT_V(8); PG8_WAIT_L(0); PG8_BAR; PG8_MMA(0, 0, At, B0); PG8_MMA(0, 1, At, B1); PG8_BAR; PG8_SCHED;
            PG8_LDA(At, 1, 1); PG8_STB(PG8_SB(1, 0), b3); PG8_STB(PG8_SB(1, 1), b3 + hstepB); PG8_STA(PG8_SA(1, 0), a3, 0, last);
            PG8_WAIT_V(8); PG8_WAIT_L(0); PG8_BAR; PG8_MMA(1, 0, At, B0); PG8_MMA(1, 1, At, B1); PG8_BAR; PG8_SCHED;
        }
        if constexpr (ALIGN_EPI) { if (wr == 0) PG8_BAR; }
        if constexpr (MXS != 0) asm volatile("s_nop 15\n\ts_nop 15" ::: "memory");
        { int fr_ = fr, fq_ = fq; asm volatile("" : "+v"(fr_), "+v"(fq_));
          E(acc, cur, wr, wc, fr_, fq_); }
        if (!has_next) break;
#pragma unroll
        for (int a = 0; a < 2; ++a)
#pragma unroll
            for (int b = 0; b < 2; ++b)
#pragma unroll
                for (int m = 0; m < 4; ++m)
#pragma unroll
                    for (int n = 0; n < 2; ++n) acc[a][b][m][n] = (f32x4){0.f, 0.f, 0.f, 0.f};
        cur = nxt; cA = nA; cB = nB; ++ui;
        if constexpr (GATHER) {
#pragma unroll
            for (int h = 0; h < 2; ++h)
#pragma unroll
                for (int i = 0; i < 2; ++i) vc[h][i] = vn[h][i];
        }
        if constexpr (ALIGN_EPI) { if (wr == 1) PG8_BAR; }
    }
    PG8_WAIT_V(0);
    if constexpr (!ALIGN_EPI) { if (wr == 0) PG8_BAR; }
    PG8_BAR;
#undef PG8_SA
#undef PG8_SB
#undef PG8_STB
#undef PG8_STA
#undef PG8_LDA
#undef PG8_LDB
#undef PG8_MMA
#undef PG8_WAIT_V
#undef PG8_WAIT_L
#undef PG8_BAR
#undef PG8_SCHED
}
}
#define XB_TMO      128
#define XB_XCNT(j)  (256  + 64 * (j))
#define XB_XSUB(j)  (1280 + 64 * (j))
#define XB_XGEN(j)  (2304 + 64 * (j))
#define XB_TOP      3328
#define XB_TOPGEN   3392
#define XCD_BAR_WORDS 3456
#define XB_SPIN_CAP (1u << 18)
__device__ __forceinline__ unsigned xb_ld(unsigned* p)              { return __hip_atomic_load(p, __ATOMIC_RELAXED, __HIP_MEMORY_SCOPE_AGENT); }
__device__ __forceinline__ unsigned xb_add(unsigned* p, unsigned v) { return __hip_atomic_fetch_add(p, v, __ATOMIC_RELAXED, __HIP_MEMORY_SCOPE_AGENT); }
__device__ __forceinline__ unsigned xb_xcc_id() { return (unsigned)__builtin_amdgcn_s_getreg((3 << 11) | 20) & 0xFu; }
#define XB_SPIN(cond, bar) do { unsigned _sp = 0; while (cond) { __builtin_amdgcn_s_sleep(1); \
    if ((++_sp & 255u) == 0u) { if (xb_ld(&(bar)[XB_TMO])) break; if (_sp > XB_SPIN_CAP) { atomicAdd(&(bar)[XB_TMO], 1u); break; } } } } while (0)
struct XcdBarrier { unsigned* bar; unsigned x; volatile LAS unsigned* st; };
__device__ __forceinline__ XcdBarrier xcd_barrier_post(unsigned* bar, volatile LAS unsigned* st) {
    XcdBarrier b; b.bar = bar; b.x = xb_xcc_id(); b.st = st;
    if (threadIdx.x == 0) (void)xb_add(&bar[XB_XCNT(b.x)], 1u);
    return b;
}
__device__ __forceinline__ void xcd_barrier_complete(unsigned* bar, unsigned x, unsigned& nloc, unsigned& nx) {
    const unsigned G = gridDim.x * gridDim.y * gridDim.z;
    unsigned sum, cnt, mine, sp = 0u;
    for (;;) {
        sum = 0u; cnt = 0u; mine = 0u;
#pragma unroll
        for (unsigned j = 0; j < 16; ++j) { const unsigned c = xb_ld(&bar[XB_XCNT(j)]); sum += c; cnt += (c > 0u) ? 1u : 0u; mine = (j == x) ? c : mine; }
        if (sum == G) break;
        __builtin_amdgcn_s_sleep(1);
        if ((++sp & 255u) == 0u) { if (xb_ld(&bar[XB_TMO])) break; if (sp > XB_SPIN_CAP) { atomicAdd(&bar[XB_TMO], 1u); break; } }
    }
    nloc = mine > 0u ? mine : 1u; nx = cnt > 0u ? cnt : 1u;
}
__device__ __forceinline__ void xcd_barrier(const XcdBarrier& b) {
    asm volatile("s_waitcnt vmcnt(0)" ::: "memory");
    __syncthreads();
    if (threadIdx.x == 0) {
        unsigned* bar = b.bar;
        __builtin_amdgcn_s_waitcnt(0);
        unsigned nloc = b.st[0], nx = b.st[1];
        if (nloc == 0u) { xcd_barrier_complete(bar, b.x, nloc, nx); b.st[0] = nloc; b.st[1] = nx; }
        const unsigned old = xb_add(&bar[XB_XSUB(b.x)], 1u);
        const unsigned gen = old / nloc;
        if (old + 1u == (gen + 1u) * nloc) {
            __builtin_amdgcn_fence(__ATOMIC_RELEASE, "agent");
            asm volatile("s_waitcnt vmcnt(0)" ::: "memory");
            const unsigned og = xb_add(&bar[XB_TOP], 1u);
            const unsigned tg = og / nx;
            if (og + 1u == (tg + 1u) * nx) xb_add(&bar[XB_TOPGEN], 1u);
            else XB_SPIN(xb_ld(&bar[XB_TOPGEN]) == tg, bar);
            __builtin_amdgcn_fence(__ATOMIC_ACQUIRE, "agent");
            xb_add(&bar[XB_XGEN(b.x)], 1u);
            asm volatile("s_waitcnt vmcnt(0)" ::: "memory");
        } else {
            XB_SPIN(xb_ld(&bar[XB_XGEN(b.x)]) == gen, bar);
            __builtin_amdgcn_fence(__ATOMIC_ACQUIRE, "agent");
            asm volatile("s_waitcnt vmcnt(0)" ::: "memory");
        }
    }
    __syncthreads();
}

constexpr size_t MiB = 1u << 20;
constexpr size_t WS_CTL = 0, CTL_ZERO_BYTES = 64 * 1024;
constexpr size_t WS_MOD = 1 * MiB;
constexpr size_t WS_EIDX = 2 * MiB;
constexpr size_t WS_WSEL = WS_EIDX + 512 * 1024;
constexpr size_t WS_RANK = WS_WSEL + 512 * 1024;
constexpr size_t WS_TOK = 4 * MiB;
constexpr size_t WS_DST = WS_TOK + 1 * MiB;
constexpr size_t WS_WSL = WS_DST + 1 * MiB;
constexpr size_t WS_WIN = 8 * MiB;
constexpr size_t WS_POOLW = 55 * MiB;
constexpr size_t WS_WPO = 56 * MiB;
constexpr size_t WS_LORA = 60 * MiB;
constexpr size_t WS_G2 = 62 * MiB;
constexpr size_t WS_WRO = 63 * MiB;
constexpr size_t WS_WO = 71 * MiB;
constexpr size_t WS_SLAB = 80 * MiB;
constexpr size_t WS_EA = 80 * MiB;
constexpr size_t EA_STRIDE = (size_t)MT * D * 2;
constexpr size_t WS_YF = 352 * MiB, WS_YB = 416 * MiB;
constexpr size_t WS_HA = 438 * MiB;
constexpr size_t WS_Z = 480 * MiB;
constexpr size_t WS_U = 506 * MiB;
constexpr size_t WS_RM = 544 * MiB, WS_KM = 612 * MiB, WS_VM = 680 * MiB;
constexpr size_t WS_LIN = 748 * MiB;
constexpr size_t WS_DP = 774 * MiB;
constexpr size_t WS_BON = 774 * MiB;
constexpr size_t WS_Y2 = 806 * MiB;
constexpr size_t WS_MP = 838 * MiB;
constexpr size_t WS_GATES = 902 * MiB;
constexpr size_t WS_OR = 80 * MiB;
constexpr size_t WS_H2 = 520 * MiB;
constexpr size_t WS_GU = 584 * MiB;
constexpr size_t WS_GU2 = 966 * MiB, WS_GU3 = 1134 * MiB;
constexpr int GU_E2 = 52, GU_E3 = 61;
constexpr size_t WS_ACT = 792 * MiB;
constexpr size_t WS_DT = 1004 * MiB;
constexpr size_t WS_X1 = 328 * MiB;
constexpr size_t WS_YP = 8 * MiB;
constexpr size_t WS_END = 1150 * MiB;
__host__ __device__ __forceinline__ size_t gu_base(int e) { return e < GU_E2 ? WS_GU + (size_t)e * (4 * MiB) : e < GU_E3 ? WS_GU2 + (size_t)(e - GU_E2) * (4 * MiB) : WS_GU3 + (size_t)(e - GU_E3) * (4 * MiB); }
constexpr int CW_BAR = 1024;
constexpr int CW_GCNT = 8192;
constexpr int CW_O64 = 8192 + 100;
constexpr int CW_CONV = 8448, CW_P2DONE = 8512;
static_assert((CW_BAR + XCD_BAR_WORDS) <= CW_GCNT && (CW_P2DONE + 128) * 4 <= (int)CTL_ZERO_BYTES, "ctl");

constexpr int RING_OFF = 0, RING_BYTES = 131072;
constexpr int LDSCTL_OFF = RING_BYTES;
constexpr int ROWTAB_OFF = LDSCTL_OFF + 1024 + 4096, ROWTAB_UNITS = 24;
constexpr int TAB_OFF = LDSCTL_OFF + 1024;
constexpr int LDS_BYTES = 163840;

using pg8::Unit;
struct RepOrder { static constexpr bool ROW_LDS = false;
    const char* A; const char* B; size_t repA, repB, tA, tB; int nM, nN, nrep, G, c;
    __device__ __forceinline__ bool next(int i, Unit& u) const {
        const long L = (long)i * G + c; const int per = nM * nN; if (L >= (long)per * nrep) return false;
        const int rep = (int)(L / per); const int w = pg8::xcd_remap((int)(L % per), per); pg8::grid_tile(w, nM, nN, u.pm, u.pn); u.aux = rep;
        u.A = A + (size_t)rep * repA + (size_t)u.pm * tA; u.B = B + (size_t)rep * repB + (size_t)u.pn * tB; return true; }
    __device__ __forceinline__ int row(const Unit&, int) const { return 0; }
};
struct G1Order { static constexpr bool ROW_LDS = false;
    const char* A; const char* B; size_t tA, tB; int G, c;
    __device__ __forceinline__ bool next(int i, Unit& u) const {
        const long L = (long)i * G + c; constexpr int N1 = 64 * 47, N2 = 4 * 27; if (L >= N1 + N2) return false;
        if (L < N1) { const int w = pg8::xcd_remap((int)L, N1); pg8::grid_tile(w, 64, 47, u.pm, u.pn); }
        else { const int l2 = (int)L - N1; u.pm = 64 + (l2 & 3); u.pn = 4 + (l2 >> 2); }
        u.aux = 0; u.A = A + (size_t)u.pm * tA; u.B = B + (size_t)u.pn * tB; return true; }
    __device__ __forceinline__ int row(const Unit&, int) const { return 0; }
};
template <bool GUMAP> struct MoeOrderT { static constexpr bool ROW_LDS = true;
    const char* A; const char* B; const LAS int* te; const LAS int* rowtab; size_t tA, estride, jstride; int ntiles, NJ, G, c;
    __device__ __forceinline__ bool next(int i, Unit& u) const {
        const long L = (long)i * G + c; const int tot = ntiles * NJ; if (L >= tot) return false;
        const int w = pg8::xcd_remap((int)L, tot); const int rt = w / NJ, j = w - rt * NJ; const int e = te[rt];
        u.pm = rt; u.pn = j; u.aux = e; u.ui = i; u.A = A + (size_t)rt * tA; u.B = B + (GUMAP ? gu_base(e) : (size_t)e * estride) + (size_t)j * jstride; return true; }
    __device__ __forceinline__ int row(const Unit& u, int r) const { return rowtab[u.ui * 256 + r]; }
};

typedef f32x4 AccT[2][2][4][2];
#define EPI_ROWS_BEGIN _Pragma("unroll") for (int ai = 0; ai < 2; ++ai) _Pragma("unroll") for (int m = 0; m < 4; ++m) { const int rl = ai * 128 + wr * 64 + m * 16 + fr;
#define EPI_ROWS_END if (m & 1) asm volatile("" ::: "memory"); }
struct EpiG1 { static constexpr bool PERM = true; bf16* U; bf16* SLAB; unsigned char* GATES;
    __device__ __forceinline__ void operator()(const AccT& acc, const Unit& u, int wr, int wc, int fr, int fq) const {
        if (u.pn >= 31) {
            const int c0 = (u.pn - 31) * 256 + wc * 32 + 8 * fq;
            EPI_ROWS_BEGIN
                unsigned char* rowp = GATES + (size_t)(u.pm * 256 + rl) * 4096 + c0;
#pragma unroll
                for (int bj = 0; bj < 2; ++bj) { const f32x4 v0 = acc[ai][bj][m][0], v1 = acc[ai][bj][m][1]; unsigned p0 = 0u, p1 = 0u;
                    p0 = __builtin_amdgcn_cvt_pk_u8_f32(255.0f * sigmoidf_(v0[0]), 0, p0); p0 = __builtin_amdgcn_cvt_pk_u8_f32(255.0f * sigmoidf_(v0[1]), 1, p0);
                    p0 = __builtin_amdgcn_cvt_pk_u8_f32(255.0f * sigmoidf_(v0[2]), 2, p0); p0 = __builtin_amdgcn_cvt_pk_u8_f32(255.0f * sigmoidf_(v0[3]), 3, p0);
                    p1 = __builtin_amdgcn_cvt_pk_u8_f32(255.0f * sigmoidf_(v1[0]), 0, p1); p1 = __builtin_amdgcn_cvt_pk_u8_f32(255.0f * sigmoidf_(v1[1]), 1, p1);
                    p1 = __builtin_amdgcn_cvt_pk_u8_f32(255.0f * sigmoidf_(v1[2]), 2, p1); p1 = __builtin_amdgcn_cvt_pk_u8_f32(255.0f * sigmoidf_(v1[3]), 3, p1);
                    v2u w; w.x = p0; w.y = p1; *(v2u*)(rowp + bj * 128) = w; }
            EPI_ROWS_END
            return;
        }
        bf16* base; int ld, c0;
        if (u.pn < 4) { base = U; ld = 1024; c0 = u.pn * 256; } else { base = SLAB; ld = SLABLD; c0 = (u.pn - 4) * 256; }
        EPI_ROWS_BEGIN
            bf16* rowp = base + (size_t)(u.pm * 256 + rl) * ld + c0 + wc * 32 + 8 * fq;
#pragma unroll
            for (int bj = 0; bj < 2; ++bj) { const f32x4 v0 = acc[ai][bj][m][0], v1 = acc[ai][bj][m][1];
                v4u w; w.x = pk2(v0[0], v0[1]); w.y = pk2(v0[2], v0[3]); w.z = pk2(v1[0], v1[1]); w.w = pk2(v1[2], v1[3]); *(v4u*)(rowp + bj * 128) = w; }
        EPI_ROWS_END
    }
};
struct EpiLora { static constexpr bool PERM = true; unsigned short* EA; const float* w0; const float* a0;
    __device__ __forceinline__ void operator()(const AccT& acc, const Unit& u, int wr, int wc, int fr, int fq) const {
        const int rep = u.aux; const float* bias = (rep < 2 ? w0 + rep * D : a0 + (rep - 2) * D) + u.pn * 256 + wc * 32 + 8 * fq;
        unsigned short* base = EA + (size_t)rep * ((size_t)MT * D);
        if (rep < 2) { const float cc = -0.8750424f;
            EPI_ROWS_BEGIN
                unsigned short* rowp = base + (size_t)(u.pm * 256 + rl) * D + u.pn * 256 + wc * 32 + 8 * fq;
#pragma unroll
                for (int bj = 0; bj < 2; ++bj) { const f32x4 v0 = acc[ai][bj][m][0] + *(const f32x4*)(bias + bj * 128), v1 = acc[ai][bj][m][1] + *(const f32x4*)(bias + bj * 128 + 4);
                    v4u w; w.x = pkh2(cc * sigmoidf_(v0[0]), cc * sigmoidf_(v0[1])); w.y = pkh2(cc * sigmoidf_(v0[2]), cc * sigmoidf_(v0[3]));
                    w.z = pkh2(cc * sigmoidf_(v1[0]), cc * sigmoidf_(v1[1])); w.w = pkh2(cc * sigmoidf_(v1[2]), cc * sigmoidf_(v1[3]));
                    *(v4u*)(rowp + bj * 128) = w; }
            EPI_ROWS_END
        } else {
            EPI_ROWS_BEGIN
                unsigned char* rowp = (unsigned char*)base + (size_t)(u.pm * 256 + rl) * D + u.pn * 256 + wc * 32 + 8 * fq;
#pragma unroll
                for (int bj = 0; bj < 2; ++bj) { const f32x4 v0 = acc[ai][bj][m][0] + *(const f32x4*)(bias + bj * 128), v1 = acc[ai][bj][m][1] + *(const f32x4*)(bias + bj * 128 + 4); unsigned p0 = 0u, p1 = 0u;
                    p0 = __builtin_amdgcn_cvt_pk_u8_f32(255.0f * sigmoidf_(v0[0]), 0, p0); p0 = __builtin_amdgcn_cvt_pk_u8_f32(255.0f * sigmoidf_(v0[1]), 1, p0);
                    p0 = __builtin_amdgcn_cvt_pk_u8_f32(255.0f * sigmoidf_(v0[2]), 2, p0); p0 = __builtin_amdgcn_cvt_pk_u8_f32(255.0f * sigmoidf_(v0[3]), 3, p0);
                    p1 = __builtin_amdgcn_cvt_pk_u8_f32(255.0f * sigmoidf_(v1[0]), 0, p1); p1 = __builtin_amdgcn_cvt_pk_u8_f32(255.0f * sigmoidf_(v1[1]), 1, p1);
                    p1 = __builtin_amdgcn_cvt_pk_u8_f32(255.0f * sigmoidf_(v1[2]), 2, p1); p1 = __builtin_amdgcn_cvt_pk_u8_f32(255.0f * sigmoidf_(v1[3]), 3, p1);
                    v2u w; w.x = p0; w.y = p1; *(v2u*)(rowp + bj * 128) = w; }
            EPI_ROWS_END
        }
    }
};
struct EpiPoolG { static constexpr bool PERM = true; bf16* Y2; const float* scale;
    __device__ __forceinline__ void operator()(const AccT& acc, const Unit& u, int wr, int wc, int fr, int fq) const {
        const int cb = u.aux * 256 + wc * 32 + 8 * fq;
        f32x4 s0[2], s1[2];
#pragma unroll
        for (int bj = 0; bj < 2; ++bj) { s0[bj] = *(const f32x4*)(scale + cb + bj * 128); s1[bj] = *(const f32x4*)(scale + cb + bj * 128 + 4); }
        EPI_ROWS_BEGIN
            bf16* rowp = Y2 + (size_t)(u.pm * 256 + rl) * 1024 + cb;
#pragma unroll
            for (int bj = 0; bj < 2; ++bj) { const f32x4 v0 = acc[ai][bj][m][0] * s0[bj], v1 = acc[ai][bj][m][1] * s1[bj];
                v4u w; w.x = pk2(v0[0], v0[1]); w.y = pk2(v0[2], v0[3]); w.z = pk2(v1[0], v1[1]); w.w = pk2(v1[2], v1[3]); *(v4u*)(rowp + bj * 128) = w; }
        EPI_ROWS_END
    }
};
template <int MODE> struct EpiMix { static constexpr bool PERM = true; bf16* OUT; int ldo; const void* AUX1; int ld1; const bf16* AUX2; int ld2;
    __device__ __forceinline__ void operator()(const AccT& acc, const Unit& u, int wr, int wc, int fr, int fq) const {
        const int cb = u.pn * 256 + wc * 32 + 8 * fq;
        EPI_ROWS_BEGIN
            const size_t row = (size_t)(u.pm * 256 + rl);
#pragma unroll
            for (int bj = 0; bj < 2; ++bj) { const f32x4 v0 = acc[ai][bj][m][0], v1 = acc[ai][bj][m][1];
                float x[8];
                if (MODE == 1) { const v4u a1 = *(const v4u*)((const bf16*)AUX1 + row * ld1 + cb + bj * 128);
                    x[0] = bflo(a1.x); x[1] = bfhi(a1.x); x[2] = bflo(a1.y); x[3] = bfhi(a1.y); x[4] = bflo(a1.z); x[5] = bfhi(a1.z); x[6] = bflo(a1.w); x[7] = bfhi(a1.w); }
                else { const v2u a1 = *(const v2u*)((const unsigned char*)AUX1 + row * ld1 + cb + bj * 128); const float k = 1.0f / 255.0f;
                    x[0] = (float)(a1.x & 0xffu) * k; x[1] = (float)((a1.x >> 8) & 0xffu) * k; x[2] = (float)((a1.x >> 16) & 0xffu) * k; x[3] = (float)(a1.x >> 24) * k;
                    x[4] = (float)(a1.y & 0xffu) * k; x[5] = (float)((a1.y >> 8) & 0xffu) * k; x[6] = (float)((a1.y >> 16) & 0xffu) * k; x[7] = (float)(a1.y >> 24) * k; }
                float o[8];
                if (MODE == 0 || MODE == 1) {
#pragma unroll
                    for (int j = 0; j < 4; ++j) { o[j] = x[j] * v0[j]; o[4 + j] = x[4 + j] * v1[j]; } }
                else { const v4u a2 = *(const v4u*)(AUX2 + row * ld2 + cb + bj * 128);
                    const float y[8] = {bflo(a2.x), bfhi(a2.x), bflo(a2.y), bfhi(a2.y), bflo(a2.z), bfhi(a2.z), bflo(a2.w), bfhi(a2.w)};
#pragma unroll
                    for (int j = 0; j < 4; ++j) { o[j] = y[j] + x[j] * v0[j]; o[4 + j] = y[4 + j] + x[4 + j] * v1[j]; } }
                v4u w; w.x = pk2(o[0], o[1]); w.y = pk2(o[2], o[3]); w.z = pk2(o[4], o[5]); w.w = pk2(o[6], o[7]);
                *(v4u*)(OUT + row * ldo + cb + bj * 128) = w; }
        EPI_ROWS_END
    }
};
struct EpiX1 { static constexpr bool PERM = true; const float* X; bf16* OUT; const float* MOD;
    __device__ __forceinline__ void operator()(const AccT& acc, const Unit& u, int wr, int wc, int fr, int fq) const {
        const int b = u.pm >> 4;
        const int cb = u.pn * 256 + wc * 32 + 8 * fq; const float* g = MOD + (size_t)b * 12288 + 4096 + cb;
        f32x4 gv[2][2];
#pragma unroll
        for (int bj = 0; bj < 2; ++bj)
#pragma unroll
            for (int n = 0; n < 2; ++n) gv[bj][n] = *(const f32x4*)(g + bj * 128 + n * 4);
        EPI_ROWS_BEGIN
            const size_t off = (size_t)(u.pm * 256 + rl) * D + cb;
#pragma unroll
            for (int bj = 0; bj < 2; ++bj) { const f32x4 x0 = *(const f32x4*)(X + off + bj * 128), x1 = *(const f32x4*)(X + off + bj * 128 + 4);
                const f32x4 v0 = x0 + gv[bj][0] * acc[ai][bj][m][0], v1 = x1 + gv[bj][1] * acc[ai][bj][m][1];
                v4u w; w.x = pk2(v0[0], v0[1]); w.y = pk2(v0[2], v0[3]); w.z = pk2(v1[0], v1[1]); w.w = pk2(v1[2], v1[3]); *(v4u*)(OUT + off + bj * 128) = w; }
        EPI_ROWS_END
    }
};
constexpr float ACT_F8SCALE = 8.0f;
struct EpiAct { static constexpr bool PERM = true; unsigned char* ACT;
    __device__ __forceinline__ void operator()(const AccT& acc, const Unit& u, int wr, int wc, int fr, int fq) const {
        EPI_ROWS_BEGIN
            const f32x4 g0 = acc[ai][0][m][0], g1 = acc[ai][0][m][1], u0 = acc[ai][1][m][0], u1 = acc[ai][1][m][1];
            float o[8];
#pragma unroll
            for (int j = 0; j < 4; ++j) { o[j] = __builtin_amdgcn_fmed3f(ACT_F8SCALE * g0[j] * sigmoidf_(g0[j]) * u0[j], -440.f, 440.f); o[4 + j] = __builtin_amdgcn_fmed3f(ACT_F8SCALE * g1[j] * sigmoidf_(g1[j]) * u1[j], -440.f, 440.f); }
            v2u w; w.x = pk8(o[0], o[1], o[2], o[3]); w.y = pk8(o[4], o[5], o[6], o[7]);
            *(v2u*)(ACT + (size_t)(u.pm * 256 + rl) * DEXP + u.pn * 128 + wc * 32 + 8 * fq) = w;
        EPI_ROWS_END
    }
};
constexpr float YP_SCALE = 8.0f;
struct EpiDown { static constexpr bool PERM = true, PERM16 = true; unsigned char* YP;
    __device__ __forceinline__ void operator()(const AccT& acc, const Unit& u, int wr, int wc, int fr, int fq) const {
        const int cb = u.pn * 256 + wc * 64 + 16 * fq;
        EPI_ROWS_BEGIN
            int p[4];
#pragma unroll
            for (int bj = 0; bj < 2; ++bj) { const f32x4 v0 = acc[ai][bj][m][0] * YP_SCALE, v1 = acc[ai][bj][m][1] * YP_SCALE;
                int p0 = __builtin_amdgcn_cvt_pk_fp8_f32(v0[0], v0[1], 0, false); p0 = __builtin_amdgcn_cvt_pk_fp8_f32(v0[2], v0[3], p0, true);
                int p1 = __builtin_amdgcn_cvt_pk_fp8_f32(v1[0], v1[1], 0, false); p1 = __builtin_amdgcn_cvt_pk_fp8_f32(v1[2], v1[3], p1, true);
                p[2 * bj] = p0; p[2 * bj + 1] = p1; }
            v4u w; w.x = (unsigned)p[0]; w.y = (unsigned)p[1]; w.z = (unsigned)p[2]; w.w = (unsigned)p[3];
            *(v4u*)(YP + (size_t)(u.pm * 256 + rl) * D + cb) = w;
        EPI_ROWS_END
    }
};
struct Frame {
    LAS unsigned char* lds;
    volatile LAS unsigned* MISC;
    unsigned* ctl;
    int tid, lane, wave, vcu, G;
    unsigned char* ws;
};
struct Args { const float* in[34]; float* out; unsigned char* ws; int ph_lo, ph_hi; };
enum { I_X = 0, I_C, I_CTX, I_CCTX, I_N1G, I_N2G, I_ADAW, I_ADAB, I_WIN, I_MU, I_POOLW, I_POOLS, I_WPO, I_DW0, I_DW2, I_IA0, I_IA2, I_G2, I_KK, I_KA, I_RK, I_LNW, I_LNB,
       I_WRO, I_WO, I_RW, I_RB, I_EG, I_EU, I_ED, I_SG, I_SU, I_SD, I_FG };

struct TrJob { const float* src; bf16* dst; int ldw, kvalid, ldt, k0, n0, drow0; float f8; };
template <bool NT = false> __device__ __forceinline__ void tr_load(const TrJob& j, f32x4 (&v)[16], int lane) {
    const int r2 = lane >> 4, c4 = lane & 15;
#pragma unroll
    for (int i = 0; i < 8; ++i) {
#pragma unroll
        for (int h = 0; h < 2; ++h) { const int k = j.k0 + 8 * i + 2 * r2 + h; const int kc = k < j.kvalid ? k : 0;
            const f32x4* sp_ = (const f32x4*)(j.src + (size_t)kc * j.ldw + j.n0 + 4 * c4); const f32x4 x = NT ? __builtin_nontemporal_load(sp_) : *sp_; v[2 * i + h] = (k < j.kvalid) ? x : (f32x4){0.f, 0.f, 0.f, 0.f}; } }
}
template <bool NT = false> __device__ __forceinline__ void tr_store(const TrJob& j, const f32x4 (&v)[16], LAS unsigned* P, int lane) {
    const int r2 = lane >> 4, c4 = lane & 15;
#pragma unroll
    for (int i = 0; i < 8; ++i) { LAS unsigned* p = P + (4 * i + r2) * 65 + 4 * c4;
        p[0] = pk2(v[2 * i].x, v[2 * i + 1].x); p[1] = pk2(v[2 * i].y, v[2 * i + 1].y); p[2] = pk2(v[2 * i].z, v[2 * i + 1].z); p[3] = pk2(v[2 * i].w, v[2 * i + 1].w); }
    LDS_WAIT(); asm volatile("" ::: "memory");
    const int nl = lane >> 3, q = lane & 7;
#pragma unroll
    for (int jj = 0; jj < 8; ++jj) { const int n = 8 * jj + nl; const LAS unsigned* s = P + (4 * q) * 65 + n;
        v4u o; o.x = s[0]; o.y = s[65]; o.z = s[130]; o.w = s[195];
        v4u* dp_ = (v4u*)(j.dst + (size_t)(j.drow0 + n) * j.ldt + j.k0 + 8 * q); if (NT) __builtin_nontemporal_store(o, dp_); else *dp_ = o; }
    LDS_WAIT(); asm volatile("" ::: "memory");
}
template <bool NT = false> __device__ __forceinline__ void tr_load8(const TrJob& j, f32x4 (&v)[16], int lane) {
    const int r2 = lane >> 4, c4 = lane & 15;
#pragma unroll
    for (int i = 0; i < 4; ++i) {
#pragma unroll
        for (int h = 0; h < 4; ++h) { const int k = j.k0 + 16 * i + 4 * r2 + h; const f32x4* sp_ = (const f32x4*)(j.src + (size_t)k * j.ldw + j.n0 + 4 * c4); v[4 * i + h] = NT ? __builtin_nontemporal_load(sp_) : *sp_; } }
}
template <bool NT = false> __device__ __forceinline__ void tr_store8(const TrJob& j, const f32x4 (&v)[16], LAS unsigned* P, int lane) {
    const int r2 = lane >> 4, c4 = lane & 15; const float sc = j.f8;
#pragma unroll
    for (int i = 0; i < 4; ++i) { LAS unsigned* p = P + (4 * i + r2) * 65 + 4 * c4;
        p[0] = pk8(sc * v[4 * i].x, sc * v[4 * i + 1].x, sc * v[4 * i + 2].x, sc * v[4 * i + 3].x); p[1] = pk8(sc * v[4 * i].y, sc * v[4 * i + 1].y, sc * v[4 * i + 2].y, sc * v[4 * i + 3].y);
        p[2] = pk8(sc * v[4 * i].z, sc * v[4 * i + 1].z, sc * v[4 * i + 2].z, sc * v[4 * i + 3].z); p[3] = pk8(sc * v[4 * i].w, sc * v[4 * i + 1].w, sc * v[4 * i + 2].w, sc * v[4 * i + 3].w); }
    LDS_WAIT(); asm volatile("" ::: "memory");
    const int nl = lane >> 2, q = lane & 3;
#pragma unroll
    for (int jj = 0; jj < 4; ++jj) { const int n = 16 * jj + nl; const LAS unsigned* s = P + (4 * q) * 65 + n;
        v4u o; o.x = s[0]; o.y = s[65]; o.z = s[130]; o.w = s[195];
        v4u* dp_ = (v4u*)((unsigned char*)j.dst + (size_t)(j.drow0 + n) * j.ldt + j.k0 + 16 * q); if (NT) __builtin_nontemporal_store(o, dp_); else *dp_ = o; }
    LDS_WAIT(); asm volatile("" ::: "memory");
}
template <bool NT = false> __device__ __forceinline__ void tr_ld(const TrJob& j, f32x4 (&v)[16], int lane) { if (j.f8 != 0.f) tr_load8<NT>(j, v, lane); else tr_load<NT>(j, v, lane); }
template <bool NT = false> __device__ __forceinline__ void tr_st(const TrJob& j, const f32x4 (&v)[16], LAS unsigned* P, int lane) { if (j.f8 != 0.f) tr_store8<NT>(j, v, P, lane); else tr_store<NT>(j, v, P, lane); }
template <class Dec> __device__ __forceinline__ void tr_run(const Dec& dec, int first, int stride, LAS unsigned* P, int lane) {
    TrJob ja, jb; f32x4 va[16], vb[16];
    int it = first; bool ha = dec(it, ja); if (ha) tr_ld(ja, va, lane);
    while (ha) {
        it += stride; const bool hb = dec(it, jb); if (hb) tr_ld(jb, vb, lane);
        tr_st(ja, va, P, lane);
        if (!hb) break;
        it += stride; ha = dec(it, ja); if (ha) tr_ld(ja, va, lane);
        tr_st(jb, vb, P, lane);
    }
}
__device__ __forceinline__ void p0_prologue(Frame& F, const Args& a) {
    {
        LAS float* sv = (LAS float*)F.lds;
        LAS float* part = (LAS float*)(F.lds + 40960);
        bool did = false;
        for (int cb = blockIdx.x; cb < 192; cb += F.G) {
            if (!did) { for (int idx = F.tid; idx < 5 * D; idx += 512) { const int j = idx >> 11, k = idx & 2047; const float v = (j < 4) ? a.in[I_C][j * D + k] : a.in[I_CCTX][k]; sv[idx] = v / (1.0f + __expf(-v)); } did = true; }
            __syncthreads();
            const int col = 64 * cb + F.lane, k0 = 256 * F.wave; const float* wp = a.in[I_ADAW] + (size_t)k0 * 12288 + col;
            float acc[5] = {0.f, 0.f, 0.f, 0.f, 0.f};
#pragma unroll 32
            for (int k = 0; k < 256; ++k) { const float w = wp[(size_t)k * 12288];
#pragma unroll
                for (int j = 0; j < 5; ++j) acc[j] += sv[j * D + k0 + k] * w; }
#pragma unroll
            for (int j = 0; j < 5; ++j) part[(F.wave * 5 + j) * 64 + F.lane] = acc[j];
            __syncthreads();
            if (F.tid < 320) { const int j = F.tid >> 6, l = F.tid & 63; float s = a.in[I_ADAB][64 * cb + l];
#pragma unroll
                for (int w = 0; w < 8; ++w) s += part[(w * 5 + j) * 64 + l];
                ((float*)(F.ws + WS_MOD))[j * 12288 + 64 * cb + l] = s; }
            __syncthreads();
        }
        __syncthreads();
    }
    {
        struct DecSmall { const float* const* in; unsigned char* ws;
            __device__ __forceinline__ bool operator()(int it, TrJob& j) const {
                constexpr int I_1 = 32 * 186, I_2 = 4 * 16, I_3 = 16 * 32, I_4 = 4 * 32, I_5 = 32 * 32, I_6 = 32 * 32, I_7 = 4 * 2 * 32;
                int r = it; if (r < 0) return false;
                if (r < I_1) { const int kb = r / 186, nb = r % 186, n0 = nb * 64; j = TrJob{in[I_WIN], (bf16*)(ws + WS_WIN), DIN, D, D, kb * 64, n0, n0 + (n0 >= 7808 ? 128 : 0), P2_FP8 ? 8.0f : 0.0f}; return true; } r -= I_1;
                if (r < I_2) { const int g = r / 16, q = r % 16; j = TrJob{in[I_POOLW] + (size_t)g * 65536, (bf16*)(ws + WS_POOLW) + (size_t)g * 65536, 256, 256, 256, (q / 4) * 64, (q % 4) * 64, (q % 4) * 64}; return true; } r -= I_2;
                if (r < I_3) { j = TrJob{in[I_WPO], (bf16*)(ws + WS_WPO), D, 1024, 1024, (r / 32) * 64, (r % 32) * 64, (r % 32) * 64}; return true; } r -= I_3;
                if (r < I_4) { j = TrJob{in[I_G2], (bf16*)(ws + WS_G2), D, 256, 256, (r / 32) * 64, (r % 32) * 64, (r % 32) * 64}; return true; } r -= I_4;
                if (r < I_5) { j = TrJob{in[I_WRO], (bf16*)(ws + WS_WRO), D, D, D, (r / 32) * 64, (r % 32) * 64, (r % 32) * 64}; return true; } r -= I_5;
                if (r < I_6) { j = TrJob{in[I_WO], (bf16*)(ws + WS_WO), D, D, D, (r / 32) * 64, (r % 32) * 64, (r % 32) * 64}; return true; } r -= I_6;
                if (r < I_7) { const int mtx = r / 64, q = r % 64;
                    const float* src = (mtx < 2 ? in[I_DW2] + (size_t)mtx * 96 * D : in[I_IA2] + (size_t)(mtx - 2) * 96 * D);
                    j = TrJob{src, (bf16*)(ws + WS_LORA) + (size_t)mtx * D * 128, D, 96, 128, (q / 32) * 64, (q % 32) * 64, (q % 32) * 64}; return true; }
                return false; } };
        DecSmall dec{a.in, F.ws};
        tr_run(dec, F.vcu * 8 + F.wave, F.G * 8, (LAS unsigned*)(F.lds + F.wave * 16384), F.lane);
    }
    const int gt = F.vcu * 512 + F.tid, NGT = F.G * 512;
    { v4u* z = (v4u*)(F.ws + WS_WIN + (size_t)7808 * D * (P2_FP8 ? 1 : 2)); for (int i = gt; i < 128 * D / (P2_FP8 ? 16 : 8); i += NGT) z[i] = (v4u){0u, 0u, 0u, 0u}; }
    { int* tok = (int*)(F.ws + WS_TOK); for (int i = gt; i < NSLOT; i += NGT) tok[i] = 0; }
}

__device__ __forceinline__ void p1_norm1(Frame& F, const Args& a) {
    const int gw = F.vcu * 8 + F.wave, NGW = F.G * 8; const float* MOD = (const float*)(F.ws + WS_MOD); bf16* HA = (bf16*)(F.ws + WS_HA);
    for (int mrow = gw; mrow < MT; mrow += NGW) {
        const float* src = (mrow < NT) ? a.in[I_X] + (size_t)mrow * D : a.in[I_CTX] + (size_t)(mrow - NT) * D; const int j = (mrow < NT) ? (mrow >> 12) : 4;
        const f32x4* xr = (const f32x4*)src + F.lane; f32x4 v[8]; float s = 0.f;
#pragma unroll
        for (int q = 0; q < 8; ++q) { v[q] = xr[64 * q]; s += (v[q].x * v[q].x + v[q].y * v[q].y) + (v[q].z * v[q].z + v[q].w * v[q].w); }
        const float rstd = 1.0f / sqrtf(wave_sum(s) * (1.0f / D) + 1e-6f);
        const f32x4* g = (const f32x4*)a.in[I_N1G] + F.lane; const f32x4* sh = (const f32x4*)(MOD + (size_t)j * 12288) + F.lane; const f32x4* sc = (const f32x4*)(MOD + (size_t)j * 12288 + 2048) + F.lane;
        v2u* o = (v2u*)(HA + (size_t)mrow * D) + F.lane; unsigned* o8 = (unsigned*)((unsigned char*)HA + (size_t)mrow * D) + F.lane;
#pragma unroll
        for (int q = 0; q < 8; ++q) { const f32x4 y = v[q] * rstd * g[64 * q] * (sc[64 * q] + 1.0f) + sh[64 * q];
            if (P2_FP8) o8[64 * q] = pk8(8.0f * y.x, 8.0f * y.y, 8.0f * y.z, 8.0f * y.w); else { v2u w; w.x = pk2(y.x, y.y); w.y = pk2(y.z, y.w); o[64 * q] = w; } }
    }
}

template <int W> __device__ __forceinline__ void pool_item(const unsigned* U32, unsigned* DP32, int m0, int cp) {
    unsigned raw[64];
#pragma unroll
    for (int x = 0; x < 64; ++x) raw[x] = U32[(size_t)(m0 + x) * 512 + cp];
    float lo[64], hi[64];
#pragma unroll
    for (int x = 0; x < 64; ++x) { lo[x] = bflo(raw[x]); hi[x] = bfhi(raw[x]); }
#pragma unroll
    for (int x = 0; x < 64; ++x) { const int l = (x - W / 2) < 0 ? 0 : (x - W / 2), h = (x + W / 2) > 64 ? 64 : (x + W / 2); float s0 = 0.f, s1 = 0.f;
#pragma unroll
        for (int j = l; j < h; ++j) { s0 += lo[j]; s1 += hi[j]; }
        const float inv = 1.0f / (float)(h - l); DP32[(size_t)(m0 + x) * 512 + cp] = pk2(s0 * inv - lo[x], s1 * inv - hi[x]); }
}
__device__ __forceinline__ void p3_mix_store(const v4u o, const v4u nb, const f32x4 m0, const f32x4 m1, int c0, int mrow, bf16* RM, bf16* KM, bf16* VM, bf16* LIN) {
    float r[8];
    { const float ov[8] = {bflo(o.x), bfhi(o.x), bflo(o.y), bfhi(o.y), bflo(o.z), bfhi(o.z), bflo(o.w), bfhi(o.w)};
      const float nv[8] = {bflo(nb.x), bfhi(nb.x), bflo(nb.y), bfhi(nb.y), bflo(nb.z), bfhi(nb.z), bflo(nb.w), bfhi(nb.w)};
      const float mv[8] = {m0.x, m0.y, m0.z, m0.w, m1.x, m1.y, m1.z, m1.w};
#pragma unroll
      for (int e = 0; e < 8; ++e) r[e] = ov[e] + (nv[e] - ov[e]) * mv[e]; }
    bf16* dstp;
    if (c0 < 2048) dstp = RM + (size_t)mrow * D + c0;
    else if (c0 < 4096) dstp = KM + (size_t)mrow * D + (c0 - 2048);
    else if (c0 < 6144) dstp = VM + (size_t)mrow * D + (c0 - 4096);
    else { const int lc = c0 - 6144; int dc;
        if (lc < 192) {
#pragma unroll
            for (int e = 0; e < 8; ++e) r[e] = tanhf_(r[e]);
            dc = (lc < 96) ? lc : 128 + (lc - 96); }
        else if (lc < 384) dc = (lc < 288) ? 256 + (lc - 192) : 384 + (lc - 288);
        else {
#pragma unroll
            for (int e = 0; e < 8; ++e) r[e] = sigmoidf_(r[e]);
            dc = 512 + (lc - 384); }
        dstp = LIN + (size_t)mrow * LINLD + dc; }
    v4u w; w.x = pk2(r[0], r[1]); w.y = pk2(r[2], r[3]); w.z = pk2(r[4], r[5]); w.w = pk2(r[6], r[7]); *(v4u*)dstp = w;
}
constexpr int P3_SLICE = 512, P3_NSLICE = (DSH + P3_SLICE - 1) / P3_SLICE  , P3_SLOTS = 96;
__device__ __forceinline__ void p3_prep(Frame& F, const Args& a) {
    const bf16* SLAB = (const bf16*)(F.ws + WS_SLAB); const float* mu = a.in[I_MU];
    bf16* RM = (bf16*)(F.ws + WS_RM); bf16* KM = (bf16*)(F.ws + WS_KM); bf16* VM = (bf16*)(F.ws + WS_VM); bf16* LIN = (bf16*)(F.ws + WS_LIN);
    LAS unsigned char* T = F.lds;
    const int w = F.wave, lane = F.lane;
    for (int pid = F.vcu; pid < NB * 64; pid += F.G) {
        const int b = pid >> 6, py = (pid >> 3) & 7, px = pid & 7; const int m00 = b * TSEQ + (py * 8) * 64 + px * 8;
        int srow[12];
#pragma unroll
        for (int i = 0; i < 12; ++i) { const int sl = w * 12 + i; int gyl, gxl; bool ok = true;
            if (sl < 64) { gyl = sl >> 3; gxl = sl & 7; } else if (sl < 72) { gyl = -1; gxl = sl - 64; ok = py > 0; } else if (sl < 80) { gyl = 8; gxl = sl - 72; ok = py < 7; }
            else if (sl < 88) { gyl = sl - 80; gxl = -1; ok = px > 0; } else { gyl = sl - 88; gxl = 8; ok = px < 7; }
            srow[i] = ok ? m00 + gyl * 64 + gxl : m00; }
        v4u pre[12];
        { const int cl = lane * 8;
#pragma unroll
          for (int i = 0; i < 12; ++i) pre[i] = *(const v4u*)(SLAB + (size_t)srow[i] * SLABLD + cl); }
        for (int sl_ = 0; sl_ < P3_NSLICE; ++sl_) {
            const int c0 = sl_ * P3_SLICE + lane * 8; const bool cok = c0 < DSH;
            __syncthreads();
#pragma unroll
            for (int i = 0; i < 12; ++i) *(LAS v4u*)(T + (w * 12 + i) * 1024 + lane * 16) = pre[i];
            if (sl_ + 1 < P3_NSLICE) { const int cn = (sl_ + 1) * P3_SLICE + lane * 8; const int cl = cn < DSH ? cn : 0;
#pragma unroll
                for (int i = 0; i < 12; ++i) pre[i] = *(const v4u*)(SLAB + (size_t)srow[i] * SLABLD + cl); }
            __syncthreads();
            const f32x4 m0 = *(const f32x4*)(mu + (cok ? c0 : 0)), m1 = *(const f32x4*)(mu + (cok ? c0 : 0) + 4);
            const int gy = py * 8 + w; const unsigned k2m = gy > 0 ? 0xffffu : 0u, k3m = gy < 63 ? 0xffff0000u : 0u;
#pragma unroll
            for (int x = 0; x < 8; ++x) {
                const int gx = px * 8 + x; const unsigned k0m = gx > 0 ? 0xffffu : 0u, k1m = gx < 63 ? 0xffff0000u : 0u;
                const int so = w * 8 + x, sL = x > 0 ? so - 1 : 80 + w, sR = x < 7 ? so + 1 : 88 + w, sU = w > 0 ? so - 8 : 64 + x, sD = w < 7 ? so + 8 : 72 + x;
                const v4u o = *(const LAS v4u*)(T + so * 1024 + lane * 16), n0 = *(const LAS v4u*)(T + sL * 1024 + lane * 16), n1 = *(const LAS v4u*)(T + sR * 1024 + lane * 16),
                          n2 = *(const LAS v4u*)(T + sU * 1024 + lane * 16), n3 = *(const LAS v4u*)(T + sD * 1024 + lane * 16);
                v4u nb; nb.x = (n0.x & k0m) | (n1.x & k1m); nb.y = (n2.y & k2m) | (n3.y & k3m); nb.z = (n0.z & k0m) | (n1.z & k1m); nb.w = (n2.w & k2m) | (n3.w & k3m);
                const int mrow = m00 + w * 64 + x;
                if (cok) p3_mix_store(o, nb, m0, m1, c0, mrow, RM, KM, VM, LIN);
                if (sl_ == P3_NSLICE - 1 && lane >= 48) { const int l16 = lane - 48, p = l16 >> 2, off = (l16 & 3) * 8; *(v4u*)(LIN + (size_t)mrow * LINLD + 128 * p + 96 + off) = (v4u){0u, 0u, 0u, 0u}; }
            }
        }
        __syncthreads();
    }
    const int gw = F.vcu * 8 + F.wave, NGW = F.G * 8;
    for (int mrow = NT + gw; mrow < MT; mrow += NGW) {
        const bf16* own = SLAB + (size_t)mrow * SLABLD; const int sidx = (mrow - NT) & 255; const bool v0 = sidx > 0, v1 = sidx < 255;
        const bf16* p0 = v0 ? own - SLABLD : own; const bf16* p1 = v1 ? own + SLABLD : own;
        const unsigned k0m = v0 ? 0xffffu : 0u, k1m = v1 ? 0xffff0000u : 0u;
        for (int ci0 = F.lane; ci0 < DSH / 8; ci0 += 256) {
            v4u o[4], nb[4]; f32x4 m0[4], m1[4];
#pragma unroll
            for (int u = 0; u < 4; ++u) { const int ci = ci0 + 64 * u; const int c0 = (ci < DSH / 8 ? ci : F.lane) * 8;
                o[u] = *(const v4u*)(own + c0); const v4u n0 = *(const v4u*)(p0 + c0), n1 = *(const v4u*)(p1 + c0);
                nb[u].x = (n0.x & k0m) | (n1.x & k1m); nb[u].y = (n0.y & k0m) | (n1.y & k1m); nb[u].z = (n0.z & k0m) | (n1.z & k1m); nb[u].w = (n0.w & k0m) | (n1.w & k1m);
                m0[u] = *(const f32x4*)(mu + c0); m1[u] = *(const f32x4*)(mu + c0 + 4); }
#pragma unroll
            for (int u = 0; u < 4; ++u) { const int ci = ci0 + 64 * u; if (ci < DSH / 8) p3_mix_store(o[u], nb[u], m0[u], m1[u], ci * 8, mrow, RM, KM, VM, LIN); }
        }
        if (F.lane < 16) { const int p = F.lane >> 2, off = (F.lane & 3) * 8; *(v4u*)(LIN + (size_t)mrow * LINLD + 128 * p + 96 + off) = (v4u){0u, 0u, 0u, 0u}; }
    }
    const unsigned* U32 = (const unsigned*)(F.ws + WS_U); unsigned* DP32 = (unsigned*)(F.ws + WS_DP);
    for (int gr = F.vcu; gr < 256; gr += F.G) {
        const int m0 = gr * 64, cp = F.tid; const int g = F.wave >> 1;
        if (g == 0) pool_item<2>(U32, DP32, m0, cp); else if (g == 1) pool_item<4>(U32, DP32, m0, cp); else if (g == 2) pool_item<8>(U32, DP32, m0, cp); else pool_item<16>(U32, DP32, m0, cp);
    }
}

constexpr int CK = 16, NSL = 8;
constexpr int SL_Z = 0, SL_AF = 2560, SL_TMT = 3584, SL_ABF = 4096, SL_TM = 4608, SL_ZTT = 5120, SL_RT = 7680, SL_CRT = 9728, SL_ART = 10240, SL_BGT = 10752, SL_KGT = 12800, SL_VT = 14848, SL_GC = 16896,
              SL_SIZE = 17152, ZTT_LD = 80, SB_OFF = 7 * SL_SIZE  , SL7_OFF = 132096  ;
static_assert(SB_OFF + 8192 <= 131072 && SL7_OFF + SL_SIZE <= 163840, "scan LDS map");
__device__ __forceinline__ int kpos(int zt, int q) { return 32 * (zt >> 1) + 8 * q + 4 * (zt & 1); }
__device__ __forceinline__ int slot_off(int n) { return n < 7 ? n * SL_SIZE : SL7_OFF; }
__device__ __forceinline__ int sw64(int row, int col) { return (row * 64 + ((((col >> 3) ^ (row & 7)) << 3) | (col & 7))) * 2; }
__device__ __forceinline__ int scan_row(int n, int b, int dir) {
    if (n < CTXL) return NT + b * CTXL + (dir ? (CTXL - 1 - n) : n);
    const int t = n - CTXL; return b * TSEQ + (dir ? (TSEQ - 1 - t) : t);
}
__device__ __forceinline__ bf16x8 frag_ld(const LAS unsigned char* p, bool ok) { v4u z = (v4u){0u, 0u, 0u, 0u}; if (ok) z = *(const LAS v4u*)p; return __builtin_bit_cast(bf16x8, z); }
__device__ __forceinline__ f32x4 mfma16(bf16x8 a, bf16x8 b, f32x4 c) { return __builtin_amdgcn_mfma_f32_16x16x32_bf16(a, b, c, 0, 0, 0); }
__device__ __forceinline__ float dpp_shr(float v, const int n, float fill) {
    const int x = __builtin_bit_cast(int, v), f = __builtin_bit_cast(int, fill); int r;
    if (n == 1) r = __builtin_amdgcn_update_dpp(f, x, 0x111, 0xF, 0xF, false); else if (n == 2) r = __builtin_amdgcn_update_dpp(f, x, 0x112, 0xF, 0xF, false);
    else if (n == 4) r = __builtin_amdgcn_update_dpp(f, x, 0x114, 0xF, 0xF, false); else r = __builtin_amdgcn_update_dpp(f, x, 0x118, 0xF, 0xF, false);
    return __builtin_bit_cast(float, r);
}
struct SeqOps { bf16x8 fV, fZc, fZk[2], fR[2], fCr, fAr4, fKG[4], fBG4[4]; f32x4 gc[4]; };
__device__ __forceinline__ bf16x8 frag4_ld(const LAS unsigned char* p) { const v2u t = *(const LAS v2u*)p; v4u z; z.x = t.x; z.y = t.y; z.z = 0u; z.w = 0u; return __builtin_bit_cast(bf16x8, z); }
__device__ __forceinline__ void seq_load(SeqOps& o, const LAS unsigned char* SL, int w, int c, int q, bool klo) {
    o.fV = frag_ld(SL + SL_VT + ((16 * w + c) * 16 + 8 * q) * 2, klo);
    o.fZc = frag_ld(SL + SL_ZTT + (c * ZTT_LD + 64 + 8 * q) * 2, klo); o.fCr = frag_ld(SL + SL_CRT + (c * 16 + 8 * q) * 2, klo); o.fAr4 = frag4_ld(SL + SL_ART + (c * 16 + 4 * q) * 2);
#pragma unroll
    for (int ks = 0; ks < 2; ++ks) { o.fZk[ks] = frag_ld(SL + SL_ZTT + (c * ZTT_LD + 32 * ks + 8 * q) * 2, true); o.fR[ks] = frag_ld(SL + SL_RT + sw64(c, 32 * ks + 8 * q), true); }
#pragma unroll
    for (int jt = 0; jt < 4; ++jt) { o.fKG[jt] = frag_ld(SL + SL_KGT + ((16 * jt + c) * 16 + 8 * q) * 2, klo); o.fBG4[jt] = frag4_ld(SL + SL_BGT + ((16 * jt + c) * 16 + 4 * q) * 2);
        o.gc[jt] = *(const LAS f32x4*)(SL + SL_GC + (16 * jt + 4 * q) * 4); }
}
__device__ __forceinline__ void seq_step(const SeqOps& o, f32x4 (&X)[4], bool emit, bf16* YO, int chunk, int b, int dir, int h, int w, int c, int q) {
    const f32x4 z4 = (f32x4){0.f, 0.f, 0.f, 0.f};
    bf16x8 fS[2];
#pragma unroll
    for (int ks = 0; ks < 2; ++ks) { v4u p; p.x = pk2(X[2 * ks][0], X[2 * ks][1]); p.y = pk2(X[2 * ks][2], X[2 * ks][3]); p.z = pk2(X[2 * ks + 1][0], X[2 * ks + 1][1]); p.w = pk2(X[2 * ks + 1][2], X[2 * ks + 1][3]);
        fS[ks] = __builtin_bit_cast(bf16x8, p); }
    f32x4 un = mfma16(o.fZc, o.fV, z4);
#pragma unroll
    for (int ks = 0; ks < 2; ++ks) un = mfma16(o.fZk[ks], fS[ks], un);
    bf16x8 fU; { v4u p; p.x = pk2(un[0], un[1]); p.y = pk2(un[2], un[3]); p.z = 0u; p.w = 0u; fU = __builtin_bit_cast(bf16x8, p); }
    if (emit) {
        f32x4 y = mfma16(o.fCr, o.fV, z4); y = mfma16(o.fAr4, fU, y);
#pragma unroll
        for (int ks = 0; ks < 2; ++ks) y = mfma16(o.fR[ks], fS[ks], y);
#pragma unroll
        for (int g = 0; g < 4; ++g) YO[(size_t)scan_row(chunk * CK + 4 * q + g, b, dir) * D + h * 64 + 16 * w + c] = (bf16)f2bf(y[g]);
    }
#pragma unroll
    for (int jt = 0; jt < 4; ++jt) { const f32x4 d = mfma16(o.fBG4[jt], fU, mfma16(o.fKG[jt], o.fV, z4));
        X[jt] = X[jt] * o.gc[jt] + d; }
}
struct ScanRaw { v4u r[2], k[2], v[2], e[2]; v2u a[2]; };
__device__ __forceinline__ void scan_fetch(ScanRaw& R, const bf16* RM, const bf16* KM, const bf16* VM, const unsigned char* AX, const unsigned short* EX, size_t rowoff) {
#pragma unroll
    for (int ks = 0; ks < 2; ++ks) { const size_t off = rowoff + 32 * ks; R.r[ks] = *(const v4u*)(RM + off); R.k[ks] = *(const v4u*)(KM + off); R.v[ks] = *(const v4u*)(VM + off); R.a[ks] = *(const v2u*)(AX + off); R.e[ks] = *(const v4u*)(EX + off); }
}
__device__ __forceinline__ void p6_scan(Frame& F, const Args& a) {
    const bf16* RM = (const bf16*)(F.ws + WS_RM); const bf16* KM = (const bf16*)(F.ws + WS_KM); const bf16* VM = (const bf16*)(F.ws + WS_VM);
    const int lane = F.lane, w = F.wave, c0_ = lane & 15, q0_ = lane >> 4;
    for (int unit = blockIdx.x; unit < NB * NH * 2; unit += F.G) {
        const int dir = unit & 1, h = (unit >> 1) & 31, b = unit >> 6;
        const unsigned short* EX = (const unsigned short*)(F.ws + WS_EA + (size_t)dir * EA_STRIDE);
        const unsigned char* AX = (const unsigned char*)(F.ws + WS_EA + (size_t)(2 + dir) * EA_STRIDE);
        bf16* YO = (bf16*)(F.ws + (dir ? WS_YB : WS_YF)); float* BON = (float*)(F.ws + WS_BON) + (size_t)dir * NT * NH;
        f32x4 X[4];
#pragma unroll
        for (int jt = 0; jt < 4; ++jt) X[jt] = (f32x4){0.f, 0.f, 0.f, 0.f};
        constexpr int NBATCH = (CTXL + TSEQ) / CK / NSL;
        { LAS float* cst = (LAS float*)(F.lds + SB_OFF);
          if (F.tid < 192) { const int which = F.tid >> 6, j = F.tid & 63; cst[F.tid] = (which == 0 ? a.in[I_KK] : which == 1 ? a.in[I_KA] : a.in[I_RK])[h * 64 + j]; } }
        ScanRaw R; scan_fetch(R, RM, KM, VM, AX, EX, (size_t)scan_row(w * CK + c0_, b, dir) * D + h * 64 + 8 * q0_);
        __syncthreads();
        for (int bt = 0; bt < NBATCH; ++bt) {
            int c = c0_, q = q0_; asm volatile("" : "+v"(c), "+v"(q));
            const bool klo = q < 2;
            {
                LAS unsigned char* SL = F.lds + slot_off(w);
                int cq8 = 8 * q; asm volatile("" : "+v"(cq8));
                const LAS float* cst = (const LAS float*)(F.lds + SB_OFF) + cq8;
                float ss = 0.f;
#pragma unroll
                for (int ks = 0; ks < 2; ++ks) {
                    const f32x4 k0 = *(const LAS f32x4*)(cst + 32 * ks), k1 = *(const LAS f32x4*)(cst + 32 * ks + 4);
                    const float kv[8] = {bflo(R.k[ks].x), bfhi(R.k[ks].x), bflo(R.k[ks].y), bfhi(R.k[ks].y), bflo(R.k[ks].z), bfhi(R.k[ks].z), bflo(R.k[ks].w), bfhi(R.k[ks].w)};
#pragma unroll
                    for (int e = 0; e < 4; ++e) { const float p0 = kv[e] * k0[e], p1 = kv[4 + e] * k1[e]; ss += p0 * p0 + p1 * p1; } }
                ss += __shfl_xor(ss, 16); ss += __shfl_xor(ss, 32);
                const float inv = __builtin_amdgcn_rsqf(ss + 1e-12f);
                bf16x8 fKT[2], fRT[2], fBT[2], fKQ[2]; float bonp = 0.f;
#pragma unroll
                for (int ks = 0; ks < 2; ++ks) {
                    const v4u xr = R.r[ks], xk = R.k[ks], xv = R.v[ks], xe = R.e[ks]; const v2u xa = R.a[ks];
                    const f32x4 k0 = *(const LAS f32x4*)(cst + 32 * ks), k1 = *(const LAS f32x4*)(cst + 32 * ks + 4), a0 = *(const LAS f32x4*)(cst + 64 + 32 * ks), a1 = *(const LAS f32x4*)(cst + 64 + 32 * ks + 4);
                    const float kkw[8] = {k0[0], k0[1], k0[2], k0[3], k1[0], k1[1], k1[2], k1[3]}, kaw[8] = {a0[0], a0[1], a0[2], a0[3], a1[0], a1[1], a1[2], a1[3]};
                    const f32x4 q0 = *(const LAS f32x4*)(cst + 128 + 32 * ks), q1 = *(const LAS f32x4*)(cst + 128 + 32 * ks + 4); const float rkw[8] = {q0[0], q0[1], q0[2], q0[3], q1[0], q1[1], q1[2], q1[3]};
                    const float r[8] = {bflo(xr.x), bfhi(xr.x), bflo(xr.y), bfhi(xr.y), bflo(xr.z), bfhi(xr.z), bflo(xr.w), bfhi(xr.w)};
                    const float k[8] = {bflo(xk.x), bfhi(xk.x), bflo(xk.y), bfhi(xk.y), bflo(xk.z), bfhi(xk.z), bflo(xk.w), bfhi(xk.w)};
                    const float v[8] = {bflo(xv.x), bfhi(xv.x), bflo(xv.y), bfhi(xv.y), bflo(xv.z), bfhi(xv.z), bflo(xv.w), bfhi(xv.w)};
                    const float ku8 = 1.0f / 255.0f;
                    const float ai[8] = {(float)(xa.x & 0xffu) * ku8, (float)((xa.x >> 8) & 0xffu) * ku8, (float)((xa.x >> 16) & 0xffu) * ku8, (float)(xa.x >> 24) * ku8,
                                         (float)(xa.y & 0xffu) * ku8, (float)((xa.y >> 8) & 0xffu) * ku8, (float)((xa.y >> 16) & 0xffu) * ku8, (float)(xa.y >> 24) * ku8};
                    const float lw[8] = {hlo(xe.x), hhi(xe.x), hlo(xe.y), hhi(xe.y), hlo(xe.z), hhi(xe.z), hlo(xe.w), hhi(xe.w)};
                    float kt[8], rt[8], btl[8], kq[8], cl[8], G[8], Gi[8], Gm[8], GCv[8];
#pragma unroll
                    for (int e = 0; e < 8; ++e) cl[e] = lw[e];
#pragma unroll
                    for (int e = 0; e < 8; ++e) cl[e] += dpp_shr(cl[e], 1, 0.f);
#pragma unroll
                    for (int e = 0; e < 8; ++e) cl[e] += dpp_shr(cl[e], 2, 0.f);
#pragma unroll
                    for (int e = 0; e < 8; ++e) cl[e] += dpp_shr(cl[e], 4, 0.f);
#pragma unroll
                    for (int e = 0; e < 8; ++e) cl[e] += dpp_shr(cl[e], 8, 0.f);
#pragma unroll
                    for (int e = 0; e < 8; ++e) { G[e] = __builtin_amdgcn_exp2f(cl[e]); Gi[e] = __builtin_amdgcn_exp2f(-cl[e]); }
#pragma unroll
                    for (int e = 0; e < 8; ++e) { Gm[e] = dpp_shr(G[e], 1, 1.0f); GCv[e] = __shfl(G[e], (lane & 48) | 15); }
#pragma unroll
                    for (int e = 0; e < 8; ++e) {
                        const float kke = k[e] * kkw[e] * inv, kd = k[e] * ((ai[e] - 1.0f) * kaw[e] + 1.0f), bb = kke * ai[e], ratio = GCv[e] * Gi[e];
                        kt[e] = Gm[e] * kke; rt[e] = G[e] * r[e]; btl[e] = bb * Gi[e]; kq[e] = kd * Gi[e];
                        bonp += r[e] * kd * rkw[e];
                        const int j = 32 * ks + 8 * q + e;
                        const unsigned w0 = pk2(kt[e], bb * ratio), w1 = pk2(kd * ratio, v[e]);
                        ((LAS bf16*)(SL + SL_Z))[j * 16 + c] = (bf16)(w0 & 0xffffu); ((LAS bf16*)(SL + SL_BGT))[j * 16 + c] = (bf16)(w0 >> 16);
                        ((LAS bf16*)(SL + SL_KGT))[j * 16 + c] = (bf16)(w1 & 0xffffu); ((LAS bf16*)(SL + SL_VT))[j * 16 + c] = (bf16)(w1 >> 16);
                    }
                    if (c == 15) { *(LAS f32x4*)(SL + SL_GC + (32 * ks + 8 * q) * 4) = (f32x4){G[0], G[1], G[2], G[3]}; *(LAS f32x4*)(SL + SL_GC + (32 * ks + 8 * q + 4) * 4) = (f32x4){G[4], G[5], G[6], G[7]}; }
                    v4u p; p.x = pk2(kt[0], kt[1]); p.y = pk2(kt[2], kt[3]); p.z = pk2(kt[4], kt[5]); p.w = pk2(kt[6], kt[7]); fKT[ks] = __builtin_bit_cast(bf16x8, p);
                    p.x = pk2(rt[0], rt[1]); p.y = pk2(rt[2], rt[3]); p.z = pk2(rt[4], rt[5]); p.w = pk2(rt[6], rt[7]); fRT[ks] = __builtin_bit_cast(bf16x8, p);
                    { v2u p0; p0.x = p.x; p0.y = p.y; v2u p1; p1.x = p.z; p1.y = p.w; const int pp = 32 * ks + 16 * (q & 1) + 4 * (q >> 1);
                      *(LAS v2u*)(SL + SL_RT + sw64(c, pp)) = p0; *(LAS v2u*)(SL + SL_RT + sw64(c, pp + 8)) = p1; }
                    p.x = pk2(btl[0], btl[1]); p.y = pk2(btl[2], btl[3]); p.z = pk2(btl[4], btl[5]); p.w = pk2(btl[6], btl[7]); fBT[ks] = __builtin_bit_cast(bf16x8, p);
                    p.x = pk2(kq[0], kq[1]); p.y = pk2(kq[2], kq[3]); p.z = pk2(kq[4], kq[5]); p.w = pk2(kq[6], kq[7]); fKQ[ks] = __builtin_bit_cast(bf16x8, p);
                    asm volatile("" ::: "memory");
                }
                bonp += __shfl_xor(bonp, 16); bonp += __shfl_xor(bonp, 32);
                if (q == 0 && (NSL * bt + w) * CK >= CTXL) BON[(size_t)scan_row((NSL * bt + w) * CK + c, b, dir) * NH + h] = bonp;
                const f32x4 z4 = (f32x4){0.f, 0.f, 0.f, 0.f};
                f32x4 accA = mfma16(fBT[1], fKT[1], mfma16(fBT[0], fKT[0], z4)), accAr = mfma16(fBT[1], fRT[1], mfma16(fBT[0], fRT[0], z4));
                f32x4 accCm = mfma16(fKQ[1], fKT[1], mfma16(fKQ[0], fKT[0], z4)), accCr = mfma16(fKQ[1], fRT[1], mfma16(fKQ[0], fRT[0], z4));
#pragma unroll
                for (int g = 0; g < 4; ++g) { const int srow = 4 * q + g; const bool lt = srow < c, le = srow <= c;
                    accA[g] = lt ? accA[g] : 0.f; accAr[g] = le ? accAr[g] : 0.f; accCm[g] = lt ? accCm[g] : 0.f; accCr[g] = le ? accCr[g] : 0.f;
                    ((LAS float*)(SL + SL_AF))[srow * 16 + c] = accA[g]; ((LAS bf16*)(SL + SL_ABF))[srow * 16 + c] = (bf16)f2bf(accA[g]); ((LAS bf16*)(SL + SL_Z))[(64 + srow) * 16 + c] = (bf16)f2bf(accCm[g]); }
                { v2u p; p.x = pk2(accAr[0], accAr[1]); p.y = pk2(accAr[2], accAr[3]); *(LAS v2u*)(SL + SL_ART + (c * 16 + 4 * q) * 2) = p; }
                { v2u p; p.x = pk2(accCr[0], accCr[1]); p.y = pk2(accCr[2], accCr[3]); *(LAS v2u*)(SL + SL_CRT + (c * 16 + 4 * q) * 2) = p; }
                LDS_WAIT(); asm volatile("" ::: "memory");
                {
                    const int base = c & 8, cl = c & 7; float x[8];
#pragma unroll
                    for (int sr = 7; sr >= 0; --sr) { float acc = 0.f;
#pragma unroll
                        for (int m = sr + 1; m < 8; ++m) acc += ((const LAS float*)(SL + SL_AF))[(base + sr) * 16 + base + m] * x[m];
                        x[sr] = (sr < cl) ? -acc : ((sr == cl) ? -1.0f : 0.f); }
                    if (q == 0) { v4u px; px.x = pk2(x[0], x[1]); px.y = pk2(x[2], x[3]); px.z = pk2(x[4], x[5]); px.w = pk2(x[6], x[7]);
                        *(LAS v4u*)(SL + SL_TMT + (c * 16 + base) * 2) = px; *(LAS v4u*)(SL + SL_TMT + (c * 16 + (base ^ 8)) * 2) = (v4u){0u, 0u, 0u, 0u};
#pragma unroll
                        for (int sr = 0; sr < 8; ++sr) { ((LAS bf16*)(SL + SL_TM))[(base + sr) * 16 + c] = (bf16)f2bf(x[sr]); ((LAS bf16*)(SL + SL_TM))[((base ^ 8) + sr) * 16 + c] = (bf16)0; } }
                    LDS_WAIT(); asm volatile("" ::: "memory");
                    const bf16x8 fAb = frag_ld(SL + SL_ABF + (c * 16 + 8 * q) * 2, klo), fTd = frag_ld(SL + SL_TMT + (c * 16 + 8 * q) * 2, klo);
                    const f32x4 d1 = mfma16(fAb, fTd, z4);
                    bf16x8 fD1; { v4u p; p.x = pk2(d1[0], d1[1]); p.y = pk2(d1[2], d1[3]); p.z = 0u; p.w = 0u; fD1 = __builtin_bit_cast(bf16x8, p); }
                    const f32x4 d2 = mfma16(fD1, frag4_ld(SL + SL_TM + (c * 16 + 4 * q) * 2), z4);
                    if (c < 8 && q >= 2) {
#pragma unroll
                        for (int g = 0; g < 4; ++g) ((LAS bf16*)(SL + SL_TMT))[(4 * q + g) * 16 + c] = (bf16)f2bf(d2[g]); }
                }
                LDS_WAIT(); asm volatile("" ::: "memory");
                {
                    const bf16x8 fT = frag_ld(SL + SL_TMT + (c * 16 + 8 * q) * 2, klo);
#pragma unroll
                    for (int zt = 0; zt < 5; ++zt) { const bf16x8 fZ = frag_ld(SL + SL_Z + ((16 * zt + c) * 16 + 8 * q) * 2, klo); const f32x4 d = mfma16(fZ, fT, z4);
                        v2u p; p.x = pk2(d[0], d[1]); p.y = pk2(d[2], d[3]); *(LAS v2u*)(SL + SL_ZTT + (c * ZTT_LD + (zt < 4 ? kpos(zt, q) : 64 + 4 * q)) * 2) = p; }
                }
            }
            if (bt + 1 < NBATCH) scan_fetch(R, RM, KM, VM, AX, EX, (size_t)scan_row((NSL * (bt + 1) + w) * CK + c, b, dir) * D + h * 64 + 8 * q);
            __syncthreads();
            asm volatile("" : "+v"(c), "+v"(q));
            if (w < 4) {
                const bool emit = (NSL * bt) * CK >= CTXL;
#pragma unroll 1
                for (int n = 0; n < NSL; ++n) { SeqOps A; seq_load(A, F.lds + slot_off(n), w, c, q, klo); seq_step(A, X, emit, YO, NSL * bt + n, b, dir, h, w, c, q); }
            }
            __syncthreads();
        }
    }
}

__device__ __forceinline__ void p7_readout(Frame& F, const Args& a) {
    const bf16* VM = (const bf16*)(F.ws + WS_VM); const float* BONF = (const float*)(F.ws + WS_BON); const float* BONB = BONF + (size_t)NT * NH;
    const bf16* YF = (const bf16*)(F.ws + WS_YF); const bf16* YB = (const bf16*)(F.ws + WS_YB); bf16* Z = (bf16*)(F.ws + WS_Z);
    const int sub = F.tid & 15; const int ngrp = F.G * 32;
    for (int gid0 = F.vcu * 32 + (F.tid >> 4); gid0 < NT * NH; gid0 += 4 * ngrp) {
        v2u ayf[4], ayb[4], alv[4]; float abf[4], abb[4]; f32x4 alw[4], alb[4];
#pragma unroll
        for (int u = 0; u < 4; ++u) { const int gid = gid0 + u * ngrp; const int mrow = gid >> 5, h = gid & 31, c = h * 64 + 4 * sub; const size_t off = (size_t)mrow * D + c;
            ayf[u] = *(const v2u*)(YF + off); ayb[u] = *(const v2u*)(YB + off); alv[u] = *(const v2u*)(VM + off); abf[u] = BONF[gid]; abb[u] = BONB[gid]; alw[u] = *(const f32x4*)(a.in[I_LNW] + c); alb[u] = *(const f32x4*)(a.in[I_LNB] + c); }
#pragma unroll
        for (int u = 0; u < 4; ++u) { const int gid = gid0 + u * ngrp;
        const int mrow = gid >> 5, h = gid & 31, c = h * 64 + 4 * sub; const size_t off = (size_t)mrow * D + c;
        const v2u yf = ayf[u], yb = ayb[u], lv = alv[u];
        const f32x4 y = (f32x4){bflo(yf.x) + bflo(yb.x), bfhi(yf.x) + bfhi(yb.x), bflo(yf.y) + bflo(yb.y), bfhi(yf.y) + bfhi(yb.y)};
        const float mean = allred16((y.x + y.y) + (y.z + y.w)) * (1.0f / 64.0f); const f32x4 d = y - mean;
        const float var = allred16((d.x * d.x + d.y * d.y) + (d.z * d.z + d.w * d.w)) * (1.0f / 64.0f);
        const f32x4 yn = d * __builtin_amdgcn_rsqf(var + 64e-5f) * alw[u] + alb[u];
        const f32x4 v = (f32x4){bflo(lv.x), bfhi(lv.x), bflo(lv.y), bfhi(lv.y)};
        const f32x4 z = yn + v * (abf[u] + abb[u]); v2u wv; wv.x = pk2(z.x, z.y); wv.y = pk2(z.z, z.w); *(v2u*)(Z + off) = wv;
        }
    }
}
constexpr float GU_F8SCALE = 8.0f, H2_F8SCALE = 8.0f, DT_F8SCALE = 8.0f;
constexpr int CONV_ITEMS = 65 * 768, CONV_DT = 65 * 256, CONV_FREE = CONV_DT + (65 - GU_E2) * 512;
struct DecExp { const float* const* in; unsigned char* ws;
    __device__ __forceinline__ bool operator()(int it, TrJob& j) const {
        if (it < 0 || it >= CONV_ITEMS) return false;
        if (it < CONV_DT) { const int e = it >> 8, r = it & 255; const float* src = (e < 64) ? in[I_ED] + (size_t)e * DEXP * D : in[I_SD];
            const int kb = r >> 5, nb = r & 31; j = TrJob{src, (bf16*)(ws + WS_DT + (size_t)e * D * DEXP), D, DEXP, DEXP, kb * 64, nb * 64, nb * 64, DT_F8SCALE}; }
        else { const int g = it - CONV_DT, eg = g >> 9, q = g & 511, which = q >> 8, r = q & 255, e = eg < 65 - GU_E2 ? GU_E2 + eg : eg - (65 - GU_E2);
            const float* src = (e < 64) ? (which == 0 ? in[I_EG] : in[I_EU]) + (size_t)e * D * DEXP : (which == 0 ? in[I_SG] : in[I_SU]);
            const int kb = r >> 3, nb = r & 7, n0 = nb * 64;
            j = TrJob{src, (bf16*)(ws + gu_base(e)), DEXP, D, D, kb * 64, n0, (n0 >> 7) * 256 + which * 128 + (n0 & 127), GU_F8SCALE}; }
        return true; } };
__device__ __forceinline__ void conv_steal(Frame& F, const Args& a, const unsigned stopn) {
    DecExp dec{a.in, F.ws};
    unsigned* cnt = F.ctl + CW_CONV; unsigned* dnp = F.ctl + CW_P2DONE;
    LAS unsigned* P = (LAS unsigned*)(F.lds + F.wave * 16384);
    const int lane = F.lane;
    unsigned nxt = 0u, dnow = 0u;
    if (lane == 0) nxt = xb_add(cnt, 1u);
    nxt = __builtin_amdgcn_readfirstlane(nxt);
#pragma unroll 1
    for (;;) {
        const unsigned cur = nxt;
        if (cur >= (unsigned)CONV_FREE) break;
        unsigned n2 = (unsigned)CONV_FREE, d2 = dnow;
        if (dnow < stopn) { if (lane == 0) { n2 = xb_add(cnt, 1u); d2 = xb_ld(dnp); } }
        asm volatile("" ::: "memory");
        TrJob ja; f32x4 va[16];
        dec((int)cur, ja); tr_ld<true>(ja, va, lane);
        tr_st<true>(ja, va, P, lane);
        nxt = __builtin_amdgcn_readfirstlane(n2); dnow = __builtin_amdgcn_readfirstlane(d2);
    }
}
constexpr int RT_LD = 68;
__device__ __forceinline__ void p11_route(Frame& F, const Args& a) {
    for (int repa_ = 0, nrepa_ = opaque_n(1 + ((DUPMASK >> 16) & 1)); repa_ < nrepa_; ++repa_) {
        unsigned nd = xb_ld(F.ctl + CW_CONV); nd = __builtin_amdgcn_readfirstlane(nd < (unsigned)CONV_FREE ? nd : (unsigned)CONV_FREE);
        DecExp dec{a.in, F.ws};
        tr_run(dec, (int)nd + F.vcu * 8 + F.wave, F.G * 8, (LAS unsigned*)(F.lds + F.wave * 16384), F.lane);
        __syncthreads();
    }
    const bf16* X1 = (const bf16*)(F.ws + WS_X1); const float* MOD = (const float*)(F.ws + WS_MOD); unsigned char* H2 = F.ws + WS_H2;
    LAS float* hs = (LAS float*)F.lds;
    LAS float* wsb = hs + 64 * RT_LD;
    LAS float* lg = wsb + 64 * RT_LD;
    LAS float* lg2 = lg + 64 * 65;
    LAS float* selb = lg2 + 64 * 65;
    LAS float* rs = selb + 64 * 65;
    LAS int* cnt = (LAS int*)(rs + 64);
    LAS int* basee = cnt + 64;
    LAS int* eloc = basee + 64;
    LAS int* rloc = eloc + 512;
    for (int tile = F.vcu; tile < NT / 64; tile += F.G) {
        const int t0 = tile * 64, b = t0 >> 12;
        const float* sh2 = MOD + (size_t)b * 12288 + 6144; const float* sc2 = MOD + (size_t)b * 12288 + 8192; const float* g2 = a.in[I_N2G];
        if (F.tid < 64) cnt[F.tid] = 0;
        for (int rr = 0; rr < 8; ++rr) { const int tl = F.wave * 8 + rr; const v2u* xr = (const v2u*)(X1 + (size_t)(t0 + tl) * D) + F.lane; f32x4 v[8]; float s = 0.f;
#pragma unroll
            for (int q = 0; q < 8; ++q) { const v2u xw = xr[64 * q]; v[q] = (f32x4){bflo(xw.x), bfhi(xw.x), bflo(xw.y), bfhi(xw.y)}; s += (v[q].x * v[q].x + v[q].y * v[q].y) + (v[q].z * v[q].z + v[q].w * v[q].w); }
            const float rstd = 1.0f / sqrtf(wave_sum(s) * (1.0f / D) + 1e-6f); if (F.lane == 0) rs[tl] = rstd;
            unsigned* o = (unsigned*)(H2 + (size_t)(t0 + tl) * D) + F.lane;
#pragma unroll
            for (int q = 0; q < 8; ++q) { const f32x4 y = v[q] * rstd * ((const f32x4*)g2)[F.lane + 64 * q] * (((const f32x4*)sc2)[F.lane + 64 * q] + 1.0f) + ((const f32x4*)sh2)[F.lane + 64 * q];
                o[64 * q] = pk8(H2_F8SCALE * y.x, H2_F8SCALE * y.y, H2_F8SCALE * y.z, H2_F8SCALE * y.w); } }
        __syncthreads();
        const int tg = F.tid & 15, eg = (F.tid >> 4) & 15, kh = F.tid >> 8;
        float acc[4][4];
#pragma unroll
        for (int i = 0; i < 4; ++i)
#pragma unroll
            for (int j = 0; j < 4; ++j) acc[i][j] = 0.f;
        const int stok = F.tid >> 3, sk8 = (F.tid & 7) * 8; const float rstd_s = rs[stok];
        f32x4 px0, px1, pw0, pw1;
        { const v4u xw = *(const v4u*)(X1 + (size_t)(t0 + stok) * D + sk8); px0 = (f32x4){bflo(xw.x), bfhi(xw.x), bflo(xw.y), bfhi(xw.y)}; px1 = (f32x4){bflo(xw.z), bfhi(xw.z), bflo(xw.w), bfhi(xw.w)}; const float* wp = a.in[I_RW] + F.tid * 8; pw0 = *(const f32x4*)wp; pw1 = *(const f32x4*)(wp + 4); }
        for (int kc = 0; kc < D / 64; ++kc) {
            { const int k0 = kc * 64 + sk8;
              const f32x4 ga = *(const f32x4*)(g2 + k0), gb = *(const f32x4*)(g2 + k0 + 4), ca = *(const f32x4*)(sc2 + k0), cb = *(const f32x4*)(sc2 + k0 + 4), ha = *(const f32x4*)(sh2 + k0), hb = *(const f32x4*)(sh2 + k0 + 4);
              const f32x4 y0 = px0 * rstd_s * ga * (ca + 1.0f) + ha, y1 = px1 * rstd_s * gb * (cb + 1.0f) + hb;
              hs[(sk8 + 0) * RT_LD + stok] = y0.x; hs[(sk8 + 1) * RT_LD + stok] = y0.y; hs[(sk8 + 2) * RT_LD + stok] = y0.z; hs[(sk8 + 3) * RT_LD + stok] = y0.w;
              hs[(sk8 + 4) * RT_LD + stok] = y1.x; hs[(sk8 + 5) * RT_LD + stok] = y1.y; hs[(sk8 + 6) * RT_LD + stok] = y1.z; hs[(sk8 + 7) * RT_LD + stok] = y1.w;
              const int wk = F.tid >> 3, we = (F.tid & 7) * 8; *(LAS f32x4*)(wsb + wk * RT_LD + we) = pw0; *(LAS f32x4*)(wsb + wk * RT_LD + we + 4) = pw1; }
            __syncthreads();
            if (kc + 1 < D / 64) { const v4u xw = *(const v4u*)(X1 + (size_t)(t0 + stok) * D + (kc + 1) * 64 + sk8); px0 = (f32x4){bflo(xw.x), bfhi(xw.x), bflo(xw.y), bfhi(xw.y)}; px1 = (f32x4){bflo(xw.z), bfhi(xw.z), bflo(xw.w), bfhi(xw.w)};
                const float* wp = a.in[I_RW] + (size_t)(kc + 1) * 4096 + F.tid * 8; pw0 = *(const f32x4*)wp; pw1 = *(const f32x4*)(wp + 4); }
#pragma unroll 8
            for (int k = kh * 32; k < kh * 32 + 32; ++k) { const f32x4 h4 = *(const LAS f32x4*)(hs + k * RT_LD + 4 * tg), w4 = *(const LAS f32x4*)(wsb + k * RT_LD + 4 * eg);
                acc[0][0] += h4.x * w4.x; acc[0][1] += h4.x * w4.y; acc[0][2] += h4.x * w4.z; acc[0][3] += h4.x * w4.w;
                acc[1][0] += h4.y * w4.x; acc[1][1] += h4.y * w4.y; acc[1][2] += h4.y * w4.z; acc[1][3] += h4.y * w4.w;
                acc[2][0] += h4.z * w4.x; acc[2][1] += h4.z * w4.y; acc[2][2] += h4.z * w4.z; acc[2][3] += h4.z * w4.w;
                acc[3][0] += h4.w * w4.x; acc[3][1] += h4.w * w4.y; acc[3][2] += h4.w * w4.z; acc[3][3] += h4.w * w4.w; }
            __syncthreads();
        }
        { LAS float* dstl = kh ? lg2 : lg;
#pragma unroll
          for (int i = 0; i < 4; ++i)
#pragma unroll
              for (int j = 0; j < 4; ++j) dstl[(4 * tg + i) * 65 + 4 * eg + j] = acc[i][j]; }
        __syncthreads();
        for (int idx = F.tid; idx < 4096; idx += 512) { const int tl = idx >> 6, e = idx & 63; const float sc = sigmoidf_(lg[tl * 65 + e] + lg2[tl * 65 + e]); lg[tl * 65 + e] = sc; selb[tl * 65 + e] = sc + a.in[I_RB][e]; }
        __syncthreads();
        if (F.tid < 64) {
            const int tl = F.tid; LAS float* sel = selb + tl * 65; const LAS float* scr = lg + tl * 65;
            float gs[8];
#pragma unroll
            for (int g = 0; g < 8; ++g) { float m1 = -INFINITY, m2 = -INFINITY;
#pragma unroll
                for (int j = 0; j < 8; ++j) { const float v = sel[g * 8 + j]; if (v > m1) { m2 = m1; m1 = v; } else if (v > m2) m2 = v; }
                gs[g] = m1 + m2; }
            unsigned gmask = 0u;
#pragma unroll
            for (int it = 0; it < 4; ++it) { float best = -INFINITY; int bi = 0;
#pragma unroll
                for (int g = 0; g < 8; ++g) { const bool ok = !((gmask >> g) & 1u) && gs[g] > best; best = ok ? gs[g] : best; bi = ok ? g : bi; }
                gmask |= 1u << bi; }
            for (int g = 0; g < 8; ++g) if (!((gmask >> g) & 1u)) { for (int j = 0; j < 8; ++j) sel[g * 8 + j] = -INFINITY; }
            float wv[8]; int ev[8]; float wsum = 0.f;
#pragma unroll
            for (int it = 0; it < 8; ++it) { float best = -INFINITY; int bi = 0;
                for (int e = 0; e < 64; ++e) { const float v = sel[e]; if (v > best) { best = v; bi = e; } }
                sel[bi] = -INFINITY; ev[it] = bi; wv[it] = scr[bi]; wsum += wv[it]; }
            const float inv = 2.5f / wsum;
#pragma unroll
            for (int it = 0; it < 8; ++it) { const int lr = atomicAdd((int*)&cnt[ev[it]], 1); eloc[tl * 8 + it] = ev[it]; rloc[tl * 8 + it] = lr;
                ((float*)(F.ws + WS_WSEL))[(size_t)(t0 + tl) * 8 + it] = wv[it] * inv; }
        }
        __syncthreads();
        if (F.tid < 64) basee[F.tid] = (int)__hip_atomic_fetch_add(F.ctl + CW_GCNT + F.tid, (unsigned)cnt[F.tid], __ATOMIC_RELAXED, __HIP_MEMORY_SCOPE_AGENT);
        __syncthreads();
        { const int e = eloc[F.tid]; ((int*)(F.ws + WS_EIDX))[(size_t)t0 * 8 + F.tid] = e; ((int*)(F.ws + WS_RANK))[(size_t)t0 * 8 + F.tid] = basee[e] + rloc[F.tid]; }
        __syncthreads();
    }
}
__device__ __forceinline__ int moe_tables(Frame& F) {
    LAS int* te = (LAS int*)(F.lds + TAB_OFF); LAS int* off = te + MAXTILES;
    if (F.tid < 64) off[66 + F.tid] = (int)__hip_atomic_load(F.ctl + CW_GCNT + F.tid, __ATOMIC_RELAXED, __HIP_MEMORY_SCOPE_AGENT);
    __syncthreads();
    if (F.tid == 0) { int o = 0; for (int e = 0; e < 64; ++e) { off[e] = o; o += (off[66 + e] + 255) & ~255; } off[64] = o; off[65] = o / 256 + NT / 256; }
    __syncthreads();
    const int ntiles = off[65];
    for (int rt = F.tid; rt < ntiles; rt += 512) { int e = 0; for (int j = 1; j <= 64; ++j) if (rt * 256 >= off[j]) e = j; te[rt] = e; }
    __syncthreads();
    return ntiles;
}
__device__ __forceinline__ void p12_slots(Frame& F) {
    (void)moe_tables(F);
    const LAS int* off = (const LAS int*)(F.lds + TAB_OFF) + MAXTILES;
    int* tok = (int*)(F.ws + WS_TOK);
    const int* eidx = (const int*)(F.ws + WS_EIDX); int* rank = (int*)(F.ws + WS_RANK);
    const int gt = F.vcu * 512 + F.tid, NGT = F.G * 512;
    for (int i = gt; i < NT * 8; i += NGT) { const int slot = off[eidx[i]] + rank[i]; tok[slot] = i >> 3; rank[i] = slot; }
    const int o64 = off[64];
    for (int t = gt; t < NT; t += NGT) tok[o64 + t] = t;
    if (gt == 0) F.ctl[CW_O64] = (unsigned)o64;
}
__device__ __forceinline__ void p15_final(Frame& F, const Args& a) {
    const int gw = F.vcu * 8 + F.wave, NGW = F.G * 8; const float* MOD = (const float*)(F.ws + WS_MOD); const unsigned char* YP = (const unsigned char*)(F.ws + WS_YP);
    const int* SLOTMAP = (const int*)(F.ws + WS_RANK); const float* WSEL = (const float*)(F.ws + WS_WSEL); const int o64 = (int)F.ctl[CW_O64];
    for (int t = gw; t < NT; t += NGW) {
        const int b = t >> 12; const float* gt2 = MOD + (size_t)b * 12288 + 10240; const float* fg = a.in[I_FG]; float* xr = a.out + (size_t)t * D; const bf16* x1r = (const bf16*)(F.ws + WS_X1) + (size_t)t * D;
        const v4u s0 = *(const v4u*)(SLOTMAP + (size_t)t * 8), s1 = *(const v4u*)(SLOTMAP + (size_t)t * 8 + 4); const f32x4 w0 = *(const f32x4*)(WSEL + (size_t)t * 8), w1 = *(const f32x4*)(WSEL + (size_t)t * 8 + 4);
        const unsigned sl[9] = {s0.x, s0.y, s0.z, s0.w, s1.x, s1.y, s1.z, s1.w, (unsigned)(o64 + t)}; const float wt[9] = {w0.x, w0.y, w0.z, w0.w, w1.x, w1.y, w1.z, w1.w, 1.0f};
        float v[2][16]; float s = 0.f;
#pragma unroll
        for (int jj = 0; jj < 2; ++jj) { const int col = 16 * F.lane + 1024 * jj; float m[16];
#pragma unroll
            for (int e = 0; e < 16; ++e) m[e] = 0.f;
#pragma unroll
            for (int j = 0; j < 9; ++j) { const v4u y = *(const v4u*)(YP + (size_t)sl[j] * D + col); const unsigned yw[4] = {y.x, y.y, y.z, y.w}; const float wj = wt[j];
#pragma unroll
                for (int e = 0; e < 4; ++e) { const f32x2 lo = __builtin_amdgcn_cvt_pk_f32_fp8((int)yw[e], false), hi = __builtin_amdgcn_cvt_pk_f32_fp8((int)yw[e], true);
                    m[4 * e] += wj * lo.x; m[4 * e + 1] += wj * lo.y; m[4 * e + 2] += wj * hi.x; m[4 * e + 3] += wj * hi.y; } }
#pragma unroll
            for (int e4 = 0; e4 < 4; ++e4) { const v2u xw = *(const v2u*)(x1r + col + 4 * e4); const f32x4 x0 = (f32x4){bflo(xw.x), bfhi(xw.x), bflo(xw.y), bfhi(xw.y)}, g0 = *(const f32x4*)(gt2 + col + 4 * e4);
#pragma unroll
                for (int e = 0; e < 4; ++e) { const float val = x0[e] + g0[e] * (m[4 * e4 + e] * (1.0f / YP_SCALE)); v[jj][4 * e4 + e] = val; s += val * val; } } }
        float rstd = __builtin_amdgcn_rsqf(wave_sum(s) * (1.0f / D) + 1e-6f);
#if defined(PROBE_PHASE)
        if (PROBE_PHASE >= 0) rstd *= 1.0f + (float)__hip_atomic_load(F.ctl + 12000, __ATOMIC_RELAXED, __HIP_MEMORY_SCOPE_AGENT) * 2e-6f;
#endif
#pragma unroll
        for (int jj = 0; jj < 2; ++jj) { const int col = 16 * F.lane + 1024 * jj;
#pragma unroll
            for (int e4 = 0; e4 < 4; ++e4) { const f32x4 f0 = *(const f32x4*)(fg + col + 4 * e4);
                *(f32x4*)(xr + col + 4 * e4) = (f32x4){v[jj][4 * e4], v[jj][4 * e4 + 1], v[jj][4 * e4 + 2], v[jj][4 * e4 + 3]} * rstd * f0; } }
    }
}
#ifndef MK_ONE_LAUNCH
#define MK_ONE_LAUNCH 1
#endif
constexpr int NPHASE = 16;
__global__ void __launch_bounds__(512, 2) mk_fwd(Args args) {
    extern __shared__ __attribute__((aligned(16))) unsigned char lds[];
    Frame F;
    F.lds = (LAS unsigned char*)lds; F.MISC = (volatile LAS unsigned*)(F.lds + LDSCTL_OFF);
    int wave0 = __builtin_amdgcn_readfirstlane((int)threadIdx.x >> 6); asm volatile("" : "+s"(wave0));
    F.tid = threadIdx.x; F.lane = F.tid & 63; F.wave = wave0;
    F.G = gridDim.x; { const int bx = blockIdx.x; F.vcu = (F.G % 8 == 0) ? (bx % 8) * (F.G / 8) + bx / 8 : bx; }
    F.ws = args.ws; F.ctl = (unsigned*)(args.ws + WS_CTL);
    for (int u = F.tid; u < 256; u += 512) ((LAS unsigned*)(F.lds + LDSCTL_OFF))[u] = 0u;
    __syncthreads();
    XcdBarrier bar; bar.bar = F.ctl + CW_BAR; bar.x = 0; bar.st = nullptr;
    if (MK_ONE_LAUNCH) bar = xcd_barrier_post(F.ctl + CW_BAR, F.MISC + 8);
    const int lo = args.ph_lo, hi = args.ph_hi;
#ifndef PHMASK
#define PHMASK 0xFFFF
#endif
#define IN(k) (((PHMASK >> (k)) & 1) && lo <= (k) && (k) < hi)
#ifndef DUPMASK
#define DUPMASK 0
#endif
#define DUP(k) for (int rep_ = 0, nrep_ = opaque_n(1 + ((DUPMASK >> (k)) & 1)); rep_ < nrep_; ++rep_)
#define FRESH() do { int l_ = (int)__builtin_amdgcn_mbcnt_hi(~0u, __builtin_amdgcn_mbcnt_lo(~0u, 0u)); asm volatile("" : "+v"(l_)); int w_ = wave0; asm volatile("" : "+s"(w_)); F.lane = l_; F.wave = w_; F.tid = w_ * 64 + l_; { unsigned char* p_ = args.ws; asm volatile("" : "+s"(p_)); F.ws = p_; ws = p_; F.ctl = (unsigned*)(p_ + WS_CTL); } } while (0)
#define SEAM(k) do { if (MK_ONE_LAUNCH) { if (IN(k) && IN((k) + 1)) { xcd_barrier(bar); if ((DUPMASK >> 18) & 1) xcd_barrier(bar); } } } while (0)
    const int G = F.G, c = (int)blockIdx.x;
#ifndef PROBE_PHASE
#define PROBE_PHASE -1
#endif
    unsigned long long pt0_ = 0;
#define PSTART(k) do { if (PROBE_PHASE == (k)) pt0_ = __builtin_amdgcn_s_memrealtime(); } while (0)
#define PEND(k) do { if (PROBE_PHASE == (k) && blockIdx.x == 0 && threadIdx.x == 0) { const unsigned long long t1_ = __builtin_amdgcn_s_memrealtime(); __hip_atomic_store(F.ctl + 12000, (unsigned)(t1_ - pt0_), __ATOMIC_RELAXED, __HIP_MEMORY_SCOPE_AGENT); } } while (0)
    unsigned char* ws = args.ws;

    PSTART(0);
    if (IN(0)) DUP(0) { FRESH(); p0_prologue(F, args); } SEAM(0); PEND(0);
    PSTART(1);
    if (IN(1)) DUP(1) { FRESH(); p1_norm1(F, args); } SEAM(1); PEND(1);
    PSTART(2);
    if (IN(2)) DUP(2) { FRESH();
        const int g1 = (G == 256) ? 240 : G;
        if (c < g1) {
            G1Order S{(const char*)(ws + WS_HA), (const char*)(ws + WS_WIN), (size_t)256 * D * (P2_FP8 ? 1 : 2), (size_t)256 * D * (P2_FP8 ? 1 : 2), g1, c};
            EpiG1 E{(bf16*)(ws + WS_U), (bf16*)(ws + WS_SLAB), (unsigned char*)(ws + WS_GATES)};
            if (P2_FP8) pg8::gemm_phase<EpiG1, G1Order, false, true, 124>(F.lds + RING_OFF, F.wave, D / 2, D / 2, D / 2, S, E);
            else pg8::gemm_phase<EpiG1, G1Order, false>(F.lds + RING_OFF, F.wave, D, D, D, S, E);
            FRESH();
            if (F.tid == 0) (void)xb_add(F.ctl + CW_P2DONE, 1u);
        } else conv_steal(F, args, 8u);
    } SEAM(2); PEND(2);
    PSTART(3);
    if (IN(3)) DUP(3) { FRESH(); p3_prep(F, args); } SEAM(3); PEND(3);
    PSTART(4);
    if (IN(4)) DUP(4) { FRESH();
#ifndef NO4A
        {
            RepOrder S{(const char*)(ws + WS_LIN), (const char*)(ws + WS_LORA), (size_t)128 * 2, (size_t)D * 128 * 2, (size_t)256 * LINLD * 2, (size_t)256 * 128 * 2, MT / 256, D / 256, 4, G, c};
            EpiLora E{(unsigned short*)(ws + WS_EA), args.in[I_DW0], args.in[I_IA0]};
            pg8::gemm_phase<EpiLora, RepOrder, false>(F.lds + RING_OFF, F.wave, 128, LINLD, 128, S, E);
        }
#endif
    }
    if (IN(4)) DUP(4) { FRESH();
#ifndef NO4B
        {
            RepOrder S{(const char*)(ws + WS_DP), (const char*)(ws + WS_POOLW), (size_t)256 * 2, (size_t)256 * 256 * 2, (size_t)256 * 1024 * 2, (size_t)256 * 256 * 2, NT / 256, 1, 4, G, c};
            EpiPoolG E{(bf16*)(ws + WS_Y2), args.in[I_POOLS]};
            pg8::gemm_phase<EpiPoolG, RepOrder, false>(F.lds + RING_OFF, F.wave, 256, 1024, 256, S, E);
        }
#endif
    } SEAM(4); PEND(4);
    PSTART(5);
    if (IN(5)) DUP(5) { FRESH();
        RepOrder S{(const char*)(ws + WS_Y2), (const char*)(ws + WS_WPO), 0, 0, (size_t)256 * 1024 * 2, (size_t)256 * 1024 * 2, NT / 256, D / 256, 1, G, c};
        EpiMix<0> E{(bf16*)(ws + WS_MP), D, (const void*)(ws + WS_GATES), 4096, nullptr, 0};
        pg8::gemm_phase<EpiMix<0>, RepOrder, false>(F.lds + RING_OFF, F.wave, 1024, 1024, 1024, S, E);
    }
    PSTART(6);
    if (IN(6)) DUP(6) { FRESH(); p6_scan(F, args); if ((DUPMASK >> 19) & 1) { FRESH(); p6_scan(F, args); } } SEAM(6); PEND(6);
    PSTART(7);
    if (IN(7)) DUP(7) { FRESH(); p7_readout(F, args); } SEAM(7); PEND(7);
    PSTART(8);
    if (IN(8)) DUP(8) { FRESH();
        RepOrder S{(const char*)(ws + WS_LIN) + 512 * 2, (const char*)(ws + WS_G2), 0, 0, (size_t)256 * LINLD * 2, (size_t)256 * 256 * 2, NT / 256, D / 256, 1, G, c};
        EpiMix<1> E{(bf16*)(ws + WS_OR), D, (const void*)(ws + WS_Z), D, nullptr, 0};
        pg8::gemm_phase<EpiMix<1>, RepOrder, false>(F.lds + RING_OFF, F.wave, 256, LINLD, 256, S, E);
    } SEAM(8); PEND(8);
    PSTART(9);
    if (IN(9)) DUP(9) { FRESH();
        RepOrder S{(const char*)(ws + WS_OR), (const char*)(ws + WS_WRO), 0, 0, (size_t)256 * D * 2, (size_t)256 * D * 2, NT / 256, D / 256, 1, G, c};
        EpiMix<2> E{(bf16*)(ws + WS_Z), D, (const void*)(ws + WS_GATES + 2048), 4096, (const bf16*)(ws + WS_MP), D};
        pg8::gemm_phase<EpiMix<2>, RepOrder, false>(F.lds + RING_OFF, F.wave, D, D, D, S, E);
    } SEAM(9); PEND(9);
    PSTART(10);
    if (IN(10)) DUP(10) { FRESH();
        RepOrder S{(const char*)(ws + WS_Z), (const char*)(ws + WS_WO), 0, 0, (size_t)256 * D * 2, (size_t)256 * D * 2, NT / 256, D / 256, 1, G, c};
        EpiX1 E{args.in[I_X], (bf16*)(ws + WS_X1), (const float*)(ws + WS_MOD)};
        pg8::gemm_phase<EpiX1, RepOrder, false>(F.lds + RING_OFF, F.wave, D, D, D, S, E);
    } SEAM(10); PEND(10);
    PSTART(11);
    if (IN(11)) DUP(11) { FRESH(); p11_route(F, args); } SEAM(11); PEND(11);
    PSTART(12);
    if (IN(12)) DUP(12) { FRESH(); p12_slots(F); } SEAM(12); PEND(12);
    PSTART(13);
    if (IN(13)) DUP(13) { FRESH();
        const int ntiles = moe_tables(F);
        MoeOrderT<true> S{(const char*)(ws + WS_H2), (const char*)ws, (const LAS int*)(F.lds + TAB_OFF), (const LAS int*)(F.lds + ROWTAB_OFF), 0, (size_t)1024 * D * 2, (size_t)256 * D, ntiles, 4, G, c};
        { LAS int* rt = (LAS int*)(F.lds + ROWTAB_OFF); const int* tok = (const int*)(ws + WS_TOK); Unit uu;
          for (int i = 0; i < ROWTAB_UNITS && S.next(i, uu); ++i) if (F.tid < 256) rt[i * 256 + F.tid] = tok[uu.pm * 256 + F.tid];
          __syncthreads(); }
        EpiAct E{ws + WS_ACT};
        pg8::gemm_phase<EpiAct, MoeOrderT<true>, true, true, 124>(F.lds + RING_OFF, F.wave, D / 2, D / 2, D / 2, S, E);
    } SEAM(13); PEND(13);
    PSTART(14);
    if (IN(14)) DUP(14) { FRESH();
        const int ntiles = moe_tables(F);
        MoeOrderT<false> S{(const char*)(ws + WS_ACT), (const char*)(ws + WS_DT), (const LAS int*)(F.lds + TAB_OFF), (const LAS int*)(F.lds + ROWTAB_OFF), (size_t)256 * DEXP, (size_t)D * DEXP, (size_t)256 * DEXP, ntiles, 8, G, c};
        EpiDown E{(unsigned char*)(ws + WS_YP)};
        pg8::gemm_phase<EpiDown, MoeOrderT<false>, false, true, 124>(F.lds + RING_OFF, F.wave, DEXP / 2, DEXP / 2, DEXP / 2, S, E);
    } SEAM(14); PEND(14);
    PSTART(15);
    if (IN(15)) DUP(15) { FRESH(); p15_final(F, args); }
#undef IN
#undef SEAM
}

extern "C" void kernel_launch(void* const* d_in, const int* in_sizes, int n_in, void* d_out, int out_size, void* d_ws, size_t ws_size, hipStream_t stream) {
    static int grid = 0;
    if (grid == 0) {
        if (n_in != 34 || in_sizes[0] != NT * D || out_size != NT * D || ws_size < WS_END) { fprintf(stderr, "kernel_launch: unexpected shapes (n_in %d, in0 %d, out %d, ws %zu < %zu)\n", n_in, n_in > 0 ? in_sizes[0] : -1, out_size, ws_size, (size_t)WS_END); grid = -1; return; }
        int dev = 0, cus = 0, per_cu = 0;
        if (hipGetDevice(&dev) != hipSuccess || hipDeviceGetAttribute(&cus, hipDeviceAttributeMultiprocessorCount, dev) != hipSuccess) { grid = -1; return; }
        if (hipFuncSetAttribute((const void*)mk_fwd, hipFuncAttributeMaxDynamicSharedMemorySize, LDS_BYTES) != hipSuccess) { fprintf(stderr, "kernel_launch: hipFuncSetAttribute failed\n"); grid = -1; return; }
        if (hipOccupancyMaxActiveBlocksPerMultiprocessor(&per_cu, (const void*)mk_fwd, 512, LDS_BYTES) != hipSuccess || per_cu < 1) fprintf(stderr, "kernel_launch: occupancy query reports %d\n", per_cu);
        (void)hipGetLastError();
        grid = cus;
    }
    if (grid < 0) return;
    if (hipMemsetAsync((char*)d_ws + WS_CTL, 0, CTL_ZERO_BYTES, stream) != hipSuccess) return;
    Args a{};
    for (int i = 0; i < 34; ++i) a.in[i] = (const float*)d_in[i];
    a.out = (float*)d_out; a.ws = (unsigned char*)d_ws;
#if MK_ONE_LAUNCH
    a.ph_lo = 0; a.ph_hi = NPHASE;
    hipLaunchKernelGGL(mk_fwd, dim3(grid), dim3(512), LDS_BYTES, stream, a);
#else
    for (int p = 0; p < NPHASE; ++p) { a.ph_lo = p; a.ph_hi = p + 1; hipLaunchKernelGGL(mk_fwd, dim3(grid), dim3(512), LDS_BYTES, stream, a); }
#endif
}
```

```cpp
#include <hip/hip_runtime.h>
#include <cstdio>
#include <cstdint>
#ifndef DUPMASK
#define DUPMASK 0
#endif
#ifndef PROBE_PHASE
#define PROBE_PHASE -1
#endif
#ifndef P2_FP8
#define P2_FP8 1
#endif
#ifndef P10_FP8
#define P10_FP8 1
#endif

#define GAS __attribute__((address_space(1)))
#define LAS __attribute__((address_space(3)))
typedef unsigned short bf16;
typedef unsigned v4u __attribute__((ext_vector_type(4)));
typedef unsigned v2u __attribute__((ext_vector_type(2)));
typedef float f32x4 __attribute__((ext_vector_type(4)));
typedef float f32x2 __attribute__((ext_vector_type(2)));
typedef short bf16x8 __attribute__((ext_vector_type(8)));

constexpr int D = 2048, NB = 4, TSEQ = 4096, NT = NB * TSEQ  , CTXL = 256, NC = NB * CTXL  , MT = NT + NC  ;
constexpr int DIN = 11904, DSH = 6784, NPAD = 12032, SLABLD = 6912, NH = 32, HS = 64;
constexpr int NEXP = 64, DEXP = 512, TOPK = 8;
constexpr int NSLOT = NT * TOPK + NEXP * 256 + NT;
constexpr int MAXTILES = NSLOT / 256;
constexpr int LINLD = 768;

__device__ __forceinline__ int opaque_n(int n) { asm volatile("" : "+s"(n)); return n; }
__device__ __forceinline__ unsigned f2bf(float f) { unsigned u = __builtin_bit_cast(unsigned, f); return (u + 0x7fffu + ((u >> 16) & 1u)) >> 16; }
typedef __bf16 bf16x2_t __attribute__((ext_vector_type(2)));
__device__ __forceinline__ unsigned pk2(float lo, float hi) { const f32x2 v = {lo, hi}; const bf16x2_t b = __builtin_convertvector(v, bf16x2_t); return __builtin_bit_cast(unsigned, b); }
__device__ __forceinline__ unsigned pk8(float a, float b, float c, float d) { int w = __builtin_amdgcn_cvt_pk_fp8_f32(a, b, 0, false); w = __builtin_amdgcn_cvt_pk_fp8_f32(c, d, w, true); return (unsigned)w; }
__device__ __forceinline__ float bflo(unsigned w) { return __builtin_bit_cast(float, w << 16); }
__device__ __forceinline__ float bfhi(unsigned w) { return __builtin_bit_cast(float, w & 0xffff0000u); }
__device__ __forceinline__ unsigned pkh2(float lo, float hi) { const unsigned short a = __builtin_bit_cast(unsigned short, (_Float16)lo), b = __builtin_bit_cast(unsigned short, (_Float16)hi); return (unsigned)a | ((unsigned)b << 16); }
__device__ __forceinline__ float hlo(unsigned w) { return (float)__builtin_bit_cast(_Float16, (unsigned short)(w & 0xffffu)); }
__device__ __forceinline__ float hhi(unsigned w) { return (float)__builtin_bit_cast(_Float16, (unsigned short)(w >> 16)); }
__device__ __forceinline__ float sigmoidf_(float x) { return __builtin_amdgcn_rcpf(1.0f + __builtin_amdgcn_exp2f(-1.44269504f * x)); }
__device__ __forceinline__ float tanhf_(float x) { return 1.0f - 2.0f * __builtin_amdgcn_rcpf(1.0f + __builtin_amdgcn_exp2f(2.88539008f * x)); }
__device__ __forceinline__ float wave_sum(float v) {
#pragma unroll
    for (int o = 1; o < 64; o <<= 1) v += __shfl_xor(v, o);
    return v;
}
__device__ __forceinline__ float dpp_f(float v, const int ctrl_sel) {
    int r;
    const int x = __builtin_bit_cast(int, v);
    if (ctrl_sel == 0) r = __builtin_amdgcn_update_dpp(0, x, 0xB1, 0xF, 0xF, true);
    else if (ctrl_sel == 1) r = __builtin_amdgcn_update_dpp(0, x, 0x4E, 0xF, 0xF, true);
    else if (ctrl_sel == 2) r = __builtin_amdgcn_update_dpp(0, x, 0x141, 0xF, 0xF, true);
    else r = __builtin_amdgcn_update_dpp(0, x, 0x140, 0xF, 0xF, true);
    return __builtin_bit_cast(float, r);
}
__device__ __forceinline__ float allred16(float v) { v += dpp_f(v, 0); v += dpp_f(v, 1); v += dpp_f(v, 2); v += dpp_f(v, 3); return v; }

#define LDS_WAIT() asm volatile("s_waitcnt lgkmcnt(0)" ::: "memory")
#define VM_WAIT() asm volatile("s_waitcnt vmcnt(0)" ::: "memory")

namespace pg8 {
constexpr int BM = 256, BK = 64, HALF = 128, HTB = HALF * BK * 2, STAGE_BYTES = 8 * HTB, NXCD = 8, WGM = 8;
__host__ __device__ __forceinline__ int lds_byte(int r, int c) { const int st = (r >> 4) * 2 + (c >> 5), rr = r & 15, cc = c & 31, ob = rr * 64 + cc * 2; return st * 1024 + (ob ^ (((ob >> 9) & 1) << 5)); }
__host__ __device__ __forceinline__ void stage_rc(int b, int& R, int& C) { const int st = b / 1024, sb = b % 1024, swz = sb ^ (((sb >> 9) & 1) << 5); R = (st >> 1) * 16 + swz / 64; C = (st & 1) * 32 + (swz % 64) / 2; }
__host__ __device__ __forceinline__ int perm32(int rho) { const int n = rho >> 4, i = rho & 15; return 8 * (i >> 2) + 4 * n + (i & 3); }
struct Unit { const char* A; const char* B; int pm, pn, aux, ui; };
__device__ __forceinline__ int xcd_remap(int L, int nwg) { const int q = nwg / NXCD, r = nwg % NXCD, xcd = L % NXCD, off = L / NXCD; return (xcd < r ? xcd * (q + 1) : r * (q + 1) + (xcd - r) * q) + off; }
__device__ __forceinline__ void grid_tile(int wgid, int nM, int nN, int& pm, int& pn) { const int nig = WGM * nN, gid = wgid / nig, fm = gid * WGM, gsz = (nM - fm) < WGM ? (nM - fm) : WGM; pm = fm + ((wgid % nig) % gsz); pn = (wgid % nig) / gsz; }

__device__ __forceinline__ void stage2(LAS unsigned char* lds, int bufoff, unsigned ldsw, const char* g, unsigned o0, unsigned o1) {
    __builtin_amdgcn_global_load_lds((const unsigned*)(g + o0), (LAS unsigned*)(lds + bufoff + ldsw), 16, 0, 0);
    __builtin_amdgcn_global_load_lds((const unsigned*)(g + o1), (LAS unsigned*)(lds + bufoff + ldsw + 8192), 16, 0, 0);
}

typedef int v8i_t __attribute__((ext_vector_type(8)));
typedef int v4i_t __attribute__((ext_vector_type(4)));
__device__ __forceinline__ v8i_t mx_cat(const bf16x8& lo, const bf16x8& hi) { const v4i_t a = __builtin_bit_cast(v4i_t, lo), b = __builtin_bit_cast(v4i_t, hi); return __builtin_shufflevector(a, b, 0, 1, 2, 3, 4, 5, 6, 7); }

template <class Epi, class = void> struct EpiPerm16 { static constexpr bool value = false; };
template <class Epi> struct EpiPerm16<Epi, decltype((void)Epi::PERM16)> { static constexpr bool value = Epi::PERM16; };
template <class Epi> __host__ __device__ constexpr bool epi_perm16() { return EpiPerm16<Epi>::value; }
template <class Epi> __host__ __device__ __forceinline__ int perm_row(int R) {
    if (epi_perm16<Epi>()) { const int wc = R >> 5, rho = R & 31, n = rho >> 4, i = rho & 15; return 64 * wc + 16 * (i >> 2) + 4 * n + (i & 3); }
    return Epi::PERM ? ((R & ~31) + perm32(R & 31)) : R;
}
template <class Epi, class Sched, bool GATHER, bool ALIGN_EPI = true, int MXS = 0>
__device__ __forceinline__ void gemm_phase(LAS unsigned char* lds, const int wave_, const int K, const int lda, const int ldb, const Sched& S, const Epi& E) {
    int tid_ = wave_ * 64 + (int)__builtin_amdgcn_mbcnt_hi(~0u, __builtin_amdgcn_mbcnt_lo(~0u, 0u)); asm volatile("" : "+v"(tid_));
    const int tid = tid_, wid = __builtin_amdgcn_readfirstlane(tid >> 6), lane = tid & 63, wr = wid >> 2, wc = wid & 3, fr = lane & 15, fq = lane >> 4;
    const int nt = opaque_n(K / BK);
    unsigned voffA[2], voffB[2]; int RA[2], CA[2];
#pragma unroll
    for (int i = 0; i < 2; ++i) { int R, C; stage_rc(tid * 16 + i * 8192, R, C); const int Rb = perm_row<Epi>(R);
        RA[i] = R; CA[i] = C; voffA[i] = (unsigned)(R * lda + C) * 2u; voffB[i] = (unsigned)(Rb * ldb + C) * 2u; }
    const size_t kstep = (size_t)(BK * 2);
    const size_t hstepA = (size_t)HALF * lda * 2, hstepB = (size_t)(epi_perm16<Epi>() ? 8 : HALF) * ldb * 2;
    const unsigned ldsw = (unsigned)wid * 1024u;
    const int aoff = lds_byte(wr * 64 + fr, fq * 8), boff = lds_byte(wc * 32 + fr, fq * 8);
#define PG8_SA(b, h) (((b) * 2 + (h)) * HTB)
#define PG8_SB(b, h) ((4 + (b) * 2 + (h)) * HTB)
#define PG8_STB(bufoff, gbase) stage2(lds, (bufoff), ldsw, (gbase), voffB[0], voffB[1])
#define PG8_STA(bufoff, gk, h, NX) do { if constexpr (GATHER) { const unsigned _o0 = (NX) ? vn[h][0] : vc[h][0], _o1 = (NX) ? vn[h][1] : vc[h][1]; stage2(lds, (bufoff), ldsw, (gk), _o0, _o1); } \
        else stage2(lds, (bufoff), ldsw, (gk) + (h) * hstepA, voffA[0], voffA[1]); } while (0)
#define PG8_LDA(dst, b, h) do { _Pragma("unroll") for (int m = 0; m < 4; ++m) _Pragma("unroll") for (int k = 0; k < 2; ++k) dst[m][k] = *(const LAS bf16x8*)(lds + PG8_SA(b, h) + aoff + m * 2048 + k * 1024); } while (0)
#define PG8_LDB(dst, b, h) do { _Pragma("unroll") for (int n = 0; n < 2; ++n) _Pragma("unroll") for (int k = 0; k < 2; ++k) dst[n][k] = *(const LAS bf16x8*)(lds + PG8_SB(b, h) + boff + n * 2048 + k * 1024); } while (0)
#define PG8_MMA(ai, bj, At, Bt) do { __builtin_amdgcn_s_setprio(1); if constexpr (MXS != 0) { _Pragma("unroll") for (int m = 0; m < 4; ++m) _Pragma("unroll") for (int n = 0; n < 2; ++n) \
        asm volatile("v_mfma_scale_f32_16x16x128_f8f6f4 %0, %1, %2, %0, %3, %3 op_sel_hi:[0,0,0]" : "+v"(acc[ai][bj][m][n]) : "v"(mx_cat(Bt[n][0], Bt[n][1])), "v"(mx_cat(At[m][0], At[m][1])), "v"(mxs_)); } \
        else { _Pragma("unroll") for (int m = 0; m < 4; ++m) _Pragma("unroll") for (int n = 0; n < 2; ++n) _Pragma("unroll") for (int k = 0; k < 2; ++k) \
        acc[ai][bj][m][n] = __builtin_amdgcn_mfma_f32_16x16x32_bf16(Bt[n][k], At[m][k], acc[ai][bj][m][n], 0, 0, 0); } __builtin_amdgcn_s_setprio(0); } while (0)
#define PG8_WAIT_V(n) asm volatile("s_waitcnt vmcnt(" #n ")" ::: "memory")
#define PG8_WAIT_L(n) asm volatile("s_waitcnt lgkmcnt(" #n ")" ::: "memory")
#define PG8_BAR __builtin_amdgcn_s_barrier()
#define PG8_SCHED __builtin_amdgcn_sched_barrier(0)
    Unit cur, nxt; int ui = 0;
    if (!S.next(0, cur)) return;
    int mxs_ = MXS * 0x01010101; asm volatile("" : "+v"(mxs_));
    unsigned vc[2][2], vn[2][2];
    if constexpr (GATHER) {
#pragma unroll
        for (int h = 0; h < 2; ++h)
#pragma unroll
            for (int i = 0; i < 2; ++i) { vc[h][i] = ((unsigned)S.row(cur, h * HALF + RA[i]) * (unsigned)lda + (unsigned)CA[i]) * 2u; vn[h][i] = vc[h][i]; }
        if constexpr (!Sched::ROW_LDS) asm volatile("s_waitcnt vmcnt(0)" ::: "memory");
    }
    f32x4 acc[2][2][4][2];
#pragma unroll
    for (int a = 0; a < 2; ++a)
#pragma unroll
        for (int b = 0; b < 2; ++b)
#pragma unroll
            for (int m = 0; m < 4; ++m)
#pragma unroll
                for (int n = 0; n < 2; ++n) acc[a][b][m][n] = (f32x4){0.f, 0.f, 0.f, 0.f};
    bf16x8 At[4][2], B0[2][2], B1[2][2];
    const char* cA = cur.A; const char* cB = cur.B;
    PG8_STB(PG8_SB(0, 0), cB); PG8_STB(PG8_SB(0, 1), cB + hstepB); PG8_STA(PG8_SA(0, 0), cA, 0, false); PG8_STA(PG8_SA(0, 1), cA, 1, false);
    if (wr == 1) PG8_BAR;
    PG8_WAIT_V(2); PG8_BAR;
    PG8_STB(PG8_SB(1, 0), cB + kstep); PG8_STA(PG8_SA(1, 0), cA + kstep, 0, false); PG8_STB(PG8_SB(1, 1), cB + hstepB + kstep);
    PG8_WAIT_V(6); PG8_BAR;
    for (;;) {
        const bool has_next = S.next(ui + 1, nxt);
        const char* nA = has_next ? nxt.A : cA; const char* nB = has_next ? nxt.B : cB;
#pragma unroll 1
        for (int t = 0; t < nt; t += 2) {
            const bool last = (t == nt - 2);
            const char* a1 = cA + (size_t)(t + 1) * kstep;
            const char* a2 = last ? nA : cA + (size_t)(t + 2) * kstep; const char* b2 = last ? nB : cB + (size_t)(t + 2) * kstep;
            const char* a3 = a2 + kstep; const char* b3 = b2 + kstep;
            if constexpr (GATHER) {
                if (last && has_next) {
#pragma unroll
                    for (int h = 0; h < 2; ++h)
#pragma unroll
                        for (int i = 0; i < 2; ++i) vn[h][i] = ((unsigned)S.row(nxt, h * HALF + RA[i]) * (unsigned)lda + (unsigned)CA[i]) * 2u;
                    if constexpr (!Sched::ROW_LDS) asm volatile("s_waitcnt vmcnt(0)" ::: "memory");
                }
            }
            PG8_LDB(B0, 0, 0); PG8_LDB(B1, 0, 1); PG8_SCHED; PG8_LDA(At, 0, 0); PG8_STA(PG8_SA(1, 1), a1, 1, false);
            PG8_WAIT_V(8); PG8_WAIT_L(0); PG8_BAR; PG8_MMA(0, 0, At, B0); PG8_MMA(0, 1, At, B1); PG8_BAR; PG8_SCHED;
            PG8_LDA(At, 0, 1); PG8_STB(PG8_SB(0, 0), b2); PG8_STB(PG8_SB(0, 1), b2 + hstepB); PG8_STA(PG8_SA(0, 0), a2, 0, last);
            PG8_WAIT_V(8); PG8_WAIT_L(0); PG8_BAR; PG8_MMA(1, 0, At, B0); PG8_MMA(1, 1, At, B1); PG8_BAR; PG8_SCHED;
            PG8_LDB(B0, 1, 0); PG8_LDB(B1, 1, 1); PG8_SCHED; PG8_LDA(At, 1, 0); PG8_STA(PG8_SA(0, 1), a2, 1, last);
            PG8_WAIT_V(8); PG8_WAIT_L(0); PG8_BAR; PG8_MMA(0, 0, At, B0); PG8_MMA(0, 1, At, B1); PG8_BAR; PG8_SCHED;
            PG8_LDA(At, 1, 1); PG8_STB(PG8_SB(1, 0), b3); PG8_STB(PG8_SB(1, 1), b3 + hstepB); PG8_STA(PG8_SA(1, 0), a3, 0, last);
            PG8_WAIT_V(8); PG8_WAIT_L(0); PG8_BAR; PG8_MMA(1, 0, At, B0); PG8_MMA(1, 1, At, B1); PG8_BAR; PG8_SCHED;
        }
        if constexpr (ALIGN_EPI) { if (wr == 0) PG8_BAR; }
        if constexpr (MXS != 0) asm volatile("s_nop 15\n\ts_nop 15" ::: "memory");
        { int fr_ = fr, fq_ = fq; asm volatile("" : "+v"(fr_), "+v"(fq_));
          E(acc, cur, wr, wc, fr_, fq_); }
        if (!has_next) break;
#pragma unroll
        for (int a = 0; a < 2; ++a)
#pragma unroll
            for (int b = 0; b < 2; ++b)
#pragma unroll
                for (int m = 0; m < 4; ++m)
#pragma unroll
                    for (int n = 0; n < 2; ++n) acc[a][b][m][n] = (f32x4){0.f, 0.f, 0.f, 0.f};
        cur = nxt; cA = nA; cB = nB; ++ui;
        if constexpr (GATHER) {
#pragma unroll
            for (int h = 0; h < 2; ++h)
#pragma unroll
                for (int i = 0; i < 2; ++i) vc[h][i] = vn[h][i];
        }
        if constexpr (ALIGN_EPI) { if (wr == 1) PG8_BAR; }
    }
    PG8_WAIT_V(0);
    if constexpr (!ALIGN_EPI) { if (wr == 0) PG8_BAR; }
    PG8_BAR;
#undef PG8_SA
#undef PG8_SB
#undef PG8_STB
#undef PG8_STA
#undef PG8_LDA
#undef PG8_LDB
#undef PG8_MMA
#undef PG8_WAIT_V
#undef PG8_WAIT_L
#undef PG8_BAR
#undef PG8_SCHED
}
}
#define XB_TMO      128
#define XB_XCNT(j)  (256  + 64 * (j))
#define XB_XSUB(j)  (1280 + 64 * (j))
#define XB_XGEN(j)  (2304 + 64 * (j))
#define XB_TOP      3328
#define XB_TOPGEN   3392
#define XCD_BAR_WORDS 3456
#define XB_SPIN_CAP (1u << 18)
__device__ __forceinline__ unsigned xb_ld(unsigned* p)              { return __hip_atomic_load(p, __ATOMIC_RELAXED, __HIP_MEMORY_SCOPE_AGENT); }
__device__ __forceinline__ unsigned xb_add(unsigned* p, unsigned v) { return __hip_atomic_fetch_add(p, v, __ATOMIC_RELAXED, __HIP_MEMORY_SCOPE_AGENT); }
__device__ __forceinline__ unsigned xb_xcc_id() { return (unsigned)__builtin_amdgcn_s_getreg((3 << 11) | 20) & 0xFu; }
#define XB_SPIN(cond, bar) do { unsigned _sp = 0; while (cond) { __builtin_amdgcn_s_sleep(1); \
    if ((++_sp & 255u) == 0u) { if (xb_ld(&(bar)[XB_TMO])) break; if (_sp > XB_SPIN_CAP) { atomicAdd(&(bar)[XB_TMO], 1u); break; } } } } while (0)
struct XcdBarrier { unsigned* bar; unsigned x; volatile LAS unsigned* st; };
__device__ __forceinline__ XcdBarrier xcd_barrier_post(unsigned* bar, volatile LAS unsigned* st) {
    XcdBarrier b; b.bar = bar; b.x = xb_xcc_id(); b.st = st;
    if (threadIdx.x == 0) (void)xb_add(&bar[XB_XCNT(b.x)], 1u);
    return b;
}
__device__ __forceinline__ void xcd_barrier_complete(unsigned* bar, unsigned x, unsigned& nloc, unsigned& nx) {
    const unsigned G = gridDim.x * gridDim.y * gridDim.z;
    unsigned sum, cnt, mine, sp = 0u;
    for (;;) {
        sum = 0u; cnt = 0u; mine = 0u;
#pragma unroll
        for (unsigned j = 0; j < 16; ++j) { const unsigned c = xb_ld(&bar[XB_XCNT(j)]); sum += c; cnt += (c > 0u) ? 1u : 0u; mine = (j == x) ? c : mine; }
        if (sum == G) break;
        __builtin_amdgcn_s_sleep(1);
        if ((++sp & 255u) == 0u) { if (xb_ld(&bar[XB_TMO])) break; if (sp > XB_SPIN_CAP) { atomicAdd(&bar[XB_TMO], 1u); break; } }
    }
    nloc = mine > 0u ? mine : 1u; nx = cnt > 0u ? cnt : 1u;
}
__device__ __forceinline__ void xcd_barrier(const XcdBarrier& b) {
    asm volatile("s_waitcnt vmcnt(0)" ::: "memory");
    __syncthreads();
    if (threadIdx.x == 0) {
        unsigned* bar = b.bar;
        __builtin_amdgcn_s_waitcnt(0);
        unsigned nloc = b.st[0], nx = b.st[1];
        if (nloc == 0u) { xcd_barrier_complete(bar, b.x, nloc, nx); b.st[0] = nloc; b.st[1] = nx; }
        const unsigned old = xb_add(&bar[XB_XSUB(b.x)], 1u);
        const unsigned gen = old / nloc;
        if (old + 1u == (gen + 1u) * nloc) {
            __builtin_amdgcn_fence(__ATOMIC_RELEASE, "agent");
            asm volatile("s_waitcnt vmcnt(0)" ::: "memory");
            const unsigned og = xb_add(&bar[XB_TOP], 1u);
            const unsigned tg = og / nx;
            if (og + 1u == (tg + 1u) * nx) xb_add(&bar[XB_TOPGEN], 1u);
            else XB_SPIN(xb_ld(&bar[XB_TOPGEN]) == tg, bar);
            __builtin_amdgcn_fence(__ATOMIC_ACQUIRE, "agent");
            xb_add(&bar[XB_XGEN(b.x)], 1u);
            asm volatile("s_waitcnt vmcnt(0)" ::: "memory");
        } else {
            XB_SPIN(xb_ld(&bar[XB_XGEN(b.x)]) == gen, bar);
            __builtin_amdgcn_fence(__ATOMIC_ACQUIRE, "agent");
            asm volatile("s_waitcnt vmcnt(0)" ::: "memory");
        }
    }
    __syncthreads();
}

constexpr size_t MiB = 1u << 20;
constexpr size_t WS_CTL = 0, CTL_ZERO_BYTES = 64 * 1024;
constexpr size_t WS_MOD = 1 * MiB;
constexpr size_t WS_EIDX = 2 * MiB;
constexpr size_t WS_WSEL = WS_EIDX + 512 * 1024;
constexpr size_t WS_RANK = WS_WSEL + 512 * 1024;
constexpr size_t WS_TOK = 4 * MiB;
constexpr size_t WS_DST = WS_TOK + 1 * MiB;
constexpr size_t WS_WSL = WS_DST + 1 * MiB;
constexpr size_t WS_WIN = 8 * MiB;
constexpr size_t WS_POOLW = 55 * MiB;
constexpr size_t WS_WPO = 56 * MiB;
constexpr size_t WS_LORA = 60 * MiB;
constexpr size_t WS_G2 = 62 * MiB;
constexpr size_t WS_WRO = 63 * MiB;
constexpr size_t WS_WO = 71 * MiB;
constexpr size_t WS_SLAB = 80 * MiB;
constexpr size_t WS_EA = 80 * MiB;
constexpr size_t EA_STRIDE = (size_t)MT * D * 2;
constexpr size_t WS_YF = 352 * MiB, WS_YB = 416 * MiB;
constexpr size_t WS_HA = 438 * MiB;
constexpr size_t WS_Z = 480 * MiB;
constexpr size_t WS_U = 506 * MiB;
constexpr size_t WS_RM = 544 * MiB, WS_KM = 612 * MiB, WS_VM = 680 * MiB;
constexpr size_t WS_LIN = 748 * MiB;
constexpr size_t WS_DP = 774 * MiB;
constexpr size_t WS_BON = 774 * MiB;
constexpr size_t WS_Y2 = 806 * MiB;
constexpr size_t WS_MP = 838 * MiB;
constexpr size_t WS_GATES = 902 * MiB;
constexpr size_t WS_OR = 80 * MiB;
constexpr size_t WS_H2 = 520 * MiB;
constexpr size_t WS_GU = 584 * MiB;
constexpr size_t WS_GU2 = 966 * MiB, WS_GU3 = 1134 * MiB;
constexpr int GU_E2 = 52, GU_E3 = 61;
constexpr size_t WS_ACT = 792 * MiB;
constexpr size_t WS_DT = 1004 * MiB;
constexpr size_t WS_X1 = 328 * MiB;
constexpr size_t WS_YP = 8 * MiB;
constexpr size_t WS_END = 1150 * MiB;
__host__ __device__ __forceinline__ size_t gu_base(int e) { return e < GU_E2 ? WS_GU + (size_t)e * (4 * MiB) : e < GU_E3 ? WS_GU2 + (size_t)(e - GU_E2) * (4 * MiB) : WS_GU3 + (size_t)(e - GU_E3) * (4 * MiB); }
constexpr int CW_BAR = 1024;
constexpr int CW_GCNT = 8192;
constexpr int CW_O64 = 8192 + 100;
constexpr int CW_CONV = 8448, CW_P2DONE = 8512;
static_assert((CW_BAR + XCD_BAR_WORDS) <= CW_GCNT && (CW_P2DONE + 128) * 4 <= (int)CTL_ZERO_BYTES, "ctl");

constexpr int RING_OFF = 0, RING_BYTES = 131072;
constexpr int LDSCTL_OFF = RING_BYTES;
constexpr int ROWTAB_OFF = LDSCTL_OFF + 1024 + 4096, ROWTAB_UNITS = 24;
constexpr int TAB_OFF = LDSCTL_OFF + 1024;
constexpr int LDS_BYTES = 163840;

using pg8::Unit;
struct RepOrder { static constexpr bool ROW_LDS = false;
    const char* A; const char* B; size_t repA, repB, tA, tB; int nM, nN, nrep, G, c;
    __device__ __forceinline__ bool next(int i, Unit& u) const {
        const long L = (long)i * G + c; const int per = nM * nN; if (L >= (long)per * nrep) return false;
        const int rep = (int)(L / per); const int w = pg8::xcd_remap((int)(L % per), per); pg8::grid_tile(w, nM, nN, u.pm, u.pn); u.aux = rep;
        u.A = A + (size_t)rep * repA + (size_t)u.pm * tA; u.B = B + (size_t)rep * repB + (size_t)u.pn * tB; return true; }
    __device__ __forceinline__ int row(const Unit&, int) const { return 0; }
};
struct G1Order { static constexpr bool ROW_LDS = false;
    const char* A; const char* B; size_t tA, tB; int G, c;
    __device__ __forceinline__ bool next(int i, Unit& u) const {
        const long L = (long)i * G + c; constexpr int N1 = 64 * 47, N2 = 4 * 27; if (L >= N1 + N2) return false;
        if (L < N1) { const int w = pg8::xcd_remap((int)L, N1); pg8::grid_tile(w, 64, 47, u.pm, u.pn); }
        else { const int l2 = (int)L - N1; u.pm = 64 + (l2 & 3); u.pn = 4 + (l2 >> 2); }
        u.aux = 0; u.A = A + (size_t)u.pm * tA; u.B = B + (size_t)u.pn * tB; return true; }
    __device__ __forceinline__ int row(const Unit&, int) const { return 0; }
};
template <bool GUMAP> struct MoeOrderT { static constexpr bool ROW_LDS = true;
    const char* A; const char* B; const LAS int* te; const LAS int* rowtab; size_t tA, estride, jstride; int ntiles, NJ, G, c;
    __device__ __forceinline__ bool next(int i, Unit& u) const {
        const long L = (long)i * G + c; const int tot = ntiles * NJ; if (L >= tot) return false;
        const int w = pg8::xcd_remap((int)L, tot); const int rt = w / NJ, j = w - rt * NJ; const int e = te[rt];
        u.pm = rt; u.pn = j; u.aux = e; u.ui = i; u.A = A + (size_t)rt * tA; u.B = B + (GUMAP ? gu_base(e) : (size_t)e * estride) + (size_t)j * jstride; return true; }
    __device__ __forceinline__ int row(const Unit& u, int r) const { return rowtab[u.ui * 256 + r]; }
};

typedef f32x4 AccT[2][2][4][2];
#define EPI_ROWS_BEGIN _Pragma("unroll") for (int ai = 0; ai < 2; ++ai) _Pragma("unroll") for (int m = 0; m < 4; ++m) { const int rl = ai * 128 + wr * 64 + m * 16 + fr;
#define EPI_ROWS_END if (m & 1) asm volatile("" ::: "memory"); }
struct EpiG1 { static constexpr bool PERM = true; bf16* U; bf16* SLAB; unsigned char* GATES;
    __device__ __forceinline__ void operator()(const AccT& acc, const Unit& u, int wr, int wc, int fr, int fq) const {
        if (u.pn >= 31) {
            const int c0 = (u.pn - 31) * 256 + wc * 32 + 8 * fq;
            EPI_ROWS_BEGIN
                unsigned char* rowp = GATES + (size_t)(u.pm * 256 + rl) * 4096 + c0;
#pragma unroll
                for (int bj = 0; bj < 2; ++bj) { const f32x4 v0 = acc[ai][bj][m][0], v1 = acc[ai][bj][m][1]; unsigned p0 = 0u, p1 = 0u;
                    p0 = __builtin_amdgcn_cvt_pk_u8_f32(255.0f * sigmoidf_(v0[0]), 0, p0); p0 = __builtin_amdgcn_cvt_pk_u8_f32(255.0f * sigmoidf_(v0[1]), 1, p0);
                    p0 = __builtin_amdgcn_cvt_pk_u8_f32(255.0f * sigmoidf_(v0[2]), 2, p0); p0 = __builtin_amdgcn_cvt_pk_u8_f32(255.0f * sigmoidf_(v0[3]), 3, p0);
                    p1 = __builtin_amdgcn_cvt_pk_u8_f32(255.0f * sigmoidf_(v1[0]), 0, p1); p1 = __builtin_amdgcn_cvt_pk_u8_f32(255.0f * sigmoidf_(v1[1]), 1, p1);
                    p1 = __builtin_amdgcn_cvt_pk_u8_f32(255.0f * sigmoidf_(v1[2]), 2, p1); p1 = __builtin_amdgcn_cvt_pk_u8_f32(255.0f * sigmoidf_(v1[3]), 3, p1);
                    v2u w; w.x = p0; w.y = p1; *(v2u*)(rowp + bj * 128) = w; }
            EPI_ROWS_END
            return;
        }
        bf16* base; int ld, c0;
        if (u.pn < 4) { base = U; ld = 1024; c0 = u.pn * 256; } else { base = SLAB; ld = SLABLD; c0 = (u.pn - 4) * 256; }
        EPI_ROWS_BEGIN
            bf16* rowp = base + (size_t)(u.pm * 256 + rl) * ld + c0 + wc * 32 + 8 * fq;
#pragma unroll
            for (int bj = 0; bj < 2; ++bj) { const f32x4 v0 = acc[ai][bj][m][0], v1 = acc[ai][bj][m][1];
                v4u w; w.x = pk2(v0[0], v0[1]); w.y = pk2(v0[2], v0[3]); w.z = pk2(v1[0], v1[1]); w.w = pk2(v1[2], v1[3]); *(v4u*)(rowp + bj * 128) = w; }
        EPI_ROWS_END
    }
};
struct EpiLora { static constexpr bool PERM = true; unsigned short* EA; const float* w0; const float* a0;
    __device__ __forceinline__ void operator()(const AccT& acc, const Unit& u, int wr, int wc, int fr, int fq) const {
        const int rep = u.aux; const float* bias = (rep < 2 ? w0 + rep * D : a0 + (rep - 2) * D) + u.pn * 256 + wc * 32 + 8 * fq;
        unsigned short* base = EA + (size_t)rep * ((size_t)MT * D);
        if (rep < 2) { const float cc = -0.8750424f;
            EPI_ROWS_BEGIN
                unsigned short* rowp = base + (size_t)(u.pm * 256 + rl) * D + u.pn * 256 + wc * 32 + 8 * fq;
#pragma unroll
                for (int bj = 0; bj < 2; ++bj) { const f32x4 v0 = acc[ai][bj][m][0] + *(const f32x4*)(bias + bj * 128), v1 = acc[ai][bj][m][1] + *(const f32x4*)(bias + bj * 128 + 4);
                    v4u w; w.x = pkh2(cc * sigmoidf_(v0[0]), cc * sigmoidf_(v0[1])); w.y = pkh2(cc * sigmoidf_(v0[2]), cc * sigmoidf_(v0[3]));
                    w.z = pkh2(cc * sigmoidf_(v1[0]), cc * sigmoidf_(v1[1])); w.w = pkh2(cc * sigmoidf_(v1[2]), cc * sigmoidf_(v1[3]));
                    *(v4u*)(rowp + bj * 128) = w; }
            EPI_ROWS_END
        } else {
            EPI_ROWS_BEGIN
                unsigned char* rowp = (unsigned char*)base + (size_t)(u.pm * 256 + rl) * D + u.pn * 256 + wc * 32 + 8 * fq;
#pragma unroll
                for (int bj = 0; bj < 2; ++bj) { const f32x4 v0 = acc[ai][bj][m][0] + *(const f32x4*)(bias + bj * 128), v1 = acc[ai][bj][m][1] + *(const f32x4*)(bias + bj * 128 + 4); unsigned p0 = 0u, p1 = 0u;
                    p0 = __builtin_amdgcn_cvt_pk_u8_f32(255.0f * sigmoidf_(v0[0]), 0, p0); p0 = __builtin_amdgcn_cvt_pk_u8_f32(255.0f * sigmoidf_(v0[1]), 1, p0);
                    p0 = __builtin_amdgcn_cvt_pk_u8_f32(255.0f * sigmoidf_(v0[2]), 2, p0); p0 = __builtin_amdgcn_cvt_pk_u8_f32(255.0f * sigmoidf_(v0[3]), 3, p0);
                    p1 = __builtin_amdgcn_cvt_pk_u8_f32(255.0f * sigmoidf_(v1[0]), 0, p1); p1 = __builtin_amdgcn_cvt_pk_u8_f32(255.0f * sigmoidf_(v1[1]), 1, p1);
                    p1 = __builtin_amdgcn_cvt_pk_u8_f32(255.0f * sigmoidf_(v1[2]), 2, p1); p1 = __builtin_amdgcn_cvt_pk_u8_f32(255.0f * sigmoidf_(v1[3]), 3, p1);
                    v2u w; w.x = p0; w.y = p1; *(v2u*)(rowp + bj * 128) = w; }
            EPI_ROWS_END
        }
    }
};
struct EpiPoolG { static constexpr bool PERM = true; bf16* Y2; const float* scale;
    __device__ __forceinline__ void operator()(const AccT& acc, const Unit& u, int wr, int wc, int fr, int fq) const {
        const int cb = u.aux * 256 + wc * 32 + 8 * fq;
        f32x4 s0[2], s1[2];
#pragma unroll
        for (int bj = 0; bj < 2; ++bj) { s0[bj] = *(const f32x4*)(scale + cb + bj * 128); s1[bj] = *(const f32x4*)(scale + cb + bj * 128 + 4); }
        EPI_ROWS_BEGIN
            bf16* rowp = Y2 + (size_t)(u.pm * 256 + rl) * 1024 + cb;
#pragma unroll
            for (int bj = 0; bj < 2; ++bj) { const f32x4 v0 = acc[ai][bj][m][0] * s0[bj], v1 = acc[ai][bj][m][1] * s1[bj];
                v4u w; w.x = pk2(v0[0], v0[1]); w.y = pk2(v0[2], v0[3]); w.z = pk2(v1[0], v1[1]); w.w = pk2(v1[2], v1[3]); *(v4u*)(rowp + bj * 128) = w; }
        EPI_ROWS_END
    }
};
template <int MODE, bool OUT8 = false> struct EpiMix { static constexpr bool PERM = true; bf16* OUT;
    int ldo; const void* AUX1; int ld1; const bf16* AUX2; int ld2;
    __device__ __forceinline__ void operator()(const AccT& acc, const Unit& u, int wr, int wc, int fr, int fq) const {
        const int cb = u.pn * 256 + wc * 32 + 8 * fq;
        EPI_ROWS_BEGIN
            const size_t row = (size_t)(u.pm * 256 + rl);
#pragma unroll
            for (int bj = 0; bj < 2; ++bj) { const f32x4 v0 = acc[ai][bj][m][0], v1 = acc[ai][bj][m][1];
                float x[8];
                if (MODE == 1) { const v4u a1 = *(const v4u*)((const bf16*)AUX1 + row * ld1 + cb + bj * 128);
                    x[0] = bflo(a1.x); x[1] = bfhi(a1.x); x[2] = bflo(a1.y); x[3] = bfhi(a1.y); x[4] = bflo(a1.z); x[5] = bfhi(a1.z); x[6] = bflo(a1.w); x[7] = bfhi(a1.w); }
                else { const v2u a1 = *(const v2u*)((const unsigned char*)AUX1 + row * ld1 + cb + bj * 128); const float k = 1.0f / 255.0f;
                    x[0] = (float)(a1.x & 0xffu) * k; x[1] = (float)((a1.x >> 8) & 0xffu) * k; x[2] = (float)((a1.x >> 16) & 0xffu) * k; x[3] = (float)(a1.x >> 24) * k;
                    x[4] = (float)(a1.y & 0xffu) * k; x[5] = (float)((a1.y >> 8) & 0xffu) * k; x[6] = (float)((a1.y >> 16) & 0xffu) * k; x[7] = (float)(a1.y >> 24) * k; }
                float o[8];
                if (MODE == 0 || MODE == 1) {
#pragma unroll
                    for (int j = 0; j < 4; ++j) { o[j] = x[j] * v0[j]; o[4 + j] = x[4 + j] * v1[j]; } }
                else { const v4u a2 = *(const v4u*)(AUX2 + row * ld2 + cb + bj * 128);
                    const float y[8] = {bflo(a2.x), bfhi(a2.x), bflo(a2.y), bfhi(a2.y), bflo(a2.z), bfhi(a2.z), bflo(a2.w), bfhi(a2.w)};
#pragma unroll
                    for (int j = 0; j < 4; ++j) { o[j] = y[j] + x[j] * v0[j]; o[4 + j] = y[4 + j] + x[4 + j] * v1[j]; } }
                if (OUT8) { v2u w; w.x = pk8(8.0f * o[0], 8.0f * o[1], 8.0f * o[2], 8.0f * o[3]); w.y = pk8(8.0f * o[4], 8.0f * o[5], 8.0f * o[6], 8.0f * o[7]); *(v2u*)((unsigned char*)OUT + row * ldo + cb + bj * 128) = w; }
                else { v4u w; w.x = pk2(o[0], o[1]); w.y = pk2(o[2], o[3]); w.z = pk2(o[4], o[5]); w.w = pk2(o[6], o[7]);
                *(v4u*)(OUT + row * ldo + cb + bj * 128) = w; } }
        EPI_ROWS_END
    }
};
struct EpiX1 { static constexpr bool PERM = true; const float* X; bf16* OUT; const float* MOD;
    __device__ __forceinline__ void operator()(const AccT& acc, const Unit& u, int wr, int wc, int fr, int fq) const {
        const int b = u.pm >> 4;
        const int cb = u.pn * 256 + wc * 32 + 8 * fq; const float* g = MOD + (size_t)b * 12288 + 4096 + cb;
        f32x4 gv[2][2];
#pragma unroll
        for (int bj = 0; bj < 2; ++bj)
#pragma unroll
            for (int n = 0; n < 2; ++n) gv[bj][n] = *(const f32x4*)(g + bj * 128 + n * 4);
        EPI_ROWS_BEGIN
            const size_t off = (size_t)(u.pm * 256 + rl) * D + cb;
#pragma unroll
            for (int bj = 0; bj < 2; ++bj) { const f32x4 x0 = *(const f32x4*)(X + off + bj * 128), x1 = *(const f32x4*)(X + off + bj * 128 + 4);
                const f32x4 v0 = x0 + gv[bj][0] * acc[ai][bj][m][0], v1 = x1 + gv[bj][1] * acc[ai][bj][m][1];
                v4u w; w.x = pk2(v0[0], v0[1]); w.y = pk2(v0[2], v0[3]); w.z = pk2(v1[0], v1[1]); w.w = pk2(v1[2], v1[3]); *(v4u*)(OUT + off + bj * 128) = w; }
        EPI_ROWS_END
    }
};
constexpr float ACT_F8SCALE = 8.0f;
struct EpiAct { static constexpr bool PERM = true; unsigned char* ACT;
    __device__ __forceinline__ void operator()(const AccT& acc, const Unit& u, int wr, int wc, int fr, int fq) const {
        EPI_ROWS_BEGIN
            const f32x4 g0 = acc[ai][0][m][0], g1 = acc[ai][0][m][1], u0 = acc[ai][1][m][0], u1 = acc[ai][1][m][1];
            float o[8];
#pragma unroll
            for (int j = 0; j < 4; ++j) { o[j] = __builtin_amdgcn_fmed3f(ACT_F8SCALE * g0[j] * sigmoidf_(g0[j]) * u0[j], -440.f, 440.f); o[4 + j] = __builtin_amdgcn_fmed3f(ACT_F8SCALE * g1[j] * sigmoidf_(g1[j]) * u1[j], -440.f, 440.f); }
            v2u w; w.x = pk8(o[0], o[1], o[2], o[3]); w.y = pk8(o[4], o[5], o[6], o[7]);
            *(v2u*)(ACT + (size_t)(u.pm * 256 + rl) * DEXP + u.pn * 128 + wc * 32 + 8 * fq) = w;
        EPI_ROWS_END
    }
};
constexpr float YP_SCALE = 8.0f;
struct EpiDown { static constexpr bool PERM = true, PERM16 = true; unsigned char* YP;
    __device__ __forceinline__ void operator()(const AccT& acc, const Unit& u, int wr, int wc, int fr, int fq) const {
        const int cb = u.pn * 256 + wc * 64 + 16 * fq;
        EPI_ROWS_BEGIN
            int p[4];
#pragma unroll
            for (int bj = 0; bj < 2; ++bj) { const f32x4 v0 = acc[ai][bj][m][0] * YP_SCALE, v1 = acc[ai][bj][m][1] * YP_SCALE;
                int p0 = __builtin_amdgcn_cvt_pk_fp8_f32(v0[0], v0[1], 0, false); p0 = __builtin_amdgcn_cvt_pk_fp8_f32(v0[2], v0[3], p0, true);
                int p1 = __builtin_amdgcn_cvt_pk_fp8_f32(v1[0], v1[1], 0, false); p1 = __builtin_amdgcn_cvt_pk_fp8_f32(v1[2], v1[3], p1, true);
                p[2 * bj] = p0; p[2 * bj + 1] = p1; }
            v4u w; w.x = (unsigned)p[0]; w.y = (unsigned)p[1]; w.z = (unsigned)p[2]; w.w = (unsigned)p[3];
            *(v4u*)(YP + (size_t)(u.pm * 256 + rl) * D + cb) = w;
        EPI_ROWS_END
    }
};
struct Frame {
    LAS unsigned char* lds;
    volatile LAS unsigned* MISC;
    unsigned* ctl;
    int tid, lane, wave, vcu, G;
    unsigned char* ws;
};
struct Args { const float* in[34]; float* out; unsigned char* ws; int ph_lo, ph_hi; };
enum { I_X = 0, I_C, I_CTX, I_CCTX, I_N1G, I_N2G, I_ADAW, I_ADAB, I_WIN, I_MU, I_POOLW, I_POOLS, I_WPO, I_DW0, I_DW2, I_IA0, I_IA2, I_G2, I_KK, I_KA, I_RK, I_LNW, I_LNB,
       I_WRO, I_WO, I_RW, I_RB, I_EG, I_EU, I_ED, I_SG, I_SU, I_SD, I_FG };

struct TrJob { const float* src; bf16* dst; int ldw, kvalid, ldt, k0, n0, drow0; float f8; };
template <bool NT = false> __device__ __forceinline__ void tr_load(const TrJob& j, f32x4 (&v)[16], int lane) {
    const int r2 = lane >> 4, c4 = lane & 15;
#pragma unroll
    for (int i = 0; i < 8; ++i) {
#pragma unroll
        for (int h = 0; h < 2; ++h) { const int k = j.k0 + 8 * i + 2 * r2 + h; const int kc = k < j.kvalid ? k : 0;
            const f32x4* sp_ = (const f32x4*)(j.src + (size_t)kc * j.ldw + j.n0 + 4 * c4); const f32x4 x = NT ? __builtin_nontemporal_load(sp_) : *sp_; v[2 * i + h] = (k < j.kvalid) ? x : (f32x4){0.f, 0.f, 0.f, 0.f}; } }
}
template <bool NT = false> __device__ __forceinline__ void tr_store(const TrJob& j, const f32x4 (&v)[16], LAS unsigned* P, int lane) {
    const int r2 = lane >> 4, c4 = lane & 15;
#pragma unroll
    for (int i = 0; i < 8; ++i) { LAS unsigned* p = P + (4 * i + r2) * 65 + 4 * c4;
        p[0] = pk2(v[2 * i].x, v[2 * i + 1].x); p[1] = pk2(v[2 * i].y, v[2 * i + 1].y); p[2] = pk2(v[2 * i].z, v[2 * i + 1].z); p[3] = pk2(v[2 * i].w, v[2 * i + 1].w); }
    LDS_WAIT(); asm volatile("" ::: "memory");
    const int nl = lane >> 3, q = lane & 7;
#pragma unroll
    for (int jj = 0; jj < 8; ++jj) { const int n = 8 * jj + nl; const LAS unsigned* s = P + (4 * q) * 65 + n;
        v4u o; o.x = s[0]; o.y = s[65]; o.z = s[130]; o.w = s[195];
        v4u* dp_ = (v4u*)(j.dst + (size_t)(j.drow0 + n) * j.ldt + j.k0 + 8 * q); if (NT) __builtin_nontemporal_store(o, dp_); else *dp_ = o; }
    LDS_WAIT(); asm volatile("" ::: "memory");
}
template <bool NT = false> __device__ __forceinline__ void tr_load8(const TrJob& j, f32x4 (&v)[16], int lane) {
    const int r2 = lane >> 4, c4 = lane & 15;
#pragma unroll
    for (int i = 0; i < 4; ++i) {
#pragma unroll
        for (int h = 0; h < 4; ++h) { const int k = j.k0 + 16 * i + 4 * r2 + h; const f32x4* sp_ = (const f32x4*)(j.src + (size_t)k * j.ldw + j.n0 + 4 * c4); v[4 * i + h] = NT ? __builtin_nontemporal_load(sp_) : *sp_; } }
}
template <bool NT = false> __device__ __forceinline__ void tr_store8(const TrJob& j, const f32x4 (&v)[16], LAS unsigned* P, int lane) {
    const int r2 = lane >> 4, c4 = lane & 15; const float sc = j.f8;
#pragma unroll
    for (int i = 0; i < 4; ++i) { LAS unsigned* p = P + (4 * i + r2) * 65 + 4 * c4;
        p[0] = pk8(sc * v[4 * i].x, sc * v[4 * i + 1].x, sc * v[4 * i + 2].x, sc * v[4 * i + 3].x); p[1] = pk8(sc * v[4 * i].y, sc * v[4 * i + 1].y, sc * v[4 * i + 2].y, sc * v[4 * i + 3].y);
        p[2] = pk8(sc * v[4 * i].z, sc * v[4 * i + 1].z, sc * v[4 * i + 2].z, sc * v[4 * i + 3].z); p[3] = pk8(sc * v[4 * i].w, sc * v[4 * i + 1].w, sc * v[4 * i + 2].w, sc * v[4 * i + 3].w); }
    LDS_WAIT(); asm volatile("" ::: "memory");
    const int nl = lane >> 2, q = lane & 3;
#pragma unroll
    for (int jj = 0; jj < 4; ++jj) { const int n = 16 * jj + nl; const LAS unsigned* s = P + (4 * q) * 65 + n;
        v4u o; o.x = s[0]; o.y = s[65]; o.z = s[130]; o.w = s[195];
        v4u* dp_ = (v4u*)((unsigned char*)j.dst + (size_t)(j.drow0 + n) * j.ldt + j.k0 + 16 * q); if (NT) __builtin_nontemporal_store(o, dp_); else *dp_ = o; }
    LDS_WAIT(); asm volatile("" ::: "memory");
}
template <bool NT = false> __device__ __forceinline__ void tr_ld(const TrJob& j, f32x4 (&v)[16], int lane) { if (j.f8 != 0.f) tr_load8<NT>(j, v, lane); else tr_load<NT>(j, v, lane); }
template <bool NT = false> __device__ __forceinline__ void tr_st(const TrJob& j, const f32x4 (&v)[16], LAS unsigned* P, int lane) { if (j.f8 != 0.f) tr_store8<NT>(j, v, P, lane); else tr_store<NT>(j, v, P, lane); }
template <class Dec> __device__ __forceinline__ void tr_run(const Dec& dec, int first, int stride, LAS unsigned* P, int lane) {
    TrJob ja, jb; f32x4 va[16], vb[16];
    int it = first; bool ha = dec(it, ja); if (ha) tr_ld(ja, va, lane);
    while (ha) {
        it += stride; const bool hb = dec(it, jb); if (hb) tr_ld(jb, vb, lane);
        tr_st(ja, va, P, lane);
        if (!hb) break;
        it += stride; ha = dec(it, ja); if (ha) tr_ld(ja, va, lane);
        tr_st(jb, vb, P, lane);
    }
}
__device__ __forceinline__ void p0_prologue(Frame& F, const Args& a) {
    {
        LAS float* sv = (LAS float*)F.lds;
        LAS float* part = (LAS float*)(F.lds + 40960);
        bool did = false;
        for (int cb = blockIdx.x; cb < 192; cb += F.G) {
            if (!did) { for (int idx = F.tid; idx < 5 * D; idx += 512) { const int j = idx >> 11, k = idx & 2047; const float v = (j < 4) ? a.in[I_C][j * D + k] : a.in[I_CCTX][k]; sv[idx] = v / (1.0f + __expf(-v)); } did = true; }
            __syncthreads();
            const int col = 64 * cb + F.lane, k0 = 256 * F.wave; const float* wp = a.in[I_ADAW] + (size_t)k0 * 12288 + col;
            float acc[5] = {0.f, 0.f, 0.f, 0.f, 0.f};
#pragma unroll 32
            for (int k = 0; k < 256; ++k) { const float w = wp[(size_t)k * 12288];
#pragma unroll
                for (int j = 0; j < 5; ++j) acc[j] += sv[j * D + k0 + k] * w; }
#pragma unroll
            for (int j = 0; j < 5; ++j) part[(F.wave * 5 + j) * 64 + F.lane] = acc[j];
            __syncthreads();
            if (F.tid < 320) { const int j = F.tid >> 6, l = F.tid & 63; float s = a.in[I_ADAB][64 * cb + l];
#pragma unroll
                for (int w = 0; w < 8; ++w) s += part[(w * 5 + j) * 64 + l];
                ((float*)(F.ws + WS_MOD))[j * 12288 + 64 * cb + l] = s; }
            __syncthreads();
        }
        __syncthreads();
    }
    {
        struct DecSmall { const float* const* in; unsigned char* ws;
            __device__ __forceinline__ bool operator()(int it, TrJob& j) const {
                constexpr int I_1 = 32 * 186, I_2 = 4 * 16, I_3 = 16 * 32, I_4 = 4 * 32, I_5 = 32 * 32, I_6 = 32 * 32, I_7 = 4 * 2 * 32;
                int r = it; if (r < 0) return false;
                if (r < I_1) { const int kb = r / 186, nb = r % 186, n0 = nb * 64; j = TrJob{in[I_WIN], (bf16*)(ws + WS_WIN), DIN, D, D, kb * 64, n0, n0 + (n0 >= 7808 ? 128 : 0), P2_FP8 ? 8.0f : 0.0f}; return true; } r -= I_1;
                if (r < I_2) { const int g = r / 16, q = r % 16; j = TrJob{in[I_POOLW] + (size_t)g * 65536, (bf16*)(ws + WS_POOLW) + (size_t)g * 65536, 256, 256, 256, (q / 4) * 64, (q % 4) * 64, (q % 4) * 64}; return true; } r -= I_2;
                if (r < I_3) { j = TrJob{in[I_WPO], (bf16*)(ws + WS_WPO), D, 1024, 1024, (r / 32) * 64, (r % 32) * 64, (r % 32) * 64}; return true; } r -= I_3;
                if (r < I_4) { j = TrJob{in[I_G2], (bf16*)(ws + WS_G2), D, 256, 256, (r / 32) * 64, (r % 32) * 64, (r % 32) * 64}; return true; } r -= I_4;
                if (r < I_5) { j = TrJob{in[I_WRO], (bf16*)(ws + WS_WRO), D, D, D, (r / 32) * 64, (r % 32) * 64, (r % 32) * 64}; return true; } r -= I_5;
                if (r < I_6) { j = TrJob{in[I_WO], (bf16*)(ws + WS_WO), D, D, D, (r / 32) * 64, (r % 32) * 64, (r % 32) * 64, P10_FP8 ? 8.0f : 0.0f}; return true; } r -= I_6;
                if (r < I_7) { const int mtx = r / 64, q = r % 64;
                    const float* src = (mtx < 2 ? in[I_DW2] + (size_t)mtx * 96 * D : in[I_IA2] + (size_t)(mtx - 2) * 96 * D);
                    j = TrJob{src, (bf16*)(ws + WS_LORA) + (size_t)mtx * D * 128, D, 96, 128, (q / 32) * 64, (q % 32) * 64, (q % 32) * 64}; return true; }
                return false; } };
        DecSmall dec{a.in, F.ws};
        tr_run(dec, F.vcu * 8 + F.wave, F.G * 8, (LAS unsigned*)(F.lds + F.wave * 16384), F.lane);
    }
    const int gt = F.vcu * 512 + F.tid, NGT = F.G * 512;
    { v4u* z = (v4u*)(F.ws + WS_WIN + (size_t)7808 * D * (P2_FP8 ? 1 : 2)); for (int i = gt; i < 128 * D / (P2_FP8 ? 16 : 8); i += NGT) z[i] = (v4u){0u, 0u, 0u, 0u}; }
    { int* tok = (int*)(F.ws + WS_TOK); for (int i = gt; i < NSLOT; i += NGT) tok[i] = 0; }
}

__device__ __forceinline__ void p1_norm1(Frame& F, const Args& a) {
    const int gw = F.vcu * 8 + F.wave, NGW = F.G * 8; const float* MOD = (const float*)(F.ws + WS_MOD); bf16* HA = (bf16*)(F.ws + WS_HA);
    for (int mrow = gw; mrow < MT; mrow += NGW) {
        const float* src = (mrow < NT) ? a.in[I_X] + (size_t)mrow * D : a.in[I_CTX] + (size_t)(mrow - NT) * D; const int j = (mrow < NT) ? (mrow >> 12) : 4;
        const f32x4* xr = (const f32x4*)src + F.lane; f32x4 v[8]; float s = 0.f;
#pragma unroll
        for (int q = 0; q < 8; ++q) { v[q] = xr[64 * q]; s += (v[q].x * v[q].x + v[q].y * v[q].y) + (v[q].z * v[q].z + v[q].w * v[q].w); }
        const float rstd = 1.0f / sqrtf(wave_sum(s) * (1.0f / D) + 1e-6f);
        const f32x4* g = (const f32x4*)a.in[I_N1G] + F.lane; const f32x4* sh = (const f32x4*)(MOD + (size_t)j * 12288) + F.lane; const f32x4* sc = (const f32x4*)(MOD + (size_t)j * 12288 + 2048) + F.lane;
        v2u* o = (v2u*)(HA + (size_t)mrow * D) + F.lane; unsigned* o8 = (unsigned*)((unsigned char*)HA + (size_t)mrow * D) + F.lane;
#pragma unroll
        for (int q = 0; q < 8; ++q) { const f32x4 y = v[q] * rstd * g[64 * q] * (sc[64 * q] + 1.0f) + sh[64 * q];
            if (P2_FP8) o8[64 * q] = pk8(8.0f * y.x, 8.0f * y.y, 8.0f * y.z, 8.0f * y.w); else { v2u w; w.x = pk2(y.x, y.y); w.y = pk2(y.z, y.w); o[64 * q] = w; } }
    }
}

template <int W> __device__ __forceinline__ void pool_item(const unsigned* U32, unsigned* DP32, int m0, int cp) {
    unsigned raw[64];
#pragma unroll
    for (int x = 0; x < 64; ++x) raw[x] = U32[(size_t)(m0 + x) * 512 + cp];
    float lo[64], hi[64];
#pragma unroll
    for (int x = 0; x < 64; ++x) { lo[x] = bflo(raw[x]); hi[x] = bfhi(raw[x]); }
#pragma unroll
    for (int x = 0; x < 64; ++x) { const int l = (x - W / 2) < 0 ? 0 : (x - W / 2), h = (x + W / 2) > 64 ? 64 : (x + W / 2); float s0 = 0.f, s1 = 0.f;
#pragma unroll
        for (int j = l; j < h; ++j) { s0 += lo[j]; s1 += hi[j]; }
        const float inv = 1.0f / (float)(h - l); DP32[(size_t)(m0 + x) * 512 + cp] = pk2(s0 * inv - lo[x], s1 * inv - hi[x]); }
}
__device__ __forceinline__ void p3_mix_store(const v4u o, const v4u nb, const f32x4 m0, const f32x4 m1, int c0, int mrow, bf16* RM, bf16* KM, bf16* VM, bf16* LIN) {
    float r[8];
    { const float ov[8] = {bflo(o.x), bfhi(o.x), bflo(o.y), bfhi(o.y), bflo(o.z), bfhi(o.z), bflo(o.w), bfhi(o.w)};
      const float nv[8] = {bflo(nb.x), bfhi(nb.x), bflo(nb.y), bfhi(nb.y), bflo(nb.z), bfhi(nb.z), bflo(nb.w), bfhi(nb.w)};
      const float mv[8] = {m0.x, m0.y, m0.z, m0.w, m1.x, m1.y, m1.z, m1.w};
#pragma unroll
      for (int e = 0; e < 8; ++e) r[e] = ov[e] + (nv[e] - ov[e]) * mv[e]; }
    bf16* dstp;
    if (c0 < 2048) dstp = RM + (size_t)mrow * D + c0;
    else if (c0 < 4096) dstp = KM + (size_t)mrow * D + (c0 - 2048);
    else if (c0 < 6144) dstp = VM + (size_t)mrow * D + (c0 - 4096);
    else { const int lc = c0 - 6144; int dc;
        if (lc < 192) {
#pragma unroll
            for (int e = 0; e < 8; ++e) r[e] = tanhf_(r[e]);
            dc = (lc < 96) ? lc : 128 + (lc - 96); }
        else if (lc < 384) dc = (lc < 288) ? 256 + (lc - 192) : 384 + (lc - 288);
        else {
#pragma unroll
            for (int e = 0; e < 8; ++e) r[e] = sigmoidf_(r[e]);
            dc = 512 + (lc - 384); }
        dstp = LIN + (size_t)mrow * LINLD + dc; }
    v4u w; w.x = pk2(r[0], r[1]); w.y = pk2(r[2], r[3]); w.z = pk2(r[4], r[5]); w.w = pk2(r[6], r[7]); *(v4u*)dstp = w;
}
constexpr int P3_SLICE = 512, P3_NSLICE = (DSH + P3_SLICE - 1) / P3_SLICE  , P3_SLOTS = 96;
__device__ __forceinline__ void p3_prep(Frame& F, const Args& a) {
    const bf16* SLAB = (const bf16*)(F.ws + WS_SLAB); const float* mu = a.in[I_MU];
    bf16* RM = (bf16*)(F.ws + WS_RM); bf16* KM = (bf16*)(F.ws + WS_KM); bf16* VM = (bf16*)(F.ws + WS_VM); bf16* LIN = (bf16*)(F.ws + WS_LIN);
    LAS unsigned char* T = F.lds;
    const int w = F.wave, lane = F.lane;
    for (int pid = F.vcu; pid < NB * 64; pid += F.G) {
        const int b = pid >> 6, py = (pid >> 3) & 7, px = pid & 7; const int m00 = b * TSEQ + (py * 8) * 64 + px * 8;
        int srow[12];
#pragma unroll
        for (int i = 0; i < 12; ++i) { const int sl = w * 12 + i; int gyl, gxl; bool ok = true;
            if (sl < 64) { gyl = sl >> 3; gxl = sl & 7; } else if (sl < 72) { gyl = -1; gxl = sl - 64; ok = py > 0; } else if (sl < 80) { gyl = 8; gxl = sl - 72; ok = py < 7; }
            else if (sl < 88) { gyl = sl - 80; gxl = -1; ok = px > 0; } else { gyl = sl - 88; gxl = 8; ok = px < 7; }
            srow[i] = ok ? m00 + gyl * 64 + gxl : m00; }
        v4u pre[12];
        { const int cl = lane * 8;
#pragma unroll
          for (int i = 0; i < 12; ++i) pre[i] = *(const v4u*)(SLAB + (size_t)srow[i] * SLABLD + cl); }
        for (int sl_ = 0; sl_ < P3_NSLICE; ++sl_) {
            const int c0 = sl_ * P3_SLICE + lane * 8; const bool cok = c0 < DSH;
            __syncthreads();
#pragma unroll
            for (int i = 0; i < 12; ++i) *(LAS v4u*)(T + (w * 12 + i) * 1024 + lane * 16) = pre[i];
            if (sl_ + 1 < P3_NSLICE) { const int cn = (sl_ + 1) * P3_SLICE + lane * 8; const int cl = cn < DSH ? cn : 0;
#pragma unroll
                for (int i = 0; i < 12; ++i) pre[i] = *(const v4u*)(SLAB + (size_t)srow[i] * SLABLD + cl); }
            __syncthreads();
            const f32x4 m0 = *(const f32x4*)(mu + (cok ? c0 : 0)), m1 = *(const f32x4*)(mu + (cok ? c0 : 0) + 4);
            const int gy = py * 8 + w; const unsigned k2m = gy > 0 ? 0xffffu : 0u, k3m = gy < 63 ? 0xffff0000u : 0u;
#pragma unroll
            for (int x = 0; x < 8; ++x) {
                const int gx = px * 8 + x; const unsigned k0m = gx > 0 ? 0xffffu : 0u, k1m = gx < 63 ? 0xffff0000u : 0u;
                const int so = w * 8 + x, sL = x > 0 ? so - 1 : 80 + w, sR = x < 7 ? so + 1 : 88 + w, sU = w > 0 ? so - 8 : 64 + x, sD = w < 7 ? so + 8 : 72 + x;
                const v4u o = *(const LAS v4u*)(T + so * 1024 + lane * 16), n0 = *(const LAS v4u*)(T + sL * 1024 + lane * 16), n1 = *(const LAS v4u*)(T + sR * 1024 + lane * 16),
                          n2 = *(const LAS v4u*)(T + sU * 1024 + lane * 16), n3 = *(const LAS v4u*)(T + sD * 1024 + lane * 16);
                v4u nb; nb.x = (n0.x & k0m) | (n1.x & k1m); nb.y = (n2.y & k2m) | (n3.y & k3m); nb.z = (n0.z & k0m) | (n1.z & k1m); nb.w = (n2.w & k2m) | (n3.w & k3m);
                const int mrow = m00 + w * 64 + x;
                if (cok) p3_mix_store(o, nb, m0, m1, c0, mrow, RM, KM, VM, LIN);
                if (sl_ == P3_NSLICE - 1 && lane >= 48) { const int l16 = lane - 48, p = l16 >> 2, off = (l16 & 3) * 8; *(v4u*)(LIN + (size_t)mrow * LINLD + 128 * p + 96 + off) = (v4u){0u, 0u, 0u, 0u}; }
            }
        }
        __syncthreads();
    }
    const int gw = F.vcu * 8 + F.wave, NGW = F.G * 8;
    for (int mrow = NT + gw; mrow < MT; mrow += NGW) {
        const bf16* own = SLAB + (size_t)mrow * SLABLD; const int sidx = (mrow - NT) & 255; const bool v0 = sidx > 0, v1 = sidx < 255;
        const bf16* p0 = v0 ? own - SLABLD : own; const bf16* p1 = v1 ? own + SLABLD : own;
        const unsigned k0m = v0 ? 0xffffu : 0u, k1m = v1 ? 0xffff0000u : 0u;
        for (int ci0 = F.lane; ci0 < DSH / 8; ci0 += 256) {
            v4u o[4], nb[4]; f32x4 m0[4], m1[4];
#pragma unroll
            for (int u = 0; u < 4; ++u) { const int ci = ci0 + 64 * u; const int c0 = (ci < DSH / 8 ? ci : F.lane) * 8;
                o[u] = *(const v4u*)(own + c0); const v4u n0 = *(const v4u*)(p0 + c0), n1 = *(const v4u*)(p1 + c0);
                nb[u].x = (n0.x & k0m) | (n1.x & k1m); nb[u].y = (n0.y & k0m) | (n1.y & k1m); nb[u].z = (n0.z & k0m) | (n1.z & k1m); nb[u].w = (n0.w & k0m) | (n1.w & k1m);
                m0[u] = *(const f32x4*)(mu + c0); m1[u] = *(const f32x4*)(mu + c0 + 4); }
#pragma unroll
            for (int u = 0; u < 4; ++u) { const int ci = ci0 + 64 * u; if (ci < DSH / 8) p3_mix_store(o[u], nb[u], m0[u], m1[u], ci * 8, mrow, RM, KM, VM, LIN); }
        }
        if (F.lane < 16) { const int p = F.lane >> 2, off = (F.lane & 3) * 8; *(v4u*)(LIN + (size_t)mrow * LINLD + 128 * p + 96 + off) = (v4u){0u, 0u, 0u, 0u}; }
    }
    const unsigned* U32 = (const unsigned*)(F.ws + WS_U); unsigned* DP32 = (unsigned*)(F.ws + WS_DP);
    for (int gr = F.vcu; gr < 256; gr += F.G) {
        const int m0 = gr * 64, cp = F.tid; const int g = F.wave >> 1;
        if (g == 0) pool_item<2>(U32, DP32, m0, cp); else if (g == 1) pool_item<4>(U32, DP32, m0, cp); else if (g == 2) pool_item<8>(U32, DP32, m0, cp); else pool_item<16>(U32, DP32, m0, cp);
    }
}

constexpr int CK = 16, NSL = 8;
constexpr int SL_Z = 0, SL_AF = 2560, SL_TMT = 3584, SL_ABF = 4096, SL_TM = 4608, SL_ZTT = 5120, SL_RT = 7680, SL_CRT = 9728, SL_ART = 10240, SL_BGT = 10752, SL_KGT = 12800, SL_VT = 14848, SL_GC = 16896,
              SL_SIZE = 17152, ZTT_LD = 80, SB_OFF = 7 * SL_SIZE  , SL7_OFF = 132096  ;
static_assert(SB_OFF + 8192 <= 131072 && SL7_OFF + SL_SIZE <= 163840, "scan LDS map");
__device__ __forceinline__ int kpos(int zt, int q) { return 32 * (zt >> 1) + 8 * q + 4 * (zt & 1); }
__device__ __forceinline__ int slot_off(int n) { return n < 7 ? n * SL_SIZE : SL7_OFF; }
__device__ __forceinline__ int sw64(int row, int col) { return (row * 64 + ((((col >> 3) ^ (row & 7)) << 3) | (col & 7))) * 2; }
__device__ __forceinline__ int scan_row(int n, int b, int dir) {
    if (n < CTXL) return NT + b * CTXL + (dir ? (CTXL - 1 - n) : n);
    const int t = n - CTXL; return b * TSEQ + (dir ? (TSEQ - 1 - t) : t);
}
__device__ __forceinline__ bf16x8 frag_ld(const LAS unsigned char* p, bool ok) { v4u z = (v4u){0u, 0u, 0u, 0u}; if (ok) z = *(const LAS v4u*)p; return __builtin_bit_cast(bf16x8, z); }
__device__ __forceinline__ f32x4 mfma16(bf16x8 a, bf16x8 b, f32x4 c) { return __builtin_amdgcn_mfma_f32_16x16x32_bf16(a, b, c, 0, 0, 0); }
__device__ __forceinline__ float dpp_shr(float v, const int n, float fill) {
    const int x = __builtin_bit_cast(int, v), f = __builtin_bit_cast(int, fill); int r;
    if (n == 1) r = __builtin_amdgcn_update_dpp(f, x, 0x111, 0xF, 0xF, false); else if (n == 2) r = __builtin_amdgcn_update_dpp(f, x, 0x112, 0xF, 0xF, false);
    else if (n == 4) r = __builtin_amdgcn_update_dpp(f, x, 0x114, 0xF, 0xF, false); else r = __builtin_amdgcn_update_dpp(f, x, 0x118, 0xF, 0xF, false);
    return __builtin_bit_cast(float, r);
}
struct SeqOps { bf16x8 fV, fZc, fZk[2], fR[2], fCr, fAr4, fKG[4], fBG4[4]; f32x4 gc[4]; };
__device__ __forceinline__ bf16x8 frag4_ld(const LAS unsigned char* p) { const v2u t = *(const LAS v2u*)p; v4u z; z.x = t.x; z.y = t.y; z.z = 0u; z.w = 0u; return __builtin_bit_cast(bf16x8, z); }
__device__ __forceinline__ void seq_load(SeqOps& o, const LAS unsigned char* SL, int w, int c, int q, bool klo) {
    o.fV = frag_ld(SL + SL_VT + ((16 * w + c) * 16 + 8 * q) * 2, klo);
    o.fZc = frag_ld(SL + SL_ZTT + (c * ZTT_LD + 64 + 8 * q) * 2, klo); o.fCr = frag_ld(SL + SL_CRT + (c * 16 + 8 * q) * 2, klo); o.fAr4 = frag4_ld(SL + SL_ART + (c * 16 + 4 * q) * 2);
#pragma unroll
    for (int ks = 0; ks < 2; ++ks) { o.fZk[ks] = frag_ld(SL + SL_ZTT + (c * ZTT_LD + 32 * ks + 8 * q) * 2, true); o.fR[ks] = frag_ld(SL + SL_RT + sw64(c, 32 * ks + 8 * q), true); }
#pragma unroll
    for (int jt = 0; jt < 4; ++jt) { o.fKG[jt] = frag_ld(SL + SL_KGT + ((16 * jt + c) * 16 + 8 * q) * 2, klo); o.fBG4[jt] = frag4_ld(SL + SL_BGT + ((16 * jt + c) * 16 + 4 * q) * 2);
        o.gc[jt] = *(const LAS f32x4*)(SL + SL_GC + (16 * jt + 4 * q) * 4); }
}
__device__ __forceinline__ void seq_step(const SeqOps& o, f32x4 (&X)[4], bool emit, bf16* YO, int chunk, int b, int dir, int h, int w, int c, int q) {
    const f32x4 z4 = (f32x4){0.f, 0.f, 0.f, 0.f};
    bf16x8 fS[2];
#pragma unroll
    for (int ks = 0; ks < 2; ++ks) { v4u p; p.x = pk2(X[2 * ks][0], X[2 * ks][1]); p.y = pk2(X[2 * ks][2], X[2 * ks][3]); p.z = pk2(X[2 * ks + 1][0], X[2 * ks + 1][1]); p.w = pk2(X[2 * ks + 1][2], X[2 * ks + 1][3]);
        fS[ks] = __builtin_bit_cast(bf16x8, p); }
    f32x4 un = mfma16(o.fZc, o.fV, z4);
#pragma unroll
    for (int ks = 0; ks < 2; ++ks) un = mfma16(o.fZk[ks], fS[ks], un);
    bf16x8 fU; { v4u p; p.x = pk2(un[0], un[1]); p.y = pk2(un[2], un[3]); p.z = 0u; p.w = 0u; fU = __builtin_bit_cast(bf16x8, p); }
    if (emit) {
        f32x4 y = mfma16(o.fCr, o.fV, z4); y = mfma16(o.fAr4, fU, y);
#pragma unroll
        for (int ks = 0; ks < 2; ++ks) y = mfma16(o.fR[ks], fS[ks], y);
#pragma unroll
        for (int g = 0; g < 4; ++g) YO[(size_t)scan_row(chunk * CK + 4 * q + g, b, dir) * D + h * 64 + 16 * w + c] = (bf16)f2bf(y[g]);
    }
#pragma unroll
    for (int jt = 0; jt < 4; ++jt) { const f32x4 d = mfma16(o.fBG4[jt], fU, mfma16(o.fKG[jt], o.fV, z4));
        X[jt] = X[jt] * o.gc[jt] + d; }
}
struct ScanRaw { v4u r[2], k[2], v[2], e[2]; v2u a[2]; };
__device__ __forceinline__ void scan_fetch(ScanRaw& R, const bf16* RM, const bf16* KM, const bf16* VM, const unsigned char* AX, const unsigned short* EX, size_t rowoff) {
#pragma unroll
    for (int ks = 0; ks < 2; ++ks) { const size_t off = rowoff + 32 * ks; R.r[ks] = *(const v4u*)(RM + off); R.k[ks] = *(const v4u*)(KM + off); R.v[ks] = *(const v4u*)(VM + off); R.a[ks] = *(const v2u*)(AX + off); R.e[ks] = *(const v4u*)(EX + off); }
}
__device__ __forceinline__ void p6_scan(Frame& F, const Args& a) {
    const bf16* RM = (const bf16*)(F.ws + WS_RM); const bf16* KM = (const bf16*)(F.ws + WS_KM); const bf16* VM = (const bf16*)(F.ws + WS_VM);
    const int lane = F.lane, w = F.wave, c0_ = lane & 15, q0_ = lane >> 4;
    for (int unit = blockIdx.x; unit < NB * NH * 2; unit += F.G) {
        const int dir = unit & 1, h = (unit >> 1) & 31, b = unit >> 6;
        const unsigned short* EX = (const unsigned short*)(F.ws + WS_EA + (size_t)dir * EA_STRIDE);
        const unsigned char* AX = (const unsigned char*)(F.ws + WS_EA + (size_t)(2 + dir) * EA_STRIDE);
        bf16* YO = (bf16*)(F.ws + (dir ? WS_YB : WS_YF)); float* BON = (float*)(F.ws + WS_BON) + (size_t)dir * NT * NH;
        f32x4 X[4];
#pragma unroll
        for (int jt = 0; jt < 4; ++jt) X[jt] = (f32x4){0.f, 0.f, 0.f, 0.f};
        constexpr int NBATCH = (CTXL + TSEQ) / CK / NSL;
        { LAS float* cst = (LAS float*)(F.lds + SB_OFF);
          if (F.tid < 192) { const int which = F.tid >> 6, j = F.tid & 63; cst[F.tid] = (which == 0 ? a.in[I_KK] : which == 1 ? a.in[I_KA] : a.in[I_RK])[h * 64 + j]; } }
        ScanRaw R; scan_fetch(R, RM, KM, VM, AX, EX, (size_t)scan_row(w * CK + c0_, b, dir) * D + h * 64 + 8 * q0_);
        __syncthreads();
        for (int bt = 0; bt < NBATCH; ++bt) {
            int c = c0_, q = q0_; asm volatile("" : "+v"(c), "+v"(q));
            const bool klo = q < 2;
            {
                LAS unsigned char* SL = F.lds + slot_off(w);
                int cq8 = 8 * q; asm volatile("" : "+v"(cq8));
                const LAS float* cst = (const LAS float*)(F.lds + SB_OFF) + cq8;
                float ss = 0.f;
#pragma unroll
                for (int ks = 0; ks < 2; ++ks) {
                    const f32x4 k0 = *(const LAS f32x4*)(cst + 32 * ks), k1 = *(const LAS f32x4*)(cst + 32 * ks + 4);
                    const float kv[8] = {bflo(R.k[ks].x), bfhi(R.k[ks].x), bflo(R.k[ks].y), bfhi(R.k[ks].y), bflo(R.k[ks].z), bfhi(R.k[ks].z), bflo(R.k[ks].w), bfhi(R.k[ks].w)};
#pragma unroll
                    for (int e = 0; e < 4; ++e) { const float p0 = kv[e] * k0[e], p1 = kv[4 + e] * k1[e]; ss += p0 * p0 + p1 * p1; } }
                ss += __shfl_xor(ss, 16); ss += __shfl_xor(ss, 32);
                const float inv = __builtin_amdgcn_rsqf(ss + 1e-12f);
                bf16x8 fKT[2], fRT[2], fBT[2], fKQ[2]; float bonp = 0.f;
#pragma unroll
                for (int ks = 0; ks < 2; ++ks) {
                    const v4u xr = R.r[ks], xk = R.k[ks], xv = R.v[ks], xe = R.e[ks]; const v2u xa = R.a[ks];
                    const f32x4 k0 = *(const LAS f32x4*)(cst + 32 * ks), k1 = *(const LAS f32x4*)(cst + 32 * ks + 4), a0 = *(const LAS f32x4*)(cst + 64 + 32 * ks), a1 = *(const LAS f32x4*)(cst + 64 + 32 * ks + 4);
                    const float kkw[8] = {k0[0], k0[1], k0[2], k0[3], k1[0], k1[1], k1[2], k1[3]}, kaw[8] = {a0[0], a0[1], a0[2], a0[3], a1[0], a1[1], a1[2], a1[3]};
                    const f32x4 q0 = *(const LAS f32x4*)(cst + 128 + 32 * ks), q1 = *(const LAS f32x4*)(cst + 128 + 32 * ks + 4); const float rkw[8] = {q0[0], q0[1], q0[2], q0[3], q1[0], q1[1], q1[2], q1[3]};
                    const float r[8] = {bflo(xr.x), bfhi(xr.x), bflo(xr.y), bfhi(xr.y), bflo(xr.z), bfhi(xr.z), bflo(xr.w), bfhi(xr.w)};
                    const float k[8] = {bflo(xk.x), bfhi(xk.x), bflo(xk.y), bfhi(xk.y), bflo(xk.z), bfhi(xk.z), bflo(xk.w), bfhi(xk.w)};
                    const float v[8] = {bflo(xv.x), bfhi(xv.x), bflo(xv.y), bfhi(xv.y), bflo(xv.z), bfhi(xv.z), bflo(xv.w), bfhi(xv.w)};
                    const float ku8 = 1.0f / 255.0f;
                    const float ai[8] = {(float)(xa.x & 0xffu) * ku8, (float)((xa.x >> 8) & 0xffu) * ku8, (float)((xa.x >> 16) & 0xffu) * ku8, (float)(xa.x >> 24) * ku8,
                                         (float)(xa.y & 0xffu) * ku8, (float)((xa.y >> 8) & 0xffu) * ku8, (float)((xa.y >> 16) & 0xffu) * ku8, (float)(xa.y >> 24) * ku8};
                    const float lw[8] = {hlo(xe.x), hhi(xe.x), hlo(xe.y), hhi(xe.y), hlo(xe.z), hhi(xe.z), hlo(xe.w), hhi(xe.w)};
                    float kt[8], rt[8], btl[8], kq[8], cl[8], G[8], Gi[8], Gm[8], GCv[8];
#pragma unroll
                    for (int e = 0; e < 8; ++e) cl[e] = lw[e];
#pragma unroll
                    for (int e = 0; e < 8; ++e) cl[e] += dpp_shr(cl[e], 1, 0.f);
#pragma unroll
                    for (int e = 0; e < 8; ++e) cl[e] += dpp_shr(cl[e], 2, 0.f);
#pragma unroll
                    for (int e = 0; e < 8; ++e) cl[e] += dpp_shr(cl[e], 4, 0.f);
#pragma unroll
                    for (int e = 0; e < 8; ++e) cl[e] += dpp_shr(cl[e], 8, 0.f);
#pragma unroll
                    for (int e = 0; e < 8; ++e) { G[e] = __builtin_amdgcn_exp2f(cl[e]); Gi[e] = __builtin_amdgcn_exp2f(-cl[e]); }
#pragma unroll
                    for (int e = 0; e < 8; ++e) { Gm[e] = dpp_shr(G[e], 1, 1.0f); GCv[e] = __shfl(G[e], (lane & 48) | 15); }
#pragma unroll
                    for (int e = 0; e < 8; ++e) {
                        const float kke = k[e] * kkw[e] * inv, kd = k[e] * ((ai[e] - 1.0f) * kaw[e] + 1.0f), bb = kke * ai[e], ratio = GCv[e] * Gi[e];
                        kt[e] = Gm[e] * kke; rt[e] = G[e] * r[e]; btl[e] = bb * Gi[e]; kq[e] = kd * Gi[e];
                        bonp += r[e] * kd * rkw[e];
                        const int j = 32 * ks + 8 * q + e;
                        const unsigned w0 = pk2(kt[e], bb * ratio), w1 = pk2(kd * ratio, v[e]);
                        ((LAS bf16*)(SL + SL_Z))[j * 16 + c] = (bf16)(w0 & 0xffffu); ((LAS bf16*)(SL + SL_BGT))[j * 16 + c] = (bf16)(w0 >> 16);
                        ((LAS bf16*)(SL + SL_KGT))[j * 16 + c] = (bf16)(w1 & 0xffffu); ((LAS bf16*)(SL + SL_VT))[j * 16 + c] = (bf16)(w1 >> 16);
                    }
                    if (c == 15) { *(LAS f32x4*)(SL + SL_GC + (32 * ks + 8 * q) * 4) = (f32x4){G[0], G[1], G[2], G[3]}; *(LAS f32x4*)(SL + SL_GC + (32 * ks + 8 * q + 4) * 4) = (f32x4){G[4], G[5], G[6], G[7]}; }
                    v4u p; p.x = pk2(kt[0], kt[1]); p.y = pk2(kt[2], kt[3]); p.z = pk2(kt[4], kt[5]); p.w = pk2(kt[6], kt[7]); fKT[ks] = __builtin_bit_cast(bf16x8, p);
                    p.x = pk2(rt[0], rt[1]); p.y = pk2(rt[2], rt[3]); p.z = pk2(rt[4], rt[5]); p.w = pk2(rt[6], rt[7]); fRT[ks] = __builtin_bit_cast(bf16x8, p);
                    { v2u p0; p0.x = p.x; p0.y = p.y; v2u p1; p1.x = p.z; p1.y = p.w; const int pp = 32 * ks + 16 * (q & 1) + 4 * (q >> 1);
                      *(LAS v2u*)(SL + SL_RT + sw64(c, pp)) = p0; *(LAS v2u*)(SL + SL_RT + sw64(c, pp + 8)) = p1; }
                    p.x = pk2(btl[0], btl[1]); p.y = pk2(btl[2], btl[3]); p.z = pk2(btl[4], btl[5]); p.w = pk2(btl[6], btl[7]); fBT[ks] = __builtin_bit_cast(bf16x8, p);
                    p.x = pk2(kq[0], kq[1]); p.y = pk2(kq[2], kq[3]); p.z = pk2(kq[4], kq[5]); p.w = pk2(kq[6], kq[7]); fKQ[ks] = __builtin_bit_cast(bf16x8, p);
                    asm volatile("" ::: "memory");
                }
                bonp += __shfl_xor(bonp, 16); bonp += __shfl_xor(bonp, 32);
                if (q == 0 && (NSL * bt + w) * CK >= CTXL) BON[(size_t)scan_row((NSL * bt + w) * CK + c, b, dir) * NH + h] = bonp;
                const f32x4 z4 = (f32x4){0.f, 0.f, 0.f, 0.f};
                f32x4 accA = mfma16(fBT[1], fKT[1], mfma16(fBT[0], fKT[0], z4)), accAr = mfma16(fBT[1], fRT[1], mfma16(fBT[0], fRT[0], z4));
                f32x4 accCm = mfma16(fKQ[1], fKT[1], mfma16(fKQ[0], fKT[0], z4)), accCr = mfma16(fKQ[1], fRT[1], mfma16(fKQ[0], fRT[0], z4));
#pragma unroll
                for (int g = 0; g < 4; ++g) { const int srow = 4 * q + g; const bool lt = srow < c, le = srow <= c;
                    accA[g] = lt ? accA[g] : 0.f; accAr[g] = le ? accAr[g] : 0.f; accCm[g] = lt ? accCm[g] : 0.f; accCr[g] = le ? accCr[g] : 0.f;
                    ((LAS float*)(SL + SL_AF))[srow * 16 + c] = accA[g]; ((LAS bf16*)(SL + SL_ABF))[srow * 16 + c] = (bf16)f2bf(accA[g]); ((LAS bf16*)(SL + SL_Z))[(64 + srow) * 16 + c] = (bf16)f2bf(accCm[g]); }
                { v2u p; p.x = pk2(accAr[0], accAr[1]); p.y = pk2(accAr[2], accAr[3]); *(LAS v2u*)(SL + SL_ART + (c * 16 + 4 * q) * 2) = p; }
                { v2u p; p.x = pk2(accCr[0], accCr[1]); p.y = pk2(accCr[2], accCr[3]); *(LAS v2u*)(SL + SL_CRT + (c * 16 + 4 * q) * 2) = p; }
                LDS_WAIT(); asm volatile("" ::: "memory");
                {
                    const int base = c & 8, cl = c & 7; float x[8];
#pragma unroll
                    for (int sr = 7; sr >= 0; --sr) { float acc = 0.f;
#pragma unroll
                        for (int m = sr + 1; m < 8; ++m) acc += ((const LAS float*)(SL + SL_AF))[(base + sr) * 16 + base + m] * x[m];
                        x[sr] = (sr < cl) ? -acc : ((sr == cl) ? -1.0f : 0.f); }
                    if (q == 0) { v4u px; px.x = pk2(x[0], x[1]); px.y = pk2(x[2], x[3]); px.z = pk2(x[4], x[5]); px.w = pk2(x[6], x[7]);
                        *(LAS v4u*)(SL + SL_TMT + (c * 16 + base) * 2) = px; *(LAS v4u*)(SL + SL_TMT + (c * 16 + (base ^ 8)) * 2) = (v4u){0u, 0u, 0u, 0u};
#pragma unroll
                        for (int sr = 0; sr < 8; ++sr) { ((LAS bf16*)(SL + SL_TM))[(base + sr) * 16 + c] = (bf16)f2bf(x[sr]); ((LAS bf16*)(SL + SL_TM))[((base ^ 8) + sr) * 16 + c] = (bf16)0; } }
                    LDS_WAIT(); asm volatile("" ::: "memory");
                    const bf16x8 fAb = frag_ld(SL + SL_ABF + (c * 16 + 8 * q) * 2, klo), fTd = frag_ld(SL + SL_TMT + (c * 16 + 8 * q) * 2, klo);
                    const f32x4 d1 = mfma16(fAb, fTd, z4);
                    bf16x8 fD1; { v4u p; p.x = pk2(d1[0], d1[1]); p.y = pk2(d1[2], d1[3]); p.z = 0u; p.w = 0u; fD1 = __builtin_bit_cast(bf16x8, p); }
                    const f32x4 d2 = mfma16(fD1, frag4_ld(SL + SL_TM + (c * 16 + 4 * q) * 2), z4);
                    if (c < 8 && q >= 2) {
#pragma unroll
                        for (int g = 0; g < 4; ++g) ((LAS bf16*)(SL + SL_TMT))[(4 * q + g) * 16 + c] = (bf16)f2bf(d2[g]); }
                }
                LDS_WAIT(); asm volatile("" ::: "memory");
                {
                    const bf16x8 fT = frag_ld(SL + SL_TMT + (c * 16 + 8 * q) * 2, klo);
#pragma unroll
                    for (int zt = 0; zt < 5; ++zt) { const bf16x8 fZ = frag_ld(SL + SL_Z + ((16 * zt + c) * 16 + 8 * q) * 2, klo); const f32x4 d = mfma16(fZ, fT, z4);
                        v2u p; p.x = pk2(d[0], d[1]); p.y = pk2(d[2], d[3]); *(LAS v2u*)(SL + SL_ZTT + (c * ZTT_LD + (zt < 4 ? kpos(zt, q) : 64 + 4 * q)) * 2) = p; }
                }
            }
            if (bt + 1 < NBATCH) scan_fetch(R, RM, KM, VM, AX, EX, (size_t)scan_row((NSL * (bt + 1) + w) * CK + c, b, dir) * D + h * 64 + 8 * q);
            __syncthreads();
            asm volatile("" : "+v"(c), "+v"(q));
            if (w < 4) {
                const bool emit = (NSL * bt) * CK >= CTXL;
#pragma unroll 1
                for (int n = 0; n < NSL; ++n) { SeqOps A; seq_load(A, F.lds + slot_off(n), w, c, q, klo); seq_step(A, X, emit, YO, NSL * bt + n, b, dir, h, w, c, q); }
            }
            __syncthreads();
        }
    }
}

__device__ __forceinline__ void p7_readout(Frame& F, const Args& a) {
    const bf16* VM = (const bf16*)(F.ws + WS_VM); const float* BONF = (const float*)(F.ws + WS_BON); const float* BONB = BONF + (size_t)NT * NH;
    const bf16* YF = (const bf16*)(F.ws + WS_YF); const bf16* YB = (const bf16*)(F.ws + WS_YB); bf16* Z = (bf16*)(F.ws + WS_Z);
    const int sub = F.tid & 15; const int ngrp = F.G * 32;
    for (int gid0 = F.vcu * 32 + (F.tid >> 4); gid0 < NT * NH; gid0 += 4 * ngrp) {
        v2u ayf[4], ayb[4], alv[4]; float abf[4], abb[4]; f32x4 alw[4], alb[4];
#pragma unroll
        for (int u = 0; u < 4; ++u) { const int gid = gid0 + u * ngrp; const int mrow = gid >> 5, h = gid & 31, c = h * 64 + 4 * sub; const size_t off = (size_t)mrow * D + c;
            ayf[u] = *(const v2u*)(YF + off); ayb[u] = *(const v2u*)(YB + off); alv[u] = *(const v2u*)(VM + off); abf[u] = BONF[gid]; abb[u] = BONB[gid]; alw[u] = *(const f32x4*)(a.in[I_LNW] + c); alb[u] = *(const f32x4*)(a.in[I_LNB] + c); }
#pragma unroll
        for (int u = 0; u < 4; ++u) { const int gid = gid0 + u * ngrp;
        const int mrow = gid >> 5, h = gid & 31, c = h * 64 + 4 * sub; const size_t off = (size_t)mrow * D + c;
        const v2u yf = ayf[u], yb = ayb[u], lv = alv[u];
        const f32x4 y = (f32x4){bflo(yf.x) + bflo(yb.x), bfhi(yf.x) + bfhi(yb.x), bflo(yf.y) + bflo(yb.y), bfhi(yf.y) + bfhi(yb.y)};
        const float mean = allred16((y.x + y.y) + (y.z + y.w)) * (1.0f / 64.0f); const f32x4 d = y - mean;
        const float var = allred16((d.x * d.x + d.y * d.y) + (d.z * d.z + d.w * d.w)) * (1.0f / 64.0f);
        const f32x4 yn = d * __builtin_amdgcn_rsqf(var + 64e-5f) * alw[u] + alb[u];
        const f32x4 v = (f32x4){bflo(lv.x), bfhi(lv.x), bflo(lv.y), bfhi(lv.y)};
        const f32x4 z = yn + v * (abf[u] + abb[u]); v2u wv; wv.x = pk2(z.x, z.y); wv.y = pk2(z.z, z.w); *(v2u*)(Z + off) = wv;
        }
    }
}
constexpr float GU_F8SCALE = 8.0f, H2_F8SCALE = 8.0f, DT_F8SCALE = 8.0f;
constexpr int CONV_ITEMS = 65 * 768, CONV_DT = 65 * 256, CONV_FREE = CONV_DT + (65 - GU_E2) * 512;
struct DecExp { const float* const* in; unsigned char* ws;
    __device__ __forceinline__ bool operator()(int it, TrJob& j) const {
        if (it < 0 || it >= CONV_ITEMS) return false;
        if (it < CONV_DT) { const int e = it >> 8, r = it & 255; const float* src = (e < 64) ? in[I_ED] + (size_t)e * DEXP * D : in[I_SD];
            const int kb = r >> 5, nb = r & 31; j = TrJob{src, (bf16*)(ws + WS_DT + (size_t)e * D * DEXP), D, DEXP, DEXP, kb * 64, nb * 64, nb * 64, DT_F8SCALE}; }
        else { const int g = it - CONV_DT, eg = g >> 9, q = g & 511, which = q >> 8, r = q & 255, e = eg < 65 - GU_E2 ? GU_E2 + eg : eg - (65 - GU_E2);
            const float* src = (e < 64) ? (which == 0 ? in[I_EG] : in[I_EU]) + (size_t)e * D * DEXP : (which == 0 ? in[I_SG] : in[I_SU]);
            const int kb = r >> 3, nb = r & 7, n0 = nb * 64;
            j = TrJob{src, (bf16*)(ws + gu_base(e)), DEXP, D, D, kb * 64, n0, (n0 >> 7) * 256 + which * 128 + (n0 & 127), GU_F8SCALE}; }
        return true; } };
__device__ __forceinline__ void conv_steal(Frame& F, const Args& a, const unsigned stopn) {
    DecExp dec{a.in, F.ws};
    unsigned* cnt = F.ctl + CW_CONV; unsigned* dnp = F.ctl + CW_P2DONE;
    LAS unsigned* P = (LAS unsigned*)(F.lds + F.wave * 16384);
    const int lane = F.lane;
    unsigned nxt = 0u, dnow = 0u;
    if (lane == 0) nxt = xb_add(cnt, 1u);
    nxt = __builtin_amdgcn_readfirstlane(nxt);
#pragma unroll 1
    for (;;) {
        const unsigned cur = nxt;
        if (cur >= (unsigned)CONV_FREE) break;
        unsigned n2 = (unsigned)CONV_FREE, d2 = dnow;
        if (dnow < stopn) { if (lane == 0) { n2 = xb_add(cnt, 1u); d2 = xb_ld(dnp); } }
        asm volatile("" ::: "memory");
        TrJob ja; f32x4 va[16];
        dec((int)cur, ja); tr_ld<true>(ja, va, lane);
        tr_st<true>(ja, va, P, lane);
        nxt = __builtin_amdgcn_readfirstlane(n2); dnow = __builtin_amdgcn_readfirstlane(d2);
    }
}
constexpr int RT_LD = 68;
__device__ __forceinline__ void p11_route(Frame& F, const Args& a) {
    for (int repa_ = 0, nrepa_ = opaque_n(1 + ((DUPMASK >> 16) & 1)); repa_ < nrepa_; ++repa_) {
        unsigned nd = xb_ld(F.ctl + CW_CONV); nd = __builtin_amdgcn_readfirstlane(nd < (unsigned)CONV_FREE ? nd : (unsigned)CONV_FREE);
        DecExp dec{a.in, F.ws};
        tr_run(dec, (int)nd + F.vcu * 8 + F.wave, F.G * 8, (LAS unsigned*)(F.lds + F.wave * 16384), F.lane);
        __syncthreads();
    }
    const bf16* X1 = (const bf16*)(F.ws + WS_X1); const float* MOD = (const float*)(F.ws + WS_MOD); unsigned char* H2 = F.ws + WS_H2;
    LAS float* hs = (LAS float*)F.lds;
    LAS float* wsb = hs + 64 * RT_LD;
    LAS float* lg = wsb + 64 * RT_LD;
    LAS float* lg2 = lg + 64 * 65;
    LAS float* selb = lg2 + 64 * 65;
    LAS float* rs = selb + 64 * 65;
    LAS int* cnt = (LAS int*)(rs + 64);
    LAS int* basee = cnt + 64;
    LAS int* eloc = basee + 64;
    LAS int* rloc = eloc + 512;
    for (int tile = F.vcu; tile < NT / 64; tile += F.G) {
        const int t0 = tile * 64, b = t0 >> 12;
        const float* sh2 = MOD + (size_t)b * 12288 + 6144; const float* sc2 = MOD + (size_t)b * 12288 + 8192; const float* g2 = a.in[I_N2G];
        if (F.tid < 64) cnt[F.tid] = 0;
        for (int rr = 0; rr < 8; ++rr) { const int tl = F.wave * 8 + rr; const v2u* xr = (const v2u*)(X1 + (size_t)(t0 + tl) * D) + F.lane; f32x4 v[8]; float s = 0.f;
#pragma unroll
            for (int q = 0; q < 8; ++q) { const v2u xw = xr[64 * q]; v[q] = (f32x4){bflo(xw.x), bfhi(xw.x), bflo(xw.y), bfhi(xw.y)}; s += (v[q].x * v[q].x + v[q].y * v[q].y) + (v[q].z * v[q].z + v[q].w * v[q].w); }
            const float rstd = 1.0f / sqrtf(wave_sum(s) * (1.0f / D) + 1e-6f); if (F.lane == 0) rs[tl] = rstd;
            unsigned* o = (unsigned*)(H2 + (size_t)(t0 + tl) * D) + F.lane;
#pragma unroll
            for (int q = 0; q < 8; ++q) { const f32x4 y = v[q] * rstd * ((const f32x4*)g2)[F.lane + 64 * q] * (((const f32x4*)sc2)[F.lane + 64 * q] + 1.0f) + ((const f32x4*)sh2)[F.lane + 64 * q];
                o[64 * q] = pk8(H2_F8SCALE * y.x, H2_F8SCALE * y.y, H2_F8SCALE * y.z, H2_F8SCALE * y.w); } }
        __syncthreads();
        const int tg = F.tid & 15, eg = (F.tid >> 4) & 15, kh = F.tid >> 8;
        float acc[4][4];
#pragma unroll
        for (int i = 0; i < 4; ++i)
#pragma unroll
            for (int j = 0; j < 4; ++j) acc[i][j] = 0.f;
        const int stok = F.tid >> 3, sk8 = (F.tid & 7) * 8; const float rstd_s = rs[stok];
        f32x4 px0, px1, pw0, pw1;
        { const v4u xw = *(const v4u*)(X1 + (size_t)(t0 + stok) * D + sk8); px0 = (f32x4){bflo(xw.x), bfhi(xw.x), bflo(xw.y), bfhi(xw.y)}; px1 = (f32x4){bflo(xw.z), bfhi(xw.z), bflo(xw.w), bfhi(xw.w)}; const float* wp = a.in[I_RW] + F.tid * 8; pw0 = *(const f32x4*)wp; pw1 = *(const f32x4*)(wp + 4); }
        for (int kc = 0; kc < D / 64; ++kc) {
            { const int k0 = kc * 64 + sk8;
              const f32x4 ga = *(const f32x4*)(g2 + k0), gb = *(const f32x4*)(g2 + k0 + 4), ca = *(const f32x4*)(sc2 + k0), cb = *(const f32x4*)(sc2 + k0 + 4), ha = *(const f32x4*)(sh2 + k0), hb = *(const f32x4*)(sh2 + k0 + 4);
              const f32x4 y0 = px0 * rstd_s * ga * (ca + 1.0f) + ha, y1 = px1 * rstd_s * gb * (cb + 1.0f) + hb;
              hs[(sk8 + 0) * RT_LD + stok] = y0.x; hs[(sk8 + 1) * RT_LD + stok] = y0.y; hs[(sk8 + 2) * RT_LD + stok] = y0.z; hs[(sk8 + 3) * RT_LD + stok] = y0.w;
              hs[(sk8 + 4) * RT_LD + stok] = y1.x; hs[(sk8 + 5) * RT_LD + stok] = y1.y; hs[(sk8 + 6) * RT_LD + stok] = y1.z; hs[(sk8 + 7) * RT_LD + stok] = y1.w;
              const int wk = F.tid >> 3, we = (F.tid & 7) * 8; *(LAS f32x4*)(wsb + wk * RT_LD + we) = pw0; *(LAS f32x4*)(wsb + wk * RT_LD + we + 4) = pw1; }
            __syncthreads();
            if (kc + 1 < D / 64) { const v4u xw = *(const v4u*)(X1 + (size_t)(t0 + stok) * D + (kc + 1) * 64 + sk8); px0 = (f32x4){bflo(xw.x), bfhi(xw.x), bflo(xw.y), bfhi(xw.y)}; px1 = (f32x4){bflo(xw.z), bfhi(xw.z), bflo(xw.w), bfhi(xw.w)};
                const float* wp = a.in[I_RW] + (size_t)(kc + 1) * 4096 + F.tid * 8; pw0 = *(const f32x4*)wp; pw1 = *(const f32x4*)(wp + 4); }
#pragma unroll 8
            for (int k = kh * 32; k < kh * 32 + 32; ++k) { const f32x4 h4 = *(const LAS f32x4*)(hs + k * RT_LD + 4 * tg), w4 = *(const LAS f32x4*)(wsb + k * RT_LD + 4 * eg);
                acc[0][0] += h4.x * w4.x; acc[0][1] += h4.x * w4.y; acc[0][2] += h4.x * w4.z; acc[0][3] += h4.x * w4.w;
                acc[1][0] += h4.y * w4.x; acc[1][1] += h4.y * w4.y; acc[1][2] += h4.y * w4.z; acc[1][3] += h4.y * w4.w;
                acc[2][0] += h4.z * w4.x; acc[2][1] += h4.z * w4.y; acc[2][2] += h4.z * w4.z; acc[2][3] += h4.z * w4.w;
                acc[3][0] += h4.w * w4.x; acc[3][1] += h4.w * w4.y; acc[3][2] += h4.w * w4.z; acc[3][3] += h4.w * w4.w; }
            __syncthreads();
        }
        { LAS float* dstl = kh ? lg2 : lg;
#pragma unroll
          for (int i = 0; i < 4; ++i)
#pragma unroll
              for (int j = 0; j < 4; ++j) dstl[(4 * tg + i) * 65 + 4 * eg + j] = acc[i][j]; }
        __syncthreads();
        for (int idx = F.tid; idx < 4096; idx += 512) { const int tl = idx >> 6, e = idx & 63; const float sc = sigmoidf_(lg[tl * 65 + e] + lg2[tl * 65 + e]); lg[tl * 65 + e] = sc; selb[tl * 65 + e] = sc + a.in[I_RB][e]; }
        __syncthreads();
        if (F.tid < 64) {
            const int tl = F.tid; LAS float* sel = selb + tl * 65; const LAS float* scr = lg + tl * 65;
            float gs[8];
#pragma unroll
            for (int g = 0; g < 8; ++g) { float m1 = -INFINITY, m2 = -INFINITY;
#pragma unroll
                for (int j = 0; j < 8; ++j) { const float v = sel[g * 8 + j]; if (v > m1) { m2 = m1; m1 = v; } else if (v > m2) m2 = v; }
                gs[g] = m1 + m2; }
            unsigned gmask = 0u;
#pragma unroll
            for (int it = 0; it < 4; ++it) { float best = -INFINITY; int bi = 0;
#pragma unroll
                for (int g = 0; g < 8; ++g) { const bool ok = !((gmask >> g) & 1u) && gs[g] > best; best = ok ? gs[g] : best; bi = ok ? g : bi; }
                gmask |= 1u << bi; }
            for (int g = 0; g < 8; ++g) if (!((gmask >> g) & 1u)) { for (int j = 0; j < 8; ++j) sel[g * 8 + j] = -INFINITY; }
            float wv[8]; int ev[8]; float wsum = 0.f;
#pragma unroll
            for (int it = 0; it < 8; ++it) { float best = -INFINITY; int bi = 0;
                for (int e = 0; e < 64; ++e) { const float v = sel[e]; if (v > best) { best = v; bi = e; } }
                sel[bi] = -INFINITY; ev[it] = bi; wv[it] = scr[bi]; wsum += wv[it]; }
            const float inv = 2.5f / wsum;
#pragma unroll
            for (int it = 0; it < 8; ++it) { const int lr = atomicAdd((int*)&cnt[ev[it]], 1); eloc[tl * 8 + it] = ev[it]; rloc[tl * 8 + it] = lr;
                ((float*)(F.ws + WS_WSEL))[(size_t)(t0 + tl) * 8 + it] = wv[it] * inv; }
        }
        __syncthreads();
        if (F.tid < 64) basee[F.tid] = (int)__hip_atomic_fetch_add(F.ctl + CW_GCNT + F.tid, (unsigned)cnt[F.tid], __ATOMIC_RELAXED, __HIP_MEMORY_SCOPE_AGENT);
        __syncthreads();
        { const int e = eloc[F.tid]; ((int*)(F.ws + WS_EIDX))[(size_t)t0 * 8 + F.tid] = e; ((int*)(F.ws + WS_RANK))[(size_t)t0 * 8 + F.tid] = basee[e] + rloc[F.tid]; }
        __syncthreads();
    }
}
__device__ __forceinline__ int moe_tables(Frame& F) {
    LAS int* te = (LAS int*)(F.lds + TAB_OFF); LAS int* off = te + MAXTILES;
    if (F.tid < 64) off[66 + F.tid] = (int)__hip_atomic_load(F.ctl + CW_GCNT + F.tid, __ATOMIC_RELAXED, __HIP_MEMORY_SCOPE_AGENT);
    __syncthreads();
    if (F.tid == 0) { int o = 0; for (int e = 0; e < 64; ++e) { off[e] = o; o += (off[66 + e] + 255) & ~255; } off[64] = o; off[65] = o / 256 + NT / 256; }
    __syncthreads();
    const int ntiles = off[65];
    for (int rt = F.tid; rt < ntiles; rt += 512) { int e = 0; for (int j = 1; j <= 64; ++j) if (rt * 256 >= off[j]) e = j; te[rt] = e; }
    __syncthreads();
    return ntiles;
}
__device__ __forceinline__ void p12_slots(Frame& F) {
    (void)moe_tables(F);
    const LAS int* off = (const LAS int*)(F.lds + TAB_OFF) + MAXTILES;
    int* tok = (int*)(F.ws + WS_TOK);
    const int* eidx = (const int*)(F.ws + WS_EIDX); int* rank = (int*)(F.ws + WS_RANK);
    const int gt = F.vcu * 512 + F.tid, NGT = F.G * 512;
    for (int i = gt; i < NT * 8; i += NGT) { const int slot = off[eidx[i]] + rank[i]; tok[slot] = i >> 3; rank[i] = slot; }
    const int o64 = off[64];
    for (int t = gt; t < NT; t += NGT) tok[o64 + t] = t;
    if (gt == 0) F.ctl[CW_O64] = (unsigned)o64;
}
__device__ __forceinline__ void p15_final(Frame& F, const Args& a) {
    const int gw = F.vcu * 8 + F.wave, NGW = F.G * 8; const float* MOD = (const float*)(F.ws + WS_MOD); const unsigned char* YP = (const unsigned char*)(F.ws + WS_YP);
    const int* SLOTMAP = (const int*)(F.ws + WS_RANK); const float* WSEL = (const float*)(F.ws + WS_WSEL); const int o64 = (int)F.ctl[CW_O64];
    for (int t = gw; t < NT; t += NGW) {
        const int b = t >> 12; const float* gt2 = MOD + (size_t)b * 12288 + 10240; const float* fg = a.in[I_FG]; float* xr = a.out + (size_t)t * D; const bf16* x1r = (const bf16*)(F.ws + WS_X1) + (size_t)t * D;
        const v4u s0 = *(const v4u*)(SLOTMAP + (size_t)t * 8), s1 = *(const v4u*)(SLOTMAP + (size_t)t * 8 + 4); const f32x4 w0 = *(const f32x4*)(WSEL + (size_t)t * 8), w1 = *(const f32x4*)(WSEL + (size_t)t * 8 + 4);
        const unsigned sl[9] = {s0.x, s0.y, s0.z, s0.w, s1.x, s1.y, s1.z, s1.w, (unsigned)(o64 + t)}; const float wt[9] = {w0.x, w0.y, w0.z, w0.w, w1.x, w1.y, w1.z, w1.w, 1.0f};
        float v[2][16]; float s = 0.f;
#pragma unroll
        for (int jj = 0; jj < 2; ++jj) { const int col = 16 * F.lane + 1024 * jj; float m[16];
#pragma unroll
            for (int e = 0; e < 16; ++e) m[e] = 0.f;
#pragma unroll
            for (int j = 0; j < 9; ++j) { const v4u y = *(const v4u*)(YP + (size_t)sl[j] * D + col); const unsigned yw[4] = {y.x, y.y, y.z, y.w}; const float wj = wt[j];
#pragma unroll
                for (int e = 0; e < 4; ++e) { const f32x2 lo = __builtin_amdgcn_cvt_pk_f32_fp8((int)yw[e], false), hi = __builtin_amdgcn_cvt_pk_f32_fp8((int)yw[e], true);
                    m[4 * e] += wj * lo.x; m[4 * e + 1] += wj * lo.y; m[4 * e + 2] += wj * hi.x; m[4 * e + 3] += wj * hi.y; } }
#pragma unroll
            for (int e4 = 0; e4 < 4; ++e4) { const v2u xw = *(const v2u*)(x1r + col + 4 * e4); const f32x4 x0 = (f32x4){bflo(xw.x), bfhi(xw.x), bflo(xw.y), bfhi(xw.y)}, g0 = *(const f32x4*)(gt2 + col + 4 * e4);
#pragma unroll
                for (int e = 0; e < 4; ++e) { const float val = x0[e] + g0[e] * (m[4 * e4 + e] * (1.0f / YP_SCALE)); v[jj][4 * e4 + e] = val; s += val * val; } } }
        float rstd = __builtin_amdgcn_rsqf(wave_sum(s) * (1.0f / D) + 1e-6f);
#if defined(PROBE_PHASE)
        if (PROBE_PHASE >= 0) rstd *= 1.0f + (float)__hip_atomic_load(F.ctl + 12000, __ATOMIC_RELAXED, __HIP_MEMORY_SCOPE_AGENT) * 2e-6f;
#endif
#pragma unroll
        for (int jj = 0; jj < 2; ++jj) { const int col = 16 * F.lane + 1024 * jj;
#pragma unroll
            for (int e4 = 0; e4 < 4; ++e4) { const f32x4 f0 = *(const f32x4*)(fg + col + 4 * e4);
                *(f32x4*)(xr + col + 4 * e4) = (f32x4){v[jj][4 * e4], v[jj][4 * e4 + 1], v[jj][4 * e4 + 2], v[jj][4 * e4 + 3]} * rstd * f0; } }
    }
}
#ifndef MK_ONE_LAUNCH
#define MK_ONE_LAUNCH 1
#endif
constexpr int NPHASE = 16;
__global__ void __launch_bounds__(512, 2) mk_fwd(Args args) {
    extern __shared__ __attribute__((aligned(16))) unsigned char lds[];
    Frame F;
    F.lds = (LAS unsigned char*)lds; F.MISC = (volatile LAS unsigned*)(F.lds + LDSCTL_OFF);
    int wave0 = __builtin_amdgcn_readfirstlane((int)threadIdx.x >> 6); asm volatile("" : "+s"(wave0));
    F.tid = threadIdx.x; F.lane = F.tid & 63; F.wave = wave0;
    F.G = gridDim.x; { const int bx = blockIdx.x; F.vcu = (F.G % 8 == 0) ? (bx % 8) * (F.G / 8) + bx / 8 : bx; }
    F.ws = args.ws; F.ctl = (unsigned*)(args.ws + WS_CTL);
    for (int u = F.tid; u < 256; u += 512) ((LAS unsigned*)(F.lds + LDSCTL_OFF))[u] = 0u;
    __syncthreads();
    XcdBarrier bar; bar.bar = F.ctl + CW_BAR; bar.x = 0; bar.st = nullptr;
    if (MK_ONE_LAUNCH) bar = xcd_barrier_post(F.ctl + CW_BAR, F.MISC + 8);
    const int lo = args.ph_lo, hi = args.ph_hi;
#ifndef PHMASK
#define PHMASK 0xFFFF
#endif
#define IN(k) (((PHMASK >> (k)) & 1) && lo <= (k) && (k) < hi)
#ifndef DUPMASK
#define DUPMASK 0
#endif
#define DUP(k) for (int rep_ = 0, nrep_ = opaque_n(1 + ((DUPMASK >> (k)) & 1)); rep_ < nrep_; ++rep_)
#define FRESH() do { int l_ = (int)__builtin_amdgcn_mbcnt_hi(~0u, __builtin_amdgcn_mbcnt_lo(~0u, 0u)); asm volatile("" : "+v"(l_)); int w_ = wave0; asm volatile("" : "+s"(w_)); F.lane = l_; F.wave = w_; F.tid = w_ * 64 + l_; { unsigned char* p_ = args.ws; asm volatile("" : "+s"(p_)); F.ws = p_; ws = p_; F.ctl = (unsigned*)(p_ + WS_CTL); } } while (0)
#define SEAM(k) do { if (MK_ONE_LAUNCH) { if (IN(k) && IN((k) + 1)) { xcd_barrier(bar); if ((DUPMASK >> 18) & 1) xcd_barrier(bar); } } } while (0)
    const int G = F.G, c = (int)blockIdx.x;
#ifndef PROBE_PHASE
#define PROBE_PHASE -1
#endif
    unsigned long long pt0_ = 0;
#define PSTART(k) do { if (PROBE_PHASE == (k)) pt0_ = __builtin_amdgcn_s_memrealtime(); } while (0)
#define PEND(k) do { if (PROBE_PHASE == (k) && blockIdx.x == 0 && threadIdx.x == 0) { const unsigned long long t1_ = __builtin_amdgcn_s_memrealtime(); __hip_atomic_store(F.ctl + 12000, (unsigned)(t1_ - pt0_), __ATOMIC_RELAXED, __HIP_MEMORY_SCOPE_AGENT); } } while (0)
    unsigned char* ws = args.ws;

    PSTART(0);
    if (IN(0)) DUP(0) { FRESH(); p0_prologue(F, args); } SEAM(0); PEND(0);
    PSTART(1);
    if (IN(1)) DUP(1) { FRESH(); p1_norm1(F, args); } SEAM(1); PEND(1);
    PSTART(2);
    if (IN(2)) DUP(2) { FRESH();
        const int g1 = (G == 256) ? 240 : G;
        if (c < g1) {
            G1Order S{(const char*)(ws + WS_HA), (const char*)(ws + WS_WIN), (size_t)256 * D * (P2_FP8 ? 1 : 2), (size_t)256 * D * (P2_FP8 ? 1 : 2), g1, c};
            EpiG1 E{(bf16*)(ws + WS_U), (bf16*)(ws + WS_SLAB), (unsigned char*)(ws + WS_GATES)};
            if (P2_FP8) pg8::gemm_phase<EpiG1, G1Order, false, true, 124>(F.lds + RING_OFF, F.wave, D / 2, D / 2, D / 2, S, E);
            else pg8::gemm_phase<EpiG1, G1Order, false>(F.lds + RING_OFF, F.wave, D, D, D, S, E);
            FRESH();
            if (F.tid == 0) (void)xb_add(F.ctl + CW_P2DONE, 1u);
        } else conv_steal(F, args, 8u);
    } SEAM(2); PEND(2);
    PSTART(3);
    if (IN(3)) DUP(3) { FRESH(); p3_prep(F, args); } SEAM(3); PEND(3);
    PSTART(4);
    if (IN(4)) DUP(4) { FRESH();
#ifndef NO4A
        {
            RepOrder S{(const char*)(ws + WS_LIN), (const char*)(ws + WS_LORA), (size_t)128 * 2, (size_t)D * 128 * 2, (size_t)256 * LINLD * 2, (size_t)256 * 128 * 2, MT / 256, D / 256, 4, G, c};
            EpiLora E{(unsigned short*)(ws + WS_EA), args.in[I_DW0], args.in[I_IA0]};
            pg8::gemm_phase<EpiLora, RepOrder, false>(F.lds + RING_OFF, F.wave, 128, LINLD, 128, S, E);
        }
#endif
    }
    if (IN(4)) DUP(4) { FRESH();
#ifndef NO4B
        {
            RepOrder S{(const char*)(ws + WS_DP), (const char*)(ws + WS_POOLW), (size_t)256 * 2, (size_t)256 * 256 * 2, (size_t)256 * 1024 * 2, (size_t)256 * 256 * 2, NT / 256, 1, 4, G, c};
            EpiPoolG E{(bf16*)(ws + WS_Y2), args.in[I_POOLS]};
            pg8::gemm_phase<EpiPoolG, RepOrder, false>(F.lds + RING_OFF, F.wave, 256, 1024, 256, S, E);
        }
#endif
    } SEAM(4); PEND(4);
    PSTART(5);
    if (IN(5)) DUP(5) { FRESH();
        RepOrder S{(const char*)(ws + WS_Y2), (const char*)(ws + WS_WPO), 0, 0, (size_t)256 * 1024 * 2, (size_t)256 * 1024 * 2, NT / 256, D / 256, 1, G, c};
        EpiMix<0> E{(bf16*)(ws + WS_MP), D, (const void*)(ws + WS_GATES), 4096, nullptr, 0};
        pg8::gemm_phase<EpiMix<0>, RepOrder, false>(F.lds + RING_OFF, F.wave, 1024, 1024, 1024, S, E);
    }
    PSTART(6);
    if (IN(6)) DUP(6) { FRESH(); p6_scan(F, args); if ((DUPMASK >> 19) & 1) { FRESH(); p6_scan(F, args); } } SEAM(6); PEND(6);
    PSTART(7);
    if (IN(7)) DUP(7) { FRESH(); p7_readout(F, args); } SEAM(7); PEND(7);
    PSTART(8);
    if (IN(8)) DUP(8) { FRESH();
        RepOrder S{(const char*)(ws + WS_LIN) + 512 * 2, (const char*)(ws + WS_G2), 0, 0, (size_t)256 * LINLD * 2, (size_t)256 * 256 * 2, NT / 256, D / 256, 1, G, c};
        EpiMix<1> E{(bf16*)(ws + WS_OR), D, (const void*)(ws + WS_Z), D, nullptr, 0};
        pg8::gemm_phase<EpiMix<1>, RepOrder, false>(F.lds + RING_OFF, F.wave, 256, LINLD, 256, S, E);
    } SEAM(8); PEND(8);
    PSTART(9);
    if (IN(9)) DUP(9) { FRESH();
        RepOrder S{(const char*)(ws + WS_OR), (const char*)(ws + WS_WRO), 0, 0, (size_t)256 * D * 2, (size_t)256 * D * 2, NT / 256, D / 256, 1, G, c};
        EpiMix<2, P10_FP8 != 0> E{(bf16*)(ws + WS_Z), P10_FP8 ? D : D, (const void*)(ws + WS_GATES + 2048), 4096, (const bf16*)(ws + WS_MP), D};
        pg8::gemm_phase<EpiMix<2, P10_FP8 != 0>, RepOrder, false>(F.lds + RING_OFF, F.wave, D, D, D, S, E);
    } SEAM(9); PEND(9);
    PSTART(10);
    if (IN(10)) DUP(10) { FRESH();
        RepOrder S{(const char*)(ws + WS_Z), (const char*)(ws + WS_WO), 0, 0, (size_t)256 * D * (P10_FP8 ? 1 : 2), (size_t)256 * D * (P10_FP8 ? 1 : 2), NT / 256, D / 256, 1, G, c};
        EpiX1 E{args.in[I_X], (bf16*)(ws + WS_X1), (const float*)(ws + WS_MOD)};
        if (P10_FP8) pg8::gemm_phase<EpiX1, RepOrder, false, true, 124>(F.lds + RING_OFF, F.wave, D / 2, D / 2, D / 2, S, E);
        else pg8::gemm_phase<EpiX1, RepOrder, false>(F.lds + RING_OFF, F.wave, D, D, D, S, E);
    } SEAM(10); PEND(10);
    PSTART(11);
    if (IN(11)) DUP(11) { FRESH(); p11_route(F, args); } SEAM(11); PEND(11);
    PSTART(12);
    if (IN(12)) DUP(12) { FRESH(); p12_slots(F); } SEAM(12); PEND(12);
    PSTART(13);
    if (IN(13)) DUP(13) { FRESH();
        const int ntiles = moe_tables(F);
        MoeOrderT<true> S{(const char*)(ws + WS_H2), (const char*)ws, (const LAS int*)(F.lds + TAB_OFF), (const LAS int*)(F.lds + ROWTAB_OFF), 0, (size_t)1024 * D * 2, (size_t)256 * D, ntiles, 4, G, c};
        { LAS int* rt = (LAS int*)(F.lds + ROWTAB_OFF); const int* tok = (const int*)(ws + WS_TOK); Unit uu;
          for (int i = 0; i < ROWTAB_UNITS && S.next(i, uu); ++i) if (F.tid < 256) rt[i * 256 + F.tid] = tok[uu.pm * 256 + F.tid];
          __syncthreads(); }
        EpiAct E{ws + WS_ACT};
        pg8::gemm_phase<EpiAct, MoeOrderT<true>, true, true, 124>(F.lds + RING_OFF, F.wave, D / 2, D / 2, D / 2, S, E);
    } SEAM(13); PEND(13);
    PSTART(14);
    if (IN(14)) DUP(14) { FRESH();
        const int ntiles = moe_tables(F);
        MoeOrderT<false> S{(const char*)(ws + WS_ACT), (const char*)(ws + WS_DT), (const LAS int*)(F.lds + TAB_OFF), (const LAS int*)(F.lds + ROWTAB_OFF), (size_t)256 * DEXP, (size_t)D * DEXP, (size_t)256 * DEXP, ntiles, 8, G, c};
        EpiDown E{(unsigned char*)(ws + WS_YP)};
        pg8::gemm_phase<EpiDown, MoeOrderT<false>, false, true, 124>(F.lds + RING_OFF, F.wave, DEXP / 2, DEXP / 2, DEXP / 2, S, E);
    } SEAM(14); PEND(14);
    PSTART(15);
    if (IN(15)) DUP(15) { FRESH(); p15_final(F, args); }
#undef IN
#undef SEAM
}

extern "C" void kernel_launch(void* const* d_in, const int* in_sizes, int n_in, void* d_out, int out_size, void* d_ws, size_t ws_size, hipStream_t stream) {
    static int grid = 0;
    if (grid == 0) {
        if (n_in != 34 || in_sizes[0] != NT * D || out_size != NT * D || ws_size < WS_END) { fprintf(stderr, "kernel_launch: unexpected shapes (n_in %d, in0 %d, out %d, ws %zu < %zu)\n", n_in, n_in > 0 ? in_sizes[0] : -1, out_size, ws_size, (size_t)WS_END); grid = -1; return; }
        int dev = 0, cus = 0, per_cu = 0;
        if (hipGetDevice(&dev) != hipSuccess || hipDeviceGetAttribute(&cus, hipDeviceAttributeMultiprocessorCount, dev) != hipSuccess) { grid = -1; return; }
        if (hipFuncSetAttribute((const void*)mk_fwd, hipFuncAttributeMaxDynamicSharedMemorySize, LDS_BYTES) != hipSuccess) { fprintf(stderr, "kernel_launch: hipFuncSetAttribute failed\n"); grid = -1; return; }
        if (hipOccupancyMaxActiveBlocksPerMultiprocessor(&per_cu, (const void*)mk_fwd, 512, LDS_BYTES) != hipSuccess || per_cu < 1) fprintf(stderr, "kernel_launch: occupancy query reports %d\n", per_cu);
        (void)hipGetLastError();
        grid = cus;
    }
    if (grid < 0) return;
    if (hipMemsetAsync((char*)d_ws + WS_CTL, 0, CTL_ZERO_BYTES, stream) != hipSuccess) return;
    Args a{};
    for (int i = 0; i < 34; ++i) a.in[i] = (const float*)d_in[i];
    a.out = (float*)d_out; a.ws = (unsigned char*)d_ws;
#if MK_ONE_LAUNCH
    a.ph_lo = 0; a.ph_hi = NPHASE;
    hipLaunchKernelGGL(mk_fwd, dim3(grid), dim3(512), LDS_BYTES, stream, a);
#else
    for (int p = 0; p < NPHASE; ++p) { a.ph_lo = p; a.ph_hi = p + 1; hipLaunchKernelGGL(mk_fwd, dim3(grid), dim3(512), LDS_BYTES, stream, a); }
#endif
}
```

```cpp
#include <hip/hip_runtime.h>
#include <cstdio>
#include <cstdint>
#ifndef DUPMASK
#define DUPMASK 0
#endif
#ifndef PROBE_PHASE
#define PROBE_PHASE -1
#endif
#ifndef P2_FP8
#define P2_FP8 1
#endif
#ifndef P10_FP8
#define P10_FP8 0
#endif
static_assert(P10_FP8 == 0, "the w_out copy is bf16");
#ifndef NOCONV
#define NOCONV 0
#endif

#define GAS __attribute__((address_space(1)))
#define LAS __attribute__((address_space(3)))
typedef unsigned short bf16;
typedef unsigned v4u __attribute__((ext_vector_type(4)));
typedef unsigned v2u __attribute__((ext_vector_type(2)));
typedef float f32x4 __attribute__((ext_vector_type(4)));
typedef float f32x2 __attribute__((ext_vector_type(2)));
typedef short bf16x8 __attribute__((ext_vector_type(8)));

constexpr int D = 2048, NB = 4, TSEQ = 4096, NT = NB * TSEQ  , CTXL = 256, NC = NB * CTXL  , MT = NT + NC  ;
constexpr int DIN = 11904, DSH = 6784, NPAD = 12032, SLABLD = 6912, NH = 32, HS = 64;
constexpr int NEXP = 64, DEXP = 512, TOPK = 8;
constexpr int NSLOT = NT * TOPK + NEXP * 256 + NT;
constexpr int MAXTILES = NSLOT / 256;
constexpr int LINLD = 768;

__device__ __forceinline__ int opaque_n(int n) { asm volatile("" : "+s"(n)); return n; }
__device__ __forceinline__ unsigned f2bf(float f) { unsigned u = __builtin_bit_cast(unsigned, f); return (u + 0x7fffu + ((u >> 16) & 1u)) >> 16; }
typedef __bf16 bf16x2_t __attribute__((ext_vector_type(2)));
__device__ __forceinline__ unsigned pk2(float lo, float hi) { const f32x2 v = {lo, hi}; const bf16x2_t b = __builtin_convertvector(v, bf16x2_t); return __builtin_bit_cast(unsigned, b); }
__device__ __forceinline__ unsigned pk8(float a, float b, float c, float d) { int w = __builtin_amdgcn_cvt_pk_fp8_f32(a, b, 0, false); w = __builtin_amdgcn_cvt_pk_fp8_f32(c, d, w, true); return (unsigned)w; }
__device__ __forceinline__ float bflo(unsigned w) { return __builtin_bit_cast(float, w << 16); }
__device__ __forceinline__ float bfhi(unsigned w) { return __builtin_bit_cast(float, w & 0xffff0000u); }
__device__ __forceinline__ unsigned pkh2(float lo, float hi) { const unsigned short a = __builtin_bit_cast(unsigned short, (_Float16)lo), b = __builtin_bit_cast(unsigned short, (_Float16)hi); return (unsigned)a | ((unsigned)b << 16); }
__device__ __forceinline__ float hlo(unsigned w) { return (float)__builtin_bit_cast(_Float16, (unsigned short)(w & 0xffffu)); }
__device__ __forceinline__ float hhi(unsigned w) { return (float)__builtin_bit_cast(_Float16, (unsigned short)(w >> 16)); }
__device__ __forceinline__ float sigmoidf_(float x) { return __builtin_amdgcn_rcpf(1.0f + __builtin_amdgcn_exp2f(-1.44269504f * x)); }
__device__ __forceinline__ float tanhf_(float x) { return 1.0f - 2.0f * __builtin_amdgcn_rcpf(1.0f + __builtin_amdgcn_exp2f(2.88539008f * x)); }
__device__ __forceinline__ float wave_sum(float v) {
#pragma unroll
    for (int o = 1; o < 64; o <<= 1) v += __shfl_xor(v, o);
    return v;
}
__device__ __forceinline__ float dpp_f(float v, const int ctrl_sel) {
    int r;
    const int x = __builtin_bit_cast(int, v);
    if (ctrl_sel == 0) r = __builtin_amdgcn_update_dpp(0, x, 0xB1, 0xF, 0xF, true);
    else if (ctrl_sel == 1) r = __builtin_amdgcn_update_dpp(0, x, 0x4E, 0xF, 0xF, true);
    else if (ctrl_sel == 2) r = __builtin_amdgcn_update_dpp(0, x, 0x141, 0xF, 0xF, true);
    else r = __builtin_amdgcn_update_dpp(0, x, 0x140, 0xF, 0xF, true);
    return __builtin_bit_cast(float, r);
}
__device__ __forceinline__ float allred16(float v) { v += dpp_f(v, 0); v += dpp_f(v, 1); v += dpp_f(v, 2); v += dpp_f(v, 3); return v; }

#define LDS_WAIT() asm volatile("s_waitcnt lgkmcnt(0)" ::: "memory")
#define VM_WAIT() asm volatile("s_waitcnt vmcnt(0)" ::: "memory")

namespace pg8 {
constexpr int BM = 256, BK = 64, HALF = 128, HTB = HALF * BK * 2, STAGE_BYTES = 8 * HTB, NXCD = 8, WGM = 8;
__host__ __device__ __forceinline__ int lds_byte(int r, int c) { const int st = (r >> 4) * 2 + (c >> 5), rr = r & 15, cc = c & 31, ob = rr * 64 + cc * 2; return st * 1024 + (ob ^ (((ob >> 9) & 1) << 5)); }
__host__ __device__ __forceinline__ void stage_rc(int b, int& R, int& C) { const int st = b / 1024, sb = b % 1024, swz = sb ^ (((sb >> 9) & 1) << 5); R = (st >> 1) * 16 + swz / 64; C = (st & 1) * 32 + (swz % 64) / 2; }
__host__ __device__ __forceinline__ int perm32(int rho) { const int n = rho >> 4, i = rho & 15; return 8 * (i >> 2) + 4 * n + (i & 3); }
struct Unit { const char* A; const char* B; int pm, pn, aux, ui; };
__device__ __forceinline__ int xcd_remap(int L, int nwg) { const int q = nwg / NXCD, r = nwg % NXCD, xcd = L % NXCD, off = L / NXCD; return (xcd < r ? xcd * (q + 1) : r * (q + 1) + (xcd - r) * q) + off; }
__device__ __forceinline__ void grid_tile(int wgid, int nM, int nN, int& pm, int& pn) { const int nig = WGM * nN, gid = wgid / nig, fm = gid * WGM, gsz = (nM - fm) < WGM ? (nM - fm) : WGM; pm = fm + ((wgid % nig) % gsz); pn = (wgid % nig) / gsz; }

__device__ __forceinline__ void stage2(LAS unsigned char* lds, int bufoff, unsigned ldsw, const char* g, unsigned o0, unsigned o1) {
    __builtin_amdgcn_global_load_lds((const unsigned*)(g + o0), (LAS unsigned*)(lds + bufoff + ldsw), 16, 0, 0);
    __builtin_amdgcn_global_load_lds((const unsigned*)(g + o1), (LAS unsigned*)(lds + bufoff + ldsw + 8192), 16, 0, 0);
}

typedef int v8i_t __attribute__((ext_vector_type(8)));
typedef int v4i_t __attribute__((ext_vector_type(4)));
__device__ __forceinline__ v8i_t mx_cat(const bf16x8& lo, const bf16x8& hi) { const v4i_t a = __builtin_bit_cast(v4i_t, lo), b = __builtin_bit_cast(v4i_t, hi); return __builtin_shufflevector(a, b, 0, 1, 2, 3, 4, 5, 6, 7); }

template <class Epi, class = void> struct EpiPerm16 { static constexpr bool value = false; };
template <class Epi> struct EpiPerm16<Epi, decltype((void)Epi::PERM16)> { static constexpr bool value = Epi::PERM16; };
template <class Epi> __host__ __device__ constexpr bool epi_perm16() { return EpiPerm16<Epi>::value; }
template <class Epi> __host__ __device__ __forceinline__ int perm_row(int R) {
    if (epi_perm16<Epi>()) { const int wc = R >> 5, rho = R & 31, n = rho >> 4, i = rho & 15; return 64 * wc + 16 * (i >> 2) + 4 * n + (i & 3); }
    return Epi::PERM ? ((R & ~31) + perm32(R & 31)) : R;
}
template <class Epi, class Sched, bool GATHER, bool ALIGN_EPI = true, int MXS = 0>
__device__ __forceinline__ void gemm_phase(LAS unsigned char* lds, const int wave_, const int K, const int lda, const int ldb, const Sched& S, const Epi& E) {
    int tid_ = wave_ * 64 + (int)__builtin_amdgcn_mbcnt_hi(~0u, __builtin_amdgcn_mbcnt_lo(~0u, 0u)); asm volatile("" : "+v"(tid_));
    const int tid = tid_, wid = __builtin_amdgcn_readfirstlane(tid >> 6), lane = tid & 63, wr = wid >> 2, wc = wid & 3, fr = lane & 15, fq = lane >> 4;
    const int nt = opaque_n(K / BK);
    unsigned voffA[2], voffB[2]; int RA[2], CA[2];
#pragma unroll
    for (int i = 0; i < 2; ++i) { int R, C; stage_rc(tid * 16 + i * 8192, R, C); const int Rb = perm_row<Epi>(R);
        RA[i] = R; CA[i] = C; voffA[i] = (unsigned)(R * lda + C) * 2u; voffB[i] = (unsigned)(Rb * ldb + C) * 2u; }
    const size_t kstep = (size_t)(BK * 2);
    const size_t hstepA = (size_t)HALF * lda * 2, hstepB = (size_t)(epi_perm16<Epi>() ? 8 : HALF) * ldb * 2;
    const unsigned ldsw = (unsigned)wid * 1024u;
    const int aoff = lds_byte(wr * 64 + fr, fq * 8), boff = lds_byte(wc * 32 + fr, fq * 8);
#define PG8_SA(b, h) (((b) * 2 + (h)) * HTB)
#define PG8_SB(b, h) ((4 + (b) * 2 + (h)) * HTB)
#define PG8_STB(bufoff, gbase) stage2(lds, (bufoff), ldsw, (gbase), voffB[0], voffB[1])
#define PG8_STA(bufoff, gk, h, NX) do { if constexpr (GATHER) { const unsigned _o0 = (NX) ? vn[h][0] : vc[h][0], _o1 = (NX) ? vn[h][1] : vc[h][1]; stage2(lds, (bufoff), ldsw, (gk), _o0, _o1); } \
        else stage2(lds, (bufoff), ldsw, (gk) + (h) * hstepA, voffA[0], voffA[1]); } while (0)
#define PG8_LDA(dst, b, h) do { _Pragma("unroll") for (int m = 0; m < 4; ++m) _Pragma("unroll") for (int k = 0; k < 2; ++k) dst[m][k] = *(const LAS bf16x8*)(lds + PG8_SA(b, h) + aoff + m * 2048 + k * 1024); } while (0)
#define PG8_LDB(dst, b, h) do { _Pragma("unroll") for (int n = 0; n < 2; ++n) _Pragma("unroll") for (int k = 0; k < 2; ++k) dst[n][k] = *(const LAS bf16x8*)(lds + PG8_SB(b, h) + boff + n * 2048 + k * 1024); } while (0)
#define PG8_MMA(ai, bj, At, Bt) do { __builtin_amdgcn_s_setprio(1); if constexpr (MXS != 0) { _Pragma("unroll") for (int m = 0; m < 4; ++m) _Pragma("unroll") for (int n = 0; n < 2; ++n) \
        asm volatile("v_mfma_scale_f32_16x16x128_f8f6f4 %0, %1, %2, %0, %3, %3 op_sel_hi:[0,0,0]" : "+v"(acc[ai][bj][m][n]) : "v"(mx_cat(Bt[n][0], Bt[n][1])), "v"(mx_cat(At[m][0], At[m][1])), "v"(mxs_)); } \
        else { _Pragma("unroll") for (int m = 0; m < 4; ++m) _Pragma("unroll") for (int n = 0; n < 2; ++n) _Pragma("unroll") for (int k = 0; k < 2; ++k) \
        acc[ai][bj][m][n] = __builtin_amdgcn_mfma_f32_16x16x32_bf16(Bt[n][k], At[m][k], acc[ai][bj][m][n], 0, 0, 0); } __builtin_amdgcn_s_setprio(0); } while (0)
#define PG8_WAIT_V(n) asm volatile("s_waitcnt vmcnt(" #n ")" ::: "memory")
#define PG8_WAIT_L(n) asm volatile("s_waitcnt lgkmcnt(" #n ")" ::: "memory")
#define PG8_BAR __builtin_amdgcn_s_barrier()
#define PG8_SCHED __builtin_amdgcn_sched_barrier(0)
    Unit cur, nxt; int ui = 0;
    if (!S.next(0, cur)) return;
    int mxs_ = MXS * 0x01010101; asm volatile("" : "+v"(mxs_));
    unsigned vc[2][2], vn[2][2];
    if constexpr (GATHER) {
#pragma unroll
        for (int h = 0; h < 2; ++h)
#pragma unroll
            for (int i = 0; i < 2; ++i) { vc[h][i] = ((unsigned)S.row(cur, h * HALF + RA[i]) * (unsigned)lda + (unsigned)CA[i]) * 2u; vn[h][i] = vc[h][i]; }
        if constexpr (!Sched::ROW_LDS) asm volatile("s_waitcnt vmcnt(0)" ::: "memory");
    }
    f32x4 acc[2][2][4][2];
#pragma unroll
    for (int a = 0; a < 2; ++a)
#pragma unroll
        for (int b = 0; b < 2; ++b)
#pragma unroll
            for (int m = 0; m < 4; ++m)
#pragma unroll
                for (int n = 0; n < 2; ++n) acc[a][b][m][n] = (f32x4){0.f, 0.f, 0.f, 0.f};
    bf16x8 At[4][2], B0[2][2], B1[2][2];
    const char* cA = cur.A; const char* cB = cur.B;
    PG8_STB(PG8_SB(0, 0), cB); PG8_STB(PG8_SB(0, 1), cB + hstepB); PG8_STA(PG8_SA(0, 0), cA, 0, false); PG8_STA(PG8_SA(0, 1), cA, 1, false);
    if (wr == 1) PG8_BAR;
    PG8_WAIT_V(2); PG8_BAR;
    PG8_STB(PG8_SB(1, 0), cB + kstep); PG8_STA(PG8_SA(1, 0), cA + kstep, 0, false); PG8_STB(PG8_SB(1, 1), cB + hstepB + kstep);
    PG8_WAIT_V(6); PG8_BAR;
    for (;;) {
        const bool has_next = S.next(ui + 1, nxt);
        const char* nA = has_next ? nxt.A : cA; const char* nB = has_next ? nxt.B : cB;
#pragma unroll 1
        for (int t = 0; t < nt; t += 2) {
            const bool last = (t == nt - 2);
            const char* a1 = cA + (size_t)(t + 1) * kstep;
            const char* a2 = last ? nA : cA + (size_t)(t + 2) * kstep; const char* b2 = last ? nB : cB + (size_t)(t + 2) * kstep;
            const char* a3 = a2 + kstep; const char* b3 = b2 + kstep;
            if constexpr (GATHER) {
                if (last && has_next) {
#pragma unroll
                    for (int h = 0; h < 2; ++h)
#pragma unroll
                        for (int i = 0; i < 2; ++i) vn[h][i] = ((unsigned)S.row(nxt, h * HALF + RA[i]) * (unsigned)lda + (unsigned)CA[i]) * 2u;
                    if constexpr (!Sched::ROW_LDS) asm volatile("s_waitcnt vmcnt(0)" ::: "memory");
                }
            }
            PG8_LDB(B0, 0, 0); PG8_LDB(B1, 0, 1); PG8_SCHED; PG8_LDA(At, 0, 0); PG8_STA(PG8_SA(1, 1), a1, 1, false);
            PG8_WAIT_V(8); PG8_WAIT_L(0); PG8_BAR; PG8_MMA(0, 0, At, B0); PG8_MMA(0, 1, At, B1); PG8_BAR; PG8_SCHED;
            PG8_LDA(At, 0, 1); PG8_STB(PG8_SB(0, 0), b2); PG8_STB(PG8_SB(0, 1), b2 + hstepB); PG8_STA(PG8_SA(0, 0), a2, 0, last);
            PG8_WAIT_V(8); PG8_WAIT_L(0); PG8_BAR; PG8_MMA(1, 0, At, B0); PG8_MMA(1, 1, At, B1); PG8_BAR; PG8_SCHED;
            PG8_LDB(B0, 1, 0); PG8_LDB(B1, 1, 1); PG8_SCHED; PG8_LDA(At, 1, 0); PG8_STA(PG8_SA(0, 1), a2, 1, last);
            PG8_WAIT_V(8); PG8_WAIT_L(0); PG8_BAR; PG8_MMA(0, 0, At, B0); PG8_MMA(0, 1, At, B1); PG8_BAR; PG8_SCHED;
            PG8_LDA(At, 1, 1); PG8_STB(PG8_SB(1, 0), b3); PG8_STB(PG8_SB(1, 1), b3 + hstepB); PG8_STA(PG8_SA(1, 0), a3, 0, last);
            PG8_WAIT_V(8); PG8_WAIT_L(0); PG8_BAR; PG8_MMA(1, 0, At, B0); PG8_MMA(1, 1, At, B1); PG8_BAR; PG8_SCHED;
        }
        if constexpr (ALIGN_EPI) { if (wr == 0) PG8_BAR; }
        if constexpr (MXS != 0) asm volatile("s_nop 15\n\ts_nop 15" ::: "memory");
        { int fr_ = fr, fq_ = fq; asm volatile("" : "+v"(fr_), "+v"(fq_));
          E(acc, cur, wr, wc, fr_, fq_); }
        if (!has_next) break;
#pragma unroll
        for (int a = 0; a < 2; ++a)
#pragma unroll
            for (int b = 0; b < 2; ++b)
#pragma unroll
                for (int m = 0; m < 4; ++m)
#pragma unroll
                    for (int n = 0; n < 2; ++n) acc[a][b][m][n] = (f32x4){0.f, 0.f, 0.f, 0.f};
        cur = nxt; cA = nA; cB = nB; ++ui;
        if constexpr (GATHER) {
#pragma unroll
            for (int h = 0; h < 2; ++h)
#pragma unroll
                for (int i = 0; i < 2; ++i) vc[h][i] = vn[h][i];
        }
        if constexpr (ALIGN_EPI) { if (wr == 1) PG8_BAR; }
    }
    PG8_WAIT_V(0);
    if constexpr (!ALIGN_EPI) { if (wr == 0) PG8_BAR; }
    PG8_BAR;
#undef PG8_SA
#undef PG8_SB
#undef PG8_STB
#undef PG8_STA
#undef PG8_LDA
#undef PG8_LDB
#undef PG8_MMA
#undef PG8_WAIT_V
#undef PG8_WAIT_L
#undef PG8_BAR
#undef PG8_SCHED
}
}
#define XB_TMO      128
#define XB_XCNT(j)  (256  + 64 * (j))
#define XB_XSUB(j)  (1280 + 64 * (j))
#define XB_XGEN(j)  (2304 + 64 * (j))
#define XB_TOP      3328
#define XB_TOPGEN   3392
#define XCD_BAR_WORDS 3456
#define XB_SPIN_CAP (1u << 18)
__device__ __forceinline__ unsigned xb_ld(unsigned* p)              { return __hip_atomic_load(p, __ATOMIC_RELAXED, __HIP_MEMORY_SCOPE_AGENT); }
__device__ __forceinline__ unsigned xb_add(unsigned* p, unsigned v) { return __hip_atomic_fetch_add(p, v, __ATOMIC_RELAXED, __HIP_MEMORY_SCOPE_AGENT); }
__device__ __forceinline__ unsigned xb_xcc_id() { return (unsigned)__builtin_amdgcn_s_getreg((3 << 11) | 20) & 0xFu; }
#define XB_SPIN(cond, bar) do { unsigned _sp = 0; while (cond) { __builtin_amdgcn_s_sleep(1); \
    if ((++_sp & 255u) == 0u) { if (xb_ld(&(bar)[XB_TMO])) break; if (_sp > XB_SPIN_CAP) { atomicAdd(&(bar)[XB_TMO], 1u); break; } } } } while (0)
struct XcdBarrier { unsigned* bar; unsigned x; volatile LAS unsigned* st; };
__device__ __forceinline__ XcdBarrier xcd_barrier_post(unsigned* bar, volatile LAS unsigned* st) {
    XcdBarrier b; b.bar = bar; b.x = xb_xcc_id(); b.st = st;
    if (threadIdx.x == 0) (void)xb_add(&bar[XB_XCNT(b.x)], 1u);
    return b;
}
__device__ __forceinline__ void xcd_barrier_complete(unsigned* bar, unsigned x, unsigned& nloc, unsigned& nx) {
    const unsigned G = gridDim.x * gridDim.y * gridDim.z;
    unsigned sum, cnt, mine, sp = 0u;
    for (;;) {
        sum = 0u; cnt = 0u; mine = 0u;
#pragma unroll
        for (unsigned j = 0; j < 16; ++j) { const unsigned c = xb_ld(&bar[XB_XCNT(j)]); sum += c; cnt += (c > 0u) ? 1u : 0u; mine = (j == x) ? c : mine; }
        if (sum == G) break;
        __builtin_amdgcn_s_sleep(1);
        if ((++sp & 255u) == 0u) { if (xb_ld(&bar[XB_TMO])) break; if (sp > XB_SPIN_CAP) { atomicAdd(&bar[XB_TMO], 1u); break; } }
    }
    nloc = mine > 0u ? mine : 1u; nx = cnt > 0u ? cnt : 1u;
}
__device__ __forceinline__ void xcd_barrier(const XcdBarrier& b) {
    asm volatile("s_waitcnt vmcnt(0)" ::: "memory");
    __syncthreads();
    if (threadIdx.x == 0) {
        unsigned* bar = b.bar;
        __builtin_amdgcn_s_waitcnt(0);
        unsigned nloc = b.st[0], nx = b.st[1];
        if (nloc == 0u) { xcd_barrier_complete(bar, b.x, nloc, nx); b.st[0] = nloc; b.st[1] = nx; }
        const unsigned old = xb_add(&bar[XB_XSUB(b.x)], 1u);
        const unsigned gen = old / nloc;
        if (old + 1u == (gen + 1u) * nloc) {
            __builtin_amdgcn_fence(__ATOMIC_RELEASE, "agent");
            asm volatile("s_waitcnt vmcnt(0)" ::: "memory");
            const unsigned og = xb_add(&bar[XB_TOP], 1u);
            const unsigned tg = og / nx;
            if (og + 1u == (tg + 1u) * nx) xb_add(&bar[XB_TOPGEN], 1u);
            else XB_SPIN(xb_ld(&bar[XB_TOPGEN]) == tg, bar);
            __builtin_amdgcn_fence(__ATOMIC_ACQUIRE, "agent");
            xb_add(&bar[XB_XGEN(b.x)], 1u);
            asm volatile("s_waitcnt vmcnt(0)" ::: "memory");
        } else {
            XB_SPIN(xb_ld(&bar[XB_XGEN(b.x)]) == gen, bar);
            __builtin_amdgcn_fence(__ATOMIC_ACQUIRE, "agent");
            asm volatile("s_waitcnt vmcnt(0)" ::: "memory");
        }
    }
    __syncthreads();
}

constexpr size_t MiB = 1u << 20;
constexpr size_t WS_CTL = 0, CTL_ZERO_BYTES = 64 * 1024;
constexpr size_t WS_MOD = 1 * MiB;
constexpr size_t WS_EIDX = 2 * MiB;
constexpr size_t WS_WSEL = WS_EIDX + 512 * 1024;
constexpr size_t WS_RANK = WS_WSEL + 512 * 1024;
constexpr size_t WS_TOK = 4 * MiB;
constexpr size_t WS_DST = WS_TOK + 1 * MiB;
constexpr size_t WS_WSL = WS_DST + 1 * MiB;
constexpr size_t WS_WIN = 8 * MiB;
constexpr size_t WS_POOLW = 55 * MiB;
constexpr size_t WS_WPO = 56 * MiB;
constexpr size_t WS_LORA = 60 * MiB;
constexpr size_t WS_G2 = 62 * MiB;
constexpr size_t WS_WRO = 63 * MiB;
constexpr size_t WS_WO = 71 * MiB;
constexpr size_t WS_SLAB = 80 * MiB;
constexpr size_t WS_EA = 80 * MiB;
constexpr size_t EA_STRIDE = (size_t)MT * D * 2;
constexpr size_t WS_YF = 352 * MiB, WS_YB = 416 * MiB;
constexpr size_t WS_HA = 438 * MiB;
constexpr size_t WS_Z = 480 * MiB;
constexpr size_t WS_U = 506 * MiB;
constexpr size_t WS_RM = 544 * MiB, WS_KM = 612 * MiB, WS_VM = 680 * MiB;
constexpr size_t WS_LIN = 748 * MiB;
constexpr size_t WS_DP = 774 * MiB;
constexpr size_t WS_BON = 774 * MiB;
constexpr size_t WS_Y2 = 806 * MiB;
constexpr size_t WS_MP = 838 * MiB;
constexpr size_t WS_GATES = 902 * MiB;
constexpr size_t WS_OR = 80 * MiB;
constexpr size_t WS_H2 = 520 * MiB;
constexpr size_t WS_GU = 584 * MiB;
constexpr size_t WS_GU2 = 966 * MiB, WS_GU3 = 1134 * MiB;
constexpr int GU_E2 = 52, GU_E3 = 61;
constexpr size_t WS_ACT = 792 * MiB;
constexpr size_t WS_DT = 1004 * MiB;
constexpr size_t WS_X1 = 328 * MiB;
constexpr size_t WS_YP = 8 * MiB;
constexpr size_t WS_END = 1150 * MiB;
__host__ __device__ __forceinline__ size_t gu_base(int e) { return e < GU_E2 ? WS_GU + (size_t)e * (4 * MiB) : e < GU_E3 ? WS_GU2 + (size_t)(e - GU_E2) * (4 * MiB) : WS_GU3 + (size_t)(e - GU_E3) * (4 * MiB); }
constexpr int CW_BAR = 1024;
constexpr int CW_GCNT = 8192;
constexpr int CW_O64 = 8192 + 100;
constexpr int CW_CONV = 8448, CW_P2DONE = 8512;
static_assert((CW_BAR + XCD_BAR_WORDS) <= CW_GCNT && (CW_P2DONE + 128) * 4 <= (int)CTL_ZERO_BYTES, "ctl");

constexpr int RING_OFF = 0, RING_BYTES = 131072;
constexpr int LDSCTL_OFF = RING_BYTES;
constexpr int ROWTAB_OFF = LDSCTL_OFF + 1024 + 4096, ROWTAB_UNITS = 24;
constexpr int TAB_OFF = LDSCTL_OFF + 1024;
constexpr int LDS_BYTES = 163840;

using pg8::Unit;
struct RepOrder { static constexpr bool ROW_LDS = false;
    const char* A; const char* B; size_t repA, repB, tA, tB; int nM, nN, nrep, G, c;
    __device__ __forceinline__ bool next(int i, Unit& u) const {
        const long L = (long)i * G + c; const int per = nM * nN; if (L >= (long)per * nrep) return false;
        const int rep = (int)(L / per); const int w = pg8::xcd_remap((int)(L % per), per); pg8::grid_tile(w, nM, nN, u.pm, u.pn); u.aux = rep;
        u.A = A + (size_t)rep * repA + (size_t)u.pm * tA; u.B = B + (size_t)rep * repB + (size_t)u.pn * tB; return true; }
    __device__ __forceinline__ int row(const Unit&, int) const { return 0; }
};
struct G1Order { static constexpr bool ROW_LDS = false;
    const char* A; const char* B; size_t tA, tB; int G, c;
    __device__ __forceinline__ bool next(int i, Unit& u) const {
        const long L = (long)i * G + c; constexpr int N1 = 64 * 47, N2 = 4 * 27; if (L >= N1 + N2) return false;
        if (L < N1) { const int w = pg8::xcd_remap((int)L, N1); pg8::grid_tile(w, 64, 47, u.pm, u.pn); }
        else { const int l2 = (int)L - N1; u.pm = 64 + (l2 & 3); u.pn = 4 + (l2 >> 2); }
        u.aux = 0; u.A = A + (size_t)u.pm * tA; u.B = B + (size_t)u.pn * tB; return true; }
    __device__ __forceinline__ int row(const Unit&, int) const { return 0; }
};
template <bool GUMAP> struct MoeOrderT { static constexpr bool ROW_LDS = true;
    const char* A; const char* B; const LAS int* te; const LAS int* rowtab; size_t tA, estride, jstride; int ntiles, NJ, G, c;
    __device__ __forceinline__ bool next(int i, Unit& u) const {
        const long L = (long)i * G + c; const int tot = ntiles * NJ; if (L >= tot) return false;
        const int w = pg8::xcd_remap((int)L, tot); const int rt = w / NJ, j = w - rt * NJ; const int e = te[rt];
        u.pm = rt; u.pn = j; u.aux = e; u.ui = i; u.A = A + (size_t)rt * tA; u.B = B + (GUMAP ? gu_base(e) : (size_t)e * estride) + (size_t)j * jstride; return true; }
    __device__ __forceinline__ int row(const Unit& u, int r) const { return rowtab[u.ui * 256 + r]; }
};

typedef f32x4 AccT[2][2][4][2];
#define EPI_ROWS_BEGIN _Pragma("unroll") for (int ai = 0; ai < 2; ++ai) _Pragma("unroll") for (int m = 0; m < 4; ++m) { const int rl = ai * 128 + wr * 64 + m * 16 + fr;
#define EPI_ROWS_END if (m & 1) asm volatile("" ::: "memory"); }
struct EpiG1 { static constexpr bool PERM = true; bf16* U; bf16* SLAB; unsigned char* GATES;
    __device__ __forceinline__ void operator()(const AccT& acc, const Unit& u, int wr, int wc, int fr, int fq) const {
        if (u.pn >= 31) {
            const int c0 = (u.pn - 31) * 256 + wc * 32 + 8 * fq;
            EPI_ROWS_BEGIN
                unsigned char* rowp = GATES + (size_t)(u.pm * 256 + rl) * 4096 + c0;
#pragma unroll
                for (int bj = 0; bj < 2; ++bj) { const f32x4 v0 = acc[ai][bj][m][0], v1 = acc[ai][bj][m][1]; unsigned p0 = 0u, p1 = 0u;
                    p0 = __builtin_amdgcn_cvt_pk_u8_f32(255.0f * sigmoidf_(v0[0]), 0, p0); p0 = __builtin_amdgcn_cvt_pk_u8_f32(255.0f * sigmoidf_(v0[1]), 1, p0);
                    p0 = __builtin_amdgcn_cvt_pk_u8_f32(255.0f * sigmoidf_(v0[2]), 2, p0); p0 = __builtin_amdgcn_cvt_pk_u8_f32(255.0f * sigmoidf_(v0[3]), 3, p0);
                    p1 = __builtin_amdgcn_cvt_pk_u8_f32(255.0f * sigmoidf_(v1[0]), 0, p1); p1 = __builtin_amdgcn_cvt_pk_u8_f32(255.0f * sigmoidf_(v1[1]), 1, p1);
                    p1 = __builtin_amdgcn_cvt_pk_u8_f32(255.0f * sigmoidf_(v1[2]), 2, p1); p1 = __builtin_amdgcn_cvt_pk_u8_f32(255.0f * sigmoidf_(v1[3]), 3, p1);
                    v2u w; w.x = p0; w.y = p1; *(v2u*)(rowp + bj * 128) = w; }
            EPI_ROWS_END
            return;
        }
        bf16* base; int ld, c0;
        if (u.pn < 4) { base = U; ld = 1024; c0 = u.pn * 256; } else { base = SLAB; ld = SLABLD; c0 = (u.pn - 4) * 256; }
        EPI_ROWS_BEGIN
            bf16* rowp = base + (size_t)(u.pm * 256 + rl) * ld + c0 + wc * 32 + 8 * fq;
#pragma unroll
            for (int bj = 0; bj < 2; ++bj) { const f32x4 v0 = acc[ai][bj][m][0], v1 = acc[ai][bj][m][1];
                v4u w; w.x = pk2(v0[0], v0[1]); w.y = pk2(v0[2], v0[3]); w.z = pk2(v1[0], v1[1]); w.w = pk2(v1[2], v1[3]); *(v4u*)(rowp + bj * 128) = w; }
        EPI_ROWS_END
    }
};
struct EpiLora { static constexpr bool PERM = true; unsigned short* EA; const float* w0; const float* a0;
    __device__ __forceinline__ void operator()(const AccT& acc, const Unit& u, int wr, int wc, int fr, int fq) const {
        const int rep = u.aux; const float* bias = (rep < 2 ? w0 + rep * D : a0 + (rep - 2) * D) + u.pn * 256 + wc * 32 + 8 * fq;
        unsigned short* base = EA + (size_t)rep * ((size_t)MT * D);
        if (rep < 2) { const float cc = -0.8750424f;
            EPI_ROWS_BEGIN
                unsigned short* rowp = base + (size_t)(u.pm * 256 + rl) * D + u.pn * 256 + wc * 32 + 8 * fq;
#pragma unroll
                for (int bj = 0; bj < 2; ++bj) { const f32x4 v0 = acc[ai][bj][m][0] + *(const f32x4*)(bias + bj * 128), v1 = acc[ai][bj][m][1] + *(const f32x4*)(bias + bj * 128 + 4);
                    v4u w; w.x = pkh2(cc * sigmoidf_(v0[0]), cc * sigmoidf_(v0[1])); w.y = pkh2(cc * sigmoidf_(v0[2]), cc * sigmoidf_(v0[3]));
                    w.z = pkh2(cc * sigmoidf_(v1[0]), cc * sigmoidf_(v1[1])); w.w = pkh2(cc * sigmoidf_(v1[2]), cc * sigmoidf_(v1[3]));
                    *(v4u*)(rowp + bj * 128) = w; }
            EPI_ROWS_END
        } else {
            EPI_ROWS_BEGIN
                unsigned char* rowp = (unsigned char*)base + (size_t)(u.pm * 256 + rl) * D + u.pn * 256 + wc * 32 + 8 * fq;
#pragma unroll
                for (int bj = 0; bj < 2; ++bj) { const f32x4 v0 = acc[ai][bj][m][0] + *(const f32x4*)(bias + bj * 128), v1 = acc[ai][bj][m][1] + *(const f32x4*)(bias + bj * 128 + 4); unsigned p0 = 0u, p1 = 0u;
                    p0 = __builtin_amdgcn_cvt_pk_u8_f32(255.0f * sigmoidf_(v0[0]), 0, p0); p0 = __builtin_amdgcn_cvt_pk_u8_f32(255.0f * sigmoidf_(v0[1]), 1, p0);
                    p0 = __builtin_amdgcn_cvt_pk_u8_f32(255.0f * sigmoidf_(v0[2]), 2, p0); p0 = __builtin_amdgcn_cvt_pk_u8_f32(255.0f * sigmoidf_(v0[3]), 3, p0);
                    p1 = __builtin_amdgcn_cvt_pk_u8_f32(255.0f * sigmoidf_(v1[0]), 0, p1); p1 = __builtin_amdgcn_cvt_pk_u8_f32(255.0f * sigmoidf_(v1[1]), 1, p1);
                    p1 = __builtin_amdgcn_cvt_pk_u8_f32(255.0f * sigmoidf_(v1[2]), 2, p1); p1 = __builtin_amdgcn_cvt_pk_u8_f32(255.0f * sigmoidf_(v1[3]), 3, p1);
                    v2u w; w.x = p0; w.y = p1; *(v2u*)(rowp + bj * 128) = w; }
            EPI_ROWS_END
        }
    }
};
struct EpiPoolG { static constexpr bool PERM = true; bf16* Y2; const float* scale;
    __device__ __forceinline__ void operator()(const AccT& acc, const Unit& u, int wr, int wc, int fr, int fq) const {
        const int cb = u.aux * 256 + wc * 32 + 8 * fq;
        f32x4 s0[2], s1[2];
#pragma unroll
        for (int bj = 0; bj < 2; ++bj) { s0[bj] = *(const f32x4*)(scale + cb + bj * 128); s1[bj] = *(const f32x4*)(scale + cb + bj * 128 + 4); }
        EPI_ROWS_BEGIN
            bf16* rowp = Y2 + (size_t)(u.pm * 256 + rl) * 1024 + cb;
#pragma unroll
            for (int bj = 0; bj < 2; ++bj) { const f32x4 v0 = acc[ai][bj][m][0] * s0[bj], v1 = acc[ai][bj][m][1] * s1[bj];
                v4u w; w.x = pk2(v0[0], v0[1]); w.y = pk2(v0[2], v0[3]); w.z = pk2(v1[0], v1[1]); w.w = pk2(v1[2], v1[3]); *(v4u*)(rowp + bj * 128) = w; }
        EPI_ROWS_END
    }
};
template <int MODE, bool OUT8 = false> struct EpiMix { static constexpr bool PERM = true; bf16* OUT;
    int ldo; const void* AUX1; int ld1; const bf16* AUX2; int ld2;
    __device__ __forceinline__ void operator()(const AccT& acc, const Unit& u, int wr, int wc, int fr, int fq) const {
        const int cb = u.pn * 256 + wc * 32 + 8 * fq;
        EPI_ROWS_BEGIN
            const size_t row = (size_t)(u.pm * 256 + rl);
#pragma unroll
            for (int bj = 0; bj < 2; ++bj) { const f32x4 v0 = acc[ai][bj][m][0], v1 = acc[ai][bj][m][1];
                float x[8];
                if (MODE == 1) { const v4u a1 = *(const v4u*)((const bf16*)AUX1 + row * ld1 + cb + bj * 128);
                    x[0] = bflo(a1.x); x[1] = bfhi(a1.x); x[2] = bflo(a1.y); x[3] = bfhi(a1.y); x[4] = bflo(a1.z); x[5] = bfhi(a1.z); x[6] = bflo(a1.w); x[7] = bfhi(a1.w); }
                else { const v2u a1 = *(const v2u*)((const unsigned char*)AUX1 + row * ld1 + cb + bj * 128); const float k = 1.0f / 255.0f;
                    x[0] = (float)(a1.x & 0xffu) * k; x[1] = (float)((a1.x >> 8) & 0xffu) * k; x[2] = (float)((a1.x >> 16) & 0xffu) * k; x[3] = (float)(a1.x >> 24) * k;
                    x[4] = (float)(a1.y & 0xffu) * k; x[5] = (float)((a1.y >> 8) & 0xffu) * k; x[6] = (float)((a1.y >> 16) & 0xffu) * k; x[7] = (float)(a1.y >> 24) * k; }
                float o[8];
                if (MODE == 0 || MODE == 1) {
#pragma unroll
                    for (int j = 0; j < 4; ++j) { o[j] = x[j] * v0[j]; o[4 + j] = x[4 + j] * v1[j]; } }
                else { const v4u a2 = *(const v4u*)(AUX2 + row * ld2 + cb + bj * 128);
                    const float y[8] = {bflo(a2.x), bfhi(a2.x), bflo(a2.y), bfhi(a2.y), bflo(a2.z), bfhi(a2.z), bflo(a2.w), bfhi(a2.w)};
#pragma unroll
                    for (int j = 0; j < 4; ++j) { o[j] = y[j] + x[j] * v0[j]; o[4 + j] = y[4 + j] + x[4 + j] * v1[j]; } }
                if (OUT8) { v2u w; w.x = pk8(8.0f * o[0], 8.0f * o[1], 8.0f * o[2], 8.0f * o[3]); w.y = pk8(8.0f * o[4], 8.0f * o[5], 8.0f * o[6], 8.0f * o[7]); *(v2u*)((unsigned char*)OUT + row * ldo + cb + bj * 128) = w; }
                else { v4u w; w.x = pk2(o[0], o[1]); w.y = pk2(o[2], o[3]); w.z = pk2(o[4], o[5]); w.w = pk2(o[6], o[7]);
                *(v4u*)(OUT + row * ldo + cb + bj * 128) = w; } }
        EPI_ROWS_END
    }
};
struct EpiX1 { static constexpr bool PERM = true; const float* X; bf16* OUT; const float* MOD;
    __device__ __forceinline__ void operator()(const AccT& acc, const Unit& u, int wr, int wc, int fr, int fq) const {
        const int b = u.pm >> 4;
        const int cb = u.pn * 256 + wc * 32 + 8 * fq; const float* g = MOD + (size_t)b * 12288 + 4096 + cb;
        f32x4 gv[2][2];
#pragma unroll
        for (int bj = 0; bj < 2; ++bj)
#pragma unroll
            for (int n = 0; n < 2; ++n) gv[bj][n] = *(const f32x4*)(g + bj * 128 + n * 4);
        EPI_ROWS_BEGIN
            const size_t off = (size_t)(u.pm * 256 + rl) * D + cb;
#pragma unroll
            for (int bj = 0; bj < 2; ++bj) { const f32x4 x0 = *(const f32x4*)(X + off + bj * 128), x1 = *(const f32x4*)(X + off + bj * 128 + 4);
                const f32x4 v0 = x0 + gv[bj][0] * acc[ai][bj][m][0], v1 = x1 + gv[bj][1] * acc[ai][bj][m][1];
                v4u w; w.x = pk2(v0[0], v0[1]); w.y = pk2(v0[2], v0[3]); w.z = pk2(v1[0], v1[1]); w.w = pk2(v1[2], v1[3]); *(v4u*)(OUT + off + bj * 128) = w; }
        EPI_ROWS_END
    }
};
constexpr float ACT_F8SCALE = 8.0f;
struct EpiAct { static constexpr bool PERM = true; unsigned char* ACT;
    __device__ __forceinline__ void operator()(const AccT& acc, const Unit& u, int wr, int wc, int fr, int fq) const {
        EPI_ROWS_BEGIN
            const f32x4 g0 = acc[ai][0][m][0], g1 = acc[ai][0][m][1], u0 = acc[ai][1][m][0], u1 = acc[ai][1][m][1];
            float o[8];
#pragma unroll
            for (int j = 0; j < 4; ++j) { o[j] = __builtin_amdgcn_fmed3f(ACT_F8SCALE * g0[j] * sigmoidf_(g0[j]) * u0[j], -440.f, 440.f); o[4 + j] = __builtin_amdgcn_fmed3f(ACT_F8SCALE * g1[j] * sigmoidf_(g1[j]) * u1[j], -440.f, 440.f); }
            v2u w; w.x = pk8(o[0], o[1], o[2], o[3]); w.y = pk8(o[4], o[5], o[6], o[7]);
            *(v2u*)(ACT + (size_t)(u.pm * 256 + rl) * DEXP + u.pn * 128 + wc * 32 + 8 * fq) = w;
        EPI_ROWS_END
    }
};
constexpr float YP_SCALE = 8.0f;
struct EpiDown { static constexpr bool PERM = true, PERM16 = true; unsigned char* YP;
    __device__ __forceinline__ void operator()(const AccT& acc, const Unit& u, int wr, int wc, int fr, int fq) const {
        const int cb = u.pn * 256 + wc * 64 + 16 * fq;
        EPI_ROWS_BEGIN
            int p[4];
#pragma unroll
            for (int bj = 0; bj < 2; ++bj) { const f32x4 v0 = acc[ai][bj][m][0] * YP_SCALE, v1 = acc[ai][bj][m][1] * YP_SCALE;
                int p0 = __builtin_amdgcn_cvt_pk_fp8_f32(v0[0], v0[1], 0, false); p0 = __builtin_amdgcn_cvt_pk_fp8_f32(v0[2], v0[3], p0, true);
                int p1 = __builtin_amdgcn_cvt_pk_fp8_f32(v1[0], v1[1], 0, false); p1 = __builtin_amdgcn_cvt_pk_fp8_f32(v1[2], v1[3], p1, true);
                p[2 * bj] = p0; p[2 * bj + 1] = p1; }
            v4u w; w.x = (unsigned)p[0]; w.y = (unsigned)p[1]; w.z = (unsigned)p[2]; w.w = (unsigned)p[3];
            *(v4u*)(YP + (size_t)(u.pm * 256 + rl) * D + cb) = w;
        EPI_ROWS_END
    }
};
struct Frame {
    LAS unsigned char* lds;
    volatile LAS unsigned* MISC;
    unsigned* ctl;
    int tid, lane, wave, vcu, G;
    unsigned char* ws;
};
struct Args { const float* in[34]; float* out; unsigned char* ws; int ph_lo, ph_hi; };
enum { I_X = 0, I_C, I_CTX, I_CCTX, I_N1G, I_N2G, I_ADAW, I_ADAB, I_WIN, I_MU, I_POOLW, I_POOLS, I_WPO, I_DW0, I_DW2, I_IA0, I_IA2, I_G2, I_KK, I_KA, I_RK, I_LNW, I_LNB,
       I_WRO, I_WO, I_RW, I_RB, I_EG, I_EU, I_ED, I_SG, I_SU, I_SD, I_FG };

struct TrJob { const float* src; bf16* dst; int ldw, kvalid, ldt, k0, n0, drow0; float f8; };
template <bool NT = false> __device__ __forceinline__ void tr_load(const TrJob& j, f32x4 (&v)[16], int lane) {
    const int r2 = lane >> 4, c4 = lane & 15;
#pragma unroll
    for (int i = 0; i < 8; ++i) {
#pragma unroll
        for (int h = 0; h < 2; ++h) { const int k = j.k0 + 8 * i + 2 * r2 + h; const int kc = k < j.kvalid ? k : 0;
            const f32x4* sp_ = (const f32x4*)(j.src + (size_t)kc * j.ldw + j.n0 + 4 * c4); const f32x4 x = NT ? __builtin_nontemporal_load(sp_) : *sp_; v[2 * i + h] = (k < j.kvalid) ? x : (f32x4){0.f, 0.f, 0.f, 0.f}; } }
}
template <bool NT = false> __device__ __forceinline__ void tr_store(const TrJob& j, const f32x4 (&v)[16], LAS unsigned* P, int lane) {
    const int r2 = lane >> 4, c4 = lane & 15;
#pragma unroll
    for (int i = 0; i < 8; ++i) { LAS unsigned* p = P + (4 * i + r2) * 65 + 4 * c4;
        p[0] = pk2(v[2 * i].x, v[2 * i + 1].x); p[1] = pk2(v[2 * i].y, v[2 * i + 1].y); p[2] = pk2(v[2 * i].z, v[2 * i + 1].z); p[3] = pk2(v[2 * i].w, v[2 * i + 1].w); }
    LDS_WAIT(); asm volatile("" ::: "memory");
    const int nl = lane >> 3, q = lane & 7;
#pragma unroll
    for (int jj = 0; jj < 8; ++jj) { const int n = 8 * jj + nl; const LAS unsigned* s = P + (4 * q) * 65 + n;
        v4u o; o.x = s[0]; o.y = s[65]; o.z = s[130]; o.w = s[195];
        v4u* dp_ = (v4u*)(j.dst + (size_t)(j.drow0 + n) * j.ldt + j.k0 + 8 * q); if (NT) __builtin_nontemporal_store(o, dp_); else *dp_ = o; }
    LDS_WAIT(); asm volatile("" ::: "memory");
}
template <bool NT = false> __device__ __forceinline__ void tr8_load(const TrJob& j, int half, f32x4 (&v)[16], int lane) {
    const int r2 = lane >> 4, c4 = lane & 15;
#pragma unroll
    for (int i = 0; i < 4; ++i) {
#pragma unroll
        for (int h = 0; h < 4; ++h) { const int k = j.k0 + 64 * half + 16 * i + 4 * r2 + h; const f32x4* sp_ = (const f32x4*)(j.src + (size_t)k * j.ldw + j.n0 + 4 * c4); v[4 * i + h] = NT ? __builtin_nontemporal_load(sp_) : *sp_; } }
}
__device__ __forceinline__ void tr8_lds(const TrJob& j, int half, const f32x4 (&v)[16], LAS unsigned* P, int lane) {
    const int r2 = lane >> 4, c4 = lane & 15; const float sc = j.f8;
#pragma unroll
    for (int i = 0; i < 4; ++i) { LAS unsigned* p = P + (16 * half + 4 * i + r2) * 65 + 4 * c4;
        p[0] = pk8(sc * v[4 * i].x, sc * v[4 * i + 1].x, sc * v[4 * i + 2].x, sc * v[4 * i + 3].x); p[1] = pk8(sc * v[4 * i].y, sc * v[4 * i + 1].y, sc * v[4 * i + 2].y, sc * v[4 * i + 3].y);
        p[2] = pk8(sc * v[4 * i].z, sc * v[4 * i + 1].z, sc * v[4 * i + 2].z, sc * v[4 * i + 3].z); p[3] = pk8(sc * v[4 * i].w, sc * v[4 * i + 1].w, sc * v[4 * i + 2].w, sc * v[4 * i + 3].w); }
}
template <bool NT = false> __device__ __forceinline__ void tr8_flush(const TrJob& j, LAS unsigned* P, int lane) {
    LDS_WAIT(); asm volatile("" ::: "memory");
    const int nl = lane >> 3, q = lane & 7;
#pragma unroll
    for (int jj = 0; jj < 8; ++jj) { const int n = 8 * jj + nl; const LAS unsigned* s = P + (4 * q) * 65 + n;
        v4u o; o.x = s[0]; o.y = s[65]; o.z = s[130]; o.w = s[195];
        v4u* dp_ = (v4u*)((unsigned char*)j.dst + (size_t)(j.drow0 + n) * j.ldt + j.k0 + 16 * q); if (NT) __builtin_nontemporal_store(o, dp_); else *dp_ = o; }
    LDS_WAIT(); asm volatile("" ::: "memory");
}
template <class Dec> __device__ __forceinline__ void tr_run8(const Dec& dec, int first, int stride, LAS unsigned* P, int lane) {
    TrJob j, jn; f32x4 va[16], vb[16];
    int it = first; bool h = dec(it, j); if (h) { tr8_load(j, 0, va, lane); tr8_load(j, 1, vb, lane); }
    while (h) {
        tr8_lds(j, 0, va, P, lane); tr8_lds(j, 1, vb, P, lane);
        it += stride; const bool hn = dec(it, jn); if (hn) { tr8_load(jn, 0, va, lane); tr8_load(jn, 1, vb, lane); }
        tr8_flush(j, P, lane);
        j = jn; h = hn;
    }
}
template <class Dec> __device__ __forceinline__ void tr_run(const Dec& dec, int first, int stride, LAS unsigned* P, int lane) {
    TrJob ja, jb; f32x4 va[16], vb[16];
    int it = first; bool ha = dec(it, ja); if (ha) tr_load(ja, va, lane);
    while (ha) {
        it += stride; const bool hb = dec(it, jb); if (hb) tr_load(jb, vb, lane);
        tr_store(ja, va, P, lane);
        if (!hb) break;
        it += stride; ha = dec(it, ja); if (ha) tr_load(ja, va, lane);
        tr_store(jb, vb, P, lane);
    }
}
__device__ __forceinline__ void p0_prologue(Frame& F, const Args& a) {
    {
        LAS float* sv = (LAS float*)F.lds;
        LAS float* part = (LAS float*)(F.lds + 40960);
        bool did = false;
        for (int cb = blockIdx.x; cb < 192; cb += F.G) {
            if (!did) { for (int idx = F.tid; idx < 5 * D; idx += 512) { const int j = idx >> 11, k = idx & 2047; const float v = (j < 4) ? a.in[I_C][j * D + k] : a.in[I_CCTX][k]; sv[idx] = v / (1.0f + __expf(-v)); } did = true; }
            __syncthreads();
            const int col = 64 * cb + F.lane, k0 = 256 * F.wave; const float* wp = a.in[I_ADAW] + (size_t)k0 * 12288 + col;
            float acc[5] = {0.f, 0.f, 0.f, 0.f, 0.f};
#pragma unroll 32
            for (int k = 0; k < 256; ++k) { const float w = wp[(size_t)k * 12288];
#pragma unroll
                for (int j = 0; j < 5; ++j) acc[j] += sv[j * D + k0 + k] * w; }
#pragma unroll
            for (int j = 0; j < 5; ++j) part[(F.wave * 5 + j) * 64 + F.lane] = acc[j];
            __syncthreads();
            if (F.tid < 320) { const int j = F.tid >> 6, l = F.tid & 63; float s = a.in[I_ADAB][64 * cb + l];
#pragma unroll
                for (int w = 0; w < 8; ++w) s += part[(w * 5 + j) * 64 + l];
                ((float*)(F.ws + WS_MOD))[j * 12288 + 64 * cb + l] = s; }
            __syncthreads();
        }
        __syncthreads();
    }
    {
        struct DecSmall { const float* const* in; unsigned char* ws;
            __device__ __forceinline__ bool operator()(int it, TrJob& j) const {
                constexpr int I_1 = P2_FP8 ? 0 : 32 * 186, I_2 = 4 * 16, I_3 = 16 * 32, I_4 = 4 * 32, I_5 = 32 * 32, I_6 = 32 * 32, I_7 = 4 * 2 * 32;
                int r = it; if (r < 0) return false;
                if (r < I_1) { const int kb = r / 186, nb = r % 186, n0 = nb * 64; j = TrJob{in[I_WIN], (bf16*)(ws + WS_WIN), DIN, D, D, kb * 64, n0, n0 + (n0 >= 7808 ? 128 : 0)}; return true; } r -= I_1;
                if (r < I_2) { const int g = r / 16, q = r % 16; j = TrJob{in[I_POOLW] + (size_t)g * 65536, (bf16*)(ws + WS_POOLW) + (size_t)g * 65536, 256, 256, 256, (q / 4) * 64, (q % 4) * 64, (q % 4) * 64}; return true; } r -= I_2;
                if (r < I_3) { j = TrJob{in[I_WPO], (bf16*)(ws + WS_WPO), D, 1024, 1024, (r / 32) * 64, (r % 32) * 64, (r % 32) * 64}; return true; } r -= I_3;
                if (r < I_4) { j = TrJob{in[I_G2], (bf16*)(ws + WS_G2), D, 256, 256, (r / 32) * 64, (r % 32) * 64, (r % 32) * 64}; return true; } r -= I_4;
                if (r < I_5) { j = TrJob{in[I_WRO], (bf16*)(ws + WS_WRO), D, D, D, (r / 32) * 64, (r % 32) * 64, (r % 32) * 64}; return true; } r -= I_5;
                if (r < I_6) { j = TrJob{in[I_WO], (bf16*)(ws + WS_WO), D, D, D, (r / 32) * 64, (r % 32) * 64, (r % 32) * 64}; return true; } r -= I_6;
                if (r < I_7) { const int mtx = r / 64, q = r % 64;
                    const float* src = (mtx < 2 ? in[I_DW2] + (size_t)mtx * 96 * D : in[I_IA2] + (size_t)(mtx - 2) * 96 * D);
                    j = TrJob{src, (bf16*)(ws + WS_LORA) + (size_t)mtx * D * 128, D, 96, 128, (q / 32) * 64, (q % 32) * 64, (q % 32) * 64}; return true; }
                return false; } };
        DecSmall dec{a.in, F.ws};
        tr_run(dec, F.vcu * 8 + F.wave, F.G * 8, (LAS unsigned*)(F.lds + F.wave * 16384), F.lane);
        if (P2_FP8) {
            struct DecWin8 { const float* const* in; unsigned char* ws;
                __device__ __forceinline__ bool operator()(int it, TrJob& j) const {
                    if (it < 0 || it >= 16 * 186) return false;
                    const int kb = it / 186, nb = it % 186, n0 = nb * 64; j = TrJob{in[I_WIN], (bf16*)(ws + WS_WIN), DIN, D, D, kb * 128, n0, n0 + (n0 >= 7808 ? 128 : 0), 8.0f}; return true; } };
            DecWin8 dw{a.in, F.ws};
            tr_run8(dw, F.vcu * 8 + F.wave, F.G * 8, (LAS unsigned*)(F.lds + F.wave * 16384), F.lane);
        }
    }
    const int gt = F.vcu * 512 + F.tid, NGT = F.G * 512;
    { v4u* z = (v4u*)(F.ws + WS_WIN + (size_t)7808 * D * (P2_FP8 ? 1 : 2)); for (int i = gt; i < 128 * D / (P2_FP8 ? 16 : 8); i += NGT) z[i] = (v4u){0u, 0u, 0u, 0u}; }
    { int* tok = (int*)(F.ws + WS_TOK); for (int i = gt; i < NSLOT; i += NGT) tok[i] = 0; }
}

__device__ __forceinline__ void p1_norm1(Frame& F, const Args& a) {
    const int gw = F.vcu * 8 + F.wave, NGW = F.G * 8; const float* MOD = (const float*)(F.ws + WS_MOD); bf16* HA = (bf16*)(F.ws + WS_HA);
    for (int mrow = gw; mrow < MT; mrow += NGW) {
        const float* src = (mrow < NT) ? a.in[I_X] + (size_t)mrow * D : a.in[I_CTX] + (size_t)(mrow - NT) * D; const int j = (mrow < NT) ? (mrow >> 12) : 4;
        const f32x4* xr = (const f32x4*)src + F.lane; f32x4 v[8]; float s = 0.f;
#pragma unroll
        for (int q = 0; q < 8; ++q) { v[q] = xr[64 * q]; s += (v[q].x * v[q].x + v[q].y * v[q].y) + (v[q].z * v[q].z + v[q].w * v[q].w); }
        const float rstd = 1.0f / sqrtf(wave_sum(s) * (1.0f / D) + 1e-6f);
        const f32x4* g = (const f32x4*)a.in[I_N1G] + F.lane; const f32x4* sh = (const f32x4*)(MOD + (size_t)j * 12288) + F.lane; const f32x4* sc = (const f32x4*)(MOD + (size_t)j * 12288 + 2048) + F.lane;
        v2u* o = (v2u*)(HA + (size_t)mrow * D) + F.lane; unsigned* o8 = (unsigned*)((unsigned char*)HA + (size_t)mrow * D) + F.lane;
#pragma unroll
        for (int q = 0; q < 8; ++q) { const f32x4 y = v[q] * rstd * g[64 * q] * (sc[64 * q] + 1.0f) + sh[64 * q];
            if (P2_FP8) o8[64 * q] = pk8(8.0f * y.x, 8.0f * y.y, 8.0f * y.z, 8.0f * y.w); else { v2u w; w.x = pk2(y.x, y.y); w.y = pk2(y.z, y.w); o[64 * q] = w; } }
    }
}

template <int W> __device__ __forceinline__ void pool_item(const unsigned* U32, unsigned* DP32, int m0, int cp) {
    unsigned raw[64];
#pragma unroll
    for (int x = 0; x < 64; ++x) raw[x] = U32[(size_t)(m0 + x) * 512 + cp];
    float lo[64], hi[64];
#pragma unroll
    for (int x = 0; x < 64; ++x) { lo[x] = bflo(raw[x]); hi[x] = bfhi(raw[x]); }
#pragma unroll
    for (int x = 0; x < 64; ++x) { const int l = (x - W / 2) < 0 ? 0 : (x - W / 2), h = (x + W / 2) > 64 ? 64 : (x + W / 2); float s0 = 0.f, s1 = 0.f;
#pragma unroll
        for (int j = l; j < h; ++j) { s0 += lo[j]; s1 += hi[j]; }
        const float inv = 1.0f / (float)(h - l); DP32[(size_t)(m0 + x) * 512 + cp] = pk2(s0 * inv - lo[x], s1 * inv - hi[x]); }
}
__device__ __forceinline__ void p3_mix_store(const v4u o, const v4u nb, const f32x4 m0, const f32x4 m1, int c0, int mrow, bf16* RM, bf16* KM, bf16* VM, bf16* LIN) {
    float r[8];
    { const float ov[8] = {bflo(o.x), bfhi(o.x), bflo(o.y), bfhi(o.y), bflo(o.z), bfhi(o.z), bflo(o.w), bfhi(o.w)};
      const float nv[8] = {bflo(nb.x), bfhi(nb.x), bflo(nb.y), bfhi(nb.y), bflo(nb.z), bfhi(nb.z), bflo(nb.w), bfhi(nb.w)};
      const float mv[8] = {m0.x, m0.y, m0.z, m0.w, m1.x, m1.y, m1.z, m1.w};
#pragma unroll
      for (int e = 0; e < 8; ++e) r[e] = ov[e] + (nv[e] - ov[e]) * mv[e]; }
    bf16* dstp;
    if (c0 < 2048) dstp = RM + (size_t)mrow * D + c0;
    else if (c0 < 4096) dstp = KM + (size_t)mrow * D + (c0 - 2048);
    else if (c0 < 6144) dstp = VM + (size_t)mrow * D + (c0 - 4096);
    else { const int lc = c0 - 6144; int dc;
        if (lc < 192) {
#pragma unroll
            for (int e = 0; e < 8; ++e) r[e] = tanhf_(r[e]);
            dc = (lc < 96) ? lc : 128 + (lc - 96); }
        else if (lc < 384) dc = (lc < 288) ? 256 + (lc - 192) : 384 + (lc - 288);
        else {
#pragma unroll
            for (int e = 0; e < 8; ++e) r[e] = sigmoidf_(r[e]);
            dc = 512 + (lc - 384); }
        dstp = LIN + (size_t)mrow * LINLD + dc; }
    v4u w; w.x = pk2(r[0], r[1]); w.y = pk2(r[2], r[3]); w.z = pk2(r[4], r[5]); w.w = pk2(r[6], r[7]); *(v4u*)dstp = w;
}
constexpr int P3_SLICE = 512, P3_NSLICE = (DSH + P3_SLICE - 1) / P3_SLICE  , P3_SLOTS = 96;
__device__ __forceinline__ void p3_prep(Frame& F, const Args& a) {
    const bf16* SLAB = (const bf16*)(F.ws + WS_SLAB); const float* mu = a.in[I_MU];
    bf16* RM = (bf16*)(F.ws + WS_RM); bf16* KM = (bf16*)(F.ws + WS_KM); bf16* VM = (bf16*)(F.ws + WS_VM); bf16* LIN = (bf16*)(F.ws + WS_LIN);
    LAS unsigned char* T = F.lds;
    const int w = F.wave, lane = F.lane;
    for (int pid = F.vcu; pid < NB * 64; pid += F.G) {
        const int b = pid >> 6, py = (pid >> 3) & 7, px = pid & 7; const int m00 = b * TSEQ + (py * 8) * 64 + px * 8;
        int srow[12];
#pragma unroll
        for (int i = 0; i < 12; ++i) { const int sl = w * 12 + i; int gyl, gxl; bool ok = true;
            if (sl < 64) { gyl = sl >> 3; gxl = sl & 7; } else if (sl < 72) { gyl = -1; gxl = sl - 64; ok = py > 0; } else if (sl < 80) { gyl = 8; gxl = sl - 72; ok = py < 7; }
            else if (sl < 88) { gyl = sl - 80; gxl = -1; ok = px > 0; } else { gyl = sl - 88; gxl = 8; ok = px < 7; }
            srow[i] = ok ? m00 + gyl * 64 + gxl : m00; }
        v4u pre[12];
        { const int cl = lane * 8;
#pragma unroll
          for (int i = 0; i < 12; ++i) pre[i] = *(const v4u*)(SLAB + (size_t)srow[i] * SLABLD + cl); }
        for (int sl_ = 0; sl_ < P3_NSLICE; ++sl_) {
            const int c0 = sl_ * P3_SLICE + lane * 8; const bool cok = c0 < DSH;
            __syncthreads();
#pragma unroll
            for (int i = 0; i < 12; ++i) *(LAS v4u*)(T + (w * 12 + i) * 1024 + lane * 16) = pre[i];
            if (sl_ + 1 < P3_NSLICE) { const int cn = (sl_ + 1) * P3_SLICE + lane * 8; const int cl = cn < DSH ? cn : 0;
#pragma unroll
                for (int i = 0; i < 12; ++i) pre[i] = *(const v4u*)(SLAB + (size_t)srow[i] * SLABLD + cl); }
            __syncthreads();
            const f32x4 m0 = *(const f32x4*)(mu + (cok ? c0 : 0)), m1 = *(const f32x4*)(mu + (cok ? c0 : 0) + 4);
            const int gy = py * 8 + w; const unsigned k2m = gy > 0 ? 0xffffu : 0u, k3m = gy < 63 ? 0xffff0000u : 0u;
#pragma unroll
            for (int x = 0; x < 8; ++x) {
                const int gx = px * 8 + x; const unsigned k0m = gx > 0 ? 0xffffu : 0u, k1m = gx < 63 ? 0xffff0000u : 0u;
                const int so = w * 8 + x, sL = x > 0 ? so - 1 : 80 + w, sR = x < 7 ? so + 1 : 88 + w, sU = w > 0 ? so - 8 : 64 + x, sD = w < 7 ? so + 8 : 72 + x;
                const v4u o = *(const LAS v4u*)(T + so * 1024 + lane * 16), n0 = *(const LAS v4u*)(T + sL * 1024 + lane * 16), n1 = *(const LAS v4u*)(T + sR * 1024 + lane * 16),
                          n2 = *(const LAS v4u*)(T + sU * 1024 + lane * 16), n3 = *(const LAS v4u*)(T + sD * 1024 + lane * 16);
                v4u nb; nb.x = (n0.x & k0m) | (n1.x & k1m); nb.y = (n2.y & k2m) | (n3.y & k3m); nb.z = (n0.z & k0m) | (n1.z & k1m); nb.w = (n2.w & k2m) | (n3.w & k3m);
                const int mrow = m00 + w * 64 + x;
                if (cok) p3_mix_store(o, nb, m0, m1, c0, mrow, RM, KM, VM, LIN);
                if (sl_ == P3_NSLICE - 1 && lane >= 48) { const int l16 = lane - 48, p = l16 >> 2, off = (l16 & 3) * 8; *(v4u*)(LIN + (size_t)mrow * LINLD + 128 * p + 96 + off) = (v4u){0u, 0u, 0u, 0u}; }
            }
        }
        __syncthreads();
    }
    const int gw = F.vcu * 8 + F.wave, NGW = F.G * 8;
    for (int mrow = NT + gw; mrow < MT; mrow += NGW) {
        const bf16* own = SLAB + (size_t)mrow * SLABLD; const int sidx = (mrow - NT) & 255; const bool v0 = sidx > 0, v1 = sidx < 255;
        const bf16* p0 = v0 ? own - SLABLD : own; const bf16* p1 = v1 ? own + SLABLD : own;
        const unsigned k0m = v0 ? 0xffffu : 0u, k1m = v1 ? 0xffff0000u : 0u;
        for (int ci0 = F.lane; ci0 < DSH / 8; ci0 += 256) {
            v4u o[4], nb[4]; f32x4 m0[4], m1[4];
#pragma unroll
            for (int u = 0; u < 4; ++u) { const int ci = ci0 + 64 * u; const int c0 = (ci < DSH / 8 ? ci : F.lane) * 8;
                o[u] = *(const v4u*)(own + c0); const v4u n0 = *(const v4u*)(p0 + c0), n1 = *(const v4u*)(p1 + c0);
                nb[u].x = (n0.x & k0m) | (n1.x & k1m); nb[u].y = (n0.y & k0m) | (n1.y & k1m); nb[u].z = (n0.z & k0m) | (n1.z & k1m); nb[u].w = (n0.w & k0m) | (n1.w & k1m);
                m0[u] = *(const f32x4*)(mu + c0); m1[u] = *(const f32x4*)(mu + c0 + 4); }
#pragma unroll
            for (int u = 0; u < 4; ++u) { const int ci = ci0 + 64 * u; if (ci < DSH / 8) p3_mix_store(o[u], nb[u], m0[u], m1[u], ci * 8, mrow, RM, KM, VM, LIN); }
        }
        if (F.lane < 16) { const int p = F.lane >> 2, off = (F.lane & 3) * 8; *(v4u*)(LIN + (size_t)mrow * LINLD + 128 * p + 96 + off) = (v4u){0u, 0u, 0u, 0u}; }
    }
    const unsigned* U32 = (const unsigned*)(F.ws + WS_U); unsigned* DP32 = (unsigned*)(F.ws + WS_DP);
    for (int gr = F.vcu; gr < 256; gr += F.G) {
        const int m0 = gr * 64, cp = F.tid; const int g = F.wave >> 1;
        if (g == 0) pool_item<2>(U32, DP32, m0, cp); else if (g == 1) pool_item<4>(U32, DP32, m0, cp); else if (g == 2) pool_item<8>(U32, DP32, m0, cp); else pool_item<16>(U32, DP32, m0, cp);
    }
}

constexpr int CK = 16, NSL = 8;
constexpr int SL_Z = 0, SL_AF = 2560, SL_TMT = 3584, SL_ABF = 4096, SL_TM = 4608, SL_ZTT = 5120, SL_RT = 7680, SL_CRT = 9728, SL_ART = 10240, SL_BGT = 10752, SL_KGT = 12800, SL_VT = 14848, SL_GC = 16896,
              SL_SIZE = 17152, ZTT_LD = 80, SB_OFF = 7 * SL_SIZE  , SL7_OFF = 132096  ;
static_assert(SB_OFF + 8192 <= 131072 && SL7_OFF + SL_SIZE <= 163840, "scan LDS map");
__device__ __forceinline__ int kpos(int zt, int q) { return 32 * (zt >> 1) + 8 * q + 4 * (zt & 1); }
__device__ __forceinline__ int slot_off(int n) { return n < 7 ? n * SL_SIZE : SL7_OFF; }
__device__ __forceinline__ int sw64(int row, int col) { return (row * 64 + ((((col >> 3) ^ (row & 7)) << 3) | (col & 7))) * 2; }
__device__ __forceinline__ int scan_row(int n, int b, int dir) {
    if (n < CTXL) return NT + b * CTXL + (dir ? (CTXL - 1 - n) : n);
    const int t = n - CTXL; return b * TSEQ + (dir ? (TSEQ - 1 - t) : t);
}
__device__ __forceinline__ bf16x8 frag_ld(const LAS unsigned char* p, bool ok) { v4u z = (v4u){0u, 0u, 0u, 0u}; if (ok) z = *(const LAS v4u*)p; return __builtin_bit_cast(bf16x8, z); }
__device__ __forceinline__ f32x4 mfma16(bf16x8 a, bf16x8 b, f32x4 c) { return __builtin_amdgcn_mfma_f32_16x16x32_bf16(a, b, c, 0, 0, 0); }
__device__ __forceinline__ float dpp_shr(float v, const int n, float fill) {
    const int x = __builtin_bit_cast(int, v), f = __builtin_bit_cast(int, fill); int r;
    if (n == 1) r = __builtin_amdgcn_update_dpp(f, x, 0x111, 0xF, 0xF, false); else if (n == 2) r = __builtin_amdgcn_update_dpp(f, x, 0x112, 0xF, 0xF, false);
    else if (n == 4) r = __builtin_amdgcn_update_dpp(f, x, 0x114, 0xF, 0xF, false); else r = __builtin_amdgcn_update_dpp(f, x, 0x118, 0xF, 0xF, false);
    return __builtin_bit_cast(float, r);
}
struct SeqOps { bf16x8 fV, fZc, fZk[2], fR[2], fCr, fAr4, fKG[4], fBG4[4]; f32x4 gc[4]; };
__device__ __forceinline__ bf16x8 frag4_ld(const LAS unsigned char* p) { const v2u t = *(const LAS v2u*)p; v4u z; z.x = t.x; z.y = t.y; z.z = 0u; z.w = 0u; return __builtin_bit_cast(bf16x8, z); }
__device__ __forceinline__ void seq_load(SeqOps& o, const LAS unsigned char* SL, int w, int c, int q, bool klo) {
    o.fV = frag_ld(SL + SL_VT + ((16 * w + c) * 16 + 8 * q) * 2, klo);
    o.fZc = frag_ld(SL + SL_ZTT + (c * ZTT_LD + 64 + 8 * q) * 2, klo); o.fCr = frag_ld(SL + SL_CRT + (c * 16 + 8 * q) * 2, klo); o.fAr4 = frag4_ld(SL + SL_ART + (c * 16 + 4 * q) * 2);
#pragma unroll
    for (int ks = 0; ks < 2; ++ks) { o.fZk[ks] = frag_ld(SL + SL_ZTT + (c * ZTT_LD + 32 * ks + 8 * q) * 2, true); o.fR[ks] = frag_ld(SL + SL_RT + sw64(c, 32 * ks + 8 * q), true); }
#pragma unroll
    for (int jt = 0; jt < 4; ++jt) { o.fKG[jt] = frag_ld(SL + SL_KGT + ((16 * jt + c) * 16 + 8 * q) * 2, klo); o.fBG4[jt] = frag4_ld(SL + SL_BGT + ((16 * jt + c) * 16 + 4 * q) * 2);
        o.gc[jt] = *(const LAS f32x4*)(SL + SL_GC + (16 * jt + 4 * q) * 4); }
}
__device__ __forceinline__ void seq_step(const SeqOps& o, f32x4 (&X)[4], bool emit, bf16* YO, int chunk, int b, int dir, int h, int w, int c, int q) {
    const f32x4 z4 = (f32x4){0.f, 0.f, 0.f, 0.f};
    bf16x8 fS[2];
#pragma unroll
    for (int ks = 0; ks < 2; ++ks) { v4u p; p.x = pk2(X[2 * ks][0], X[2 * ks][1]); p.y = pk2(X[2 * ks][2], X[2 * ks][3]); p.z = pk2(X[2 * ks + 1][0], X[2 * ks + 1][1]); p.w = pk2(X[2 * ks + 1][2], X[2 * ks + 1][3]);
        fS[ks] = __builtin_bit_cast(bf16x8, p); }
    f32x4 un = mfma16(o.fZc, o.fV, z4);
#pragma unroll
    for (int ks = 0; ks < 2; ++ks) un = mfma16(o.fZk[ks], fS[ks], un);
    bf16x8 fU; { v4u p; p.x = pk2(un[0], un[1]); p.y = pk2(un[2], un[3]); p.z = 0u; p.w = 0u; fU = __builtin_bit_cast(bf16x8, p); }
    if (emit) {
        f32x4 y = mfma16(o.fCr, o.fV, z4); y = mfma16(o.fAr4, fU, y);
#pragma unroll
        for (int ks = 0; ks < 2; ++ks) y = mfma16(o.fR[ks], fS[ks], y);
#pragma unroll
        for (int g = 0; g < 4; ++g) YO[(size_t)scan_row(chunk * CK + 4 * q + g, b, dir) * D + h * 64 + 16 * w + c] = (bf16)f2bf(y[g]);
    }
#pragma unroll
    for (int jt = 0; jt < 4; ++jt) { const f32x4 d = mfma16(o.fBG4[jt], fU, mfma16(o.fKG[jt], o.fV, z4));
        X[jt] = X[jt] * o.gc[jt] + d; }
}
struct ScanRaw { v4u r[2], k[2], v[2], e[2]; v2u a[2]; };
__device__ __forceinline__ void scan_fetch(ScanRaw& R, const bf16* RM, const bf16* KM, const bf16* VM, const unsigned char* AX, const unsigned short* EX, size_t rowoff) {
#pragma unroll
    for (int ks = 0; ks < 2; ++ks) { const size_t off = rowoff + 32 * ks; R.r[ks] = *(const v4u*)(RM + off); R.k[ks] = *(const v4u*)(KM + off); R.v[ks] = *(const v4u*)(VM + off); R.a[ks] = *(const v2u*)(AX + off); R.e[ks] = *(const v4u*)(EX + off); }
}
__device__ __forceinline__ void p6_scan(Frame& F, const Args& a) {
    const bf16* RM = (const bf16*)(F.ws + WS_RM); const bf16* KM = (const bf16*)(F.ws + WS_KM); const bf16* VM = (const bf16*)(F.ws + WS_VM);
    const int lane = F.lane, w = F.wave, c0_ = lane & 15, q0_ = lane >> 4;
    for (int unit = blockIdx.x; unit < NB * NH * 2; unit += F.G) {
        const int dir = unit & 1, h = (unit >> 1) & 31, b = unit >> 6;
        const unsigned short* EX = (const unsigned short*)(F.ws + WS_EA + (size_t)dir * EA_STRIDE);
        const unsigned char* AX = (const unsigned char*)(F.ws + WS_EA + (size_t)(2 + dir) * EA_STRIDE);
        bf16* YO = (bf16*)(F.ws + (dir ? WS_YB : WS_YF)); float* BON = (float*)(F.ws + WS_BON) + (size_t)dir * NT * NH;
        f32x4 X[4];
#pragma unroll
        for (int jt = 0; jt < 4; ++jt) X[jt] = (f32x4){0.f, 0.f, 0.f, 0.f};
        constexpr int NBATCH = (CTXL + TSEQ) / CK / NSL;
        { LAS float* cst = (LAS float*)(F.lds + SB_OFF);
          if (F.tid < 192) { const int which = F.tid >> 6, j = F.tid & 63; cst[F.tid] = (which == 0 ? a.in[I_KK] : which == 1 ? a.in[I_KA] : a.in[I_RK])[h * 64 + j]; } }
        ScanRaw R; scan_fetch(R, RM, KM, VM, AX, EX, (size_t)scan_row(w * CK + c0_, b, dir) * D + h * 64 + 8 * q0_);
        __syncthreads();
        for (int bt = 0; bt < NBATCH; ++bt) {
            int c = c0_, q = q0_; asm volatile("" : "+v"(c), "+v"(q));
            const bool klo = q < 2;
            {
                LAS unsigned char* SL = F.lds + slot_off(w);
                int cq8 = 8 * q; asm volatile("" : "+v"(cq8));
                const LAS float* cst = (const LAS float*)(F.lds + SB_OFF) + cq8;
                float ss = 0.f;
#pragma unroll
                for (int ks = 0; ks < 2; ++ks) {
                    const f32x4 k0 = *(const LAS f32x4*)(cst + 32 * ks), k1 = *(const LAS f32x4*)(cst + 32 * ks + 4);
                    const float kv[8] = {bflo(R.k[ks].x), bfhi(R.k[ks].x), bflo(R.k[ks].y), bfhi(R.k[ks].y), bflo(R.k[ks].z), bfhi(R.k[ks].z), bflo(R.k[ks].w), bfhi(R.k[ks].w)};
#pragma unroll
                    for (int e = 0; e < 4; ++e) { const float p0 = kv[e] * k0[e], p1 = kv[4 + e] * k1[e]; ss += p0 * p0 + p1 * p1; } }
                ss += __shfl_xor(ss, 16); ss += __shfl_xor(ss, 32);
                const float inv = __builtin_amdgcn_rsqf(ss + 1e-12f);
                bf16x8 fKT[2], fRT[2], fBT[2], fKQ[2]; float bonp = 0.f;
#pragma unroll
                for (int ks = 0; ks < 2; ++ks) {
                    const v4u xr = R.r[ks], xk = R.k[ks], xv = R.v[ks], xe = R.e[ks]; const v2u xa = R.a[ks];
                    const f32x4 k0 = *(const LAS f32x4*)(cst + 32 * ks), k1 = *(const LAS f32x4*)(cst + 32 * ks + 4), a0 = *(const LAS f32x4*)(cst + 64 + 32 * ks), a1 = *(const LAS f32x4*)(cst + 64 + 32 * ks + 4);
                    const float kkw[8] = {k0[0], k0[1], k0[2], k0[3], k1[0], k1[1], k1[2], k1[3]}, kaw[8] = {a0[0], a0[1], a0[2], a0[3], a1[0], a1[1], a1[2], a1[3]};
                    const f32x4 q0 = *(const LAS f32x4*)(cst + 128 + 32 * ks), q1 = *(const LAS f32x4*)(cst + 128 + 32 * ks + 4); const float rkw[8] = {q0[0], q0[1], q0[2], q0[3], q1[0], q1[1], q1[2], q1[3]};
                    const float r[8] = {bflo(xr.x), bfhi(xr.x), bflo(xr.y), bfhi(xr.y), bflo(xr.z), bfhi(xr.z), bflo(xr.w), bfhi(xr.w)};
                    const float k[8] = {bflo(xk.x), bfhi(xk.x), bflo(xk.y), bfhi(xk.y), bflo(xk.z), bfhi(xk.z), bflo(xk.w), bfhi(xk.w)};
                    const float v[8] = {bflo(xv.x), bfhi(xv.x), bflo(xv.y), bfhi(xv.y), bflo(xv.z), bfhi(xv.z), bflo(xv.w), bfhi(xv.w)};
                    const float ku8 = 1.0f / 255.0f;
                    const float ai[8] = {(float)(xa.x & 0xffu) * ku8, (float)((xa.x >> 8) & 0xffu) * ku8, (float)((xa.x >> 16) & 0xffu) * ku8, (float)(xa.x >> 24) * ku8,
                                         (float)(xa.y & 0xffu) * ku8, (float)((xa.y >> 8) & 0xffu) * ku8, (float)((xa.y >> 16) & 0xffu) * ku8, (float)(xa.y >> 24) * ku8};
                    const float lw[8] = {hlo(xe.x), hhi(xe.x), hlo(xe.y), hhi(xe.y), hlo(xe.z), hhi(xe.z), hlo(xe.w), hhi(xe.w)};
                    float kt[8], rt[8], btl[8], kq[8], cl[8], G[8], Gi[8], Gm[8], GCv[8];
#pragma unroll
                    for (int e = 0; e < 8; ++e) cl[e] = lw[e];
#pragma unroll
                    for (int e = 0; e < 8; ++e) cl[e] += dpp_shr(cl[e], 1, 0.f);
#pragma unroll
                    for (int e = 0; e < 8; ++e) cl[e] += dpp_shr(cl[e], 2, 0.f);
#pragma unroll
                    for (int e = 0; e < 8; ++e) cl[e] += dpp_shr(cl[e], 4, 0.f);
#pragma unroll
                    for (int e = 0; e < 8; ++e) cl[e] += dpp_shr(cl[e], 8, 0.f);
#pragma unroll
                    for (int e = 0; e < 8; ++e) { G[e] = __builtin_amdgcn_exp2f(cl[e]); Gi[e] = __builtin_amdgcn_exp2f(-cl[e]); }
#pragma unroll
                    for (int e = 0; e < 8; ++e) { Gm[e] = dpp_shr(G[e], 1, 1.0f); GCv[e] = __shfl(G[e], (lane & 48) | 15); }
#pragma unroll
                    for (int e = 0; e < 8; ++e) {
                        const float kke = k[e] * kkw[e] * inv, kd = k[e] * ((ai[e] - 1.0f) * kaw[e] + 1.0f), bb = kke * ai[e], ratio = GCv[e] * Gi[e];
                        kt[e] = Gm[e] * kke; rt[e] = G[e] * r[e]; btl[e] = bb * Gi[e]; kq[e] = kd * Gi[e];
                        bonp += r[e] * kd * rkw[e];
                        const int j = 32 * ks + 8 * q + e;
                        const unsigned w0 = pk2(kt[e], bb * ratio), w1 = pk2(kd * ratio, v[e]);
                        ((LAS bf16*)(SL + SL_Z))[j * 16 + c] = (bf16)(w0 & 0xffffu); ((LAS bf16*)(SL + SL_BGT))[j * 16 + c] = (bf16)(w0 >> 16);
                        ((LAS bf16*)(SL + SL_KGT))[j * 16 + c] = (bf16)(w1 & 0xffffu); ((LAS bf16*)(SL + SL_VT))[j * 16 + c] = (bf16)(w1 >> 16);
                    }
                    if (c == 15) { *(LAS f32x4*)(SL + SL_GC + (32 * ks + 8 * q) * 4) = (f32x4){G[0], G[1], G[2], G[3]}; *(LAS f32x4*)(SL + SL_GC + (32 * ks + 8 * q + 4) * 4) = (f32x4){G[4], G[5], G[6], G[7]}; }
                    v4u p; p.x = pk2(kt[0], kt[1]); p.y = pk2(kt[2], kt[3]); p.z = pk2(kt[4], kt[5]); p.w = pk2(kt[6], kt[7]); fKT[ks] = __builtin_bit_cast(bf16x8, p);
                    p.x = pk2(rt[0], rt[1]); p.y = pk2(rt[2], rt[3]); p.z = pk2(rt[4], rt[5]); p.w = pk2(rt[6], rt[7]); fRT[ks] = __builtin_bit_cast(bf16x8, p);
                    { v2u p0; p0.x = p.x; p0.y = p.y; v2u p1; p1.x = p.z; p1.y = p.w; const int pp = 32 * ks + 16 * (q & 1) + 4 * (q >> 1);
                      *(LAS v2u*)(SL + SL_RT + sw64(c, pp)) = p0; *(LAS v2u*)(SL + SL_RT + sw64(c, pp + 8)) = p1; }
                    p.x = pk2(btl[0], btl[1]); p.y = pk2(btl[2], btl[3]); p.z = pk2(btl[4], btl[5]); p.w = pk2(btl[6], btl[7]); fBT[ks] = __builtin_bit_cast(bf16x8, p);
                    p.x = pk2(kq[0], kq[1]); p.y = pk2(kq[2], kq[3]); p.z = pk2(kq[4], kq[5]); p.w = pk2(kq[6], kq[7]); fKQ[ks] = __builtin_bit_cast(bf16x8, p);
                    asm volatile("" ::: "memory");
                }
                bonp += __shfl_xor(bonp, 16); bonp += __shfl_xor(bonp, 32);
                if (q == 0 && (NSL * bt + w) * CK >= CTXL) BON[(size_t)scan_row((NSL * bt + w) * CK + c, b, dir) * NH + h] = bonp;
                const f32x4 z4 = (f32x4){0.f, 0.f, 0.f, 0.f};
                f32x4 accA = mfma16(fBT[1], fKT[1], mfma16(fBT[0], fKT[0], z4)), accAr = mfma16(fBT[1], fRT[1], mfma16(fBT[0], fRT[0], z4));
                f32x4 accCm = mfma16(fKQ[1], fKT[1], mfma16(fKQ[0], fKT[0], z4)), accCr = mfma16(fKQ[1], fRT[1], mfma16(fKQ[0], fRT[0], z4));
#pragma unroll
                for (int g = 0; g < 4; ++g) { const int srow = 4 * q + g; const bool lt = srow < c, le = srow <= c;
                    accA[g] = lt ? accA[g] : 0.f; accAr[g] = le ? accAr[g] : 0.f; accCm[g] = lt ? accCm[g] : 0.f; accCr[g] = le ? accCr[g] : 0.f;
                    ((LAS float*)(SL + SL_AF))[srow * 16 + c] = accA[g]; ((LAS bf16*)(SL + SL_ABF))[srow * 16 + c] = (bf16)f2bf(accA[g]); ((LAS bf16*)(SL + SL_Z))[(64 + srow) * 16 + c] = (bf16)f2bf(accCm[g]); }
                { v2u p; p.x = pk2(accAr[0], accAr[1]); p.y = pk2(accAr[2], accAr[3]); *(LAS v2u*)(SL + SL_ART + (c * 16 + 4 * q) * 2) = p; }
                { v2u p; p.x = pk2(accCr[0], accCr[1]); p.y = pk2(accCr[2], accCr[3]); *(LAS v2u*)(SL + SL_CRT + (c * 16 + 4 * q) * 2) = p; }
                LDS_WAIT(); asm volatile("" ::: "memory");
                {
                    const int base = c & 8, cl = c & 7; float x[8];
#pragma unroll
                    for (int sr = 7; sr >= 0; --sr) { float acc = 0.f;
#pragma unroll
                        for (int m = sr + 1; m < 8; ++m) acc += ((const LAS float*)(SL + SL_AF))[(base + sr) * 16 + base + m] * x[m];
                        x[sr] = (sr < cl) ? -acc : ((sr == cl) ? -1.0f : 0.f); }
                    if (q == 0) { v4u px; px.x = pk2(x[0], x[1]); px.y = pk2(x[2], x[3]); px.z = pk2(x[4], x[5]); px.w = pk2(x[6], x[7]);
                        *(LAS v4u*)(SL + SL_TMT + (c * 16 + base) * 2) = px; *(LAS v4u*)(SL + SL_TMT + (c * 16 + (base ^ 8)) * 2) = (v4u){0u, 0u, 0u, 0u};
#pragma unroll
                        for (int sr = 0; sr < 8; ++sr) { ((LAS bf16*)(SL + SL_TM))[(base + sr) * 16 + c] = (bf16)f2bf(x[sr]); ((LAS bf16*)(SL + SL_TM))[((base ^ 8) + sr) * 16 + c] = (bf16)0; } }
                    LDS_WAIT(); asm volatile("" ::: "memory");
                    const bf16x8 fAb = frag_ld(SL + SL_ABF + (c * 16 + 8 * q) * 2, klo), fTd = frag_ld(SL + SL_TMT + (c * 16 + 8 * q) * 2, klo);
                    const f32x4 d1 = mfma16(fAb, fTd, z4);
                    bf16x8 fD1; { v4u p; p.x = pk2(d1[0], d1[1]); p.y = pk2(d1[2], d1[3]); p.z = 0u; p.w = 0u; fD1 = __builtin_bit_cast(bf16x8, p); }
                    const f32x4 d2 = mfma16(fD1, frag4_ld(SL + SL_TM + (c * 16 + 4 * q) * 2), z4);
                    if (c < 8 && q >= 2) {
#pragma unroll
                        for (int g = 0; g < 4; ++g) ((LAS bf16*)(SL + SL_TMT))[(4 * q + g) * 16 + c] = (bf16)f2bf(d2[g]); }
                }
                LDS_WAIT(); asm volatile("" ::: "memory");
                {
                    const bf16x8 fT = frag_ld(SL + SL_TMT + (c * 16 + 8 * q) * 2, klo);
#pragma unroll
                    for (int zt = 0; zt < 5; ++zt) { const bf16x8 fZ = frag_ld(SL + SL_Z + ((16 * zt + c) * 16 + 8 * q) * 2, klo); const f32x4 d = mfma16(fZ, fT, z4);
                        v2u p; p.x = pk2(d[0], d[1]); p.y = pk2(d[2], d[3]); *(LAS v2u*)(SL + SL_ZTT + (c * ZTT_LD + (zt < 4 ? kpos(zt, q) : 64 + 4 * q)) * 2) = p; }
                }
            }
            if (bt + 1 < NBATCH) scan_fetch(R, RM, KM, VM, AX, EX, (size_t)scan_row((NSL * (bt + 1) + w) * CK + c, b, dir) * D + h * 64 + 8 * q);
            __syncthreads();
            asm volatile("" : "+v"(c), "+v"(q));
            if (w < 4) {
                const bool emit = (NSL * bt) * CK >= CTXL;
#pragma unroll 1
                for (int n = 0; n < NSL; ++n) { SeqOps A; seq_load(A, F.lds + slot_off(n), w, c, q, klo); seq_step(A, X, emit, YO, NSL * bt + n, b, dir, h, w, c, q); }
            }
            __syncthreads();
        }
    }
}

__device__ __forceinline__ void p7_readout(Frame& F, const Args& a) {
    const bf16* VM = (const bf16*)(F.ws + WS_VM); const float* BONF = (const float*)(F.ws + WS_BON); const float* BONB = BONF + (size_t)NT * NH;
    const bf16* YF = (const bf16*)(F.ws + WS_YF); const bf16* YB = (const bf16*)(F.ws + WS_YB); bf16* Z = (bf16*)(F.ws + WS_Z);
    const int sub = F.tid & 15; const int ngrp = F.G * 32;
    for (int gid0 = F.vcu * 32 + (F.tid >> 4); gid0 < NT * NH; gid0 += 4 * ngrp) {
        v2u ayf[4], ayb[4], alv[4]; float abf[4], abb[4]; f32x4 alw[4], alb[4];
#pragma unroll
        for (int u = 0; u < 4; ++u) { const int gid = gid0 + u * ngrp; const int mrow = gid >> 5, h = gid & 31, c = h * 64 + 4 * sub; const size_t off = (size_t)mrow * D + c;
            ayf[u] = *(const v2u*)(YF + off); ayb[u] = *(const v2u*)(YB + off); alv[u] = *(const v2u*)(VM + off); abf[u] = BONF[gid]; abb[u] = BONB[gid]; alw[u] = *(const f32x4*)(a.in[I_LNW] + c); alb[u] = *(const f32x4*)(a.in[I_LNB] + c); }
#pragma unroll
        for (int u = 0; u < 4; ++u) { const int gid = gid0 + u * ngrp;
        const int mrow = gid >> 5, h = gid & 31, c = h * 64 + 4 * sub; const size_t off = (size_t)mrow * D + c;
        const v2u yf = ayf[u], yb = ayb[u], lv = alv[u];
        const f32x4 y = (f32x4){bflo(yf.x) + bflo(yb.x), bfhi(yf.x) + bfhi(yb.x), bflo(yf.y) + bflo(yb.y), bfhi(yf.y) + bfhi(yb.y)};
        const float mean = allred16((y.x + y.y) + (y.z + y.w)) * (1.0f / 64.0f); const f32x4 d = y - mean;
        const float var = allred16((d.x * d.x + d.y * d.y) + (d.z * d.z + d.w * d.w)) * (1.0f / 64.0f);
        const f32x4 yn = d * __builtin_amdgcn_rsqf(var + 64e-5f) * alw[u] + alb[u];
        const f32x4 v = (f32x4){bflo(lv.x), bfhi(lv.x), bflo(lv.y), bfhi(lv.y)};
        const f32x4 z = yn + v * (abf[u] + abb[u]); v2u wv; wv.x = pk2(z.x, z.y); wv.y = pk2(z.z, z.w); *(v2u*)(Z + off) = wv;
        }
    }
}
constexpr float GU_F8SCALE = 8.0f, H2_F8SCALE = 8.0f, DT_F8SCALE = 8.0f;
constexpr int CONV_ITEMS = 65 * 384, CONV_DT = 65 * 128, CONV_FREE = CONV_DT + (65 - GU_E2) * 256;
struct DecExp { const float* const* in; unsigned char* ws;
    __device__ __forceinline__ bool operator()(int it, TrJob& j) const {
        if (it < 0 || it >= CONV_ITEMS) return false;
        if (it < CONV_DT) { const int e = it >> 7, r = it & 127; const float* src = (e < 64) ? in[I_ED] + (size_t)e * DEXP * D : in[I_SD];
            const int kb = r >> 5, nb = r & 31; j = TrJob{src, (bf16*)(ws + WS_DT + (size_t)e * D * DEXP), D, DEXP, DEXP, kb * 128, nb * 64, nb * 64, DT_F8SCALE}; }
        else { const int g = it - CONV_DT, eg = g >> 8, q = g & 255, which = q >> 7, r = q & 127, e = eg < 65 - GU_E2 ? GU_E2 + eg : eg - (65 - GU_E2);
            const float* src = (e < 64) ? (which == 0 ? in[I_EG] : in[I_EU]) + (size_t)e * D * DEXP : (which == 0 ? in[I_SG] : in[I_SU]);
            const int kb = r >> 3, nb = r & 7, n0 = nb * 64;
            j = TrJob{src, (bf16*)(ws + gu_base(e)), DEXP, D, D, kb * 128, n0, (n0 >> 7) * 256 + which * 128 + (n0 & 127), GU_F8SCALE}; }
        return true; } };
__device__ __forceinline__ void conv_steal(Frame& F, const Args& a, const unsigned stopn) {
    DecExp dec{a.in, F.ws};
    unsigned* cnt = F.ctl + CW_CONV; unsigned* dnp = F.ctl + CW_P2DONE;
    LAS unsigned* P = (LAS unsigned*)(F.lds + F.wave * 16384);
    const int lane = F.lane;
    unsigned nxt = 0u, dnow = 0u;
    if (lane == 0) nxt = xb_add(cnt, 1u);
    nxt = __builtin_amdgcn_readfirstlane(nxt);
#pragma unroll 1
    for (;;) {
        const unsigned cur = nxt;
        if (cur >= (unsigned)CONV_FREE) break;
        unsigned n2 = (unsigned)CONV_FREE, d2 = dnow;
        if (dnow < stopn) { if (lane == 0) { n2 = xb_add(cnt, 1u); d2 = xb_ld(dnp); } }
        asm volatile("" ::: "memory");
        TrJob ja; f32x4 va[16];
        dec((int)cur, ja);
        tr8_load<true>(ja, 0, va, lane); tr8_lds(ja, 0, va, P, lane);
        tr8_load<true>(ja, 1, va, lane); tr8_lds(ja, 1, va, P, lane);
        tr8_flush<true>(ja, P, lane);
        nxt = __builtin_amdgcn_readfirstlane(n2); dnow = __builtin_amdgcn_readfirstlane(d2);
    }
}
constexpr int RT_LD = 68;
__device__ __forceinline__ void p11_route(Frame& F, const Args& a) {
    for (int repa_ = 0, nrepa_ = opaque_n(1 + ((DUPMASK >> 16) & 1)); repa_ < nrepa_; ++repa_) {
        unsigned nd = xb_ld(F.ctl + CW_CONV); nd = __builtin_amdgcn_readfirstlane(nd < (unsigned)CONV_FREE ? nd : (unsigned)CONV_FREE);
        DecExp dec{a.in, F.ws};
        tr_run8(dec, (int)nd + F.vcu * 8 + F.wave, F.G * 8, (LAS unsigned*)(F.lds + F.wave * 16384), F.lane);
        __syncthreads();
    }
    const bf16* X1 = (const bf16*)(F.ws + WS_X1); const float* MOD = (const float*)(F.ws + WS_MOD); unsigned char* H2 = F.ws + WS_H2;
    LAS float* hs = (LAS float*)F.lds;
    LAS float* wsb = hs + 64 * RT_LD;
    LAS float* lg = wsb + 64 * RT_LD;
    LAS float* lg2 = lg + 64 * 65;
    LAS float* selb = lg2 + 64 * 65;
    LAS float* rs = selb + 64 * 65;
    LAS int* cnt = (LAS int*)(rs + 64);
    LAS int* basee = cnt + 64;
    LAS int* eloc = basee + 64;
    LAS int* rloc = eloc + 512;
    for (int tile = F.vcu; tile < NT / 64; tile += F.G) {
        const int t0 = tile * 64, b = t0 >> 12;
        const float* sh2 = MOD + (size_t)b * 12288 + 6144; const float* sc2 = MOD + (size_t)b * 12288 + 8192; const float* g2 = a.in[I_N2G];
        if (F.tid < 64) cnt[F.tid] = 0;
        for (int rr = 0; rr < 8; ++rr) { const int tl = F.wave * 8 + rr; const v2u* xr = (const v2u*)(X1 + (size_t)(t0 + tl) * D) + F.lane; f32x4 v[8]; float s = 0.f;
#pragma unroll
            for (int q = 0; q < 8; ++q) { const v2u xw = xr[64 * q]; v[q] = (f32x4){bflo(xw.x), bfhi(xw.x), bflo(xw.y), bfhi(xw.y)}; s += (v[q].x * v[q].x + v[q].y * v[q].y) + (v[q].z * v[q].z + v[q].w * v[q].w); }
            const float rstd = 1.0f / sqrtf(wave_sum(s) * (1.0f / D) + 1e-6f); if (F.lane == 0) rs[tl] = rstd;
            unsigned* o = (unsigned*)(H2 + (size_t)(t0 + tl) * D) + F.lane;
#pragma unroll
            for (int q = 0; q < 8; ++q) { const f32x4 y = v[q] * rstd * ((const f32x4*)g2)[F.lane + 64 * q] * (((const f32x4*)sc2)[F.lane + 64 * q] + 1.0f) + ((const f32x4*)sh2)[F.lane + 64 * q];
                o[64 * q] = pk8(H2_F8SCALE * y.x, H2_F8SCALE * y.y, H2_F8SCALE * y.z, H2_F8SCALE * y.w); } }
        __syncthreads();
        const int tg = F.tid & 15, eg = (F.tid >> 4) & 15, kh = F.tid >> 8;
        float acc[4][4];
#pragma unroll
        for (int i = 0; i < 4; ++i)
#pragma unroll
            for (int j = 0; j < 4; ++j) acc[i][j] = 0.f;
        const int stok = F.tid >> 3, sk8 = (F.tid & 7) * 8; const float rstd_s = rs[stok];
        f32x4 px0, px1, pw0, pw1;
        { const v4u xw = *(const v4u*)(X1 + (size_t)(t0 + stok) * D + sk8); px0 = (f32x4){bflo(xw.x), bfhi(xw.x), bflo(xw.y), bfhi(xw.y)}; px1 = (f32x4){bflo(xw.z), bfhi(xw.z), bflo(xw.w), bfhi(xw.w)}; const float* wp = a.in[I_RW] + F.tid * 8; pw0 = *(const f32x4*)wp; pw1 = *(const f32x4*)(wp + 4); }
        for (int kc = 0; kc < D / 64; ++kc) {
            { const int k0 = kc * 64 + sk8;
              const f32x4 ga = *(const f32x4*)(g2 + k0), gb = *(const f32x4*)(g2 + k0 + 4), ca = *(const f32x4*)(sc2 + k0), cb = *(const f32x4*)(sc2 + k0 + 4), ha = *(const f32x4*)(sh2 + k0), hb = *(const f32x4*)(sh2 + k0 + 4);
              const f32x4 y0 = px0 * rstd_s * ga * (ca + 1.0f) + ha, y1 = px1 * rstd_s * gb * (cb + 1.0f) + hb;
              hs[(sk8 + 0) * RT_LD + stok] = y0.x; hs[(sk8 + 1) * RT_LD + stok] = y0.y; hs[(sk8 + 2) * RT_LD + stok] = y0.z; hs[(sk8 + 3) * RT_LD + stok] = y0.w;
              hs[(sk8 + 4) * RT_LD + stok] = y1.x; hs[(sk8 + 5) * RT_LD + stok] = y1.y; hs[(sk8 + 6) * RT_LD + stok] = y1.z; hs[(sk8 + 7) * RT_LD + stok] = y1.w;
              const int wk = F.tid >> 3, we = (F.tid & 7) * 8; *(LAS f32x4*)(wsb + wk * RT_LD + we) = pw0; *(LAS f32x4*)(wsb + wk * RT_LD + we + 4) = pw1; }
            __syncthreads();
            if (kc + 1 < D / 64) { const v4u xw = *(const v4u*)(X1 + (size_t)(t0 + stok) * D + (kc + 1) * 64 + sk8); px0 = (f32x4){bflo(xw.x), bfhi(xw.x), bflo(xw.y), bfhi(xw.y)}; px1 = (f32x4){bflo(xw.z), bfhi(xw.z), bflo(xw.w), bfhi(xw.w)};
                const float* wp = a.in[I_RW] + (size_t)(kc + 1) * 4096 + F.tid * 8; pw0 = *(const f32x4*)wp; pw1 = *(const f32x4*)(wp + 4); }
#pragma unroll 8
            for (int k = kh * 32; k < kh * 32 + 32; ++k) { const f32x4 h4 = *(const LAS f32x4*)(hs + k * RT_LD + 4 * tg), w4 = *(const LAS f32x4*)(wsb + k * RT_LD + 4 * eg);
                acc[0][0] += h4.x * w4.x; acc[0][1] += h4.x * w4.y; acc[0][2] += h4.x * w4.z; acc[0][3] += h4.x * w4.w;
                acc[1][0] += h4.y * w4.x; acc[1][1] += h4.y * w4.y; acc[1][2] += h4.y * w4.z; acc[1][3] += h4.y * w4.w;
                acc[2][0] += h4.z * w4.x; acc[2][1] += h4.z * w4.y; acc[2][2] += h4.z * w4.z; acc[2][3] += h4.z * w4.w;
                acc[3][0] += h4.w * w4.x; acc[3][1] += h4.w * w4.y; acc[3][2] += h4.w * w4.z; acc[3][3] += h4.w * w4.w; }
            __syncthreads();
        }
        { LAS float* dstl = kh ? lg2 : lg;
#pragma unroll
          for (int i = 0; i < 4; ++i)
#pragma unroll
              for (int j = 0; j < 4; ++j) dstl[(4 * tg + i) * 65 + 4 * eg + j] = acc[i][j]; }
        __syncthreads();
        for (int idx = F.tid; idx < 4096; idx += 512) { const int tl = idx >> 6, e = idx & 63; const float sc = sigmoidf_(lg[tl * 65 + e] + lg2[tl * 65 + e]); lg[tl * 65 + e] = sc; selb[tl * 65 + e] = sc + a.in[I_RB][e]; }
        __syncthreads();
        if (F.tid < 64) {
            const int tl = F.tid; LAS float* sel = selb + tl * 65; const LAS float* scr = lg + tl * 65;
            float gs[8];
#pragma unroll
            for (int g = 0; g < 8; ++g) { float m1 = -INFINITY, m2 = -INFINITY;
#pragma unroll
                for (int j = 0; j < 8; ++j) { const float v = sel[g * 8 + j]; if (v > m1) { m2 = m1; m1 = v; } else if (v > m2) m2 = v; }
                gs[g] = m1 + m2; }
            unsigned gmask = 0u;
#pragma unroll
            for (int it = 0; it < 4; ++it) { float best = -INFINITY; int bi = 0;
#pragma unroll
                for (int g = 0; g < 8; ++g) { const bool ok = !((gmask >> g) & 1u) && gs[g] > best; best = ok ? gs[g] : best; bi = ok ? g : bi; }
                gmask |= 1u << bi; }
            for (int g = 0; g < 8; ++g) if (!((gmask >> g) & 1u)) { for (int j = 0; j < 8; ++j) sel[g * 8 + j] = -INFINITY; }
            float wv[8]; int ev[8]; float wsum = 0.f;
#pragma unroll
            for (int it = 0; it < 8; ++it) { float best = -INFINITY; int bi = 0;
                for (int e = 0; e < 64; ++e) { const float v = sel[e]; if (v > best) { best = v; bi = e; } }
                sel[bi] = -INFINITY; ev[it] = bi; wv[it] = scr[bi]; wsum += wv[it]; }
            const float inv = 2.5f / wsum;
#pragma unroll
            for (int it = 0; it < 8; ++it) { const int lr = atomicAdd((int*)&cnt[ev[it]], 1); eloc[tl * 8 + it] = ev[it]; rloc[tl * 8 + it] = lr;
                ((float*)(F.ws + WS_WSEL))[(size_t)(t0 + tl) * 8 + it] = wv[it] * inv; }
        }
        __syncthreads();
        if (F.tid < 64) basee[F.tid] = (int)__hip_atomic_fetch_add(F.ctl + CW_GCNT + F.tid, (unsigned)cnt[F.tid], __ATOMIC_RELAXED, __HIP_MEMORY_SCOPE_AGENT);
        __syncthreads();
        { const int e = eloc[F.tid]; ((int*)(F.ws + WS_EIDX))[(size_t)t0 * 8 + F.tid] = e; ((int*)(F.ws + WS_RANK))[(size_t)t0 * 8 + F.tid] = basee[e] + rloc[F.tid]; }
        __syncthreads();
    }
}
__device__ __forceinline__ int moe_tables(Frame& F) {
    LAS int* te = (LAS int*)(F.lds + TAB_OFF); LAS int* off = te + MAXTILES;
    if (F.tid < 64) off[66 + F.tid] = (int)__hip_atomic_load(F.ctl + CW_GCNT + F.tid, __ATOMIC_RELAXED, __HIP_MEMORY_SCOPE_AGENT);
    __syncthreads();
    if (F.tid == 0) { int o = 0; for (int e = 0; e < 64; ++e) { off[e] = o; o += (off[66 + e] + 255) & ~255; } off[64] = o; off[65] = o / 256 + NT / 256; }
    __syncthreads();
    const int ntiles = off[65];
    for (int rt = F.tid; rt < ntiles; rt += 512) { int e = 0; for (int j = 1; j <= 64; ++j) if (rt * 256 >= off[j]) e = j; te[rt] = e; }
    __syncthreads();
    return ntiles;
}
__device__ __forceinline__ void p12_slots(Frame& F) {
    (void)moe_tables(F);
    const LAS int* off = (const LAS int*)(F.lds + TAB_OFF) + MAXTILES;
    int* tok = (int*)(F.ws + WS_TOK);
    const int* eidx = (const int*)(F.ws + WS_EIDX); int* rank = (int*)(F.ws + WS_RANK);
    const int gt = F.vcu * 512 + F.tid, NGT = F.G * 512;
    for (int i = gt; i < NT * 8; i += NGT) { const int slot = off[eidx[i]] + rank[i]; tok[slot] = i >> 3; rank[i] = slot; }
    const int o64 = off[64];
    for (int t = gt; t < NT; t += NGT) tok[o64 + t] = t;
    if (gt == 0) F.ctl[CW_O64] = (unsigned)o64;
}
__device__ __forceinline__ void p15_final(Frame& F, const Args& a) {
    const int gw = F.vcu * 8 + F.wave, NGW = F.G * 8; const float* MOD = (const float*)(F.ws + WS_MOD); const unsigned char* YP = (const unsigned char*)(F.ws + WS_YP);
    const int* SLOTMAP = (const int*)(F.ws + WS_RANK); const float* WSEL = (const float*)(F.ws + WS_WSEL); const int o64 = (int)F.ctl[CW_O64];
    for (int t = gw; t < NT; t += NGW) {
        const int b = t >> 12; const float* gt2 = MOD + (size_t)b * 12288 + 10240; const float* fg = a.in[I_FG]; float* xr = a.out + (size_t)t * D; const bf16* x1r = (const bf16*)(F.ws + WS_X1) + (size_t)t * D;
        const v4u s0 = *(const v4u*)(SLOTMAP + (size_t)t * 8), s1 = *(const v4u*)(SLOTMAP + (size_t)t * 8 + 4); const f32x4 w0 = *(const f32x4*)(WSEL + (size_t)t * 8), w1 = *(const f32x4*)(WSEL + (size_t)t * 8 + 4);
        const unsigned sl[9] = {s0.x, s0.y, s0.z, s0.w, s1.x, s1.y, s1.z, s1.w, (unsigned)(o64 + t)}; const float wt[9] = {w0.x, w0.y, w0.z, w0.w, w1.x, w1.y, w1.z, w1.w, 1.0f};
        float v[2][16]; float s = 0.f;
#pragma unroll
        for (int jj = 0; jj < 2; ++jj) { const int col = 16 * F.lane + 1024 * jj; float m[16];
#pragma unroll
            for (int e = 0; e < 16; ++e) m[e] = 0.f;
#pragma unroll
            for (int j = 0; j < 9; ++j) { const v4u y = *(const v4u*)(YP + (size_t)sl[j] * D + col); const unsigned yw[4] = {y.x, y.y, y.z, y.w}; const float wj = wt[j];
#pragma unroll
                for (int e = 0; e < 4; ++e) { const f32x2 lo = __builtin_amdgcn_cvt_pk_f32_fp8((int)yw[e], false), hi = __builtin_amdgcn_cvt_pk_f32_fp8((int)yw[e], true);
                    m[4 * e] += wj * lo.x; m[4 * e + 1] += wj * lo.y; m[4 * e + 2] += wj * hi.x; m[4 * e + 3] += wj * hi.y; } }
#pragma unroll
            for (int e4 = 0; e4 < 4; ++e4) { const v2u xw = *(const v2u*)(x1r + col + 4 * e4); const f32x4 x0 = (f32x4){bflo(xw.x), bfhi(xw.x), bflo(xw.y), bfhi(xw.y)}, g0 = *(const f32x4*)(gt2 + col + 4 * e4);
#pragma unroll
                for (int e = 0; e < 4; ++e) { const float val = x0[e] + g0[e] * (m[4 * e4 + e] * (1.0f / YP_SCALE)); v[jj][4 * e4 + e] = val; s += val * val; } } }
        float rstd = __builtin_amdgcn_rsqf(wave_sum(s) * (1.0f / D) + 1e-6f);
#if defined(PROBE_PHASE)
        if (PROBE_PHASE >= 0) rstd *= 1.0f + (float)__hip_atomic_load(F.ctl + 12000, __ATOMIC_RELAXED, __HIP_MEMORY_SCOPE_AGENT) * 2e-6f;
#endif
#pragma unroll
        for (int jj = 0; jj < 2; ++jj) { const int col = 16 * F.lane + 1024 * jj;
#pragma unroll
            for (int e4 = 0; e4 < 4; ++e4) { const f32x4 f0 = *(const f32x4*)(fg + col + 4 * e4);
                *(f32x4*)(xr + col + 4 * e4) = (f32x4){v[jj][4 * e4], v[jj][4 * e4 + 1], v[jj][4 * e4 + 2], v[jj][4 * e4 + 3]} * rstd * f0; } }
    }
}
#ifndef MK_ONE_LAUNCH
#define MK_ONE_LAUNCH 1
#endif
constexpr int NPHASE = 16;
__global__ void __launch_bounds__(512, 2) mk_fwd(Args args) {
    extern __shared__ __attribute__((aligned(16))) unsigned char lds[];
    Frame F;
    F.lds = (LAS unsigned char*)lds; F.MISC = (volatile LAS unsigned*)(F.lds + LDSCTL_OFF);
    int wave0 = __builtin_amdgcn_readfirstlane((int)threadIdx.x >> 6); asm volatile("" : "+s"(wave0));
    F.tid = threadIdx.x; F.lane = F.tid & 63; F.wave = wave0;
    F.G = gridDim.x; { const int bx = blockIdx.x; F.vcu = (F.G % 8 == 0) ? (bx % 8) * (F.G / 8) + bx / 8 : bx; }
    F.ws = args.ws; F.ctl = (unsigned*)(args.ws + WS_CTL);
    for (int u = F.tid; u < 256; u += 512) ((LAS unsigned*)(F.lds + LDSCTL_OFF))[u] = 0u;
    __syncthreads();
    XcdBarrier bar; bar.bar = F.ctl + CW_BAR; bar.x = 0; bar.st = nullptr;
    if (MK_ONE_LAUNCH) bar = xcd_barrier_post(F.ctl + CW_BAR, F.MISC + 8);
    const int lo = args.ph_lo, hi = args.ph_hi;
#ifndef PHMASK
#define PHMASK 0xFFFF
#endif
#define IN(k) (((PHMASK >> (k)) & 1) && lo <= (k) && (k) < hi)
#ifndef DUPMASK
#define DUPMASK 0
#endif
#define DUP(k) for (int rep_ = 0, nrep_ = opaque_n(1 + ((DUPMASK >> (k)) & 1)); rep_ < nrep_; ++rep_)
#define FRESH() do { int l_ = (int)__builtin_amdgcn_mbcnt_hi(~0u, __builtin_amdgcn_mbcnt_lo(~0u, 0u)); asm volatile("" : "+v"(l_)); int w_ = wave0; asm volatile("" : "+s"(w_)); F.lane = l_; F.wave = w_; F.tid = w_ * 64 + l_; { unsigned char* p_ = args.ws; asm volatile("" : "+s"(p_)); F.ws = p_; ws = p_; F.ctl = (unsigned*)(p_ + WS_CTL); } } while (0)
#define SEAM(k) do { if (MK_ONE_LAUNCH) { if (IN(k) && IN((k) + 1)) { xcd_barrier(bar); if ((DUPMASK >> 18) & 1) xcd_barrier(bar); } } } while (0)
    const int G = F.G, c = (int)blockIdx.x;
#ifndef PROBE_PHASE
#define PROBE_PHASE -1
#endif
    unsigned long long pt0_ = 0;
#define PSTART(k) do { if (PROBE_PHASE == (k)) pt0_ = __builtin_amdgcn_s_memrealtime(); } while (0)
#define PEND(k) do { if (PROBE_PHASE == (k) && blockIdx.x == 0 && threadIdx.x == 0) { const unsigned long long t1_ = __builtin_amdgcn_s_memrealtime(); __hip_atomic_store(F.ctl + 12000, (unsigned)(t1_ - pt0_), __ATOMIC_RELAXED, __HIP_MEMORY_SCOPE_AGENT); } } while (0)
    unsigned char* ws = args.ws;

    PSTART(0);
    if (IN(0)) DUP(0) { FRESH(); p0_prologue(F, args); } SEAM(0); PEND(0);
    PSTART(1);
    if (IN(1)) DUP(1) { FRESH(); p1_norm1(F, args); } SEAM(1); PEND(1);
    PSTART(2);
    if (IN(2)) DUP(2) { FRESH();
        const int g1 = (G == 256 && !NOCONV) ? 240 : G;
        if (c < g1) {
            G1Order S{(const char*)(ws + WS_HA), (const char*)(ws + WS_WIN), (size_t)256 * D * (P2_FP8 ? 1 : 2), (size_t)256 * D * (P2_FP8 ? 1 : 2), g1, c};
            EpiG1 E{(bf16*)(ws + WS_U), (bf16*)(ws + WS_SLAB), (unsigned char*)(ws + WS_GATES)};
            if (P2_FP8) pg8::gemm_phase<EpiG1, G1Order, false, true, 124>(F.lds + RING_OFF, F.wave, D / 2, D / 2, D / 2, S, E);
            else pg8::gemm_phase<EpiG1, G1Order, false>(F.lds + RING_OFF, F.wave, D, D, D, S, E);
            FRESH();
            if (F.tid == 0) (void)xb_add(F.ctl + CW_P2DONE, 1u);
        } else conv_steal(F, args, 8u);
    } SEAM(2); PEND(2);
    PSTART(3);
    if (IN(3)) DUP(3) { FRESH(); p3_prep(F, args); } SEAM(3); PEND(3);
    PSTART(4);
    if (IN(4)) DUP(4) { FRESH();
#ifndef NO4A
        {
            RepOrder S{(const char*)(ws + WS_LIN), (const char*)(ws + WS_LORA), (size_t)128 * 2, (size_t)D * 128 * 2, (size_t)256 * LINLD * 2, (size_t)256 * 128 * 2, MT / 256, D / 256, 4, G, c};
            EpiLora E{(unsigned short*)(ws + WS_EA), args.in[I_DW0], args.in[I_IA0]};
            pg8::gemm_phase<EpiLora, RepOrder, false>(F.lds + RING_OFF, F.wave, 128, LINLD, 128, S, E);
        }
#endif
    }
    if (IN(4)) DUP(4) { FRESH();
#ifndef NO4B
        {
            RepOrder S{(const char*)(ws + WS_DP), (const char*)(ws + WS_POOLW), (size_t)256 * 2, (size_t)256 * 256 * 2, (size_t)256 * 1024 * 2, (size_t)256 * 256 * 2, NT / 256, 1, 4, G, c};
            EpiPoolG E{(bf16*)(ws + WS_Y2), args.in[I_POOLS]};
            pg8::gemm_phase<EpiPoolG, RepOrder, false>(F.lds + RING_OFF, F.wave, 256, 1024, 256, S, E);
        }
#endif
    } SEAM(4); PEND(4);
    PSTART(5);
    if (IN(5)) DUP(5) { FRESH();
        RepOrder S{(const char*)(ws + WS_Y2), (const char*)(ws + WS_WPO), 0, 0, (size_t)256 * 1024 * 2, (size_t)256 * 1024 * 2, NT / 256, D / 256, 1, G, c};
        EpiMix<0> E{(bf16*)(ws + WS_MP), D, (const void*)(ws + WS_GATES), 4096, nullptr, 0};
        pg8::gemm_phase<EpiMix<0>, RepOrder, false>(F.lds + RING_OFF, F.wave, 1024, 1024, 1024, S, E);
    }
    PSTART(6);
    if (IN(6)) DUP(6) { FRESH(); p6_scan(F, args); if ((DUPMASK >> 19) & 1) { FRESH(); p6_scan(F, args); } } SEAM(6); PEND(6);
    PSTART(7);
    if (IN(7)) DUP(7) { FRESH(); p7_readout(F, args); } SEAM(7); PEND(7);
    PSTART(8);
    if (IN(8)) DUP(8) { FRESH();
        RepOrder S{(const char*)(ws + WS_LIN) + 512 * 2, (const char*)(ws + WS_G2), 0, 0, (size_t)256 * LINLD * 2, (size_t)256 * 256 * 2, NT / 256, D / 256, 1, G, c};
        EpiMix<1> E{(bf16*)(ws + WS_OR), D, (const void*)(ws + WS_Z), D, nullptr, 0};
        pg8::gemm_phase<EpiMix<1>, RepOrder, false>(F.lds + RING_OFF, F.wave, 256, LINLD, 256, S, E);
    } SEAM(8); PEND(8);
    PSTART(9);
    if (IN(9)) DUP(9) { FRESH();
        RepOrder S{(const char*)(ws + WS_OR), (const char*)(ws + WS_WRO), 0, 0, (size_t)256 * D * 2, (size_t)256 * D * 2, NT / 256, D / 256, 1, G, c};
        EpiMix<2, P10_FP8 != 0> E{(bf16*)(ws + WS_Z), P10_FP8 ? D : D, (const void*)(ws + WS_GATES + 2048), 4096, (const bf16*)(ws + WS_MP), D};
        pg8::gemm_phase<EpiMix<2, P10_FP8 != 0>, RepOrder, false>(F.lds + RING_OFF, F.wave, D, D, D, S, E);
    } SEAM(9); PEND(9);
    PSTART(10);
    if (IN(10)) DUP(10) { FRESH();
        RepOrder S{(const char*)(ws + WS_Z), (const char*)(ws + WS_WO), 0, 0, (size_t)256 * D * (P10_FP8 ? 1 : 2), (size_t)256 * D * (P10_FP8 ? 1 : 2), NT / 256, D / 256, 1, G, c};
        EpiX1 E{args.in[I_X], (bf16*)(ws + WS_X1), (const float*)(ws + WS_MOD)};
        if (P10_FP8) pg8::gemm_phase<EpiX1, RepOrder, false, true, 124>(F.lds + RING_OFF, F.wave, D / 2, D / 2, D / 2, S, E);
        else pg8::gemm_phase<EpiX1, RepOrder, false>(F.lds + RING_OFF, F.wave, D, D, D, S, E);
    } SEAM(10); PEND(10);
    PSTART(11);
    if (IN(11)) DUP(11) { FRESH(); p11_route(F, args); } SEAM(11); PEND(11);
    PSTART(12);
    if (IN(12)) DUP(12) { FRESH(); p12_slots(F); } SEAM(12); PEND(12);
    PSTART(13);
    if (IN(13)) DUP(13) { FRESH();
        const int ntiles = moe_tables(F);
        MoeOrderT<true> S{(const char*)(ws + WS_H2), (const char*)ws, (const LAS int*)(F.lds + TAB_OFF), (const LAS int*)(F.lds + ROWTAB_OFF), 0, (size_t)1024 * D * 2, (size_t)256 * D, ntiles, 4, G, c};
        { LAS int* rt = (LAS int*)(F.lds + ROWTAB_OFF); const int* tok = (const int*)(ws + WS_TOK); Unit uu;
          for (int i = 0; i < ROWTAB_UNITS && S.next(i, uu); ++i) if (F.tid < 256) rt[i * 256 + F.tid] = tok[uu.pm * 256 + F.tid];
          __syncthreads(); }
        EpiAct E{ws + WS_ACT};
        pg8::gemm_phase<EpiAct, MoeOrderT<true>, true, true, 124>(F.lds + RING_OFF, F.wave, D / 2, D / 2, D / 2, S, E);
    } SEAM(13); PEND(13);
    PSTART(14);
    if (IN(14)) DUP(14) { FRESH();
        const int ntiles = moe_tables(F);
        MoeOrderT<false> S{(const char*)(ws + WS_ACT), (const char*)(ws + WS_DT), (const LAS int*)(F.lds + TAB_OFF), (const LAS int*)(F.lds + ROWTAB_OFF), (size_t)256 * DEXP, (size_t)D * DEXP, (size_t)256 * DEXP, ntiles, 8, G, c};
        EpiDown E{(unsigned char*)(ws + WS_YP)};
        pg8::gemm_phase<EpiDown, MoeOrderT<false>, false, true, 124>(F.lds + RING_OFF, F.wave, DEXP / 2, DEXP / 2, DEXP / 2, S, E);
    } SEAM(14); PEND(14);
    PSTART(15);
    if (IN(15)) DUP(15) { FRESH(); p15_final(F, args); }
#undef IN
#undef SEAM
}

extern "C" void kernel_launch(void* const* d_in, const int* in_sizes, int n_in, void* d_out, int out_size, void* d_ws, size_t ws_size, hipStream_t stream) {
    static int grid = 0;
    if (grid == 0) {
        if (n_in != 34 || in_sizes[0] != NT * D || out_size != NT * D || ws_size < WS_END) { fprintf(stderr, "kernel_launch: unexpected shapes (n_in %d, in0 %d, out %d, ws %zu < %zu)\n", n_in, n_in > 0 ? in_sizes[0] : -1, out_size, ws_size, (size_t)WS_END); grid = -1; return; }
        int dev = 0, cus = 0, per_cu = 0;
        if (hipGetDevice(&dev) != hipSuccess || hipDeviceGetAttribute(&cus, hipDeviceAttributeMultiprocessorCount, dev) != hipSuccess) { grid = -1; return; }
        if (hipFuncSetAttribute((const void*)mk_fwd, hipFuncAttributeMaxDynamicSharedMemorySize, LDS_BYTES) != hipSuccess) { fprintf(stderr, "kernel_launch: hipFuncSetAttribute failed\n"); grid = -1; return; }
        if (hipOccupancyMaxActiveBlocksPerMultiprocessor(&per_cu, (const void*)mk_fwd, 512, LDS_BYTES) != hipSuccess || per_cu < 1) fprintf(stderr, "kernel_launch: occupancy query reports %d\n", per_cu);
        (void)hipGetLastError();
        grid = cus;
    }
    if (grid < 0) return;
    if (hipMemsetAsync((char*)d_ws + WS_CTL, 0, CTL_ZERO_BYTES, stream) != hipSuccess) return;
    Args a{};
    for (int i = 0; i < 34; ++i) a.in[i] = (const float*)d_in[i];
    a.out = (float*)d_out; a.ws = (unsigned char*)d_ws;
#if MK_ONE_LAUNCH
    a.ph_lo = 0; a.ph_hi = NPHASE;
    hipLaunchKernelGGL(mk_fwd, dim3(grid), dim3(512), LDS_BYTES, stream, a);
#else
    for (int p = 0; p < NPHASE; ++p) { a.ph_lo = p; a.ph_hi = p + 1; hipLaunchKernelGGL(mk_fwd, dim3(grid), dim3(512), LDS_BYTES, stream, a); }
#endif
}
```

```cpp
#include <hip/hip_runtime.h>
#include <cstdio>
#include <cstdint>
#ifndef DUPMASK
#define DUPMASK 0
#endif
#ifndef PROBE_PHASE
#define PROBE_PHASE -1
#endif
#ifndef P2_FP8
#define P2_FP8 1
#endif
#ifndef P10_FP8
#define P10_FP8 0
#endif
static_assert(P10_FP8 == 0, "the w_out copy is bf16");
#ifndef STAGGER14
#define STAGGER14 0
#endif
#ifndef NOCONV
#define NOCONV 0
#endif

#define GAS __attribute__((address_space(1)))
#define LAS __attribute__((address_space(3)))
typedef unsigned short bf16;
typedef unsigned v4u __attribute__((ext_vector_type(4)));
typedef unsigned v2u __attribute__((ext_vector_type(2)));
typedef float f32x4 __attribute__((ext_vector_type(4)));
typedef float f32x2 __attribute__((ext_vector_type(2)));
typedef short bf16x8 __attribute__((ext_vector_type(8)));

constexpr int D = 2048, NB = 4, TSEQ = 4096, NT = NB * TSEQ  , CTXL = 256, NC = NB * CTXL  , MT = NT + NC  ;
constexpr int DIN = 11904, DSH = 6784, NPAD = 12032, SLABLD = 6912, NH = 32, HS = 64;
constexpr int NEXP = 64, DEXP = 512, TOPK = 8;
constexpr int NSLOT = NT * TOPK + NEXP * 256 + NT;
constexpr int MAXTILES = NSLOT / 256;
constexpr int LINLD = 768;

__device__ __forceinline__ int opaque_n(int n) { asm volatile("" : "+s"(n)); return n; }
__device__ __forceinline__ unsigned f2bf(float f) { unsigned u = __builtin_bit_cast(unsigned, f); return (u + 0x7fffu + ((u >> 16) & 1u)) >> 16; }
typedef __bf16 bf16x2_t __attribute__((ext_vector_type(2)));
__device__ __forceinline__ unsigned pk2(float lo, float hi) { const f32x2 v = {lo, hi}; const bf16x2_t b = __builtin_convertvector(v, bf16x2_t); return __builtin_bit_cast(unsigned, b); }
__device__ __forceinline__ unsigned pk8(float a, float b, float c, float d) { int w = __builtin_amdgcn_cvt_pk_fp8_f32(a, b, 0, false); w = __builtin_amdgcn_cvt_pk_fp8_f32(c, d, w, true); return (unsigned)w; }
__device__ __forceinline__ float bflo(unsigned w) { return __builtin_bit_cast(float, w << 16); }
__device__ __forceinline__ float bfhi(unsigned w) { return __builtin_bit_cast(float, w & 0xffff0000u); }
__device__ __forceinline__ unsigned pkh2(float lo, float hi) { const unsigned short a = __builtin_bit_cast(unsigned short, (_Float16)lo), b = __builtin_bit_cast(unsigned short, (_Float16)hi); return (unsigned)a | ((unsigned)b << 16); }
__device__ __forceinline__ float hlo(unsigned w) { return (float)__builtin_bit_cast(_Float16, (unsigned short)(w & 0xffffu)); }
__device__ __forceinline__ float hhi(unsigned w) { return (float)__builtin_bit_cast(_Float16, (unsigned short)(w >> 16)); }
__device__ __forceinline__ float sigmoidf_(float x) { return __builtin_amdgcn_rcpf(1.0f + __builtin_amdgcn_exp2f(-1.44269504f * x)); }
__device__ __forceinline__ float tanhf_(float x) { return 1.0f - 2.0f * __builtin_amdgcn_rcpf(1.0f + __builtin_amdgcn_exp2f(2.88539008f * x)); }
__device__ __forceinline__ float wave_sum(float v) {
#pragma unroll
    for (int o = 1; o < 64; o <<= 1) v += __shfl_xor(v, o);
    return v;
}
__device__ __forceinline__ float dpp_f(float v, const int ctrl_sel) {
    int r;
    const int x = __builtin_bit_cast(int, v);
    if (ctrl_sel == 0) r = __builtin_amdgcn_update_dpp(0, x, 0xB1, 0xF, 0xF, true);
    else if (ctrl_sel == 1) r = __builtin_amdgcn_update_dpp(0, x, 0x4E, 0xF, 0xF, true);
    else if (ctrl_sel == 2) r = __builtin_amdgcn_update_dpp(0, x, 0x141, 0xF, 0xF, true);
    else r = __builtin_amdgcn_update_dpp(0, x, 0x140, 0xF, 0xF, true);
    return __builtin_bit_cast(float, r);
}
__device__ __forceinline__ float allred16(float v) { v += dpp_f(v, 0); v += dpp_f(v, 1); v += dpp_f(v, 2); v += dpp_f(v, 3); return v; }

#define LDS_WAIT() asm volatile("s_waitcnt lgkmcnt(0)" ::: "memory")
#define VM_WAIT() asm volatile("s_waitcnt vmcnt(0)" ::: "memory")

namespace pg8 {
constexpr int BM = 256, BK = 64, HALF = 128, HTB = HALF * BK * 2, STAGE_BYTES = 8 * HTB, NXCD = 8, WGM = 8;
__host__ __device__ __forceinline__ int lds_byte(int r, int c) { const int st = (r >> 4) * 2 + (c >> 5), rr = r & 15, cc = c & 31, ob = rr * 64 + cc * 2; return st * 1024 + (ob ^ (((ob >> 9) & 1) << 5)); }
__host__ __device__ __forceinline__ void stage_rc(int b, int& R, int& C) { const int st = b / 1024, sb = b % 1024, swz = sb ^ (((sb >> 9) & 1) << 5); R = (st >> 1) * 16 + swz / 64; C = (st & 1) * 32 + (swz % 64) / 2; }
__host__ __device__ __forceinline__ int perm32(int rho) { const int n = rho >> 4, i = rho & 15; return 8 * (i >> 2) + 4 * n + (i & 3); }
struct Unit { const char* A; const char* B; int pm, pn, aux, ui; };
__device__ __forceinline__ int xcd_remap(int L, int nwg) { const int q = nwg / NXCD, r = nwg % NXCD, xcd = L % NXCD, off = L / NXCD; return (xcd < r ? xcd * (q + 1) : r * (q + 1) + (xcd - r) * q) + off; }
__device__ __forceinline__ void grid_tile(int wgid, int nM, int nN, int& pm, int& pn) { const int nig = WGM * nN, gid = wgid / nig, fm = gid * WGM, gsz = (nM - fm) < WGM ? (nM - fm) : WGM; pm = fm + ((wgid % nig) % gsz); pn = (wgid % nig) / gsz; }

__device__ __forceinline__ void stage2(LAS unsigned char* lds, int bufoff, unsigned ldsw, const char* g, unsigned o0, unsigned o1) {
    __builtin_amdgcn_global_load_lds((const unsigned*)(g + o0), (LAS unsigned*)(lds + bufoff + ldsw), 16, 0, 0);
    __builtin_amdgcn_global_load_lds((const unsigned*)(g + o1), (LAS unsigned*)(lds + bufoff + ldsw + 8192), 16, 0, 0);
}

typedef int v8i_t __attribute__((ext_vector_type(8)));
typedef int v4i_t __attribute__((ext_vector_type(4)));
__device__ __forceinline__ v8i_t mx_cat(const bf16x8& lo, const bf16x8& hi) { const v4i_t a = __builtin_bit_cast(v4i_t, lo), b = __builtin_bit_cast(v4i_t, hi); return __builtin_shufflevector(a, b, 0, 1, 2, 3, 4, 5, 6, 7); }

template <class Epi, class = void> struct EpiPerm16 { static constexpr bool value = false; };
template <class Epi> struct EpiPerm16<Epi, decltype((void)Epi::PERM16)> { static constexpr bool value = Epi::PERM16; };
template <class Epi> __host__ __device__ constexpr bool epi_perm16() { return EpiPerm16<Epi>::value; }
template <class Epi> __host__ __device__ __forceinline__ int perm_row(int R) {
    if (epi_perm16<Epi>()) { const int wc = R >> 5, rho = R & 31, n = rho >> 4, i = rho & 15; return 64 * wc + 16 * (i >> 2) + 4 * n + (i & 3); }
    return Epi::PERM ? ((R & ~31) + perm32(R & 31)) : R;
}
template <class Epi, class Sched, bool GATHER, bool ALIGN_EPI = true, int MXS = 0>
__device__ __forceinline__ void gemm_phase(LAS unsigned char* lds, const int wave_, const int K, const int lda, const int ldb, const Sched& S, const Epi& E) {
    int tid_ = wave_ * 64 + (int)__builtin_amdgcn_mbcnt_hi(~0u, __builtin_amdgcn_mbcnt_lo(~0u, 0u)); asm volatile("" : "+v"(tid_));
    const int tid = tid_, wid = __builtin_amdgcn_readfirstlane(tid >> 6), lane = tid & 63, wr = wid >> 2, wc = wid & 3, fr = lane & 15, fq = lane >> 4;
    const int nt = opaque_n(K / BK);
    unsigned voffA[2], voffB[2]; int RA[2], CA[2];
#pragma unroll
    for (int i = 0; i < 2; ++i) { int R, C; stage_rc(tid * 16 + i * 8192, R, C); const int Rb = perm_row<Epi>(R);
        RA[i] = R; CA[i] = C; voffA[i] = (unsigned)(R * lda + C) * 2u; voffB[i] = (unsigned)(Rb * ldb + C) * 2u; }
    const size_t kstep = (size_t)(BK * 2);
    const size_t hstepA = (size_t)HALF * lda * 2, hstepB = (size_t)(epi_perm16<Epi>() ? 8 : HALF) * ldb * 2;
    const unsigned ldsw = (unsigned)wid * 1024u;
    const int aoff = lds_byte(wr * 64 + fr, fq * 8), boff = lds_byte(wc * 32 + fr, fq * 8);
#define PG8_SA(b, h) (((b) * 2 + (h)) * HTB)
#define PG8_SB(b, h) ((4 + (b) * 2 + (h)) * HTB)
#define PG8_STB(bufoff, gbase) stage2(lds, (bufoff), ldsw, (gbase), voffB[0], voffB[1])
#define PG8_STA(bufoff, gk, h, NX) do { if constexpr (GATHER) { const unsigned _o0 = (NX) ? vn[h][0] : vc[h][0], _o1 = (NX) ? vn[h][1] : vc[h][1]; stage2(lds, (bufoff), ldsw, (gk), _o0, _o1); } \
        else stage2(lds, (bufoff), ldsw, (gk) + (h) * hstepA, voffA[0], voffA[1]); } while (0)
#define PG8_LDA(dst, b, h) do { _Pragma("unroll") for (int m = 0; m < 4; ++m) _Pragma("unroll") for (int k = 0; k < 2; ++k) dst[m][k] = *(const LAS bf16x8*)(lds + PG8_SA(b, h) + aoff + m * 2048 + k * 1024); } while (0)
#define PG8_LDB(dst, b, h) do { _Pragma("unroll") for (int n = 0; n < 2; ++n) _Pragma("unroll") for (int k = 0; k < 2; ++k) dst[n][k] = *(const LAS bf16x8*)(lds + PG8_SB(b, h) + boff + n * 2048 + k * 1024); } while (0)
#define PG8_MMA(ai, bj, At, Bt) do { __builtin_amdgcn_s_setprio(1); if constexpr (MXS != 0) { _Pragma("unroll") for (int m = 0; m < 4; ++m) _Pragma("unroll") for (int n = 0; n < 2; ++n) \
        asm volatile("v_mfma_scale_f32_16x16x128_f8f6f4 %0, %1, %2, %0, %3, %3 op_sel_hi:[0,0,0]" : "+v"(acc[ai][bj][m][n]) : "v"(mx_cat(Bt[n][0], Bt[n][1])), "v"(mx_cat(At[m][0], At[m][1])), "v"(mxs_)); } \
        else { _Pragma("unroll") for (int m = 0; m < 4; ++m) _Pragma("unroll") for (int n = 0; n < 2; ++n) _Pragma("unroll") for (int k = 0; k < 2; ++k) \
        acc[ai][bj][m][n] = __builtin_amdgcn_mfma_f32_16x16x32_bf16(Bt[n][k], At[m][k], acc[ai][bj][m][n], 0, 0, 0); } __builtin_amdgcn_s_setprio(0); } while (0)
#define PG8_WAIT_V(n) asm volatile("s_waitcnt vmcnt(" #n ")" ::: "memory")
#define PG8_WAIT_L(n) asm volatile("s_waitcnt lgkmcnt(" #n ")" ::: "memory")
#define PG8_BAR __builtin_amdgcn_s_barrier()
#define PG8_SCHED __builtin_amdgcn_sched_barrier(0)
    Unit cur, nxt; int ui = 0;
    if (!S.next(0, cur)) return;
    int mxs_ = MXS * 0x01010101; asm volatile("" : "+v"(mxs_));
    unsigned vc[2][2], vn[2][2];
    if constexpr (GATHER) {
#pragma unroll
        for (int h = 0; h < 2; ++h)
#pragma unroll
            for (int i = 0; i < 2; ++i) { vc[h][i] = ((unsigned)S.row(cur, h * HALF + RA[i]) * (unsigned)lda + (unsigned)CA[i]) * 2u; vn[h][i] = vc[h][i]; }
        if constexpr (!Sched::ROW_LDS) asm volatile("s_waitcnt vmcnt(0)" ::: "memory");
    }
    f32x4 acc[2][2][4][2];
#pragma unroll
    for (int a = 0; a < 2; ++a)
#pragma unroll
        for (int b = 0; b < 2; ++b)
#pragma unroll
            for (int m = 0; m < 4; ++m)
#pragma unroll
                for (int n = 0; n < 2; ++n) acc[a][b][m][n] = (f32x4){0.f, 0.f, 0.f, 0.f};
    bf16x8 At[4][2], B0[2][2], B1[2][2];
    const char* cA = cur.A; const char* cB = cur.B;
    PG8_STB(PG8_SB(0, 0), cB); PG8_STB(PG8_SB(0, 1), cB + hstepB); PG8_STA(PG8_SA(0, 0), cA, 0, false); PG8_STA(PG8_SA(0, 1), cA, 1, false);
    if (wr == 1) PG8_BAR;
    PG8_WAIT_V(2); PG8_BAR;
    PG8_STB(PG8_SB(1, 0), cB + kstep); PG8_STA(PG8_SA(1, 0), cA + kstep, 0, false); PG8_STB(PG8_SB(1, 1), cB + hstepB + kstep);
    PG8_WAIT_V(6); PG8_BAR;
    for (;;) {
        const bool has_next = S.next(ui + 1, nxt);
        const char* nA = has_next ? nxt.A : cA; const char* nB = has_next ? nxt.B : cB;
#pragma unroll 1
        for (int t = 0; t < nt; t += 2) {
            const bool last = (t == nt - 2);
            const char* a1 = cA + (size_t)(t + 1) * kstep;
            const char* a2 = last ? nA : cA + (size_t)(t + 2) * kstep; const char* b2 = last ? nB : cB + (size_t)(t + 2) * kstep;
            const char* a3 = a2 + kstep; const char* b3 = b2 + kstep;
            if constexpr (GATHER) {
                if (last && has_next) {
#pragma unroll
                    for (int h = 0; h < 2; ++h)
#pragma unroll
                        for (int i = 0; i < 2; ++i) vn[h][i] = ((unsigned)S.row(nxt, h * HALF + RA[i]) * (unsigned)lda + (unsigned)CA[i]) * 2u;
                    if constexpr (!Sched::ROW_LDS) asm volatile("s_waitcnt vmcnt(0)" ::: "memory");
                }
            }
            PG8_LDB(B0, 0, 0); PG8_LDB(B1, 0, 1); PG8_SCHED; PG8_LDA(At, 0, 0); PG8_STA(PG8_SA(1, 1), a1, 1, false);
            PG8_WAIT_V(8); PG8_WAIT_L(0); PG8_BAR; PG8_MMA(0, 0, At, B0); PG8_MMA(0, 1, At, B1); PG8_BAR; PG8_SCHED;
            PG8_LDA(At, 0, 1); PG8_STB(PG8_SB(0, 0), b2); PG8_STB(PG8_SB(0, 1), b2 + hstepB); PG8_STA(PG8_SA(0, 0), a2, 0, last);
            PG8_WAIT_V(8); PG8_WAIT_L(0); PG8_BAR; PG8_MMA(1, 0, At, B0); PG8_MMA(1, 1, At, B1); PG8_BAR; PG8_SCHED;
            PG8_LDB(B0, 1, 0); PG8_LDB(B1, 1, 1); PG8_SCHED; PG8_LDA(At, 1, 0); PG8_STA(PG8_SA(0, 1), a2, 1, last);
            PG8_WAIT_V(8); PG8_WAIT_L(0); PG8_BAR; PG8_MMA(0, 0, At, B0); PG8_MMA(0, 1, At, B1); PG8_BAR; PG8_SCHED;
            PG8_LDA(At, 1, 1); PG8_STB(PG8_SB(1, 0), b3); PG8_STB(PG8_SB(1, 1), b3 + hstepB); PG8_STA(PG8_SA(1, 0), a3, 0, last);
            PG8_WAIT_V(8); PG8_WAIT_L(0); PG8_BAR; PG8_MMA(1, 0, At, B0); PG8_MMA(1, 1, At, B1); PG8_BAR; PG8_SCHED;
        }
        if constexpr (ALIGN_EPI) { if (wr == 0) PG8_BAR; }
        if constexpr (MXS != 0) asm volatile("s_nop 15\n\ts_nop 15" ::: "memory");
        { int fr_ = fr, fq_ = fq; asm volatile("" : "+v"(fr_), "+v"(fq_));
          E(acc, cur, wr, wc, fr_, fq_); }
        if (!has_next) break;
#pragma unroll
        for (int a = 0; a < 2; ++a)
#pragma unroll
            for (int b = 0; b < 2; ++b)
#pragma unroll
                for (int m = 0; m < 4; ++m)
#pragma unroll
                    for (int n = 0; n < 2; ++n) acc[a][b][m][n] = (f32x4){0.f, 0.f, 0.f, 0.f};
        cur = nxt; cA = nA; cB = nB; ++ui;
        if constexpr (GATHER) {
#pragma unroll
            for (int h = 0; h < 2; ++h)
#pragma unroll
                for (int i = 0; i < 2; ++i) vc[h][i] = vn[h][i];
        }
        if constexpr (ALIGN_EPI) { if (wr == 1) PG8_BAR; }
    }
    PG8_WAIT_V(0);
    if constexpr (!ALIGN_EPI) { if (wr == 0) PG8_BAR; }
    PG8_BAR;
#undef PG8_SA
#undef PG8_SB
#undef PG8_STB
#undef PG8_STA
#undef PG8_LDA
#undef PG8_LDB
#undef PG8_MMA
#undef PG8_WAIT_V
#undef PG8_WAIT_L
#undef PG8_BAR
#undef PG8_SCHED
}
}
#define XB_TMO      128
#define XB_XCNT(j)  (256  + 64 * (j))
#define XB_XSUB(j)  (1280 + 64 * (j))
#define XB_XGEN(j)  (2304 + 64 * (j))
#define XB_TOP      3328
#define XB_TOPGEN   3392
#define XCD_BAR_WORDS 3456
#define XB_SPIN_CAP (1u << 18)
__device__ __forceinline__ unsigned xb_ld(unsigned* p)              { return __hip_atomic_load(p, __ATOMIC_RELAXED, __HIP_MEMORY_SCOPE_AGENT); }
__device__ __forceinline__ unsigned xb_add(unsigned* p, unsigned v) { return __hip_atomic_fetch_add(p, v, __ATOMIC_RELAXED, __HIP_MEMORY_SCOPE_AGENT); }
__device__ __forceinline__ unsigned xb_xcc_id() { return (unsigned)__builtin_amdgcn_s_getreg((3 << 11) | 20) & 0xFu; }
#define XB_SPIN(cond, bar) do { unsigned _sp = 0; while (cond) { __builtin_amdgcn_s_sleep(1); \
    if ((++_sp & 255u) == 0u) { if (xb_ld(&(bar)[XB_TMO])) break; if (_sp > XB_SPIN_CAP) { atomicAdd(&(bar)[XB_TMO], 1u); break; } } } } while (0)
struct XcdBarrier { unsigned* bar; unsigned x; volatile LAS unsigned* st; };
__device__ __forceinline__ XcdBarrier xcd_barrier_post(unsigned* bar, volatile LAS unsigned* st) {
    XcdBarrier b; b.bar = bar; b.x = xb_xcc_id(); b.st = st;
    if (threadIdx.x == 0) (void)xb_add(&bar[XB_XCNT(b.x)], 1u);
    return b;
}
__device__ __forceinline__ void xcd_barrier_complete(unsigned* bar, unsigned x, unsigned& nloc, unsigned& nx) {
    const unsigned G = gridDim.x * gridDim.y * gridDim.z;
    unsigned sum, cnt, mine, sp = 0u;
    for (;;) {
        sum = 0u; cnt = 0u; mine = 0u;
#pragma unroll
        for (unsigned j = 0; j < 16; ++j) { const unsigned c = xb_ld(&bar[XB_XCNT(j)]); sum += c; cnt += (c > 0u) ? 1u : 0u; mine = (j == x) ? c : mine; }
        if (sum == G) break;
        __builtin_amdgcn_s_sleep(1);
        if ((++sp & 255u) == 0u) { if (xb_ld(&bar[XB_TMO])) break; if (sp > XB_SPIN_CAP) { atomicAdd(&bar[XB_TMO], 1u); break; } }
    }
    nloc = mine > 0u ? mine : 1u; nx = cnt > 0u ? cnt : 1u;
}
__device__ __forceinline__ void xcd_barrier(const XcdBarrier& b) {
    asm volatile("s_waitcnt vmcnt(0)" ::: "memory");
    __syncthreads();
    if (threadIdx.x == 0) {
        unsigned* bar = b.bar;
        __builtin_amdgcn_s_waitcnt(0);
        unsigned nloc = b.st[0], nx = b.st[1];
        if (nloc == 0u) { xcd_barrier_complete(bar, b.x, nloc, nx); b.st[0] = nloc; b.st[1] = nx; }
        const unsigned old = xb_add(&bar[XB_XSUB(b.x)], 1u);
        const unsigned gen = old / nloc;
        if (old + 1u == (gen + 1u) * nloc) {
            __builtin_amdgcn_fence(__ATOMIC_RELEASE, "agent");
            asm volatile("s_waitcnt vmcnt(0)" ::: "memory");
            const unsigned og = xb_add(&bar[XB_TOP], 1u);
            const unsigned tg = og / nx;
            if (og + 1u == (tg + 1u) * nx) xb_add(&bar[XB_TOPGEN], 1u);
            else XB_SPIN(xb_ld(&bar[XB_TOPGEN]) == tg, bar);
            __builtin_amdgcn_fence(__ATOMIC_ACQUIRE, "agent");
            xb_add(&bar[XB_XGEN(b.x)], 1u);
            asm volatile("s_waitcnt vmcnt(0)" ::: "memory");
        } else {
            XB_SPIN(xb_ld(&bar[XB_XGEN(b.x)]) == gen, bar);
            __builtin_amdgcn_fence(__ATOMIC_ACQUIRE, "agent");
            asm volatile("s_waitcnt vmcnt(0)" ::: "memory");
        }
    }
    __syncthreads();
}

constexpr size_t MiB = 1u << 20;
constexpr size_t WS_CTL = 0, CTL_ZERO_BYTES = 64 * 1024;
constexpr size_t WS_MOD = 1 * MiB;
constexpr size_t WS_EIDX = 2 * MiB;
constexpr size_t WS_WSEL = WS_EIDX + 512 * 1024;
constexpr size_t WS_RANK = WS_WSEL + 512 * 1024;
constexpr size_t WS_TOK = 4 * MiB;
constexpr size_t WS_DST = WS_TOK + 1 * MiB;
constexpr size_t WS_WSL = WS_DST + 1 * MiB;
constexpr size_t WS_WIN = 8 * MiB;
constexpr size_t WS_POOLW = 55 * MiB;
constexpr size_t WS_WPO = 56 * MiB;
constexpr size_t WS_LORA = 60 * MiB;
constexpr size_t WS_G2 = 62 * MiB;
constexpr size_t WS_WRO = 63 * MiB;
constexpr size_t WS_WO = 71 * MiB;
constexpr size_t WS_SLAB = 80 * MiB;
constexpr size_t WS_EA = 80 * MiB;
constexpr size_t EA_STRIDE = (size_t)MT * D * 2;
constexpr size_t WS_YF = 352 * MiB, WS_YB = 416 * MiB;
constexpr size_t WS_HA = 438 * MiB;
constexpr size_t WS_Z = 480 * MiB;
constexpr size_t WS_U = 506 * MiB;
constexpr size_t WS_RM = 544 * MiB, WS_KM = 612 * MiB, WS_VM = 680 * MiB;
constexpr size_t WS_LIN = 748 * MiB;
constexpr size_t WS_DP = 774 * MiB;
constexpr size_t WS_BON = 774 * MiB;
constexpr size_t WS_Y2 = 806 * MiB;
constexpr size_t WS_MP = 838 * MiB;
constexpr size_t WS_GATES = 902 * MiB;
constexpr size_t WS_OR = 80 * MiB;
constexpr size_t WS_H2 = 520 * MiB;
constexpr size_t WS_GU = 584 * MiB;
constexpr size_t WS_GU2 = 966 * MiB, WS_GU3 = 1134 * MiB;
constexpr int GU_E2 = 52, GU_E3 = 61;
constexpr size_t WS_ACT = 792 * MiB;
constexpr size_t WS_DT = 1004 * MiB;
constexpr size_t WS_X1 = 328 * MiB;
constexpr size_t WS_YP = 8 * MiB;
constexpr size_t WS_END = 1150 * MiB;
__host__ __device__ __forceinline__ size_t gu_base(int e) { return e < GU_E2 ? WS_GU + (size_t)e * (4 * MiB) : e < GU_E3 ? WS_GU2 + (size_t)(e - GU_E2) * (4 * MiB) : WS_GU3 + (size_t)(e - GU_E3) * (4 * MiB); }
constexpr int CW_BAR = 1024;
constexpr int CW_GCNT = 8192;
constexpr int CW_O64 = 8192 + 100;
constexpr int CW_CONV = 8448, CW_P2DONE = 8512;
static_assert((CW_BAR + XCD_BAR_WORDS) <= CW_GCNT && (CW_P2DONE + 128) * 4 <= (int)CTL_ZERO_BYTES, "ctl");

constexpr int RING_OFF = 0, RING_BYTES = 131072;
constexpr int LDSCTL_OFF = RING_BYTES;
constexpr int ROWTAB_OFF = LDSCTL_OFF + 1024 + 4096, ROWTAB_UNITS = 24;
constexpr int TAB_OFF = LDSCTL_OFF + 1024;
constexpr int LDS_BYTES = 163840;

using pg8::Unit;
struct RepOrder { static constexpr bool ROW_LDS = false;
    const char* A; const char* B; size_t repA, repB, tA, tB; int nM, nN, nrep, G, c;
    __device__ __forceinline__ bool next(int i, Unit& u) const {
        const long L = (long)i * G + c; const int per = nM * nN; if (L >= (long)per * nrep) return false;
        const int rep = (int)(L / per); const int w = pg8::xcd_remap((int)(L % per), per); pg8::grid_tile(w, nM, nN, u.pm, u.pn); u.aux = rep;
        u.A = A + (size_t)rep * repA + (size_t)u.pm * tA; u.B = B + (size_t)rep * repB + (size_t)u.pn * tB; return true; }
    __device__ __forceinline__ int row(const Unit&, int) const { return 0; }
};
struct G1Order { static constexpr bool ROW_LDS = false;
    const char* A; const char* B; size_t tA, tB; int G, c;
    __device__ __forceinline__ bool next(int i, Unit& u) const {
        const long L = (long)i * G + c; constexpr int N1 = 64 * 47, N2 = 4 * 27; if (L >= N1 + N2) return false;
        if (L < N1) { const int w = pg8::xcd_remap((int)L, N1); pg8::grid_tile(w, 64, 47, u.pm, u.pn); }
        else { const int l2 = (int)L - N1; u.pm = 64 + (l2 & 3); u.pn = 4 + (l2 >> 2); }
        u.aux = 0; u.A = A + (size_t)u.pm * tA; u.B = B + (size_t)u.pn * tB; return true; }
    __device__ __forceinline__ int row(const Unit&, int) const { return 0; }
};
template <bool GUMAP> struct MoeOrderT { static constexpr bool ROW_LDS = true;
    const char* A; const char* B; const LAS int* te; const LAS int* rowtab; size_t tA, estride, jstride; int ntiles, NJ, G, c;
    __device__ __forceinline__ bool next(int i, Unit& u) const {
        const long L = (long)i * G + c; const int tot = ntiles * NJ; if (L >= tot) return false;
        const int w = pg8::xcd_remap((int)L, tot); const int rt = w / NJ, j = w - rt * NJ; const int e = te[rt];
        u.pm = rt; u.pn = j; u.aux = e; u.ui = i; u.A = A + (size_t)rt * tA; u.B = B + (GUMAP ? gu_base(e) : (size_t)e * estride) + (size_t)j * jstride; return true; }
    __device__ __forceinline__ int row(const Unit& u, int r) const { return rowtab[u.ui * 256 + r]; }
};

typedef f32x4 AccT[2][2][4][2];
#define EPI_ROWS_BEGIN _Pragma("unroll") for (int ai = 0; ai < 2; ++ai) _Pragma("unroll") for (int m = 0; m < 4; ++m) { const int rl = ai * 128 + wr * 64 + m * 16 + fr;
#define EPI_ROWS_END if (m & 1) asm volatile("" ::: "memory"); }
struct EpiG1 { static constexpr bool PERM = true; bf16* U; bf16* SLAB; unsigned char* GATES;
    __device__ __forceinline__ void operator()(const AccT& acc, const Unit& u, int wr, int wc, int fr, int fq) const {
        if (u.pn >= 31) {
            const int c0 = (u.pn - 31) * 256 + wc * 32 + 8 * fq;
            EPI_ROWS_BEGIN
                unsigned char* rowp = GATES + (size_t)(u.pm * 256 + rl) * 4096 + c0;
#pragma unroll
                for (int bj = 0; bj < 2; ++bj) { const f32x4 v0 = acc[ai][bj][m][0], v1 = acc[ai][bj][m][1]; unsigned p0 = 0u, p1 = 0u;
                    p0 = __builtin_amdgcn_cvt_pk_u8_f32(255.0f * sigmoidf_(v0[0]), 0, p0); p0 = __builtin_amdgcn_cvt_pk_u8_f32(255.0f * sigmoidf_(v0[1]), 1, p0);
                    p0 = __builtin_amdgcn_cvt_pk_u8_f32(255.0f * sigmoidf_(v0[2]), 2, p0); p0 = __builtin_amdgcn_cvt_pk_u8_f32(255.0f * sigmoidf_(v0[3]), 3, p0);
                    p1 = __builtin_amdgcn_cvt_pk_u8_f32(255.0f * sigmoidf_(v1[0]), 0, p1); p1 = __builtin_amdgcn_cvt_pk_u8_f32(255.0f * sigmoidf_(v1[1]), 1, p1);
                    p1 = __builtin_amdgcn_cvt_pk_u8_f32(255.0f * sigmoidf_(v1[2]), 2, p1); p1 = __builtin_amdgcn_cvt_pk_u8_f32(255.0f * sigmoidf_(v1[3]), 3, p1);
                    v2u w; w.x = p0; w.y = p1; *(v2u*)(rowp + bj * 128) = w; }
            EPI_ROWS_END
            return;
        }
        bf16* base; int ld, c0;
        if (u.pn < 4) { base = U; ld = 1024; c0 = u.pn * 256; } else { base = SLAB; ld = SLABLD; c0 = (u.pn - 4) * 256; }
        EPI_ROWS_BEGIN
            bf16* rowp = base + (size_t)(u.pm * 256 + rl) * ld + c0 + wc * 32 + 8 * fq;
#pragma unroll
            for (int bj = 0; bj < 2; ++bj) { const f32x4 v0 = acc[ai][bj][m][0], v1 = acc[ai][bj][m][1];
                v4u w; w.x = pk2(v0[0], v0[1]); w.y = pk2(v0[2], v0[3]); w.z = pk2(v1[0], v1[1]); w.w = pk2(v1[2], v1[3]); *(v4u*)(rowp + bj * 128) = w; }
        EPI_ROWS_END
    }
};
struct EpiLora { static constexpr bool PERM = true; unsigned short* EA; const float* w0; const float* a0;
    __device__ __forceinline__ void operator()(const AccT& acc, const Unit& u, int wr, int wc, int fr, int fq) const {
        const int rep = u.aux; const float* bias = (rep < 2 ? w0 + rep * D : a0 + (rep - 2) * D) + u.pn * 256 + wc * 32 + 8 * fq;
        unsigned short* base = EA + (size_t)rep * ((size_t)MT * D);
        if (rep < 2) { const float cc = -0.8750424f;
            EPI_ROWS_BEGIN
                unsigned short* rowp = base + (size_t)(u.pm * 256 + rl) * D + u.pn * 256 + wc * 32 + 8 * fq;
#pragma unroll
                for (int bj = 0; bj < 2; ++bj) { const f32x4 v0 = acc[ai][bj][m][0] + *(const f32x4*)(bias + bj * 128), v1 = acc[ai][bj][m][1] + *(const f32x4*)(bias + bj * 128 + 4);
                    v4u w; w.x = pkh2(cc * sigmoidf_(v0[0]), cc * sigmoidf_(v0[1])); w.y = pkh2(cc * sigmoidf_(v0[2]), cc * sigmoidf_(v0[3]));
                    w.z = pkh2(cc * sigmoidf_(v1[0]), cc * sigmoidf_(v1[1])); w.w = pkh2(cc * sigmoidf_(v1[2]), cc * sigmoidf_(v1[3]));
                    *(v4u*)(rowp + bj * 128) = w; }
            EPI_ROWS_END
        } else {
            EPI_ROWS_BEGIN
                unsigned char* rowp = (unsigned char*)base + (size_t)(u.pm * 256 + rl) * D + u.pn * 256 + wc * 32 + 8 * fq;
#pragma unroll
                for (int bj = 0; bj < 2; ++bj) { const f32x4 v0 = acc[ai][bj][m][0] + *(const f32x4*)(bias + bj * 128), v1 = acc[ai][bj][m][1] + *(const f32x4*)(bias + bj * 128 + 4); unsigned p0 = 0u, p1 = 0u;
                    p0 = __builtin_amdgcn_cvt_pk_u8_f32(255.0f * sigmoidf_(v0[0]), 0, p0); p0 = __builtin_amdgcn_cvt_pk_u8_f32(255.0f * sigmoidf_(v0[1]), 1, p0);
                    p0 = __builtin_amdgcn_cvt_pk_u8_f32(255.0f * sigmoidf_(v0[2]), 2, p0); p0 = __builtin_amdgcn_cvt_pk_u8_f32(255.0f * sigmoidf_(v0[3]), 3, p0);
                    p1 = __builtin_amdgcn_cvt_pk_u8_f32(255.0f * sigmoidf_(v1[0]), 0, p1); p1 = __builtin_amdgcn_cvt_pk_u8_f32(255.0f * sigmoidf_(v1[1]), 1, p1);
                    p1 = __builtin_amdgcn_cvt_pk_u8_f32(255.0f * sigmoidf_(v1[2]), 2, p1); p1 = __builtin_amdgcn_cvt_pk_u8_f32(255.0f * sigmoidf_(v1[3]), 3, p1);
                    v2u w; w.x = p0; w.y = p1; *(v2u*)(rowp + bj * 128) = w; }
            EPI_ROWS_END
        }
    }
};
struct EpiPoolG { static constexpr bool PERM = true; bf16* Y2; const float* scale;
    __device__ __forceinline__ void operator()(const AccT& acc, const Unit& u, int wr, int wc, int fr, int fq) const {
        const int cb = u.aux * 256 + wc * 32 + 8 * fq;
        f32x4 s0[2], s1[2];
#pragma unroll
        for (int bj = 0; bj < 2; ++bj) { s0[bj] = *(const f32x4*)(scale + cb + bj * 128); s1[bj] = *(const f32x4*)(scale + cb + bj * 128 + 4); }
        EPI_ROWS_BEGIN
            bf16* rowp = Y2 + (size_t)(u.pm * 256 + rl) * 1024 + cb;
#pragma unroll
            for (int bj = 0; bj < 2; ++bj) { const f32x4 v0 = acc[ai][bj][m][0] * s0[bj], v1 = acc[ai][bj][m][1] * s1[bj];
                v4u w; w.x = pk2(v0[0], v0[1]); w.y = pk2(v0[2], v0[3]); w.z = pk2(v1[0], v1[1]); w.w = pk2(v1[2], v1[3]); *(v4u*)(rowp + bj * 128) = w; }
        EPI_ROWS_END
    }
};
template <int MODE, bool OUT8 = false> struct EpiMix { static constexpr bool PERM = true; bf16* OUT;
    int ldo; const void* AUX1; int ld1; const bf16* AUX2; int ld2;
    __device__ __forceinline__ void operator()(const AccT& acc, const Unit& u, int wr, int wc, int fr, int fq) const {
        const int cb = u.pn * 256 + wc * 32 + 8 * fq;
        EPI_ROWS_BEGIN
            const size_t row = (size_t)(u.pm * 256 + rl);
#pragma unroll
            for (int bj = 0; bj < 2; ++bj) { const f32x4 v0 = acc[ai][bj][m][0], v1 = acc[ai][bj][m][1];
                float x[8];
                if (MODE == 1) { const v4u a1 = *(const v4u*)((const bf16*)AUX1 + row * ld1 + cb + bj * 128);
                    x[0] = bflo(a1.x); x[1] = bfhi(a1.x); x[2] = bflo(a1.y); x[3] = bfhi(a1.y); x[4] = bflo(a1.z); x[5] = bfhi(a1.z); x[6] = bflo(a1.w); x[7] = bfhi(a1.w); }
                else { const v2u a1 = *(const v2u*)((const unsigned char*)AUX1 + row * ld1 + cb + bj * 128); const float k = 1.0f / 255.0f;
                    x[0] = (float)(a1.x & 0xffu) * k; x[1] = (float)((a1.x >> 8) & 0xffu) * k; x[2] = (float)((a1.x >> 16) & 0xffu) * k; x[3] = (float)(a1.x >> 24) * k;
                    x[4] = (float)(a1.y & 0xffu) * k; x[5] = (float)((a1.y >> 8) & 0xffu) * k; x[6] = (float)((a1.y >> 16) & 0xffu) * k; x[7] = (float)(a1.y >> 24) * k; }
                float o[8];
                if (MODE == 0 || MODE == 1) {
#pragma unroll
                    for (int j = 0; j < 4; ++j) { o[j] = x[j] * v0[j]; o[4 + j] = x[4 + j] * v1[j]; } }
                else { const v4u a2 = *(const v4u*)(AUX2 + row * ld2 + cb + bj * 128);
                    const float y[8] = {bflo(a2.x), bfhi(a2.x), bflo(a2.y), bfhi(a2.y), bflo(a2.z), bfhi(a2.z), bflo(a2.w), bfhi(a2.w)};
#pragma unroll
                    for (int j = 0; j < 4; ++j) { o[j] = y[j] + x[j] * v0[j]; o[4 + j] = y[4 + j] + x[4 + j] * v1[j]; } }
                if (OUT8) { v2u w; w.x = pk8(8.0f * o[0], 8.0f * o[1], 8.0f * o[2], 8.0f * o[3]); w.y = pk8(8.0f * o[4], 8.0f * o[5], 8.0f * o[6], 8.0f * o[7]); *(v2u*)((unsigned char*)OUT + row * ldo + cb + bj * 128) = w; }
                else { v4u w; w.x = pk2(o[0], o[1]); w.y = pk2(o[2], o[3]); w.z = pk2(o[4], o[5]); w.w = pk2(o[6], o[7]);
                *(v4u*)(OUT + row * ldo + cb + bj * 128) = w; } }
        EPI_ROWS_END
    }
};
struct EpiX1 { static constexpr bool PERM = true; const float* X; bf16* OUT; const float* MOD;
    __device__ __forceinline__ void operator()(const AccT& acc, const Unit& u, int wr, int wc, int fr, int fq) const {
        const int b = u.pm >> 4;
        const int cb = u.pn * 256 + wc * 32 + 8 * fq; const float* g = MOD + (size_t)b * 12288 + 4096 + cb;
        f32x4 gv[2][2];
#pragma unroll
        for (int bj = 0; bj < 2; ++bj)
#pragma unroll
            for (int n = 0; n < 2; ++n) gv[bj][n] = *(const f32x4*)(g + bj * 128 + n * 4);
        EPI_ROWS_BEGIN
            const size_t off = (size_t)(u.pm * 256 + rl) * D + cb;
#pragma unroll
            for (int bj = 0; bj < 2; ++bj) { const f32x4 x0 = *(const f32x4*)(X + off + bj * 128), x1 = *(const f32x4*)(X + off + bj * 128 + 4);
                const f32x4 v0 = x0 + gv[bj][0] * acc[ai][bj][m][0], v1 = x1 + gv[bj][1] * acc[ai][bj][m][1];
                v4u w; w.x = pk2(v0[0], v0[1]); w.y = pk2(v0[2], v0[3]); w.z = pk2(v1[0], v1[1]); w.w = pk2(v1[2], v1[3]); *(v4u*)(OUT + off + bj * 128) = w; }
        EPI_ROWS_END
    }
};
constexpr float ACT_F8SCALE = 8.0f;
struct EpiAct { static constexpr bool PERM = true; unsigned char* ACT;
    __device__ __forceinline__ void operator()(const AccT& acc, const Unit& u, int wr, int wc, int fr, int fq) const {
        EPI_ROWS_BEGIN
            const f32x4 g0 = acc[ai][0][m][0], g1 = acc[ai][0][m][1], u0 = acc[ai][1][m][0], u1 = acc[ai][1][m][1];
            float o[8];
#pragma unroll
            for (int j = 0; j < 4; ++j) { o[j] = __builtin_amdgcn_fmed3f(ACT_F8SCALE * g0[j] * sigmoidf_(g0[j]) * u0[j], -440.f, 440.f); o[4 + j] = __builtin_amdgcn_fmed3f(ACT_F8SCALE * g1[j] * sigmoidf_(g1[j]) * u1[j], -440.f, 440.f); }
            v2u w; w.x = pk8(o[0], o[1], o[2], o[3]); w.y = pk8(o[4], o[5], o[6], o[7]);
            *(v2u*)(ACT + (size_t)(u.pm * 256 + rl) * DEXP + u.pn * 128 + wc * 32 + 8 * fq) = w;
        EPI_ROWS_END
    }
};
constexpr float YP_SCALE = 8.0f;
struct EpiDown { static constexpr bool PERM = true, PERM16 = true; unsigned char* YP;
    __device__ __forceinline__ void operator()(const AccT& acc, const Unit& u, int wr, int wc, int fr, int fq) const {
        const int cb = u.pn * 256 + wc * 64 + 16 * fq;
        EPI_ROWS_BEGIN
            int p[4];
#pragma unroll
            for (int bj = 0; bj < 2; ++bj) { const f32x4 v0 = acc[ai][bj][m][0] * YP_SCALE, v1 = acc[ai][bj][m][1] * YP_SCALE;
                int p0 = __builtin_amdgcn_cvt_pk_fp8_f32(v0[0], v0[1], 0, false); p0 = __builtin_amdgcn_cvt_pk_fp8_f32(v0[2], v0[3], p0, true);
                int p1 = __builtin_amdgcn_cvt_pk_fp8_f32(v1[0], v1[1], 0, false); p1 = __builtin_amdgcn_cvt_pk_fp8_f32(v1[2], v1[3], p1, true);
                p[2 * bj] = p0; p[2 * bj + 1] = p1; }
            v4u w; w.x = (unsigned)p[0]; w.y = (unsigned)p[1]; w.z = (unsigned)p[2]; w.w = (unsigned)p[3];
            *(v4u*)(YP + (size_t)(u.pm * 256 + rl) * D + cb) = w;
        EPI_ROWS_END
    }
};
struct Frame {
    LAS unsigned char* lds;
    volatile LAS unsigned* MISC;
    unsigned* ctl;
    int tid, lane, wave, vcu, G;
    unsigned char* ws;
};
struct Args { const float* in[34]; float* out; unsigned char* ws; int ph_lo, ph_hi; };
enum { I_X = 0, I_C, I_CTX, I_CCTX, I_N1G, I_N2G, I_ADAW, I_ADAB, I_WIN, I_MU, I_POOLW, I_POOLS, I_WPO, I_DW0, I_DW2, I_IA0, I_IA2, I_G2, I_KK, I_KA, I_RK, I_LNW, I_LNB,
       I_WRO, I_WO, I_RW, I_RB, I_EG, I_EU, I_ED, I_SG, I_SU, I_SD, I_FG };

struct TrJob { const float* src; bf16* dst; int ldw, kvalid, ldt, k0, n0, drow0; float f8; };
template <bool NT = false> __device__ __forceinline__ void tr_load(const TrJob& j, f32x4 (&v)[16], int lane) {
    const int r2 = lane >> 4, c4 = lane & 15;
#pragma unroll
    for (int i = 0; i < 8; ++i) {
#pragma unroll
        for (int h = 0; h < 2; ++h) { const int k = j.k0 + 8 * i + 2 * r2 + h; const int kc = k < j.kvalid ? k : 0;
            const f32x4* sp_ = (const f32x4*)(j.src + (size_t)kc * j.ldw + j.n0 + 4 * c4); const f32x4 x = NT ? __builtin_nontemporal_load(sp_) : *sp_; v[2 * i + h] = (k < j.kvalid) ? x : (f32x4){0.f, 0.f, 0.f, 0.f}; } }
}
template <bool NT = false> __device__ __forceinline__ void tr_store(const TrJob& j, const f32x4 (&v)[16], LAS unsigned* P, int lane) {
    const int r2 = lane >> 4, c4 = lane & 15;
#pragma unroll
    for (int i = 0; i < 8; ++i) { LAS unsigned* p = P + (4 * i + r2) * 65 + 4 * c4;
        p[0] = pk2(v[2 * i].x, v[2 * i + 1].x); p[1] = pk2(v[2 * i].y, v[2 * i + 1].y); p[2] = pk2(v[2 * i].z, v[2 * i + 1].z); p[3] = pk2(v[2 * i].w, v[2 * i + 1].w); }
    LDS_WAIT(); asm volatile("" ::: "memory");
    const int nl = lane >> 3, q = lane & 7;
#pragma unroll
    for (int jj = 0; jj < 8; ++jj) { const int n = 8 * jj + nl; const LAS unsigned* s = P + (4 * q) * 65 + n;
        v4u o; o.x = s[0]; o.y = s[65]; o.z = s[130]; o.w = s[195];
        v4u* dp_ = (v4u*)(j.dst + (size_t)(j.drow0 + n) * j.ldt + j.k0 + 8 * q); if (NT) __builtin_nontemporal_store(o, dp_); else *dp_ = o; }
    LDS_WAIT(); asm volatile("" ::: "memory");
}
template <bool NT = false> __device__ __forceinline__ void tr8_load(const TrJob& j, int half, f32x4 (&v)[16], int lane) {
    const int r2 = lane >> 4, c4 = lane & 15;
#pragma unroll
    for (int i = 0; i < 4; ++i) {
#pragma unroll
        for (int h = 0; h < 4; ++h) { const int k = j.k0 + 64 * half + 16 * i + 4 * r2 + h; const f32x4* sp_ = (const f32x4*)(j.src + (size_t)k * j.ldw + j.n0 + 4 * c4); v[4 * i + h] = NT ? __builtin_nontemporal_load(sp_) : *sp_; } }
}
__device__ __forceinline__ void tr8_lds(const TrJob& j, int half, const f32x4 (&v)[16], LAS unsigned* P, int lane) {
    const int r2 = lane >> 4, c4 = lane & 15; const float sc = j.f8;
#pragma unroll
    for (int i = 0; i < 4; ++i) { LAS unsigned* p = P + (16 * half + 4 * i + r2) * 65 + 4 * c4;
        p[0] = pk8(sc * v[4 * i].x, sc * v[4 * i + 1].x, sc * v[4 * i + 2].x, sc * v[4 * i + 3].x); p[1] = pk8(sc * v[4 * i].y, sc * v[4 * i + 1].y, sc * v[4 * i + 2].y, sc * v[4 * i + 3].y);
        p[2] = pk8(sc * v[4 * i].z, sc * v[4 * i + 1].z, sc * v[4 * i + 2].z, sc * v[4 * i + 3].z); p[3] = pk8(sc * v[4 * i].w, sc * v[4 * i + 1].w, sc * v[4 * i + 2].w, sc * v[4 * i + 3].w); }
}
template <bool NT = false> __device__ __forceinline__ void tr8_flush(const TrJob& j, LAS unsigned* P, int lane) {
    LDS_WAIT(); asm volatile("" ::: "memory");
    const int nl = lane >> 3, q = lane & 7;
#pragma unroll
    for (int jj = 0; jj < 8; ++jj) { const int n = 8 * jj + nl; const LAS unsigned* s = P + (4 * q) * 65 + n;
        v4u o; o.x = s[0]; o.y = s[65]; o.z = s[130]; o.w = s[195];
        v4u* dp_ = (v4u*)((unsigned char*)j.dst + (size_t)(j.drow0 + n) * j.ldt + j.k0 + 16 * q); if (NT) __builtin_nontemporal_store(o, dp_); else *dp_ = o; }
    LDS_WAIT(); asm volatile("" ::: "memory");
}
template <class Dec> __device__ __forceinline__ void tr_run8(const Dec& dec, int first, int stride, LAS unsigned* P, int lane) {
    TrJob j, jn; f32x4 va[16], vb[16];
    int it = first; bool h = dec(it, j); if (h) { tr8_load(j, 0, va, lane); tr8_load(j, 1, vb, lane); }
    while (h) {
        tr8_lds(j, 0, va, P, lane); tr8_lds(j, 1, vb, P, lane);
        it += stride; const bool hn = dec(it, jn); if (hn) { tr8_load(jn, 0, va, lane); tr8_load(jn, 1, vb, lane); }
        tr8_flush(j, P, lane);
        j = jn; h = hn;
    }
}
template <class Dec> __device__ __forceinline__ void tr_run(const Dec& dec, int first, int stride, LAS unsigned* P, int lane) {
    TrJob ja, jb; f32x4 va[16], vb[16];
    int it = first; bool ha = dec(it, ja); if (ha) tr_load(ja, va, lane);
    while (ha) {
        it += stride; const bool hb = dec(it, jb); if (hb) tr_load(jb, vb, lane);
        tr_store(ja, va, P, lane);
        if (!hb) break;
        it += stride; ha = dec(it, ja); if (ha) tr_load(ja, va, lane);
        tr_store(jb, vb, P, lane);
    }
}
__device__ __forceinline__ void p0_prologue(Frame& F, const Args& a) {
    {
        LAS float* sv = (LAS float*)F.lds;
        LAS float* part = (LAS float*)(F.lds + 40960);
        bool did = false;
        for (int cb = blockIdx.x; cb < 192; cb += F.G) {
            if (!did) { for (int idx = F.tid; idx < 5 * D; idx += 512) { const int j = idx >> 11, k = idx & 2047; const float v = (j < 4) ? a.in[I_C][j * D + k] : a.in[I_CCTX][k]; sv[idx] = v / (1.0f + __expf(-v)); } did = true; }
            __syncthreads();
            const int col = 64 * cb + F.lane, k0 = 256 * F.wave; const float* wp = a.in[I_ADAW] + (size_t)k0 * 12288 + col;
            float acc[5] = {0.f, 0.f, 0.f, 0.f, 0.f};
#pragma unroll 32
            for (int k = 0; k < 256; ++k) { const float w = wp[(size_t)k * 12288];
#pragma unroll
                for (int j = 0; j < 5; ++j) acc[j] += sv[j * D + k0 + k] * w; }
#pragma unroll
            for (int j = 0; j < 5; ++j) part[(F.wave * 5 + j) * 64 + F.lane] = acc[j];
            __syncthreads();
            if (F.tid < 320) { const int j = F.tid >> 6, l = F.tid & 63; float s = a.in[I_ADAB][64 * cb + l];
#pragma unroll
                for (int w = 0; w < 8; ++w) s += part[(w * 5 + j) * 64 + l];
                ((float*)(F.ws + WS_MOD))[j * 12288 + 64 * cb + l] = s; }
            __syncthreads();
        }
        __syncthreads();
    }
    {
        struct DecSmall { const float* const* in; unsigned char* ws;
            __device__ __forceinline__ bool operator()(int it, TrJob& j) const {
                constexpr int I_1 = P2_FP8 ? 0 : 32 * 186, I_2 = 4 * 16, I_3 = 16 * 32, I_4 = 4 * 32, I_5 = 32 * 32, I_6 = 32 * 32, I_7 = 4 * 2 * 32;
                int r = it; if (r < 0) return false;
                if (r < I_1) { const int kb = r / 186, nb = r % 186, n0 = nb * 64; j = TrJob{in[I_WIN], (bf16*)(ws + WS_WIN), DIN, D, D, kb * 64, n0, n0 + (n0 >= 7808 ? 128 : 0)}; return true; } r -= I_1;
                if (r < I_2) { const int g = r / 16, q = r % 16; j = TrJob{in[I_POOLW] + (size_t)g * 65536, (bf16*)(ws + WS_POOLW) + (size_t)g * 65536, 256, 256, 256, (q / 4) * 64, (q % 4) * 64, (q % 4) * 64}; return true; } r -= I_2;
                if (r < I_3) { j = TrJob{in[I_WPO], (bf16*)(ws + WS_WPO), D, 1024, 1024, (r / 32) * 64, (r % 32) * 64, (r % 32) * 64}; return true; } r -= I_3;
                if (r < I_4) { j = TrJob{in[I_G2], (bf16*)(ws + WS_G2), D, 256, 256, (r / 32) * 64, (r % 32) * 64, (r % 32) * 64}; return true; } r -= I_4;
                if (r < I_5) { j = TrJob{in[I_WRO], (bf16*)(ws + WS_WRO), D, D, D, (r / 32) * 64, (r % 32) * 64, (r % 32) * 64}; return true; } r -= I_5;
                if (r < I_6) { j = TrJob{in[I_WO], (bf16*)(ws + WS_WO), D, D, D, (r / 32) * 64, (r % 32) * 64, (r % 32) * 64}; return true; } r -= I_6;
                if (r < I_7) { const int mtx = r / 64, q = r % 64;
                    const float* src = (mtx < 2 ? in[I_DW2] + (size_t)mtx * 96 * D : in[I_IA2] + (size_t)(mtx - 2) * 96 * D);
                    j = TrJob{src, (bf16*)(ws + WS_LORA) + (size_t)mtx * D * 128, D, 96, 128, (q / 32) * 64, (q % 32) * 64, (q % 32) * 64}; return true; }
                return false; } };
        DecSmall dec{a.in, F.ws};
        tr_run(dec, F.vcu * 8 + F.wave, F.G * 8, (LAS unsigned*)(F.lds + F.wave * 16384), F.lane);
        if (P2_FP8) {
            struct DecWin8 { const float* const* in; unsigned char* ws;
                __device__ __forceinline__ bool operator()(int it, TrJob& j) const {
                    if (it < 0 || it >= 16 * 186) return false;
                    const int kb = it / 186, nb = it % 186, n0 = nb * 64; j = TrJob{in[I_WIN], (bf16*)(ws + WS_WIN), DIN, D, D, kb * 128, n0, n0 + (n0 >= 7808 ? 128 : 0), 8.0f}; return true; } };
            DecWin8 dw{a.in, F.ws};
            tr_run8(dw, F.vcu * 8 + F.wave, F.G * 8, (LAS unsigned*)(F.lds + F.wave * 16384), F.lane);
        }
    }
    const int gt = F.vcu * 512 + F.tid, NGT = F.G * 512;
    { v4u* z = (v4u*)(F.ws + WS_WIN + (size_t)7808 * D * (P2_FP8 ? 1 : 2)); for (int i = gt; i < 128 * D / (P2_FP8 ? 16 : 8); i += NGT) z[i] = (v4u){0u, 0u, 0u, 0u}; }
    { int* tok = (int*)(F.ws + WS_TOK); for (int i = gt; i < NSLOT; i += NGT) tok[i] = 0; }
}

__device__ __forceinline__ void p1_norm1(Frame& F, const Args& a) {
    const int gw = F.vcu * 8 + F.wave, NGW = F.G * 8; const float* MOD = (const float*)(F.ws + WS_MOD); bf16* HA = (bf16*)(F.ws + WS_HA);
    for (int mrow = gw; mrow < MT; mrow += NGW) {
        const float* src = (mrow < NT) ? a.in[I_X] + (size_t)mrow * D : a.in[I_CTX] + (size_t)(mrow - NT) * D; const int j = (mrow < NT) ? (mrow >> 12) : 4;
        const f32x4* xr = (const f32x4*)src + F.lane; f32x4 v[8]; float s = 0.f;
#pragma unroll
        for (int q = 0; q < 8; ++q) { v[q] = xr[64 * q]; s += (v[q].x * v[q].x + v[q].y * v[q].y) + (v[q].z * v[q].z + v[q].w * v[q].w); }
        const float rstd = 1.0f / sqrtf(wave_sum(s) * (1.0f / D) + 1e-6f);
        const f32x4* g = (const f32x4*)a.in[I_N1G] + F.lane; const f32x4* sh = (const f32x4*)(MOD + (size_t)j * 12288) + F.lane; const f32x4* sc = (const f32x4*)(MOD + (size_t)j * 12288 + 2048) + F.lane;
        v2u* o = (v2u*)(HA + (size_t)mrow * D) + F.lane; unsigned* o8 = (unsigned*)((unsigned char*)HA + (size_t)mrow * D) + F.lane;
#pragma unroll
        for (int q = 0; q < 8; ++q) { const f32x4 y = v[q] * rstd * g[64 * q] * (sc[64 * q] + 1.0f) + sh[64 * q];
            if (P2_FP8) o8[64 * q] = pk8(8.0f * y.x, 8.0f * y.y, 8.0f * y.z, 8.0f * y.w); else { v2u w; w.x = pk2(y.x, y.y); w.y = pk2(y.z, y.w); o[64 * q] = w; } }
    }
}

template <int W> __device__ __forceinline__ void pool_item(const unsigned* U32, unsigned* DP32, int m0, int cp) {
    unsigned raw[64];
#pragma unroll
    for (int x = 0; x < 64; ++x) raw[x] = U32[(size_t)(m0 + x) * 512 + cp];
    float lo[64], hi[64];
#pragma unroll
    for (int x = 0; x < 64; ++x) { lo[x] = bflo(raw[x]); hi[x] = bfhi(raw[x]); }
#pragma unroll
    for (int x = 0; x < 64; ++x) { const int l = (x - W / 2) < 0 ? 0 : (x - W / 2), h = (x + W / 2) > 64 ? 64 : (x + W / 2); float s0 = 0.f, s1 = 0.f;
#pragma unroll
        for (int j = l; j < h; ++j) { s0 += lo[j]; s1 += hi[j]; }
        const float inv = 1.0f / (float)(h - l); DP32[(size_t)(m0 + x) * 512 + cp] = pk2(s0 * inv - lo[x], s1 * inv - hi[x]); }
}
__device__ __forceinline__ void p3_mix_store(const v4u o, const v4u nb, const f32x4 m0, const f32x4 m1, int c0, int mrow, bf16* RM, bf16* KM, bf16* VM, bf16* LIN) {
    float r[8];
    { const float ov[8] = {bflo(o.x), bfhi(o.x), bflo(o.y), bfhi(o.y), bflo(o.z), bfhi(o.z), bflo(o.w), bfhi(o.w)};
      const float nv[8] = {bflo(nb.x), bfhi(nb.x), bflo(nb.y), bfhi(nb.y), bflo(nb.z), bfhi(nb.z), bflo(nb.w), bfhi(nb.w)};
      const float mv[8] = {m0.x, m0.y, m0.z, m0.w, m1.x, m1.y, m1.z, m1.w};
#pragma unroll
      for (int e = 0; e < 8; ++e) r[e] = ov[e] + (nv[e] - ov[e]) * mv[e]; }
    bf16* dstp;
    if (c0 < 2048) dstp = RM + (size_t)mrow * D + c0;
    else if (c0 < 4096) dstp = KM + (size_t)mrow * D + (c0 - 2048);
    else if (c0 < 6144) dstp = VM + (size_t)mrow * D + (c0 - 4096);
    else { const int lc = c0 - 6144; int dc;
        if (lc < 192) {
#pragma unroll
            for (int e = 0; e < 8; ++e) r[e] = tanhf_(r[e]);
            dc = (lc < 96) ? lc : 128 + (lc - 96); }
        else if (lc < 384) dc = (lc < 288) ? 256 + (lc - 192) : 384 + (lc - 288);
        else {
#pragma unroll
            for (int e = 0; e < 8; ++e) r[e] = sigmoidf_(r[e]);
            dc = 512 + (lc - 384); }
        dstp = LIN + (size_t)mrow * LINLD + dc; }
    v4u w; w.x = pk2(r[0], r[1]); w.y = pk2(r[2], r[3]); w.z = pk2(r[4], r[5]); w.w = pk2(r[6], r[7]); *(v4u*)dstp = w;
}
constexpr int P3_SLICE = 512, P3_NSLICE = (DSH + P3_SLICE - 1) / P3_SLICE  , P3_SLOTS = 96;
__device__ __forceinline__ void p3_prep(Frame& F, const Args& a) {
    const bf16* SLAB = (const bf16*)(F.ws + WS_SLAB); const float* mu = a.in[I_MU];
    bf16* RM = (bf16*)(F.ws + WS_RM); bf16* KM = (bf16*)(F.ws + WS_KM); bf16* VM = (bf16*)(F.ws + WS_VM); bf16* LIN = (bf16*)(F.ws + WS_LIN);
    LAS unsigned char* T = F.lds;
    const int w = F.wave, lane = F.lane;
    for (int pid = F.vcu; pid < NB * 64; pid += F.G) {
        const int b = pid >> 6, py = (pid >> 3) & 7, px = pid & 7; const int m00 = b * TSEQ + (py * 8) * 64 + px * 8;
        int srow[12];
#pragma unroll
        for (int i = 0; i < 12; ++i) { const int sl = w * 12 + i; int gyl, gxl; bool ok = true;
            if (sl < 64) { gyl = sl >> 3; gxl = sl & 7; } else if (sl < 72) { gyl = -1; gxl = sl - 64; ok = py > 0; } else if (sl < 80) { gyl = 8; gxl = sl - 72; ok = py < 7; }
            else if (sl < 88) { gyl = sl - 80; gxl = -1; ok = px > 0; } else { gyl = sl - 88; gxl = 8; ok = px < 7; }
            srow[i] = ok ? m00 + gyl * 64 + gxl : m00; }
        v4u pre[12];
        { const int cl = lane * 8;
#pragma unroll
          for (int i = 0; i < 12; ++i) pre[i] = *(const v4u*)(SLAB + (size_t)srow[i] * SLABLD + cl); }
        for (int sl_ = 0; sl_ < P3_NSLICE; ++sl_) {
            const int c0 = sl_ * P3_SLICE + lane * 8; const bool cok = c0 < DSH;
            __syncthreads();
#pragma unroll
            for (int i = 0; i < 12; ++i) *(LAS v4u*)(T + (w * 12 + i) * 1024 + lane * 16) = pre[i];
            if (sl_ + 1 < P3_NSLICE) { const int cn = (sl_ + 1) * P3_SLICE + lane * 8; const int cl = cn < DSH ? cn : 0;
#pragma unroll
                for (int i = 0; i < 12; ++i) pre[i] = *(const v4u*)(SLAB + (size_t)srow[i] * SLABLD + cl); }
            __syncthreads();
            const f32x4 m0 = *(const f32x4*)(mu + (cok ? c0 : 0)), m1 = *(const f32x4*)(mu + (cok ? c0 : 0) + 4);
            const int gy = py * 8 + w; const unsigned k2m = gy > 0 ? 0xffffu : 0u, k3m = gy < 63 ? 0xffff0000u : 0u;
#pragma unroll
            for (int x = 0; x < 8; ++x) {
                const int gx = px * 8 + x; const unsigned k0m = gx > 0 ? 0xffffu : 0u, k1m = gx < 63 ? 0xffff0000u : 0u;
                const int so = w * 8 + x, sL = x > 0 ? so - 1 : 80 + w, sR = x < 7 ? so + 1 : 88 + w, sU = w > 0 ? so - 8 : 64 + x, sD = w < 7 ? so + 8 : 72 + x;
                const v4u o = *(const LAS v4u*)(T + so * 1024 + lane * 16), n0 = *(const LAS v4u*)(T + sL * 1024 + lane * 16), n1 = *(const LAS v4u*)(T + sR * 1024 + lane * 16),
                          n2 = *(const LAS v4u*)(T + sU * 1024 + lane * 16), n3 = *(const LAS v4u*)(T + sD * 1024 + lane * 16);
                v4u nb; nb.x = (n0.x & k0m) | (n1.x & k1m); nb.y = (n2.y & k2m) | (n3.y & k3m); nb.z = (n0.z & k0m) | (n1.z & k1m); nb.w = (n2.w & k2m) | (n3.w & k3m);
                const int mrow = m00 + w * 64 + x;
                if (cok) p3_mix_store(o, nb, m0, m1, c0, mrow, RM, KM, VM, LIN);
                if (sl_ == P3_NSLICE - 1 && lane >= 48) { const int l16 = lane - 48, p = l16 >> 2, off = (l16 & 3) * 8; *(v4u*)(LIN + (size_t)mrow * LINLD + 128 * p + 96 + off) = (v4u){0u, 0u, 0u, 0u}; }
            }
        }
        __syncthreads();
    }
    const int gw = F.vcu * 8 + F.wave, NGW = F.G * 8;
    for (int mrow = NT + gw; mrow < MT; mrow += NGW) {
        const bf16* own = SLAB + (size_t)mrow * SLABLD; const int sidx = (mrow - NT) & 255; const bool v0 = sidx > 0, v1 = sidx < 255;
        const bf16* p0 = v0 ? own - SLABLD : own; const bf16* p1 = v1 ? own + SLABLD : own;
        const unsigned k0m = v0 ? 0xffffu : 0u, k1m = v1 ? 0xffff0000u : 0u;
        for (int ci0 = F.lane; ci0 < DSH / 8; ci0 += 256) {
            v4u o[4], nb[4]; f32x4 m0[4], m1[4];
#pragma unroll
            for (int u = 0; u < 4; ++u) { const int ci = ci0 + 64 * u; const int c0 = (ci < DSH / 8 ? ci : F.lane) * 8;
                o[u] = *(const v4u*)(own + c0); const v4u n0 = *(const v4u*)(p0 + c0), n1 = *(const v4u*)(p1 + c0);
                nb[u].x = (n0.x & k0m) | (n1.x & k1m); nb[u].y = (n0.y & k0m) | (n1.y & k1m); nb[u].z = (n0.z & k0m) | (n1.z & k1m); nb[u].w = (n0.w & k0m) | (n1.w & k1m);
                m0[u] = *(const f32x4*)(mu + c0); m1[u] = *(const f32x4*)(mu + c0 + 4); }
#pragma unroll
            for (int u = 0; u < 4; ++u) { const int ci = ci0 + 64 * u; if (ci < DSH / 8) p3_mix_store(o[u], nb[u], m0[u], m1[u], ci * 8, mrow, RM, KM, VM, LIN); }
        }
        if (F.lane < 16) { const int p = F.lane >> 2, off = (F.lane & 3) * 8; *(v4u*)(LIN + (size_t)mrow * LINLD + 128 * p + 96 + off) = (v4u){0u, 0u, 0u, 0u}; }
    }
    const unsigned* U32 = (const unsigned*)(F.ws + WS_U); unsigned* DP32 = (unsigned*)(F.ws + WS_DP);
    for (int gr = F.vcu; gr < 256; gr += F.G) {
        const int m0 = gr * 64, cp = F.tid; const int g = F.wave >> 1;
        if (g == 0) pool_item<2>(U32, DP32, m0, cp); else if (g == 1) pool_item<4>(U32, DP32, m0, cp); else if (g == 2) pool_item<8>(U32, DP32, m0, cp); else pool_item<16>(U32, DP32, m0, cp);
    }
}

constexpr int CK = 16, NSL = 8;
constexpr int SL_Z = 0, SL_AF = 2560, SL_TMT = 3584, SL_ABF = 4096, SL_TM = 4608, SL_ZTT = 5120, SL_RT = 7680, SL_CRT = 9728, SL_ART = 10240, SL_BGT = 10752, SL_KGT = 12800, SL_VT = 14848, SL_GC = 16896,
              SL_SIZE = 17152, ZTT_LD = 80, SB_OFF = 7 * SL_SIZE  , SL7_OFF = 132096  ;
static_assert(SB_OFF + 8192 <= 131072 && SL7_OFF + SL_SIZE <= 163840, "scan LDS map");
__device__ __forceinline__ int kpos(int zt, int q) { return 32 * (zt >> 1) + 8 * q + 4 * (zt & 1); }
__device__ __forceinline__ int slot_off(int n) { return n < 7 ? n * SL_SIZE : SL7_OFF; }
__device__ __forceinline__ int sw64(int row, int col) { return (row * 64 + ((((col >> 3) ^ (row & 7)) << 3) | (col & 7))) * 2; }
__device__ __forceinline__ int scan_row(int n, int b, int dir) {
    if (n < CTXL) return NT + b * CTXL + (dir ? (CTXL - 1 - n) : n);
    const int t = n - CTXL; return b * TSEQ + (dir ? (TSEQ - 1 - t) : t);
}
__device__ __forceinline__ bf16x8 frag_ld(const LAS unsigned char* p, bool ok) { v4u z = (v4u){0u, 0u, 0u, 0u}; if (ok) z = *(const LAS v4u*)p; return __builtin_bit_cast(bf16x8, z); }
__device__ __forceinline__ f32x4 mfma16(bf16x8 a, bf16x8 b, f32x4 c) { return __builtin_amdgcn_mfma_f32_16x16x32_bf16(a, b, c, 0, 0, 0); }
__device__ __forceinline__ float dpp_shr(float v, const int n, float fill) {
    const int x = __builtin_bit_cast(int, v), f = __builtin_bit_cast(int, fill); int r;
    if (n == 1) r = __builtin_amdgcn_update_dpp(f, x, 0x111, 0xF, 0xF, false); else if (n == 2) r = __builtin_amdgcn_update_dpp(f, x, 0x112, 0xF, 0xF, false);
    else if (n == 4) r = __builtin_amdgcn_update_dpp(f, x, 0x114, 0xF, 0xF, false); else r = __builtin_amdgcn_update_dpp(f, x, 0x118, 0xF, 0xF, false);
    return __builtin_bit_cast(float, r);
}
struct SeqOps { bf16x8 fV, fZc, fZk[2], fR[2], fCr, fAr4, fKG[4], fBG4[4]; f32x4 gc[4]; };
__device__ __forceinline__ bf16x8 frag4_ld(const LAS unsigned char* p) { const v2u t = *(const LAS v2u*)p; v4u z; z.x = t.x; z.y = t.y; z.z = 0u; z.w = 0u; return __builtin_bit_cast(bf16x8, z); }
__device__ __forceinline__ void seq_load(SeqOps& o, const LAS unsigned char* SL, int w, int c, int q, bool klo) {
    o.fV = frag_ld(SL + SL_VT + ((16 * w + c) * 16 + 8 * q) * 2, klo);
    o.fZc = frag_ld(SL + SL_ZTT + (c * ZTT_LD + 64 + 8 * q) * 2, klo); o.fCr = frag_ld(SL + SL_CRT + (c * 16 + 8 * q) * 2, klo); o.fAr4 = frag4_ld(SL + SL_ART + (c * 16 + 4 * q) * 2);
#pragma unroll
    for (int ks = 0; ks < 2; ++ks) { o.fZk[ks] = frag_ld(SL + SL_ZTT + (c * ZTT_LD + 32 * ks + 8 * q) * 2, true); o.fR[ks] = frag_ld(SL + SL_RT + sw64(c, 32 * ks + 8 * q), true); }
#pragma unroll
    for (int jt = 0; jt < 4; ++jt) { o.fKG[jt] = frag_ld(SL + SL_KGT + ((16 * jt + c) * 16 + 8 * q) * 2, klo); o.fBG4[jt] = frag4_ld(SL + SL_BGT + ((16 * jt + c) * 16 + 4 * q) * 2);
        o.gc[jt] = *(const LAS f32x4*)(SL + SL_GC + (16 * jt + 4 * q) * 4); }
}
__device__ __forceinline__ void seq_step(const SeqOps& o, f32x4 (&X)[4], bool emit, bf16* YO, int chunk, int b, int dir, int h, int w, int c, int q) {
    const f32x4 z4 = (f32x4){0.f, 0.f, 0.f, 0.f};
    bf16x8 fS[2];
#pragma unroll
    for (int ks = 0; ks < 2; ++ks) { v4u p; p.x = pk2(X[2 * ks][0], X[2 * ks][1]); p.y = pk2(X[2 * ks][2], X[2 * ks][3]); p.z = pk2(X[2 * ks + 1][0], X[2 * ks + 1][1]); p.w = pk2(X[2 * ks + 1][2], X[2 * ks + 1][3]);
        fS[ks] = __builtin_bit_cast(bf16x8, p); }
    f32x4 un = mfma16(o.fZc, o.fV, z4);
#pragma unroll
    for (int ks = 0; ks < 2; ++ks) un = mfma16(o.fZk[ks], fS[ks], un);
    bf16x8 fU; { v4u p; p.x = pk2(un[0], un[1]); p.y = pk2(un[2], un[3]); p.z = 0u; p.w = 0u; fU = __builtin_bit_cast(bf16x8, p); }
    if (emit) {
        f32x4 y = mfma16(o.fCr, o.fV, z4); y = mfma16(o.fAr4, fU, y);
#pragma unroll
        for (int ks = 0; ks < 2; ++ks) y = mfma16(o.fR[ks], fS[ks], y);
#pragma unroll
        for (int g = 0; g < 4; ++g) YO[(size_t)scan_row(chunk * CK + 4 * q + g, b, dir) * D + h * 64 + 16 * w + c] = (bf16)f2bf(y[g]);
    }
#pragma unroll
    for (int jt = 0; jt < 4; ++jt) { const f32x4 d = mfma16(o.fBG4[jt], fU, mfma16(o.fKG[jt], o.fV, z4));
        X[jt] = X[jt] * o.gc[jt] + d; }
}
struct ScanRaw { v4u r[2], k[2], v[2], e[2]; v2u a[2]; };
__device__ __forceinline__ void scan_fetch(ScanRaw& R, const bf16* RM, const bf16* KM, const bf16* VM, const unsigned char* AX, const unsigned short* EX, size_t rowoff) {
#pragma unroll
    for (int ks = 0; ks < 2; ++ks) { const size_t off = rowoff + 32 * ks; R.r[ks] = *(const v4u*)(RM + off); R.k[ks] = *(const v4u*)(KM + off); R.v[ks] = *(const v4u*)(VM + off); R.a[ks] = *(const v2u*)(AX + off); R.e[ks] = *(const v4u*)(EX + off); }
}
__device__ __forceinline__ void p6_scan(Frame& F, const Args& a) {
    const bf16* RM = (const bf16*)(F.ws + WS_RM); const bf16* KM = (const bf16*)(F.ws + WS_KM); const bf16* VM = (const bf16*)(F.ws + WS_VM);
    const int lane = F.lane, w = F.wave, c0_ = lane & 15, q0_ = lane >> 4;
    for (int unit = blockIdx.x; unit < NB * NH * 2; unit += F.G) {
        const int dir = unit & 1, h = (unit >> 1) & 31, b = unit >> 6;
        const unsigned short* EX = (const unsigned short*)(F.ws + WS_EA + (size_t)dir * EA_STRIDE);
        const unsigned char* AX = (const unsigned char*)(F.ws + WS_EA + (size_t)(2 + dir) * EA_STRIDE);
        bf16* YO = (bf16*)(F.ws + (dir ? WS_YB : WS_YF)); float* BON = (float*)(F.ws + WS_BON) + (size_t)dir * NT * NH;
        f32x4 X[4];
#pragma unroll
        for (int jt = 0; jt < 4; ++jt) X[jt] = (f32x4){0.f, 0.f, 0.f, 0.f};
        constexpr int NBATCH = (CTXL + TSEQ) / CK / NSL;
        { LAS float* cst = (LAS float*)(F.lds + SB_OFF);
          if (F.tid < 192) { const int which = F.tid >> 6, j = F.tid & 63; cst[F.tid] = (which == 0 ? a.in[I_KK] : which == 1 ? a.in[I_KA] : a.in[I_RK])[h * 64 + j]; } }
        ScanRaw R; scan_fetch(R, RM, KM, VM, AX, EX, (size_t)scan_row(w * CK + c0_, b, dir) * D + h * 64 + 8 * q0_);
        __syncthreads();
        for (int bt = 0; bt < NBATCH; ++bt) {
            int c = c0_, q = q0_; asm volatile("" : "+v"(c), "+v"(q));
            const bool klo = q < 2;
            {
                LAS unsigned char* SL = F.lds + slot_off(w);
                int cq8 = 8 * q; asm volatile("" : "+v"(cq8));
                const LAS float* cst = (const LAS float*)(F.lds + SB_OFF) + cq8;
                float ss = 0.f;
#pragma unroll
                for (int ks = 0; ks < 2; ++ks) {
                    const f32x4 k0 = *(const LAS f32x4*)(cst + 32 * ks), k1 = *(const LAS f32x4*)(cst + 32 * ks + 4);
                    const float kv[8] = {bflo(R.k[ks].x), bfhi(R.k[ks].x), bflo(R.k[ks].y), bfhi(R.k[ks].y), bflo(R.k[ks].z), bfhi(R.k[ks].z), bflo(R.k[ks].w), bfhi(R.k[ks].w)};
#pragma unroll
                    for (int e = 0; e < 4; ++e) { const float p0 = kv[e] * k0[e], p1 = kv[4 + e] * k1[e]; ss += p0 * p0 + p1 * p1; } }
                ss += __shfl_xor(ss, 16); ss += __shfl_xor(ss, 32);
                const float inv = __builtin_amdgcn_rsqf(ss + 1e-12f);
                bf16x8 fKT[2], fRT[2], fBT[2], fKQ[2]; float bonp = 0.f;
#pragma unroll
                for (int ks = 0; ks < 2; ++ks) {
                    const v4u xr = R.r[ks], xk = R.k[ks], xv = R.v[ks], xe = R.e[ks]; const v2u xa = R.a[ks];
                    const f32x4 k0 = *(const LAS f32x4*)(cst + 32 * ks), k1 = *(const LAS f32x4*)(cst + 32 * ks + 4), a0 = *(const LAS f32x4*)(cst + 64 + 32 * ks), a1 = *(const LAS f32x4*)(cst + 64 + 32 * ks + 4);
                    const float kkw[8] = {k0[0], k0[1], k0[2], k0[3], k1[0], k1[1], k1[2], k1[3]}, kaw[8] = {a0[0], a0[1], a0[2], a0[3], a1[0], a1[1], a1[2], a1[3]};
                    const f32x4 q0 = *(const LAS f32x4*)(cst + 128 + 32 * ks), q1 = *(const LAS f32x4*)(cst + 128 + 32 * ks + 4); const float rkw[8] = {q0[0], q0[1], q0[2], q0[3], q1[0], q1[1], q1[2], q1[3]};
                    const float r[8] = {bflo(xr.x), bfhi(xr.x), bflo(xr.y), bfhi(xr.y), bflo(xr.z), bfhi(xr.z), bflo(xr.w), bfhi(xr.w)};
                    const float k[8] = {bflo(xk.x), bfhi(xk.x), bflo(xk.y), bfhi(xk.y), bflo(xk.z), bfhi(xk.z), bflo(xk.w), bfhi(xk.w)};
                    const float v[8] = {bflo(xv.x), bfhi(xv.x), bflo(xv.y), bfhi(xv.y), bflo(xv.z), bfhi(xv.z), bflo(xv.w), bfhi(xv.w)};
                    const float ku8 = 1.0f / 255.0f;
                    const float ai[8] = {(float)(xa.x & 0xffu) * ku8, (float)((xa.x >> 8) & 0xffu) * ku8, (float)((xa.x >> 16) & 0xffu) * ku8, (float)(xa.x >> 24) * ku8,
                                         (float)(xa.y & 0xffu) * ku8, (float)((xa.y >> 8) & 0xffu) * ku8, (float)((xa.y >> 16) & 0xffu) * ku8, (float)(xa.y >> 24) * ku8};
                    const float lw[8] = {hlo(xe.x), hhi(xe.x), hlo(xe.y), hhi(xe.y), hlo(xe.z), hhi(xe.z), hlo(xe.w), hhi(xe.w)};
                    float kt[8], rt[8], btl[8], kq[8], cl[8], G[8], Gi[8], Gm[8], GCv[8];
#pragma unroll
                    for (int e = 0; e < 8; ++e) cl[e] = lw[e];
#pragma unroll
                    for (int e = 0; e < 8; ++e) cl[e] += dpp_shr(cl[e], 1, 0.f);
#pragma unroll
                    for (int e = 0; e < 8; ++e) cl[e] += dpp_shr(cl[e], 2, 0.f);
#pragma unroll
                    for (int e = 0; e < 8; ++e) cl[e] += dpp_shr(cl[e], 4, 0.f);
#pragma unroll
                    for (int e = 0; e < 8; ++e) cl[e] += dpp_shr(cl[e], 8, 0.f);
#pragma unroll
                    for (int e = 0; e < 8; ++e) { G[e] = __builtin_amdgcn_exp2f(cl[e]); Gi[e] = __builtin_amdgcn_exp2f(-cl[e]); }
#pragma unroll
                    for (int e = 0; e < 8; ++e) { Gm[e] = dpp_shr(G[e], 1, 1.0f); GCv[e] = __shfl(G[e], (lane & 48) | 15); }
#pragma unroll
                    for (int e = 0; e < 8; ++e) {
                        const float kke = k[e] * kkw[e] * inv, kd = k[e] * ((ai[e] - 1.0f) * kaw[e] + 1.0f), bb = kke * ai[e], ratio = GCv[e] * Gi[e];
                        kt[e] = Gm[e] * kke; rt[e] = G[e] * r[e]; btl[e] = bb * Gi[e]; kq[e] = kd * Gi[e];
                        bonp += r[e] * kd * rkw[e];
                        const int j = 32 * ks + 8 * q + e;
                        const unsigned w0 = pk2(kt[e], bb * ratio), w1 = pk2(kd * ratio, v[e]);
                        ((LAS bf16*)(SL + SL_Z))[j * 16 + c] = (bf16)(w0 & 0xffffu); ((LAS bf16*)(SL + SL_BGT))[j * 16 + c] = (bf16)(w0 >> 16);
                        ((LAS bf16*)(SL + SL_KGT))[j * 16 + c] = (bf16)(w1 & 0xffffu); ((LAS bf16*)(SL + SL_VT))[j * 16 + c] = (bf16)(w1 >> 16);
                    }
                    if (c == 15) { *(LAS f32x4*)(SL + SL_GC + (32 * ks + 8 * q) * 4) = (f32x4){G[0], G[1], G[2], G[3]}; *(LAS f32x4*)(SL + SL_GC + (32 * ks + 8 * q + 4) * 4) = (f32x4){G[4], G[5], G[6], G[7]}; }
                    v4u p; p.x = pk2(kt[0], kt[1]); p.y = pk2(kt[2], kt[3]); p.z = pk2(kt[4], kt[5]); p.w = pk2(kt[6], kt[7]); fKT[ks] = __builtin_bit_cast(bf16x8, p);
                    p.x = pk2(rt[0], rt[1]); p.y = pk2(rt[2], rt[3]); p.z = pk2(rt[4], rt[5]); p.w = pk2(rt[6], rt[7]); fRT[ks] = __builtin_bit_cast(bf16x8, p);
                    { v2u p0; p0.x = p.x; p0.y = p.y; v2u p1; p1.x = p.z; p1.y = p.w; const int pp = 32 * ks + 16 * (q & 1) + 4 * (q >> 1);
                      *(LAS v2u*)(SL + SL_RT + sw64(c, pp)) = p0; *(LAS v2u*)(SL + SL_RT + sw64(c, pp + 8)) = p1; }
                    p.x = pk2(btl[0], btl[1]); p.y = pk2(btl[2], btl[3]); p.z = pk2(btl[4], btl[5]); p.w = pk2(btl[6], btl[7]); fBT[ks] = __builtin_bit_cast(bf16x8, p);
                    p.x = pk2(kq[0], kq[1]); p.y = pk2(kq[2], kq[3]); p.z = pk2(kq[4], kq[5]); p.w = pk2(kq[6], kq[7]); fKQ[ks] = __builtin_bit_cast(bf16x8, p);
                    asm volatile("" ::: "memory");
                }
                bonp += __shfl_xor(bonp, 16); bonp += __shfl_xor(bonp, 32);
                if (q == 0 && (NSL * bt + w) * CK >= CTXL) BON[(size_t)scan_row((NSL * bt + w) * CK + c, b, dir) * NH + h] = bonp;
                const f32x4 z4 = (f32x4){0.f, 0.f, 0.f, 0.f};
                f32x4 accA = mfma16(fBT[1], fKT[1], mfma16(fBT[0], fKT[0], z4)), accAr = mfma16(fBT[1], fRT[1], mfma16(fBT[0], fRT[0], z4));
                f32x4 accCm = mfma16(fKQ[1], fKT[1], mfma16(fKQ[0], fKT[0], z4)), accCr = mfma16(fKQ[1], fRT[1], mfma16(fKQ[0], fRT[0], z4));
#pragma unroll
                for (int g = 0; g < 4; ++g) { const int srow = 4 * q + g; const bool lt = srow < c, le = srow <= c;
                    accA[g] = lt ? accA[g] : 0.f; accAr[g] = le ? accAr[g] : 0.f; accCm[g] = lt ? accCm[g] : 0.f; accCr[g] = le ? accCr[g] : 0.f;
                    ((LAS float*)(SL + SL_AF))[srow * 16 + c] = accA[g]; ((LAS bf16*)(SL + SL_ABF))[srow * 16 + c] = (bf16)f2bf(accA[g]); ((LAS bf16*)(SL + SL_Z))[(64 + srow) * 16 + c] = (bf16)f2bf(accCm[g]); }
                { v2u p; p.x = pk2(accAr[0], accAr[1]); p.y = pk2(accAr[2], accAr[3]); *(LAS v2u*)(SL + SL_ART + (c * 16 + 4 * q) * 2) = p; }
                { v2u p; p.x = pk2(accCr[0], accCr[1]); p.y = pk2(accCr[2], accCr[3]); *(LAS v2u*)(SL + SL_CRT + (c * 16 + 4 * q) * 2) = p; }
                LDS_WAIT(); asm volatile("" ::: "memory");
                {
                    const int base = c & 8, cl = c & 7; float x[8];
#pragma unroll
                    for (int sr = 7; sr >= 0; --sr) { float acc = 0.f;
#pragma unroll
                        for (int m = sr + 1; m < 8; ++m) acc += ((const LAS float*)(SL + SL_AF))[(base + sr) * 16 + base + m] * x[m];
                        x[sr] = (sr < cl) ? -acc : ((sr == cl) ? -1.0f : 0.f); }
                    if (q == 0) { v4u px; px.x = pk2(x[0], x[1]); px.y = pk2(x[2], x[3]); px.z = pk2(x[4], x[5]); px.w = pk2(x[6], x[7]);
                        *(LAS v4u*)(SL + SL_TMT + (c * 16 + base) * 2) = px; *(LAS v4u*)(SL + SL_TMT + (c * 16 + (base ^ 8)) * 2) = (v4u){0u, 0u, 0u, 0u};
#pragma unroll
                        for (int sr = 0; sr < 8; ++sr) { ((LAS bf16*)(SL + SL_TM))[(base + sr) * 16 + c] = (bf16)f2bf(x[sr]); ((LAS bf16*)(SL + SL_TM))[((base ^ 8) + sr) * 16 + c] = (bf16)0; } }
                    LDS_WAIT(); asm volatile("" ::: "memory");
                    const bf16x8 fAb = frag_ld(SL + SL_ABF + (c * 16 + 8 * q) * 2, klo), fTd = frag_ld(SL + SL_TMT + (c * 16 + 8 * q) * 2, klo);
                    const f32x4 d1 = mfma16(fAb, fTd, z4);
                    bf16x8 fD1; { v4u p; p.x = pk2(d1[0], d1[1]); p.y = pk2(d1[2], d1[3]); p.z = 0u; p.w = 0u; fD1 = __builtin_bit_cast(bf16x8, p); }
                    const f32x4 d2 = mfma16(fD1, frag4_ld(SL + SL_TM + (c * 16 + 4 * q) * 2), z4);
                    if (c < 8 && q >= 2) {
#pragma unroll
                        for (int g = 0; g < 4; ++g) ((LAS bf16*)(SL + SL_TMT))[(4 * q + g) * 16 + c] = (bf16)f2bf(d2[g]); }
                }
                LDS_WAIT(); asm volatile("" ::: "memory");
                {
                    const bf16x8 fT = frag_ld(SL + SL_TMT + (c * 16 + 8 * q) * 2, klo);
#pragma unroll
                    for (int zt = 0; zt < 5; ++zt) { const bf16x8 fZ = frag_ld(SL + SL_Z + ((16 * zt + c) * 16 + 8 * q) * 2, klo); const f32x4 d = mfma16(fZ, fT, z4);
                        v2u p; p.x = pk2(d[0], d[1]); p.y = pk2(d[2], d[3]); *(LAS v2u*)(SL + SL_ZTT + (c * ZTT_LD + (zt < 4 ? kpos(zt, q) : 64 + 4 * q)) * 2) = p; }
                }
            }
            if (bt + 1 < NBATCH) scan_fetch(R, RM, KM, VM, AX, EX, (size_t)scan_row((NSL * (bt + 1) + w) * CK + c, b, dir) * D + h * 64 + 8 * q);
            __syncthreads();
            asm volatile("" : "+v"(c), "+v"(q));
            if (w < 4) {
                const bool emit = (NSL * bt) * CK >= CTXL;
#pragma unroll 1
                for (int n = 0; n < NSL; ++n) { SeqOps A; seq_load(A, F.lds + slot_off(n), w, c, q, klo); seq_step(A, X, emit, YO, NSL * bt + n, b, dir, h, w, c, q); }
            }
            __syncthreads();
        }
    }
}

__device__ __forceinline__ void p7_readout(Frame& F, const Args& a) {
    const bf16* VM = (const bf16*)(F.ws + WS_VM); const float* BONF = (const float*)(F.ws + WS_BON); const float* BONB = BONF + (size_t)NT * NH;
    const bf16* YF = (const bf16*)(F.ws + WS_YF); const bf16* YB = (const bf16*)(F.ws + WS_YB); bf16* Z = (bf16*)(F.ws + WS_Z);
    const int sub = F.tid & 15; const int ngrp = F.G * 32;
    for (int gid0 = F.vcu * 32 + (F.tid >> 4); gid0 < NT * NH; gid0 += 4 * ngrp) {
        v2u ayf[4], ayb[4], alv[4]; float abf[4], abb[4]; f32x4 alw[4], alb[4];
#pragma unroll
        for (int u = 0; u < 4; ++u) { const int gid = gid0 + u * ngrp; const int mrow = gid >> 5, h = gid & 31, c = h * 64 + 4 * sub; const size_t off = (size_t)mrow * D + c;
            ayf[u] = *(const v2u*)(YF + off); ayb[u] = *(const v2u*)(YB + off); alv[u] = *(const v2u*)(VM + off); abf[u] = BONF[gid]; abb[u] = BONB[gid]; alw[u] = *(const f32x4*)(a.in[I_LNW] + c); alb[u] = *(const f32x4*)(a.in[I_LNB] + c); }
#pragma unroll
        for (int u = 0; u < 4; ++u) { const int gid = gid0 + u * ngrp;
        const int mrow = gid >> 5, h = gid & 31, c = h * 64 + 4 * sub; const size_t off = (size_t)mrow * D + c;
        const v2u yf = ayf[u], yb = ayb[u], lv = alv[u];
        const f32x4 y = (f32x4){bflo(yf.x) + bflo(yb.x), bfhi(yf.x) + bfhi(yb.x), bflo(yf.y) + bflo(yb.y), bfhi(yf.y) + bfhi(yb.y)};
        const float mean = allred16((y.x + y.y) + (y.z + y.w)) * (1.0f / 64.0f); const f32x4 d = y - mean;
        const float var = allred16((d.x * d.x + d.y * d.y) + (d.z * d.z + d.w * d.w)) * (1.0f / 64.0f);
        const f32x4 yn = d * __builtin_amdgcn_rsqf(var + 64e-5f) * alw[u] + alb[u];
        const f32x4 v = (f32x4){bflo(lv.x), bfhi(lv.x), bflo(lv.y), bfhi(lv.y)};
        const f32x4 z = yn + v * (abf[u] + abb[u]); v2u wv; wv.x = pk2(z.x, z.y); wv.y = pk2(z.z, z.w); *(v2u*)(Z + off) = wv;
        }
    }
}
constexpr float GU_F8SCALE = 8.0f, H2_F8SCALE = 8.0f, DT_F8SCALE = 8.0f;
constexpr int CONV_ITEMS = 65 * 384, CONV_DT = 65 * 128, CONV_FREE = CONV_DT + (65 - GU_E2) * 256;
struct DecExp { const float* const* in; unsigned char* ws;
    __device__ __forceinline__ bool operator()(int it, TrJob& j) const {
        if (it < 0 || it >= CONV_ITEMS) return false;
        if (it < CONV_DT) { const int e = it >> 7, r = it & 127; const float* src = (e < 64) ? in[I_ED] + (size_t)e * DEXP * D : in[I_SD];
            const int kb = r >> 5, nb = r & 31; j = TrJob{src, (bf16*)(ws + WS_DT + (size_t)e * D * DEXP), D, DEXP, DEXP, kb * 128, nb * 64, nb * 64, DT_F8SCALE}; }
        else { const int g = it - CONV_DT, eg = g >> 8, q = g & 255, which = q >> 7, r = q & 127, e = eg < 65 - GU_E2 ? GU_E2 + eg : eg - (65 - GU_E2);
            const float* src = (e < 64) ? (which == 0 ? in[I_EG] : in[I_EU]) + (size_t)e * D * DEXP : (which == 0 ? in[I_SG] : in[I_SU]);
            const int kb = r >> 3, nb = r & 7, n0 = nb * 64;
            j = TrJob{src, (bf16*)(ws + gu_base(e)), DEXP, D, D, kb * 128, n0, (n0 >> 7) * 256 + which * 128 + (n0 & 127), GU_F8SCALE}; }
        return true; } };
__device__ __forceinline__ void conv_steal(Frame& F, const Args& a, const unsigned stopn) {
    DecExp dec{a.in, F.ws};
    unsigned* cnt = F.ctl + CW_CONV; unsigned* dnp = F.ctl + CW_P2DONE;
    LAS unsigned* P = (LAS unsigned*)(F.lds + F.wave * 16384);
    const int lane = F.lane;
    unsigned nxt = 0u, dnow = 0u;
    if (lane == 0) nxt = xb_add(cnt, 1u);
    nxt = __builtin_amdgcn_readfirstlane(nxt);
#pragma unroll 1
    for (;;) {
        const unsigned cur = nxt;
        if (cur >= (unsigned)CONV_FREE) break;
        unsigned n2 = (unsigned)CONV_FREE, d2 = dnow;
        if (dnow < stopn) { if (lane == 0) { n2 = xb_add(cnt, 1u); d2 = xb_ld(dnp); } }
        asm volatile("" ::: "memory");
        TrJob ja; f32x4 va[16];
        dec((int)cur, ja);
        tr8_load<true>(ja, 0, va, lane); tr8_lds(ja, 0, va, P, lane);
        tr8_load<true>(ja, 1, va, lane); tr8_lds(ja, 1, va, P, lane);
        tr8_flush<true>(ja, P, lane);
        nxt = __builtin_amdgcn_readfirstlane(n2); dnow = __builtin_amdgcn_readfirstlane(d2);
    }
}
constexpr int RT_LD = 68;
__device__ __forceinline__ void p11_route(Frame& F, const Args& a) {
    for (int repa_ = 0, nrepa_ = opaque_n(1 + ((DUPMASK >> 16) & 1)); repa_ < nrepa_; ++repa_) {
        unsigned nd = xb_ld(F.ctl + CW_CONV); nd = __builtin_amdgcn_readfirstlane(nd < (unsigned)CONV_FREE ? nd : (unsigned)CONV_FREE);
        DecExp dec{a.in, F.ws};
        tr_run8(dec, (int)nd + F.vcu * 8 + F.wave, F.G * 8, (LAS unsigned*)(F.lds + F.wave * 16384), F.lane);
        __syncthreads();
    }
    const bf16* X1 = (const bf16*)(F.ws + WS_X1); const float* MOD = (const float*)(F.ws + WS_MOD); unsigned char* H2 = F.ws + WS_H2;
    LAS float* hs = (LAS float*)F.lds;
    LAS float* wsb = hs + 64 * RT_LD;
    LAS float* lg = wsb + 64 * RT_LD;
    LAS float* lg2 = lg + 64 * 65;
    LAS float* selb = lg2 + 64 * 65;
    LAS float* rs = selb + 64 * 65;
    LAS int* cnt = (LAS int*)(rs + 64);
    LAS int* basee = cnt + 64;
    LAS int* eloc = basee + 64;
    LAS int* rloc = eloc + 512;
    for (int tile = F.vcu; tile < NT / 64; tile += F.G) {
        const int t0 = tile * 64, b = t0 >> 12;
        const float* sh2 = MOD + (size_t)b * 12288 + 6144; const float* sc2 = MOD + (size_t)b * 12288 + 8192; const float* g2 = a.in[I_N2G];
        if (F.tid < 64) cnt[F.tid] = 0;
        for (int rr = 0; rr < 8; ++rr) { const int tl = F.wave * 8 + rr; const v2u* xr = (const v2u*)(X1 + (size_t)(t0 + tl) * D) + F.lane; f32x4 v[8]; float s = 0.f;
#pragma unroll
            for (int q = 0; q < 8; ++q) { const v2u xw = xr[64 * q]; v[q] = (f32x4){bflo(xw.x), bfhi(xw.x), bflo(xw.y), bfhi(xw.y)}; s += (v[q].x * v[q].x + v[q].y * v[q].y) + (v[q].z * v[q].z + v[q].w * v[q].w); }
            const float rstd = 1.0f / sqrtf(wave_sum(s) * (1.0f / D) + 1e-6f); if (F.lane == 0) rs[tl] = rstd;
            unsigned* o = (unsigned*)(H2 + (size_t)(t0 + tl) * D) + F.lane;
#pragma unroll
            for (int q = 0; q < 8; ++q) { const f32x4 y = v[q] * rstd * ((const f32x4*)g2)[F.lane + 64 * q] * (((const f32x4*)sc2)[F.lane + 64 * q] + 1.0f) + ((const f32x4*)sh2)[F.lane + 64 * q];
                o[64 * q] = pk8(H2_F8SCALE * y.x, H2_F8SCALE * y.y, H2_F8SCALE * y.z, H2_F8SCALE * y.w); } }
        __syncthreads();
        const int tg = F.tid & 15, eg = (F.tid >> 4) & 15, kh = F.tid >> 8;
        float acc[4][4];
#pragma unroll
        for (int i = 0; i < 4; ++i)
#pragma unroll
            for (int j = 0; j < 4; ++j) acc[i][j] = 0.f;
        const int stok = F.tid >> 3, sk8 = (F.tid & 7) * 8; const float rstd_s = rs[stok];
        f32x4 px0, px1, pw0, pw1;
        { const v4u xw = *(const v4u*)(X1 + (size_t)(t0 + stok) * D + sk8); px0 = (f32x4){bflo(xw.x), bfhi(xw.x), bflo(xw.y), bfhi(xw.y)}; px1 = (f32x4){bflo(xw.z), bfhi(xw.z), bflo(xw.w), bfhi(xw.w)}; const float* wp = a.in[I_RW] + F.tid * 8; pw0 = *(const f32x4*)wp; pw1 = *(const f32x4*)(wp + 4); }
        for (int kc = 0; kc < D / 64; ++kc) {
            { const int k0 = kc * 64 + sk8;
              const f32x4 ga = *(const f32x4*)(g2 + k0), gb = *(const f32x4*)(g2 + k0 + 4), ca = *(const f32x4*)(sc2 + k0), cb = *(const f32x4*)(sc2 + k0 + 4), ha = *(const f32x4*)(sh2 + k0), hb = *(const f32x4*)(sh2 + k0 + 4);
              const f32x4 y0 = px0 * rstd_s * ga * (ca + 1.0f) + ha, y1 = px1 * rstd_s * gb * (cb + 1.0f) + hb;
              hs[(sk8 + 0) * RT_LD + stok] = y0.x; hs[(sk8 + 1) * RT_LD + stok] = y0.y; hs[(sk8 + 2) * RT_LD + stok] = y0.z; hs[(sk8 + 3) * RT_LD + stok] = y0.w;
              hs[(sk8 + 4) * RT_LD + stok] = y1.x; hs[(sk8 + 5) * RT_LD + stok] = y1.y; hs[(sk8 + 6) * RT_LD + stok] = y1.z; hs[(sk8 + 7) * RT_LD + stok] = y1.w;
              const int wk = F.tid >> 3, we = (F.tid & 7) * 8; *(LAS f32x4*)(wsb + wk * RT_LD + we) = pw0; *(LAS f32x4*)(wsb + wk * RT_LD + we + 4) = pw1; }
            __syncthreads();
            if (kc + 1 < D / 64) { const v4u xw = *(const v4u*)(X1 + (size_t)(t0 + stok) * D + (kc + 1) * 64 + sk8); px0 = (f32x4){bflo(xw.x), bfhi(xw.x), bflo(xw.y), bfhi(xw.y)}; px1 = (f32x4){bflo(xw.z), bfhi(xw.z), bflo(xw.w), bfhi(xw.w)};
                const float* wp = a.in[I_RW] + (size_t)(kc + 1) * 4096 + F.tid * 8; pw0 = *(const f32x4*)wp; pw1 = *(const f32x4*)(wp + 4); }
#pragma unroll 8
            for (int k = kh * 32; k < kh * 32 + 32; ++k) { const f32x4 h4 = *(const LAS f32x4*)(hs + k * RT_LD + 4 * tg), w4 = *(const LAS f32x4*)(wsb + k * RT_LD + 4 * eg);
                acc[0][0] += h4.x * w4.x; acc[0][1] += h4.x * w4.y; acc[0][2] += h4.x * w4.z; acc[0][3] += h4.x * w4.w;
                acc[1][0] += h4.y * w4.x; acc[1][1] += h4.y * w4.y; acc[1][2] += h4.y * w4.z; acc[1][3] += h4.y * w4.w;
                acc[2][0] += h4.z * w4.x; acc[2][1] += h4.z * w4.y; acc[2][2] += h4.z * w4.z; acc[2][3] += h4.z * w4.w;
                acc[3][0] += h4.w * w4.x; acc[3][1] += h4.w * w4.y; acc[3][2] += h4.w * w4.z; acc[3][3] += h4.w * w4.w; }
            __syncthreads();
        }
        { LAS float* dstl = kh ? lg2 : lg;
#pragma unroll
          for (int i = 0; i < 4; ++i)
#pragma unroll
              for (int j = 0; j < 4; ++j) dstl[(4 * tg + i) * 65 + 4 * eg + j] = acc[i][j]; }
        __syncthreads();
        for (int idx = F.tid; idx < 4096; idx += 512) { const int tl = idx >> 6, e = idx & 63; const float sc = sigmoidf_(lg[tl * 65 + e] + lg2[tl * 65 + e]); lg[tl * 65 + e] = sc; selb[tl * 65 + e] = sc + a.in[I_RB][e]; }
        __syncthreads();
        if (F.tid < 64) {
            const int tl = F.tid; LAS float* sel = selb + tl * 65; const LAS float* scr = lg + tl * 65;
            float gs[8];
#pragma unroll
            for (int g = 0; g < 8; ++g) { float m1 = -INFINITY, m2 = -INFINITY;
#pragma unroll
                for (int j = 0; j < 8; ++j) { const float v = sel[g * 8 + j]; if (v > m1) { m2 = m1; m1 = v; } else if (v > m2) m2 = v; }
                gs[g] = m1 + m2; }
            unsigned gmask = 0u;
#pragma unroll
            for (int it = 0; it < 4; ++it) { float best = -INFINITY; int bi = 0;
#pragma unroll
                for (int g = 0; g < 8; ++g) { const bool ok = !((gmask >> g) & 1u) && gs[g] > best; best = ok ? gs[g] : best; bi = ok ? g : bi; }
                gmask |= 1u << bi; }
            for (int g = 0; g < 8; ++g) if (!((gmask >> g) & 1u)) { for (int j = 0; j < 8; ++j) sel[g * 8 + j] = -INFINITY; }
            float wv[8]; int ev[8]; float wsum = 0.f;
#pragma unroll
            for (int it = 0; it < 8; ++it) { float best = -INFINITY; int bi = 0;
                for (int e = 0; e < 64; ++e) { const float v = sel[e]; if (v > best) { best = v; bi = e; } }
                sel[bi] = -INFINITY; ev[it] = bi; wv[it] = scr[bi]; wsum += wv[it]; }
            const float inv = 2.5f / wsum;
#pragma unroll
            for (int it = 0; it < 8; ++it) { const int lr = atomicAdd((int*)&cnt[ev[it]], 1); eloc[tl * 8 + it] = ev[it]; rloc[tl * 8 + it] = lr;
                ((float*)(F.ws + WS_WSEL))[(size_t)(t0 + tl) * 8 + it] = wv[it] * inv; }
        }
        __syncthreads();
        if (F.tid < 64) basee[F.tid] = (int)__hip_atomic_fetch_add(F.ctl + CW_GCNT + F.tid, (unsigned)cnt[F.tid], __ATOMIC_RELAXED, __HIP_MEMORY_SCOPE_AGENT);
        __syncthreads();
        { const int e = eloc[F.tid]; ((int*)(F.ws + WS_EIDX))[(size_t)t0 * 8 + F.tid] = e; ((int*)(F.ws + WS_RANK))[(size_t)t0 * 8 + F.tid] = basee[e] + rloc[F.tid]; }
        __syncthreads();
    }
}
__device__ __forceinline__ int moe_tables(Frame& F) {
    LAS int* te = (LAS int*)(F.lds + TAB_OFF); LAS int* off = te + MAXTILES;
    if (F.tid < 64) off[66 + F.tid] = (int)__hip_atomic_load(F.ctl + CW_GCNT + F.tid, __ATOMIC_RELAXED, __HIP_MEMORY_SCOPE_AGENT);
    __syncthreads();
    if (F.tid == 0) { int o = 0; for (int e = 0; e < 64; ++e) { off[e] = o; o += (off[66 + e] + 255) & ~255; } off[64] = o; off[65] = o / 256 + NT / 256; }
    __syncthreads();
    const int ntiles = off[65];
    for (int rt = F.tid; rt < ntiles; rt += 512) { int e = 0; for (int j = 1; j <= 64; ++j) if (rt * 256 >= off[j]) e = j; te[rt] = e; }
    __syncthreads();
    return ntiles;
}
__device__ __forceinline__ void p12_slots(Frame& F) {
    (void)moe_tables(F);
    const LAS int* off = (const LAS int*)(F.lds + TAB_OFF) + MAXTILES;
    int* tok = (int*)(F.ws + WS_TOK);
    const int* eidx = (const int*)(F.ws + WS_EIDX); int* rank = (int*)(F.ws + WS_RANK);
    const int gt = F.vcu * 512 + F.tid, NGT = F.G * 512;
    for (int i = gt; i < NT * 8; i += NGT) { const int slot = off[eidx[i]] + rank[i]; tok[slot] = i >> 3; rank[i] = slot; }
    const int o64 = off[64];
    for (int t = gt; t < NT; t += NGT) tok[o64 + t] = t;
    if (gt == 0) F.ctl[CW_O64] = (unsigned)o64;
}
__device__ __forceinline__ void p15_final(Frame& F, const Args& a) {
    const int gw = F.vcu * 8 + F.wave, NGW = F.G * 8; const float* MOD = (const float*)(F.ws + WS_MOD); const unsigned char* YP = (const unsigned char*)(F.ws + WS_YP);
    const int* SLOTMAP = (const int*)(F.ws + WS_RANK); const float* WSEL = (const float*)(F.ws + WS_WSEL); const int o64 = (int)F.ctl[CW_O64];
    for (int t = gw; t < NT; t += NGW) {
        const int b = t >> 12; const float* gt2 = MOD + (size_t)b * 12288 + 10240; const float* fg = a.in[I_FG]; float* xr = a.out + (size_t)t * D; const bf16* x1r = (const bf16*)(F.ws + WS_X1) + (size_t)t * D;
        const v4u s0 = *(const v4u*)(SLOTMAP + (size_t)t * 8), s1 = *(const v4u*)(SLOTMAP + (size_t)t * 8 + 4); const f32x4 w0 = *(const f32x4*)(WSEL + (size_t)t * 8), w1 = *(const f32x4*)(WSEL + (size_t)t * 8 + 4);
        const unsigned sl[9] = {s0.x, s0.y, s0.z, s0.w, s1.x, s1.y, s1.z, s1.w, (unsigned)(o64 + t)}; const float wt[9] = {w0.x, w0.y, w0.z, w0.w, w1.x, w1.y, w1.z, w1.w, 1.0f};
        LAS float* Tw = (LAS float*)(F.lds + F.wave * 8192);
#pragma unroll
        for (int jj = 0; jj < 2; ++jj) { const int col = 16 * F.lane + 1024 * jj; float m[16];
#pragma unroll
            for (int e = 0; e < 16; ++e) m[e] = 0.f;
#pragma unroll
            for (int j = 0; j < 9; ++j) { const v4u y = *(const v4u*)(YP + (size_t)sl[j] * D + col); const unsigned yw[4] = {y.x, y.y, y.z, y.w}; const float wj = wt[j];
#pragma unroll
                for (int e = 0; e < 4; ++e) { const f32x2 lo = __builtin_amdgcn_cvt_pk_f32_fp8((int)yw[e], false), hi = __builtin_amdgcn_cvt_pk_f32_fp8((int)yw[e], true);
                    m[4 * e] += wj * lo.x; m[4 * e + 1] += wj * lo.y; m[4 * e + 2] += wj * hi.x; m[4 * e + 3] += wj * hi.y; } }
#pragma unroll
            for (int e4 = 0; e4 < 4; ++e4) *(LAS f32x4*)(Tw + col + 4 * e4) = (f32x4){m[4 * e4], m[4 * e4 + 1], m[4 * e4 + 2], m[4 * e4 + 3]}; }
        LDS_WAIT(); asm volatile("" ::: "memory");
        f32x4 v[8]; float s = 0.f;
#pragma unroll
        for (int k = 0; k < 8; ++k) { const int col = 256 * k + 4 * F.lane; const f32x4 mm = *(const LAS f32x4*)(Tw + col);
            const v2u xw = *(const v2u*)(x1r + col); const f32x4 x0 = (f32x4){bflo(xw.x), bfhi(xw.x), bflo(xw.y), bfhi(xw.y)}, g0 = *(const f32x4*)(gt2 + col);
            v[k] = x0 + g0 * (mm * (1.0f / YP_SCALE)); s += (v[k].x * v[k].x + v[k].y * v[k].y) + (v[k].z * v[k].z + v[k].w * v[k].w); }
        LDS_WAIT(); asm volatile("" ::: "memory");
        float rstd = __builtin_amdgcn_rsqf(wave_sum(s) * (1.0f / D) + 1e-6f);
#if defined(PROBE_PHASE)
        if (PROBE_PHASE >= 0) rstd *= 1.0f + (float)__hip_atomic_load(F.ctl + 12000, __ATOMIC_RELAXED, __HIP_MEMORY_SCOPE_AGENT) * 2e-6f;
#endif
#pragma unroll
        for (int k = 0; k < 8; ++k) { const int col = 256 * k + 4 * F.lane; *(f32x4*)(xr + col) = v[k] * rstd * *(const f32x4*)(fg + col); }
    }
}
#ifndef MK_ONE_LAUNCH
#define MK_ONE_LAUNCH 1
#endif
constexpr int NPHASE = 16;
__global__ void __launch_bounds__(512, 2) mk_fwd(Args args) {
    extern __shared__ __attribute__((aligned(16))) unsigned char lds[];
    Frame F;
    F.lds = (LAS unsigned char*)lds; F.MISC = (volatile LAS unsigned*)(F.lds + LDSCTL_OFF);
    int wave0 = __builtin_amdgcn_readfirstlane((int)threadIdx.x >> 6); asm volatile("" : "+s"(wave0));
    F.tid = threadIdx.x; F.lane = F.tid & 63; F.wave = wave0;
    F.G = gridDim.x; { const int bx = blockIdx.x; F.vcu = (F.G % 8 == 0) ? (bx % 8) * (F.G / 8) + bx / 8 : bx; }
    F.ws = args.ws; F.ctl = (unsigned*)(args.ws + WS_CTL);
    for (int u = F.tid; u < 256; u += 512) ((LAS unsigned*)(F.lds + LDSCTL_OFF))[u] = 0u;
    __syncthreads();
    XcdBarrier bar; bar.bar = F.ctl + CW_BAR; bar.x = 0; bar.st = nullptr;
    if (MK_ONE_LAUNCH) bar = xcd_barrier_post(F.ctl + CW_BAR, F.MISC + 8);
    const int lo = args.ph_lo, hi = args.ph_hi;
#ifndef PHMASK
#define PHMASK 0xFFFF
#endif
#define IN(k) (((PHMASK >> (k)) & 1) && lo <= (k) && (k) < hi)
#ifndef DUPMASK
#define DUPMASK 0
#endif
#define DUP(k) for (int rep_ = 0, nrep_ = opaque_n(1 + ((DUPMASK >> (k)) & 1)); rep_ < nrep_; ++rep_)
#define FRESH() do { int l_ = (int)__builtin_amdgcn_mbcnt_hi(~0u, __builtin_amdgcn_mbcnt_lo(~0u, 0u)); asm volatile("" : "+v"(l_)); int w_ = wave0; asm volatile("" : "+s"(w_)); F.lane = l_; F.wave = w_; F.tid = w_ * 64 + l_; { unsigned char* p_ = args.ws; asm volatile("" : "+s"(p_)); F.ws = p_; ws = p_; F.ctl = (unsigned*)(p_ + WS_CTL); } } while (0)
#define SEAM(k) do { if (MK_ONE_LAUNCH) { if (IN(k) && IN((k) + 1)) { xcd_barrier(bar); if ((DUPMASK >> 18) & 1) xcd_barrier(bar); } } } while (0)
    const int G = F.G, c = (int)blockIdx.x;
#ifndef PROBE_PHASE
#define PROBE_PHASE -1
#endif
    unsigned long long pt0_ = 0;
#define PSTART(k) do { if (PROBE_PHASE == (k)) pt0_ = __builtin_amdgcn_s_memrealtime(); } while (0)
#define PEND(k) do { if (PROBE_PHASE == (k) && blockIdx.x == 0 && threadIdx.x == 0) { const unsigned long long t1_ = __builtin_amdgcn_s_memrealtime(); __hip_atomic_store(F.ctl + 12000, (unsigned)(t1_ - pt0_), __ATOMIC_RELAXED, __HIP_MEMORY_SCOPE_AGENT); } } while (0)
    unsigned char* ws = args.ws;

    PSTART(0);
    if (IN(0)) DUP(0) { FRESH(); p0_prologue(F, args); } SEAM(0); PEND(0);
    PSTART(1);
    if (IN(1)) DUP(1) { FRESH(); p1_norm1(F, args); } SEAM(1); PEND(1);
    PSTART(2);
    if (IN(2)) DUP(2) { FRESH();
        const int g1 = (G == 256 && !NOCONV) ? 240 : G;
        if (c < g1) {
            G1Order S{(const char*)(ws + WS_HA), (const char*)(ws + WS_WIN), (size_t)256 * D * (P2_FP8 ? 1 : 2), (size_t)256 * D * (P2_FP8 ? 1 : 2), g1, c};
            EpiG1 E{(bf16*)(ws + WS_U), (bf16*)(ws + WS_SLAB), (unsigned char*)(ws + WS_GATES)};
            if (P2_FP8) pg8::gemm_phase<EpiG1, G1Order, false, true, 124>(F.lds + RING_OFF, F.wave, D / 2, D / 2, D / 2, S, E);
            else pg8::gemm_phase<EpiG1, G1Order, false>(F.lds + RING_OFF, F.wave, D, D, D, S, E);
            FRESH();
            if (F.tid == 0) (void)xb_add(F.ctl + CW_P2DONE, 1u);
        } else conv_steal(F, args, 8u);
    } SEAM(2); PEND(2);
    PSTART(3);
    if (IN(3)) DUP(3) { FRESH(); p3_prep(F, args); } SEAM(3); PEND(3);
    PSTART(4);
    if (IN(4)) DUP(4) { FRESH();
#ifndef NO4A
        {
            RepOrder S{(const char*)(ws + WS_LIN), (const char*)(ws + WS_LORA), (size_t)128 * 2, (size_t)D * 128 * 2, (size_t)256 * LINLD * 2, (size_t)256 * 128 * 2, MT / 256, D / 256, 4, G, c};
            EpiLora E{(unsigned short*)(ws + WS_EA), args.in[I_DW0], args.in[I_IA0]};
            pg8::gemm_phase<EpiLora, RepOrder, false>(F.lds + RING_OFF, F.wave, 128, LINLD, 128, S, E);
        }
#endif
    }
    if (IN(4)) DUP(4) { FRESH();
#ifndef NO4B
        {
            RepOrder S{(const char*)(ws + WS_DP), (const char*)(ws + WS_POOLW), (size_t)256 * 2, (size_t)256 * 256 * 2, (size_t)256 * 1024 * 2, (size_t)256 * 256 * 2, NT / 256, 1, 4, G, c};
            EpiPoolG E{(bf16*)(ws + WS_Y2), args.in[I_POOLS]};
            pg8::gemm_phase<EpiPoolG, RepOrder, false>(F.lds + RING_OFF, F.wave, 256, 1024, 256, S, E);
        }
#endif
    } SEAM(4); PEND(4);
    PSTART(5);
    if (IN(5)) DUP(5) { FRESH();
        RepOrder S{(const char*)(ws + WS_Y2), (const char*)(ws + WS_WPO), 0, 0, (size_t)256 * 1024 * 2, (size_t)256 * 1024 * 2, NT / 256, D / 256, 1, G, c};
        EpiMix<0> E{(bf16*)(ws + WS_MP), D, (const void*)(ws + WS_GATES), 4096, nullptr, 0};
        pg8::gemm_phase<EpiMix<0>, RepOrder, false>(F.lds + RING_OFF, F.wave, 1024, 1024, 1024, S, E);
    }
    PSTART(6);
    if (IN(6)) DUP(6) { FRESH(); p6_scan(F, args); if ((DUPMASK >> 19) & 1) { FRESH(); p6_scan(F, args); } } SEAM(6); PEND(6);
    PSTART(7);
    if (IN(7)) DUP(7) { FRESH(); p7_readout(F, args); } SEAM(7); PEND(7);
    PSTART(8);
    if (IN(8)) DUP(8) { FRESH();
        RepOrder S{(const char*)(ws + WS_LIN) + 512 * 2, (const char*)(ws + WS_G2), 0, 0, (size_t)256 * LINLD * 2, (size_t)256 * 256 * 2, NT / 256, D / 256, 1, G, c};
        EpiMix<1> E{(bf16*)(ws + WS_OR), D, (const void*)(ws + WS_Z), D, nullptr, 0};
        pg8::gemm_phase<EpiMix<1>, RepOrder, false>(F.lds + RING_OFF, F.wave, 256, LINLD, 256, S, E);
    } SEAM(8); PEND(8);
    PSTART(9);
    if (IN(9)) DUP(9) { FRESH();
        RepOrder S{(const char*)(ws + WS_OR), (const char*)(ws + WS_WRO), 0, 0, (size_t)256 * D * 2, (size_t)256 * D * 2, NT / 256, D / 256, 1, G, c};
        EpiMix<2, P10_FP8 != 0> E{(bf16*)(ws + WS_Z), P10_FP8 ? D : D, (const void*)(ws + WS_GATES + 2048), 4096, (const bf16*)(ws + WS_MP), D};
        pg8::gemm_phase<EpiMix<2, P10_FP8 != 0>, RepOrder, false>(F.lds + RING_OFF, F.wave, D, D, D, S, E);
    } SEAM(9); PEND(9);
    PSTART(10);
    if (IN(10)) DUP(10) { FRESH();
        RepOrder S{(const char*)(ws + WS_Z), (const char*)(ws + WS_WO), 0, 0, (size_t)256 * D * (P10_FP8 ? 1 : 2), (size_t)256 * D * (P10_FP8 ? 1 : 2), NT / 256, D / 256, 1, G, c};
        EpiX1 E{args.in[I_X], (bf16*)(ws + WS_X1), (const float*)(ws + WS_MOD)};
        if (P10_FP8) pg8::gemm_phase<EpiX1, RepOrder, false, true, 124>(F.lds + RING_OFF, F.wave, D / 2, D / 2, D / 2, S, E);
        else pg8::gemm_phase<EpiX1, RepOrder, false>(F.lds + RING_OFF, F.wave, D, D, D, S, E);
    } SEAM(10); PEND(10);
    PSTART(11);
    if (IN(11)) DUP(11) { FRESH(); p11_route(F, args); } SEAM(11); PEND(11);
    PSTART(12);
    if (IN(12)) DUP(12) { FRESH(); p12_slots(F); } SEAM(12); PEND(12);
    PSTART(13);
    if (IN(13)) DUP(13) { FRESH();
        const int ntiles = moe_tables(F);
        MoeOrderT<true> S{(const char*)(ws + WS_H2), (const char*)ws, (const LAS int*)(F.lds + TAB_OFF), (const LAS int*)(F.lds + ROWTAB_OFF), 0, (size_t)1024 * D * 2, (size_t)256 * D, ntiles, 4, G, c};
        { LAS int* rt = (LAS int*)(F.lds + ROWTAB_OFF); const int* tok = (const int*)(ws + WS_TOK); Unit uu;
          for (int i = 0; i < ROWTAB_UNITS && S.next(i, uu); ++i) if (F.tid < 256) rt[i * 256 + F.tid] = tok[uu.pm * 256 + F.tid];
          __syncthreads(); }
        EpiAct E{ws + WS_ACT};
        pg8::gemm_phase<EpiAct, MoeOrderT<true>, true, true, 124>(F.lds + RING_OFF, F.wave, D / 2, D / 2, D / 2, S, E);
    } SEAM(13); PEND(13);
    PSTART(14);
    if (IN(14)) DUP(14) { FRESH();
        const int ntiles = moe_tables(F);
        MoeOrderT<false> S{(const char*)(ws + WS_ACT), (const char*)(ws + WS_DT), (const LAS int*)(F.lds + TAB_OFF), (const LAS int*)(F.lds + ROWTAB_OFF), (size_t)256 * DEXP, (size_t)D * DEXP, (size_t)256 * DEXP, ntiles, 8, G, c};
        EpiDown E{(unsigned char*)(ws + WS_YP)};
        if (STAGGER14 && (c & 8)) { for (int i_ = 0; i_ < STAGGER14; ++i_) __builtin_amdgcn_s_sleep(127); }
        pg8::gemm_phase<EpiDown, MoeOrderT<false>, false, true, 124>(F.lds + RING_OFF, F.wave, DEXP / 2, DEXP / 2, DEXP / 2, S, E);
    } SEAM(14); PEND(14);
    PSTART(15);
    if (IN(15)) DUP(15) { FRESH(); p15_final(F, args); }
#undef IN
#undef SEAM
}

extern "C" void kernel_launch(void* const* d_in, const int* in_sizes, int n_in, void* d_out, int out_size, void* d_ws, size_t ws_size, hipStream_t stream) {
    static int grid = 0;
    if (grid == 0) {
        if (n_in != 34 || in_sizes[0] != NT * D || out_size != NT * D || ws_size < WS_END) { fprintf(stderr, "kernel_launch: unexpected shapes (n_in %d, in0 %d, out %d, ws %zu < %zu)\n", n_in, n_in > 0 ? in_sizes[0] : -1, out_size, ws_size, (size_t)WS_END); grid = -1; return; }
        int dev = 0, cus = 0, per_cu = 0;
        if (hipGetDevice(&dev) != hipSuccess || hipDeviceGetAttribute(&cus, hipDeviceAttributeMultiprocessorCount, dev) != hipSuccess) { grid = -1; return; }
        if (hipFuncSetAttribute((const void*)mk_fwd, hipFuncAttributeMaxDynamicSharedMemorySize, LDS_BYTES) != hipSuccess) { fprintf(stderr, "kernel_launch: hipFuncSetAttribute failed\n"); grid = -1; return; }
        if (hipOccupancyMaxActiveBlocksPerMultiprocessor(&per_cu, (const void*)mk_fwd, 512, LDS_BYTES) != hipSuccess || per_cu < 1) fprintf(stderr, "kernel_launch: occupancy query reports %d\n", per_cu);
        (void)hipGetLastError();
        grid = cus;
    }
    if (grid < 0) return;
    if (hipMemsetAsync((char*)d_ws + WS_CTL, 0, CTL_ZERO_BYTES, stream) != hipSuccess) return;
    Args a{};
    for (int i = 0; i < 34; ++i) a.in[i] = (const float*)d_in[i];
    a.out = (float*)d_out; a.ws = (unsigned char*)d_ws;
#if MK_ONE_LAUNCH
    a.ph_lo = 0; a.ph_hi = NPHASE;
    hipLaunchKernelGGL(mk_fwd, dim3(grid), dim3(512), LDS_BYTES, stream, a);
#else
    for (int p = 0; p < NPHASE; ++p) { a.ph_lo = p; a.ph_hi = p + 1; hipLaunchKernelGGL(mk_fwd, dim3(grid), dim3(512), LDS_BYTES, stream, a); }
#endif
}
```

```cpp
#include <hip/hip_runtime.h>
#include <cstdio>
#include <cstdint>
#ifndef DUPMASK
#define DUPMASK 0
#endif
#ifndef PROBE_PHASE
#define PROBE_PHASE -1
#endif
#ifndef P2_FP8
#define P2_FP8 1
#endif
#ifndef P10_FP8
#define P10_FP8 0
#endif
static_assert(P10_FP8 == 0, "the w_out copy is bf16");
#ifndef STAGGER14
#define STAGGER14 0
#endif
#ifndef NOCONV
#define NOCONV 0
#endif

#define GAS __attribute__((address_space(1)))
#define LAS __attribute__((address_space(3)))
typedef unsigned short bf16;
typedef unsigned v4u __attribute__((ext_vector_type(4)));
typedef unsigned v2u __attribute__((ext_vector_type(2)));
typedef float f32x4 __attribute__((ext_vector_type(4)));
typedef float f32x2 __attribute__((ext_vector_type(2)));
typedef short bf16x8 __attribute__((ext_vector_type(8)));

constexpr int D = 2048, NB = 4, TSEQ = 4096, NT = NB * TSEQ  , CTXL = 256, NC = NB * CTXL  , MT = NT + NC  ;
constexpr int DIN = 11904, DSH = 6784, NPAD = 12032, SLABLD = 6912, NH = 32, HS = 64;
constexpr int NEXP = 64, DEXP = 512, TOPK = 8;
constexpr int NSLOT = NT * TOPK + NEXP * 256 + NT;
constexpr int MAXTILES = NSLOT / 256;
constexpr int LINLD = 768;

__device__ __forceinline__ int opaque_n(int n) { asm volatile("" : "+s"(n)); return n; }
__device__ __forceinline__ unsigned f2bf(float f) { unsigned u = __builtin_bit_cast(unsigned, f); return (u + 0x7fffu + ((u >> 16) & 1u)) >> 16; }
typedef __bf16 bf16x2_t __attribute__((ext_vector_type(2)));
__device__ __forceinline__ unsigned pk2(float lo, float hi) { const f32x2 v = {lo, hi}; const bf16x2_t b = __builtin_convertvector(v, bf16x2_t); return __builtin_bit_cast(unsigned, b); }
__device__ __forceinline__ unsigned pk8(float a, float b, float c, float d) { int w = __builtin_amdgcn_cvt_pk_fp8_f32(a, b, 0, false); w = __builtin_amdgcn_cvt_pk_fp8_f32(c, d, w, true); return (unsigned)w; }
__device__ __forceinline__ float bflo(unsigned w) { return __builtin_bit_cast(float, w << 16); }
__device__ __forceinline__ float bfhi(unsigned w) { return __builtin_bit_cast(float, w & 0xffff0000u); }
__device__ __forceinline__ unsigned pkh2(float lo, float hi) { const unsigned short a = __builtin_bit_cast(unsigned short, (_Float16)lo), b = __builtin_bit_cast(unsigned short, (_Float16)hi); return (unsigned)a | ((unsigned)b << 16); }
__device__ __forceinline__ float hlo(unsigned w) { return (float)__builtin_bit_cast(_Float16, (unsigned short)(w & 0xffffu)); }
__device__ __forceinline__ float hhi(unsigned w) { return (float)__builtin_bit_cast(_Float16, (unsigned short)(w >> 16)); }
__device__ __forceinline__ float sigmoidf_(float x) { return __builtin_amdgcn_rcpf(1.0f + __builtin_amdgcn_exp2f(-1.44269504f * x)); }
__device__ __forceinline__ float tanhf_(float x) { return 1.0f - 2.0f * __builtin_amdgcn_rcpf(1.0f + __builtin_amdgcn_exp2f(2.88539008f * x)); }
__device__ __forceinline__ float wave_sum(float v) {
#pragma unroll
    for (int o = 1; o < 64; o <<= 1) v += __shfl_xor(v, o);
    return v;
}
__device__ __forceinline__ float dpp_f(float v, const int ctrl_sel) {
    int r;
    const int x = __builtin_bit_cast(int, v);
    if (ctrl_sel == 0) r = __builtin_amdgcn_update_dpp(0, x, 0xB1, 0xF, 0xF, true);
    else if (ctrl_sel == 1) r = __builtin_amdgcn_update_dpp(0, x, 0x4E, 0xF, 0xF, true);
    else if (ctrl_sel == 2) r = __builtin_amdgcn_update_dpp(0, x, 0x141, 0xF, 0xF, true);
    else r = __builtin_amdgcn_update_dpp(0, x, 0x140, 0xF, 0xF, true);
    return __builtin_bit_cast(float, r);
}
__device__ __forceinline__ float allred16(float v) { v += dpp_f(v, 0); v += dpp_f(v, 1); v += dpp_f(v, 2); v += dpp_f(v, 3); return v; }

#define LDS_WAIT() asm volatile("s_waitcnt lgkmcnt(0)" ::: "memory")
#define VM_WAIT() asm volatile("s_waitcnt vmcnt(0)" ::: "memory")

namespace pg8 {
constexpr int BM = 256, BK = 64, HALF = 128, HTB = HALF * BK * 2, STAGE_BYTES = 8 * HTB, NXCD = 8, WGM = 8;
__host__ __device__ __forceinline__ int lds_byte(int r, int c) { const int st = (r >> 4) * 2 + (c >> 5), rr = r & 15, cc = c & 31, ob = rr * 64 + cc * 2; return st * 1024 + (ob ^ (((ob >> 9) & 1) << 5)); }
__host__ __device__ __forceinline__ void stage_rc(int b, int& R, int& C) { const int st = b / 1024, sb = b % 1024, swz = sb ^ (((sb >> 9) & 1) << 5); R = (st >> 1) * 16 + swz / 64; C = (st & 1) * 32 + (swz % 64) / 2; }
__host__ __device__ __forceinline__ int perm32(int rho) { const int n = rho >> 4, i = rho & 15; return 8 * (i >> 2) + 4 * n + (i & 3); }
struct Unit { const char* A; const char* B; int pm, pn, aux, ui; };
__device__ __forceinline__ int xcd_remap(int L, int nwg) { const int q = nwg / NXCD, r = nwg % NXCD, xcd = L % NXCD, off = L / NXCD; return (xcd < r ? xcd * (q + 1) : r * (q + 1) + (xcd - r) * q) + off; }
__device__ __forceinline__ void grid_tile(int wgid, int nM, int nN, int& pm, int& pn) { const int nig = WGM * nN, gid = wgid / nig, fm = gid * WGM, gsz = (nM - fm) < WGM ? (nM - fm) : WGM; pm = fm + ((wgid % nig) % gsz); pn = (wgid % nig) / gsz; }

__device__ __forceinline__ void stage2(LAS unsigned char* lds, int bufoff, unsigned ldsw, const char* g, unsigned o0, unsigned o1) {
    __builtin_amdgcn_global_load_lds((const unsigned*)(g + o0), (LAS unsigned*)(lds + bufoff + ldsw), 16, 0, 0);
    __builtin_amdgcn_global_load_lds((const unsigned*)(g + o1), (LAS unsigned*)(lds + bufoff + ldsw + 8192), 16, 0, 0);
}

typedef int v8i_t __attribute__((ext_vector_type(8)));
typedef int v4i_t __attribute__((ext_vector_type(4)));
__device__ __forceinline__ v8i_t mx_cat(const bf16x8& lo, const bf16x8& hi) { const v4i_t a = __builtin_bit_cast(v4i_t, lo), b = __builtin_bit_cast(v4i_t, hi); return __builtin_shufflevector(a, b, 0, 1, 2, 3, 4, 5, 6, 7); }

template <class Epi, class = void> struct EpiPerm16 { static constexpr bool value = false; };
template <class Epi> struct EpiPerm16<Epi, decltype((void)Epi::PERM16)> { static constexpr bool value = Epi::PERM16; };
template <class Epi> __host__ __device__ constexpr bool epi_perm16() { return EpiPerm16<Epi>::value; }
template <class Epi> __host__ __device__ __forceinline__ int perm_row(int R) {
    if (epi_perm16<Epi>()) { const int wc = R >> 5, rho = R & 31, n = rho >> 4, i = rho & 15; return 64 * wc + 16 * (i >> 2) + 4 * n + (i & 3); }
    return Epi::PERM ? ((R & ~31) + perm32(R & 31)) : R;
}
template <class Epi, class Sched, bool GATHER, bool ALIGN_EPI = true, int MXS = 0>
__device__ __forceinline__ void gemm_phase(LAS unsigned char* lds, const int wave_, const int K, const int lda, const int ldb, const Sched& S, const Epi& E) {
    int tid_ = wave_ * 64 + (int)__builtin_amdgcn_mbcnt_hi(~0u, __builtin_amdgcn_mbcnt_lo(~0u, 0u)); asm volatile("" : "+v"(tid_));
    const int tid = tid_, wid = __builtin_amdgcn_readfirstlane(tid >> 6), lane = tid & 63, wr = wid >> 2, wc = wid & 3, fr = lane & 15, fq = lane >> 4;
    const int nt = opaque_n(K / BK);
    unsigned voffA[2], voffB[2]; int RA[2], CA[2];
#pragma unroll
    for (int i = 0; i < 2; ++i) { int R, C; stage_rc(tid * 16 + i * 8192, R, C); const int Rb = perm_row<Epi>(R);
        RA[i] = R; CA[i] = C; voffA[i] = (unsigned)(R * lda + C) * 2u; voffB[i] = (unsigned)(Rb * ldb + C) * 2u; }
    const size_t kstep = (size_t)(BK * 2);
    const size_t hstepA = (size_t)HALF * lda * 2, hstepB = (size_t)(epi_perm16<Epi>() ? 8 : HALF) * ldb * 2;
    const unsigned ldsw = (unsigned)wid * 1024u;
    const int aoff = lds_byte(wr * 64 + fr, fq * 8), boff = lds_byte(wc * 32 + fr, fq * 8);
#define PG8_SA(b, h) (((b) * 2 + (h)) * HTB)
#define PG8_SB(b, h) ((4 + (b) * 2 + (h)) * HTB)
#define PG8_STB(bufoff, gbase) stage2(lds, (bufoff), ldsw, (gbase), voffB[0], voffB[1])
#define PG8_STA(bufoff, gk, h, NX) do { if constexpr (GATHER) { const unsigned _o0 = (NX) ? vn[h][0] : vc[h][0], _o1 = (NX) ? vn[h][1] : vc[h][1]; stage2(lds, (bufoff), ldsw, (gk), _o0, _o1); } \
        else stage2(lds, (bufoff), ldsw, (gk) + (h) * hstepA, voffA[0], voffA[1]); } while (0)
#define PG8_LDA(dst, b, h) do { _Pragma("unroll") for (int m = 0; m < 4; ++m) _Pragma("unroll") for (int k = 0; k < 2; ++k) dst[m][k] = *(const LAS bf16x8*)(lds + PG8_SA(b, h) + aoff + m * 2048 + k * 1024); } while (0)
#define PG8_LDB(dst, b, h) do { _Pragma("unroll") for (int n = 0; n < 2; ++n) _Pragma("unroll") for (int k = 0; k < 2; ++k) dst[n][k] = *(const LAS bf16x8*)(lds + PG8_SB(b, h) + boff + n * 2048 + k * 1024); } while (0)
#define PG8_MMA(ai, bj, At, Bt) do { __builtin_amdgcn_s_setprio(1); if constexpr (MXS != 0) { _Pragma("unroll") for (int m = 0; m < 4; ++m) _Pragma("unroll") for (int n = 0; n < 2; ++n) \
        asm volatile("v_mfma_scale_f32_16x16x128_f8f6f4 %0, %1, %2, %0, %3, %3 op_sel_hi:[0,0,0]" : "+v"(acc[ai][bj][m][n]) : "v"(mx_cat(Bt[n][0], Bt[n][1])), "v"(mx_cat(At[m][0], At[m][1])), "v"(mxs_)); } \
        else { _Pragma("unroll") for (int m = 0; m < 4; ++m) _Pragma("unroll") for (int n = 0; n < 2; ++n) _Pragma("unroll") for (int k = 0; k < 2; ++k) \
        acc[ai][bj][m][n] = __builtin_amdgcn_mfma_f32_16x16x32_bf16(Bt[n][k], At[m][k], acc[ai][bj][m][n], 0, 0, 0); } __builtin_amdgcn_s_setprio(0); } while (0)
#define PG8_WAIT_V(n) asm volatile("s_waitcnt vmcnt(" #n ")" ::: "memory")
#define PG8_WAIT_L(n) asm volatile("s_waitcnt lgkmcnt(" #n ")" ::: "memory")
#define PG8_BAR __builtin_amdgcn_s_barrier()
#define PG8_SCHED __builtin_amdgcn_sched_barrier(0)
    Unit cur, nxt; int ui = 0;
    if (!S.next(0, cur)) return;
    int mxs_ = MXS * 0x01010101; asm volatile("" : "+v"(mxs_));
    unsigned vc[2][2], vn[2][2];
    if constexpr (GATHER) {
#pragma unroll
        for (int h = 0; h < 2; ++h)
#pragma unroll
            for (int i = 0; i < 2; ++i) { vc[h][i] = ((unsigned)S.row(cur, h * HALF + RA[i]) * (unsigned)lda + (unsigned)CA[i]) * 2u; vn[h][i] = vc[h][i]; }
        if constexpr (!Sched::ROW_LDS) asm volatile("s_waitcnt vmcnt(0)" ::: "memory");
    }
    f32x4 acc[2][2][4][2];
#pragma unroll
    for (int a = 0; a < 2; ++a)
#pragma unroll
        for (int b = 0; b < 2; ++b)
#pragma unroll
            for (int m = 0; m < 4; ++m)
#pragma unroll
                for (int n = 0; n < 2; ++n) acc[a][b][m][n] = (f32x4){0.f, 0.f, 0.f, 0.f};
    bf16x8 At[4][2], B0[2][2], B1[2][2];
    const char* cA = cur.A; const char* cB = cur.B;
    PG8_STB(PG8_SB(0, 0), cB); PG8_STB(PG8_SB(0, 1), cB + hstepB); PG8_STA(PG8_SA(0, 0), cA, 0, false); PG8_STA(PG8_SA(0, 1), cA, 1, false);
    if (wr == 1) PG8_BAR;
    PG8_WAIT_V(2); PG8_BAR;
    PG8_STB(PG8_SB(1, 0), cB + kstep); PG8_STA(PG8_SA(1, 0), cA + kstep, 0, false); PG8_STB(PG8_SB(1, 1), cB + hstepB + kstep);
    PG8_WAIT_V(6); PG8_BAR;
    for (;;) {
        const bool has_next = S.next(ui + 1, nxt);
        const char* nA = has_next ? nxt.A : cA; const char* nB = has_next ? nxt.B : cB;
#pragma unroll 1
        for (int t = 0; t < nt; t += 2) {
            const bool last = (t == nt - 2);
            const char* a1 = cA + (size_t)(t + 1) * kstep;
            const char* a2 = last ? nA : cA + (size_t)(t + 2) * kstep; const char* b2 = last ? nB : cB + (size_t)(t + 2) * kstep;
            const char* a3 = a2 + kstep; const char* b3 = b2 + kstep;
            if constexpr (GATHER) {
                if (last && has_next) {
#pragma unroll
                    for (int h = 0; h < 2; ++h)
#pragma unroll
                        for (int i = 0; i < 2; ++i) vn[h][i] = ((unsigned)S.row(nxt, h * HALF + RA[i]) * (unsigned)lda + (unsigned)CA[i]) * 2u;
                    if constexpr (!Sched::ROW_LDS) asm volatile("s_waitcnt vmcnt(0)" ::: "memory");
                }
            }
            PG8_LDB(B0, 0, 0); PG8_LDB(B1, 0, 1); PG8_SCHED; PG8_LDA(At, 0, 0); PG8_STA(PG8_SA(1, 1), a1, 1, false);
            PG8_WAIT_V(8); PG8_WAIT_L(0); PG8_BAR; PG8_MMA(0, 0, At, B0); PG8_MMA(0, 1, At, B1); PG8_BAR; PG8_SCHED;
            PG8_LDA(At, 0, 1); PG8_STB(PG8_SB(0, 0), b2); PG8_STB(PG8_SB(0, 1), b2 + hstepB); PG8_STA(PG8_SA(0, 0), a2, 0, last);
            PG8_WAIT_V(8); PG8_WAIT_L(0); PG8_BAR; PG8_MMA(1, 0, At, B0); PG8_MMA(1, 1, At, B1); PG8_BAR; PG8_SCHED;
            PG8_LDB(B0, 1, 0); PG8_LDB(B1, 1, 1); PG8_SCHED; PG8_LDA(At, 1, 0); PG8_STA(PG8_SA(0, 1), a2, 1, last);
            PG8_WAIT_V(8); PG8_WAIT_L(0); PG8_BAR; PG8_MMA(0, 0, At, B0); PG8_MMA(0, 1, At, B1); PG8_BAR; PG8_SCHED;
            PG8_LDA(At, 1, 1); PG8_STB(PG8_SB(1, 0), b3); PG8_STB(PG8_SB(1, 1), b3 + hstepB); PG8_STA(PG8_SA(1, 0), a3, 0, last);
            PG8_WAIT_V(8); PG8_WAIT_L(0); PG8_BAR; PG8_MMA(1, 0, At, B0); PG8_MMA(1, 1, At, B1); PG8_BAR; PG8_SCHED;
        }
        if constexpr (ALIGN_EPI) { if (wr == 0) PG8_BAR; }
        if constexpr (MXS != 0) asm volatile("s_nop 15\n\ts_nop 15" ::: "memory");
        { int fr_ = fr, fq_ = fq; asm volatile("" : "+v"(fr_), "+v"(fq_));
          E(acc, cur, wr, wc, fr_, fq_); }
        if (!has_next) break;
#pragma unroll
        for (int a = 0; a < 2; ++a)
#pragma unroll
            for (int b = 0; b < 2; ++b)
#pragma unroll
                for (int m = 0; m < 4; ++m)
#pragma unroll
                    for (int n = 0; n < 2; ++n) acc[a][b][m][n] = (f32x4){0.f, 0.f, 0.f, 0.f};
        cur = nxt; cA = nA; cB = nB; ++ui;
        if constexpr (GATHER) {
#pragma unroll
            for (int h = 0; h < 2; ++h)
#pragma unroll
                for (int i = 0; i < 2; ++i) vc[h][i] = vn[h][i];
        }
        if constexpr (ALIGN_EPI) { if (wr == 1) PG8_BAR; }
    }
    PG8_WAIT_V(0);
    if constexpr (!ALIGN_EPI) { if (wr == 0) PG8_BAR; }
    PG8_BAR;
#undef PG8_SA
#undef PG8_SB
#undef PG8_STB
#undef PG8_STA
#undef PG8_LDA
#undef PG8_LDB
#undef PG8_MMA
#undef PG8_WAIT_V
#undef PG8_WAIT_L
#undef PG8_BAR
#undef PG8_SCHED
}
}
#define XB_TMO      128
#define XB_XCNT(j)  (256  + 64 * (j))
#define XB_XSUB(j)  (1280 + 64 * (j))
#define XB_XGEN(j)  (2304 + 64 * (j))
#define XB_TOP      3328
#define XB_TOPGEN   3392
#define XCD_BAR_WORDS 3456
#define XB_SPIN_CAP (1u << 18)
__device__ __forceinline__ unsigned xb_ld(unsigned* p)              { return __hip_atomic_load(p, __ATOMIC_RELAXED, __HIP_MEMORY_SCOPE_AGENT); }
__device__ __forceinline__ unsigned xb_add(unsigned* p, unsigned v) { return __hip_atomic_fetch_add(p, v, __ATOMIC_RELAXED, __HIP_MEMORY_SCOPE_AGENT); }
__device__ __forceinline__ unsigned xb_xcc_id() { return (unsigned)__builtin_amdgcn_s_getreg((3 << 11) | 20) & 0xFu; }
#define XB_SPIN(cond, bar) do { unsigned _sp = 0; while (cond) { __builtin_amdgcn_s_sleep(1); \
    if ((++_sp & 255u) == 0u) { if (xb_ld(&(bar)[XB_TMO])) break; if (_sp > XB_SPIN_CAP) { atomicAdd(&(bar)[XB_TMO], 1u); break; } } } } while (0)
struct XcdBarrier { unsigned* bar; unsigned x; volatile LAS unsigned* st; };
__device__ __forceinline__ XcdBarrier xcd_barrier_post(unsigned* bar, volatile LAS unsigned* st) {
    XcdBarrier b; b.bar = bar; b.x = xb_xcc_id(); b.st = st;
    if (threadIdx.x == 0) (void)xb_add(&bar[XB_XCNT(b.x)], 1u);
    return b;
}
__device__ __forceinline__ void xcd_barrier_complete(unsigned* bar, unsigned x, unsigned& nloc, unsigned& nx) {
    const unsigned G = gridDim.x * gridDim.y * gridDim.z;
    unsigned sum, cnt, mine, sp = 0u;
    for (;;) {
        sum = 0u; cnt = 0u; mine = 0u;
#pragma unroll
        for (unsigned j = 0; j < 16; ++j) { const unsigned c = xb_ld(&bar[XB_XCNT(j)]); sum += c; cnt += (c > 0u) ? 1u : 0u; mine = (j == x) ? c : mine; }
        if (sum == G) break;
        __builtin_amdgcn_s_sleep(1);
        if ((++sp & 255u) == 0u) { if (xb_ld(&bar[XB_TMO])) break; if (sp > XB_SPIN_CAP) { atomicAdd(&bar[XB_TMO], 1u); break; } }
    }
    nloc = mine > 0u ? mine : 1u; nx = cnt > 0u ? cnt : 1u;
}
__device__ __forceinline__ void xcd_barrier(const XcdBarrier& b) {
    asm volatile("s_waitcnt vmcnt(0)" ::: "memory");
    __syncthreads();
    if (threadIdx.x == 0) {
        unsigned* bar = b.bar;
        __builtin_amdgcn_s_waitcnt(0);
        unsigned nloc = b.st[0], nx = b.st[1];
        if (nloc == 0u) { xcd_barrier_complete(bar, b.x, nloc, nx); b.st[0] = nloc; b.st[1] = nx; }
        const unsigned old = xb_add(&bar[XB_XSUB(b.x)], 1u);
        const unsigned gen = old / nloc;
        if (old + 1u == (gen + 1u) * nloc) {
            __builtin_amdgcn_fence(__ATOMIC_RELEASE, "agent");
            asm volatile("s_waitcnt vmcnt(0)" ::: "memory");
            const unsigned og = xb_add(&bar[XB_TOP], 1u);
            const unsigned tg = og / nx;
            if (og + 1u == (tg + 1u) * nx) xb_add(&bar[XB_TOPGEN], 1u);
            else XB_SPIN(xb_ld(&bar[XB_TOPGEN]) == tg, bar);
            __builtin_amdgcn_fence(__ATOMIC_ACQUIRE, "agent");
            xb_add(&bar[XB_XGEN(b.x)], 1u);
            asm volatile("s_waitcnt vmcnt(0)" ::: "memory");
        } else {
            XB_SPIN(xb_ld(&bar[XB_XGEN(b.x)]) == gen, bar);
            __builtin_amdgcn_fence(__ATOMIC_ACQUIRE, "agent");
            asm volatile("s_waitcnt vmcnt(0)" ::: "memory");
        }
    }
    __syncthreads();
}

constexpr size_t MiB = 1u << 20;
constexpr size_t WS_CTL = 0, CTL_ZERO_BYTES = 64 * 1024;
constexpr size_t WS_MOD = 1 * MiB;
constexpr size_t WS_EIDX = 2 * MiB;
constexpr size_t WS_WSEL = WS_EIDX + 512 * 1024;
constexpr size_t WS_RANK = WS_WSEL + 512 * 1024;
constexpr size_t WS_TOK = 4 * MiB;
constexpr size_t WS_DST = WS_TOK + 1 * MiB;
constexpr size_t WS_WSL = WS_DST + 1 * MiB;
constexpr size_t WS_WIN = 8 * MiB;
constexpr size_t WS_POOLW = 55 * MiB;
constexpr size_t WS_WPO = 56 * MiB;
constexpr size_t WS_LORA = 60 * MiB;
constexpr size_t WS_G2 = 62 * MiB;
constexpr size_t WS_WRO = 63 * MiB;
constexpr size_t WS_WO = 71 * MiB;
constexpr size_t WS_SLAB = 80 * MiB;
constexpr size_t WS_EA = 80 * MiB;
constexpr size_t EA_STRIDE = (size_t)MT * D * 2;
constexpr size_t WS_YF = 352 * MiB, WS_YB = 416 * MiB;
constexpr size_t WS_HA = 438 * MiB;
constexpr size_t WS_Z = 480 * MiB;
constexpr size_t WS_U = 506 * MiB;
constexpr size_t WS_RM = 544 * MiB, WS_KM = 612 * MiB, WS_VM = 680 * MiB;
constexpr size_t WS_LIN = 748 * MiB;
constexpr size_t WS_DP = 774 * MiB;
constexpr size_t WS_BON = 774 * MiB;
constexpr size_t WS_Y2 = 806 * MiB;
constexpr size_t WS_MP = 838 * MiB;
constexpr size_t WS_GATES = 902 * MiB;
constexpr size_t WS_OR = 80 * MiB;
constexpr size_t WS_H2 = 520 * MiB;
constexpr size_t WS_GU = 584 * MiB;
constexpr size_t WS_GU2 = 966 * MiB, WS_GU3 = 1134 * MiB;
constexpr int GU_E2 = 52, GU_E3 = 61;
constexpr size_t WS_ACT = 792 * MiB;
constexpr size_t WS_DT = 1004 * MiB;
constexpr size_t WS_X1 = 328 * MiB;
constexpr size_t WS_YP = 8 * MiB;
constexpr size_t WS_END = 1150 * MiB;
__host__ __device__ __forceinline__ size_t gu_base(int e) { return e < GU_E2 ? WS_GU + (size_t)e * (4 * MiB) : e < GU_E3 ? WS_GU2 + (size_t)(e - GU_E2) * (4 * MiB) : WS_GU3 + (size_t)(e - GU_E3) * (4 * MiB); }
constexpr int CW_BAR = 1024;
constexpr int CW_GCNT = 8192;
constexpr int CW_O64 = 8192 + 100;
constexpr int CW_CONV = 8448, CW_P2DONE = 8512;
static_assert((CW_BAR + XCD_BAR_WORDS) <= CW_GCNT && (CW_P2DONE + 128) * 4 <= (int)CTL_ZERO_BYTES, "ctl");

constexpr int RING_OFF = 0, RING_BYTES = 131072;
constexpr int LDSCTL_OFF = RING_BYTES;
constexpr int ROWTAB_OFF = LDSCTL_OFF + 1024 + 4096, ROWTAB_UNITS = 24;
constexpr int TAB_OFF = LDSCTL_OFF + 1024;
constexpr int LDS_BYTES = 163840;

using pg8::Unit;
struct RepOrder { static constexpr bool ROW_LDS = false;
    const char* A; const char* B; size_t repA, repB, tA, tB; int nM, nN, nrep, G, c;
    __device__ __forceinline__ bool next(int i, Unit& u) const {
        const long L = (long)i * G + c; const int per = nM * nN; if (L >= (long)per * nrep) return false;
        const int rep = (int)(L / per); const int w = pg8::xcd_remap((int)(L % per), per); pg8::grid_tile(w, nM, nN, u.pm, u.pn); u.aux = rep;
        u.A = A + (size_t)rep * repA + (size_t)u.pm * tA; u.B = B + (size_t)rep * repB + (size_t)u.pn * tB; return true; }
    __device__ __forceinline__ int row(const Unit&, int) const { return 0; }
};
struct G1Order { static constexpr bool ROW_LDS = false;
    const char* A; const char* B; size_t tA, tB; int G, c;
    __device__ __forceinline__ bool next(int i, Unit& u) const {
        const long L = (long)i * G + c; constexpr int N1 = 64 * 47, N2 = 4 * 27; if (L >= N1 + N2) return false;
        if (L < N1) { const int w = pg8::xcd_remap((int)L, N1); pg8::grid_tile(w, 64, 47, u.pm, u.pn); }
        else { const int l2 = (int)L - N1; u.pm = 64 + (l2 & 3); u.pn = 4 + (l2 >> 2); }
        u.aux = 0; u.A = A + (size_t)u.pm * tA; u.B = B + (size_t)u.pn * tB; return true; }
    __device__ __forceinline__ int row(const Unit&, int) const { return 0; }
};
template <bool GUMAP> struct MoeOrderT { static constexpr bool ROW_LDS = true;
    const char* A; const char* B; const LAS int* te; const LAS int* rowtab; size_t tA, estride, jstride; int ntiles, NJ, G, c;
    __device__ __forceinline__ bool next(int i, Unit& u) const {
        const long L = (long)i * G + c; const int tot = ntiles * NJ; if (L >= tot) return false;
        const int w = pg8::xcd_remap((int)L, tot); const int rt = w / NJ, j = w - rt * NJ; const int e = te[rt];
        u.pm = rt; u.pn = j; u.aux = e; u.ui = i; u.A = A + (size_t)rt * tA; u.B = B + (GUMAP ? gu_base(e) : (size_t)e * estride) + (size_t)j * jstride; return true; }
    __device__ __forceinline__ int row(const Unit& u, int r) const { return rowtab[u.ui * 256 + r]; }
};

typedef f32x4 AccT[2][2][4][2];
#define EPI_ROWS_BEGIN _Pragma("unroll") for (int ai = 0; ai < 2; ++ai) _Pragma("unroll") for (int m = 0; m < 4; ++m) { const int rl = ai * 128 + wr * 64 + m * 16 + fr;
#define EPI_ROWS_END if (m & 1) asm volatile("" ::: "memory"); }
struct EpiG1 { static constexpr bool PERM = true; bf16* U; bf16* SLAB; unsigned char* GATES;
    __device__ __forceinline__ void operator()(const AccT& acc, const Unit& u, int wr, int wc, int fr, int fq) const {
        if (u.pn >= 31) {
            const int c0 = (u.pn - 31) * 256 + wc * 32 + 8 * fq;
            EPI_ROWS_BEGIN
                unsigned char* rowp = GATES + (size_t)(u.pm * 256 + rl) * 4096 + c0;
#pragma unroll
                for (int bj = 0; bj < 2; ++bj) { const f32x4 v0 = acc[ai][bj][m][0], v1 = acc[ai][bj][m][1]; unsigned p0 = 0u, p1 = 0u;
                    p0 = __builtin_amdgcn_cvt_pk_u8_f32(255.0f * sigmoidf_(v0[0]), 0, p0); p0 = __builtin_amdgcn_cvt_pk_u8_f32(255.0f * sigmoidf_(v0[1]), 1, p0);
                    p0 = __builtin_amdgcn_cvt_pk_u8_f32(255.0f * sigmoidf_(v0[2]), 2, p0); p0 = __builtin_amdgcn_cvt_pk_u8_f32(255.0f * sigmoidf_(v0[3]), 3, p0);
                    p1 = __builtin_amdgcn_cvt_pk_u8_f32(255.0f * sigmoidf_(v1[0]), 0, p1); p1 = __builtin_amdgcn_cvt_pk_u8_f32(255.0f * sigmoidf_(v1[1]), 1, p1);
                    p1 = __builtin_amdgcn_cvt_pk_u8_f32(255.0f * sigmoidf_(v1[2]), 2, p1); p1 = __builtin_amdgcn_cvt_pk_u8_f32(255.0f * sigmoidf_(v1[3]), 3, p1);
                    v2u w; w.x = p0; w.y = p1; *(v2u*)(rowp + bj * 128) = w; }
            EPI_ROWS_END
            return;
        }
        bf16* base; int ld, c0;
        if (u.pn < 4) { base = U; ld = 1024; c0 = u.pn * 256; } else { base = SLAB; ld = SLABLD; c0 = (u.pn - 4) * 256; }
        EPI_ROWS_BEGIN
            bf16* rowp = base + (size_t)(u.pm * 256 + rl) * ld + c0 + wc * 32 + 8 * fq;
#pragma unroll
            for (int bj = 0; bj < 2; ++bj) { const f32x4 v0 = acc[ai][bj][m][0], v1 = acc[ai][bj][m][1];
                v4u w; w.x = pk2(v0[0], v0[1]); w.y = pk2(v0[2], v0[3]); w.z = pk2(v1[0], v1[1]); w.w = pk2(v1[2], v1[3]); *(v4u*)(rowp + bj * 128) = w; }
        EPI_ROWS_END
    }
};
struct EpiLora { static constexpr bool PERM = true; unsigned short* EA; const float* w0; const float* a0;
    __device__ __forceinline__ void operator()(const AccT& acc, const Unit& u, int wr, int wc, int fr, int fq) const {
        const int rep = u.aux; const float* bias = (rep < 2 ? w0 + rep * D : a0 + (rep - 2) * D) + u.pn * 256 + wc * 32 + 8 * fq;
        unsigned short* base = EA + (size_t)rep * ((size_t)MT * D);
        if (rep < 2) { const float cc = -0.8750424f;
            EPI_ROWS_BEGIN
                unsigned short* rowp = base + (size_t)(u.pm * 256 + rl) * D + u.pn * 256 + wc * 32 + 8 * fq;
#pragma unroll
                for (int bj = 0; bj < 2; ++bj) { const f32x4 v0 = acc[ai][bj][m][0] + *(const f32x4*)(bias + bj * 128), v1 = acc[ai][bj][m][1] + *(const f32x4*)(bias + bj * 128 + 4);
                    v4u w; w.x = pkh2(cc * sigmoidf_(v0[0]), cc * sigmoidf_(v0[1])); w.y = pkh2(cc * sigmoidf_(v0[2]), cc * sigmoidf_(v0[3]));
                    w.z = pkh2(cc * sigmoidf_(v1[0]), cc * sigmoidf_(v1[1])); w.w = pkh2(cc * sigmoidf_(v1[2]), cc * sigmoidf_(v1[3]));
                    *(v4u*)(rowp + bj * 128) = w; }
            EPI_ROWS_END
        } else {
            EPI_ROWS_BEGIN
                unsigned char* rowp = (unsigned char*)base + (size_t)(u.pm * 256 + rl) * D + u.pn * 256 + wc * 32 + 8 * fq;
#pragma unroll
                for (int bj = 0; bj < 2; ++bj) { const f32x4 v0 = acc[ai][bj][m][0] + *(const f32x4*)(bias + bj * 128), v1 = acc[ai][bj][m][1] + *(const f32x4*)(bias + bj * 128 + 4); unsigned p0 = 0u, p1 = 0u;
                    p0 = __builtin_amdgcn_cvt_pk_u8_f32(255.0f * sigmoidf_(v0[0]), 0, p0); p0 = __builtin_amdgcn_cvt_pk_u8_f32(255.0f * sigmoidf_(v0[1]), 1, p0);
                    p0 = __builtin_amdgcn_cvt_pk_u8_f32(255.0f * sigmoidf_(v0[2]), 2, p0); p0 = __builtin_amdgcn_cvt_pk_u8_f32(255.0f * sigmoidf_(v0[3]), 3, p0);
                    p1 = __builtin_amdgcn_cvt_pk_u8_f32(255.0f * sigmoidf_(v1[0]), 0, p1); p1 = __builtin_amdgcn_cvt_pk_u8_f32(255.0f * sigmoidf_(v1[1]), 1, p1);
                    p1 = __builtin_amdgcn_cvt_pk_u8_f32(255.0f * sigmoidf_(v1[2]), 2, p1); p1 = __builtin_amdgcn_cvt_pk_u8_f32(255.0f * sigmoidf_(v1[3]), 3, p1);
                    v2u w; w.x = p0; w.y = p1; *(v2u*)(rowp + bj * 128) = w; }
            EPI_ROWS_END
        }
    }
};
struct EpiPoolG { static constexpr bool PERM = true; bf16* Y2; const float* scale;
    __device__ __forceinline__ void operator()(const AccT& acc, const Unit& u, int wr, int wc, int fr, int fq) const {
        const int cb = u.aux * 256 + wc * 32 + 8 * fq;
        f32x4 s0[2], s1[2];
#pragma unroll
        for (int bj = 0; bj < 2; ++bj) { s0[bj] = *(const f32x4*)(scale + cb + bj * 128); s1[bj] = *(const f32x4*)(scale + cb + bj * 128 + 4); }
        EPI_ROWS_BEGIN
            bf16* rowp = Y2 + (size_t)(u.pm * 256 + rl) * 1024 + cb;
#pragma unroll
            for (int bj = 0; bj < 2; ++bj) { const f32x4 v0 = acc[ai][bj][m][0] * s0[bj], v1 = acc[ai][bj][m][1] * s1[bj];
                v4u w; w.x = pk2(v0[0], v0[1]); w.y = pk2(v0[2], v0[3]); w.z = pk2(v1[0], v1[1]); w.w = pk2(v1[2], v1[3]); *(v4u*)(rowp + bj * 128) = w; }
        EPI_ROWS_END
    }
};
template <int MODE, bool OUT8 = false> struct EpiMix { static constexpr bool PERM = true; bf16* OUT;
    int ldo; const void* AUX1; int ld1; const bf16* AUX2; int ld2;
    __device__ __forceinline__ void operator()(const AccT& acc, const Unit& u, int wr, int wc, int fr, int fq) const {
        const int cb = u.pn * 256 + wc * 32 + 8 * fq;
        EPI_ROWS_BEGIN
            const size_t row = (size_t)(u.pm * 256 + rl);
#pragma unroll
            for (int bj = 0; bj < 2; ++bj) { const f32x4 v0 = acc[ai][bj][m][0], v1 = acc[ai][bj][m][1];
                float x[8];
                if (MODE == 1) { const v4u a1 = *(const v4u*)((const bf16*)AUX1 + row * ld1 + cb + bj * 128);
                    x[0] = bflo(a1.x); x[1] = bfhi(a1.x); x[2] = bflo(a1.y); x[3] = bfhi(a1.y); x[4] = bflo(a1.z); x[5] = bfhi(a1.z); x[6] = bflo(a1.w); x[7] = bfhi(a1.w); }
                else { const v2u a1 = *(const v2u*)((const unsigned char*)AUX1 + row * ld1 + cb + bj * 128); const float k = 1.0f / 255.0f;
                    x[0] = (float)(a1.x & 0xffu) * k; x[1] = (float)((a1.x >> 8) & 0xffu) * k; x[2] = (float)((a1.x >> 16) & 0xffu) * k; x[3] = (float)(a1.x >> 24) * k;
                    x[4] = (float)(a1.y & 0xffu) * k; x[5] = (float)((a1.y >> 8) & 0xffu) * k; x[6] = (float)((a1.y >> 16) & 0xffu) * k; x[7] = (float)(a1.y >> 24) * k; }
                float o[8];
                if (MODE == 0 || MODE == 1) {
#pragma unroll
                    for (int j = 0; j < 4; ++j) { o[j] = x[j] * v0[j]; o[4 + j] = x[4 + j] * v1[j]; } }
                else { const v4u a2 = *(const v4u*)(AUX2 + row * ld2 + cb + bj * 128);
                    const float y[8] = {bflo(a2.x), bfhi(a2.x), bflo(a2.y), bfhi(a2.y), bflo(a2.z), bfhi(a2.z), bflo(a2.w), bfhi(a2.w)};
#pragma unroll
                    for (int j = 0; j < 4; ++j) { o[j] = y[j] + x[j] * v0[j]; o[4 + j] = y[4 + j] + x[4 + j] * v1[j]; } }
                if (OUT8) { v2u w; w.x = pk8(8.0f * o[0], 8.0f * o[1], 8.0f * o[2], 8.0f * o[3]); w.y = pk8(8.0f * o[4], 8.0f * o[5], 8.0f * o[6], 8.0f * o[7]); *(v2u*)((unsigned char*)OUT + row * ldo + cb + bj * 128) = w; }
                else { v4u w; w.x = pk2(o[0], o[1]); w.y = pk2(o[2], o[3]); w.z = pk2(o[4], o[5]); w.w = pk2(o[6], o[7]);
                *(v4u*)(OUT + row * ldo + cb + bj * 128) = w; } }
        EPI_ROWS_END
    }
};
struct EpiX1 { static constexpr bool PERM = true; const float* X; bf16* OUT; const float* MOD;
    __device__ __forceinline__ void operator()(const AccT& acc, const Unit& u, int wr, int wc, int fr, int fq) const {
        const int b = u.pm >> 4;
        const int cb = u.pn * 256 + wc * 32 + 8 * fq; const float* g = MOD + (size_t)b * 12288 + 4096 + cb;
        f32x4 gv[2][2];
#pragma unroll
        for (int bj = 0; bj < 2; ++bj)
#pragma unroll
            for (int n = 0; n < 2; ++n) gv[bj][n] = *(const f32x4*)(g + bj * 128 + n * 4);
        EPI_ROWS_BEGIN
            const size_t off = (size_t)(u.pm * 256 + rl) * D + cb;
#pragma unroll
            for (int bj = 0; bj < 2; ++bj) { const f32x4 x0 = *(const f32x4*)(X + off + bj * 128), x1 = *(const f32x4*)(X + off + bj * 128 + 4);
                const f32x4 v0 = x0 + gv[bj][0] * acc[ai][bj][m][0], v1 = x1 + gv[bj][1] * acc[ai][bj][m][1];
                v4u w; w.x = pk2(v0[0], v0[1]); w.y = pk2(v0[2], v0[3]); w.z = pk2(v1[0], v1[1]); w.w = pk2(v1[2], v1[3]); *(v4u*)(OUT + off + bj * 128) = w; }
        EPI_ROWS_END
    }
};
constexpr float ACT_F8SCALE = 8.0f;
struct EpiAct { static constexpr bool PERM = true; unsigned char* ACT;
    __device__ __forceinline__ void operator()(const AccT& acc, const Unit& u, int wr, int wc, int fr, int fq) const {
        EPI_ROWS_BEGIN
            const f32x4 g0 = acc[ai][0][m][0], g1 = acc[ai][0][m][1], u0 = acc[ai][1][m][0], u1 = acc[ai][1][m][1];
            float o[8];
#pragma unroll
            for (int j = 0; j < 4; ++j) { o[j] = __builtin_amdgcn_fmed3f(ACT_F8SCALE * g0[j] * sigmoidf_(g0[j]) * u0[j], -440.f, 440.f); o[4 + j] = __builtin_amdgcn_fmed3f(ACT_F8SCALE * g1[j] * sigmoidf_(g1[j]) * u1[j], -440.f, 440.f); }
            v2u w; w.x = pk8(o[0], o[1], o[2], o[3]); w.y = pk8(o[4], o[5], o[6], o[7]);
            *(v2u*)(ACT + (size_t)(u.pm * 256 + rl) * DEXP + u.pn * 128 + wc * 32 + 8 * fq) = w;
        EPI_ROWS_END
    }
};
constexpr float YP_SCALE = 8.0f;
struct EpiDown { static constexpr bool PERM = true, PERM16 = true; unsigned char* YP;
    __device__ __forceinline__ void operator()(const AccT& acc, const Unit& u, int wr, int wc, int fr, int fq) const {
        const int cb = u.pn * 256 + wc * 64 + 16 * fq;
        EPI_ROWS_BEGIN
            int p[4];
#pragma unroll
            for (int bj = 0; bj < 2; ++bj) { const f32x4 v0 = acc[ai][bj][m][0] * YP_SCALE, v1 = acc[ai][bj][m][1] * YP_SCALE;
                int p0 = __builtin_amdgcn_cvt_pk_fp8_f32(v0[0], v0[1], 0, false); p0 = __builtin_amdgcn_cvt_pk_fp8_f32(v0[2], v0[3], p0, true);
                int p1 = __builtin_amdgcn_cvt_pk_fp8_f32(v1[0], v1[1], 0, false); p1 = __builtin_amdgcn_cvt_pk_fp8_f32(v1[2], v1[3], p1, true);
                p[2 * bj] = p0; p[2 * bj + 1] = p1; }
            v4u w; w.x = (unsigned)p[0]; w.y = (unsigned)p[1]; w.z = (unsigned)p[2]; w.w = (unsigned)p[3];
            *(v4u*)(YP + (size_t)(u.pm * 256 + rl) * D + cb) = w;
        EPI_ROWS_END
    }
};
struct Frame {
    LAS unsigned char* lds;
    volatile LAS unsigned* MISC;
    unsigned* ctl;
    int tid, lane, wave, vcu, G;
    unsigned char* ws;
};
struct Args { const float* in[34]; float* out; unsigned char* ws; int ph_lo, ph_hi; };
enum { I_X = 0, I_C, I_CTX, I_CCTX, I_N1G, I_N2G, I_ADAW, I_ADAB, I_WIN, I_MU, I_POOLW, I_POOLS, I_WPO, I_DW0, I_DW2, I_IA0, I_IA2, I_G2, I_KK, I_KA, I_RK, I_LNW, I_LNB,
       I_WRO, I_WO, I_RW, I_RB, I_EG, I_EU, I_ED, I_SG, I_SU, I_SD, I_FG };

struct TrJob { const float* src; bf16* dst; int ldw, kvalid, ldt, k0, n0, drow0; float f8; };
template <bool NT = false> __device__ __forceinline__ void tr_load(const TrJob& j, f32x4 (&v)[16], int lane) {
    const int r2 = lane >> 4, c4 = lane & 15;
#pragma unroll
    for (int i = 0; i < 8; ++i) {
#pragma unroll
        for (int h = 0; h < 2; ++h) { const int k = j.k0 + 8 * i + 2 * r2 + h; const int kc = k < j.kvalid ? k : 0;
            const f32x4* sp_ = (const f32x4*)(j.src + (size_t)kc * j.ldw + j.n0 + 4 * c4); const f32x4 x = NT ? __builtin_nontemporal_load(sp_) : *sp_; v[2 * i + h] = (k < j.kvalid) ? x : (f32x4){0.f, 0.f, 0.f, 0.f}; } }
}
template <bool NT = false> __device__ __forceinline__ void tr_store(const TrJob& j, const f32x4 (&v)[16], LAS unsigned* P, int lane) {
    const int r2 = lane >> 4, c4 = lane & 15;
#pragma unroll
    for (int i = 0; i < 8; ++i) { LAS unsigned* p = P + (4 * i + r2) * 65 + 4 * c4;
        p[0] = pk2(v[2 * i].x, v[2 * i + 1].x); p[1] = pk2(v[2 * i].y, v[2 * i + 1].y); p[2] = pk2(v[2 * i].z, v[2 * i + 1].z); p[3] = pk2(v[2 * i].w, v[2 * i + 1].w); }
    LDS_WAIT(); asm volatile("" ::: "memory");
    const int nl = lane >> 3, q = lane & 7;
#pragma unroll
    for (int jj = 0; jj < 8; ++jj) { const int n = 8 * jj + nl; const LAS unsigned* s = P + (4 * q) * 65 + n;
        v4u o; o.x = s[0]; o.y = s[65]; o.z = s[130]; o.w = s[195];
        v4u* dp_ = (v4u*)(j.dst + (size_t)(j.drow0 + n) * j.ldt + j.k0 + 8 * q); if (NT) __builtin_nontemporal_store(o, dp_); else *dp_ = o; }
    LDS_WAIT(); asm volatile("" ::: "memory");
}
template <bool NT = false> __device__ __forceinline__ void tr8_load(const TrJob& j, int half, f32x4 (&v)[16], int lane) {
    const int r2 = lane >> 4, c4 = lane & 15;
#pragma unroll
    for (int i = 0; i < 4; ++i) {
#pragma unroll
        for (int h = 0; h < 4; ++h) { const int k = j.k0 + 64 * half + 16 * i + 4 * r2 + h; const f32x4* sp_ = (const f32x4*)(j.src + (size_t)k * j.ldw + j.n0 + 4 * c4); v[4 * i + h] = NT ? __builtin_nontemporal_load(sp_) : *sp_; } }
}
__device__ __forceinline__ void tr8_lds(const TrJob& j, int half, const f32x4 (&v)[16], LAS unsigned* P, int lane) {
    const int r2 = lane >> 4, c4 = lane & 15; const float sc = j.f8;
#pragma unroll
    for (int i = 0; i < 4; ++i) { LAS unsigned* p = P + (16 * half + 4 * i + r2) * 65 + 4 * c4;
        p[0] = pk8(sc * v[4 * i].x, sc * v[4 * i + 1].x, sc * v[4 * i + 2].x, sc * v[4 * i + 3].x); p[1] = pk8(sc * v[4 * i].y, sc * v[4 * i + 1].y, sc * v[4 * i + 2].y, sc * v[4 * i + 3].y);
        p[2] = pk8(sc * v[4 * i].z, sc * v[4 * i + 1].z, sc * v[4 * i + 2].z, sc * v[4 * i + 3].z); p[3] = pk8(sc * v[4 * i].w, sc * v[4 * i + 1].w, sc * v[4 * i + 2].w, sc * v[4 * i + 3].w); }
}
template <bool NT = false> __device__ __forceinline__ void tr8_flush(const TrJob& j, LAS unsigned* P, int lane) {
    LDS_WAIT(); asm volatile("" ::: "memory");
    const int nl = lane >> 3, q = lane & 7;
#pragma unroll
    for (int jj = 0; jj < 8; ++jj) { const int n = 8 * jj + nl; const LAS unsigned* s = P + (4 * q) * 65 + n;
        v4u o; o.x = s[0]; o.y = s[65]; o.z = s[130]; o.w = s[195];
        v4u* dp_ = (v4u*)((unsigned char*)j.dst + (size_t)(j.drow0 + n) * j.ldt + j.k0 + 16 * q); if (NT) __builtin_nontemporal_store(o, dp_); else *dp_ = o; }
    LDS_WAIT(); asm volatile("" ::: "memory");
}
template <class Dec> __device__ __forceinline__ void tr_run8(const Dec& dec, int first, int stride, LAS unsigned* P, int lane) {
    TrJob j, jn; f32x4 va[16], vb[16];
    int it = first; bool h = dec(it, j); if (h) { tr8_load(j, 0, va, lane); tr8_load(j, 1, vb, lane); }
    while (h) {
        tr8_lds(j, 0, va, P, lane); tr8_lds(j, 1, vb, P, lane);
        it += stride; const bool hn = dec(it, jn); if (hn) { tr8_load(jn, 0, va, lane); tr8_load(jn, 1, vb, lane); }
        tr8_flush(j, P, lane);
        j = jn; h = hn;
    }
}
template <class Dec> __device__ __forceinline__ void tr_run(const Dec& dec, int first, int stride, LAS unsigned* P, int lane) {
    TrJob ja, jb; f32x4 va[16], vb[16];
    int it = first; bool ha = dec(it, ja); if (ha) tr_load(ja, va, lane);
    while (ha) {
        it += stride; const bool hb = dec(it, jb); if (hb) tr_load(jb, vb, lane);
        tr_store(ja, va, P, lane);
        if (!hb) break;
        it += stride; ha = dec(it, ja); if (ha) tr_load(ja, va, lane);
        tr_store(jb, vb, P, lane);
    }
}
__device__ __forceinline__ void p0_prologue(Frame& F, const Args& a) {
    {
        LAS float* sv = (LAS float*)F.lds;
        LAS float* part = (LAS float*)(F.lds + 40960);
        bool did = false;
        for (int cb = blockIdx.x; cb < 192; cb += F.G) {
            if (!did) { for (int idx = F.tid; idx < 5 * D; idx += 512) { const int j = idx >> 11, k = idx & 2047; const float v = (j < 4) ? a.in[I_C][j * D + k] : a.in[I_CCTX][k]; sv[idx] = v / (1.0f + __expf(-v)); } did = true; }
            __syncthreads();
            const int col = 64 * cb + F.lane, k0 = 256 * F.wave; const float* wp = a.in[I_ADAW] + (size_t)k0 * 12288 + col;
            float acc[5] = {0.f, 0.f, 0.f, 0.f, 0.f};
#pragma unroll 32
            for (int k = 0; k < 256; ++k) { const float w = wp[(size_t)k * 12288];
#pragma unroll
                for (int j = 0; j < 5; ++j) acc[j] += sv[j * D + k0 + k] * w; }
#pragma unroll
            for (int j = 0; j < 5; ++j) part[(F.wave * 5 + j) * 64 + F.lane] = acc[j];
            __syncthreads();
            if (F.tid < 320) { const int j = F.tid >> 6, l = F.tid & 63; float s = a.in[I_ADAB][64 * cb + l];
#pragma unroll
                for (int w = 0; w < 8; ++w) s += part[(w * 5 + j) * 64 + l];
                ((float*)(F.ws + WS_MOD))[j * 12288 + 64 * cb + l] = s; }
            __syncthreads();
        }
        __syncthreads();
    }
    {
        struct DecSmall { const float* const* in; unsigned char* ws;
            __device__ __forceinline__ bool operator()(int it, TrJob& j) const {
                constexpr int I_1 = P2_FP8 ? 0 : 32 * 186, I_2 = 4 * 16, I_3 = 16 * 32, I_4 = 4 * 32, I_5 = 32 * 32, I_6 = 32 * 32, I_7 = 4 * 2 * 32;
                int r = it; if (r < 0) return false;
                if (r < I_1) { const int kb = r / 186, nb = r % 186, n0 = nb * 64; j = TrJob{in[I_WIN], (bf16*)(ws + WS_WIN), DIN, D, D, kb * 64, n0, n0 + (n0 >= 7808 ? 128 : 0)}; return true; } r -= I_1;
                if (r < I_2) { const int g = r / 16, q = r % 16; j = TrJob{in[I_POOLW] + (size_t)g * 65536, (bf16*)(ws + WS_POOLW) + (size_t)g * 65536, 256, 256, 256, (q / 4) * 64, (q % 4) * 64, (q % 4) * 64}; return true; } r -= I_2;
                if (r < I_3) { j = TrJob{in[I_WPO], (bf16*)(ws + WS_WPO), D, 1024, 1024, (r / 32) * 64, (r % 32) * 64, (r % 32) * 64}; return true; } r -= I_3;
                if (r < I_4) { j = TrJob{in[I_G2], (bf16*)(ws + WS_G2), D, 256, 256, (r / 32) * 64, (r % 32) * 64, (r % 32) * 64}; return true; } r -= I_4;
                if (r < I_5) { j = TrJob{in[I_WRO], (bf16*)(ws + WS_WRO), D, D, D, (r / 32) * 64, (r % 32) * 64, (r % 32) * 64}; return true; } r -= I_5;
                if (r < I_6) { j = TrJob{in[I_WO], (bf16*)(ws + WS_WO), D, D, D, (r / 32) * 64, (r % 32) * 64, (r % 32) * 64}; return true; } r -= I_6;
                if (r < I_7) { const int mtx = r / 64, q = r % 64;
                    const float* src = (mtx < 2 ? in[I_DW2] + (size_t)mtx * 96 * D : in[I_IA2] + (size_t)(mtx - 2) * 96 * D);
                    j = TrJob{src, (bf16*)(ws + WS_LORA) + (size_t)mtx * D * 128, D, 96, 128, (q / 32) * 64, (q % 32) * 64, (q % 32) * 64}; return true; }
                return false; } };
        DecSmall dec{a.in, F.ws};
        tr_run(dec, F.vcu * 8 + F.wave, F.G * 8, (LAS unsigned*)(F.lds + F.wave * 16384), F.lane);
        if (P2_FP8) {
            struct DecWin8 { const float* const* in; unsigned char* ws;
                __device__ __forceinline__ bool operator()(int it, TrJob& j) const {
                    if (it < 0 || it >= 16 * 186) return false;
                    const int kb = it / 186, nb = it % 186, n0 = nb * 64; j = TrJob{in[I_WIN], (bf16*)(ws + WS_WIN), DIN, D, D, kb * 128, n0, n0 + (n0 >= 7808 ? 128 : 0), 8.0f}; return true; } };
            DecWin8 dw{a.in, F.ws};
            tr_run8(dw, F.vcu * 8 + F.wave, F.G * 8, (LAS unsigned*)(F.lds + F.wave * 16384), F.lane);
        }
    }
    const int gt = F.vcu * 512 + F.tid, NGT = F.G * 512;
    { v4u* z = (v4u*)(F.ws + WS_WIN + (size_t)7808 * D * (P2_FP8 ? 1 : 2)); for (int i = gt; i < 128 * D / (P2_FP8 ? 16 : 8); i += NGT) z[i] = (v4u){0u, 0u, 0u, 0u}; }
    { int* tok = (int*)(F.ws + WS_TOK); for (int i = gt; i < NSLOT; i += NGT) tok[i] = 0; }
}

__device__ __forceinline__ void p1_norm1(Frame& F, const Args& a) {
    const int gw = F.vcu * 8 + F.wave, NGW = F.G * 8; const float* MOD = (const float*)(F.ws + WS_MOD); bf16* HA = (bf16*)(F.ws + WS_HA);
    for (int mrow = gw; mrow < MT; mrow += NGW) {
        const float* src = (mrow < NT) ? a.in[I_X] + (size_t)mrow * D : a.in[I_CTX] + (size_t)(mrow - NT) * D; const int j = (mrow < NT) ? (mrow >> 12) : 4;
        const f32x4* xr = (const f32x4*)src + F.lane; f32x4 v[8]; float s = 0.f;
#pragma unroll
        for (int q = 0; q < 8; ++q) { v[q] = xr[64 * q]; s += (v[q].x * v[q].x + v[q].y * v[q].y) + (v[q].z * v[q].z + v[q].w * v[q].w); }
        const float rstd = 1.0f / sqrtf(wave_sum(s) * (1.0f / D) + 1e-6f);
        const f32x4* g = (const f32x4*)a.in[I_N1G] + F.lane; const f32x4* sh = (const f32x4*)(MOD + (size_t)j * 12288) + F.lane; const f32x4* sc = (const f32x4*)(MOD + (size_t)j * 12288 + 2048) + F.lane;
        v2u* o = (v2u*)(HA + (size_t)mrow * D) + F.lane; unsigned* o8 = (unsigned*)((unsigned char*)HA + (size_t)mrow * D) + F.lane;
#pragma unroll
        for (int q = 0; q < 8; ++q) { const f32x4 y = v[q] * rstd * g[64 * q] * (sc[64 * q] + 1.0f) + sh[64 * q];
            if (P2_FP8) o8[64 * q] = pk8(8.0f * y.x, 8.0f * y.y, 8.0f * y.z, 8.0f * y.w); else { v2u w; w.x = pk2(y.x, y.y); w.y = pk2(y.z, y.w); o[64 * q] = w; } }
    }
}

template <int W> __device__ __forceinline__ void pool_item(const unsigned* U32, unsigned* DP32, int m0, int cp) {
    unsigned raw[64];
#pragma unroll
    for (int x = 0; x < 64; ++x) raw[x] = U32[(size_t)(m0 + x) * 512 + cp];
    float lo[64], hi[64];
#pragma unroll
    for (int x = 0; x < 64; ++x) { lo[x] = bflo(raw[x]); hi[x] = bfhi(raw[x]); }
#pragma unroll
    for (int x = 0; x < 64; ++x) { const int l = (x - W / 2) < 0 ? 0 : (x - W / 2), h = (x + W / 2) > 64 ? 64 : (x + W / 2); float s0 = 0.f, s1 = 0.f;
#pragma unroll
        for (int j = l; j < h; ++j) { s0 += lo[j]; s1 += hi[j]; }
        const float inv = 1.0f / (float)(h - l); DP32[(size_t)(m0 + x) * 512 + cp] = pk2(s0 * inv - lo[x], s1 * inv - hi[x]); }
}
__device__ __forceinline__ void p3_mix_store(const v4u o, const v4u nb, const f32x4 m0, const f32x4 m1, int c0, int mrow, bf16* RM, bf16* KM, bf16* VM, bf16* LIN) {
    float r[8];
    { const float ov[8] = {bflo(o.x), bfhi(o.x), bflo(o.y), bfhi(o.y), bflo(o.z), bfhi(o.z), bflo(o.w), bfhi(o.w)};
      const float nv[8] = {bflo(nb.x), bfhi(nb.x), bflo(nb.y), bfhi(nb.y), bflo(nb.z), bfhi(nb.z), bflo(nb.w), bfhi(nb.w)};
      const float mv[8] = {m0.x, m0.y, m0.z, m0.w, m1.x, m1.y, m1.z, m1.w};
#pragma unroll
      for (int e = 0; e < 8; ++e) r[e] = ov[e] + (nv[e] - ov[e]) * mv[e]; }
    bf16* dstp;
    if (c0 < 2048) dstp = RM + (size_t)mrow * D + c0;
    else if (c0 < 4096) dstp = KM + (size_t)mrow * D + (c0 - 2048);
    else if (c0 < 6144) dstp = VM + (size_t)mrow * D + (c0 - 4096);
    else { const int lc = c0 - 6144; int dc;
        if (lc < 192) {
#pragma unroll
            for (int e = 0; e < 8; ++e) r[e] = tanhf_(r[e]);
            dc = (lc < 96) ? lc : 128 + (lc - 96); }
        else if (lc < 384) dc = (lc < 288) ? 256 + (lc - 192) : 384 + (lc - 288);
        else {
#pragma unroll
            for (int e = 0; e < 8; ++e) r[e] = sigmoidf_(r[e]);
            dc = 512 + (lc - 384); }
        dstp = LIN + (size_t)mrow * LINLD + dc; }
    v4u w; w.x = pk2(r[0], r[1]); w.y = pk2(r[2], r[3]); w.z = pk2(r[4], r[5]); w.w = pk2(r[6], r[7]); *(v4u*)dstp = w;
}
constexpr int P3_SLICE = 512, P3_NSLICE = (DSH + P3_SLICE - 1) / P3_SLICE  , P3_SLOTS = 96;
__device__ __forceinline__ void p3_prep(Frame& F, const Args& a) {
    const bf16* SLAB = (const bf16*)(F.ws + WS_SLAB); const float* mu = a.in[I_MU];
    bf16* RM = (bf16*)(F.ws + WS_RM); bf16* KM = (bf16*)(F.ws + WS_KM); bf16* VM = (bf16*)(F.ws + WS_VM); bf16* LIN = (bf16*)(F.ws + WS_LIN);
    LAS unsigned char* T = F.lds;
    const int w = F.wave, lane = F.lane;
    for (int pid = F.vcu; pid < NB * 64; pid += F.G) {
        const int b = pid >> 6, py = (pid >> 3) & 7, px = pid & 7; const int m00 = b * TSEQ + (py * 8) * 64 + px * 8;
        int srow[12];
#pragma unroll
        for (int i = 0; i < 12; ++i) { const int sl = w * 12 + i; int gyl, gxl; bool ok = true;
            if (sl < 64) { gyl = sl >> 3; gxl = sl & 7; } else if (sl < 72) { gyl = -1; gxl = sl - 64; ok = py > 0; } else if (sl < 80) { gyl = 8; gxl = sl - 72; ok = py < 7; }
            else if (sl < 88) { gyl = sl - 80; gxl = -1; ok = px > 0; } else { gyl = sl - 88; gxl = 8; ok = px < 7; }
            srow[i] = ok ? m00 + gyl * 64 + gxl : m00; }
        v4u pre[12];
        { const int cl = lane * 8;
#pragma unroll
          for (int i = 0; i < 12; ++i) pre[i] = *(const v4u*)(SLAB + (size_t)srow[i] * SLABLD + cl); }
        for (int sl_ = 0; sl_ < P3_NSLICE; ++sl_) {
            const int c0 = sl_ * P3_SLICE + lane * 8; const bool cok = c0 < DSH;
            __syncthreads();
#pragma unroll
            for (int i = 0; i < 12; ++i) *(LAS v4u*)(T + (w * 12 + i) * 1024 + lane * 16) = pre[i];
            if (sl_ + 1 < P3_NSLICE) { const int cn = (sl_ + 1) * P3_SLICE + lane * 8; const int cl = cn < DSH ? cn : 0;
#pragma unroll
                for (int i = 0; i < 12; ++i) pre[i] = *(const v4u*)(SLAB + (size_t)srow[i] * SLABLD + cl); }
            __syncthreads();
            const f32x4 m0 = *(const f32x4*)(mu + (cok ? c0 : 0)), m1 = *(const f32x4*)(mu + (cok ? c0 : 0) + 4);
            const int gy = py * 8 + w; const unsigned k2m = gy > 0 ? 0xffffu : 0u, k3m = gy < 63 ? 0xffff0000u : 0u;
#pragma unroll
            for (int x = 0; x < 8; ++x) {
                const int gx = px * 8 + x; const unsigned k0m = gx > 0 ? 0xffffu : 0u, k1m = gx < 63 ? 0xffff0000u : 0u;
                const int so = w * 8 + x, sL = x > 0 ? so - 1 : 80 + w, sR = x < 7 ? so + 1 : 88 + w, sU = w > 0 ? so - 8 : 64 + x, sD = w < 7 ? so + 8 : 72 + x;
                const v4u o = *(const LAS v4u*)(T + so * 1024 + lane * 16), n0 = *(const LAS v4u*)(T + sL * 1024 + lane * 16), n1 = *(const LAS v4u*)(T + sR * 1024 + lane * 16),
                          n2 = *(const LAS v4u*)(T + sU * 1024 + lane * 16), n3 = *(const LAS v4u*)(T + sD * 1024 + lane * 16);
                v4u nb; nb.x = (n0.x & k0m) | (n1.x & k1m); nb.y = (n2.y & k2m) | (n3.y & k3m); nb.z = (n0.z & k0m) | (n1.z & k1m); nb.w = (n2.w & k2m) | (n3.w & k3m);
                const int mrow = m00 + w * 64 + x;
                if (cok) p3_mix_store(o, nb, m0, m1, c0, mrow, RM, KM, VM, LIN);
                if (sl_ == P3_NSLICE - 1 && lane >= 48) { const int l16 = lane - 48, p = l16 >> 2, off = (l16 & 3) * 8; *(v4u*)(LIN + (size_t)mrow * LINLD + 128 * p + 96 + off) = (v4u){0u, 0u, 0u, 0u}; }
            }
        }
        __syncthreads();
    }
    const int gw = F.vcu * 8 + F.wave, NGW = F.G * 8;
    for (int mrow = NT + gw; mrow < MT; mrow += NGW) {
        const bf16* own = SLAB + (size_t)mrow * SLABLD; const int sidx = (mrow - NT) & 255; const bool v0 = sidx > 0, v1 = sidx < 255;
        const bf16* p0 = v0 ? own - SLABLD : own; const bf16* p1 = v1 ? own + SLABLD : own;
        const unsigned k0m = v0 ? 0xffffu : 0u, k1m = v1 ? 0xffff0000u : 0u;
        for (int ci0 = F.lane; ci0 < DSH / 8; ci0 += 256) {
            v4u o[4], nb[4]; f32x4 m0[4], m1[4];
#pragma unroll
            for (int u = 0; u < 4; ++u) { const int ci = ci0 + 64 * u; const int c0 = (ci < DSH / 8 ? ci : F.lane) * 8;
                o[u] = *(const v4u*)(own + c0); const v4u n0 = *(const v4u*)(p0 + c0), n1 = *(const v4u*)(p1 + c0);
                nb[u].x = (n0.x & k0m) | (n1.x & k1m); nb[u].y = (n0.y & k0m) | (n1.y & k1m); nb[u].z = (n0.z & k0m) | (n1.z & k1m); nb[u].w = (n0.w & k0m) | (n1.w & k1m);
                m0[u] = *(const f32x4*)(mu + c0); m1[u] = *(const f32x4*)(mu + c0 + 4); }
#pragma unroll
            for (int u = 0; u < 4; ++u) { const int ci = ci0 + 64 * u; if (ci < DSH / 8) p3_mix_store(o[u], nb[u], m0[u], m1[u], ci * 8, mrow, RM, KM, VM, LIN); }
        }
        if (F.lane < 16) { const int p = F.lane >> 2, off = (F.lane & 3) * 8; *(v4u*)(LIN + (size_t)mrow * LINLD + 128 * p + 96 + off) = (v4u){0u, 0u, 0u, 0u}; }
    }
    const unsigned* U32 = (const unsigned*)(F.ws + WS_U); unsigned* DP32 = (unsigned*)(F.ws + WS_DP);
    for (int gr = F.vcu; gr < 256; gr += F.G) {
        const int m0 = gr * 64, cp = F.tid; const int g = F.wave >> 1;
        if (g == 0) pool_item<2>(U32, DP32, m0, cp); else if (g == 1) pool_item<4>(U32, DP32, m0, cp); else if (g == 2) pool_item<8>(U32, DP32, m0, cp); else pool_item<16>(U32, DP32, m0, cp);
    }
}

constexpr int CK = 16, NSL = 8;
constexpr int SL_Z = 0, SL_AF = 2560, SL_TMT = 3584, SL_ABF = 4096, SL_TM = 4608, SL_ZTT = 5120, SL_RT = 7680, SL_CRT = 9728, SL_ART = 10240, SL_BGT = 10752, SL_KGT = 12800, SL_VT = 14848, SL_GC = 16896,
              SL_SIZE = 17152, ZTT_LD = 80, SB_OFF = 7 * SL_SIZE  , SL7_OFF = 132096  ;
static_assert(SB_OFF + 8192 <= 131072 && SL7_OFF + SL_SIZE <= 163840, "scan LDS map");
__device__ __forceinline__ int kpos(int zt, int q) { return 32 * (zt >> 1) + 8 * q + 4 * (zt & 1); }
__device__ __forceinline__ int slot_off(int n) { return n < 7 ? n * SL_SIZE : SL7_OFF; }
__device__ __forceinline__ int sw64(int row, int col) { return (row * 64 + ((((col >> 3) ^ (row & 7)) << 3) | (col & 7))) * 2; }
__device__ __forceinline__ int scan_row(int n, int b, int dir) {
    if (n < CTXL) return NT + b * CTXL + (dir ? (CTXL - 1 - n) : n);
    const int t = n - CTXL; return b * TSEQ + (dir ? (TSEQ - 1 - t) : t);
}
__device__ __forceinline__ bf16x8 frag_ld(const LAS unsigned char* p, bool ok) { v4u z = (v4u){0u, 0u, 0u, 0u}; if (ok) z = *(const LAS v4u*)p; return __builtin_bit_cast(bf16x8, z); }
__device__ __forceinline__ f32x4 mfma16(bf16x8 a, bf16x8 b, f32x4 c) { return __builtin_amdgcn_mfma_f32_16x16x32_bf16(a, b, c, 0, 0, 0); }
__device__ __forceinline__ float dpp_shr(float v, const int n, float fill) {
    const int x = __builtin_bit_cast(int, v), f = __builtin_bit_cast(int, fill); int r;
    if (n == 1) r = __builtin_amdgcn_update_dpp(f, x, 0x111, 0xF, 0xF, false); else if (n == 2) r = __builtin_amdgcn_update_dpp(f, x, 0x112, 0xF, 0xF, false);
    else if (n == 4) r = __builtin_amdgcn_update_dpp(f, x, 0x114, 0xF, 0xF, false); else r = __builtin_amdgcn_update_dpp(f, x, 0x118, 0xF, 0xF, false);
    return __builtin_bit_cast(float, r);
}
struct SeqOps { bf16x8 fV, fZc, fZk[2], fR[2], fCr, fAr4, fKG[4], fBG4[4]; f32x4 gc[4]; };
__device__ __forceinline__ bf16x8 frag4_ld(const LAS unsigned char* p) { const v2u t = *(const LAS v2u*)p; v4u z; z.x = t.x; z.y = t.y; z.z = 0u; z.w = 0u; return __builtin_bit_cast(bf16x8, z); }
__device__ __forceinline__ void seq_load(SeqOps& o, const LAS unsigned char* SL, int w, int c, int q, bool klo) {
    o.fV = frag_ld(SL + SL_VT + ((16 * w + c) * 16 + 8 * q) * 2, klo);
    o.fZc = frag_ld(SL + SL_ZTT + (c * ZTT_LD + 64 + 8 * q) * 2, klo); o.fCr = frag_ld(SL + SL_CRT + (c * 16 + 8 * q) * 2, klo); o.fAr4 = frag4_ld(SL + SL_ART + (c * 16 + 4 * q) * 2);
#pragma unroll
    for (int ks = 0; ks < 2; ++ks) { o.fZk[ks] = frag_ld(SL + SL_ZTT + (c * ZTT_LD + 32 * ks + 8 * q) * 2, true); o.fR[ks] = frag_ld(SL + SL_RT + sw64(c, 32 * ks + 8 * q), true); }
#pragma unroll
    for (int jt = 0; jt < 4; ++jt) { o.fKG[jt] = frag_ld(SL + SL_KGT + ((16 * jt + c) * 16 + 8 * q) * 2, klo); o.fBG4[jt] = frag4_ld(SL + SL_BGT + ((16 * jt + c) * 16 + 4 * q) * 2);
        o.gc[jt] = *(const LAS f32x4*)(SL + SL_GC + (16 * jt + 4 * q) * 4); }
}
__device__ __forceinline__ void seq_step(const SeqOps& o, f32x4 (&X)[4], bool emit, bf16* YO, int chunk, int b, int dir, int h, int w, int c, int q) {
    const f32x4 z4 = (f32x4){0.f, 0.f, 0.f, 0.f};
    bf16x8 fS[2];
#pragma unroll
    for (int ks = 0; ks < 2; ++ks) { v4u p; p.x = pk2(X[2 * ks][0], X[2 * ks][1]); p.y = pk2(X[2 * ks][2], X[2 * ks][3]); p.z = pk2(X[2 * ks + 1][0], X[2 * ks + 1][1]); p.w = pk2(X[2 * ks + 1][2], X[2 * ks + 1][3]);
        fS[ks] = __builtin_bit_cast(bf16x8, p); }
    f32x4 un = mfma16(o.fZc, o.fV, z4);
#pragma unroll
    for (int ks = 0; ks < 2; ++ks) un = mfma16(o.fZk[ks], fS[ks], un);
    bf16x8 fU; { v4u p; p.x = pk2(un[0], un[1]); p.y = pk2(un[2], un[3]); p.z = 0u; p.w = 0u; fU = __builtin_bit_cast(bf16x8, p); }
    if (emit) {
        f32x4 y = mfma16(o.fCr, o.fV, z4); y = mfma16(o.fAr4, fU, y);
#pragma unroll
        for (int ks = 0; ks < 2; ++ks) y = mfma16(o.fR[ks], fS[ks], y);
#pragma unroll
        for (int g = 0; g < 4; ++g) YO[(size_t)scan_row(chunk * CK + 4 * q + g, b, dir) * D + h * 64 + 16 * w + c] = (bf16)f2bf(y[g]);
    }
#pragma unroll
    for (int jt = 0; jt < 4; ++jt) { const f32x4 d = mfma16(o.fBG4[jt], fU, mfma16(o.fKG[jt], o.fV, z4));
        X[jt] = X[jt] * o.gc[jt] + d; }
}
struct ScanRaw { v4u r[2], k[2], v[2], e[2]; v2u a[2]; };
__device__ __forceinline__ void scan_fetch(ScanRaw& R, const bf16* RM, const bf16* KM, const bf16* VM, const unsigned char* AX, const unsigned short* EX, size_t rowoff) {
#pragma unroll
    for (int ks = 0; ks < 2; ++ks) { const size_t off = rowoff + 32 * ks; R.r[ks] = *(const v4u*)(RM + off); R.k[ks] = *(const v4u*)(KM + off); R.v[ks] = *(const v4u*)(VM + off); R.a[ks] = *(const v2u*)(AX + off); R.e[ks] = *(const v4u*)(EX + off); }
}
__device__ __forceinline__ void p6_scan(Frame& F, const Args& a) {
    const bf16* RM = (const bf16*)(F.ws + WS_RM); const bf16* KM = (const bf16*)(F.ws + WS_KM); const bf16* VM = (const bf16*)(F.ws + WS_VM);
    const int lane = F.lane, w = F.wave, c0_ = lane & 15, q0_ = lane >> 4;
    for (int unit = blockIdx.x; unit < NB * NH * 2; unit += F.G) {
        const int dir = unit & 1, h = (unit >> 1) & 31, b = unit >> 6;
        const unsigned short* EX = (const unsigned short*)(F.ws + WS_EA + (size_t)dir * EA_STRIDE);
        const unsigned char* AX = (const unsigned char*)(F.ws + WS_EA + (size_t)(2 + dir) * EA_STRIDE);
        bf16* YO = (bf16*)(F.ws + (dir ? WS_YB : WS_YF)); float* BON = (float*)(F.ws + WS_BON) + (size_t)dir * NT * NH;
        f32x4 X[4];
#pragma unroll
        for (int jt = 0; jt < 4; ++jt) X[jt] = (f32x4){0.f, 0.f, 0.f, 0.f};
        constexpr int NBATCH = (CTXL + TSEQ) / CK / NSL;
        { LAS float* cst = (LAS float*)(F.lds + SB_OFF);
          if (F.tid < 192) { const int which = F.tid >> 6, j = F.tid & 63; cst[F.tid] = (which == 0 ? a.in[I_KK] : which == 1 ? a.in[I_KA] : a.in[I_RK])[h * 64 + j]; } }
        ScanRaw R; scan_fetch(R, RM, KM, VM, AX, EX, (size_t)scan_row(w * CK + c0_, b, dir) * D + h * 64 + 8 * q0_);
        __syncthreads();
        for (int bt = 0; bt < NBATCH; ++bt) {
            int c = c0_, q = q0_; asm volatile("" : "+v"(c), "+v"(q));
            const bool klo = q < 2;
            {
                LAS unsigned char* SL = F.lds + slot_off(w);
                int cq8 = 8 * q; asm volatile("" : "+v"(cq8));
                const LAS float* cst = (const LAS float*)(F.lds + SB_OFF) + cq8;
                float ss = 0.f;
#pragma unroll
                for (int ks = 0; ks < 2; ++ks) {
                    const f32x4 k0 = *(const LAS f32x4*)(cst + 32 * ks), k1 = *(const LAS f32x4*)(cst + 32 * ks + 4);
                    const float kv[8] = {bflo(R.k[ks].x), bfhi(R.k[ks].x), bflo(R.k[ks].y), bfhi(R.k[ks].y), bflo(R.k[ks].z), bfhi(R.k[ks].z), bflo(R.k[ks].w), bfhi(R.k[ks].w)};
#pragma unroll
                    for (int e = 0; e < 4; ++e) { const float p0 = kv[e] * k0[e], p1 = kv[4 + e] * k1[e]; ss += p0 * p0 + p1 * p1; } }
                ss += __shfl_xor(ss, 16); ss += __shfl_xor(ss, 32);
                const float inv = __builtin_amdgcn_rsqf(ss + 1e-12f);
                bf16x8 fKT[2], fRT[2], fBT[2], fKQ[2]; float bonp = 0.f;
#pragma unroll
                for (int ks = 0; ks < 2; ++ks) {
                    const v4u xr = R.r[ks], xk = R.k[ks], xv = R.v[ks], xe = R.e[ks]; const v2u xa = R.a[ks];
                    const f32x4 k0 = *(const LAS f32x4*)(cst + 32 * ks), k1 = *(const LAS f32x4*)(cst + 32 * ks + 4), a0 = *(const LAS f32x4*)(cst + 64 + 32 * ks), a1 = *(const LAS f32x4*)(cst + 64 + 32 * ks + 4);
                    const float kkw[8] = {k0[0], k0[1], k0[2], k0[3], k1[0], k1[1], k1[2], k1[3]}, kaw[8] = {a0[0], a0[1], a0[2], a0[3], a1[0], a1[1], a1[2], a1[3]};
                    const f32x4 q0 = *(const LAS f32x4*)(cst + 128 + 32 * ks), q1 = *(const LAS f32x4*)(cst + 128 + 32 * ks + 4); const float rkw[8] = {q0[0], q0[1], q0[2], q0[3], q1[0], q1[1], q1[2], q1[3]};
                    const float r[8] = {bflo(xr.x), bfhi(xr.x), bflo(xr.y), bfhi(xr.y), bflo(xr.z), bfhi(xr.z), bflo(xr.w), bfhi(xr.w)};
                    const float k[8] = {bflo(xk.x), bfhi(xk.x), bflo(xk.y), bfhi(xk.y), bflo(xk.z), bfhi(xk.z), bflo(xk.w), bfhi(xk.w)};
                    const float v[8] = {bflo(xv.x), bfhi(xv.x), bflo(xv.y), bfhi(xv.y), bflo(xv.z), bfhi(xv.z), bflo(xv.w), bfhi(xv.w)};
                    const float ku8 = 1.0f / 255.0f;
                    const float ai[8] = {(float)(xa.x & 0xffu) * ku8, (float)((xa.x >> 8) & 0xffu) * ku8, (float)((xa.x >> 16) & 0xffu) * ku8, (float)(xa.x >> 24) * ku8,
                                         (float)(xa.y & 0xffu) * ku8, (float)((xa.y >> 8) & 0xffu) * ku8, (float)((xa.y >> 16) & 0xffu) * ku8, (float)(xa.y >> 24) * ku8};
                    const float lw[8] = {hlo(xe.x), hhi(xe.x), hlo(xe.y), hhi(xe.y), hlo(xe.z), hhi(xe.z), hlo(xe.w), hhi(xe.w)};
                    float kt[8], rt[8], btl[8], kq[8], cl[8], G[8], Gi[8], Gm[8], GCv[8];
#pragma unroll
                    for (int e = 0; e < 8; ++e) cl[e] = lw[e];
#pragma unroll
                    for (int e = 0; e < 8; ++e) cl[e] += dpp_shr(cl[e], 1, 0.f);
#pragma unroll
                    for (int e = 0; e < 8; ++e) cl[e] += dpp_shr(cl[e], 2, 0.f);
#pragma unroll
                    for (int e = 0; e < 8; ++e) cl[e] += dpp_shr(cl[e], 4, 0.f);
#pragma unroll
                    for (int e = 0; e < 8; ++e) cl[e] += dpp_shr(cl[e], 8, 0.f);
#pragma unroll
                    for (int e = 0; e < 8; ++e) { G[e] = __builtin_amdgcn_exp2f(cl[e]); Gi[e] = __builtin_amdgcn_exp2f(-cl[e]); }
#pragma unroll
                    for (int e = 0; e < 8; ++e) { Gm[e] = dpp_shr(G[e], 1, 1.0f); GCv[e] = __shfl(G[e], (lane & 48) | 15); }
#pragma unroll
                    for (int e = 0; e < 8; ++e) {
                        const float kke = k[e] * kkw[e] * inv, kd = k[e] * ((ai[e] - 1.0f) * kaw[e] + 1.0f), bb = kke * ai[e], ratio = GCv[e] * Gi[e];
                        kt[e] = Gm[e] * kke; rt[e] = G[e] * r[e]; btl[e] = bb * Gi[e]; kq[e] = kd * Gi[e];
                        bonp += r[e] * kd * rkw[e];
                        const int j = 32 * ks + 8 * q + e;
                        const unsigned w0 = pk2(kt[e], bb * ratio), w1 = pk2(kd * ratio, v[e]);
                        ((LAS bf16*)(SL + SL_Z))[j * 16 + c] = (bf16)(w0 & 0xffffu); ((LAS bf16*)(SL + SL_BGT))[j * 16 + c] = (bf16)(w0 >> 16);
                        ((LAS bf16*)(SL + SL_KGT))[j * 16 + c] = (bf16)(w1 & 0xffffu); ((LAS bf16*)(SL + SL_VT))[j * 16 + c] = (bf16)(w1 >> 16);
                    }
                    if (c == 15) { *(LAS f32x4*)(SL + SL_GC + (32 * ks + 8 * q) * 4) = (f32x4){G[0], G[1], G[2], G[3]}; *(LAS f32x4*)(SL + SL_GC + (32 * ks + 8 * q + 4) * 4) = (f32x4){G[4], G[5], G[6], G[7]}; }
                    v4u p; p.x = pk2(kt[0], kt[1]); p.y = pk2(kt[2], kt[3]); p.z = pk2(kt[4], kt[5]); p.w = pk2(kt[6], kt[7]); fKT[ks] = __builtin_bit_cast(bf16x8, p);
                    p.x = pk2(rt[0], rt[1]); p.y = pk2(rt[2], rt[3]); p.z = pk2(rt[4], rt[5]); p.w = pk2(rt[6], rt[7]); fRT[ks] = __builtin_bit_cast(bf16x8, p);
                    { v2u p0; p0.x = p.x; p0.y = p.y; v2u p1; p1.x = p.z; p1.y = p.w; const int pp = 32 * ks + 16 * (q & 1) + 4 * (q >> 1);
                      *(LAS v2u*)(SL + SL_RT + sw64(c, pp)) = p0; *(LAS v2u*)(SL + SL_RT + sw64(c, pp + 8)) = p1; }
                    p.x = pk2(btl[0], btl[1]); p.y = pk2(btl[2], btl[3]); p.z = pk2(btl[4], btl[5]); p.w = pk2(btl[6], btl[7]); fBT[ks] = __builtin_bit_cast(bf16x8, p);
                    p.x = pk2(kq[0], kq[1]); p.y = pk2(kq[2], kq[3]); p.z = pk2(kq[4], kq[5]); p.w = pk2(kq[6], kq[7]); fKQ[ks] = __builtin_bit_cast(bf16x8, p);
                    asm volatile("" ::: "memory");
                }
                bonp += __shfl_xor(bonp, 16); bonp += __shfl_xor(bonp, 32);
                if (q == 0 && (NSL * bt + w) * CK >= CTXL) BON[(size_t)scan_row((NSL * bt + w) * CK + c, b, dir) * NH + h] = bonp;
                const f32x4 z4 = (f32x4){0.f, 0.f, 0.f, 0.f};
                f32x4 accA = mfma16(fBT[1], fKT[1], mfma16(fBT[0], fKT[0], z4)), accAr = mfma16(fBT[1], fRT[1], mfma16(fBT[0], fRT[0], z4));
                f32x4 accCm = mfma16(fKQ[1], fKT[1], mfma16(fKQ[0], fKT[0], z4)), accCr = mfma16(fKQ[1], fRT[1], mfma16(fKQ[0], fRT[0], z4));
#pragma unroll
                for (int g = 0; g < 4; ++g) { const int srow = 4 * q + g; const bool lt = srow < c, le = srow <= c;
                    accA[g] = lt ? accA[g] : 0.f; accAr[g] = le ? accAr[g] : 0.f; accCm[g] = lt ? accCm[g] : 0.f; accCr[g] = le ? accCr[g] : 0.f;
                    ((LAS float*)(SL + SL_AF))[srow * 16 + c] = accA[g]; ((LAS bf16*)(SL + SL_ABF))[srow * 16 + c] = (bf16)f2bf(accA[g]); ((LAS bf16*)(SL + SL_Z))[(64 + srow) * 16 + c] = (bf16)f2bf(accCm[g]); }
                { v2u p; p.x = pk2(accAr[0], accAr[1]); p.y = pk2(accAr[2], accAr[3]); *(LAS v2u*)(SL + SL_ART + (c * 16 + 4 * q) * 2) = p; }
                { v2u p; p.x = pk2(accCr[0], accCr[1]); p.y = pk2(accCr[2], accCr[3]); *(LAS v2u*)(SL + SL_CRT + (c * 16 + 4 * q) * 2) = p; }
                LDS_WAIT(); asm volatile("" ::: "memory");
                {
                    const int base = c & 8, cl = c & 7; float x[8];
#pragma unroll
                    for (int sr = 7; sr >= 0; --sr) { float acc = 0.f;
#pragma unroll
                        for (int m = sr + 1; m < 8; ++m) acc += ((const LAS float*)(SL + SL_AF))[(base + sr) * 16 + base + m] * x[m];
                        x[sr] = (sr < cl) ? -acc : ((sr == cl) ? -1.0f : 0.f); }
                    if (q == 0) { v4u px; px.x = pk2(x[0], x[1]); px.y = pk2(x[2], x[3]); px.z = pk2(x[4], x[5]); px.w = pk2(x[6], x[7]);
                        *(LAS v4u*)(SL + SL_TMT + (c * 16 + base) * 2) = px; *(LAS v4u*)(SL + SL_TMT + (c * 16 + (base ^ 8)) * 2) = (v4u){0u, 0u, 0u, 0u};
#pragma unroll
                        for (int sr = 0; sr < 8; ++sr) { ((LAS bf16*)(SL + SL_TM))[(base + sr) * 16 + c] = (bf16)f2bf(x[sr]); ((LAS bf16*)(SL + SL_TM))[((base ^ 8) + sr) * 16 + c] = (bf16)0; } }
                    LDS_WAIT(); asm volatile("" ::: "memory");
                    const bf16x8 fAb = frag_ld(SL + SL_ABF + (c * 16 + 8 * q) * 2, klo), fTd = frag_ld(SL + SL_TMT + (c * 16 + 8 * q) * 2, klo);
                    const f32x4 d1 = mfma16(fAb, fTd, z4);
                    bf16x8 fD1; { v4u p; p.x = pk2(d1[0], d1[1]); p.y = pk2(d1[2], d1[3]); p.z = 0u; p.w = 0u; fD1 = __builtin_bit_cast(bf16x8, p); }
                    const f32x4 d2 = mfma16(fD1, frag4_ld(SL + SL_TM + (c * 16 + 4 * q) * 2), z4);
                    if (c < 8 && q >= 2) {
#pragma unroll
                        for (int g = 0; g < 4; ++g) ((LAS bf16*)(SL + SL_TMT))[(4 * q + g) * 16 + c] = (bf16)f2bf(d2[g]); }
                }
                LDS_WAIT(); asm volatile("" ::: "memory");
                {
                    const bf16x8 fT = frag_ld(SL + SL_TMT + (c * 16 + 8 * q) * 2, klo);
#pragma unroll
                    for (int zt = 0; zt < 5; ++zt) { const bf16x8 fZ = frag_ld(SL + SL_Z + ((16 * zt + c) * 16 + 8 * q) * 2, klo); const f32x4 d = mfma16(fZ, fT, z4);
                        v2u p; p.x = pk2(d[0], d[1]); p.y = pk2(d[2], d[3]); *(LAS v2u*)(SL + SL_ZTT + (c * ZTT_LD + (zt < 4 ? kpos(zt, q) : 64 + 4 * q)) * 2) = p; }
                }
            }
            if (bt + 1 < NBATCH) scan_fetch(R, RM, KM, VM, AX, EX, (size_t)scan_row((NSL * (bt + 1) + w) * CK + c, b, dir) * D + h * 64 + 8 * q);
            __syncthreads();
            asm volatile("" : "+v"(c), "+v"(q));
            if (w < 4) {
                const bool emit = (NSL * bt) * CK >= CTXL;
#pragma unroll 1
                for (int n = 0; n < NSL; ++n) { SeqOps A; seq_load(A, F.lds + slot_off(n), w, c, q, klo); seq_step(A, X, emit, YO, NSL * bt + n, b, dir, h, w, c, q); }
            }
            __syncthreads();
        }
    }
}

__device__ __forceinline__ void p7_readout(Frame& F, const Args& a) {
    const bf16* VM = (const bf16*)(F.ws + WS_VM); const float* BONF = (const float*)(F.ws + WS_BON); const float* BONB = BONF + (size_t)NT * NH;
    const bf16* YF = (const bf16*)(F.ws + WS_YF); const bf16* YB = (const bf16*)(F.ws + WS_YB); bf16* Z = (bf16*)(F.ws + WS_Z);
    const int sub = F.tid & 15; const int ngrp = F.G * 32;
    for (int gid0 = F.vcu * 32 + (F.tid >> 4); gid0 < NT * NH; gid0 += 4 * ngrp) {
        v2u ayf[4], ayb[4], alv[4]; float abf[4], abb[4]; f32x4 alw[4], alb[4];
#pragma unroll
        for (int u = 0; u < 4; ++u) { const int gid = gid0 + u * ngrp; const int mrow = gid >> 5, h = gid & 31, c = h * 64 + 4 * sub; const size_t off = (size_t)mrow * D + c;
            ayf[u] = *(const v2u*)(YF + off); ayb[u] = *(const v2u*)(YB + off); alv[u] = *(const v2u*)(VM + off); abf[u] = BONF[gid]; abb[u] = BONB[gid]; alw[u] = *(const f32x4*)(a.in[I_LNW] + c); alb[u] = *(const f32x4*)(a.in[I_LNB] + c); }
#pragma unroll
        for (int u = 0; u < 4; ++u) { const int gid = gid0 + u * ngrp;
        const int mrow = gid >> 5, h = gid & 31, c = h * 64 + 4 * sub; const size_t off = (size_t)mrow * D + c;
        const v2u yf = ayf[u], yb = ayb[u], lv = alv[u];
        const f32x4 y = (f32x4){bflo(yf.x) + bflo(yb.x), bfhi(yf.x) + bfhi(yb.x), bflo(yf.y) + bflo(yb.y), bfhi(yf.y) + bfhi(yb.y)};
        const float mean = allred16((y.x + y.y) + (y.z + y.w)) * (1.0f / 64.0f); const f32x4 d = y - mean;
        const float var = allred16((d.x * d.x + d.y * d.y) + (d.z * d.z + d.w * d.w)) * (1.0f / 64.0f);
        const f32x4 yn = d * __builtin_amdgcn_rsqf(var + 64e-5f) * alw[u] + alb[u];
        const f32x4 v = (f32x4){bflo(lv.x), bfhi(lv.x), bflo(lv.y), bfhi(lv.y)};
        const f32x4 z = yn + v * (abf[u] + abb[u]); v2u wv; wv.x = pk2(z.x, z.y); wv.y = pk2(z.z, z.w); *(v2u*)(Z + off) = wv;
        }
    }
}
constexpr float GU_F8SCALE = 8.0f, H2_F8SCALE = 8.0f, DT_F8SCALE = 8.0f;
constexpr int CONV_ITEMS = 65 * 384, CONV_DT = 65 * 128, CONV_FREE = CONV_DT + (65 - GU_E2) * 256;
struct DecExp { const float* const* in; unsigned char* ws;
    __device__ __forceinline__ bool operator()(int it, TrJob& j) const {
        if (it < 0 || it >= CONV_ITEMS) return false;
        if (it < CONV_DT) { const int e = it >> 7, r = it & 127; const float* src = (e < 64) ? in[I_ED] + (size_t)e * DEXP * D : in[I_SD];
            const int kb = r >> 5, nb = r & 31; j = TrJob{src, (bf16*)(ws + WS_DT + (size_t)e * D * DEXP), D, DEXP, DEXP, kb * 128, nb * 64, nb * 64, DT_F8SCALE}; }
        else { const int g = it - CONV_DT, eg = g >> 8, q = g & 255, which = q >> 7, r = q & 127, e = eg < 65 - GU_E2 ? GU_E2 + eg : eg - (65 - GU_E2);
            const float* src = (e < 64) ? (which == 0 ? in[I_EG] : in[I_EU]) + (size_t)e * D * DEXP : (which == 0 ? in[I_SG] : in[I_SU]);
            const int kb = r >> 3, nb = r & 7, n0 = nb * 64;
            j = TrJob{src, (bf16*)(ws + gu_base(e)), DEXP, D, D, kb * 128, n0, (n0 >> 7) * 256 + which * 128 + (n0 & 127), GU_F8SCALE}; }
        return true; } };
__device__ __forceinline__ void conv_steal(Frame& F, const Args& a, const unsigned stopn) {
    DecExp dec{a.in, F.ws};
    unsigned* cnt = F.ctl + CW_CONV; unsigned* dnp = F.ctl + CW_P2DONE;
    LAS unsigned* P = (LAS unsigned*)(F.lds + F.wave * 16384);
    const int lane = F.lane;
    unsigned nxt = 0u, dnow = 0u;
    if (lane == 0) nxt = xb_add(cnt, 1u);
    nxt = __builtin_amdgcn_readfirstlane(nxt);
#pragma unroll 1
    for (;;) {
        const unsigned cur = nxt;
        if (cur >= (unsigned)CONV_FREE) break;
        unsigned n2 = (unsigned)CONV_FREE, d2 = dnow;
        if (dnow < stopn) { if (lane == 0) { n2 = xb_add(cnt, 1u); d2 = xb_ld(dnp); } }
        asm volatile("" ::: "memory");
        TrJob ja; f32x4 va[16];
        dec((int)cur, ja);
        tr8_load<true>(ja, 0, va, lane); tr8_lds(ja, 0, va, P, lane);
        tr8_load<true>(ja, 1, va, lane); tr8_lds(ja, 1, va, P, lane);
        tr8_flush<true>(ja, P, lane);
        nxt = __builtin_amdgcn_readfirstlane(n2); dnow = __builtin_amdgcn_readfirstlane(d2);
    }
}
constexpr int RT_LD = 68;
__device__ __forceinline__ void p11_route(Frame& F, const Args& a) {
    for (int repa_ = 0, nrepa_ = opaque_n(1 + ((DUPMASK >> 16) & 1)); repa_ < nrepa_; ++repa_) {
        unsigned nd = xb_ld(F.ctl + CW_CONV); nd = __builtin_amdgcn_readfirstlane(nd < (unsigned)CONV_FREE ? nd : (unsigned)CONV_FREE);
        DecExp dec{a.in, F.ws};
        tr_run8(dec, (int)nd + F.vcu * 8 + F.wave, F.G * 8, (LAS unsigned*)(F.lds + F.wave * 16384), F.lane);
        __syncthreads();
    }
    const bf16* X1 = (const bf16*)(F.ws + WS_X1); const float* MOD = (const float*)(F.ws + WS_MOD); unsigned char* H2 = F.ws + WS_H2;
    LAS float* hs = (LAS float*)F.lds;
    LAS float* wsb = hs + 64 * RT_LD;
    LAS float* lg = wsb + 64 * RT_LD;
    LAS float* lg2 = lg + 64 * 65;
    LAS float* selb = lg2 + 64 * 65;
    LAS float* rs = selb + 64 * 65;
    LAS int* cnt = (LAS int*)(rs + 64);
    LAS int* basee = cnt + 64;
    LAS int* eloc = basee + 64;
    LAS int* rloc = eloc + 512;
    for (int tile = F.vcu; tile < NT / 64; tile += F.G) {
        const int t0 = tile * 64, b = t0 >> 12;
        const float* sh2 = MOD + (size_t)b * 12288 + 6144; const float* sc2 = MOD + (size_t)b * 12288 + 8192; const float* g2 = a.in[I_N2G];
        if (F.tid < 64) cnt[F.tid] = 0;
        for (int rr = 0; rr < 8; ++rr) { const int tl = F.wave * 8 + rr; const v2u* xr = (const v2u*)(X1 + (size_t)(t0 + tl) * D) + F.lane; f32x4 v[8]; float s = 0.f;
#pragma unroll
            for (int q = 0; q < 8; ++q) { const v2u xw = xr[64 * q]; v[q] = (f32x4){bflo(xw.x), bfhi(xw.x), bflo(xw.y), bfhi(xw.y)}; s += (v[q].x * v[q].x + v[q].y * v[q].y) + (v[q].z * v[q].z + v[q].w * v[q].w); }
            const float rstd = 1.0f / sqrtf(wave_sum(s) * (1.0f / D) + 1e-6f); if (F.lane == 0) rs[tl] = rstd;
            unsigned* o = (unsigned*)(H2 + (size_t)(t0 + tl) * D) + F.lane;
#pragma unroll
            for (int q = 0; q < 8; ++q) { const f32x4 y = v[q] * rstd * ((const f32x4*)g2)[F.lane + 64 * q] * (((const f32x4*)sc2)[F.lane + 64 * q] + 1.0f) + ((const f32x4*)sh2)[F.lane + 64 * q];
                o[64 * q] = pk8(H2_F8SCALE * y.x, H2_F8SCALE * y.y, H2_F8SCALE * y.z, H2_F8SCALE * y.w); } }
        __syncthreads();
        const int ti = F.wave >> 1, ei0 = 2 * (F.wave & 1), lr = F.lane & 15, lk = F.lane >> 4;
        f32x4 am0 = (f32x4){0.f, 0.f, 0.f, 0.f}, am1 = am0;
        const int stok = F.tid >> 3, sk8 = (F.tid & 7) * 8; const float rstd_s = rs[stok];
        f32x4 px0, px1, pw0, pw1;
        { const v4u xw = *(const v4u*)(X1 + (size_t)(t0 + stok) * D + sk8); px0 = (f32x4){bflo(xw.x), bfhi(xw.x), bflo(xw.y), bfhi(xw.y)}; px1 = (f32x4){bflo(xw.z), bfhi(xw.z), bflo(xw.w), bfhi(xw.w)}; const float* wp = a.in[I_RW] + F.tid * 8; pw0 = *(const f32x4*)wp; pw1 = *(const f32x4*)(wp + 4); }
        for (int kc = 0; kc < D / 64; ++kc) {
            { const int k0 = kc * 64 + sk8;
              const f32x4 ga = *(const f32x4*)(g2 + k0), gb = *(const f32x4*)(g2 + k0 + 4), ca = *(const f32x4*)(sc2 + k0), cb = *(const f32x4*)(sc2 + k0 + 4), ha = *(const f32x4*)(sh2 + k0), hb = *(const f32x4*)(sh2 + k0 + 4);
              const f32x4 y0 = px0 * rstd_s * ga * (ca + 1.0f) + ha, y1 = px1 * rstd_s * gb * (cb + 1.0f) + hb;
              hs[(sk8 + 0) * RT_LD + stok] = y0.x; hs[(sk8 + 1) * RT_LD + stok] = y0.y; hs[(sk8 + 2) * RT_LD + stok] = y0.z; hs[(sk8 + 3) * RT_LD + stok] = y0.w;
              hs[(sk8 + 4) * RT_LD + stok] = y1.x; hs[(sk8 + 5) * RT_LD + stok] = y1.y; hs[(sk8 + 6) * RT_LD + stok] = y1.z; hs[(sk8 + 7) * RT_LD + stok] = y1.w;
              const int wk = F.tid >> 3, we = (F.tid & 7) * 8; *(LAS f32x4*)(wsb + wk * RT_LD + we) = pw0; *(LAS f32x4*)(wsb + wk * RT_LD + we + 4) = pw1; }
            __syncthreads();
            if (kc + 1 < D / 64) { const v4u xw = *(const v4u*)(X1 + (size_t)(t0 + stok) * D + (kc + 1) * 64 + sk8); px0 = (f32x4){bflo(xw.x), bfhi(xw.x), bflo(xw.y), bfhi(xw.y)}; px1 = (f32x4){bflo(xw.z), bfhi(xw.z), bflo(xw.w), bfhi(xw.w)};
                const float* wp = a.in[I_RW] + (size_t)(kc + 1) * 4096 + F.tid * 8; pw0 = *(const f32x4*)wp; pw1 = *(const f32x4*)(wp + 4); }
#pragma unroll
            for (int ks = 0; ks < 16; ++ks) { const int k = 4 * ks + lk; const float av = hs[k * RT_LD + 16 * ti + lr], b0 = wsb[k * RT_LD + 16 * ei0 + lr], b1 = wsb[k * RT_LD + 16 * ei0 + 16 + lr];
                am0 = __builtin_amdgcn_mfma_f32_16x16x4f32(av, b0, am0, 0, 0, 0); am1 = __builtin_amdgcn_mfma_f32_16x16x4f32(av, b1, am1, 0, 0, 0); }
            __syncthreads();
        }
#pragma unroll
        for (int g = 0; g < 4; ++g) { lg[(16 * ti + 4 * lk + g) * 65 + 16 * ei0 + lr] = am0[g]; lg[(16 * ti + 4 * lk + g) * 65 + 16 * ei0 + 16 + lr] = am1[g]; }
        __syncthreads();
        for (int idx = F.tid; idx < 4096; idx += 512) { const int tl = idx >> 6, e = idx & 63; const float sc = sigmoidf_(lg[tl * 65 + e]); lg[tl * 65 + e] = sc; selb[tl * 65 + e] = sc + a.in[I_RB][e]; }
        __syncthreads();
        if (F.tid < 64) {
            const int tl = F.tid; LAS float* sel = selb + tl * 65; const LAS float* scr = lg + tl * 65;
            float gs[8];
#pragma unroll
            for (int g = 0; g < 8; ++g) { float m1 = -INFINITY, m2 = -INFINITY;
#pragma unroll
                for (int j = 0; j < 8; ++j) { const float v = sel[g * 8 + j]; if (v > m1) { m2 = m1; m1 = v; } else if (v > m2) m2 = v; }
                gs[g] = m1 + m2; }
            unsigned gmask = 0u;
#pragma unroll
            for (int it = 0; it < 4; ++it) { float best = -INFINITY; int bi = 0;
#pragma unroll
                for (int g = 0; g < 8; ++g) { const bool ok = !((gmask >> g) & 1u) && gs[g] > best; best = ok ? gs[g] : best; bi = ok ? g : bi; }
                gmask |= 1u << bi; }
            for (int g = 0; g < 8; ++g) if (!((gmask >> g) & 1u)) { for (int j = 0; j < 8; ++j) sel[g * 8 + j] = -INFINITY; }
            float wv[8]; int ev[8]; float wsum = 0.f;
#pragma unroll
            for (int it = 0; it < 8; ++it) { float best = -INFINITY; int bi = 0;
                for (int e = 0; e < 64; ++e) { const float v = sel[e]; if (v > best) { best = v; bi = e; } }
                sel[bi] = -INFINITY; ev[it] = bi; wv[it] = scr[bi]; wsum += wv[it]; }
            const float inv = 2.5f / wsum;
#pragma unroll
            for (int it = 0; it < 8; ++it) { const int lr = atomicAdd((int*)&cnt[ev[it]], 1); eloc[tl * 8 + it] = ev[it]; rloc[tl * 8 + it] = lr;
                ((float*)(F.ws + WS_WSEL))[(size_t)(t0 + tl) * 8 + it] = wv[it] * inv; }
        }
        __syncthreads();
        if (F.tid < 64) basee[F.tid] = (int)__hip_atomic_fetch_add(F.ctl + CW_GCNT + F.tid, (unsigned)cnt[F.tid], __ATOMIC_RELAXED, __HIP_MEMORY_SCOPE_AGENT);
        __syncthreads();
        { const int e = eloc[F.tid]; ((int*)(F.ws + WS_EIDX))[(size_t)t0 * 8 + F.tid] = e; ((int*)(F.ws + WS_RANK))[(size_t)t0 * 8 + F.tid] = basee[e] + rloc[F.tid]; }
        __syncthreads();
    }
}
__device__ __forceinline__ int moe_tables(Frame& F) {
    LAS int* te = (LAS int*)(F.lds + TAB_OFF); LAS int* off = te + MAXTILES;
    if (F.tid < 64) off[66 + F.tid] = (int)__hip_atomic_load(F.ctl + CW_GCNT + F.tid, __ATOMIC_RELAXED, __HIP_MEMORY_SCOPE_AGENT);
    __syncthreads();
    if (F.tid == 0) { int o = 0; for (int e = 0; e < 64; ++e) { off[e] = o; o += (off[66 + e] + 255) & ~255; } off[64] = o; off[65] = o / 256 + NT / 256; }
    __syncthreads();
    const int ntiles = off[65];
    for (int rt = F.tid; rt < ntiles; rt += 512) { int e = 0; for (int j = 1; j <= 64; ++j) if (rt * 256 >= off[j]) e = j; te[rt] = e; }
    __syncthreads();
    return ntiles;
}
__device__ __forceinline__ void p12_slots(Frame& F) {
    (void)moe_tables(F);
    const LAS int* off = (const LAS int*)(F.lds + TAB_OFF) + MAXTILES;
    int* tok = (int*)(F.ws + WS_TOK);
    const int* eidx = (const int*)(F.ws + WS_EIDX); int* rank = (int*)(F.ws + WS_RANK);
    const int gt = F.vcu * 512 + F.tid, NGT = F.G * 512;
    for (int i = gt; i < NT * 8; i += NGT) { const int slot = off[eidx[i]] + rank[i]; tok[slot] = i >> 3; rank[i] = slot; }
    const int o64 = off[64];
    for (int t = gt; t < NT; t += NGT) tok[o64 + t] = t;
    if (gt == 0) F.ctl[CW_O64] = (unsigned)o64;
}
__device__ __forceinline__ void p15_final(Frame& F, const Args& a) {
    const int gw = F.vcu * 8 + F.wave, NGW = F.G * 8; const float* MOD = (const float*)(F.ws + WS_MOD); const unsigned char* YP = (const unsigned char*)(F.ws + WS_YP);
    const int* SLOTMAP = (const int*)(F.ws + WS_RANK); const float* WSEL = (const float*)(F.ws + WS_WSEL); const int o64 = (int)F.ctl[CW_O64];
    for (int t = gw; t < NT; t += NGW) {
        const int b = t >> 12; const float* gt2 = MOD + (size_t)b * 12288 + 10240; const float* fg = a.in[I_FG]; float* xr = a.out + (size_t)t * D; const bf16* x1r = (const bf16*)(F.ws + WS_X1) + (size_t)t * D;
        const v4u s0 = *(const v4u*)(SLOTMAP + (size_t)t * 8), s1 = *(const v4u*)(SLOTMAP + (size_t)t * 8 + 4); const f32x4 w0 = *(const f32x4*)(WSEL + (size_t)t * 8), w1 = *(const f32x4*)(WSEL + (size_t)t * 8 + 4);
        const unsigned sl[9] = {s0.x, s0.y, s0.z, s0.w, s1.x, s1.y, s1.z, s1.w, (unsigned)(o64 + t)}; const float wt[9] = {w0.x, w0.y, w0.z, w0.w, w1.x, w1.y, w1.z, w1.w, 1.0f};
        LAS float* Tw = (LAS float*)(F.lds + F.wave * 8192);
#pragma unroll
        for (int jj = 0; jj < 2; ++jj) { const int col = 16 * F.lane + 1024 * jj; float m[16];
#pragma unroll
            for (int e = 0; e < 16; ++e) m[e] = 0.f;
#pragma unroll
            for (int j = 0; j < 9; ++j) { const v4u y = *(const v4u*)(YP + (size_t)sl[j] * D + col); const unsigned yw[4] = {y.x, y.y, y.z, y.w}; const float wj = wt[j];
#pragma unroll
                for (int e = 0; e < 4; ++e) { const f32x2 lo = __builtin_amdgcn_cvt_pk_f32_fp8((int)yw[e], false), hi = __builtin_amdgcn_cvt_pk_f32_fp8((int)yw[e], true);
                    m[4 * e] += wj * lo.x; m[4 * e + 1] += wj * lo.y; m[4 * e + 2] += wj * hi.x; m[4 * e + 3] += wj * hi.y; } }
#pragma unroll
            for (int e4 = 0; e4 < 4; ++e4) *(LAS f32x4*)(Tw + col + 4 * e4) = (f32x4){m[4 * e4], m[4 * e4 + 1], m[4 * e4 + 2], m[4 * e4 + 3]}; }
        LDS_WAIT(); asm volatile("" ::: "memory");
        f32x4 v[8]; float s = 0.f;
#pragma unroll
        for (int k = 0; k < 8; ++k) { const int col = 256 * k + 4 * F.lane; const f32x4 mm = *(const LAS f32x4*)(Tw + col);
            const v2u xw = *(const v2u*)(x1r + col); const f32x4 x0 = (f32x4){bflo(xw.x), bfhi(xw.x), bflo(xw.y), bfhi(xw.y)}, g0 = *(const f32x4*)(gt2 + col);
            v[k] = x0 + g0 * (mm * (1.0f / YP_SCALE)); s += (v[k].x * v[k].x + v[k].y * v[k].y) + (v[k].z * v[k].z + v[k].w * v[k].w); }
        LDS_WAIT(); asm volatile("" ::: "memory");
        float rstd = __builtin_amdgcn_rsqf(wave_sum(s) * (1.0f / D) + 1e-6f);
#if defined(PROBE_PHASE)
        if (PROBE_PHASE >= 0) rstd *= 1.0f + (float)__hip_atomic_load(F.ctl + 12000, __ATOMIC_RELAXED, __HIP_MEMORY_SCOPE_AGENT) * 2e-6f;
#endif
#pragma unroll
        for (int k = 0; k < 8; ++k) { const int col = 256 * k + 4 * F.lane; *(f32x4*)(xr + col) = v[k] * rstd * *(const f32x4*)(fg + col); }
    }
}
#ifndef MK_ONE_LAUNCH
#define MK_ONE_LAUNCH 1
#endif
constexpr int NPHASE = 16;
__global__ void __launch_bounds__(512, 2) mk_fwd(Args args) {
    extern __shared__ __attribute__((aligned(16))) unsigned char lds[];
    Frame F;
    F.lds = (LAS unsigned char*)lds; F.MISC = (volatile LAS unsigned*)(F.lds + LDSCTL_OFF);
    int wave0 = __builtin_amdgcn_readfirstlane((int)threadIdx.x >> 6); asm volatile("" : "+s"(wave0));
    F.tid = threadIdx.x; F.lane = F.tid & 63; F.wave = wave0;
    F.G = gridDim.x; { const int bx = blockIdx.x; F.vcu = (F.G % 8 == 0) ? (bx % 8) * (F.G / 8) + bx / 8 : bx; }
    F.ws = args.ws; F.ctl = (unsigned*)(args.ws + WS_CTL);
    for (int u = F.tid; u < 256; u += 512) ((LAS unsigned*)(F.lds + LDSCTL_OFF))[u] = 0u;
    __syncthreads();
    XcdBarrier bar; bar.bar = F.ctl + CW_BAR; bar.x = 0; bar.st = nullptr;
    if (MK_ONE_LAUNCH) bar = xcd_barrier_post(F.ctl + CW_BAR, F.MISC + 8);
    const int lo = args.ph_lo, hi = args.ph_hi;
#ifndef PHMASK
#define PHMASK 0xFFFF
#endif
#define IN(k) (((PHMASK >> (k)) & 1) && lo <= (k) && (k) < hi)
#ifndef DUPMASK
#define DUPMASK 0
#endif
#define DUP(k) for (int rep_ = 0, nrep_ = opaque_n(1 + ((DUPMASK >> (k)) & 1)); rep_ < nrep_; ++rep_)
#define FRESH() do { int l_ = (int)__builtin_amdgcn_mbcnt_hi(~0u, __builtin_amdgcn_mbcnt_lo(~0u, 0u)); asm volatile("" : "+v"(l_)); int w_ = wave0; asm volatile("" : "+s"(w_)); F.lane = l_; F.wave = w_; F.tid = w_ * 64 + l_; { unsigned char* p_ = args.ws; asm volatile("" : "+s"(p_)); F.ws = p_; ws = p_; F.ctl = (unsigned*)(p_ + WS_CTL); } } while (0)
#define SEAM(k) do { if (MK_ONE_LAUNCH) { if (IN(k) && IN((k) + 1)) { xcd_barrier(bar); if ((DUPMASK >> 18) & 1) xcd_barrier(bar); } } } while (0)
    const int G = F.G, c = (int)blockIdx.x;
#ifndef PROBE_PHASE
#define PROBE_PHASE -1
#endif
    unsigned long long pt0_ = 0;
#define PSTART(k) do { if (PROBE_PHASE == (k)) pt0_ = __builtin_amdgcn_s_memrealtime(); } while (0)
#define PEND(k) do { if (PROBE_PHASE == (k) && blockIdx.x == 0 && threadIdx.x == 0) { const unsigned long long t1_ = __builtin_amdgcn_s_memrealtime(); __hip_atomic_store(F.ctl + 12000, (unsigned)(t1_ - pt0_), __ATOMIC_RELAXED, __HIP_MEMORY_SCOPE_AGENT); } } while (0)
    unsigned char* ws = args.ws;

    PSTART(0);
    if (IN(0)) DUP(0) { FRESH(); p0_prologue(F, args); } SEAM(0); PEND(0);
    PSTART(1);
    if (IN(1)) DUP(1) { FRESH(); p1_norm1(F, args); } SEAM(1); PEND(1);
    PSTART(2);
    if (IN(2)) DUP(2) { FRESH();
        const int g1 = (G == 256 && !NOCONV) ? 240 : G;
        if (c < g1) {
            G1Order S{(const char*)(ws + WS_HA), (const char*)(ws + WS_WIN), (size_t)256 * D * (P2_FP8 ? 1 : 2), (size_t)256 * D * (P2_FP8 ? 1 : 2), g1, c};
            EpiG1 E{(bf16*)(ws + WS_U), (bf16*)(ws + WS_SLAB), (unsigned char*)(ws + WS_GATES)};
            if (P2_FP8) pg8::gemm_phase<EpiG1, G1Order, false, true, 124>(F.lds + RING_OFF, F.wave, D / 2, D / 2, D / 2, S, E);
            else pg8::gemm_phase<EpiG1, G1Order, false>(F.lds + RING_OFF, F.wave, D, D, D, S, E);
            FRESH();
            if (F.tid == 0) (void)xb_add(F.ctl + CW_P2DONE, 1u);
        } else conv_steal(F, args, 8u);
    } SEAM(2); PEND(2);
    PSTART(3);
    if (IN(3)) DUP(3) { FRESH(); p3_prep(F, args); } SEAM(3); PEND(3);
    PSTART(4);
    if (IN(4)) DUP(4) { FRESH();
#ifndef NO4A
        {
            RepOrder S{(const char*)(ws + WS_LIN), (const char*)(ws + WS_LORA), (size_t)128 * 2, (size_t)D * 128 * 2, (size_t)256 * LINLD * 2, (size_t)256 * 128 * 2, MT / 256, D / 256, 4, G, c};
            EpiLora E{(unsigned short*)(ws + WS_EA), args.in[I_DW0], args.in[I_IA0]};
            pg8::gemm_phase<EpiLora, RepOrder, false>(F.lds + RING_OFF, F.wave, 128, LINLD, 128, S, E);
        }
#endif
    }
    if (IN(4)) DUP(4) { FRESH();
#ifndef NO4B
        {
            RepOrder S{(const char*)(ws + WS_DP), (const char*)(ws + WS_POOLW), (size_t)256 * 2, (size_t)256 * 256 * 2, (size_t)256 * 1024 * 2, (size_t)256 * 256 * 2, NT / 256, 1, 4, G, c};
            EpiPoolG E{(bf16*)(ws + WS_Y2), args.in[I_POOLS]};
            pg8::gemm_phase<EpiPoolG, RepOrder, false>(F.lds + RING_OFF, F.wave, 256, 1024, 256, S, E);
        }
#endif
    } SEAM(4); PEND(4);
    PSTART(5);
    if (IN(5)) DUP(5) { FRESH();
        RepOrder S{(const char*)(ws + WS_Y2), (const char*)(ws + WS_WPO), 0, 0, (size_t)256 * 1024 * 2, (size_t)256 * 1024 * 2, NT / 256, D / 256, 1, G, c};
        EpiMix<0> E{(bf16*)(ws + WS_MP), D, (const void*)(ws + WS_GATES), 4096, nullptr, 0};
        pg8::gemm_phase<EpiMix<0>, RepOrder, false>(F.lds + RING_OFF, F.wave, 1024, 1024, 1024, S, E);
    }
    PSTART(6);
    if (IN(6)) DUP(6) { FRESH(); p6_scan(F, args); if ((DUPMASK >> 19) & 1) { FRESH(); p6_scan(F, args); } } SEAM(6); PEND(6);
    PSTART(7);
    if (IN(7)) DUP(7) { FRESH(); p7_readout(F, args); } SEAM(7); PEND(7);
    PSTART(8);
    if (IN(8)) DUP(8) { FRESH();
        RepOrder S{(const char*)(ws + WS_LIN) + 512 * 2, (const char*)(ws + WS_G2), 0, 0, (size_t)256 * LINLD * 2, (size_t)256 * 256 * 2, NT / 256, D / 256, 1, G, c};
        EpiMix<1> E{(bf16*)(ws + WS_OR), D, (const void*)(ws + WS_Z), D, nullptr, 0};
        pg8::gemm_phase<EpiMix<1>, RepOrder, false>(F.lds + RING_OFF, F.wave, 256, LINLD, 256, S, E);
    } SEAM(8); PEND(8);
    PSTART(9);
    if (IN(9)) DUP(9) { FRESH();
        RepOrder S{(const char*)(ws + WS_OR), (const char*)(ws + WS_WRO), 0, 0, (size_t)256 * D * 2, (size_t)256 * D * 2, NT / 256, D / 256, 1, G, c};
        EpiMix<2, P10_FP8 != 0> E{(bf16*)(ws + WS_Z), P10_FP8 ? D : D, (const void*)(ws + WS_GATES + 2048), 4096, (const bf16*)(ws + WS_MP), D};
        pg8::gemm_phase<EpiMix<2, P10_FP8 != 0>, RepOrder, false>(F.lds + RING_OFF, F.wave, D, D, D, S, E);
    } SEAM(9); PEND(9);
    PSTART(10);
    if (IN(10)) DUP(10) { FRESH();
        RepOrder S{(const char*)(ws + WS_Z), (const char*)(ws + WS_WO), 0, 0, (size_t)256 * D * (P10_FP8 ? 1 : 2), (size_t)256 * D * (P10_FP8 ? 1 : 2), NT / 256, D / 256, 1, G, c};
        EpiX1 E{args.in[I_X], (bf16*)(ws + WS_X1), (const float*)(ws + WS_MOD)};
        if (P10_FP8) pg8::gemm_phase<EpiX1, RepOrder, false, true, 124>(F.lds + RING_OFF, F.wave, D / 2, D / 2, D / 2, S, E);
        else pg8::gemm_phase<EpiX1, RepOrder, false>(F.lds + RING_OFF, F.wave, D, D, D, S, E);
    } SEAM(10); PEND(10);
    PSTART(11);
    if (IN(11)) DUP(11) { FRESH(); p11_route(F, args); } SEAM(11); PEND(11);
    PSTART(12);
    if (IN(12)) DUP(12) { FRESH(); p12_slots(F); } SEAM(12); PEND(12);
    PSTART(13);
    if (IN(13)) DUP(13) { FRESH();
        const int ntiles = moe_tables(F);
        MoeOrderT<true> S{(const char*)(ws + WS_H2), (const char*)ws, (const LAS int*)(F.lds + TAB_OFF), (const LAS int*)(F.lds + ROWTAB_OFF), 0, (size_t)1024 * D * 2, (size_t)256 * D, ntiles, 4, G, c};
        { LAS int* rt = (LAS int*)(F.lds + ROWTAB_OFF); const int* tok = (const int*)(ws + WS_TOK); Unit uu;
          for (int i = 0; i < ROWTAB_UNITS && S.next(i, uu); ++i) if (F.tid < 256) rt[i * 256 + F.tid] = tok[uu.pm * 256 + F.tid];
          __syncthreads(); }
        EpiAct E{ws + WS_ACT};
        pg8::gemm_phase<EpiAct, MoeOrderT<true>, true, true, 124>(F.lds + RING_OFF, F.wave, D / 2, D / 2, D / 2, S, E);
    } SEAM(13); PEND(13);
    PSTART(14);
    if (IN(14)) DUP(14) { FRESH();
        const int ntiles = moe_tables(F);
        MoeOrderT<false> S{(const char*)(ws + WS_ACT), (const char*)(ws + WS_DT), (const LAS int*)(F.lds + TAB_OFF), (const LAS int*)(F.lds + ROWTAB_OFF), (size_t)256 * DEXP, (size_t)D * DEXP, (size_t)256 * DEXP, ntiles, 8, G, c};
        EpiDown E{(unsigned char*)(ws + WS_YP)};
        if (STAGGER14 && (c & 8)) { for (int i_ = 0; i_ < STAGGER14; ++i_) __builtin_amdgcn_s_sleep(127); }
        pg8::gemm_phase<EpiDown, MoeOrderT<false>, false, true, 124>(F.lds + RING_OFF, F.wave, DEXP / 2, DEXP / 2, DEXP / 2, S, E);
    } SEAM(14); PEND(14);
    PSTART(15);
    if (IN(15)) DUP(15) { FRESH(); p15_final(F, args); }
#undef IN
#undef SEAM
}

extern "C" void kernel_launch(void* const* d_in, const int* in_sizes, int n_in, void* d_out, int out_size, void* d_ws, size_t ws_size, hipStream_t stream) {
    static int grid = 0;
    if (grid == 0) {
        if (n_in != 34 || in_sizes[0] != NT * D || out_size != NT * D || ws_size < WS_END) { fprintf(stderr, "kernel_launch: unexpected shapes (n_in %d, in0 %d, out %d, ws %zu < %zu)\n", n_in, n_in > 0 ? in_sizes[0] : -1, out_size, ws_size, (size_t)WS_END); grid = -1; return; }
        int dev = 0, cus = 0, per_cu = 0;
        if (hipGetDevice(&dev) != hipSuccess || hipDeviceGetAttribute(&cus, hipDeviceAttributeMultiprocessorCount, dev) != hipSuccess) { grid = -1; return; }
        if (hipFuncSetAttribute((const void*)mk_fwd, hipFuncAttributeMaxDynamicSharedMemorySize, LDS_BYTES) != hipSuccess) { fprintf(stderr, "kernel_launch: hipFuncSetAttribute failed\n"); grid = -1; return; }
        if (hipOccupancyMaxActiveBlocksPerMultiprocessor(&per_cu, (const void*)mk_fwd, 512, LDS_BYTES) != hipSuccess || per_cu < 1) fprintf(stderr, "kernel_launch: occupancy query reports %d\n", per_cu);
        (void)hipGetLastError();
        grid = cus;
    }
    if (grid < 0) return;
    if (hipMemsetAsync((char*)d_ws + WS_CTL, 0, CTL_ZERO_BYTES, stream) != hipSuccess) return;
    Args a{};
    for (int i = 0; i < 34; ++i) a.in[i] = (const float*)d_in[i];
    a.out = (float*)d_out; a.ws = (unsigned char*)d_ws;
#if MK_ONE_LAUNCH
    a.ph_lo = 0; a.ph_hi = NPHASE;
    hipLaunchKernelGGL(mk_fwd, dim3(grid), dim3(512), LDS_BYTES, stream, a);
#else
    for (int p = 0; p < NPHASE; ++p) { a.ph_lo = p; a.ph_hi = p + 1; hipLaunchKernelGGL(mk_fwd, dim3(grid), dim3(512), LDS_BYTES, stream, a); }
#endif
}
```

```cpp
#include <hip/hip_runtime.h>
#include <cstdio>
#include <cstdint>
#ifndef DUPMASK
#define DUPMASK 0
#endif
#ifndef PROBE_PHASE
#define PROBE_PHASE -1
#endif
#ifndef P2_FP8
#define P2_FP8 1
#endif
#ifndef POOL_FP8
#define POOL_FP8 1
#endif
#ifndef NOP12
#define NOP12 1
#endif
#ifndef MIX_FP8
#define MIX_FP8 1
#endif
#ifndef STAGGER14
#define STAGGER14 0
#endif
#ifndef P2PITCH
#define P2PITCH (2048)
#endif
#ifndef G1_TRANSPOSED
#define G1_TRANSPOSED 0
#endif
#ifndef MOE_BMAJOR
#define MOE_BMAJOR 0
#endif
#ifndef MOE_GR
#define MOE_GR 1
#endif
#ifndef NOCONV
#define NOCONV 0
#endif

#define GAS __attribute__((address_space(1)))
#define LAS __attribute__((address_space(3)))
typedef unsigned short bf16;
typedef unsigned v4u __attribute__((ext_vector_type(4)));
typedef unsigned v2u __attribute__((ext_vector_type(2)));
typedef float f32x4 __attribute__((ext_vector_type(4)));
typedef float f32x2 __attribute__((ext_vector_type(2)));
typedef short bf16x8 __attribute__((ext_vector_type(8)));

constexpr int D = 2048, NB = 4, TSEQ = 4096, NT = NB * TSEQ  , CTXL = 256, NC = NB * CTXL  , MT = NT + NC  ;
constexpr int DIN = 11904, DSH = 6784, NPAD = 12032, SLABLD = 6912, NH = 32, HS = 64;
constexpr int NEXP = 64, DEXP = 512, TOPK = 8;
constexpr int NSLOT = NT * TOPK + NEXP * 256 + NT;
constexpr int MAXTILES = NSLOT / 256;
constexpr int LINLD = 768;

__device__ __forceinline__ int opaque_n(int n) { asm volatile("" : "+s"(n)); return n; }
__device__ __forceinline__ unsigned f2bf(float f) { unsigned u = __builtin_bit_cast(unsigned, f); return (u + 0x7fffu + ((u >> 16) & 1u)) >> 16; }
typedef __bf16 bf16x2_t __attribute__((ext_vector_type(2)));
__device__ __forceinline__ unsigned pk2(float lo, float hi) { const f32x2 v = {lo, hi}; const bf16x2_t b = __builtin_convertvector(v, bf16x2_t); return __builtin_bit_cast(unsigned, b); }
__device__ __forceinline__ unsigned pk8(float a, float b, float c, float d) { a = __builtin_amdgcn_fmed3f(a, -448.f, 448.f); b = __builtin_amdgcn_fmed3f(b, -448.f, 448.f); c = __builtin_amdgcn_fmed3f(c, -448.f, 448.f); d = __builtin_amdgcn_fmed3f(d, -448.f, 448.f);
    int w = __builtin_amdgcn_cvt_pk_fp8_f32(a, b, 0, false); w = __builtin_amdgcn_cvt_pk_fp8_f32(c, d, w, true); return (unsigned)w; }
__device__ __forceinline__ float bflo(unsigned w) { return __builtin_bit_cast(float, w << 16); }
__device__ __forceinline__ float bfhi(unsigned w) { return __builtin_bit_cast(float, w & 0xffff0000u); }
__device__ __forceinline__ unsigned pkh2(float lo, float hi) { const unsigned short a = __builtin_bit_cast(unsigned short, (_Float16)lo), b = __builtin_bit_cast(unsigned short, (_Float16)hi); return (unsigned)a | ((unsigned)b << 16); }
__device__ __forceinline__ float hlo(unsigned w) { return (float)__builtin_bit_cast(_Float16, (unsigned short)(w & 0xffffu)); }
__device__ __forceinline__ float hhi(unsigned w) { return (float)__builtin_bit_cast(_Float16, (unsigned short)(w >> 16)); }
__device__ __forceinline__ float sigmoidf_(float x) { return __builtin_amdgcn_rcpf(1.0f + __builtin_amdgcn_exp2f(-1.44269504f * x)); }
__device__ __forceinline__ float tanhf_(float x) { return 1.0f - 2.0f * __builtin_amdgcn_rcpf(1.0f + __builtin_amdgcn_exp2f(2.88539008f * x)); }
__device__ __forceinline__ float wave_sum(float v) {
#pragma unroll
    for (int o = 1; o < 64; o <<= 1) v += __shfl_xor(v, o);
    return v;
}
__device__ __forceinline__ float dpp_f(float v, const int ctrl_sel) {
    int r;
    const int x = __builtin_bit_cast(int, v);
    if (ctrl_sel == 0) r = __builtin_amdgcn_update_dpp(0, x, 0xB1, 0xF, 0xF, true);
    else if (ctrl_sel == 1) r = __builtin_amdgcn_update_dpp(0, x, 0x4E, 0xF, 0xF, true);
    else if (ctrl_sel == 2) r = __builtin_amdgcn_update_dpp(0, x, 0x141, 0xF, 0xF, true);
    else r = __builtin_amdgcn_update_dpp(0, x, 0x140, 0xF, 0xF, true);
    return __builtin_bit_cast(float, r);
}
__device__ __forceinline__ float allred16(float v) { v += dpp_f(v, 0); v += dpp_f(v, 1); v += dpp_f(v, 2); v += dpp_f(v, 3); return v; }

#define LDS_WAIT() asm volatile("s_waitcnt lgkmcnt(0)" ::: "memory")
#define VM_WAIT() asm volatile("s_waitcnt vmcnt(0)" ::: "memory")

namespace pg8 {
constexpr int BM = 256, BK = 64, HALF = 128, HTB = HALF * BK * 2, STAGE_BYTES = 8 * HTB, NXCD = 8, WGM = 2;
__host__ __device__ __forceinline__ int lds_byte(int r, int c) { const int st = (r >> 4) * 2 + (c >> 5), rr = r & 15, cc = c & 31, ob = rr * 64 + cc * 2; return st * 1024 + (ob ^ (((ob >> 9) & 1) << 5)); }
__host__ __device__ __forceinline__ void stage_rc(int b, int& R, int& C) { const int st = b / 1024, sb = b % 1024, swz = sb ^ (((sb >> 9) & 1) << 5); R = (st >> 1) * 16 + swz / 64; C = (st & 1) * 32 + (swz % 64) / 2; }
__host__ __device__ __forceinline__ int perm32(int rho) { const int n = rho >> 4, i = rho & 15; return 8 * (i >> 2) + 4 * n + (i & 3); }
struct Unit { const char* A; const char* B; int pm, pn, aux, ui; };
__device__ __forceinline__ int xcd_remap(int L, int nwg) { const int q = nwg / NXCD, r = nwg % NXCD, xcd = L % NXCD, off = L / NXCD; return (xcd < r ? xcd * (q + 1) : r * (q + 1) + (xcd - r) * q) + off; }
__device__ __forceinline__ void grid_tile(int wgid, int nM, int nN, int& pm, int& pn) { const int nig = WGM * nN, gid = wgid / nig, fm = gid * WGM, gsz = (nM - fm) < WGM ? (nM - fm) : WGM; pm = fm + ((wgid % nig) % gsz); pn = (wgid % nig) / gsz; }

__device__ __forceinline__ void stage2(LAS unsigned char* lds, int bufoff, unsigned ldsw, const char* g, unsigned o0, unsigned o1) {
    __builtin_amdgcn_global_load_lds((const unsigned*)(g + o0), (LAS unsigned*)(lds + bufoff + ldsw), 16, 0, 0);
    __builtin_amdgcn_global_load_lds((const unsigned*)(g + o1), (LAS unsigned*)(lds + bufoff + ldsw + 8192), 16, 0, 0);
}

typedef int v8i_t __attribute__((ext_vector_type(8)));
typedef int v4i_t __attribute__((ext_vector_type(4)));
__device__ __forceinline__ v8i_t mx_cat(const bf16x8& lo, const bf16x8& hi) { const v4i_t a = __builtin_bit_cast(v4i_t, lo), b = __builtin_bit_cast(v4i_t, hi); return __builtin_shufflevector(a, b, 0, 1, 2, 3, 4, 5, 6, 7); }

template <class Epi, class = void> struct EpiPerm16 { static constexpr bool value = false; };
template <class Epi> struct EpiPerm16<Epi, decltype((void)Epi::PERM16)> { static constexpr bool value = Epi::PERM16; };
template <class Epi> __host__ __device__ constexpr bool epi_perm16() { return EpiPerm16<Epi>::value; }
template <class Epi> __host__ __device__ __forceinline__ int perm_row(int R) {
    if (epi_perm16<Epi>()) { const int wc = R >> 5, rho = R & 31, n = rho >> 4, i = rho & 15; return 64 * wc + 16 * (i >> 2) + 4 * n + (i & 3); }
    return Epi::PERM ? ((R & ~31) + perm32(R & 31)) : R;
}
template <class Epi, class Sched, bool GATHER, bool ALIGN_EPI = true, int MXS = 0>
__device__ __forceinline__ void gemm_phase(LAS unsigned char* lds, const int wave_, const int K, const int lda, const int ldb, const Sched& S, const Epi& E) {
    int tid_ = wave_ * 64 + (int)__builtin_amdgcn_mbcnt_hi(~0u, __builtin_amdgcn_mbcnt_lo(~0u, 0u)); asm volatile("" : "+v"(tid_));
    const int tid = tid_, wid = __builtin_amdgcn_readfirstlane(tid >> 6), lane = tid & 63, wr = wid >> 2, wc = wid & 3, fr = lane & 15, fq = lane >> 4;
    const int nt = opaque_n(K / BK);
    unsigned voffA[2], voffB[2]; int RA[2], CA[2];
#pragma unroll
    for (int i = 0; i < 2; ++i) { int R, C; stage_rc(tid * 16 + i * 8192, R, C); const int Rb = perm_row<Epi>(R);
        RA[i] = R; CA[i] = C; voffA[i] = (unsigned)(R * lda + C) * 2u; voffB[i] = (unsigned)(Rb * ldb + C) * 2u; }
    const size_t kstep = (size_t)(BK * 2);
    const size_t hstepA = (size_t)HALF * lda * 2, hstepB = (size_t)(epi_perm16<Epi>() ? 8 : HALF) * ldb * 2;
    const unsigned ldsw = (unsigned)wid * 1024u;
    const int aoff = lds_byte(wr * 64 + fr, fq * 8), boff = lds_byte(wc * 32 + fr, fq * 8);
#define PG8_SA(b, h) (((b) * 2 + (h)) * HTB)
#define PG8_SB(b, h) ((4 + (b) * 2 + (h)) * HTB)
#define PG8_STB(bufoff, gbase) stage2(lds, (bufoff), ldsw, (gbase), voffB[0], voffB[1])
#define PG8_STA(bufoff, gk, h, NX) do { if constexpr (GATHER) { const unsigned _o0 = (NX) ? vn[h][0] : vc[h][0], _o1 = (NX) ? vn[h][1] : vc[h][1]; stage2(lds, (bufoff), ldsw, (gk), _o0, _o1); } \
        else stage2(lds, (bufoff), ldsw, (gk) + (h) * hstepA, voffA[0], voffA[1]); } while (0)
#define PG8_LDA(dst, b, h) do { _Pragma("unroll") for (int m = 0; m < 4; ++m) _Pragma("unroll") for (int k = 0; k < 2; ++k) dst[m][k] = *(const LAS bf16x8*)(lds + PG8_SA(b, h) + aoff + m * 2048 + k * 1024); } while (0)
#define PG8_LDB(dst, b, h) do { _Pragma("unroll") for (int n = 0; n < 2; ++n) _Pragma("unroll") for (int k = 0; k < 2; ++k) dst[n][k] = *(const LAS bf16x8*)(lds + PG8_SB(b, h) + boff + n * 2048 + k * 1024); } while (0)
#define PG8_MMA(ai, bj, At, Bt) do { __builtin_amdgcn_s_setprio(1); if constexpr (MXS != 0) { _Pragma("unroll") for (int m = 0; m < 4; ++m) _Pragma("unroll") for (int n = 0; n < 2; ++n) \
        asm volatile("v_mfma_scale_f32_16x16x128_f8f6f4 %0, %1, %2, %0, %3, %3 op_sel_hi:[0,0,0]" : "+v"(acc[ai][bj][m][n]) : "v"(mx_cat(Bt[n][0], Bt[n][1])), "v"(mx_cat(At[m][0], At[m][1])), "v"(mxs_)); } \
        else { _Pragma("unroll") for (int m = 0; m < 4; ++m) _Pragma("unroll") for (int n = 0; n < 2; ++n) _Pragma("unroll") for (int k = 0; k < 2; ++k) \
        acc[ai][bj][m][n] = __builtin_amdgcn_mfma_f32_16x16x32_bf16(Bt[n][k], At[m][k], acc[ai][bj][m][n], 0, 0, 0); } __builtin_amdgcn_s_setprio(0); } while (0)
#define PG8_WAIT_V(n) asm volatile("s_waitcnt vmcnt(" #n ")" ::: "memory")
#define PG8_WAIT_L(n) asm volatile("s_waitcnt lgkmcnt(" #n ")" ::: "memory")
#define PG8_BAR __builtin_amdgcn_s_barrier()
#define PG8_SCHED __builtin_amdgcn_sched_barrier(0)
    Unit cur, nxt; int ui = 0;
    if (!S.next(0, cur)) return;
    int mxs_ = MXS * 0x01010101; asm volatile("" : "+v"(mxs_));
    unsigned vc[2][2], vn[2][2];
    if constexpr (GATHER) {
#pragma unroll
        for (int h = 0; h < 2; ++h)
#pragma unroll
            for (int i = 0; i < 2; ++i) { vc[h][i] = ((unsigned)S.row(cur, h * HALF + RA[i]) * (unsigned)lda + (unsigned)CA[i]) * 2u; vn[h][i] = vc[h][i]; }
        if constexpr (!Sched::ROW_LDS) asm volatile("s_waitcnt vmcnt(0)" ::: "memory");
    }
    f32x4 acc[2][2][4][2];
#pragma unroll
    for (int a = 0; a < 2; ++a)
#pragma unroll
        for (int b = 0; b < 2; ++b)
#pragma unroll
            for (int m = 0; m < 4; ++m)
#pragma unroll
                for (int n = 0; n < 2; ++n) acc[a][b][m][n] = (f32x4){0.f, 0.f, 0.f, 0.f};
    bf16x8 At[4][2], B0[2][2], B1[2][2];
    const char* cA = cur.A; const char* cB = cur.B;
    PG8_STB(PG8_SB(0, 0), cB); PG8_STB(PG8_SB(0, 1), cB + hstepB); PG8_STA(PG8_SA(0, 0), cA, 0, false); PG8_STA(PG8_SA(0, 1), cA, 1, false);
    if (wr == 1) PG8_BAR;
    PG8_WAIT_V(2); PG8_BAR;
    PG8_STB(PG8_SB(1, 0), cB + kstep); PG8_STA(PG8_SA(1, 0), cA + kstep, 0, false); PG8_STB(PG8_SB(1, 1), cB + hstepB + kstep);
    PG8_WAIT_V(6); PG8_BAR;
    for (;;) {
        const bool has_next = S.next(ui + 1, nxt);
        const char* nA = has_next ? nxt.A : cA; const char* nB = has_next ? nxt.B : cB;
#pragma unroll 1
        for (int t = 0; t < nt; t += 2) {
            const bool last = (t == nt - 2);
            const char* a1 = cA + (size_t)(t + 1) * kstep;
            const char* a2 = last ? nA : cA + (size_t)(t + 2) * kstep; const char* b2 = last ? nB : cB + (size_t)(t + 2) * kstep;
            const char* a3 = a2 + kstep; const char* b3 = b2 + kstep;
            if constexpr (GATHER) {
                if (last && has_next) {
#pragma unroll
                    for (int h = 0; h < 2; ++h)
#pragma unroll
                        for (int i = 0; i < 2; ++i) vn[h][i] = ((unsigned)S.row(nxt, h * HALF + RA[i]) * (unsigned)lda + (unsigned)CA[i]) * 2u;
                    if constexpr (!Sched::ROW_LDS) asm volatile("s_waitcnt vmcnt(0)" ::: "memory");
                }
            }
            PG8_LDB(B0, 0, 0); PG8_LDB(B1, 0, 1); PG8_SCHED; PG8_LDA(At, 0, 0); PG8_STA(PG8_SA(1, 1), a1, 1, false);
            PG8_WAIT_V(8); PG8_WAIT_L(0); PG8_BAR; PG8_MMA(0, 0, At, B0); PG8_MMA(0, 1, At, B1); PG8_BAR; PG8_SCHED;
            PG8_LDA(At, 0, 1); PG8_STB(PG8_SB(0, 0), b2); PG8_STB(PG8_SB(0, 1), b2 + hstepB); PG8_STA(PG8_SA(0, 0), a2, 0, last);
            PG8_WAIT_V(8); PG8_WAIT_L(0); PG8_BAR; PG8_MMA(1, 0, At, B0); PG8_MMA(1, 1, At, B1); PG8_BAR; PG8_SCHED;
            PG8_LDB(B0, 1, 0); PG8_LDB(B1, 1, 1); PG8_SCHED; PG8_LDA(At, 1, 0); PG8_STA(PG8_SA(0, 1), a2, 1, last);
            PG8_WAIT_V(8); PG8_WAIT_L(0); PG8_BAR; PG8_MMA(0, 0, At, B0); PG8_MMA(0, 1, At, B1); PG8_BAR; PG8_SCHED;
            PG8_LDA(At, 1, 1); PG8_STB(PG8_SB(1, 0), b3); PG8_STB(PG8_SB(1, 1), b3 + hstepB); PG8_STA(PG8_SA(1, 0), a3, 0, last);
            PG8_WAIT_V(8); PG8_WAIT_L(0); PG8_BAR; PG8_MMA(1, 0, At, B0); PG8_MMA(1, 1, At, B1); PG8_BAR; PG8_SCHED;
        }
        if constexpr (ALIGN_EPI) { if (wr == 0) PG8_BAR; }
        if constexpr (MXS != 0) asm volatile("s_nop 15\n\ts_nop 15" ::: "memory");
        { int fr_ = fr, fq_ = fq; asm volatile("" : "+v"(fr_), "+v"(fq_));
          E(acc, cur, wr, wc, fr_, fq_); }
        if (!has_next) break;
#pragma unroll
        for (int a = 0; a < 2; ++a)
#pragma unroll
            for (int b = 0; b < 2; ++b)
#pragma unroll
                for (int m = 0; m < 4; ++m)
#pragma unroll
                    for (int n = 0; n < 2; ++n) acc[a][b][m][n] = (f32x4){0.f, 0.f, 0.f, 0.f};
        cur = nxt; cA = nA; cB = nB; ++ui;
        if constexpr (GATHER) {
#pragma unroll
            for (int h = 0; h < 2; ++h)
#pragma unroll
                for (int i = 0; i < 2; ++i) vc[h][i] = vn[h][i];
        }
        if constexpr (ALIGN_EPI) { if (wr == 1) PG8_BAR; }
    }
    PG8_WAIT_V(0);
    if constexpr (!ALIGN_EPI) { if (wr == 0) PG8_BAR; }
    PG8_BAR;
#undef PG8_SA
#undef PG8_SB
#undef PG8_STB
#undef PG8_STA
#undef PG8_LDA
#undef PG8_LDB
#undef PG8_MMA
#undef PG8_WAIT_V
#undef PG8_WAIT_L
#undef PG8_BAR
#undef PG8_SCHED
}
}
#define XB_TMO      128
#define XB_XCNT(j)  (256  + 64 * (j))
#define XB_XSUB(j)  (1280 + 64 * (j))
#define XB_XGEN(j)  (2304 + 64 * (j))
#define XB_TOP      3328
#define XB_TOPGEN   3392
#define XCD_BAR_WORDS 3456
#define XB_SPIN_CAP (1u << 18)
__device__ __forceinline__ unsigned xb_ld(unsigned* p)              { return __hip_atomic_load(p, __ATOMIC_RELAXED, __HIP_MEMORY_SCOPE_AGENT); }
__device__ __forceinline__ unsigned xb_add(unsigned* p, unsigned v) { return __hip_atomic_fetch_add(p, v, __ATOMIC_RELAXED, __HIP_MEMORY_SCOPE_AGENT); }
__device__ __forceinline__ unsigned xb_xcc_id() { return (unsigned)__builtin_amdgcn_s_getreg((3 << 11) | 20) & 0xFu; }
#define XB_SPIN(cond, bar) do { unsigned _sp = 0; while (cond) { __builtin_amdgcn_s_sleep(1); \
    if ((++_sp & 255u) == 0u) { if (xb_ld(&(bar)[XB_TMO])) break; if (_sp > XB_SPIN_CAP) { atomicAdd(&(bar)[XB_TMO], 1u); break; } } } } while (0)
struct XcdBarrier { unsigned* bar; unsigned x; volatile LAS unsigned* st; };
__device__ __forceinline__ XcdBarrier xcd_barrier_post(unsigned* bar, volatile LAS unsigned* st) {
    XcdBarrier b; b.bar = bar; b.x = xb_xcc_id(); b.st = st;
    if (threadIdx.x == 0) (void)xb_add(&bar[XB_XCNT(b.x)], 1u);
    return b;
}
__device__ __forceinline__ void xcd_barrier_complete(unsigned* bar, unsigned x, unsigned& nloc, unsigned& nx) {
    const unsigned G = gridDim.x * gridDim.y * gridDim.z;
    unsigned sum, cnt, mine, sp = 0u;
    for (;;) {
        sum = 0u; cnt = 0u; mine = 0u;
#pragma unroll
        for (unsigned j = 0; j < 16; ++j) { const unsigned c = xb_ld(&bar[XB_XCNT(j)]); sum += c; cnt += (c > 0u) ? 1u : 0u; mine = (j == x) ? c : mine; }
        if (sum == G) break;
        __builtin_amdgcn_s_sleep(1);
        if ((++sp & 255u) == 0u) { if (xb_ld(&bar[XB_TMO])) break; if (sp > XB_SPIN_CAP) { atomicAdd(&bar[XB_TMO], 1u); break; } }
    }
    nloc = mine > 0u ? mine : 1u; nx = cnt > 0u ? cnt : 1u;
}
__device__ __forceinline__ void xcd_barrier(const XcdBarrier& b) {
    asm volatile("s_waitcnt vmcnt(0)" ::: "memory");
    __syncthreads();
    if (threadIdx.x == 0) {
        unsigned* bar = b.bar;
        __builtin_amdgcn_s_waitcnt(0);
        unsigned nloc = b.st[0], nx = b.st[1];
        if (nloc == 0u) { xcd_barrier_complete(bar, b.x, nloc, nx); b.st[0] = nloc; b.st[1] = nx; }
        const unsigned old = xb_add(&bar[XB_XSUB(b.x)], 1u);
        const unsigned gen = old / nloc;
        if (old + 1u == (gen + 1u) * nloc) {
            __builtin_amdgcn_fence(__ATOMIC_RELEASE, "agent");
            asm volatile("s_waitcnt vmcnt(0)" ::: "memory");
            const unsigned og = xb_add(&bar[XB_TOP], 1u);
            const unsigned tg = og / nx;
            if (og + 1u == (tg + 1u) * nx) xb_add(&bar[XB_TOPGEN], 1u);
            else XB_SPIN(xb_ld(&bar[XB_TOPGEN]) == tg, bar);
            __builtin_amdgcn_fence(__ATOMIC_ACQUIRE, "agent");
            xb_add(&bar[XB_XGEN(b.x)], 1u);
            asm volatile("s_waitcnt vmcnt(0)" ::: "memory");
        } else {
            XB_SPIN(xb_ld(&bar[XB_XGEN(b.x)]) == gen, bar);
            __builtin_amdgcn_fence(__ATOMIC_ACQUIRE, "agent");
            asm volatile("s_waitcnt vmcnt(0)" ::: "memory");
        }
    }
    __syncthreads();
}

constexpr size_t MiB = 1u << 20;
constexpr size_t WS_CTL = 0, CTL_ZERO_BYTES = 64 * 1024;
constexpr size_t WS_MOD = 1 * MiB;
constexpr size_t WS_EIDX = 2 * MiB;
constexpr size_t WS_WSEL = WS_EIDX + 512 * 1024;
constexpr size_t WS_RANK = WS_WSEL + 512 * 1024;
constexpr size_t WS_TOK = 4 * MiB;
constexpr size_t WS_DST = WS_TOK + 1 * MiB;
constexpr size_t WS_WSL = WS_DST + 1 * MiB;
constexpr size_t WS_WIN = 8 * MiB;
constexpr size_t WS_POOLW = 55 * MiB;
constexpr size_t WS_WPO = 56 * MiB;
constexpr size_t WS_LORA = 60 * MiB;
constexpr size_t WS_G2 = 62 * MiB;
constexpr size_t WS_WRO = 63 * MiB;
constexpr size_t WS_WO = 71 * MiB;
constexpr size_t WS_SLAB = 80 * MiB;
constexpr size_t WS_EA = 80 * MiB;
constexpr size_t EA_STRIDE = (size_t)MT * D * 2;
constexpr size_t WS_YF = 352 * MiB, WS_YB = 416 * MiB;
constexpr size_t WS_HA = 438 * MiB;
constexpr size_t WS_Z = 480 * MiB;
constexpr size_t WS_U = 506 * MiB;
constexpr size_t WS_RM = 544 * MiB, WS_KM = 612 * MiB, WS_VM = 680 * MiB;
constexpr size_t WS_LIN = 748 * MiB;
constexpr size_t WS_DP = 774 * MiB;
constexpr size_t WS_BON = 774 * MiB;
constexpr size_t WS_Y2 = 806 * MiB;
constexpr size_t WS_MP = 838 * MiB;
constexpr size_t WS_GATES = 902 * MiB;
constexpr size_t WS_OR = 80 * MiB;
constexpr size_t WS_H2 = 520 * MiB;
constexpr size_t WS_GU = 584 * MiB;
constexpr size_t WS_GU2 = 966 * MiB, WS_GU3 = 1134 * MiB;
constexpr int GU_E2 = 52, GU_E3 = 61;
constexpr size_t WS_ACT = 792 * MiB;
constexpr size_t WS_DT = 1004 * MiB;
constexpr size_t WS_X1 = 328 * MiB;
constexpr size_t WS_YP = 8 * MiB;
constexpr size_t WS_TOKE = 1142 * MiB;
constexpr size_t WS_GG = 1070 * MiB;
constexpr size_t WS_END = 1150 * MiB;
__host__ __device__ __forceinline__ size_t gu_base(int e) { return e < GU_E2 ? WS_GU + (size_t)e * (4 * MiB) : e < GU_E3 ? WS_GU2 + (size_t)(e - GU_E2) * (4 * MiB) : WS_GU3 + (size_t)(e - GU_E3) * (2 * MiB); }
constexpr int CW_BAR = 1024;
constexpr int CW_GCNT = 8192;
constexpr int CW_O64 = 8192 + 100;
constexpr int CW_CONV = 8448, CW_P2DONE = 8512;
static_assert((CW_BAR + XCD_BAR_WORDS) <= CW_GCNT && (CW_P2DONE + 128) * 4 <= (int)CTL_ZERO_BYTES, "ctl");

constexpr int RING_OFF = 0, RING_BYTES = 131072;
constexpr int LDSCTL_OFF = RING_BYTES;
constexpr int ROWTAB_OFF = LDSCTL_OFF + 1024 + 4096, ROWTAB_UNITS = 24;
constexpr int TAB_OFF = LDSCTL_OFF + 1024;
constexpr int LDS_BYTES = 163840;

using pg8::Unit;
struct RepOrder { static constexpr bool ROW_LDS = false;
    const char* A; const char* B; size_t repA, repB, tA, tB; int nM, nN, nrep, G, c;
    __device__ __forceinline__ bool next(int i, Unit& u) const {
        const long L = (long)i * G + c; const int per = nM * nN; if (L >= (long)per * nrep) return false;
        const int rep = (int)(L / per); const int w = pg8::xcd_remap((int)(L % per), per); pg8::grid_tile(w, nM, nN, u.pm, u.pn); u.aux = rep;
        u.A = A + (size_t)rep * repA + (size_t)u.pm * tA; u.B = B + (size_t)rep * repB + (size_t)u.pn * tB; return true; }
    __device__ __forceinline__ int row(const Unit&, int) const { return 0; }
};
struct G1Order { static constexpr bool ROW_LDS = false;
    const char* A; const char* B; size_t tA, tB; int G, c;
    __device__ __forceinline__ bool next(int i, Unit& u) const {
        const long L = (long)i * G + c; constexpr int N1 = 64 * 47, N2 = 4 * 27; if (L >= N1 + N2) return false;
        if (L < N1) { const int w = pg8::xcd_remap((int)L, N1); if (G1_TRANSPOSED) pg8::grid_tile(w, 47, 64, u.pn, u.pm); else pg8::grid_tile(w, 64, 47, u.pm, u.pn); }
        else { const int l2 = (int)L - N1; u.pm = 64 + (l2 & 3); u.pn = 4 + (l2 >> 2); }
        u.aux = 0; u.A = A + (size_t)u.pm * tA; u.B = B + (size_t)u.pn * tB; return true; }
    __device__ __forceinline__ int row(const Unit&, int) const { return 0; }
};
template <bool GUMAP> struct MoeOrderT { static constexpr bool ROW_LDS = true;
    const char* A; const char* B; const LAS int* te; const LAS int* rowtab; size_t tA, estride, jstride; int ntiles, NJ, G, c;
    __device__ __forceinline__ bool next(int i, Unit& u) const {
        const long L = (long)i * G + c; const int tot = ntiles * NJ; if (L >= tot) return false;
        const int w = pg8::xcd_remap((int)L, tot); const int per = MOE_GR * NJ, g = w / per, r = w - g * per, gsz = (ntiles - g * MOE_GR) < MOE_GR ? (ntiles - g * MOE_GR) : MOE_GR; int rt = g * MOE_GR + r % gsz, j = r / gsz; int e = te[rt];
        if (MOE_BMAJOR) { const LAS int* off = te + MAXTILES; e = te[w / NJ]; const int ts = off[e] >> 8, tn = (e < 64 ? (off[e + 1] >> 8) : off[65]) - ts, ue = w - NJ * ts; j = ue / tn; rt = ts + ue - j * tn; }
        u.pm = rt; u.pn = j; u.aux = e; u.ui = i; u.A = A + (size_t)rt * tA; u.B = B + (GUMAP ? gu_base(e) : (size_t)e * estride) + (size_t)j * jstride; return true; }
    __device__ __forceinline__ int row(const Unit& u, int r) const { return rowtab[u.ui * 256 + r]; }
};

typedef f32x4 AccT[2][2][4][2];
#define EPI_ROWS_BEGIN _Pragma("unroll") for (int ai = 0; ai < 2; ++ai) _Pragma("unroll") for (int m = 0; m < 4; ++m) { const int rl = ai * 128 + wr * 64 + m * 16 + fr;
#define EPI_ROWS_END if (m & 1) asm volatile("" ::: "memory"); }
struct EpiG1 { static constexpr bool PERM = true; bf16* U; bf16* SLAB; unsigned char* GATES;
    __device__ __forceinline__ void operator()(const AccT& acc, const Unit& u, int wr, int wc, int fr, int fq) const {
        if (u.pn >= 31) {
            const int c0 = (u.pn - 31) * 256 + wc * 32 + 8 * fq;
            EPI_ROWS_BEGIN
                unsigned char* rowp = GATES + (size_t)(u.pm * 256 + rl) * 4096 + c0;
#pragma unroll
                for (int bj = 0; bj < 2; ++bj) { const f32x4 v0 = acc[ai][bj][m][0], v1 = acc[ai][bj][m][1]; unsigned p0 = 0u, p1 = 0u;
                    p0 = __builtin_amdgcn_cvt_pk_u8_f32(255.0f * sigmoidf_(v0[0]), 0, p0); p0 = __builtin_amdgcn_cvt_pk_u8_f32(255.0f * sigmoidf_(v0[1]), 1, p0);
                    p0 = __builtin_amdgcn_cvt_pk_u8_f32(255.0f * sigmoidf_(v0[2]), 2, p0); p0 = __builtin_amdgcn_cvt_pk_u8_f32(255.0f * sigmoidf_(v0[3]), 3, p0);
                    p1 = __builtin_amdgcn_cvt_pk_u8_f32(255.0f * sigmoidf_(v1[0]), 0, p1); p1 = __builtin_amdgcn_cvt_pk_u8_f32(255.0f * sigmoidf_(v1[1]), 1, p1);
                    p1 = __builtin_amdgcn_cvt_pk_u8_f32(255.0f * sigmoidf_(v1[2]), 2, p1); p1 = __builtin_amdgcn_cvt_pk_u8_f32(255.0f * sigmoidf_(v1[3]), 3, p1);
                    v2u w; w.x = p0; w.y = p1; *(v2u*)(rowp + bj * 128) = w; }
            EPI_ROWS_END
            return;
        }
        bf16* base; int ld, c0;
        if (u.pn < 4) { base = U; ld = 1024; c0 = u.pn * 256; } else { base = SLAB; ld = SLABLD; c0 = (u.pn - 4) * 256; }
        EPI_ROWS_BEGIN
            bf16* rowp = base + (size_t)(u.pm * 256 + rl) * ld + c0 + wc * 32 + 8 * fq;
#pragma unroll
            for (int bj = 0; bj < 2; ++bj) { const f32x4 v0 = acc[ai][bj][m][0], v1 = acc[ai][bj][m][1];
                v4u w; w.x = pk2(v0[0], v0[1]); w.y = pk2(v0[2], v0[3]); w.z = pk2(v1[0], v1[1]); w.w = pk2(v1[2], v1[3]); *(v4u*)(rowp + bj * 128) = w; }
        EPI_ROWS_END
    }
};
struct EpiLora { static constexpr bool PERM = true; unsigned short* EA; const float* w0; const float* a0;
    __device__ __forceinline__ void operator()(const AccT& acc, const Unit& u, int wr, int wc, int fr, int fq) const {
        const int rep = u.aux; const float* bias = (rep < 2 ? w0 + rep * D : a0 + (rep - 2) * D) + u.pn * 256 + wc * 32 + 8 * fq;
        unsigned short* base = EA + (size_t)rep * ((size_t)MT * D);
        if (rep < 2) { const float cc = -0.8750424f;
            EPI_ROWS_BEGIN
                unsigned short* rowp = base + (size_t)(u.pm * 256 + rl) * D + u.pn * 256 + wc * 32 + 8 * fq;
#pragma unroll
                for (int bj = 0; bj < 2; ++bj) { const f32x4 v0 = acc[ai][bj][m][0] + *(const f32x4*)(bias + bj * 128), v1 = acc[ai][bj][m][1] + *(const f32x4*)(bias + bj * 128 + 4);
                    v4u w; w.x = pkh2(cc * sigmoidf_(v0[0]), cc * sigmoidf_(v0[1])); w.y = pkh2(cc * sigmoidf_(v0[2]), cc * sigmoidf_(v0[3]));
                    w.z = pkh2(cc * sigmoidf_(v1[0]), cc * sigmoidf_(v1[1])); w.w = pkh2(cc * sigmoidf_(v1[2]), cc * sigmoidf_(v1[3]));
                    *(v4u*)(rowp + bj * 128) = w; }
            EPI_ROWS_END
        } else {
            EPI_ROWS_BEGIN
                unsigned char* rowp = (unsigned char*)base + (size_t)(u.pm * 256 + rl) * D + u.pn * 256 + wc * 32 + 8 * fq;
#pragma unroll
                for (int bj = 0; bj < 2; ++bj) { const f32x4 v0 = acc[ai][bj][m][0] + *(const f32x4*)(bias + bj * 128), v1 = acc[ai][bj][m][1] + *(const f32x4*)(bias + bj * 128 + 4); unsigned p0 = 0u, p1 = 0u;
                    p0 = __builtin_amdgcn_cvt_pk_u8_f32(255.0f * sigmoidf_(v0[0]), 0, p0); p0 = __builtin_amdgcn_cvt_pk_u8_f32(255.0f * sigmoidf_(v0[1]), 1, p0);
                    p0 = __builtin_amdgcn_cvt_pk_u8_f32(255.0f * sigmoidf_(v0[2]), 2, p0); p0 = __builtin_amdgcn_cvt_pk_u8_f32(255.0f * sigmoidf_(v0[3]), 3, p0);
                    p1 = __builtin_amdgcn_cvt_pk_u8_f32(255.0f * sigmoidf_(v1[0]), 0, p1); p1 = __builtin_amdgcn_cvt_pk_u8_f32(255.0f * sigmoidf_(v1[1]), 1, p1);
                    p1 = __builtin_amdgcn_cvt_pk_u8_f32(255.0f * sigmoidf_(v1[2]), 2, p1); p1 = __builtin_amdgcn_cvt_pk_u8_f32(255.0f * sigmoidf_(v1[3]), 3, p1);
                    v2u w; w.x = p0; w.y = p1; *(v2u*)(rowp + bj * 128) = w; }
            EPI_ROWS_END
        }
    }
};
struct EpiPoolG { static constexpr bool PERM = true; bf16* Y2; const float* scale;
    __device__ __forceinline__ void operator()(const AccT& acc, const Unit& u, int wr, int wc, int fr, int fq) const {
        const int cb = u.aux * 256 + wc * 32 + 8 * fq;
        f32x4 s0[2], s1[2];
#pragma unroll
        for (int bj = 0; bj < 2; ++bj) { s0[bj] = *(const f32x4*)(scale + cb + bj * 128); s1[bj] = *(const f32x4*)(scale + cb + bj * 128 + 4); }
        EPI_ROWS_BEGIN
            bf16* rowp = Y2 + (size_t)(u.pm * 256 + rl) * 1024 + cb;
#pragma unroll
            for (int bj = 0; bj < 2; ++bj) { const f32x4 v0 = acc[ai][bj][m][0] * s0[bj], v1 = acc[ai][bj][m][1] * s1[bj];
                if (POOL_FP8) { v2u w; w.x = pk8(8.0f * v0[0], 8.0f * v0[1], 8.0f * v0[2], 8.0f * v0[3]); w.y = pk8(8.0f * v1[0], 8.0f * v1[1], 8.0f * v1[2], 8.0f * v1[3]); *(v2u*)((unsigned char*)Y2 + (size_t)(u.pm * 256 + rl) * 1024 + cb + bj * 128) = w; }
                else { v4u w; w.x = pk2(v0[0], v0[1]); w.y = pk2(v0[2], v0[3]); w.z = pk2(v1[0], v1[1]); w.w = pk2(v1[2], v1[3]); *(v4u*)(rowp + bj * 128) = w; } }
        EPI_ROWS_END
    }
};
template <int MODE, bool OUT8 = false> struct EpiMix { static constexpr bool PERM = true; bf16* OUT;
    int ldo; const void* AUX1; int ld1; const bf16* AUX2; int ld2;
    __device__ __forceinline__ void operator()(const AccT& acc, const Unit& u, int wr, int wc, int fr, int fq) const {
        const int cb = u.pn * 256 + wc * 32 + 8 * fq;
        EPI_ROWS_BEGIN
            const size_t row = (size_t)(u.pm * 256 + rl);
#pragma unroll
            for (int bj = 0; bj < 2; ++bj) { const f32x4 v0 = acc[ai][bj][m][0], v1 = acc[ai][bj][m][1];
                float x[8];
                if (MODE == 3) {
#pragma unroll
                    for (int j = 0; j < 8; ++j) x[j] = 1.0f; }
                else if (MODE == 1) { const v4u a1 = *(const v4u*)((const bf16*)AUX1 + row * ld1 + cb + bj * 128);
                    x[0] = bflo(a1.x); x[1] = bfhi(a1.x); x[2] = bflo(a1.y); x[3] = bfhi(a1.y); x[4] = bflo(a1.z); x[5] = bfhi(a1.z); x[6] = bflo(a1.w); x[7] = bfhi(a1.w); }
                else { const v2u a1 = __builtin_nontemporal_load((const v2u*)((const unsigned char*)AUX1 + row * ld1 + cb + bj * 128)); const float k = 1.0f / 255.0f;
                    x[0] = (float)(a1.x & 0xffu) * k; x[1] = (float)((a1.x >> 8) & 0xffu) * k; x[2] = (float)((a1.x >> 16) & 0xffu) * k; x[3] = (float)(a1.x >> 24) * k;
                    x[4] = (float)(a1.y & 0xffu) * k; x[5] = (float)((a1.y >> 8) & 0xffu) * k; x[6] = (float)((a1.y >> 16) & 0xffu) * k; x[7] = (float)(a1.y >> 24) * k; }
                float o[8];
                if (MODE == 0 || MODE == 1 || MODE == 3) {
#pragma unroll
                    for (int j = 0; j < 4; ++j) { o[j] = x[j] * v0[j]; o[4 + j] = x[4 + j] * v1[j]; } }
                else { const v4u a2 = __builtin_nontemporal_load((const v4u*)(AUX2 + row * ld2 + cb + bj * 128));
                    const float y[8] = {bflo(a2.x), bfhi(a2.x), bflo(a2.y), bfhi(a2.y), bflo(a2.z), bfhi(a2.z), bflo(a2.w), bfhi(a2.w)};
#pragma unroll
                    for (int j = 0; j < 4; ++j) { o[j] = y[j] + x[j] * v0[j]; o[4 + j] = y[4 + j] + x[4 + j] * v1[j]; } }
                if (OUT8) { v2u w; w.x = pk8(8.0f * o[0], 8.0f * o[1], 8.0f * o[2], 8.0f * o[3]); w.y = pk8(8.0f * o[4], 8.0f * o[5], 8.0f * o[6], 8.0f * o[7]); *(v2u*)((unsigned char*)OUT + row * ldo + cb + bj * 128) = w; }
                else { v4u w; w.x = pk2(o[0], o[1]); w.y = pk2(o[2], o[3]); w.z = pk2(o[4], o[5]); w.w = pk2(o[6], o[7]);
                *(v4u*)(OUT + row * ldo + cb + bj * 128) = w; } }
        EPI_ROWS_END
    }
};
struct EpiX1 { static constexpr bool PERM = true; const float* X; bf16* OUT; const float* MOD;
    __device__ __forceinline__ void operator()(const AccT& acc, const Unit& u, int wr, int wc, int fr, int fq) const {
        const int b = u.pm >> 4;
        const int cb = u.pn * 256 + wc * 32 + 8 * fq; const float* g = MOD + (size_t)b * 12288 + 4096 + cb;
        f32x4 gv[2][2];
#pragma unroll
        for (int bj = 0; bj < 2; ++bj)
#pragma unroll
            for (int n = 0; n < 2; ++n) gv[bj][n] = *(const f32x4*)(g + bj * 128 + n * 4);
        EPI_ROWS_BEGIN
            const size_t off = (size_t)(u.pm * 256 + rl) * D + cb;
#pragma unroll
            for (int bj = 0; bj < 2; ++bj) { const f32x4 x0 = __builtin_nontemporal_load((const f32x4*)(X + off + bj * 128)), x1 = __builtin_nontemporal_load((const f32x4*)(X + off + bj * 128 + 4));
                const f32x4 v0 = x0 + gv[bj][0] * acc[ai][bj][m][0], v1 = x1 + gv[bj][1] * acc[ai][bj][m][1];
                v4u w; w.x = pk2(v0[0], v0[1]); w.y = pk2(v0[2], v0[3]); w.z = pk2(v1[0], v1[1]); w.w = pk2(v1[2], v1[3]); *(v4u*)(OUT + off + bj * 128) = w; }
        EPI_ROWS_END
    }
};
constexpr float ACT_F8SCALE = 8.0f;
struct EpiAct { static constexpr bool PERM = true; unsigned char* ACT;
    __device__ __forceinline__ void operator()(const AccT& acc, const Unit& u, int wr, int wc, int fr, int fq) const {
        EPI_ROWS_BEGIN
            const f32x4 g0 = acc[ai][0][m][0], g1 = acc[ai][0][m][1], u0 = acc[ai][1][m][0], u1 = acc[ai][1][m][1];
            float o[8];
#pragma unroll
            for (int j = 0; j < 4; ++j) { o[j] = __builtin_amdgcn_fmed3f(ACT_F8SCALE * g0[j] * sigmoidf_(g0[j]) * u0[j], -440.f, 440.f); o[4 + j] = __builtin_amdgcn_fmed3f(ACT_F8SCALE * g1[j] * sigmoidf_(g1[j]) * u1[j], -440.f, 440.f); }
            v2u w; w.x = pk8(o[0], o[1], o[2], o[3]); w.y = pk8(o[4], o[5], o[6], o[7]);
            *(v2u*)(ACT + (size_t)(u.pm * 256 + rl) * DEXP + u.pn * 128 + wc * 32 + 8 * fq) = w;
        EPI_ROWS_END
    }
};
constexpr float YP_SCALE = 8.0f;
struct EpiDown { static constexpr bool PERM = true, PERM16 = true; unsigned char* YP;
    __device__ __forceinline__ void operator()(const AccT& acc, const Unit& u, int wr, int wc, int fr, int fq) const {
        const int cb = u.pn * 256 + wc * 64 + 16 * fq;
        EPI_ROWS_BEGIN
            int p[4];
#pragma unroll
            for (int bj = 0; bj < 2; ++bj) { const f32x4 v0 = acc[ai][bj][m][0] * YP_SCALE, v1 = acc[ai][bj][m][1] * YP_SCALE;
                int p0 = __builtin_amdgcn_cvt_pk_fp8_f32(v0[0], v0[1], 0, false); p0 = __builtin_amdgcn_cvt_pk_fp8_f32(v0[2], v0[3], p0, true);
                int p1 = __builtin_amdgcn_cvt_pk_fp8_f32(v1[0], v1[1], 0, false); p1 = __builtin_amdgcn_cvt_pk_fp8_f32(v1[2], v1[3], p1, true);
                p[2 * bj] = p0; p[2 * bj + 1] = p1; }
            v4u w; w.x = (unsigned)p[0]; w.y = (unsigned)p[1]; w.z = (unsigned)p[2]; w.w = (unsigned)p[3];
            *(v4u*)(YP + (size_t)(u.pm * 256 + rl) * D + cb) = w;
        EPI_ROWS_END
    }
};
struct Frame {
    LAS unsigned char* lds;
    volatile LAS unsigned* MISC;
    unsigned* ctl;
    int tid, lane, wave, vcu, G;
    unsigned char* ws;
};
struct Args { const float* in[34]; float* out; unsigned char* ws; int ph_lo, ph_hi; };
enum { I_X = 0, I_C, I_CTX, I_CCTX, I_N1G, I_N2G, I_ADAW, I_ADAB, I_WIN, I_MU, I_POOLW, I_POOLS, I_WPO, I_DW0, I_DW2, I_IA0, I_IA2, I_G2, I_KK, I_KA, I_RK, I_LNW, I_LNB,
       I_WRO, I_WO, I_RW, I_RB, I_EG, I_EU, I_ED, I_SG, I_SU, I_SD, I_FG };

struct TrJob { const float* src; bf16* dst; int ldw, kvalid, ldt, k0, n0, drow0; float f8; };
template <bool NT = false> __device__ __forceinline__ void tr_load(const TrJob& j, f32x4 (&v)[16], int lane) {
    const int r2 = lane >> 4, c4 = lane & 15;
#pragma unroll
    for (int i = 0; i < 8; ++i) {
#pragma unroll
        for (int h = 0; h < 2; ++h) { const int k = j.k0 + 8 * i + 2 * r2 + h; const int kc = k < j.kvalid ? k : 0;
            const f32x4* sp_ = (const f32x4*)(j.src + (size_t)kc * j.ldw + j.n0 + 4 * c4); const f32x4 x = NT ? __builtin_nontemporal_load(sp_) : *sp_; v[2 * i + h] = (k < j.kvalid) ? x : (f32x4){0.f, 0.f, 0.f, 0.f}; } }
}
template <bool NT = false> __device__ __forceinline__ void tr_store(const TrJob& j, const f32x4 (&v)[16], LAS unsigned* P, int lane) {
    const int r2 = lane >> 4, c4 = lane & 15;
#pragma unroll
    for (int i = 0; i < 8; ++i) { LAS unsigned* p = P + (4 * i + r2) * 65 + 4 * c4;
        p[0] = pk2(v[2 * i].x, v[2 * i + 1].x); p[1] = pk2(v[2 * i].y, v[2 * i + 1].y); p[2] = pk2(v[2 * i].z, v[2 * i + 1].z); p[3] = pk2(v[2 * i].w, v[2 * i + 1].w); }
    LDS_WAIT(); asm volatile("" ::: "memory");
    const int nl = lane >> 3, q = lane & 7;
#pragma unroll
    for (int jj = 0; jj < 8; ++jj) { const int n = 8 * jj + nl; const LAS unsigned* s = P + (4 * q) * 65 + n;
        v4u o; o.x = s[0]; o.y = s[65]; o.z = s[130]; o.w = s[195];
        v4u* dp_ = (v4u*)(j.dst + (size_t)(j.drow0 + n) * j.ldt + j.k0 + 8 * q); if (NT) __builtin_nontemporal_store(o, dp_); else *dp_ = o; }
    LDS_WAIT(); asm volatile("" ::: "memory");
}
template <bool NT = false> __device__ __forceinline__ void tr8_load(const TrJob& j, int half, f32x4 (&v)[16], int lane) {
    const int r2 = lane >> 4, c4 = lane & 15;
#pragma unroll
    for (int i = 0; i < 4; ++i) {
#pragma unroll
        for (int h = 0; h < 4; ++h) { const int k = j.k0 + 64 * half + 16 * i + 4 * r2 + h; const f32x4* sp_ = (const f32x4*)(j.src + (size_t)k * j.ldw + j.n0 + 4 * c4); v[4 * i + h] = NT ? __builtin_nontemporal_load(sp_) : *sp_; } }
}
__device__ __forceinline__ void tr8_lds(const TrJob& j, int half, const f32x4 (&v)[16], LAS unsigned* P, int lane) {
    const int r2 = lane >> 4, c4 = lane & 15; const float sc = j.f8;
#pragma unroll
    for (int i = 0; i < 4; ++i) { LAS unsigned* p = P + (16 * half + 4 * i + r2) * 65 + 4 * c4;
        p[0] = pk8(sc * v[4 * i].x, sc * v[4 * i + 1].x, sc * v[4 * i + 2].x, sc * v[4 * i + 3].x); p[1] = pk8(sc * v[4 * i].y, sc * v[4 * i + 1].y, sc * v[4 * i + 2].y, sc * v[4 * i + 3].y);
        p[2] = pk8(sc * v[4 * i].z, sc * v[4 * i + 1].z, sc * v[4 * i + 2].z, sc * v[4 * i + 3].z); p[3] = pk8(sc * v[4 * i].w, sc * v[4 * i + 1].w, sc * v[4 * i + 2].w, sc * v[4 * i + 3].w); }
}
template <bool NT = false> __device__ __forceinline__ void tr8_flush(const TrJob& j, LAS unsigned* P, int lane) {
    LDS_WAIT(); asm volatile("" ::: "memory");
    const int nl = lane >> 3, q = lane & 7;
#pragma unroll
    for (int jj = 0; jj < 8; ++jj) { const int n = 8 * jj + nl; const LAS unsigned* s = P + (4 * q) * 65 + n;
        v4u o; o.x = s[0]; o.y = s[65]; o.z = s[130]; o.w = s[195];
        v4u* dp_ = (v4u*)((unsigned char*)j.dst + (size_t)(j.drow0 + n) * j.ldt + j.k0 + 16 * q); if (NT) __builtin_nontemporal_store(o, dp_); else *dp_ = o; }
    LDS_WAIT(); asm volatile("" ::: "memory");
}
template <class Dec> __device__ __forceinline__ void tr_run8(const Dec& dec, int first, int stride, LAS unsigned* P, int lane) {
    TrJob j, jn; f32x4 va[16], vb[16];
    int it = first; bool h = dec(it, j); if (h) { tr8_load<true>(j, 0, va, lane); tr8_load<true>(j, 1, vb, lane); }
    while (h) {
        tr8_lds(j, 0, va, P, lane); tr8_lds(j, 1, vb, P, lane);
        it += stride; const bool hn = dec(it, jn); if (hn) { tr8_load<true>(jn, 0, va, lane); tr8_load<true>(jn, 1, vb, lane); }
        tr8_flush(j, P, lane);
        j = jn; h = hn;
    }
}
template <class Dec> __device__ __forceinline__ void tr_run(const Dec& dec, int first, int stride, LAS unsigned* P, int lane) {
    TrJob ja, jb; f32x4 va[16], vb[16];
    int it = first; bool ha = dec(it, ja); if (ha) tr_load<true>(ja, va, lane);
    while (ha) {
        it += stride; const bool hb = dec(it, jb); if (hb) tr_load<true>(jb, vb, lane);
        tr_store(ja, va, P, lane);
        if (!hb) break;
        it += stride; ha = dec(it, ja); if (ha) tr_load<true>(ja, va, lane);
        tr_store(jb, vb, P, lane);
    }
}
__device__ __forceinline__ void p0_prologue(Frame& F, const Args& a) {
    {
        LAS float* sv = (LAS float*)F.lds;
        LAS float* part = (LAS float*)(F.lds + 40960);
        bool did = false;
        for (int cb = blockIdx.x; cb < 192; cb += F.G) {
            if (!did) { for (int idx = F.tid; idx < 5 * D; idx += 512) { const int j = idx >> 11, k = idx & 2047; const float v = (j < 4) ? a.in[I_C][j * D + k] : a.in[I_CCTX][k]; sv[idx] = v / (1.0f + __expf(-v)); } did = true; }
            __syncthreads();
            const int col = 64 * cb + F.lane, k0 = 256 * F.wave; const float* wp = a.in[I_ADAW] + (size_t)k0 * 12288 + col;
            float acc[5] = {0.f, 0.f, 0.f, 0.f, 0.f};
#pragma unroll 64
            for (int k = 0; k < 256; ++k) { const float w = __builtin_nontemporal_load(wp + (size_t)k * 12288);
#pragma unroll
                for (int j = 0; j < 5; ++j) acc[j] += sv[j * D + k0 + k] * w; }
#pragma unroll
            for (int j = 0; j < 5; ++j) part[(F.wave * 5 + j) * 64 + F.lane] = acc[j];
            __syncthreads();
            if (F.tid < 320) { const int j = F.tid >> 6, l = F.tid & 63; float s = a.in[I_ADAB][64 * cb + l];
#pragma unroll
                for (int w = 0; w < 8; ++w) s += part[(w * 5 + j) * 64 + l];
                ((float*)(F.ws + WS_MOD))[j * 12288 + 64 * cb + l] = s; }
            __syncthreads();
        }
        __syncthreads();
    }
    {
        struct DecSmall { const float* const* in; unsigned char* ws;
            __device__ __forceinline__ bool operator()(int it, TrJob& j) const {
                constexpr int I_1 = P2_FP8 ? 0 : 32 * 186, I_2 = 4 * 16, I_3 = POOL_FP8 ? 0 : 16 * 32, I_4 = 4 * 32, I_5 = MIX_FP8 ? 0 : 32 * 32, I_6 = MIX_FP8 ? 0 : 32 * 32, I_7 = 4 * 2 * 32;
                int r = it; if (r < 0) return false;
                if (r < I_1) { const int kb = r / 186, nb = r % 186, n0 = nb * 64; j = TrJob{in[I_WIN], (bf16*)(ws + WS_WIN), DIN, D, D, kb * 64, n0, n0 + (n0 >= 7808 ? 128 : 0)}; return true; } r -= I_1;
                if (r < I_2) { const int g = r / 16, q = r % 16; j = TrJob{in[I_POOLW] + (size_t)g * 65536, (bf16*)(ws + WS_POOLW) + (size_t)g * 65536, 256, 256, 256, (q / 4) * 64, (q % 4) * 64, (q % 4) * 64}; return true; } r -= I_2;
                if (r < I_3) { j = TrJob{in[I_WPO], (bf16*)(ws + WS_WPO), D, 1024, 1024, (r / 32) * 64, (r % 32) * 64, (r % 32) * 64}; return true; } r -= I_3;
                if (r < I_4) { j = TrJob{in[I_G2], (bf16*)(ws + WS_G2), D, 256, 256, (r / 32) * 64, (r % 32) * 64, (r % 32) * 64}; return true; } r -= I_4;
                if (r < I_5) { j = TrJob{in[I_WRO], (bf16*)(ws + WS_WRO), D, D, D, (r / 32) * 64, (r % 32) * 64, (r % 32) * 64}; return true; } r -= I_5;
                if (r < I_6) { j = TrJob{in[I_WO], (bf16*)(ws + WS_WO), D, D, D, (r / 32) * 64, (r % 32) * 64, (r % 32) * 64}; return true; } r -= I_6;
                if (r < I_7) { const int mtx = r / 64, q = r % 64;
                    const float* src = (mtx < 2 ? in[I_DW2] + (size_t)mtx * 96 * D : in[I_IA2] + (size_t)(mtx - 2) * 96 * D);
                    j = TrJob{src, (bf16*)(ws + WS_LORA) + (size_t)mtx * D * 128, D, 96, 128, (q / 32) * 64, (q % 32) * 64, (q % 32) * 64}; return true; }
                return false; } };
        DecSmall dec{a.in, F.ws};
        tr_run(dec, F.vcu * 8 + F.wave, F.G * 8, (LAS unsigned*)(F.lds + F.wave * 16384), F.lane);
        if (P2_FP8) {
            struct DecWin8 { const float* const* in; unsigned char* ws;
                __device__ __forceinline__ bool operator()(int it, TrJob& j) const {
                    if (it < 0) return false;
                    if (it < 16 * 186) { const int kb = it / 186, nb = it % 186, n0 = nb * 64; j = TrJob{in[I_WIN], (bf16*)(ws + WS_WIN), DIN, D, P2PITCH, kb * 128, n0, n0 + (n0 >= 7808 ? 128 : 0), 8.0f}; return true; }
                    int r = it - 16 * 186;
                    if (MIX_FP8 && r < 1024) { const int which = r >> 9, q = r & 511; j = TrJob{in[which ? I_WO : I_WRO], (bf16*)(ws + (which ? WS_WO : WS_WRO)), D, D, D, (q >> 5) * 128, (q & 31) * 64, (q & 31) * 64, 8.0f}; return true; }
                    r -= MIX_FP8 ? 1024 : 0;
                    if (POOL_FP8 && r >= 0 && r < 256) { j = TrJob{in[I_WPO], (bf16*)(ws + WS_WPO), D, 1024, 1024, (r >> 5) * 128, (r & 31) * 64, (r & 31) * 64, 8.0f}; return true; }
                    return false; } };
            DecWin8 dw{a.in, F.ws};
            tr_run8(dw, F.vcu * 8 + F.wave, F.G * 8, (LAS unsigned*)(F.lds + F.wave * 16384), F.lane);
        }
    }
    const int gt = F.vcu * 512 + F.tid, NGT = F.G * 512;
    { v4u* z = (v4u*)(F.ws + WS_WIN + (size_t)7808 * (P2_FP8 ? P2PITCH : D * 2)); for (int i = gt; i < 128 * (P2_FP8 ? P2PITCH : D * 2) / 16; i += NGT) z[i] = (v4u){0u, 0u, 0u, 0u}; }
    if (!NOP12) { int* tok = (int*)(F.ws + WS_TOK); for (int i = gt; i < NSLOT; i += NGT) tok[i] = 0; }
}

__device__ __forceinline__ void p1_norm1(Frame& F, const Args& a) {
    const int gw = F.vcu * 8 + F.wave, NGW = F.G * 8; const float* MOD = (const float*)(F.ws + WS_MOD); bf16* HA = (bf16*)(F.ws + WS_HA);
    for (int mrow = gw; mrow < MT; mrow += NGW) {
        const float* src = (mrow < NT) ? a.in[I_X] + (size_t)mrow * D : a.in[I_CTX] + (size_t)(mrow - NT) * D; const int j = (mrow < NT) ? (mrow >> 12) : 4;
        const f32x4* xr = (const f32x4*)src + F.lane; f32x4 v[8]; float s = 0.f;
#pragma unroll
        for (int q = 0; q < 8; ++q) { v[q] = __builtin_nontemporal_load(xr + 64 * q); s += (v[q].x * v[q].x + v[q].y * v[q].y) + (v[q].z * v[q].z + v[q].w * v[q].w); }
        const float rstd = 1.0f / sqrtf(wave_sum(s) * (1.0f / D) + 1e-6f);
        const f32x4* g = (const f32x4*)a.in[I_N1G] + F.lane; const f32x4* sh = (const f32x4*)(MOD + (size_t)j * 12288) + F.lane; const f32x4* sc = (const f32x4*)(MOD + (size_t)j * 12288 + 2048) + F.lane;
        v2u* o = (v2u*)(HA + (size_t)mrow * D) + F.lane; unsigned* o8 = (unsigned*)((unsigned char*)HA + (size_t)mrow * P2PITCH) + F.lane;
#pragma unroll
        for (int q = 0; q < 8; ++q) { const f32x4 y = v[q] * rstd * g[64 * q] * (sc[64 * q] + 1.0f) + sh[64 * q];
            if (P2_FP8) o8[64 * q] = pk8(8.0f * y.x, 8.0f * y.y, 8.0f * y.z, 8.0f * y.w); else { v2u w; w.x = pk2(y.x, y.y); w.y = pk2(y.z, y.w); o[64 * q] = w; } }
    }
}

template <int W> __device__ __forceinline__ void pool_item(const unsigned* U32, unsigned* DP32, int m0, int cp) {
    unsigned raw[64];
#pragma unroll
    for (int x = 0; x < 64; ++x) raw[x] = __builtin_nontemporal_load(U32 + (size_t)(m0 + x) * 512 + cp);
    float lo[64], hi[64];
#pragma unroll
    for (int x = 0; x < 64; ++x) { lo[x] = bflo(raw[x]); hi[x] = bfhi(raw[x]); }
#pragma unroll
    for (int x = 0; x < 64; ++x) { const int l = (x - W / 2) < 0 ? 0 : (x - W / 2), h = (x + W / 2) > 64 ? 64 : (x + W / 2); float s0 = 0.f, s1 = 0.f;
#pragma unroll
        for (int j = l; j < h; ++j) { s0 += lo[j]; s1 += hi[j]; }
        const float inv = 1.0f / (float)(h - l); DP32[(size_t)(m0 + x) * 512 + cp] = pk2(s0 * inv - lo[x], s1 * inv - hi[x]); }
}
__device__ __forceinline__ void p3_mix_store(const v4u o, const v4u nb, const f32x4 m0, const f32x4 m1, int c0, int mrow, bf16* RM, bf16* KM, bf16* VM, bf16* LIN) {
    float r[8];
    { const float ov[8] = {bflo(o.x), bfhi(o.x), bflo(o.y), bfhi(o.y), bflo(o.z), bfhi(o.z), bflo(o.w), bfhi(o.w)};
      const float nv[8] = {bflo(nb.x), bfhi(nb.x), bflo(nb.y), bfhi(nb.y), bflo(nb.z), bfhi(nb.z), bflo(nb.w), bfhi(nb.w)};
      const float mv[8] = {m0.x, m0.y, m0.z, m0.w, m1.x, m1.y, m1.z, m1.w};
#pragma unroll
      for (int e = 0; e < 8; ++e) r[e] = ov[e] + (nv[e] - ov[e]) * mv[e]; }
    bf16* dstp;
    if (c0 < 2048) dstp = RM + (size_t)mrow * D + c0;
    else if (c0 < 4096) dstp = KM + (size_t)mrow * D + (c0 - 2048);
    else if (c0 < 6144) dstp = VM + (size_t)mrow * D + (c0 - 4096);
    else { const int lc = c0 - 6144; int dc;
        if (lc < 192) {
#pragma unroll
            for (int e = 0; e < 8; ++e) r[e] = tanhf_(r[e]);
            dc = (lc < 96) ? lc : 128 + (lc - 96); }
        else if (lc < 384) dc = (lc < 288) ? 256 + (lc - 192) : 384 + (lc - 288);
        else {
#pragma unroll
            for (int e = 0; e < 8; ++e) r[e] = sigmoidf_(r[e]);
            dc = 512 + (lc - 384); }
        dstp = LIN + (size_t)mrow * LINLD + dc; }
    v4u w; w.x = pk2(r[0], r[1]); w.y = pk2(r[2], r[3]); w.z = pk2(r[4], r[5]); w.w = pk2(r[6], r[7]); *(v4u*)dstp = w;
}
constexpr int P3_SLICE = 512, P3_NSLICE = (DSH + P3_SLICE - 1) / P3_SLICE  , P3_SLOTS = 96;
__device__ __forceinline__ void p3_prep(Frame& F, const Args& a) {
    const bf16* SLAB = (const bf16*)(F.ws + WS_SLAB); const float* mu = a.in[I_MU];
    bf16* RM = (bf16*)(F.ws + WS_RM); bf16* KM = (bf16*)(F.ws + WS_KM); bf16* VM = (bf16*)(F.ws + WS_VM); bf16* LIN = (bf16*)(F.ws + WS_LIN);
    LAS unsigned char* T = F.lds;
    const int w = F.wave, lane = F.lane;
    for (int pid = F.vcu; pid < NB * 64; pid += F.G) {
        const int b = pid >> 6, py = (pid >> 3) & 7, px = pid & 7; const int m00 = b * TSEQ + (py * 8) * 64 + px * 8;
        int srow[12];
#pragma unroll
        for (int i = 0; i < 12; ++i) { const int sl = w * 12 + i; int gyl, gxl; bool ok = true;
            if (sl < 64) { gyl = sl >> 3; gxl = sl & 7; } else if (sl < 72) { gyl = -1; gxl = sl - 64; ok = py > 0; } else if (sl < 80) { gyl = 8; gxl = sl - 72; ok = py < 7; }
            else if (sl < 88) { gyl = sl - 80; gxl = -1; ok = px > 0; } else { gyl = sl - 88; gxl = 8; ok = px < 7; }
            srow[i] = ok ? m00 + gyl * 64 + gxl : m00; }
        v4u pre[12];
        { const int cl = lane * 8;
#pragma unroll
          for (int i = 0; i < 12; ++i) pre[i] = *(const v4u*)(SLAB + (size_t)srow[i] * SLABLD + cl); }
        for (int sl_ = 0; sl_ < P3_NSLICE; ++sl_) {
            const int c0 = sl_ * P3_SLICE + lane * 8; const bool cok = c0 < DSH;
            __syncthreads();
#pragma unroll
            for (int i = 0; i < 12; ++i) *(LAS v4u*)(T + (w * 12 + i) * 1024 + lane * 16) = pre[i];
            if (sl_ + 1 < P3_NSLICE) { const int cn = (sl_ + 1) * P3_SLICE + lane * 8; const int cl = cn < DSH ? cn : 0;
#pragma unroll
                for (int i = 0; i < 12; ++i) pre[i] = *(const v4u*)(SLAB + (size_t)srow[i] * SLABLD + cl); }
            __syncthreads();
            const f32x4 m0 = *(const f32x4*)(mu + (cok ? c0 : 0)), m1 = *(const f32x4*)(mu + (cok ? c0 : 0) + 4);
            const int gy = py * 8 + w; const unsigned k2m = gy > 0 ? 0xffffu : 0u, k3m = gy < 63 ? 0xffff0000u : 0u;
#pragma unroll
            for (int x = 0; x < 8; ++x) {
                const int gx = px * 8 + x; const unsigned k0m = gx > 0 ? 0xffffu : 0u, k1m = gx < 63 ? 0xffff0000u : 0u;
                const int so = w * 8 + x, sL = x > 0 ? so - 1 : 80 + w, sR = x < 7 ? so + 1 : 88 + w, sU = w > 0 ? so - 8 : 64 + x, sD = w < 7 ? so + 8 : 72 + x;
                const v4u o = *(const LAS v4u*)(T + so * 1024 + lane * 16), n0 = *(const LAS v4u*)(T + sL * 1024 + lane * 16), n1 = *(const LAS v4u*)(T + sR * 1024 + lane * 16),
                          n2 = *(const LAS v4u*)(T + sU * 1024 + lane * 16), n3 = *(const LAS v4u*)(T + sD * 1024 + lane * 16);
                v4u nb; nb.x = (n0.x & k0m) | (n1.x & k1m); nb.y = (n2.y & k2m) | (n3.y & k3m); nb.z = (n0.z & k0m) | (n1.z & k1m); nb.w = (n2.w & k2m) | (n3.w & k3m);
                const int mrow = m00 + w * 64 + x;
                if (cok) p3_mix_store(o, nb, m0, m1, c0, mrow, RM, KM, VM, LIN);
                if (sl_ == P3_NSLICE - 1 && lane >= 48) { const int l16 = lane - 48, p = l16 >> 2, off = (l16 & 3) * 8; *(v4u*)(LIN + (size_t)mrow * LINLD + 128 * p + 96 + off) = (v4u){0u, 0u, 0u, 0u}; }
            }
        }
        __syncthreads();
    }
    const int gw = F.vcu * 8 + F.wave, NGW = F.G * 8;
    for (int mrow = NT + gw; mrow < MT; mrow += NGW) {
        const bf16* own = SLAB + (size_t)mrow * SLABLD; const int sidx = (mrow - NT) & 255; const bool v0 = sidx > 0, v1 = sidx < 255;
        const bf16* p0 = v0 ? own - SLABLD : own; const bf16* p1 = v1 ? own + SLABLD : own;
        const unsigned k0m = v0 ? 0xffffu : 0u, k1m = v1 ? 0xffff0000u : 0u;
        for (int ci0 = F.lane; ci0 < DSH / 8; ci0 += 256) {
            v4u o[4], nb[4]; f32x4 m0[4], m1[4];
#pragma unroll
            for (int u = 0; u < 4; ++u) { const int ci = ci0 + 64 * u; const int c0 = (ci < DSH / 8 ? ci : F.lane) * 8;
                o[u] = *(const v4u*)(own + c0); const v4u n0 = *(const v4u*)(p0 + c0), n1 = *(const v4u*)(p1 + c0);
                nb[u].x = (n0.x & k0m) | (n1.x & k1m); nb[u].y = (n0.y & k0m) | (n1.y & k1m); nb[u].z = (n0.z & k0m) | (n1.z & k1m); nb[u].w = (n0.w & k0m) | (n1.w & k1m);
                m0[u] = *(const f32x4*)(mu + c0); m1[u] = *(const f32x4*)(mu + c0 + 4); }
#pragma unroll
            for (int u = 0; u < 4; ++u) { const int ci = ci0 + 64 * u; if (ci < DSH / 8) p3_mix_store(o[u], nb[u], m0[u], m1[u], ci * 8, mrow, RM, KM, VM, LIN); }
        }
        if (F.lane < 16) { const int p = F.lane >> 2, off = (F.lane & 3) * 8; *(v4u*)(LIN + (size_t)mrow * LINLD + 128 * p + 96 + off) = (v4u){0u, 0u, 0u, 0u}; }
    }
    const unsigned* U32 = (const unsigned*)(F.ws + WS_U); unsigned* DP32 = (unsigned*)(F.ws + WS_DP);
    for (int gr = F.vcu; gr < 256; gr += F.G) {
        const int m0 = gr * 64, cp = F.tid; const int g = F.wave >> 1;
        if (g == 0) pool_item<2>(U32, DP32, m0, cp); else if (g == 1) pool_item<4>(U32, DP32, m0, cp); else if (g == 2) pool_item<8>(U32, DP32, m0, cp); else pool_item<16>(U32, DP32, m0, cp);
    }
}

constexpr int CK = 16, NSL = 8;
constexpr int SL_Z = 0, SL_AF = 2560, SL_TMT = 3584, SL_ABF = 4096, SL_TM = 4608, SL_ZTT = 5120, SL_RT = 7680, SL_CRT = 9728, SL_ART = 10240, SL_BGT = 10752, SL_KGT = 12800, SL_VT = 14848, SL_GC = 16896,
              SL_SIZE = 17152, ZTT_LD = 80, SB_OFF = 7 * SL_SIZE  , SL7_OFF = 132096  ;
static_assert(SB_OFF + 8192 <= 131072 && SL7_OFF + SL_SIZE <= 163840, "scan LDS map");
__device__ __forceinline__ int kpos(int zt, int q) { return 32 * (zt >> 1) + 8 * q + 4 * (zt & 1); }
__device__ __forceinline__ int slot_off(int n) { return n < 7 ? n * SL_SIZE : SL7_OFF; }
__device__ __forceinline__ int sw64(int row, int col) { return (row * 64 + ((((col >> 3) ^ (row & 7)) << 3) | (col & 7))) * 2; }
__device__ __forceinline__ int scan_row(int n, int b, int dir) {
    if (n < CTXL) return NT + b * CTXL + (dir ? (CTXL - 1 - n) : n);
    const int t = n - CTXL; return b * TSEQ + (dir ? (TSEQ - 1 - t) : t);
}
__device__ __forceinline__ bf16x8 frag_ld(const LAS unsigned char* p, bool ok) { v4u z = (v4u){0u, 0u, 0u, 0u}; if (ok) z = *(const LAS v4u*)p; return __builtin_bit_cast(bf16x8, z); }
__device__ __forceinline__ f32x4 mfma16(bf16x8 a, bf16x8 b, f32x4 c) { return __builtin_amdgcn_mfma_f32_16x16x32_bf16(a, b, c, 0, 0, 0); }
__device__ __forceinline__ float dpp_shr(float v, const int n, float fill) {
    const int x = __builtin_bit_cast(int, v), f = __builtin_bit_cast(int, fill); int r;
    if (n == 1) r = __builtin_amdgcn_update_dpp(f, x, 0x111, 0xF, 0xF, false); else if (n == 2) r = __builtin_amdgcn_update_dpp(f, x, 0x112, 0xF, 0xF, false);
    else if (n == 4) r = __builtin_amdgcn_update_dpp(f, x, 0x114, 0xF, 0xF, false); else r = __builtin_amdgcn_update_dpp(f, x, 0x118, 0xF, 0xF, false);
    return __builtin_bit_cast(float, r);
}
struct SeqOps { bf16x8 fV, fZc, fZk[2], fR[2], fCr, fAr4, fKG[4], fBG4[4]; f32x4 gc[4]; };
__device__ __forceinline__ bf16x8 frag4_ld(const LAS unsigned char* p) { const v2u t = *(const LAS v2u*)p; v4u z; z.x = t.x; z.y = t.y; z.z = 0u; z.w = 0u; return __builtin_bit_cast(bf16x8, z); }
__device__ __forceinline__ void seq_load(SeqOps& o, const LAS unsigned char* SL, int w, int c, int q, bool klo) {
    o.fV = frag_ld(SL + SL_VT + ((16 * w + c) * 16 + 8 * q) * 2, klo);
    o.fZc = frag_ld(SL + SL_ZTT + (c * ZTT_LD + 64 + 8 * q) * 2, klo); o.fCr = frag_ld(SL + SL_CRT + (c * 16 + 8 * q) * 2, klo); o.fAr4 = frag4_ld(SL + SL_ART + (c * 16 + 4 * q) * 2);
#pragma unroll
    for (int ks = 0; ks < 2; ++ks) { o.fZk[ks] = frag_ld(SL + SL_ZTT + (c * ZTT_LD + 32 * ks + 8 * q) * 2, true); o.fR[ks] = frag_ld(SL + SL_RT + sw64(c, 32 * ks + 8 * q), true); }
#pragma unroll
    for (int jt = 0; jt < 4; ++jt) { o.fKG[jt] = frag_ld(SL + SL_KGT + ((16 * jt + c) * 16 + 8 * q) * 2, klo); o.fBG4[jt] = frag4_ld(SL + SL_BGT + ((16 * jt + c) * 16 + 4 * q) * 2);
        o.gc[jt] = *(const LAS f32x4*)(SL + SL_GC + (16 * jt + 4 * q) * 4); }
}
__device__ __forceinline__ void seq_step(const SeqOps& o, f32x4 (&X)[4], bool emit, bf16* YO, int chunk, int b, int dir, int h, int w, int c, int q) {
    const f32x4 z4 = (f32x4){0.f, 0.f, 0.f, 0.f};
    bf16x8 fS[2];
#pragma unroll
    for (int ks = 0; ks < 2; ++ks) { v4u p; p.x = pk2(X[2 * ks][0], X[2 * ks][1]); p.y = pk2(X[2 * ks][2], X[2 * ks][3]); p.z = pk2(X[2 * ks + 1][0], X[2 * ks + 1][1]); p.w = pk2(X[2 * ks + 1][2], X[2 * ks + 1][3]);
        fS[ks] = __builtin_bit_cast(bf16x8, p); }
    f32x4 un = mfma16(o.fZc, o.fV, z4);
#pragma unroll
    for (int ks = 0; ks < 2; ++ks) un = mfma16(o.fZk[ks], fS[ks], un);
    bf16x8 fU; { v4u p; p.x = pk2(un[0], un[1]); p.y = pk2(un[2], un[3]); p.z = 0u; p.w = 0u; fU = __builtin_bit_cast(bf16x8, p); }
    if (emit) {
        f32x4 y = mfma16(o.fCr, o.fV, z4); y = mfma16(o.fAr4, fU, y);
#pragma unroll
        for (int ks = 0; ks < 2; ++ks) y = mfma16(o.fR[ks], fS[ks], y);
#pragma unroll
        for (int g = 0; g < 4; ++g) YO[(size_t)scan_row(chunk * CK + 4 * q + g, b, dir) * D + h * 64 + 16 * w + c] = (bf16)f2bf(y[g]);
    }
#pragma unroll
    for (int jt = 0; jt < 4; ++jt) { const f32x4 d = mfma16(o.fBG4[jt], fU, mfma16(o.fKG[jt], o.fV, z4));
        X[jt] = X[jt] * o.gc[jt] + d; }
}
struct ScanRaw { v4u r[2], k[2], v[2], e[2]; v2u a[2]; };
__device__ __forceinline__ void scan_fetch(ScanRaw& R, const bf16* RM, const bf16* KM, const bf16* VM, const unsigned char* AX, const unsigned short* EX, size_t rowoff) {
#pragma unroll
    for (int ks = 0; ks < 2; ++ks) { const size_t off = rowoff + 32 * ks; R.r[ks] = *(const v4u*)(RM + off); R.k[ks] = *(const v4u*)(KM + off); R.v[ks] = *(const v4u*)(VM + off); R.a[ks] = *(const v2u*)(AX + off); R.e[ks] = *(const v4u*)(EX + off); }
}
__device__ __forceinline__ void p6_scan(Frame& F, const Args& a) {
    const bf16* RM = (const bf16*)(F.ws + WS_RM); const bf16* KM = (const bf16*)(F.ws + WS_KM); const bf16* VM = (const bf16*)(F.ws + WS_VM);
    const int lane = F.lane, w = F.wave, c0_ = lane & 15, q0_ = lane >> 4;
    for (int unit = blockIdx.x; unit < NB * NH * 2; unit += F.G) {
        const int dir = unit & 1, h = (unit >> 1) & 31, b = unit >> 6;
        const unsigned short* EX = (const unsigned short*)(F.ws + WS_EA + (size_t)dir * EA_STRIDE);
        const unsigned char* AX = (const unsigned char*)(F.ws + WS_EA + (size_t)(2 + dir) * EA_STRIDE);
        bf16* YO = (bf16*)(F.ws + (dir ? WS_YB : WS_YF)); float* BON = (float*)(F.ws + WS_BON) + (size_t)dir * NT * NH;
        f32x4 X[4];
#pragma unroll
        for (int jt = 0; jt < 4; ++jt) X[jt] = (f32x4){0.f, 0.f, 0.f, 0.f};
        constexpr int NBATCH = (CTXL + TSEQ) / CK / NSL;
        { LAS float* cst = (LAS float*)(F.lds + SB_OFF);
          if (F.tid < 192) { const int which = F.tid >> 6, j = F.tid & 63; cst[F.tid] = (which == 0 ? a.in[I_KK] : which == 1 ? a.in[I_KA] : a.in[I_RK])[h * 64 + j]; } }
        ScanRaw R; scan_fetch(R, RM, KM, VM, AX, EX, (size_t)scan_row(w * CK + c0_, b, dir) * D + h * 64 + 8 * q0_);
        __syncthreads();
        for (int bt = 0; bt < NBATCH; ++bt) {
            int c = c0_, q = q0_; asm volatile("" : "+v"(c), "+v"(q));
            const bool klo = q < 2;
            {
                LAS unsigned char* SL = F.lds + slot_off(w);
                int cq8 = 8 * q; asm volatile("" : "+v"(cq8));
                const LAS float* cst = (const LAS float*)(F.lds + SB_OFF) + cq8;
                float ss = 0.f;
#pragma unroll
                for (int ks = 0; ks < 2; ++ks) {
                    const f32x4 k0 = *(const LAS f32x4*)(cst + 32 * ks), k1 = *(const LAS f32x4*)(cst + 32 * ks + 4);
                    const float kv[8] = {bflo(R.k[ks].x), bfhi(R.k[ks].x), bflo(R.k[ks].y), bfhi(R.k[ks].y), bflo(R.k[ks].z), bfhi(R.k[ks].z), bflo(R.k[ks].w), bfhi(R.k[ks].w)};
#pragma unroll
                    for (int e = 0; e < 4; ++e) { const float p0 = kv[e] * k0[e], p1 = kv[4 + e] * k1[e]; ss += p0 * p0 + p1 * p1; } }
                ss += __shfl_xor(ss, 16); ss += __shfl_xor(ss, 32);
                const float inv = __builtin_amdgcn_rsqf(ss + 1e-12f);
                bf16x8 fKT[2], fRT[2], fBT[2], fKQ[2]; float bonp = 0.f;
#pragma unroll
                for (int ks = 0; ks < 2; ++ks) {
                    const v4u xr = R.r[ks], xk = R.k[ks], xv = R.v[ks], xe = R.e[ks]; const v2u xa = R.a[ks];
                    const f32x4 k0 = *(const LAS f32x4*)(cst + 32 * ks), k1 = *(const LAS f32x4*)(cst + 32 * ks + 4), a0 = *(const LAS f32x4*)(cst + 64 + 32 * ks), a1 = *(const LAS f32x4*)(cst + 64 + 32 * ks + 4);
                    const float kkw[8] = {k0[0], k0[1], k0[2], k0[3], k1[0], k1[1], k1[2], k1[3]}, kaw[8] = {a0[0], a0[1], a0[2], a0[3], a1[0], a1[1], a1[2], a1[3]};
                    const f32x4 q0 = *(const LAS f32x4*)(cst + 128 + 32 * ks), q1 = *(const LAS f32x4*)(cst + 128 + 32 * ks + 4); const float rkw[8] = {q0[0], q0[1], q0[2], q0[3], q1[0], q1[1], q1[2], q1[3]};
                    const float r[8] = {bflo(xr.x), bfhi(xr.x), bflo(xr.y), bfhi(xr.y), bflo(xr.z), bfhi(xr.z), bflo(xr.w), bfhi(xr.w)};
                    const float k[8] = {bflo(xk.x), bfhi(xk.x), bflo(xk.y), bfhi(xk.y), bflo(xk.z), bfhi(xk.z), bflo(xk.w), bfhi(xk.w)};
                    const float v[8] = {bflo(xv.x), bfhi(xv.x), bflo(xv.y), bfhi(xv.y), bflo(xv.z), bfhi(xv.z), bflo(xv.w), bfhi(xv.w)};
                    const float ku8 = 1.0f / 255.0f;
                    const float ai[8] = {(float)(xa.x & 0xffu) * ku8, (float)((xa.x >> 8) & 0xffu) * ku8, (float)((xa.x >> 16) & 0xffu) * ku8, (float)(xa.x >> 24) * ku8,
                                         (float)(xa.y & 0xffu) * ku8, (float)((xa.y >> 8) & 0xffu) * ku8, (float)((xa.y >> 16) & 0xffu) * ku8, (float)(xa.y >> 24) * ku8};
                    const float lw[8] = {hlo(xe.x), hhi(xe.x), hlo(xe.y), hhi(xe.y), hlo(xe.z), hhi(xe.z), hlo(xe.w), hhi(xe.w)};
                    float kt[8], rt[8], btl[8], kq[8], cl[8], G[8], Gi[8], Gm[8], GCv[8];
#pragma unroll
                    for (int e = 0; e < 8; ++e) cl[e] = lw[e];
#pragma unroll
                    for (int e = 0; e < 8; ++e) cl[e] += dpp_shr(cl[e], 1, 0.f);
#pragma unroll
                    for (int e = 0; e < 8; ++e) cl[e] += dpp_shr(cl[e], 2, 0.f);
#pragma unroll
                    for (int e = 0; e < 8; ++e) cl[e] += dpp_shr(cl[e], 4, 0.f);
#pragma unroll
                    for (int e = 0; e < 8; ++e) cl[e] += dpp_shr(cl[e], 8, 0.f);
#pragma unroll
                    for (int e = 0; e < 8; ++e) { G[e] = __builtin_amdgcn_exp2f(cl[e]); Gi[e] = __builtin_amdgcn_exp2f(-cl[e]); }
#pragma unroll
                    for (int e = 0; e < 8; ++e) { Gm[e] = dpp_shr(G[e], 1, 1.0f); GCv[e] = __shfl(G[e], (lane & 48) | 15); }
#pragma unroll
                    for (int e = 0; e < 8; ++e) {
                        const float kke = k[e] * kkw[e] * inv, kd = k[e] * ((ai[e] - 1.0f) * kaw[e] + 1.0f), bb = kke * ai[e], ratio = GCv[e] * Gi[e];
                        kt[e] = Gm[e] * kke; rt[e] = G[e] * r[e]; btl[e] = bb * Gi[e]; kq[e] = kd * Gi[e];
                        bonp += r[e] * kd * rkw[e];
                        const int j = 32 * ks + 8 * q + e;
                        const unsigned w0 = pk2(kt[e], bb * ratio), w1 = pk2(kd * ratio, v[e]);
                        ((LAS bf16*)(SL + SL_Z))[j * 16 + c] = (bf16)(w0 & 0xffffu); ((LAS bf16*)(SL + SL_BGT))[j * 16 + c] = (bf16)(w0 >> 16);
                        ((LAS bf16*)(SL + SL_KGT))[j * 16 + c] = (bf16)(w1 & 0xffffu); ((LAS bf16*)(SL + SL_VT))[j * 16 + c] = (bf16)(w1 >> 16);
                    }
                    if (c == 15) { *(LAS f32x4*)(SL + SL_GC + (32 * ks + 8 * q) * 4) = (f32x4){G[0], G[1], G[2], G[3]}; *(LAS f32x4*)(SL + SL_GC + (32 * ks + 8 * q + 4) * 4) = (f32x4){G[4], G[5], G[6], G[7]}; }
                    v4u p; p.x = pk2(kt[0], kt[1]); p.y = pk2(kt[2], kt[3]); p.z = pk2(kt[4], kt[5]); p.w = pk2(kt[6], kt[7]); fKT[ks] = __builtin_bit_cast(bf16x8, p);
                    p.x = pk2(rt[0], rt[1]); p.y = pk2(rt[2], rt[3]); p.z = pk2(rt[4], rt[5]); p.w = pk2(rt[6], rt[7]); fRT[ks] = __builtin_bit_cast(bf16x8, p);
                    { v2u p0; p0.x = p.x; p0.y = p.y; v2u p1; p1.x = p.z; p1.y = p.w; const int pp = 32 * ks + 16 * (q & 1) + 4 * (q >> 1);
                      *(LAS v2u*)(SL + SL_RT + sw64(c, pp)) = p0; *(LAS v2u*)(SL + SL_RT + sw64(c, pp + 8)) = p1; }
                    p.x = pk2(btl[0], btl[1]); p.y = pk2(btl[2], btl[3]); p.z = pk2(btl[4], btl[5]); p.w = pk2(btl[6], btl[7]); fBT[ks] = __builtin_bit_cast(bf16x8, p);
                    p.x = pk2(kq[0], kq[1]); p.y = pk2(kq[2], kq[3]); p.z = pk2(kq[4], kq[5]); p.w = pk2(kq[6], kq[7]); fKQ[ks] = __builtin_bit_cast(bf16x8, p);
                    asm volatile("" ::: "memory");
                }
                bonp += __shfl_xor(bonp, 16); bonp += __shfl_xor(bonp, 32);
                if (q == 0 && (NSL * bt + w) * CK >= CTXL) BON[(size_t)scan_row((NSL * bt + w) * CK + c, b, dir) * NH + h] = bonp;
                const f32x4 z4 = (f32x4){0.f, 0.f, 0.f, 0.f};
                f32x4 accA = mfma16(fBT[1], fKT[1], mfma16(fBT[0], fKT[0], z4)), accAr = mfma16(fBT[1], fRT[1], mfma16(fBT[0], fRT[0], z4));
                f32x4 accCm = mfma16(fKQ[1], fKT[1], mfma16(fKQ[0], fKT[0], z4)), accCr = mfma16(fKQ[1], fRT[1], mfma16(fKQ[0], fRT[0], z4));
#pragma unroll
                for (int g = 0; g < 4; ++g) { const int srow = 4 * q + g; const bool lt = srow < c, le = srow <= c;
                    accA[g] = lt ? accA[g] : 0.f; accAr[g] = le ? accAr[g] : 0.f; accCm[g] = lt ? accCm[g] : 0.f; accCr[g] = le ? accCr[g] : 0.f;
                    ((LAS float*)(SL + SL_AF))[srow * 16 + c] = accA[g]; ((LAS bf16*)(SL + SL_ABF))[srow * 16 + c] = (bf16)f2bf(accA[g]); ((LAS bf16*)(SL + SL_Z))[(64 + srow) * 16 + c] = (bf16)f2bf(accCm[g]); }
                { v2u p; p.x = pk2(accAr[0], accAr[1]); p.y = pk2(accAr[2], accAr[3]); *(LAS v2u*)(SL + SL_ART + (c * 16 + 4 * q) * 2) = p; }
                { v2u p; p.x = pk2(accCr[0], accCr[1]); p.y = pk2(accCr[2], accCr[3]); *(LAS v2u*)(SL + SL_CRT + (c * 16 + 4 * q) * 2) = p; }
                LDS_WAIT(); asm volatile("" ::: "memory");
                {
                    const int base = c & 8, cl = c & 7; float x[8];
#pragma unroll
                    for (int sr = 7; sr >= 0; --sr) { float acc = 0.f;
#pragma unroll
                        for (int m = sr + 1; m < 8; ++m) acc += ((const LAS float*)(SL + SL_AF))[(base + sr) * 16 + base + m] * x[m];
                        x[sr] = (sr < cl) ? -acc : ((sr == cl) ? -1.0f : 0.f); }
                    if (q == 0) { v4u px; px.x = pk2(x[0], x[1]); px.y = pk2(x[2], x[3]); px.z = pk2(x[4], x[5]); px.w = pk2(x[6], x[7]);
                        *(LAS v4u*)(SL + SL_TMT + (c * 16 + base) * 2) = px; *(LAS v4u*)(SL + SL_TMT + (c * 16 + (base ^ 8)) * 2) = (v4u){0u, 0u, 0u, 0u};
#pragma unroll
                        for (int sr = 0; sr < 8; ++sr) { ((LAS bf16*)(SL + SL_TM))[(base + sr) * 16 + c] = (bf16)f2bf(x[sr]); ((LAS bf16*)(SL + SL_TM))[((base ^ 8) + sr) * 16 + c] = (bf16)0; } }
                    LDS_WAIT(); asm volatile("" ::: "memory");
                    const bf16x8 fAb = frag_ld(SL + SL_ABF + (c * 16 + 8 * q) * 2, klo), fTd = frag_ld(SL + SL_TMT + (c * 16 + 8 * q) * 2, klo);
                    const f32x4 d1 = mfma16(fAb, fTd, z4);
                    bf16x8 fD1; { v4u p; p.x = pk2(d1[0], d1[1]); p.y = pk2(d1[2], d1[3]); p.z = 0u; p.w = 0u; fD1 = __builtin_bit_cast(bf16x8, p); }
                    const f32x4 d2 = mfma16(fD1, frag4_ld(SL + SL_TM + (c * 16 + 4 * q) * 2), z4);
                    if (c < 8 && q >= 2) {
#pragma unroll
                        for (int g = 0; g < 4; ++g) ((LAS bf16*)(SL + SL_TMT))[(4 * q + g) * 16 + c] = (bf16)f2bf(d2[g]); }
                }
                LDS_WAIT(); asm volatile("" ::: "memory");
                {
                    const bf16x8 fT = frag_ld(SL + SL_TMT + (c * 16 + 8 * q) * 2, klo);
#pragma unroll
                    for (int zt = 0; zt < 5; ++zt) { const bf16x8 fZ = frag_ld(SL + SL_Z + ((16 * zt + c) * 16 + 8 * q) * 2, klo); const f32x4 d = mfma16(fZ, fT, z4);
                        v2u p; p.x = pk2(d[0], d[1]); p.y = pk2(d[2], d[3]); *(LAS v2u*)(SL + SL_ZTT + (c * ZTT_LD + (zt < 4 ? kpos(zt, q) : 64 + 4 * q)) * 2) = p; }
                }
            }
            if (bt + 1 < NBATCH) scan_fetch(R, RM, KM, VM, AX, EX, (size_t)scan_row((NSL * (bt + 1) + w) * CK + c, b, dir) * D + h * 64 + 8 * q);
            __syncthreads();
            asm volatile("" : "+v"(c), "+v"(q));
            if (w < 4) {
                const bool emit = (NSL * bt) * CK >= CTXL;
#pragma unroll 1
                for (int n = 0; n < NSL; ++n) { SeqOps A; seq_load(A, F.lds + slot_off(n), w, c, q, klo); seq_step(A, X, emit, YO, NSL * bt + n, b, dir, h, w, c, q); }
            }
            __syncthreads();
        }
    }
}

__device__ __forceinline__ void p7_readout(Frame& F, const Args& a) {
    const bf16* VM = (const bf16*)(F.ws + WS_VM); const float* BONF = (const float*)(F.ws + WS_BON); const float* BONB = BONF + (size_t)NT * NH;
    const bf16* YF = (const bf16*)(F.ws + WS_YF); const bf16* YB = (const bf16*)(F.ws + WS_YB); const bf16* GG = (const bf16*)(F.ws + WS_GG); unsigned char* OR8 = F.ws + WS_OR;
    const int sub = F.tid & 15; const int ngrp = F.G * 32;
    for (int gid0 = F.vcu * 32 + (F.tid >> 4); gid0 < NT * NH; gid0 += 4 * ngrp) {
        v2u ayf[4], ayb[4], alv[4], agg[4]; float abf[4], abb[4]; f32x4 alw[4], alb[4];
#pragma unroll
        for (int u = 0; u < 4; ++u) { const int gid = gid0 + u * ngrp; const int mrow = gid >> 5, h = gid & 31, c = h * 64 + 4 * sub; const size_t off = (size_t)mrow * D + c;
            ayf[u] = __builtin_nontemporal_load((const v2u*)(YF + off)); ayb[u] = __builtin_nontemporal_load((const v2u*)(YB + off)); alv[u] = __builtin_nontemporal_load((const v2u*)(VM + off)); agg[u] = __builtin_nontemporal_load((const v2u*)(GG + off));        abf[u] = BONF[gid]; abb[u] = BONB[gid]; alw[u] = *(const f32x4*)(a.in[I_LNW] + c); alb[u] = *(const f32x4*)(a.in[I_LNB] + c); }
#pragma unroll
        for (int u = 0; u < 4; ++u) { const int gid = gid0 + u * ngrp;
        const int mrow = gid >> 5, h = gid & 31, c = h * 64 + 4 * sub; const size_t off = (size_t)mrow * D + c;
        const v2u yf = ayf[u], yb = ayb[u], lv = alv[u];
        const f32x4 y = (f32x4){bflo(yf.x) + bflo(yb.x), bfhi(yf.x) + bfhi(yb.x), bflo(yf.y) + bflo(yb.y), bfhi(yf.y) + bfhi(yb.y)};
        const float mean = allred16((y.x + y.y) + (y.z + y.w)) * (1.0f / 64.0f); const f32x4 d = y - mean;
        const float var = allred16((d.x * d.x + d.y * d.y) + (d.z * d.z + d.w * d.w)) * (1.0f / 64.0f);
        const f32x4 yn = d * __builtin_amdgcn_rsqf(var + 64e-5f) * alw[u] + alb[u];
        const f32x4 v = (f32x4){bflo(lv.x), bfhi(lv.x), bflo(lv.y), bfhi(lv.y)};
        const v2u gw_ = agg[u]; const f32x4 gg = (f32x4){bflo(gw_.x), bfhi(gw_.x), bflo(gw_.y), bfhi(gw_.y)};
        const f32x4 z = (yn + v * (abf[u] + abb[u])) * gg;
        if (MIX_FP8) *(unsigned*)(OR8 + off) = pk8(8.0f * z.x, 8.0f * z.y, 8.0f * z.z, 8.0f * z.w); else { v2u wv; wv.x = pk2(z.x, z.y); wv.y = pk2(z.z, z.w); *(v2u*)((bf16*)OR8 + off) = wv; }
        }
    }
}
constexpr float GU_F8SCALE = 8.0f, H2_F8SCALE = 8.0f, DT_F8SCALE = 8.0f;
constexpr int CONV_ITEMS = 65 * 384, CONV_DT = 65 * 128, CONV_FREE = CONV_DT + (65 - GU_E2) * 256;
struct DecExp { const float* const* in; unsigned char* ws;
    __device__ __forceinline__ bool operator()(int it, TrJob& j) const {
        if (it < 0 || it >= CONV_ITEMS) return false;
        if (it < CONV_DT) { const int e = it >> 7, r = it & 127; const float* src = (e < 64) ? in[I_ED] + (size_t)e * DEXP * D : in[I_SD];
            const int kb = r >> 5, nb = r & 31; j = TrJob{src, (bf16*)(ws + WS_DT + (size_t)e * D * DEXP), D, DEXP, DEXP, kb * 128, nb * 64, nb * 64, DT_F8SCALE}; }
        else { const int g = it - CONV_DT, eg = g >> 8, q = g & 255, which = q >> 7, r = q & 127, e = eg < 65 - GU_E2 ? GU_E2 + eg : eg - (65 - GU_E2);
            const float* src = (e < 64) ? (which == 0 ? in[I_EG] : in[I_EU]) + (size_t)e * D * DEXP : (which == 0 ? in[I_SG] : in[I_SU]);
            const int kb = r >> 3, nb = r & 7, n0 = nb * 64;
            j = TrJob{src, (bf16*)(ws + gu_base(e)), DEXP, D, D, kb * 128, n0, (n0 >> 7) * 256 + which * 128 + (n0 & 127), GU_F8SCALE}; }
        return true; } };
__device__ __forceinline__ void conv_steal(Frame& F, const Args& a, const unsigned stopn) {
    DecExp dec{a.in, F.ws};
    unsigned* cnt = F.ctl + CW_CONV; unsigned* dnp = F.ctl + CW_P2DONE;
    LAS unsigned* P = (LAS unsigned*)(F.lds + F.wave * 16384);
    const int lane = F.lane;
    unsigned nxt = 0u, dnow = 0u;
    if (lane == 0) nxt = xb_add(cnt, 1u);
    nxt = __builtin_amdgcn_readfirstlane(nxt);
#pragma unroll 1
    for (;;) {
        const unsigned cur = nxt;
        if (cur >= (unsigned)CONV_FREE) break;
        unsigned n2 = (unsigned)CONV_FREE, d2 = dnow;
        if (dnow < stopn) { if (lane == 0) { n2 = xb_add(cnt, 1u); d2 = xb_ld(dnp); } }
        asm volatile("" ::: "memory");
        TrJob ja; f32x4 va[16];
        dec((int)cur, ja);
        tr8_load<true>(ja, 0, va, lane); tr8_lds(ja, 0, va, P, lane);
        tr8_load<true>(ja, 1, va, lane); tr8_lds(ja, 1, va, P, lane);
        tr8_flush<true>(ja, P, lane);
        nxt = __builtin_amdgcn_readfirstlane(n2); dnow = __builtin_amdgcn_readfirstlane(d2);
    }
}
constexpr int RT_LD = 68;
__device__ __forceinline__ void p11_route(Frame& F, const Args& a) {
    for (int repa_ = 0, nrepa_ = opaque_n(1 + ((DUPMASK >> 16) & 1)); repa_ < nrepa_; ++repa_) {
        unsigned nd = xb_ld(F.ctl + CW_CONV); nd = __builtin_amdgcn_readfirstlane(nd < (unsigned)CONV_FREE ? nd : (unsigned)CONV_FREE);
        DecExp dec{a.in, F.ws};
        tr_run8(dec, (int)nd + F.vcu * 8 + F.wave, F.G * 8, (LAS unsigned*)(F.lds + F.wave * 16384), F.lane);
        __syncthreads();
    }
    const bf16* X1 = (const bf16*)(F.ws + WS_X1); const float* MOD = (const float*)(F.ws + WS_MOD); unsigned char* H2 = F.ws + WS_H2;
    LAS float* hs = (LAS float*)F.lds;
    LAS float* wsb = hs + 64 * RT_LD;
    LAS float* lg = wsb + 64 * RT_LD;
    LAS float* lg2 = lg + 64 * 65;
    LAS float* selb = lg2 + 64 * 65;
    LAS float* rs = selb + 64 * 65;
    LAS int* cnt = (LAS int*)(rs + 64);
    LAS int* basee = cnt + 64;
    LAS int* eloc = basee + 64;
    LAS int* rloc = eloc + 512;
    for (int tile = F.vcu; tile < NT / 64; tile += F.G) {
        const int t0 = tile * 64, b = t0 >> 12;
        const float* sh2 = MOD + (size_t)b * 12288 + 6144; const float* sc2 = MOD + (size_t)b * 12288 + 8192; const float* g2 = a.in[I_N2G];
        if (F.tid < 64) cnt[F.tid] = 0;
        for (int hb = 0; hb < 2; ++hb) {
            v2u xw[4][8];
#pragma unroll
            for (int r = 0; r < 4; ++r) { const v2u* xr = (const v2u*)(X1 + (size_t)(t0 + F.wave * 8 + hb * 4 + r) * D) + F.lane;
#pragma unroll
                for (int q = 0; q < 8; ++q) xw[r][q] = xr[64 * q]; }
#pragma unroll
            for (int r = 0; r < 4; ++r) { const int tl = F.wave * 8 + hb * 4 + r; f32x4 v[8]; float s = 0.f;
#pragma unroll
                for (int q = 0; q < 8; ++q) { v[q] = (f32x4){bflo(xw[r][q].x), bfhi(xw[r][q].x), bflo(xw[r][q].y), bfhi(xw[r][q].y)}; s += (v[q].x * v[q].x + v[q].y * v[q].y) + (v[q].z * v[q].z + v[q].w * v[q].w); }
                const float rstd = 1.0f / sqrtf(wave_sum(s) * (1.0f / D) + 1e-6f); if (F.lane == 0) rs[tl] = rstd;
                unsigned* o = (unsigned*)(H2 + (size_t)(t0 + tl) * D) + F.lane;
#pragma unroll
                for (int q = 0; q < 8; ++q) { const f32x4 y = v[q] * rstd * ((const f32x4*)g2)[F.lane + 64 * q] * (((const f32x4*)sc2)[F.lane + 64 * q] + 1.0f) + ((const f32x4*)sh2)[F.lane + 64 * q];
                    o[64 * q] = pk8(H2_F8SCALE * y.x, H2_F8SCALE * y.y, H2_F8SCALE * y.z, H2_F8SCALE * y.w); } }
        }
        __syncthreads();
        const int ti = F.wave >> 1, ei0 = 2 * (F.wave & 1), lr = F.lane & 15, lk = F.lane >> 4;
        f32x4 am0 = (f32x4){0.f, 0.f, 0.f, 0.f}, am1 = am0;
        const int stok = F.tid >> 3, sk8 = (F.tid & 7) * 8; const float rstd_s = rs[stok];
        f32x4 px0, px1, pw0, pw1;
        { const v4u xw = *(const v4u*)(X1 + (size_t)(t0 + stok) * D + sk8); px0 = (f32x4){bflo(xw.x), bfhi(xw.x), bflo(xw.y), bfhi(xw.y)}; px1 = (f32x4){bflo(xw.z), bfhi(xw.z), bflo(xw.w), bfhi(xw.w)}; const float* wp = a.in[I_RW] + F.tid * 8; pw0 = *(const f32x4*)wp; pw1 = *(const f32x4*)(wp + 4); }
        for (int kc = 0; kc < D / 64; ++kc) {
            { const int k0 = kc * 64 + sk8;
              const f32x4 ga = *(const f32x4*)(g2 + k0), gb = *(const f32x4*)(g2 + k0 + 4), ca = *(const f32x4*)(sc2 + k0), cb = *(const f32x4*)(sc2 + k0 + 4), ha = *(const f32x4*)(sh2 + k0), hb = *(const f32x4*)(sh2 + k0 + 4);
              const f32x4 y0 = px0 * rstd_s * ga * (ca + 1.0f) + ha, y1 = px1 * rstd_s * gb * (cb + 1.0f) + hb;
              hs[(sk8 + 0) * RT_LD + stok] = y0.x; hs[(sk8 + 1) * RT_LD + stok] = y0.y; hs[(sk8 + 2) * RT_LD + stok] = y0.z; hs[(sk8 + 3) * RT_LD + stok] = y0.w;
              hs[(sk8 + 4) * RT_LD + stok] = y1.x; hs[(sk8 + 5) * RT_LD + stok] = y1.y; hs[(sk8 + 6) * RT_LD + stok] = y1.z; hs[(sk8 + 7) * RT_LD + stok] = y1.w;
              const int wk = F.tid >> 3, we = (F.tid & 7) * 8; *(LAS f32x4*)(wsb + wk * RT_LD + we) = pw0; *(LAS f32x4*)(wsb + wk * RT_LD + we + 4) = pw1; }
            __syncthreads();
            if (kc + 1 < D / 64) { const v4u xw = *(const v4u*)(X1 + (size_t)(t0 + stok) * D + (kc + 1) * 64 + sk8); px0 = (f32x4){bflo(xw.x), bfhi(xw.x), bflo(xw.y), bfhi(xw.y)}; px1 = (f32x4){bflo(xw.z), bfhi(xw.z), bflo(xw.w), bfhi(xw.w)};
                const float* wp = a.in[I_RW] + (size_t)(kc + 1) * 4096 + F.tid * 8; pw0 = *(const f32x4*)wp; pw1 = *(const f32x4*)(wp + 4); }
#pragma unroll
            for (int ks = 0; ks < 16; ++ks) { const int k = 4 * ks + lk; const float av = hs[k * RT_LD + 16 * ti + lr], b0 = wsb[k * RT_LD + 16 * ei0 + lr], b1 = wsb[k * RT_LD + 16 * ei0 + 16 + lr];
                am0 = __builtin_amdgcn_mfma_f32_16x16x4f32(av, b0, am0, 0, 0, 0); am1 = __builtin_amdgcn_mfma_f32_16x16x4f32(av, b1, am1, 0, 0, 0); }
            __syncthreads();
        }
#pragma unroll
        for (int g = 0; g < 4; ++g) { lg[(16 * ti + 4 * lk + g) * 65 + 16 * ei0 + lr] = am0[g]; lg[(16 * ti + 4 * lk + g) * 65 + 16 * ei0 + 16 + lr] = am1[g]; }
        __syncthreads();
        for (int idx = F.tid; idx < 4096; idx += 512) { const int tl = idx >> 6, e = idx & 63; const float sc = sigmoidf_(lg[tl * 65 + e]); lg[tl * 65 + e] = sc; selb[tl * 65 + e] = sc + a.in[I_RB][e]; }
        __syncthreads();
        if (F.tid < 64) {
            const int tl = F.tid; LAS float* sel = selb + tl * 65; const LAS float* scr = lg + tl * 65;
            float gs[8];
#pragma unroll
            for (int g = 0; g < 8; ++g) { float m1 = -INFINITY, m2 = -INFINITY;
#pragma unroll
                for (int j = 0; j < 8; ++j) { const float v = sel[g * 8 + j]; if (v > m1) { m2 = m1; m1 = v; } else if (v > m2) m2 = v; }
                gs[g] = m1 + m2; }
            unsigned gmask = 0u;
#pragma unroll
            for (int it = 0; it < 4; ++it) { float best = -INFINITY; int bi = 0;
#pragma unroll
                for (int g = 0; g < 8; ++g) { const bool ok = !((gmask >> g) & 1u) && gs[g] > best; best = ok ? gs[g] : best; bi = ok ? g : bi; }
                gmask |= 1u << bi; }
            for (int g = 0; g < 8; ++g) if (!((gmask >> g) & 1u)) { for (int j = 0; j < 8; ++j) sel[g * 8 + j] = -INFINITY; }
            float wv[8]; int ev[8]; float wsum = 0.f;
#pragma unroll
            for (int it = 0; it < 8; ++it) { float best = -INFINITY; int bi = 0;
                for (int e = 0; e < 64; ++e) { const float v = sel[e]; if (v > best) { best = v; bi = e; } }
                sel[bi] = -INFINITY; ev[it] = bi; wv[it] = scr[bi]; wsum += wv[it]; }
            const float inv = 2.5f / wsum;
#pragma unroll
            for (int it = 0; it < 8; ++it) { const int lr = atomicAdd((int*)&cnt[ev[it]], 1); eloc[tl * 8 + it] = ev[it]; rloc[tl * 8 + it] = lr;
                ((float*)(F.ws + WS_WSEL))[(size_t)(t0 + tl) * 8 + it] = wv[it] * inv; }
        }
        __syncthreads();
        if (F.tid < 64) basee[F.tid] = (int)__hip_atomic_fetch_add(F.ctl + CW_GCNT + F.tid, (unsigned)cnt[F.tid], __ATOMIC_RELAXED, __HIP_MEMORY_SCOPE_AGENT);
        __syncthreads();
        { const int e = eloc[F.tid], rk = basee[e] + rloc[F.tid]; ((int*)(F.ws + WS_EIDX))[(size_t)t0 * 8 + F.tid] = e; ((int*)(F.ws + WS_RANK))[(size_t)t0 * 8 + F.tid] = rk;
          if (NOP12) ((int*)(F.ws + WS_TOKE))[(size_t)e * NT + rk] = t0 + (F.tid >> 3); }
        __syncthreads();
    }
}
__device__ __forceinline__ int moe_tables(Frame& F) {
    LAS int* te = (LAS int*)(F.lds + TAB_OFF); LAS int* off = te + MAXTILES;
    if (F.wave == 0) {
        const int e = F.lane; const int cn = (int)__hip_atomic_load(F.ctl + CW_GCNT + e, __ATOMIC_RELAXED, __HIP_MEMORY_SCOPE_AGENT); const int pd = (cn + 255) & ~255;
        int incl = pd;
#pragma unroll
        for (int o = 1; o < 64; o <<= 1) { const int v = __shfl_up(incl, o); incl += (e >= o) ? v : 0; }
        const int excl = incl - pd, tot = __shfl(incl, 63);
        off[e] = excl; off[66 + e] = cn;
        if (e == 0) { off[64] = tot; off[65] = tot / 256 + NT / 256; }
        for (int rt = excl >> 8; rt < (incl >> 8); ++rt) te[rt] = e;
        for (int rt = (tot >> 8) + e; rt < (tot >> 8) + NT / 256; rt += 64) te[rt] = 64;
    }
    __syncthreads();
    const int ntiles = off[65];
    return ntiles;
}
__device__ __forceinline__ void p12_slots(Frame& F) {
    (void)moe_tables(F);
    const LAS int* off = (const LAS int*)(F.lds + TAB_OFF) + MAXTILES;
    int* tok = (int*)(F.ws + WS_TOK);
    const int* eidx = (const int*)(F.ws + WS_EIDX); int* rank = (int*)(F.ws + WS_RANK);
    const int gt = F.vcu * 512 + F.tid, NGT = F.G * 512;
    for (int i = gt; i < NT * 8; i += NGT) { const int slot = off[eidx[i]] + rank[i]; tok[slot] = i >> 3; rank[i] = slot; }
    const int o64 = off[64];
    for (int t = gt; t < NT; t += NGT) tok[o64 + t] = t;
    if (gt == 0) F.ctl[CW_O64] = (unsigned)o64;
}
__device__ __forceinline__ void p15_final(Frame& F, const Args& a) {
    const int gw = F.vcu * 8 + F.wave, NGW = F.G * 8; const float* MOD = (const float*)(F.ws + WS_MOD); const unsigned char* YP = (const unsigned char*)(F.ws + WS_YP);
    const int* SLOTMAP = (const int*)(F.ws + WS_RANK); const int* EIDXP = (const int*)(F.ws + WS_EIDX); const float* WSEL = (const float*)(F.ws + WS_WSEL);
    int o64; const LAS int* offp = (const LAS int*)(F.lds + TAB_OFF) + MAXTILES;
    if (NOP12) { (void)moe_tables(F); o64 = offp[64]; } else o64 = (int)F.ctl[CW_O64];
    for (int t = gw; t < NT; t += NGW) {
        const int b = t >> 12; const float* gt2 = MOD + (size_t)b * 12288 + 10240; const float* fg = a.in[I_FG]; float* xr = a.out + (size_t)t * D; const bf16* x1r = (const bf16*)(F.ws + WS_X1) + (size_t)t * D;
        v4u s0 = *(const v4u*)(SLOTMAP + (size_t)t * 8), s1 = *(const v4u*)(SLOTMAP + (size_t)t * 8 + 4); const f32x4 w0 = *(const f32x4*)(WSEL + (size_t)t * 8), w1 = *(const f32x4*)(WSEL + (size_t)t * 8 + 4);
        if (NOP12) { const v4u e0 = *(const v4u*)(EIDXP + (size_t)t * 8), e1 = *(const v4u*)(EIDXP + (size_t)t * 8 + 4);
            s0.x += (unsigned)offp[e0.x]; s0.y += (unsigned)offp[e0.y]; s0.z += (unsigned)offp[e0.z]; s0.w += (unsigned)offp[e0.w]; s1.x += (unsigned)offp[e1.x]; s1.y += (unsigned)offp[e1.y]; s1.z += (unsigned)offp[e1.z]; s1.w += (unsigned)offp[e1.w]; }
        const unsigned sl[9] = {s0.x, s0.y, s0.z, s0.w, s1.x, s1.y, s1.z, s1.w, (unsigned)(o64 + t)}; const float wt[9] = {w0.x, w0.y, w0.z, w0.w, w1.x, w1.y, w1.z, w1.w, 1.0f};
        LAS float* Tw = (LAS float*)(F.lds + F.wave * 8192);
#pragma unroll
        for (int jj = 0; jj < 2; ++jj) { const int col = 16 * F.lane + 1024 * jj; float m[16];
#pragma unroll
            for (int e = 0; e < 16; ++e) m[e] = 0.f;
#pragma unroll
            for (int j = 0; j < 9; ++j) { const v4u y = __builtin_nontemporal_load((const v4u*)(YP + (size_t)sl[j] * D + col));        const unsigned yw[4] = {y.x, y.y, y.z, y.w}; const float wj = wt[j];
#pragma unroll
                for (int e = 0; e < 4; ++e) { const f32x2 lo = __builtin_amdgcn_cvt_pk_f32_fp8((int)yw[e], false), hi = __builtin_amdgcn_cvt_pk_f32_fp8((int)yw[e], true);
                    m[4 * e] += wj * lo.x; m[4 * e + 1] += wj * lo.y; m[4 * e + 2] += wj * hi.x; m[4 * e + 3] += wj * hi.y; } }
#pragma unroll
            for (int e4 = 0; e4 < 4; ++e4) *(LAS f32x4*)(Tw + col + 4 * e4) = (f32x4){m[4 * e4], m[4 * e4 + 1], m[4 * e4 + 2], m[4 * e4 + 3]}; }
        LDS_WAIT(); asm volatile("" ::: "memory");
        f32x4 v[8]; float s = 0.f;
#pragma unroll
        for (int k = 0; k < 8; ++k) { const int col = 256 * k + 4 * F.lane; const f32x4 mm = *(const LAS f32x4*)(Tw + col);
            const v2u xw = __builtin_nontemporal_load((const v2u*)(x1r + col)); const f32x4 x0 = (f32x4){bflo(xw.x), bfhi(xw.x), bflo(xw.y), bfhi(xw.y)}, g0 = *(const f32x4*)(gt2 + col);
            v[k] = x0 + g0 * (mm * (1.0f / YP_SCALE)); s += (v[k].x * v[k].x + v[k].y * v[k].y) + (v[k].z * v[k].z + v[k].w * v[k].w); }
        LDS_WAIT(); asm volatile("" ::: "memory");
        float rstd = __builtin_amdgcn_rsqf(wave_sum(s) * (1.0f / D) + 1e-6f);
#if defined(PROBE_PHASE)
        if (PROBE_PHASE >= 0) rstd *= 1.0f + (float)__hip_atomic_load(F.ctl + 12000, __ATOMIC_RELAXED, __HIP_MEMORY_SCOPE_AGENT) * 2e-6f;
#endif
#pragma unroll
        for (int k = 0; k < 8; ++k) { const int col = 256 * k + 4 * F.lane; __builtin_nontemporal_store(v[k] * rstd * *(const f32x4*)(fg + col), (f32x4*)(xr + col)); }
    }
}
#ifndef MK_ONE_LAUNCH
#define MK_ONE_LAUNCH 1
#endif
constexpr int NPHASE = 16;
__global__ void __launch_bounds__(512, 2) mk_fwd(Args args) {
    extern __shared__ __attribute__((aligned(16))) unsigned char lds[];
    Frame F;
    F.lds = (LAS unsigned char*)lds; F.MISC = (volatile LAS unsigned*)(F.lds + LDSCTL_OFF);
    int wave0 = __builtin_amdgcn_readfirstlane((int)threadIdx.x >> 6); asm volatile("" : "+s"(wave0));
    F.tid = threadIdx.x; F.lane = F.tid & 63; F.wave = wave0;
    F.G = gridDim.x; { const int bx = blockIdx.x; F.vcu = (F.G % 8 == 0) ? (bx % 8) * (F.G / 8) + bx / 8 : bx; }
    F.ws = args.ws; F.ctl = (unsigned*)(args.ws + WS_CTL);
    for (int u = F.tid; u < 256; u += 512) ((LAS unsigned*)(F.lds + LDSCTL_OFF))[u] = 0u;
    __syncthreads();
    XcdBarrier bar; bar.bar = F.ctl + CW_BAR; bar.x = 0; bar.st = nullptr;
    if (MK_ONE_LAUNCH) bar = xcd_barrier_post(F.ctl + CW_BAR, F.MISC + 8);
    const int lo = args.ph_lo, hi = args.ph_hi;
#ifndef PHMASK
#define PHMASK 0xFFFF
#endif
#define IN(k) (((PHMASK >> (k)) & 1) && lo <= (k) && (k) < hi)
#ifndef DUPMASK
#define DUPMASK 0
#endif
#define DUP(k) for (int rep_ = 0, nrep_ = opaque_n(1 + ((DUPMASK >> (k)) & 1)); rep_ < nrep_; ++rep_)
#define FRESH() do { int l_ = (int)__builtin_amdgcn_mbcnt_hi(~0u, __builtin_amdgcn_mbcnt_lo(~0u, 0u)); asm volatile("" : "+v"(l_)); int w_ = wave0; asm volatile("" : "+s"(w_)); F.lane = l_; F.wave = w_; F.tid = w_ * 64 + l_; { unsigned char* p_ = args.ws; asm volatile("" : "+s"(p_)); F.ws = p_; ws = p_; F.ctl = (unsigned*)(p_ + WS_CTL); } } while (0)
#define SEAM(k) do { if (MK_ONE_LAUNCH) { if (IN(k) && IN((k) + 1)) { xcd_barrier(bar); if ((DUPMASK >> 18) & 1) xcd_barrier(bar); } } } while (0)
    const int G = F.G, c = (int)blockIdx.x;
#ifndef PROBE_PHASE
#define PROBE_PHASE -1
#endif
    unsigned long long pt0_ = 0;
#define PSTART(k) do { if (PROBE_PHASE == (k)) pt0_ = __builtin_amdgcn_s_memrealtime(); } while (0)
#define PEND(k) do { if (PROBE_PHASE == (k) && blockIdx.x == 0 && threadIdx.x == 0) { const unsigned long long t1_ = __builtin_amdgcn_s_memrealtime(); __hip_atomic_store(F.ctl + 12000, (unsigned)(t1_ - pt0_), __ATOMIC_RELAXED, __HIP_MEMORY_SCOPE_AGENT); } } while (0)
    unsigned char* ws = args.ws;

    PSTART(0);
    if (IN(0)) DUP(0) { FRESH(); p0_prologue(F, args); } SEAM(0); PEND(0);
    PSTART(1);
    if (IN(1)) DUP(1) { FRESH(); p1_norm1(F, args); } SEAM(1); PEND(1);
    PSTART(2);
    if (IN(2)) DUP(2) { FRESH();
        const int g1 = (G == 256 && !NOCONV) ? 240 : G;
        if (c < g1) {
            G1Order S{(const char*)(ws + WS_HA), (const char*)(ws + WS_WIN), (size_t)256 * (P2_FP8 ? P2PITCH : D * 2), (size_t)256 * (P2_FP8 ? P2PITCH : D * 2), g1, c};
            EpiG1 E{(bf16*)(ws + WS_U), (bf16*)(ws + WS_SLAB), (unsigned char*)(ws + WS_GATES)};
            if (P2_FP8) pg8::gemm_phase<EpiG1, G1Order, false, true, 124>(F.lds + RING_OFF, F.wave, D / 2, P2PITCH / 2, P2PITCH / 2, S, E);
            else pg8::gemm_phase<EpiG1, G1Order, false>(F.lds + RING_OFF, F.wave, D, D, D, S, E);
            FRESH();
            if (F.tid == 0) (void)xb_add(F.ctl + CW_P2DONE, 1u);
        } else conv_steal(F, args, 8u);
    } SEAM(2); PEND(2);
    PSTART(3);
    if (IN(3)) DUP(3) { FRESH(); p3_prep(F, args); } SEAM(3); PEND(3);
    PSTART(4);
    if (IN(4)) DUP(4) { FRESH();
#ifndef NO4A
        {
            RepOrder S{(const char*)(ws + WS_LIN), (const char*)(ws + WS_LORA), (size_t)128 * 2, (size_t)D * 128 * 2, (size_t)256 * LINLD * 2, (size_t)256 * 128 * 2, MT / 256, D / 256, 4, G, c};
            EpiLora E{(unsigned short*)(ws + WS_EA), args.in[I_DW0], args.in[I_IA0]};
            pg8::gemm_phase<EpiLora, RepOrder, false>(F.lds + RING_OFF, F.wave, 128, LINLD, 128, S, E);
        }
#endif
    }
    if (IN(4)) DUP(4) { FRESH();
#ifndef NO4B
        {
            RepOrder S{(const char*)(ws + WS_DP), (const char*)(ws + WS_POOLW), (size_t)256 * 2, (size_t)256 * 256 * 2, (size_t)256 * 1024 * 2, (size_t)256 * 256 * 2, NT / 256, 1, 4, G, c};
            EpiPoolG E{(bf16*)(ws + WS_Y2), args.in[I_POOLS]};
            pg8::gemm_phase<EpiPoolG, RepOrder, false>(F.lds + RING_OFF, F.wave, 256, 1024, 256, S, E);
        }
#endif
    } SEAM(4); PEND(4);
    PSTART(5);
    if (IN(5)) DUP(5) { FRESH();
        RepOrder S{(const char*)(ws + WS_Y2), (const char*)(ws + WS_WPO), 0, 0, (size_t)256 * 1024 * (POOL_FP8 ? 1 : 2), (size_t)256 * 1024 * (POOL_FP8 ? 1 : 2), NT / 256, D / 256, 1, G, c};
        EpiMix<0> E{(bf16*)(ws + WS_MP), D, (const void*)(ws + WS_GATES), 4096, nullptr, 0};
        if (POOL_FP8) pg8::gemm_phase<EpiMix<0>, RepOrder, false, true, 124>(F.lds + RING_OFF, F.wave, 512, 512, 512, S, E);
        else pg8::gemm_phase<EpiMix<0>, RepOrder, false>(F.lds + RING_OFF, F.wave, 1024, 1024, 1024, S, E);
    }
    if (IN(5)) DUP(5) { FRESH();
        RepOrder S{(const char*)(ws + WS_LIN) + 512 * 2, (const char*)(ws + WS_G2), 0, 0, (size_t)256 * LINLD * 2, (size_t)256 * 256 * 2, NT / 256, D / 256, 1, G, c};
        EpiMix<3> E{(bf16*)(ws + WS_GG), D, nullptr, 0, nullptr, 0};
        pg8::gemm_phase<EpiMix<3>, RepOrder, false>(F.lds + RING_OFF, F.wave, 256, LINLD, 256, S, E);
    }
    PSTART(6);
    if (IN(6)) DUP(6) { FRESH(); p6_scan(F, args); if ((DUPMASK >> 19) & 1) { FRESH(); p6_scan(F, args); } } SEAM(6); PEND(6);
    PSTART(7);
    if (IN(7)) DUP(7) { FRESH(); p7_readout(F, args); } SEAM(7); PEND(7);
    PSTART(8);
    PSTART(9);
    if (IN(9)) DUP(9) { FRESH();
        RepOrder S{(const char*)(ws + WS_OR), (const char*)(ws + WS_WRO), 0, 0, (size_t)256 * D * (MIX_FP8 ? 1 : 2), (size_t)256 * D * (MIX_FP8 ? 1 : 2), NT / 256, D / 256, 1, G, c};
        EpiMix<2, MIX_FP8 != 0> E{(bf16*)(ws + WS_Z), D, (const void*)(ws + WS_GATES + 2048), 4096, (const bf16*)(ws + WS_MP), D};
        if (MIX_FP8) pg8::gemm_phase<EpiMix<2, MIX_FP8 != 0>, RepOrder, false, true, 124>(F.lds + RING_OFF, F.wave, D / 2, D / 2, D / 2, S, E);
        else pg8::gemm_phase<EpiMix<2, MIX_FP8 != 0>, RepOrder, false>(F.lds + RING_OFF, F.wave, D, D, D, S, E);
    } SEAM(9); PEND(9);
    PSTART(10);
    if (IN(10)) DUP(10) { FRESH();
        RepOrder S{(const char*)(ws + WS_Z), (const char*)(ws + WS_WO), 0, 0, (size_t)256 * D * (MIX_FP8 ? 1 : 2), (size_t)256 * D * (MIX_FP8 ? 1 : 2), NT / 256, D / 256, 1, G, c};
        EpiX1 E{args.in[I_X], (bf16*)(ws + WS_X1), (const float*)(ws + WS_MOD)};
        if (MIX_FP8) pg8::gemm_phase<EpiX1, RepOrder, false, true, 124>(F.lds + RING_OFF, F.wave, D / 2, D / 2, D / 2, S, E);
        else pg8::gemm_phase<EpiX1, RepOrder, false>(F.lds + RING_OFF, F.wave, D, D, D, S, E);
    } SEAM(10); PEND(10);
    PSTART(11);
    if (IN(11)) DUP(11) { FRESH(); p11_route(F, args); } SEAM(11); PEND(11);
    PSTART(12);
    if (!NOP12) { if (IN(12)) DUP(12) { FRESH(); p12_slots(F); } SEAM(12); } PEND(12);
    PSTART(13);
    if (IN(13)) DUP(13) { FRESH();
        const int ntiles = moe_tables(F);
        MoeOrderT<true> S{(const char*)(ws + WS_H2), (const char*)ws, (const LAS int*)(F.lds + TAB_OFF), (const LAS int*)(F.lds + ROWTAB_OFF), 0, (size_t)1024 * D * 2, (size_t)256 * D, ntiles, 4, G, c};
        { LAS int* rt = (LAS int*)(F.lds + ROWTAB_OFF); const int* tok = (const int*)(ws + (NOP12 ? WS_TOKE : WS_TOK));
          const LAS int* offp = (const LAS int*)(F.lds + TAB_OFF) + MAXTILES;
          int tv[12]; const int tl_ = F.tid & 255;
#pragma unroll
          for (int i = 0; i < 12; ++i) { Unit uu; uu.pm = 0; uu.aux = 0; const bool ok = S.next(i, uu);
              if (NOP12) { const int e = uu.aux, s = uu.pm * 256 + tl_; const int idx = s - offp[e < 64 ? e : 64]; const bool ld = ok && e < 64 && idx < offp[66 + (e < 64 ? e : 0)];
                  const int x = tok[ld ? (size_t)e * NT + idx : 0]; tv[i] = (e < 64) ? (ld ? x : 0) : idx; }
              else tv[i] = tok[(ok ? uu.pm * 256 : 0) + tl_]; }
#pragma unroll
          for (int i = 0; i < 12; ++i) if (F.tid < 256) rt[i * 256 + F.tid] = tv[i];
          { Unit uu; for (int i = 12; i < ROWTAB_UNITS && S.next(i, uu); ++i) if (F.tid < 256) {
                if (NOP12) { const int e = uu.aux, idx = uu.pm * 256 + F.tid - offp[e < 64 ? e : 64]; rt[i * 256 + F.tid] = (e < 64) ? (idx < offp[66 + (e < 64 ? e : 0)] ? tok[(size_t)e * NT + idx] : 0) : idx; }
                else rt[i * 256 + F.tid] = tok[uu.pm * 256 + F.tid]; } }
          __syncthreads(); }
        EpiAct E{ws + WS_ACT};
        pg8::gemm_phase<EpiAct, MoeOrderT<true>, true, true, 124>(F.lds + RING_OFF, F.wave, D / 2, D / 2, D / 2, S, E);
    } SEAM(13); PEND(13);
    PSTART(14);
    if (IN(14)) DUP(14) { FRESH();
        const int ntiles = moe_tables(F);
        MoeOrderT<false> S{(const char*)(ws + WS_ACT), (const char*)(ws + WS_DT), (const LAS int*)(F.lds + TAB_OFF), (const LAS int*)(F.lds + ROWTAB_OFF), (size_t)256 * DEXP, (size_t)D * DEXP, (size_t)256 * DEXP, ntiles, 8, G, c};
        EpiDown E{(unsigned char*)(ws + WS_YP)};
        if (STAGGER14 && (c & 8)) { for (int i_ = 0; i_ < STAGGER14; ++i_) __builtin_amdgcn_s_sleep(127); }
        pg8::gemm_phase<EpiDown, MoeOrderT<false>, false, true, 124>(F.lds + RING_OFF, F.wave, DEXP / 2, DEXP / 2, DEXP / 2, S, E);
    } SEAM(14); PEND(14);
    PSTART(15);
    if (IN(15)) DUP(15) { FRESH(); p15_final(F, args); }
#undef IN
#undef SEAM
}

extern "C" void kernel_launch(void* const* d_in, const int* in_sizes, int n_in, void* d_out, int out_size, void* d_ws, size_t ws_size, hipStream_t stream) {
    static int grid = 0;
    if (grid == 0) {
        if (n_in != 34 || in_sizes[0] != NT * D || out_size != NT * D || ws_size < WS_END) { fprintf(stderr, "kernel_launch: unexpected shapes (n_in %d, in0 %d, out %d, ws %zu < %zu)\n", n_in, n_in > 0 ? in_sizes[0] : -1, out_size, ws_size, (size_t)WS_END); grid = -1; return; }
        int dev = 0, cus = 0, per_cu = 0;
        if (hipGetDevice(&dev) != hipSuccess || hipDeviceGetAttribute(&cus, hipDeviceAttributeMultiprocessorCount, dev) != hipSuccess) { grid = -1; return; }
        if (hipFuncSetAttribute((const void*)mk_fwd, hipFuncAttributeMaxDynamicSharedMemorySize, LDS_BYTES) != hipSuccess) { fprintf(stderr, "kernel_launch: hipFuncSetAttribute failed\n"); grid = -1; return; }
        if (hipOccupancyMaxActiveBlocksPerMultiprocessor(&per_cu, (const void*)mk_fwd, 512, LDS_BYTES) != hipSuccess || per_cu < 1) fprintf(stderr, "kernel_launch: occupancy query reports %d\n", per_cu);
        (void)hipGetLastError();
        grid = cus;
    }
    if (grid < 0) return;
    if (hipMemsetAsync((char*)d_ws + WS_CTL, 0, CTL_ZERO_BYTES, stream) != hipSuccess) return;
    Args a{};
    for (int i = 0; i < 34; ++i) a.in[i] = (const float*)d_in[i];
    a.out = (float*)d_out; a.ws = (unsigned char*)d_ws;
#if MK_ONE_LAUNCH
    a.ph_lo = 0; a.ph_hi = NPHASE;
    hipLaunchKernelGGL(mk_fwd, dim3(grid), dim3(512), LDS_BYTES, stream, a);
#else
    for (int p = 0; p < NPHASE; ++p) { a.ph_lo = p; a.ph_hi = p + 1; hipLaunchKernelGGL(mk_fwd, dim3(grid), dim3(512), LDS_BYTES, stream, a); }
#endif
}
```
